# Optimizing an MI355X kernel written in HIP

```python
import jax
import jax.numpy as jnp
from jax import lax
import numpy as np

D_MODEL = 2048
BATCH = 8
SEQ = 2048
DEPTH = 4
DEC_BATCH = 8
DEC_SEQ = 64
PAST_LEN = 1024

CHUNK = 64
PLE_DIM = 256
POOL_WINDOWS = (2, 4, 8, 16)
POOL_GROUPS = 4
POOL_WIDTH = D_MODEL // 2
POOL_GC = POOL_WIDTH // POOL_GROUPS
POOL_PAST = max(POOL_WINDOWS) - 1
RW_WIDTH = D_MODEL // 2
RW_HEAD = 64
RW_HEADS = RW_WIDTH // RW_HEAD
DECAY_LORA = 64
AAA_LORA = 64
GATE_LORA = 160
RW_PROJ = 3 * RW_WIDTH + DECAY_LORA + AAA_LORA + GATE_LORA
IN_COLS = POOL_WIDTH + RW_PROJ + 2 * D_MODEL
D_FF = ((8 * D_MODEL + 3 * 256 - 1) // (3 * 256)) * 256
NORM_EPS = 1e-6
GN_EPS = 64e-5

kernel_name = 'hybrid_pool_rwkv7_stream_step'


def rmsnorm(x, g):
    xf = x.astype(jnp.float32)
    y = xf * lax.rsqrt(jnp.mean(xf * xf, axis=-1, keepdims=True) + NORM_EPS)
    return (y * g.astype(jnp.float32)).astype(x.dtype)


def pool_mixer(u, past, pos0, pool_w, pool_scale):
    B, T, _ = u.shape
    z = jnp.concatenate([past.astype(u.dtype), u], axis=1)
    zf = z.astype(jnp.float32)
    c = jnp.concatenate([jnp.zeros((B, 1, POOL_WIDTH), jnp.float32), jnp.cumsum(zf, axis=1)], axis=1)
    pos = pos0 + jnp.arange(T, dtype=jnp.int32)
    means = []
    for gi, win in enumerate(POOL_WINDOWS):
        sl = slice(gi * POOL_GC, (gi + 1) * POOL_GC)
        hi = c[:, POOL_PAST + 1:POOL_PAST + 1 + T, sl]
        lo = c[:, POOL_PAST + 1 - win:POOL_PAST + 1 - win + T, sl]
        cnt = jnp.minimum(pos + 1, win).astype(jnp.float32)[None, :, None]
        means.append((hi - lo) / cnt)
    d = jnp.concatenate(means, axis=-1) - zf[:, POOL_PAST:]
    d = d.astype(u.dtype).reshape(B, T, POOL_GROUPS, POOL_GC)
    y = jnp.einsum('btgc,gcd->btgd', d, pool_w).reshape(B, T, POOL_WIDTH) * pool_scale
    return y, z[:, -POOL_PAST:]


def wkv7_scan(r, decay, k, v, kk, b, S0):
    def step(S, xs):
        r_t, w_t, k_t, v_t, kk_t, b_t = xs
        sa = jnp.einsum('bhvk,bhk->bhv', S, -kk_t)
        S = S * w_t[:, :, None, :] + sa[..., None] * b_t[:, :, None, :] + v_t[..., None] * k_t[:, :, None, :]
        y = jnp.einsum('bhvk,bhk->bhv', S, r_t)
        return S, y
    xs = tuple(jnp.moveaxis(a, 1, 0) for a in (r, decay, k, v, kk, b))
    S, ys = lax.scan(step, S0, xs)
    return jnp.moveaxis(ys, 0, 1), S


def rwkv7_mix(rw, shift_prev, S0, mu, w0, w_decay_up, a0, w_aaa_up, w_gate_up, k_k, k_a, r_k, gn_gain, gn_bias):
    B, T, _ = rw.shape
    prev = jnp.concatenate([shift_prev[:, None].astype(rw.dtype), rw[:, :-1]], axis=1)
    xm = rw + (prev - rw) * mu
    r, k, v, wd, ad, gd = jnp.split(
        xm, [RW_WIDTH, 2 * RW_WIDTH, 3 * RW_WIDTH, 3 * RW_WIDTH + DECAY_LORA,
             3 * RW_WIDTH + DECAY_LORA + AAA_LORA], axis=-1)
    w = -jax.nn.softplus(-(w0 + jnp.tanh(wd) @ w_decay_up)) - 0.5
    decay = jnp.exp(-jnp.exp(w.astype(jnp.float32)))
    a = jax.nn.sigmoid(a0 + ad @ w_aaa_up)
    g = jax.nn.sigmoid(gd) @ w_gate_up
    heads = lambda t: t.astype(jnp.float32).reshape(B, T, RW_HEADS, RW_HEAD)
    kk = heads(k * k_k)
    kk = kk / jnp.maximum(jnp.sqrt(jnp.sum(kk * kk, axis=-1, keepdims=True)), 1e-12)
    aH = heads(a)
    kH = heads(k * (1.0 + (a - 1.0) * k_a))
    rH = heads(r)
    vH = heads(v)
    y, S = wkv7_scan(rH, heads(decay), kH, vH, kk, kk * aH, S0.astype(jnp.float32))
    mean = jnp.mean(y, axis=-1, keepdims=True)
    var = jnp.mean(jnp.square(y - mean), axis=-1, keepdims=True)
    y = ((y - mean) * lax.rsqrt(var + GN_EPS)).reshape(B, T, RW_WIDTH)
    y = y * gn_gain.astype(jnp.float32) + gn_bias.astype(jnp.float32)
    bonus = (jnp.sum(rH * kH * r_k.astype(jnp.float32), axis=-1, keepdims=True) * vH).reshape(B, T, RW_WIDTH)
    y = (y + bonus) * g.astype(jnp.float32)
    return y.astype(rw.dtype), rw[:, -1], S.astype(S0.dtype)


def trunk_layer(x, p, shift_prev, pool_past, S0, pos0,
                norm_mix, w_in, mu_shift, pool_w, pool_scale, w0, w_decay_up, a0, w_aaa_up, w_gate_up,
                k_k, k_a, r_k, gn_gain, gn_bias, proj_pool, proj_rwkv, w_out,
                norm_ffn, w_ffn_gate, w_ffn_up, w_ffn_down, norm_ple, w_ple_gate, w_ple_proj):
    h = rmsnorm(x, norm_mix)
    proj = h @ w_in
    u_pool, u_rw, g_pool, g_rw = jnp.split(
        proj, [POOL_WIDTH, POOL_WIDTH + RW_PROJ, POOL_WIDTH + RW_PROJ + D_MODEL], axis=-1)
    y_a, new_pool = pool_mixer(u_pool, pool_past, pos0, pool_w, pool_scale)
    y_b, new_shift, S = rwkv7_mix(u_rw, shift_prev, S0, mu_shift, w0, w_decay_up, a0, w_aaa_up,
                                  w_gate_up, k_k, k_a, r_k, gn_gain, gn_bias)
    merged = jax.nn.sigmoid(g_pool) * (y_a @ proj_pool) + jax.nn.sigmoid(g_rw) * (y_b @ proj_rwkv)
    x = x + merged @ w_out
    h2 = rmsnorm(x, norm_ffn)
    x = x + (jax.nn.silu(h2 @ w_ffn_gate) * (h2 @ w_ffn_up)) @ w_ffn_down
    h3 = rmsnorm(x, norm_ple)
    x = x + jax.nn.sigmoid(h3 @ w_ple_gate) * (p @ w_ple_proj)
    return x, new_shift, new_pool, S


def setup_inputs(seed: int = 0) -> dict:
    key = jax.random.key(seed)
    ks = iter(jax.random.split(key, 40))
    nrm = lambda shape, scale: jax.random.normal(next(ks), shape, jnp.float32) * scale
    unif = lambda shape, lo, hi: jax.random.uniform(next(ks), shape, jnp.float32, lo, hi)
    L = DEPTH
    return {
        'x_prompt': nrm((BATCH, SEQ, D_MODEL), 1.0),
        'x_sample': nrm((DEC_BATCH, DEC_SEQ, D_MODEL), 1.0),
        'state_shift': nrm((L, DEC_BATCH, RW_PROJ), 1.0),
        'state_pool': nrm((L, DEC_BATCH, POOL_PAST, POOL_WIDTH), 1.0),
        'state_wkv': nrm((L, DEC_BATCH, RW_HEADS, RW_HEAD, RW_HEAD), 0.5),
        'p_prompt': nrm((L, BATCH, SEQ, PLE_DIM), 1.0),
        'p_sample': nrm((L, DEC_BATCH, DEC_SEQ, PLE_DIM), 1.0),
        'norm_mix': 1.0 + nrm((L, D_MODEL), 0.05),
        'w_in': nrm((L, D_MODEL, IN_COLS), D_MODEL ** -0.5),
        'mu_shift': unif((L, RW_PROJ), 0.0, 1.0),
        'pool_w': nrm((L, POOL_GROUPS, POOL_GC, POOL_GC), POOL_GC ** -0.5),
        'pool_scale': 1.0 + nrm((L, POOL_WIDTH), 0.1),
        'w0': unif((L, RW_WIDTH), -5.0, 0.5),
        'w_decay_up': nrm((L, DECAY_LORA, RW_WIDTH), 0.1 * DECAY_LORA ** -0.5),
        'a0': nrm((L, RW_WIDTH), 0.5),
        'w_aaa_up': nrm((L, AAA_LORA, RW_WIDTH), AAA_LORA ** -0.5),
        'w_gate_up': nrm((L, GATE_LORA, RW_WIDTH), GATE_LORA ** -0.5),
        'k_k': 0.85 + nrm((L, RW_WIDTH), 0.05),
        'k_a': 1.0 + nrm((L, RW_WIDTH), 0.05),
        'r_k': nrm((L, RW_HEADS, RW_HEAD), 0.1),
        'gn_gain': 1.0 + nrm((L, RW_WIDTH), 0.05),
        'gn_bias': nrm((L, RW_WIDTH), 0.01),
        'proj_pool': nrm((L, POOL_WIDTH, D_MODEL), POOL_WIDTH ** -0.5),
        'proj_rwkv': nrm((L, RW_WIDTH, D_MODEL), RW_WIDTH ** -0.5),
        'w_out': nrm((L, D_MODEL, D_MODEL), D_MODEL ** -0.5),
        'norm_ffn': 1.0 + nrm((L, D_MODEL), 0.05),
        'w_ffn_gate': nrm((L, D_MODEL, D_FF), D_MODEL ** -0.5),
        'w_ffn_up': nrm((L, D_MODEL, D_FF), D_MODEL ** -0.5),
        'w_ffn_down': nrm((L, D_FF, D_MODEL), D_FF ** -0.5),
        'norm_ple': 1.0 + nrm((L, D_MODEL), 0.05),
        'w_ple_gate': nrm((L, D_MODEL, D_MODEL), D_MODEL ** -0.5),
        'w_ple_proj': nrm((L, PLE_DIM, D_MODEL), PLE_DIM ** -0.5),
        'norm_final': 1.0 + nrm((D_MODEL,), 0.05),
    }


def reference(x_prompt, x_sample, state_shift, state_pool, state_wkv, p_prompt, p_sample,
              norm_mix, w_in, mu_shift, pool_w, pool_scale, w0, w_decay_up, a0, w_aaa_up, w_gate_up,
              k_k, k_a, r_k, gn_gain, gn_bias, proj_pool, proj_rwkv, w_out,
              norm_ffn, w_ffn_gate, w_ffn_up, w_ffn_down, norm_ple, w_ple_gate, w_ple_proj, norm_final):
    def layer_params(i):
        return (norm_mix[i], w_in[i], mu_shift[i], pool_w[i], pool_scale[i], w0[i], w_decay_up[i], a0[i],
                w_aaa_up[i], w_gate_up[i], k_k[i], k_a[i], r_k[i], gn_gain[i], gn_bias[i], proj_pool[i],
                proj_rwkv[i], w_out[i], norm_ffn[i], w_ffn_gate[i], w_ffn_up[i], w_ffn_down[i], norm_ple[i],
                w_ple_gate[i], w_ple_proj[i])

    bp = x_prompt.shape[0]
    x = x_prompt
    sh_p, po_p, wk_p = [], [], []
    for i in range(DEPTH):
        x, s_sh, s_po, s_wk = trunk_layer(
            x, p_prompt[i], jnp.zeros((bp, RW_PROJ), x.dtype), jnp.zeros((bp, POOL_PAST, POOL_WIDTH), x.dtype),
            jnp.zeros((bp, RW_HEADS, RW_HEAD, RW_HEAD), jnp.float32), 0, *layer_params(i))
        sh_p.append(s_sh)
        po_p.append(s_po)
        wk_p.append(s_wk)
    y_prompt = rmsnorm(x, norm_final)

    x = x_sample
    sh_s, po_s, wk_s = [], [], []
    for i in range(DEPTH):
        x, s_sh, s_po, s_wk = trunk_layer(
            x, p_sample[i], state_shift[i], state_pool[i], state_wkv[i], PAST_LEN, *layer_params(i))
        sh_s.append(s_sh)
        po_s.append(s_po)
        wk_s.append(s_wk)
    y_sample = rmsnorm(x, norm_final)

    return (y_prompt, y_sample,
            jnp.stack(sh_p), jnp.stack(po_p), jnp.stack(wk_p),
            jnp.stack(sh_s), jnp.stack(po_s), jnp.stack(wk_s))
```

```cpp
#include <hip/hip_runtime.h>
#include <cstdio>
#include <cstdint>
#include <cstring>

#ifndef MK_PER_PHASE
#define MK_PER_PHASE 0
#endif

#define LAS __attribute__((address_space(3)))
typedef unsigned short bf16_t;
typedef short bf16x8 __attribute__((ext_vector_type(8)));
typedef float f32x4 __attribute__((ext_vector_type(4)));
typedef float f32x2 __attribute__((ext_vector_type(2)));
typedef unsigned u32x4 __attribute__((ext_vector_type(4)));
typedef unsigned u32x2 __attribute__((ext_vector_type(2)));

constexpr int DM = 2048, NL = 4, MT = 16896, MPR = 16384, TP = 2048, TS = 64;
constexpr int PWD = 1024, RWD = 1024, RPJ = 3360, ICOLS = 8480, ICP = 8704, FF = 5632, PLE = 256, LK = 384;
constexpr int PC_GP = 4608, PC_GR = 6656;
constexpr float NORM_EPS = 1e-6f, GN_EPS = 64e-5f;
constexpr size_t O_YS = 33554432, O_SHP = 34603008, O_POP = 34710528, O_WKP = 35202048, O_SHS = 37299200, O_POS = 37406720, O_WKS = 37898240, O_END = 39995392;

__device__ __forceinline__ unsigned cvt_pk_bf16(float lo, float hi) { unsigned r; asm volatile("v_cvt_pk_bf16_f32 %0, %1, %2" : "=v"(r) : "v"(lo), "v"(hi)); return r; }
__device__ __forceinline__ float bf_lo(unsigned u) { return __uint_as_float(u << 16); }
__device__ __forceinline__ float bf_hi(unsigned u) { return __uint_as_float(u & 0xffff0000u); }
__device__ __forceinline__ void unpack8(const u32x4 w, float (&f)[8]) { f[0] = bf_lo(w.x); f[1] = bf_hi(w.x); f[2] = bf_lo(w.y); f[3] = bf_hi(w.y); f[4] = bf_lo(w.z); f[5] = bf_hi(w.z); f[6] = bf_lo(w.w); f[7] = bf_hi(w.w); }
__device__ __forceinline__ u32x4 pack8(const float (&f)[8]) { u32x4 w; w.x = cvt_pk_bf16(f[0], f[1]); w.y = cvt_pk_bf16(f[2], f[3]); w.z = cvt_pk_bf16(f[4], f[5]); w.w = cvt_pk_bf16(f[6], f[7]); return w; }
__device__ __forceinline__ float sigmoidf_(float x) { return __builtin_amdgcn_rcpf(1.0f + __expf(-x)); }
__device__ __forceinline__ f32x4 sigmoid4(f32x4 v) { f32x4 o; o.x = sigmoidf_(v.x); o.y = sigmoidf_(v.y); o.z = sigmoidf_(v.z); o.w = sigmoidf_(v.w); return o; }
__device__ __forceinline__ float tanhf_(float x) { const float e = __expf(2.0f * x); return 1.0f - 2.0f * __builtin_amdgcn_rcpf(e + 1.0f); }
template <int CTRL> __device__ __forceinline__ float dpp_f(float x) { return __uint_as_float((unsigned)__builtin_amdgcn_update_dpp(0, (int)__float_as_uint(x), CTRL, 0xF, 0xF, true)); }
__device__ __forceinline__ float sum8(float x) { x += dpp_f<0xB1>(x); x += dpp_f<0x4E>(x); x += dpp_f<0x141>(x); return x; }
__device__ __forceinline__ float wave_sum(float v) {
#pragma unroll
    for (int o = 1; o < 64; o <<= 1) v += __shfl_xor(v, o);
    return v;
}

namespace pg8 {
constexpr int BM = 256, BK = 64, HALF = 128, HTB = HALF * BK * 2  , STAGE_BYTES = 8 * HTB, NXCD = 8, WGM = 8;
__host__ __device__ __forceinline__ int lds_byte(int r, int c) { const int st = (r >> 4) * 2 + (c >> 5), rr = r & 15, cc = c & 31, ob = rr * 64 + cc * 2; return st * 1024 + (ob ^ (((ob >> 9) & 1) << 5)); }
__host__ __device__ __forceinline__ void stage_rc(int b, int& R, int& C) { const int st = b / 1024, sb = b % 1024, swz = sb ^ (((sb >> 9) & 1) << 5); R = (st >> 1) * 16 + swz / 64; C = (st & 1) * 32 + (swz % 64) / 2; }
__host__ __device__ __forceinline__ int perm32(int rho) { const int n = rho >> 4, i = rho & 15; return 8 * (i >> 2) + 4 * n + (i & 3); }

struct Unit { int pm, pn; };
struct Gemm { const bf16_t* A; const bf16_t* Bt; int M, N, K, lda, ldb, a_pn_off; };

struct StaticOrder {
    int nM, nN, nwg, G, c;
    __host__ __device__ void init(int M, int N, int G_, int c_) { nM = M / BM; nN = N / BM; nwg = nM * nN; G = G_; c = c_; }
    __host__ __device__ bool next(int i, Unit& u) const {
        const long L = (long)i * G + c; if (L >= nwg) return false;
        int wgid = (int)L; { const int q = nwg / NXCD, r = nwg % NXCD, xcd = wgid % NXCD, off = wgid / NXCD; wgid = (xcd < r ? xcd * (q + 1) : r * (q + 1) + (xcd - r) * q) + off; }
        const int nig = WGM * nN, gid = wgid / nig, fm = gid * WGM, gsz = (nM - fm) < WGM ? (nM - fm) : WGM;
        u.pm = fm + ((wgid % nig) % gsz); u.pn = (wgid % nig) / gsz; return true;
    }
    __device__ __forceinline__ void a_ready(const Unit&) const {}
    __device__ __forceinline__ void done(const Unit&) const {}
};

template <class Epi, class Sched, bool ALIGN_EPI>
__device__ __forceinline__ void gemm_phase(LAS unsigned char* lds, const Gemm g, const Sched& S, const Epi& E) {
    int tid_ = threadIdx.x; asm volatile("" : "+v"(tid_));
    const int tid = tid_, wid = __builtin_amdgcn_readfirstlane(tid >> 6), lane = tid & 63, wr = wid >> 2, wc = wid & 3, fr = lane & 15, fq = lane >> 4;
    int K_ = g.K; asm volatile("" : "+s"(K_));
    const int K = K_, nt = K / BK;
    unsigned voffA[2], voffB[2];
#pragma unroll
    for (int i = 0; i < 2; ++i) { int R, C; stage_rc(tid * 16 + i * 8192, R, C); const int Rb = (R & ~31) + perm32(R & 31);
        voffA[i] = (unsigned)(R * g.lda + C) * 2u; voffB[i] = (unsigned)(Rb * g.ldb + C) * 2u; }
    const size_t kstep = (size_t)(BK * 2);
    const size_t hstepA = (size_t)HALF * g.lda * 2, hstepB = (size_t)HALF * g.ldb * 2;
    const unsigned ldsw = (unsigned)wid * 1024u;
    const int aoff = lds_byte(wr * 64 + fr, fq * 8), boff = lds_byte(wc * 32 + fr, fq * 8);
#define PG8_SA(b, h) (((b) * 2 + (h)) * HTB)
#define PG8_SB(b, h) ((4 + (b) * 2 + (h)) * HTB)
#define PG8_STAGE(bufoff, gbase, voff) do { _Pragma("unroll") for (int _i = 0; _i < 2; ++_i) \
        __builtin_amdgcn_global_load_lds((const unsigned*)((const char*)(gbase) + (voff)[_i]), (LAS unsigned*)(lds + (bufoff) + ldsw + _i * 8192), 16, 0, 0); } while (0)
#define PG8_LDA(dst, b, h) do { _Pragma("unroll") for (int m = 0; m < 4; ++m) _Pragma("unroll") for (int k = 0; k < 2; ++k) dst[m][k] = *(const LAS bf16x8*)(lds + PG8_SA(b, h) + aoff + m * 2048 + k * 1024); } while (0)
#define PG8_LDB(dst, b, h) do { _Pragma("unroll") for (int n = 0; n < 2; ++n) _Pragma("unroll") for (int k = 0; k < 2; ++k) dst[n][k] = *(const LAS bf16x8*)(lds + PG8_SB(b, h) + boff + n * 2048 + k * 1024); } while (0)
#define PG8_MMA(ai, bj, At, Bt) do { __builtin_amdgcn_s_setprio(1); _Pragma("unroll") for (int m = 0; m < 4; ++m) _Pragma("unroll") for (int n = 0; n < 2; ++n) _Pragma("unroll") for (int k = 0; k < 2; ++k) \
        acc[ai][bj][m][n] = __builtin_amdgcn_mfma_f32_16x16x32_bf16(Bt[n][k], At[m][k], acc[ai][bj][m][n], 0, 0, 0); __builtin_amdgcn_s_setprio(0); } while (0)
#define PG8_WAIT_V(n) asm volatile("s_waitcnt vmcnt(" #n ")" ::: "memory")
#define PG8_WAIT_L(n) asm volatile("s_waitcnt lgkmcnt(" #n ")" ::: "memory")
#define PG8_BAR __builtin_amdgcn_s_barrier()
#define PG8_SCHED __builtin_amdgcn_sched_barrier(0)
    Unit cur, nxt; int ui = 0;
    if (!S.next(0, cur)) return;
    f32x4 acc[2][2][4][2];
#pragma unroll
    for (int a = 0; a < 2; ++a)
#pragma unroll
        for (int b = 0; b < 2; ++b)
#pragma unroll
            for (int m = 0; m < 4; ++m)
#pragma unroll
                for (int n = 0; n < 2; ++n) acc[a][b][m][n] = (f32x4){0.f, 0.f, 0.f, 0.f};
    bf16x8 At[4][2], B0[2][2], B1[2][2];
    const char* cA = (const char*)g.A + ((size_t)cur.pm * BM * g.lda + (size_t)cur.pn * g.a_pn_off) * 2; const char* cB = (const char*)g.Bt + (size_t)cur.pn * BM * g.ldb * 2;
    S.a_ready(cur);
    PG8_STAGE(PG8_SB(0, 0), cB, voffB); PG8_STAGE(PG8_SB(0, 1), cB + hstepB, voffB); PG8_STAGE(PG8_SA(0, 0), cA, voffA); PG8_STAGE(PG8_SA(0, 1), cA + hstepA, voffA);
    if (wr == 1) PG8_BAR;
    PG8_WAIT_V(2); PG8_BAR;
    PG8_STAGE(PG8_SB(1, 0), cB + kstep, voffB); PG8_STAGE(PG8_SA(1, 0), cA + kstep, voffA); PG8_STAGE(PG8_SB(1, 1), cB + hstepB + kstep, voffB);
    PG8_WAIT_V(6); PG8_BAR;
    for (;;) {
        const bool has_next = S.next(ui + 1, nxt);
        const char* nA = has_next ? (const char*)g.A + ((size_t)nxt.pm * BM * g.lda + (size_t)nxt.pn * g.a_pn_off) * 2 : cA; const char* nB = has_next ? (const char*)g.Bt + (size_t)nxt.pn * BM * g.ldb * 2 : cB;
#pragma unroll 1
        for (int t = 0; t < nt; t += 2) {
            const bool last = (t == nt - 2);
            const char* a1 = cA + (size_t)(t + 1) * kstep;
            const char* a2 = last ? nA : cA + (size_t)(t + 2) * kstep; const char* b2 = last ? nB : cB + (size_t)(t + 2) * kstep;
            const char* a3 = a2 + kstep; const char* b3 = b2 + kstep;
            if (last && has_next) S.a_ready(nxt);
            PG8_LDB(B0, 0, 0); PG8_LDB(B1, 0, 1); PG8_SCHED; PG8_LDA(At, 0, 0); PG8_STAGE(PG8_SA(1, 1), a1 + hstepA, voffA);
            PG8_WAIT_V(8); PG8_WAIT_L(0); PG8_BAR; PG8_MMA(0, 0, At, B0); PG8_MMA(0, 1, At, B1); PG8_BAR; PG8_SCHED;
            PG8_LDA(At, 0, 1); PG8_STAGE(PG8_SB(0, 0), b2, voffB); PG8_STAGE(PG8_SB(0, 1), b2 + hstepB, voffB); PG8_STAGE(PG8_SA(0, 0), a2, voffA);
            PG8_WAIT_V(8); PG8_WAIT_L(0); PG8_BAR; PG8_MMA(1, 0, At, B0); PG8_MMA(1, 1, At, B1); PG8_BAR; PG8_SCHED;
            PG8_LDB(B0, 1, 0); PG8_LDB(B1, 1, 1); PG8_SCHED; PG8_LDA(At, 1, 0); PG8_STAGE(PG8_SA(0, 1), a2 + hstepA, voffA);
            PG8_WAIT_V(8); PG8_WAIT_L(0); PG8_BAR; PG8_MMA(0, 0, At, B0); PG8_MMA(0, 1, At, B1); PG8_BAR; PG8_SCHED;
            PG8_LDA(At, 1, 1); PG8_STAGE(PG8_SB(1, 0), b3, voffB); PG8_STAGE(PG8_SB(1, 1), b3 + hstepB, voffB); PG8_STAGE(PG8_SA(1, 0), a3, voffA);
            PG8_WAIT_V(8); PG8_WAIT_L(0); PG8_BAR; PG8_MMA(1, 0, At, B0); PG8_MMA(1, 1, At, B1); PG8_BAR; PG8_SCHED;
        }
        if constexpr (ALIGN_EPI) { if (wr == 0) PG8_BAR; }
        E(acc, cur, wr, wc, fr, fq); S.done(cur);
        if (!has_next) break;
#pragma unroll
        for (int a = 0; a < 2; ++a)
#pragma unroll
            for (int b = 0; b < 2; ++b)
#pragma unroll
                for (int m = 0; m < 4; ++m)
#pragma unroll
                    for (int n = 0; n < 2; ++n) acc[a][b][m][n] = (f32x4){0.f, 0.f, 0.f, 0.f};
        cur = nxt; cA = nA; cB = nB; ++ui;
        if constexpr (ALIGN_EPI) { if (wr == 1) PG8_BAR; }
    }
    PG8_WAIT_V(0);
    if constexpr (!ALIGN_EPI) { if (wr == 0) PG8_BAR; }
    PG8_BAR;
#undef PG8_SA
#undef PG8_SB
#undef PG8_STAGE
#undef PG8_LDA
#undef PG8_LDB
#undef PG8_MMA
#undef PG8_WAIT_V
#undef PG8_WAIT_L
#undef PG8_BAR
#undef PG8_SCHED
}

#define EPI_ROW0 (u.pm * BM + wr * 64 + fr)
#define EPI_FOR_AI_M _Pragma("unroll") for (int ai = 0; ai < 2; ++ai) _Pragma("unroll") for (int m = 0; m < 4; ++m)
__device__ __forceinline__ u32x4 pack_f4x2(f32x4 v0, f32x4 v1) { u32x4 w; w.x = cvt_pk_bf16(v0[0], v0[1]); w.y = cvt_pk_bf16(v0[2], v0[3]); w.z = cvt_pk_bf16(v1[0], v1[1]); w.w = cvt_pk_bf16(v1[2], v1[3]); return w; }
__device__ __forceinline__ void unpack_f4x2(u32x4 w, f32x4& v0, f32x4& v1) { v0[0] = bf_lo(w.x); v0[1] = bf_hi(w.x); v0[2] = bf_lo(w.y); v0[3] = bf_hi(w.y); v1[0] = bf_lo(w.z); v1[1] = bf_hi(w.z); v1[2] = bf_lo(w.w); v1[3] = bf_hi(w.w); }

struct EpiProj {
    bf16_t* O;
    __device__ __forceinline__ void operator()(const f32x4 (&acc)[2][2][4][2], const Unit& u, int wr, int wc, int fr, int fq) const {
        const int row0 = EPI_ROW0, col0 = u.pn * BM + wc * 32 + 8 * fq; const bool sg = u.pn >= 18;
        EPI_FOR_AI_M { bf16_t* rowp = O + (size_t)(row0 + ai * HALF + m * 16) * ICP + col0;
#pragma unroll
            for (int bj = 0; bj < 2; ++bj) { f32x4 v0 = acc[ai][bj][m][0], v1 = acc[ai][bj][m][1];
                if (sg) { v0 = sigmoid4(v0); v1 = sigmoid4(v1); }
                *(u32x4*)(rowp + bj * HALF) = pack_f4x2(v0, v1); } }
    }
};
struct EpiBf16 {
    bf16_t* O; int ldc;
    __device__ __forceinline__ void operator()(const f32x4 (&acc)[2][2][4][2], const Unit& u, int wr, int wc, int fr, int fq) const {
        const int row0 = EPI_ROW0, col0 = u.pn * BM + wc * 32 + 8 * fq;
        EPI_FOR_AI_M { bf16_t* rowp = O + (size_t)(row0 + ai * HALF + m * 16) * ldc + col0;
#pragma unroll
            for (int bj = 0; bj < 2; ++bj) *(u32x4*)(rowp + bj * HALF) = pack_f4x2(acc[ai][bj][m][0], acc[ai][bj][m][1]); }
    }
};
struct EpiLora {
    float* DEC; bf16_t* AA; bf16_t* GG; const float* w0; const float* a0;
    __device__ __forceinline__ void operator()(const f32x4 (&acc)[2][2][4][2], const Unit& u, int wr, int wc, int fr, int fq) const {
        const int row0 = EPI_ROW0, kind = u.pn >> 2, col0 = (u.pn & 3) * BM + wc * 32 + 8 * fq;
        if (kind == 0) {
            EPI_FOR_AI_M { float* rowp = DEC + (size_t)(row0 + ai * HALF + m * 16) * RWD + col0;
#pragma unroll
                for (int bj = 0; bj < 2; ++bj)
#pragma unroll
                    for (int n = 0; n < 2; ++n) { const f32x4 b = *(const f32x4*)(w0 + col0 + bj * HALF + 4 * n); const f32x4 x = acc[ai][bj][m][n] + b; f32x4 o;
#pragma unroll
                        for (int j = 0; j < 4; ++j) { const float z = -x[j]; const float sp = z > 15.f ? z : __logf(1.0f + __expf(z)); const float w = -sp - 0.5f; o[j] = __expf(-__expf(w)); }
                        *(f32x4*)(rowp + bj * HALF + 4 * n) = o; } asm volatile("" ::: "memory"); }
        } else if (kind == 1) {
            EPI_FOR_AI_M { bf16_t* rowp = AA + (size_t)(row0 + ai * HALF + m * 16) * RWD + col0;
#pragma unroll
                for (int bj = 0; bj < 2; ++bj) { const f32x4 b0 = *(const f32x4*)(a0 + col0 + bj * HALF), b1 = *(const f32x4*)(a0 + col0 + bj * HALF + 4);
                    *(u32x4*)(rowp + bj * HALF) = pack_f4x2(sigmoid4(acc[ai][bj][m][0] + b0), sigmoid4(acc[ai][bj][m][1] + b1)); } asm volatile("" ::: "memory"); }
        } else {
            EPI_FOR_AI_M { bf16_t* rowp = GG + (size_t)(row0 + ai * HALF + m * 16) * RWD + col0;
#pragma unroll
                for (int bj = 0; bj < 2; ++bj) *(u32x4*)(rowp + bj * HALF) = pack_f4x2(acc[ai][bj][m][0], acc[ai][bj][m][1]); }
        }
    }
};
struct EpiGate1 {
    float* TMP; const bf16_t* PROJ; int gcol0;
    __device__ __forceinline__ void operator()(const f32x4 (&acc)[2][2][4][2], const Unit& u, int wr, int wc, int fr, int fq) const {
        const int row0 = EPI_ROW0, col0 = u.pn * BM + wc * 32 + 8 * fq;
        EPI_FOR_AI_M { const size_t row = (size_t)(row0 + ai * HALF + m * 16);
#pragma unroll
            for (int bj = 0; bj < 2; ++bj) { f32x4 g0, g1; unpack_f4x2(*(const u32x4*)(PROJ + row * ICP + gcol0 + col0 + bj * HALF), g0, g1);
                float* p = TMP + row * DM + col0 + bj * HALF; *(f32x4*)p = acc[ai][bj][m][0] * g0; *(f32x4*)(p + 4) = acc[ai][bj][m][1] * g1; } asm volatile("" ::: "memory"); }
    }
};
struct EpiGate2 {
    const float* TMP; const bf16_t* PROJ; int gcol0; bf16_t* O;
    __device__ __forceinline__ void operator()(const f32x4 (&acc)[2][2][4][2], const Unit& u, int wr, int wc, int fr, int fq) const {
        const int row0 = EPI_ROW0, col0 = u.pn * BM + wc * 32 + 8 * fq;
        EPI_FOR_AI_M { const size_t row = (size_t)(row0 + ai * HALF + m * 16);
#pragma unroll
            for (int bj = 0; bj < 2; ++bj) { f32x4 g0, g1; unpack_f4x2(*(const u32x4*)(PROJ + row * ICP + gcol0 + col0 + bj * HALF), g0, g1);
                const float* p = TMP + row * DM + col0 + bj * HALF; const f32x4 t0 = *(const f32x4*)p, t1 = *(const f32x4*)(p + 4);
                *(u32x4*)(O + row * DM + col0 + bj * HALF) = pack_f4x2(t0 + acc[ai][bj][m][0] * g0, t1 + acc[ai][bj][m][1] * g1); } asm volatile("" ::: "memory"); }
    }
};
struct EpiResid {
    float* X;
    __device__ __forceinline__ void operator()(const f32x4 (&acc)[2][2][4][2], const Unit& u, int wr, int wc, int fr, int fq) const {
        const int row0 = EPI_ROW0, col0 = u.pn * BM + wc * 32 + 8 * fq;
        EPI_FOR_AI_M { float* rowp = X + (size_t)(row0 + ai * HALF + m * 16) * DM + col0;
#pragma unroll
            for (int bj = 0; bj < 2; ++bj) { float* p = rowp + bj * HALF; const f32x4 x0 = *(const f32x4*)p, x1 = *(const f32x4*)(p + 4);
                *(f32x4*)p = x0 + acc[ai][bj][m][0]; *(f32x4*)(p + 4) = x1 + acc[ai][bj][m][1]; } asm volatile("" ::: "memory"); }
    }
};
struct EpiSwiglu {
    bf16_t* H;
    __device__ __forceinline__ void operator()(const f32x4 (&acc)[2][2][4][2], const Unit& u, int wr, int wc, int fr, int fq) const {
        const int row0 = EPI_ROW0, col0 = u.pn * HALF + wc * 32 + 8 * fq;
        EPI_FOR_AI_M { const f32x4 g0 = acc[ai][0][m][0], g1 = acc[ai][0][m][1], u0 = acc[ai][1][m][0], u1 = acc[ai][1][m][1];
            *(u32x4*)(H + (size_t)(row0 + ai * HALF + m * 16) * FF + col0) = pack_f4x2(g0 * sigmoid4(g0) * u0, g1 * sigmoid4(g1) * u1); }
    }
};
struct EpiPle {
    float* X; const bf16_t* PP;
    __device__ __forceinline__ void operator()(const f32x4 (&acc)[2][2][4][2], const Unit& u, int wr, int wc, int fr, int fq) const {
        const int row0 = EPI_ROW0, col0 = u.pn * BM + wc * 32 + 8 * fq;
        EPI_FOR_AI_M { const size_t row = (size_t)(row0 + ai * HALF + m * 16);
#pragma unroll
            for (int bj = 0; bj < 2; ++bj) { f32x4 p0, p1; unpack_f4x2(*(const u32x4*)(PP + row * DM + col0 + bj * HALF), p0, p1);
                float* p = X + row * DM + col0 + bj * HALF; const f32x4 x0 = *(const f32x4*)p, x1 = *(const f32x4*)(p + 4);
                *(f32x4*)p = x0 + sigmoid4(acc[ai][bj][m][0]) * p0; *(f32x4*)(p + 4) = x1 + sigmoid4(acc[ai][bj][m][1]) * p1; } asm volatile("" ::: "memory"); }
    }
};
#undef EPI_ROW0
#undef EPI_FOR_AI_M
}

constexpr size_t MiB = 1u << 20;
constexpr size_t al1m(size_t x) { return (x + MiB - 1) / MiB * MiB; }
constexpr size_t WS_CTL = 0, CTL_ZERO_BYTES = 1 * MiB;
constexpr size_t SZ_WIN = (size_t)ICP * DM * 2, SZ_POOLW = (size_t)PWD * 256 * 2, SZ_LORA = (size_t)3072 * LK * 2, SZ_PPOOL = (size_t)DM * PWD * 2, SZ_PRWKV = (size_t)DM * RWD * 2,
                 SZ_WOUT = (size_t)DM * DM * 2, SZ_WGU = (size_t)2 * FF * DM * 2, SZ_WDN = (size_t)DM * FF * 2, SZ_WPG = (size_t)DM * DM * 2, SZ_WPP = (size_t)DM * PLE * 2;
constexpr size_t WS_WIN = 1 * MiB, WS_POOLW = WS_WIN + SZ_WIN, WS_LORA = WS_POOLW + SZ_POOLW, WS_PPOOL = WS_LORA + SZ_LORA, WS_PRWKV = WS_PPOOL + SZ_PPOOL, WS_WOUT = WS_PRWKV + SZ_PRWKV,
                 WS_WGU = WS_WOUT + SZ_WOUT, WS_WDN = WS_WGU + SZ_WGU, WS_WPG = WS_WDN + SZ_WDN, WS_WPP = WS_WPG + SZ_WPG, WS_WEND = WS_WPP + SZ_WPP;
constexpr size_t WS_PB = al1m(WS_WEND);
constexpr size_t WS_XN = al1m(WS_PB + (size_t)MT * PLE * 2);
constexpr size_t WS_AA = al1m(WS_XN + (size_t)MT * DM * 2);
constexpr size_t WS_GG = al1m(WS_AA + (size_t)MT * RWD * 2);
constexpr size_t WS_PP = al1m(WS_GG + (size_t)MT * RWD * 2);
constexpr size_t WS_PROJ = al1m(WS_PP + (size_t)MT * DM * 2);
constexpr size_t WS_HID = WS_PROJ;
constexpr size_t WS_D = al1m(WS_PROJ + (size_t)MT * ICP * 2);
constexpr size_t WS_LIN = al1m(WS_D + (size_t)MT * PWD * 2);
constexpr size_t WS_YA = al1m(WS_LIN + (size_t)MT * LK * 2);
constexpr size_t WS_DEC = al1m(WS_YA + (size_t)MT * PWD * 2);
constexpr size_t WS_S = al1m(WS_DEC + (size_t)MT * RWD * 4);
constexpr size_t SZ_BH = (size_t)MT * RWD * 2;
constexpr size_t WS_KK = WS_S, WS_BB = WS_KK + SZ_BH, WS_KH = WS_BB + SZ_BH, WS_R = WS_KH + SZ_BH, WS_V = WS_R + SZ_BH, WS_Y = WS_V + SZ_BH;
constexpr size_t WS_YB = al1m(WS_Y + (size_t)MT * RWD * 4);
constexpr size_t WS_TMP = WS_S;
constexpr size_t WS_MRG = WS_TMP + (size_t)MT * DM * 4;
static_assert(WS_MRG + (size_t)MT * DM * 2 <= WS_YB, "overlay");
constexpr size_t WS_END = al1m(WS_YB + SZ_BH);
static_assert((size_t)MT * FF * 2 <= (size_t)MT * ICP * 2, "HID overlay");

constexpr int CW_BAR = 4096;
constexpr int NWAVES = 8, NTHR = 512;
constexpr int RING_BYTES = 131072, LDSCTL_OFF = RING_BYTES, LDS_BYTES = 147456;

#define XB_TMO      128
#define XB_XCNT(j)  (256  + 64 * (j))
#define XB_XSUB(j)  (1280 + 64 * (j))
#define XB_XGEN(j)  (2304 + 64 * (j))
#define XB_TOP      3328
#define XB_TOPGEN   3392
#define XCD_BAR_WORDS 3456
#define XB_SPIN_CAP (1u << 18)

__device__ __forceinline__ unsigned xb_ld(unsigned* p)              { return __hip_atomic_load(p, __ATOMIC_RELAXED, __HIP_MEMORY_SCOPE_AGENT); }
__device__ __forceinline__ unsigned xb_add(unsigned* p, unsigned v) { return __hip_atomic_fetch_add(p, v, __ATOMIC_RELAXED, __HIP_MEMORY_SCOPE_AGENT); }
__device__ __forceinline__ unsigned xb_xcc_id() { return (unsigned)__builtin_amdgcn_s_getreg((3 << 11) | 20) & 0xFu; }
#define XB_SPIN(cond, bar) do { unsigned _sp = 0; while (cond) { __builtin_amdgcn_s_sleep(1); \
    if ((++_sp & 255u) == 0u) { if (xb_ld(&(bar)[XB_TMO])) break; if (_sp > XB_SPIN_CAP) { atomicAdd(&(bar)[XB_TMO], 1u); break; } } } } while (0)

struct XcdBarrier {
    unsigned* bar; unsigned x;
    volatile LAS unsigned* st;
};

__device__ __forceinline__ XcdBarrier xcd_barrier_post(unsigned* bar, volatile LAS unsigned* st) {
    XcdBarrier b; b.bar = bar; b.x = xb_xcc_id(); b.st = st;
    if (threadIdx.x == 0) (void)xb_add(&bar[XB_XCNT(b.x)], 1u);
    return b;
}
__device__ __forceinline__ void xcd_barrier_complete(unsigned* bar, unsigned x, unsigned& nloc, unsigned& nx) {
    const unsigned G = gridDim.x * gridDim.y * gridDim.z;
    unsigned sum, cnt, mine, sp = 0u;
    for (;;) {
        sum = 0u; cnt = 0u; mine = 0u;
#pragma unroll
        for (unsigned j = 0; j < 16; ++j) { const unsigned c = xb_ld(&bar[XB_XCNT(j)]); sum += c; cnt += (c > 0u) ? 1u : 0u; mine = (j == x) ? c : mine; }
        if (sum == G) break;
        __builtin_amdgcn_s_sleep(1);
        if ((++sp & 255u) == 0u) { if (xb_ld(&bar[XB_TMO])) break; if (sp > XB_SPIN_CAP) { atomicAdd(&bar[XB_TMO], 1u); break; } }
    }
    nloc = mine > 0u ? mine : 1u; nx = cnt > 0u ? cnt : 1u;
}

__device__ __forceinline__ void xcd_barrier(const XcdBarrier& b) {
    asm volatile("s_waitcnt vmcnt(0)" ::: "memory");
    __syncthreads();
    if (threadIdx.x == 0) {
        unsigned* bar = b.bar;
        __builtin_amdgcn_s_waitcnt(0);
        unsigned nloc = b.st[0], nx = b.st[1];
        if (nloc == 0u) { xcd_barrier_complete(bar, b.x, nloc, nx); b.st[0] = nloc; b.st[1] = nx; }
        const unsigned old = xb_add(&bar[XB_XSUB(b.x)], 1u);
        const unsigned gen = old / nloc;
        if (old + 1u == (gen + 1u) * nloc) {
            __builtin_amdgcn_fence(__ATOMIC_RELEASE, "agent");
            asm volatile("s_waitcnt vmcnt(0)" ::: "memory");
            const unsigned og = xb_add(&bar[XB_TOP], 1u);
            const unsigned tg = og / nx;
            if (og + 1u == (tg + 1u) * nx) xb_add(&bar[XB_TOPGEN], 1u);
            else XB_SPIN(xb_ld(&bar[XB_TOPGEN]) == tg, bar);
            __builtin_amdgcn_fence(__ATOMIC_ACQUIRE, "agent");
            xb_add(&bar[XB_XGEN(b.x)], 1u);
            asm volatile("s_waitcnt vmcnt(0)" ::: "memory");
        } else {
            XB_SPIN(xb_ld(&bar[XB_XGEN(b.x)]) == gen, bar);
            __builtin_amdgcn_fence(__ATOMIC_ACQUIRE, "agent");
            asm volatile("s_waitcnt vmcnt(0)" ::: "memory");
        }
    }
    __syncthreads();
}


struct Args {
    const float* in[33]; float* out; unsigned char* ws; int ph_lo, ph_hi;
};
struct Frame {
    LAS unsigned char* lds; int G;
    const LAS unsigned long long* ptab; float* out; unsigned char* ws;
};
#define GAS __attribute__((address_space(1)))
__device__ __forceinline__ const float* ldptr(const LAS unsigned long long* tab, int k) { const unsigned long long v = tab[k]; const unsigned lo = __builtin_amdgcn_readfirstlane((unsigned)v), hi = __builtin_amdgcn_readfirstlane((unsigned)(v >> 32));
    return (const float*)(const GAS float*)(((unsigned long long)hi << 32) | lo); }
__device__ __forceinline__ unsigned char* fresh(unsigned char* p) { GAS unsigned char* q = (GAS unsigned char*)p; asm volatile("" : "+s"(q)); return (unsigned char*)q; }
__device__ __forceinline__ int fresh_i(int v) { asm volatile("" : "+s"(v)); return v; }
#define INP(k) ldptr(F.ptab, (k))
#define PHASE_L const int l = fresh_i(l_in); (void)l;
#define PHASE_IDS int tid_ = threadIdx.x; asm volatile("" : "+v"(tid_)); const int tid = tid_, lane = tid & 63, wave = __builtin_amdgcn_readfirstlane(tid >> 6), gtid = blockIdx.x * NTHR + tid, gw = blockIdx.x * NWAVES + wave; (void)lane; (void)wave; (void)gtid; (void)gw;
#define VM_WAIT() asm volatile("s_waitcnt vmcnt(0)" ::: "memory")
#define LDS_WAIT() asm volatile("s_waitcnt lgkmcnt(0)" ::: "memory")
constexpr int NT_ALL_SHIFT = 9;

__device__ __forceinline__ void row_info(int m, int& b, int& t, bool& samp) { samp = m >= MPR; if (samp) { b = (m - MPR) >> 6; t = (m - MPR) & 63; } else { b = m >> 11; t = m & 2047; } }

__device__ __forceinline__ void transpose_item(const float* W, int N, bf16_t* WT, int ldk, int k0, int n0, int drow0, LAS float* scr, int lane, const float* cscale = nullptr) {
    const float cs = cscale ? cscale[n0 + (lane & 31)] : 1.0f;
#pragma unroll 8
    for (int i = 0; i < 32; ++i) { const int kk = 2 * i + (lane >> 5); scr[kk * 33 + (lane & 31)] = W[(size_t)(k0 + kk) * N + n0 + (lane & 31)] * cs; }
    LDS_WAIT(); asm volatile("" ::: "memory");
    const int c = lane & 7;
#pragma unroll
    for (int j = 0; j < 4; ++j) { const int n = (lane >> 3) + 8 * j; const LAS float* s = scr + (8 * c) * 33 + n;
        u32x4 o; o.x = cvt_pk_bf16(s[0 * 33], s[1 * 33]); o.y = cvt_pk_bf16(s[2 * 33], s[3 * 33]); o.z = cvt_pk_bf16(s[4 * 33], s[5 * 33]); o.w = cvt_pk_bf16(s[6 * 33], s[7 * 33]);
        *(u32x4*)(WT + (size_t)(drow0 + n) * ldk + k0 + 8 * c) = o; }
    LDS_WAIT(); asm volatile("" ::: "memory");
}
__device__ __forceinline__ void convert_weights(Frame& F, int l_in) {
    PHASE_IDS
    unsigned char* const wsl = fresh(F.ws);
    PHASE_L
    LAS float* scr = (LAS float*)(F.lds + wave * 16384);
    const int NGW = fresh_i(F.G) * NWAVES;
    unsigned char* ws = wsl;
    constexpr int I_WIN = (DM / 64) * (ICOLS / 32), I_PW = 4 * (256 / 64) * (256 / 32), I_PP = (PWD / 64) * (DM / 32), I_WO = (DM / 64) * (DM / 32), I_FG = (DM / 64) * (FF / 32),
                  I_FD = (FF / 64) * (DM / 32), I_PL = (PLE / 64) * (DM / 32);
    constexpr int NITEMS = I_WIN + I_PW + 2 * I_PP + I_WO + 2 * I_FG + I_FD + I_WO + I_PL;
    for (int it = gw; it < NITEMS; it += NGW) {
        int r = it;
        if (r < I_WIN) { const int nblk = ICOLS / 32, kb = r / nblk, nb = r % nblk, n0 = nb * 32; transpose_item(INP(8) + (size_t)l * DM * ICOLS, ICOLS, (bf16_t*)(ws + WS_WIN), DM, kb * 64, n0, n0 < 4384 ? n0 : n0 + 224, scr, lane); continue; } r -= I_WIN;
        if (r < I_PW) { const int g = r >> 5, rr = r & 31, kb = rr >> 3, nb = rr & 7; transpose_item(INP(10) + ((size_t)l * 4 + g) * 65536, 256, (bf16_t*)(ws + WS_POOLW) + (size_t)g * 65536, 256, kb * 64, nb * 32, nb * 32, scr, lane, INP(11) + (size_t)l * PWD + g * 256); continue; } r -= I_PW;
        if (r < I_PP) { const int nblk = DM / 32, kb = r / nblk, nb = r % nblk; transpose_item(INP(22) + (size_t)l * PWD * DM, DM, (bf16_t*)(ws + WS_PPOOL), PWD, kb * 64, nb * 32, nb * 32, scr, lane); continue; } r -= I_PP;
        if (r < I_PP) { const int nblk = DM / 32, kb = r / nblk, nb = r % nblk; transpose_item(INP(23) + (size_t)l * RWD * DM, DM, (bf16_t*)(ws + WS_PRWKV), RWD, kb * 64, nb * 32, nb * 32, scr, lane); continue; } r -= I_PP;
        if (r < I_WO) { const int nblk = DM / 32, kb = r / nblk, nb = r % nblk; transpose_item(INP(24) + (size_t)l * DM * DM, DM, (bf16_t*)(ws + WS_WOUT), DM, kb * 64, nb * 32, nb * 32, scr, lane); continue; } r -= I_WO;
        if (r < I_FG) { const int nblk = FF / 32, kb = r / nblk, nb = r % nblk, n0 = nb * 32; transpose_item(INP(26) + (size_t)l * DM * FF, FF, (bf16_t*)(ws + WS_WGU), DM, kb * 64, n0, 256 * (n0 >> 7) + (n0 & 127), scr, lane); continue; } r -= I_FG;
        if (r < I_FG) { const int nblk = FF / 32, kb = r / nblk, nb = r % nblk, n0 = nb * 32; transpose_item(INP(27) + (size_t)l * DM * FF, FF, (bf16_t*)(ws + WS_WGU), DM, kb * 64, n0, 256 * (n0 >> 7) + 128 + (n0 & 127), scr, lane); continue; } r -= I_FG;
        if (r < I_FD) { const int nblk = DM / 32, kb = r / nblk, nb = r % nblk; transpose_item(INP(28) + (size_t)l * FF * DM, DM, (bf16_t*)(ws + WS_WDN), FF, kb * 64, nb * 32, nb * 32, scr, lane); continue; } r -= I_FD;
        if (r < I_WO) { const int nblk = DM / 32, kb = r / nblk, nb = r % nblk; transpose_item(INP(30) + (size_t)l * DM * DM, DM, (bf16_t*)(ws + WS_WPG), DM, kb * 64, nb * 32, nb * 32, scr, lane); continue; } r -= I_WO;
        { const int nblk = DM / 32, kb = r / nblk, nb = r % nblk; transpose_item(INP(31) + (size_t)l * PLE * DM, DM, (bf16_t*)(ws + WS_WPP), PLE, kb * 64, nb * 32, nb * 32, scr, lane); }
    }
    const int NT = fresh_i(F.G) * NTHR;
    { u32x4* z = (u32x4*)((bf16_t*)(ws + WS_WIN) + (size_t)4384 * DM); for (int i = gtid; i < 224 * DM * 2 / 16; i += NT) z[i] = (u32x4){0u, 0u, 0u, 0u}; }
    { bf16_t* LT = (bf16_t*)(ws + WS_LORA); const float* wd = INP(13) + (size_t)l * 64 * RWD; const float* wa = INP(15) + (size_t)l * 64 * RWD; const float* wg = INP(16) + (size_t)l * 160 * RWD;
      for (int i = gtid; i < 3072 * (LK / 8); i += NT) { const int n = i / (LK / 8), k0 = (i % (LK / 8)) * 8; const int kind = n >> 10, c = n & 1023; float f[8];
#pragma unroll
          for (int j = 0; j < 8; ++j) { const int k = k0 + j; float v = 0.f;
              if (kind == 0) { if (k < 64) v = wd[(size_t)k * RWD + c]; }
              else if (kind == 1) { if (k >= 64 && k < 128) v = wa[(size_t)(k - 64) * RWD + c]; }
              else { if (k >= 128 && k < 288) v = wg[(size_t)(k - 128) * RWD + c]; }
              f[j] = v; }
          *(u32x4*)(LT + (size_t)n * LK + k0) = pack8(f); } }
    { bf16_t* PB = (bf16_t*)(ws + WS_PB); const float* pp = INP(5) + (size_t)l * MPR * PLE; const float* ps = INP(6) + (size_t)l * (MT - MPR) * PLE;
      for (int i = gtid; i < MT * PLE / 8; i += NT) { const size_t e = (size_t)i * 8; const float* src = e < (size_t)MPR * PLE ? pp + e : ps + (e - (size_t)MPR * PLE);
          const f32x4 a = *(const f32x4*)src, b = *(const f32x4*)(src + 4); *(u32x4*)(PB + e) = pg8::pack_f4x2(a, b); } }
}

template <bool FROM_INPUT, bool FINAL>
__device__ __forceinline__ void norm_rows(Frame& F, const float* gain) {
    PHASE_IDS
    unsigned char* const wsl = fresh(F.ws);
    const int NGW = fresh_i(F.G) * NWAVES; float* X = F.out; bf16_t* XN = (bf16_t*)(wsl + WS_XN);
    f32x4 g[8];
#pragma unroll
    for (int j = 0; j < 8; ++j) g[j] = *(const f32x4*)(gain + 4 * lane + 256 * j);
    for (int m = gw; m < MT; m += NGW) {
        const float* src = FROM_INPUT ? (m < MPR ? INP(0) + (size_t)m * DM : INP(1) + (size_t)(m - MPR) * DM) : X + (size_t)m * DM;
        f32x4 v[8]; float s = 0.f;
#pragma unroll
        for (int j = 0; j < 8; ++j) { v[j] = *(const f32x4*)(src + 4 * lane + 256 * j); s += (v[j].x * v[j].x + v[j].y * v[j].y) + (v[j].z * v[j].z + v[j].w * v[j].w); }
        const float rstd = __builtin_amdgcn_rsqf(wave_sum(s) * (1.0f / DM) + NORM_EPS);
        if (FROM_INPUT) {
#pragma unroll
            for (int j = 0; j < 8; ++j) *(f32x4*)(X + (size_t)m * DM + 4 * lane + 256 * j) = v[j];
        }
        if (FINAL) {
#pragma unroll
            for (int j = 0; j < 8; ++j) *(f32x4*)(X + (size_t)m * DM + 4 * lane + 256 * j) = v[j] * rstd * g[j];
        } else {
#pragma unroll
            for (int j = 0; j < 8; ++j) { const f32x4 o = v[j] * rstd * g[j]; u32x2 w; w.x = cvt_pk_bf16(o.x, o.y); w.y = cvt_pk_bf16(o.z, o.w); *(u32x2*)(XN + (size_t)m * DM + 4 * lane + 256 * j) = w; }
        }
    }
}

__device__ __forceinline__ void load_z(float (&z)[8], const bf16_t* PROJ, const float* past, int m0, int t, bool samp, int c0) {
    if (t >= 0) { unpack8(*(const u32x4*)(PROJ + (size_t)(m0 + t) * ICP + c0), z); }
    else if (samp) { const float* p = past + (size_t)(15 + t) * PWD + c0; const f32x4 a = *(const f32x4*)p, b = *(const f32x4*)(p + 4); z[0] = a.x; z[1] = a.y; z[2] = a.z; z[3] = a.w; z[4] = b.x; z[5] = b.y; z[6] = b.z; z[7] = b.w; }
    else {
#pragma unroll
        for (int j = 0; j < 8; ++j) z[j] = 0.f; }
}
__device__ __forceinline__ void prep1_phase(Frame& F, int l_in) {
    PHASE_IDS
    unsigned char* const wsl = fresh(F.ws);
    PHASE_L
    const int NT = fresh_i(F.G) * NTHR; const bf16_t* PROJ = (const bf16_t*)(wsl + WS_PROJ);
    { bf16_t* D = (bf16_t*)(wsl + WS_D);
      for (int it = gtid; it < (MT / 16) * 128; it += NT) {
          const int oct = it & 127, run = it >> 7, mrow = run * 16, c0 = oct * 8, win = 2 << (c0 >> 8);
          int b, t0; bool samp; row_info(mrow, b, t0, samp);
          const int T = samp ? TS : TP, mseq = mrow - t0;
          const float* past = INP(3) + ((size_t)l * 8 + b) * 15 * PWD;
          float* npool = F.out + (samp ? O_POS : O_POP) + ((size_t)l * 8 + b) * 15 * PWD;
          float S[8], z[8];
#pragma unroll
          for (int j = 0; j < 8; ++j) S[j] = 0.f;
          for (int j = 1; j < win; ++j) { load_z(z, PROJ, past, mseq, t0 - j, samp, c0);
#pragma unroll
              for (int q = 0; q < 8; ++q) S[q] += z[q]; }
          for (int i = 0; i < 16; ++i) { const int t = t0 + i; float cur[8]; load_z(cur, PROJ, past, mseq, t, samp, c0);
              const int cnt = samp ? win : (t + 1 < win ? t + 1 : win); const float inv = 1.0f / (float)cnt; float d[8];
#pragma unroll
              for (int q = 0; q < 8; ++q) { S[q] += cur[q]; d[q] = S[q] * inv - cur[q]; }
              *(u32x4*)(D + (size_t)(mseq + t) * PWD + c0) = pack8(d);
              if (t >= T - 15) { float* o = npool + (size_t)(t - (T - 15)) * PWD + c0; *(f32x4*)o = (f32x4){cur[0], cur[1], cur[2], cur[3]}; *(f32x4*)(o + 4) = (f32x4){cur[4], cur[5], cur[6], cur[7]}; }
              load_z(z, PROJ, past, mseq, t - win + 1, samp, c0);
#pragma unroll
              for (int q = 0; q < 8; ++q) S[q] -= z[q]; }
      } }
    { bf16_t* LIN = (bf16_t*)(wsl + WS_LIN); const float* mu = INP(9) + (size_t)l * RPJ + 3072;
      for (int it = gtid; it < MT * (LK / 8); it += NT) {
          const int m = it / (LK / 8), c0 = (it % (LK / 8)) * 8; float o[8];
          if (c0 >= 288) {
#pragma unroll
              for (int j = 0; j < 8; ++j) o[j] = 0.f;
          } else {
              int b, t; bool samp; row_info(m, b, t, samp);
              float cur[8], prv[8]; unpack8(*(const u32x4*)(PROJ + (size_t)m * ICP + 4096 + c0), cur);
              if (t > 0) unpack8(*(const u32x4*)(PROJ + (size_t)(m - 1) * ICP + 4096 + c0), prv);
              else if (samp) { const float* p = INP(2) + ((size_t)l * 8 + b) * RPJ + 3072 + c0;
#pragma unroll
                  for (int j = 0; j < 8; ++j) prv[j] = p[j]; }
              else {
#pragma unroll
                  for (int j = 0; j < 8; ++j) prv[j] = 0.f; }
#pragma unroll
              for (int j = 0; j < 8; ++j) { const float xm = cur[j] + (prv[j] - cur[j]) * mu[c0 + j]; o[j] = c0 < 64 ? tanhf_(xm) : (c0 < 128 ? xm : sigmoidf_(xm)); }
          }
          *(u32x4*)(LIN + (size_t)m * LK + c0) = pack8(o);
      } }
    for (int it = gtid; it < 16 * RPJ; it += NT) { const int s = it / RPJ, c = it % RPJ; const int mlast = s < 8 ? s * TP + TP - 1 : MPR + (s - 8) * TS + TS - 1;
        F.out[(s < 8 ? O_SHP : O_SHS) + ((size_t)l * 8 + (s & 7)) * RPJ + c] = __uint_as_float((unsigned)PROJ[(size_t)mlast * ICP + 1024 + c] << 16); }
}

__device__ __forceinline__ void prep2_phase(Frame& F, int l_in) {
    PHASE_IDS
    unsigned char* const wsl = fresh(F.ws);
    PHASE_L
    const int NT = fresh_i(F.G) * NTHR; const bf16_t* PROJ = (const bf16_t*)(wsl + WS_PROJ); const bf16_t* AA = (const bf16_t*)(wsl + WS_AA);
    bf16_t* R = (bf16_t*)(wsl + WS_R); bf16_t* KH = (bf16_t*)(wsl + WS_KH); bf16_t* V = (bf16_t*)(wsl + WS_V); bf16_t* KK = (bf16_t*)(wsl + WS_KK); bf16_t* BB = (bf16_t*)(wsl + WS_BB);
    const float* mu = INP(9) + (size_t)l * RPJ; const float* k_k = INP(17) + (size_t)l * RWD; const float* k_a = INP(18) + (size_t)l * RWD;
    for (int it = gtid; it < MT * 128; it += NT) {
        const int m = it >> 7, c0 = (it & 127) * 8;
        int b, t; bool samp; row_info(m, b, t, samp);
        float x[3][8];
#pragma unroll
        for (int q = 0; q < 3; ++q) { float cur[8], prv[8]; unpack8(*(const u32x4*)(PROJ + (size_t)m * ICP + 1024 + q * 1024 + c0), cur);
            if (t > 0) unpack8(*(const u32x4*)(PROJ + (size_t)(m - 1) * ICP + 1024 + q * 1024 + c0), prv);
            else if (samp) { const float* p = INP(2) + ((size_t)l * 8 + b) * RPJ + q * 1024 + c0;
#pragma unroll
                for (int j = 0; j < 8; ++j) prv[j] = p[j]; }
            else {
#pragma unroll
                for (int j = 0; j < 8; ++j) prv[j] = 0.f; }
#pragma unroll
            for (int j = 0; j < 8; ++j) x[q][j] = cur[j] + (prv[j] - cur[j]) * mu[q * 1024 + c0 + j]; }
        float a[8]; unpack8(*(const u32x4*)(AA + (size_t)m * RWD + c0), a);
        float kk[8], kh[8], bb[8]; float ss = 0.f;
#pragma unroll
        for (int j = 0; j < 8; ++j) { kk[j] = x[1][j] * k_k[c0 + j]; ss += kk[j] * kk[j]; }
        ss = sum8(ss);
        const float inv = 1.0f / fmaxf(sqrtf(ss), 1e-12f);
#pragma unroll
        for (int j = 0; j < 8; ++j) { kk[j] *= inv; kh[j] = x[1][j] * (1.0f + (a[j] - 1.0f) * k_a[c0 + j]); bb[j] = kk[j] * a[j]; }
        const size_t o = (size_t)m * RWD + c0;
        *(u32x4*)(R + o) = pack8(x[0]); *(u32x4*)(KH + o) = pack8(kh); *(u32x4*)(V + o) = pack8(x[2]); *(u32x4*)(KK + o) = pack8(kk); *(u32x4*)(BB + o) = pack8(bb);
    }
}

constexpr int SC_TC = 32, SC_STEP = 6 * 64;
__device__ __forceinline__ void scan_phase(Frame& F, int l_in) {
    PHASE_IDS
    unsigned char* const wsl = fresh(F.ws);
    PHASE_L
    LAS float* buf = (LAS float*)F.lds;
    const float* DEC = (const float*)(wsl + WS_DEC);
    const bf16_t* arr0 = (const bf16_t*)(wsl + WS_KK);
    float* Y = (float*)(wsl + WS_Y);
    const int r8 = lane >> 3, ks = lane & 7, row = wave * 8 + r8, k0 = ks * 8;
    for (int u = blockIdx.x; u < 256; u += fresh_i(F.G)) {
        const bool samp = u >= 128; const int h = u & 15, b = (u >> 4) & 7;
        const int T = samp ? TS : TP, m0 = samp ? MPR + b * TS : b * TP, ch0 = h * 64;
        float S[8];
        if (samp) { const float* p = INP(4) + ((((size_t)l * 8 + b) * 16 + h) * 64 + row) * 64 + k0; const f32x4 s0 = *(const f32x4*)p, s1 = *(const f32x4*)(p + 4);
            S[0] = s0.x; S[1] = s0.y; S[2] = s0.z; S[3] = s0.w; S[4] = s1.x; S[5] = s1.y; S[6] = s1.z; S[7] = s1.w; }
        else {
#pragma unroll
            for (int j = 0; j < 8; ++j) S[j] = 0.f; }
        const int nch = T / SC_TC;
        f32x4 sd; u32x4 sb[3];
#define SC_LOAD(c) do { const int mm = m0 + (c) * SC_TC; sd = *(const f32x4*)(DEC + (size_t)(mm + (tid >> 4)) * RWD + ch0 + (tid & 15) * 4); \
        _Pragma("unroll") for (int i = 0; i < 3; ++i) { const int id = tid + 512 * i; if (id < 1280) { const int a = id >> 8, rem = id & 255, st = rem >> 3, oc = rem & 7; \
            sb[i] = *(const u32x4*)(arr0 + (size_t)a * MT * RWD + (size_t)(mm + st) * RWD + ch0 + oc * 8); } } } while (0)
#define SC_STORE(bufp) do { *(LAS f32x4*)((bufp) + (tid >> 4) * SC_STEP + (tid & 15) * 4) = sd; \
        _Pragma("unroll") for (int i = 0; i < 3; ++i) { const int id = tid + 512 * i; if (id < 1280) { const int a = id >> 8, rem = id & 255, st = rem >> 3, oc = rem & 7; float f[8]; unpack8(sb[i], f); \
            LAS float* d = (bufp) + st * SC_STEP + (a + 1) * 64 + oc * 8; *(LAS f32x4*)d = (f32x4){f[0], f[1], f[2], f[3]}; *(LAS f32x4*)(d + 4) = (f32x4){f[4], f[5], f[6], f[7]}; } } } while (0)
        __syncthreads();
        SC_LOAD(0); SC_STORE(buf);
        __syncthreads();
        for (int c = 0; c < nch; ++c) {
            LAS float* cur = buf + (c & 1) * SC_TC * SC_STEP; LAS float* oth = buf + ((c + 1) & 1) * SC_TC * SC_STEP;
            const bool more = c + 1 < nch;
            if (more) SC_LOAD(c + 1);
#pragma unroll 2
            for (int s = 0; s < SC_TC; ++s) {
                const LAS float* p = cur + s * SC_STEP;
                const f32x4 w0 = *(const LAS f32x4*)(p + k0), w1 = *(const LAS f32x4*)(p + k0 + 4);
                const f32x4 q0 = *(const LAS f32x4*)(p + 64 + k0), q1 = *(const LAS f32x4*)(p + 64 + k0 + 4);
                const f32x4 b0 = *(const LAS f32x4*)(p + 128 + k0), b1 = *(const LAS f32x4*)(p + 128 + k0 + 4);
                const f32x4 h0 = *(const LAS f32x4*)(p + 192 + k0), h1 = *(const LAS f32x4*)(p + 192 + k0 + 4);
                const f32x4 r0 = *(const LAS f32x4*)(p + 256 + k0), r1 = *(const LAS f32x4*)(p + 256 + k0 + 4);
                const float vv = p[320 + row];
                float sa = (S[0] * q0.x + S[1] * q0.y) + (S[2] * q0.z + S[3] * q0.w) + (S[4] * q1.x + S[5] * q1.y) + (S[6] * q1.z + S[7] * q1.w);
                sa = -sum8(sa);
                S[0] = S[0] * w0.x + sa * b0.x + vv * h0.x; S[1] = S[1] * w0.y + sa * b0.y + vv * h0.y; S[2] = S[2] * w0.z + sa * b0.z + vv * h0.z; S[3] = S[3] * w0.w + sa * b0.w + vv * h0.w;
                S[4] = S[4] * w1.x + sa * b1.x + vv * h1.x; S[5] = S[5] * w1.y + sa * b1.y + vv * h1.y; S[6] = S[6] * w1.z + sa * b1.z + vv * h1.z; S[7] = S[7] * w1.w + sa * b1.w + vv * h1.w;
                float y = (S[0] * r0.x + S[1] * r0.y) + (S[2] * r0.z + S[3] * r0.w) + (S[4] * r1.x + S[5] * r1.y) + (S[6] * r1.z + S[7] * r1.w);
                y = sum8(y);
                if (ks == 0) Y[(size_t)(m0 + c * SC_TC + s) * RWD + ch0 + row] = y;
            }
            if (more) SC_STORE(oth);
            __syncthreads();
        }
#undef SC_LOAD
#undef SC_STORE
        float* so = F.out + (samp ? O_WKS : O_WKP) + ((((size_t)l * 8 + b) * 16 + h) * 64 + row) * 64 + k0;
        *(f32x4*)so = (f32x4){S[0], S[1], S[2], S[3]}; *(f32x4*)(so + 4) = (f32x4){S[4], S[5], S[6], S[7]};
    }
}

__device__ __forceinline__ void post_phase(Frame& F, int l_in) {
    PHASE_IDS
    unsigned char* const wsl = fresh(F.ws);
    PHASE_L
    const int NT = fresh_i(F.G) * NTHR; const float* Y = (const float*)(wsl + WS_Y);
    const bf16_t* R = (const bf16_t*)(wsl + WS_R); const bf16_t* KH = (const bf16_t*)(wsl + WS_KH); const bf16_t* V = (const bf16_t*)(wsl + WS_V); const bf16_t* GG = (const bf16_t*)(wsl + WS_GG);
    bf16_t* YB = (bf16_t*)(wsl + WS_YB);
    const float* r_k = INP(19) + (size_t)l * RWD; const float* gng = INP(20) + (size_t)l * RWD; const float* gnb = INP(21) + (size_t)l * RWD;
    for (int it = gtid; it < MT * 128; it += NT) {
        const int m = it >> 7, c0 = (it & 127) * 8; const size_t o = (size_t)m * RWD + c0;
        const f32x4 y0 = *(const f32x4*)(Y + o), y1 = *(const f32x4*)(Y + o + 4);
        float y[8] = {y0.x, y0.y, y0.z, y0.w, y1.x, y1.y, y1.z, y1.w};
        float r[8], kh[8], v[8], g[8]; unpack8(*(const u32x4*)(R + o), r); unpack8(*(const u32x4*)(KH + o), kh); unpack8(*(const u32x4*)(V + o), v); unpack8(*(const u32x4*)(GG + o), g);
        float s = 0.f, bs = 0.f;
#pragma unroll
        for (int j = 0; j < 8; ++j) { s += y[j]; bs += r[j] * kh[j] * r_k[c0 + j]; }
        s = sum8(s); bs = sum8(bs);
        const float mean = s * (1.0f / 64.0f); float q = 0.f;
#pragma unroll
        for (int j = 0; j < 8; ++j) { const float d = y[j] - mean; q += d * d; }
        q = sum8(q);
        const float rstd = __builtin_amdgcn_rsqf(q * (1.0f / 64.0f) + GN_EPS);
        float outv[8];
#pragma unroll
        for (int j = 0; j < 8; ++j) outv[j] = ((y[j] - mean) * rstd * gng[c0 + j] + gnb[c0 + j] + bs * v[j]) * g[j];
        *(u32x4*)(YB + o) = pack8(outv);
    }
}

constexpr int PH_PER_LAYER = 14, N_PHASES = NL * PH_PER_LAYER + 1;
__global__ void __launch_bounds__(NTHR, 2) mega_fwd(Args args) {
    extern __shared__ __attribute__((aligned(16))) unsigned char lds[];
    Frame F;
    F.lds = (LAS unsigned char*)lds;
    F.G = gridDim.x;
    F.out = args.out; F.ws = args.ws;
    { LAS unsigned long long* pt = (LAS unsigned long long*)(F.lds + LDSCTL_OFF + 1024); F.ptab = pt;
      if (threadIdx.x == 0) {
#define PT_(k) pt[k] = (unsigned long long)args.in[k];
          PT_(0) PT_(1) PT_(2) PT_(3) PT_(4) PT_(5) PT_(6) PT_(7) PT_(8) PT_(9) PT_(10) PT_(11) PT_(12) PT_(13) PT_(14) PT_(15) PT_(16) PT_(17) PT_(18) PT_(19) PT_(20) PT_(21) PT_(22) PT_(23) PT_(24) PT_(25) PT_(26) PT_(27) PT_(28) PT_(29) PT_(30) PT_(31) PT_(32)
#undef PT_
      } }
    volatile LAS unsigned* MISC = (volatile LAS unsigned*)(F.lds + LDSCTL_OFF);
    for (int u = threadIdx.x; u < 256; u += NTHR) ((LAS unsigned*)(F.lds + LDSCTL_OFF))[u] = 0u;
    __syncthreads();
    XcdBarrier bar; bar.bar = (unsigned*)(args.ws + WS_CTL) + CW_BAR; bar.x = 0; bar.st = nullptr;
    if (!MK_PER_PHASE) bar = xcd_barrier_post((unsigned*)(args.ws + WS_CTL) + CW_BAR, MISC + 8);
    const int lo = args.ph_lo, hi = args.ph_hi;
#ifndef MK_MASK
#define MK_MASK 0x7fff
#endif
#define IN(k) (((MK_MASK >> (((k) == NL * PH_PER_LAYER) ? 14 : ((k) - pb_))) & 1) && lo <= (k) && (k) < hi)
#define SEAM(k) do { if (IN(k) && IN((k) + 1)) xcd_barrier(bar); } while (0)
    LAS unsigned char* ring = F.lds;
    const int cid = (int)blockIdx.x;
    for (int l = 0; l < NL; ++l) {
        const int pb = l * PH_PER_LAYER; const int pb_ = pb;
        if (IN(pb + 0)) { convert_weights(F, l); if (l == 0) norm_rows<true, false>(F, INP(7) + (size_t)fresh_i(l) * DM); else norm_rows<false, false>(F, INP(7) + (size_t)fresh_i(l) * DM); }
        SEAM(pb + 0);
        if (IN(pb + 1)) { pg8::Gemm g{(const bf16_t*)(fresh(F.ws) + WS_XN), (const bf16_t*)(fresh(F.ws) + WS_WIN), MT, ICP, DM, DM, DM, 0}; pg8::StaticOrder S; S.init(MT, ICP, fresh_i(F.G), fresh_i(cid));
            pg8::EpiProj E{(bf16_t*)(fresh(F.ws) + WS_PROJ)}; pg8::gemm_phase<pg8::EpiProj, pg8::StaticOrder, true>(ring, g, S, E); }
        SEAM(pb + 1);
        if (IN(pb + 2)) prep1_phase(F, l);
        SEAM(pb + 2);
        if (IN(pb + 3)) {
            { pg8::Gemm g{(const bf16_t*)(fresh(F.ws) + WS_D), (const bf16_t*)(fresh(F.ws) + WS_POOLW), MT, PWD, 256, PWD, 256, 256}; pg8::StaticOrder S; S.init(MT, PWD, fresh_i(F.G), fresh_i(cid));
              pg8::EpiBf16 E{(bf16_t*)(fresh(F.ws) + WS_YA), PWD};   pg8::gemm_phase<pg8::EpiBf16, pg8::StaticOrder, true>(ring, g, S, E); }
            { pg8::Gemm g{(const bf16_t*)(fresh(F.ws) + WS_LIN), (const bf16_t*)(fresh(F.ws) + WS_LORA), MT, 3072, LK, LK, LK, 0}; pg8::StaticOrder S; S.init(MT, 3072, fresh_i(F.G), fresh_i(cid));
              pg8::EpiLora E{(float*)(fresh(F.ws) + WS_DEC), (bf16_t*)(fresh(F.ws) + WS_AA), (bf16_t*)(fresh(F.ws) + WS_GG), INP(12) + (size_t)fresh_i(l) * RWD, INP(14) + (size_t)fresh_i(l) * RWD};
              pg8::gemm_phase<pg8::EpiLora, pg8::StaticOrder, true>(ring, g, S, E); }
        }
        SEAM(pb + 3);
        if (IN(pb + 4)) prep2_phase(F, l);
        SEAM(pb + 4);
        if (IN(pb + 5)) scan_phase(F, l);
        SEAM(pb + 5);
        if (IN(pb + 6)) post_phase(F, l);
        SEAM(pb + 6);
        if (IN(pb + 7)) {
            { pg8::Gemm g{(const bf16_t*)(fresh(F.ws) + WS_YA), (const bf16_t*)(fresh(F.ws) + WS_PPOOL), MT, DM, PWD, PWD, PWD, 0}; pg8::StaticOrder S; S.init(MT, DM, fresh_i(F.G), fresh_i(cid));
              pg8::EpiGate1 E{(float*)(fresh(F.ws) + WS_TMP), (const bf16_t*)(fresh(F.ws) + WS_PROJ), PC_GP}; pg8::gemm_phase<pg8::EpiGate1, pg8::StaticOrder, true>(ring, g, S, E); }
            { pg8::Gemm g{(const bf16_t*)(fresh(F.ws) + WS_YB), (const bf16_t*)(fresh(F.ws) + WS_PRWKV), MT, DM, RWD, RWD, RWD, 0}; pg8::StaticOrder S; S.init(MT, DM, fresh_i(F.G), fresh_i(cid));
              pg8::EpiGate2 E{(const float*)(fresh(F.ws) + WS_TMP), (const bf16_t*)(fresh(F.ws) + WS_PROJ), PC_GR, (bf16_t*)(fresh(F.ws) + WS_MRG)}; pg8::gemm_phase<pg8::EpiGate2, pg8::StaticOrder, true>(ring, g, S, E); }
        }
        SEAM(pb + 7);
        if (IN(pb + 8)) { pg8::Gemm g{(const bf16_t*)(fresh(F.ws) + WS_MRG), (const bf16_t*)(fresh(F.ws) + WS_WOUT), MT, DM, DM, DM, DM, 0}; pg8::StaticOrder S; S.init(MT, DM, fresh_i(F.G), fresh_i(cid));
            pg8::EpiResid E{F.out}; pg8::gemm_phase<pg8::EpiResid, pg8::StaticOrder, true>(ring, g, S, E); }
        SEAM(pb + 8);
        if (IN(pb + 9)) norm_rows<false, false>(F, INP(25) + (size_t)fresh_i(l) * DM);
        SEAM(pb + 9);
        if (IN(pb + 10)) {
            { pg8::Gemm g{(const bf16_t*)(fresh(F.ws) + WS_XN), (const bf16_t*)(fresh(F.ws) + WS_WGU), MT, 2 * FF, DM, DM, DM, 0}; pg8::StaticOrder S; S.init(MT, 2 * FF, fresh_i(F.G), fresh_i(cid));
              pg8::EpiSwiglu E{(bf16_t*)(fresh(F.ws) + WS_HID)}; pg8::gemm_phase<pg8::EpiSwiglu, pg8::StaticOrder, true>(ring, g, S, E); }
            { pg8::Gemm g{(const bf16_t*)(fresh(F.ws) + WS_PB), (const bf16_t*)(fresh(F.ws) + WS_WPP), MT, DM, PLE, PLE, PLE, 0}; pg8::StaticOrder S; S.init(MT, DM, fresh_i(F.G), fresh_i(cid));
              pg8::EpiBf16 E{(bf16_t*)(fresh(F.ws) + WS_PP), DM}; pg8::gemm_phase<pg8::EpiBf16, pg8::StaticOrder, true>(ring, g, S, E); }
        }
        SEAM(pb + 10);
        if (IN(pb + 11)) { pg8::Gemm g{(const bf16_t*)(fresh(F.ws) + WS_HID), (const bf16_t*)(fresh(F.ws) + WS_WDN), MT, DM, FF, FF, FF, 0}; pg8::StaticOrder S; S.init(MT, DM, fresh_i(F.G), fresh_i(cid));
            pg8::EpiResid E{F.out}; pg8::gemm_phase<pg8::EpiResid, pg8::StaticOrder, true>(ring, g, S, E); }
        SEAM(pb + 11);
        if (IN(pb + 12)) norm_rows<false, false>(F, INP(29) + (size_t)fresh_i(l) * DM);
        SEAM(pb + 12);
        if (IN(pb + 13)) { pg8::Gemm g{(const bf16_t*)(fresh(F.ws) + WS_XN), (const bf16_t*)(fresh(F.ws) + WS_WPG), MT, DM, DM, DM, DM, 0}; pg8::StaticOrder S; S.init(MT, DM, fresh_i(F.G), fresh_i(cid));
            pg8::EpiPle E{F.out, (const bf16_t*)(fresh(F.ws) + WS_PP)}; pg8::gemm_phase<pg8::EpiPle, pg8::StaticOrder, true>(ring, g, S, E); }
        SEAM(pb + 13);
    }
    { const int pb_ = 0; (void)pb_; if (IN(NL * PH_PER_LAYER)) norm_rows<false, true>(F, INP(32)); }
#undef IN
#undef SEAM
}

extern "C" void kernel_launch(void* const* d_in, const int* in_sizes, int n_in, void* d_out, int out_size, void* d_ws, size_t ws_size, hipStream_t stream) {
    static int grid = 0;
    if (grid == 0) {
        if (n_in != 33 || in_sizes[0] != MPR * DM || out_size != (int)O_END || ws_size < WS_END) {
            fprintf(stderr, "kernel_launch: unexpected shapes: n_in %d in0 %d out %d ws %zu (need %zu); nothing launched\n", n_in, n_in > 0 ? in_sizes[0] : -1, out_size, ws_size, (size_t)WS_END); grid = -1; return; }
        int dev = 0, cus = 0, per_cu = 0;
        if (hipGetDevice(&dev) != hipSuccess || hipDeviceGetAttribute(&cus, hipDeviceAttributeMultiprocessorCount, dev) != hipSuccess) { grid = -1; return; }
        if (hipFuncSetAttribute((const void*)mega_fwd, hipFuncAttributeMaxDynamicSharedMemorySize, LDS_BYTES) != hipSuccess) { fprintf(stderr, "kernel_launch: hipFuncSetAttribute failed\n"); grid = -1; return; }
        if (hipOccupancyMaxActiveBlocksPerMultiprocessor(&per_cu, (const void*)mega_fwd, NTHR, LDS_BYTES) != hipSuccess || per_cu < 1) { fprintf(stderr, "kernel_launch: occupancy query says %d\n", per_cu); (void)hipGetLastError(); grid = -1; return; }
        grid = cus;
    }
    if (grid < 0) return;
    (void)hipMemsetAsync((char*)d_ws + WS_CTL, 0, CTL_ZERO_BYTES, stream);
    Args a; memset(&a, 0, sizeof(a));
    for (int i = 0; i < 33; ++i) a.in[i] = (const float*)d_in[i];
    a.out = (float*)d_out; a.ws = (unsigned char*)d_ws;
#if MK_PER_PHASE
    for (int p = 0; p < N_PHASES; ++p) { a.ph_lo = p; a.ph_hi = p + 1; hipLaunchKernelGGL(mega_fwd, dim3(grid), dim3(NTHR), LDS_BYTES, stream, a); }
#else
    a.ph_lo = 0; a.ph_hi = N_PHASES; hipLaunchKernelGGL(mega_fwd, dim3(grid), dim3(NTHR), LDS_BYTES, stream, a);
#endif
}
```

```cpp
#include <hip/hip_runtime.h>
#include <cstdio>
#include <cstdint>
#include <cstring>

#ifndef MK_PER_PHASE
#define MK_PER_PHASE 0
#endif

#define LAS __attribute__((address_space(3)))
typedef unsigned short bf16_t;
typedef short bf16x8 __attribute__((ext_vector_type(8)));
typedef float f32x4 __attribute__((ext_vector_type(4)));
typedef float f32x2 __attribute__((ext_vector_type(2)));
typedef unsigned u32x4 __attribute__((ext_vector_type(4)));
typedef unsigned u32x2 __attribute__((ext_vector_type(2)));

constexpr int DM = 2048, NL = 4, MT = 16896, MPR = 16384, TP = 2048, TS = 64;
constexpr int PWD = 1024, RWD = 1024, RPJ = 3360, ICOLS = 8480, ICP = 8704, FF = 5632, PLE = 256, LK = 384;
constexpr int PC_GP = 4608, PC_GR = 6656;
constexpr float NORM_EPS = 1e-6f, GN_EPS = 64e-5f;
constexpr size_t O_YS = 33554432, O_SHP = 34603008, O_POP = 34710528, O_WKP = 35202048, O_SHS = 37299200, O_POS = 37406720, O_WKS = 37898240, O_END = 39995392;

__device__ __forceinline__ unsigned cvt_pk_bf16(float lo, float hi) { unsigned r; asm volatile("v_cvt_pk_bf16_f32 %0, %1, %2" : "=v"(r) : "v"(lo), "v"(hi)); return r; }
__device__ __forceinline__ float bf_lo(unsigned u) { return __uint_as_float(u << 16); }
__device__ __forceinline__ float bf_hi(unsigned u) { return __uint_as_float(u & 0xffff0000u); }
__device__ __forceinline__ void unpack8(const u32x4 w, float (&f)[8]) { f[0] = bf_lo(w.x); f[1] = bf_hi(w.x); f[2] = bf_lo(w.y); f[3] = bf_hi(w.y); f[4] = bf_lo(w.z); f[5] = bf_hi(w.z); f[6] = bf_lo(w.w); f[7] = bf_hi(w.w); }
__device__ __forceinline__ u32x4 pack8(const float (&f)[8]) { u32x4 w; w.x = cvt_pk_bf16(f[0], f[1]); w.y = cvt_pk_bf16(f[2], f[3]); w.z = cvt_pk_bf16(f[4], f[5]); w.w = cvt_pk_bf16(f[6], f[7]); return w; }
__device__ __forceinline__ float sigmoidf_(float x) { return __builtin_amdgcn_rcpf(1.0f + __expf(-x)); }
__device__ __forceinline__ f32x4 sigmoid4(f32x4 v) { f32x4 o; o.x = sigmoidf_(v.x); o.y = sigmoidf_(v.y); o.z = sigmoidf_(v.z); o.w = sigmoidf_(v.w); return o; }
__device__ __forceinline__ float tanhf_(float x) { const float e = __expf(2.0f * x); return 1.0f - 2.0f * __builtin_amdgcn_rcpf(e + 1.0f); }
template <int CTRL> __device__ __forceinline__ float dpp_f(float x) { return __uint_as_float((unsigned)__builtin_amdgcn_update_dpp(0, (int)__float_as_uint(x), CTRL, 0xF, 0xF, true)); }
__device__ __forceinline__ float sum8(float x) { x += dpp_f<0xB1>(x); x += dpp_f<0x4E>(x); x += dpp_f<0x141>(x); return x; }
__device__ __forceinline__ float wave_sum(float x) {
    x += dpp_f<0xB1>(x); x += dpp_f<0x4E>(x); x += dpp_f<0x141>(x); x += dpp_f<0x140>(x);
    x += __uint_as_float((unsigned)__builtin_amdgcn_ds_swizzle((int)__float_as_uint(x), 0x401F));
    return __uint_as_float((unsigned)__builtin_amdgcn_readlane((int)__float_as_uint(x), 0)) + __uint_as_float((unsigned)__builtin_amdgcn_readlane((int)__float_as_uint(x), 32));
}

namespace pg8 {
constexpr int BM = 256, BK = 64, HALF = 128, HTB = HALF * BK * 2  , STAGE_BYTES = 8 * HTB, NXCD = 8, WGM = 8;
__host__ __device__ __forceinline__ int lds_byte(int r, int c) { const int st = (r >> 4) * 2 + (c >> 5), rr = r & 15, cc = c & 31, ob = rr * 64 + cc * 2; return st * 1024 + (ob ^ (((ob >> 9) & 1) << 5)); }
__host__ __device__ __forceinline__ void stage_rc(int b, int& R, int& C) { const int st = b / 1024, sb = b % 1024, swz = sb ^ (((sb >> 9) & 1) << 5); R = (st >> 1) * 16 + swz / 64; C = (st & 1) * 32 + (swz % 64) / 2; }
__host__ __device__ __forceinline__ int perm32(int rho) { const int n = rho >> 4, i = rho & 15; return 8 * (i >> 2) + 4 * n + (i & 3); }

struct Unit { int pm, pn; };
struct Gemm { const bf16_t* A; const bf16_t* Bt; int M, N, K, lda, ldb, a_pn_off; };

struct StaticOrder {
    int nM, nN, nwg, G, c;
    __host__ __device__ void init(int M, int N, int G_, int c_) { nM = M / BM; nN = N / BM; nwg = nM * nN; G = G_; c = c_; }
    __host__ __device__ bool next(int i, Unit& u) const {
        const long L = (long)i * G + c; if (L >= nwg) return false;
        int wgid = (int)L; { const int q = nwg / NXCD, r = nwg % NXCD, xcd = wgid % NXCD, off = wgid / NXCD; wgid = (xcd < r ? xcd * (q + 1) : r * (q + 1) + (xcd - r) * q) + off; }
        const int nig = WGM * nN, gid = wgid / nig, fm = gid * WGM, gsz = (nM - fm) < WGM ? (nM - fm) : WGM;
        u.pm = fm + ((wgid % nig) % gsz); u.pn = (wgid % nig) / gsz; return true;
    }
    __device__ __forceinline__ void a_ready(const Unit&) const {}
    __device__ __forceinline__ void done(const Unit&) const {}
};

__device__ __forceinline__ void acc_zero(f32x4 (&acc)[2][2][4][2]) {
#pragma unroll
    for (int a = 0; a < 2; ++a)
#pragma unroll
        for (int b = 0; b < 2; ++b)
#pragma unroll
            for (int m = 0; m < 4; ++m)
#pragma unroll
                for (int n = 0; n < 2; ++n) acc[a][b][m][n] = (f32x4){0.f, 0.f, 0.f, 0.f};
}
struct RepeatOrder : StaticOrder {
    __host__ __device__ bool next(int i, Unit& u) const { if (i >= 6) return false; return StaticOrder::next(i % 3, u) || StaticOrder::next(0, u); }
};
#define EPI_ZERO_INIT __device__ __forceinline__ void init(f32x4 (&acc)[2][2][4][2], const Unit&, int, int, int, int) const { acc_zero(acc); }
template <class Epi, class Sched, bool ALIGN_EPI>
__device__ __forceinline__ void gemm_phase(LAS unsigned char* lds, const Gemm g, const Sched& S, const Epi& E) {
    int tid_ = threadIdx.x; asm volatile("" : "+v"(tid_));
    const int tid = tid_, wid = __builtin_amdgcn_readfirstlane(tid >> 6), lane = tid & 63, wr = wid >> 2, wc = wid & 3, fr = lane & 15, fq = lane >> 4;
    int K_ = g.K; asm volatile("" : "+s"(K_));
    const int K = K_, nt = K / BK;
    unsigned voffA[2], voffB[2];
#pragma unroll
    for (int i = 0; i < 2; ++i) { int R, C; stage_rc(tid * 16 + i * 8192, R, C); const int Rb = Epi::PERM ? (64 * (R >> 5) + perm32(R & 31)) : R;
        voffA[i] = (unsigned)(R * g.lda + C) * 2u; voffB[i] = (unsigned)(Rb * g.ldb + C) * 2u; }
    const size_t kstep = (size_t)(BK * 2);
    const size_t hstepA = (size_t)HALF * g.lda * 2, hstepB = (size_t)(Epi::PERM ? 32 : HALF) * g.ldb * 2;
    const unsigned ldsw = (unsigned)wid * 1024u;
    const int aoff = lds_byte(wr * 64 + fr, fq * 8), boff = lds_byte(wc * 32 + fr, fq * 8);
#define PG8_SA(b, h) (((b) * 2 + (h)) * HTB)
#define PG8_SB(b, h) ((4 + (b) * 2 + (h)) * HTB)
#define PG8_STAGE(bufoff, gbase, voff) do { _Pragma("unroll") for (int _i = 0; _i < 2; ++_i) \
        __builtin_amdgcn_global_load_lds((const unsigned*)((const char*)(gbase) + (voff)[_i]), (LAS unsigned*)(lds + (bufoff) + ldsw + _i * 8192), 16, 0, 0); } while (0)
#define PG8_LDA(dst, b, h) do { _Pragma("unroll") for (int m = 0; m < 4; ++m) _Pragma("unroll") for (int k = 0; k < 2; ++k) dst[m][k] = *(const LAS bf16x8*)(lds + PG8_SA(b, h) + aoff + m * 2048 + k * 1024); } while (0)
#define PG8_LDB(dst, b, h) do { _Pragma("unroll") for (int n = 0; n < 2; ++n) _Pragma("unroll") for (int k = 0; k < 2; ++k) dst[n][k] = *(const LAS bf16x8*)(lds + PG8_SB(b, h) + boff + n * 2048 + k * 1024); } while (0)
#define PG8_MMA(ai, bj, At, Bt) do { __builtin_amdgcn_s_setprio(1); _Pragma("unroll") for (int m = 0; m < 4; ++m) _Pragma("unroll") for (int n = 0; n < 2; ++n) _Pragma("unroll") for (int k = 0; k < 2; ++k) \
        acc[ai][bj][m][n] = __builtin_amdgcn_mfma_f32_16x16x32_bf16(Bt[n][k], At[m][k], acc[ai][bj][m][n], 0, 0, 0); __builtin_amdgcn_s_setprio(0); } while (0)
#define PG8_WAIT_V(n) asm volatile("s_waitcnt vmcnt(" #n ")" ::: "memory")
#define PG8_WAIT_L(n) asm volatile("s_waitcnt lgkmcnt(" #n ")" ::: "memory")
#define PG8_BAR __builtin_amdgcn_s_barrier()
#define PG8_SCHED __builtin_amdgcn_sched_barrier(0)
    Unit cur, nxt; int ui = 0;
    if (!S.next(0, cur)) return;
    f32x4 acc[2][2][4][2];
    E.init(acc, cur, wr, wc, fr, fq);
    bf16x8 At[4][2], B0[2][2], B1[2][2];
    const char* cA = (const char*)g.A + ((size_t)cur.pm * BM * g.lda + (size_t)cur.pn * g.a_pn_off) * 2; const char* cB = (const char*)g.Bt + (size_t)cur.pn * BM * g.ldb * 2;
    S.a_ready(cur);
    PG8_STAGE(PG8_SB(0, 0), cB, voffB); PG8_STAGE(PG8_SB(0, 1), cB + hstepB, voffB); PG8_STAGE(PG8_SA(0, 0), cA, voffA); PG8_STAGE(PG8_SA(0, 1), cA + hstepA, voffA);
    if (wr == 1) PG8_BAR;
    PG8_WAIT_V(2); PG8_BAR;
    PG8_STAGE(PG8_SB(1, 0), cB + kstep, voffB); PG8_STAGE(PG8_SA(1, 0), cA + kstep, voffA); PG8_STAGE(PG8_SB(1, 1), cB + hstepB + kstep, voffB);
    PG8_WAIT_V(6); PG8_BAR;
    for (;;) {
        const bool has_next = S.next(ui + 1, nxt);
        const char* nA = has_next ? (const char*)g.A + ((size_t)nxt.pm * BM * g.lda + (size_t)nxt.pn * g.a_pn_off) * 2 : cA; const char* nB = has_next ? (const char*)g.Bt + (size_t)nxt.pn * BM * g.ldb * 2 : cB;
#pragma unroll 1
        for (int t = 0; t < nt; t += 2) {
            const bool last = (t == nt - 2);
            const char* a1 = cA + (size_t)(t + 1) * kstep;
            const char* a2 = last ? nA : cA + (size_t)(t + 2) * kstep; const char* b2 = last ? nB : cB + (size_t)(t + 2) * kstep;
            const char* a3 = a2 + kstep; const char* b3 = b2 + kstep;
            if (last && has_next) S.a_ready(nxt);
            PG8_LDB(B0, 0, 0); PG8_LDB(B1, 0, 1); PG8_SCHED; PG8_LDA(At, 0, 0); PG8_STAGE(PG8_SA(1, 1), a1 + hstepA, voffA);
            PG8_WAIT_V(8); PG8_WAIT_L(0); PG8_BAR; PG8_MMA(0, 0, At, B0); PG8_MMA(0, 1, At, B1); PG8_BAR; PG8_SCHED;
            PG8_LDA(At, 0, 1); PG8_STAGE(PG8_SB(0, 0), b2, voffB); PG8_STAGE(PG8_SB(0, 1), b2 + hstepB, voffB); PG8_STAGE(PG8_SA(0, 0), a2, voffA);
            PG8_WAIT_V(8); PG8_WAIT_L(0); PG8_BAR; PG8_MMA(1, 0, At, B0); PG8_MMA(1, 1, At, B1); PG8_BAR; PG8_SCHED;
            PG8_LDB(B0, 1, 0); PG8_LDB(B1, 1, 1); PG8_SCHED; PG8_LDA(At, 1, 0); PG8_STAGE(PG8_SA(0, 1), a2 + hstepA, voffA);
            PG8_WAIT_V(8); PG8_WAIT_L(0); PG8_BAR; PG8_MMA(0, 0, At, B0); PG8_MMA(0, 1, At, B1); PG8_BAR; PG8_SCHED;
            PG8_LDA(At, 1, 1); PG8_STAGE(PG8_SB(1, 0), b3, voffB); PG8_STAGE(PG8_SB(1, 1), b3 + hstepB, voffB); PG8_STAGE(PG8_SA(1, 0), a3, voffA);
            PG8_WAIT_V(8); PG8_WAIT_L(0); PG8_BAR; PG8_MMA(1, 0, At, B0); PG8_MMA(1, 1, At, B1); PG8_BAR; PG8_SCHED;
        }
        if constexpr (ALIGN_EPI) { if (wr == 0) PG8_BAR; }
        E(acc, cur, wr, wc, fr, fq); S.done(cur);
        if (!has_next) break;
        E.init(acc, nxt, wr, wc, fr, fq);
        cur = nxt; cA = nA; cB = nB; ++ui;
        if constexpr (ALIGN_EPI) { if (wr == 1) PG8_BAR; }
    }
    PG8_WAIT_V(0);
    if constexpr (!ALIGN_EPI) { if (wr == 0) PG8_BAR; }
    PG8_BAR;
#undef PG8_SA
#undef PG8_SB
#undef PG8_STAGE
#undef PG8_LDA
#undef PG8_LDB
#undef PG8_MMA
#undef PG8_WAIT_V
#undef PG8_WAIT_L
#undef PG8_BAR
#undef PG8_SCHED
}

#define EPI_ROW0 (u.pm * BM + wr * 64 + fr)
#define EPI_FOR_AI_M _Pragma("unroll") for (int ai = 0; ai < 2; ++ai) _Pragma("unroll") for (int m = 0; m < 4; ++m)
__device__ __forceinline__ u32x4 pack_f4x2(f32x4 v0, f32x4 v1) { u32x4 w; w.x = cvt_pk_bf16(v0[0], v0[1]); w.y = cvt_pk_bf16(v0[2], v0[3]); w.z = cvt_pk_bf16(v1[0], v1[1]); w.w = cvt_pk_bf16(v1[2], v1[3]); return w; }
__device__ __forceinline__ void unpack_f4x2(u32x4 w, f32x4& v0, f32x4& v1) { v0[0] = bf_lo(w.x); v0[1] = bf_hi(w.x); v0[2] = bf_lo(w.y); v0[3] = bf_hi(w.y); v1[0] = bf_lo(w.z); v1[1] = bf_hi(w.z); v1[2] = bf_lo(w.w); v1[3] = bf_hi(w.w); }
__device__ __forceinline__ unsigned ror8(unsigned x) { return (unsigned)__builtin_amdgcn_update_dpp(0, (int)x, 0x128, 0xF, 0xF, true); }
__device__ __forceinline__ void st_pair(char* grp, size_t pitch, int fr, int fq, u32x4 vA, u32x4 vB) {
    const bool lo = fr < 8;
    u32x4 snd = lo ? vB : vA, rcv; rcv.x = ror8(snd.x); rcv.y = ror8(snd.y); rcv.z = ror8(snd.z); rcv.w = ror8(snd.w);
    char* p = grp + (size_t)(fr & 7) * pitch + (lo ? 0 : 64) + fq * 16;
    *(u32x4*)p = lo ? vA : rcv;
    *(u32x4*)(p + 8 * pitch) = lo ? rcv : vB;
}
__device__ __forceinline__ u32x4 as_u4(f32x4 v) { return __builtin_bit_cast(u32x4, v); }

struct EpiNull { static constexpr bool PERM = true; EPI_ZERO_INIT __device__ __forceinline__ void operator()(const f32x4 (&acc)[2][2][4][2], const Unit& u, int wr, int wc, int fr, int fq) const {
#pragma unroll
    for (int a = 0; a < 2; ++a)
#pragma unroll
        for (int b = 0; b < 2; ++b)
#pragma unroll
            for (int m = 0; m < 4; ++m)
#pragma unroll
                for (int n = 0; n < 2; ++n) asm volatile("" :: "v"(acc[a][b][m][n]));
} };
struct EpiProj { static constexpr bool PERM = true; EPI_ZERO_INIT
    bf16_t* O;
    __device__ __forceinline__ void operator()(const f32x4 (&acc)[2][2][4][2], const Unit& u, int wr, int wc, int fr, int fq) const {
        const bool sg = u.pn >= 18;
        EPI_FOR_AI_M { char* grp = (char*)(O + (size_t)(u.pm * BM + ai * HALF + wr * 64 + m * 16) * ICP + u.pn * BM + 64 * wc);
            f32x4 a0 = acc[ai][0][m][0], a1 = acc[ai][0][m][1], b0 = acc[ai][1][m][0], b1 = acc[ai][1][m][1];
            if (sg) { a0 = sigmoid4(a0); a1 = sigmoid4(a1); b0 = sigmoid4(b0); b1 = sigmoid4(b1); }
            st_pair(grp, (size_t)ICP * 2, fr, fq, pack_f4x2(a0, a1), pack_f4x2(b0, b1)); }
    }
};
struct EpiBf16 { static constexpr bool PERM = true; EPI_ZERO_INIT
    bf16_t* O; int ldc;
    __device__ __forceinline__ void operator()(const f32x4 (&acc)[2][2][4][2], const Unit& u, int wr, int wc, int fr, int fq) const {
        EPI_FOR_AI_M { char* grp = (char*)(O + (size_t)(u.pm * BM + ai * HALF + wr * 64 + m * 16) * ldc + u.pn * BM + 64 * wc);
            st_pair(grp, (size_t)ldc * 2, fr, fq, pack_f4x2(acc[ai][0][m][0], acc[ai][0][m][1]), pack_f4x2(acc[ai][1][m][0], acc[ai][1][m][1])); }
    }
};
struct EpiLora { static constexpr bool PERM = true; EPI_ZERO_INIT
    float* DEC; bf16_t* AA; bf16_t* GG; const float* w0; const float* a0;
    __device__ __forceinline__ void operator()(const f32x4 (&acc)[2][2][4][2], const Unit& u, int wr, int wc, int fr, int fq) const {
        const int row0 = EPI_ROW0, kind = u.pn >> 2, ct = (u.pn & 3) * BM + 64 * wc, col0 = ct + 8 * fq;
        if (kind == 0) {
            EPI_FOR_AI_M { float* rowp = DEC + (size_t)(row0 + ai * HALF + m * 16) * RWD + col0;
#pragma unroll
                for (int bj = 0; bj < 2; ++bj)
#pragma unroll
                    for (int n = 0; n < 2; ++n) { const f32x4 b = *(const f32x4*)(w0 + col0 + bj * 32 + 4 * n); const f32x4 x = acc[ai][bj][m][n] + b; f32x4 o;
#pragma unroll
                        for (int j = 0; j < 4; ++j) { const float z = -x[j]; const float sp = z > 15.f ? z : __logf(1.0f + __expf(z)); const float w = -sp - 0.5f; o[j] = __expf(-__expf(w)); }
                        *(f32x4*)(rowp + bj * 32 + 4 * n) = o; } asm volatile("" ::: "memory"); }
        } else if (kind == 1) {
            const f32x4 b00 = *(const f32x4*)(a0 + col0), b01 = *(const f32x4*)(a0 + col0 + 4), b10 = *(const f32x4*)(a0 + col0 + 32), b11 = *(const f32x4*)(a0 + col0 + 36);
            EPI_FOR_AI_M { char* grp = (char*)(AA + (size_t)(u.pm * BM + ai * HALF + wr * 64 + m * 16) * RWD + ct);
                st_pair(grp, (size_t)RWD * 2, fr, fq, pack_f4x2(sigmoid4(acc[ai][0][m][0] + b00), sigmoid4(acc[ai][0][m][1] + b01)), pack_f4x2(sigmoid4(acc[ai][1][m][0] + b10), sigmoid4(acc[ai][1][m][1] + b11))); }
        } else {
            EPI_FOR_AI_M { char* grp = (char*)(GG + (size_t)(u.pm * BM + ai * HALF + wr * 64 + m * 16) * RWD + ct);
                st_pair(grp, (size_t)RWD * 2, fr, fq, pack_f4x2(acc[ai][0][m][0], acc[ai][0][m][1]), pack_f4x2(acc[ai][1][m][0], acc[ai][1][m][1])); }
        }
    }
};
struct EpiGate1 { static constexpr bool PERM = true; EPI_ZERO_INIT
    bf16_t* TMP; const bf16_t* PROJ; int gcol0;
    __device__ __forceinline__ void operator()(const f32x4 (&acc)[2][2][4][2], const Unit& u, int wr, int wc, int fr, int fq) const {
        const int row0 = EPI_ROW0, ct = u.pn * BM + 64 * wc, col0 = ct + 8 * fq;
        EPI_FOR_AI_M { const size_t row = (size_t)(row0 + ai * HALF + m * 16);
            f32x4 g00, g01, g10, g11; unpack_f4x2(*(const u32x4*)(PROJ + row * ICP + gcol0 + col0), g00, g01); unpack_f4x2(*(const u32x4*)(PROJ + row * ICP + gcol0 + col0 + 32), g10, g11);
            st_pair((char*)(TMP + (size_t)(u.pm * BM + ai * HALF + wr * 64 + m * 16) * DM + ct), (size_t)DM * 2, fr, fq, pack_f4x2(acc[ai][0][m][0] * g00, acc[ai][0][m][1] * g01), pack_f4x2(acc[ai][1][m][0] * g10, acc[ai][1][m][1] * g11));
            if (m & 1) asm volatile("" ::: "memory"); }
    }
};
struct EpiGate2 { static constexpr bool PERM = true; EPI_ZERO_INIT
    const bf16_t* TMP; const bf16_t* PROJ; int gcol0; bf16_t* O;
    __device__ __forceinline__ void operator()(const f32x4 (&acc)[2][2][4][2], const Unit& u, int wr, int wc, int fr, int fq) const {
        const int row0 = EPI_ROW0, ct = u.pn * BM + 64 * wc, col0 = ct + 8 * fq;
        EPI_FOR_AI_M { const size_t row = (size_t)(row0 + ai * HALF + m * 16);
            f32x4 g00, g01, g10, g11, t00, t01, t10, t11; unpack_f4x2(*(const u32x4*)(PROJ + row * ICP + gcol0 + col0), g00, g01); unpack_f4x2(*(const u32x4*)(PROJ + row * ICP + gcol0 + col0 + 32), g10, g11);
            unpack_f4x2(*(const u32x4*)(TMP + row * DM + col0), t00, t01); unpack_f4x2(*(const u32x4*)(TMP + row * DM + col0 + 32), t10, t11);
            st_pair((char*)(O + (size_t)(u.pm * BM + ai * HALF + wr * 64 + m * 16) * DM + ct), (size_t)DM * 2, fr, fq, pack_f4x2(t00 + acc[ai][0][m][0] * g00, t01 + acc[ai][0][m][1] * g01), pack_f4x2(t10 + acc[ai][1][m][0] * g10, t11 + acc[ai][1][m][1] * g11));
            if (m & 1) asm volatile("" ::: "memory"); }
    }
};
struct EpiResid { static constexpr bool PERM = false;
    float* X;
    __device__ __forceinline__ void init(f32x4 (&acc)[2][2][4][2], const Unit& u, int wr, int wc, int fr, int fq) const {
        const int row0 = EPI_ROW0, col0 = u.pn * BM + wc * 32 + 4 * fq;
        EPI_FOR_AI_M { const float* rowp = X + (size_t)(row0 + ai * HALF + m * 16) * DM + col0;
#pragma unroll
            for (int bj = 0; bj < 2; ++bj) { acc[ai][bj][m][0] = *(const f32x4*)(rowp + bj * HALF); acc[ai][bj][m][1] = *(const f32x4*)(rowp + bj * HALF + 16); } }
    }
    __device__ __forceinline__ void operator()(const f32x4 (&acc)[2][2][4][2], const Unit& u, int wr, int wc, int fr, int fq) const {
        EPI_FOR_AI_M {
#pragma unroll
            for (int bj = 0; bj < 2; ++bj) st_pair((char*)(X + (size_t)(u.pm * BM + ai * HALF + wr * 64 + m * 16) * DM + u.pn * BM + bj * HALF + wc * 32), (size_t)DM * 4, fr, fq, as_u4(acc[ai][bj][m][0]), as_u4(acc[ai][bj][m][1])); }
    }
};
struct EpiSwiglu { static constexpr bool PERM = true; EPI_ZERO_INIT
    bf16_t* H;
    __device__ __forceinline__ void operator()(const f32x4 (&acc)[2][2][4][2], const Unit& u, int wr, int wc, int fr, int fq) const {
        const int row0 = EPI_ROW0, col0 = u.pn * HALF + wc * 32 + 8 * fq;
        EPI_FOR_AI_M { const f32x4 g0 = acc[ai][0][m][0], g1 = acc[ai][0][m][1], u0 = acc[ai][1][m][0], u1 = acc[ai][1][m][1];
            *(u32x4*)(H + (size_t)(row0 + ai * HALF + m * 16) * FF + col0) = pack_f4x2(g0 * sigmoid4(g0) * u0, g1 * sigmoid4(g1) * u1); }
    }
};
struct EpiPle { static constexpr bool PERM = false; EPI_ZERO_INIT
    float* X; const bf16_t* PP;
    __device__ __forceinline__ void operator()(const f32x4 (&acc)[2][2][4][2], const Unit& u, int wr, int wc, int fr, int fq) const {
        const int row0 = EPI_ROW0, col0 = u.pn * BM + wc * 32 + 4 * fq;
        EPI_FOR_AI_M { const size_t row = (size_t)(row0 + ai * HALF + m * 16);
#pragma unroll
            for (int bj = 0; bj < 2; ++bj) { const u32x2 q0 = *(const u32x2*)(PP + row * DM + col0 + bj * HALF), q1 = *(const u32x2*)(PP + row * DM + col0 + bj * HALF + 16);
                const f32x4 p0 = (f32x4){bf_lo(q0.x), bf_hi(q0.x), bf_lo(q0.y), bf_hi(q0.y)}, p1 = (f32x4){bf_lo(q1.x), bf_hi(q1.x), bf_lo(q1.y), bf_hi(q1.y)};
                const float* p = X + row * DM + col0 + bj * HALF; const f32x4 x0 = *(const f32x4*)p, x1 = *(const f32x4*)(p + 16);
                st_pair((char*)(X + (size_t)(u.pm * BM + ai * HALF + wr * 64 + m * 16) * DM + u.pn * BM + bj * HALF + wc * 32), (size_t)DM * 4, fr, fq, as_u4(x0 + sigmoid4(acc[ai][bj][m][0]) * p0), as_u4(x1 + sigmoid4(acc[ai][bj][m][1]) * p1)); }
            asm volatile("" ::: "memory"); }
    }
};
#undef EPI_ROW0
#undef EPI_FOR_AI_M
}

constexpr size_t MiB = 1u << 20;
constexpr size_t al1m(size_t x) { return (x + MiB - 1) / MiB * MiB; }
constexpr size_t WS_CTL = 0, CTL_ZERO_BYTES = 1 * MiB;
constexpr size_t SZ_WIN = (size_t)ICP * DM * 2, SZ_POOLW = (size_t)PWD * 256 * 2, SZ_LORA = (size_t)3072 * LK * 2, SZ_PPOOL = (size_t)DM * PWD * 2, SZ_PRWKV = (size_t)DM * RWD * 2,
                 SZ_WOUT = (size_t)DM * DM * 2, SZ_WGU = (size_t)2 * FF * DM * 2, SZ_WDN = (size_t)DM * FF * 2, SZ_WPG = (size_t)DM * DM * 2, SZ_WPP = (size_t)DM * PLE * 2;
constexpr size_t WS_WIN = 1 * MiB, WS_POOLW = WS_WIN + SZ_WIN, WS_LORA = WS_POOLW + SZ_POOLW, WS_PPOOL = WS_LORA + SZ_LORA, WS_PRWKV = WS_PPOOL + SZ_PPOOL, WS_WOUT = WS_PRWKV + SZ_PRWKV,
                 WS_WGU = WS_WOUT + SZ_WOUT, WS_WDN = WS_WGU + SZ_WGU, WS_WPG = WS_WDN + SZ_WDN, WS_WPP = WS_WPG + SZ_WPG, WS_WEND = WS_WPP + SZ_WPP;
constexpr size_t WS_PB = al1m(WS_WEND);
constexpr size_t WS_XN = al1m(WS_PB + (size_t)MT * PLE * 2);
constexpr size_t WS_AA = al1m(WS_XN + (size_t)MT * DM * 2);
constexpr size_t WS_GG = al1m(WS_AA + (size_t)MT * RWD * 2);
constexpr size_t WS_PP = al1m(WS_GG + (size_t)MT * RWD * 2);
constexpr size_t WS_PROJ = al1m(WS_PP + (size_t)MT * DM * 2);
constexpr size_t WS_HID = WS_PROJ;
constexpr size_t WS_D = al1m(WS_PROJ + (size_t)MT * ICP * 2);
constexpr size_t WS_LIN = al1m(WS_D + (size_t)MT * PWD * 2);
constexpr size_t WS_YA = al1m(WS_LIN + (size_t)MT * LK * 2);
constexpr size_t WS_DEC = al1m(WS_YA + (size_t)MT * PWD * 2);
constexpr size_t WS_BS = al1m(WS_DEC + (size_t)MT * RWD * 4);
constexpr size_t WS_Y = al1m(WS_BS + (size_t)MT * 16 * 4);
constexpr size_t SZ_BH = (size_t)MT * RWD * 2;
constexpr size_t WS_YB = al1m(WS_Y + (size_t)MT * RWD * 4);
constexpr size_t WS_TMP = al1m(WS_YB + SZ_BH);
constexpr size_t WS_MRG = al1m(WS_TMP + (size_t)MT * DM * 4);
constexpr size_t WS_END = al1m(WS_MRG + (size_t)MT * DM * 2);
static_assert((size_t)MT * FF * 2 <= (size_t)MT * ICP * 2, "HID overlay");

constexpr int CW_BAR = 4096;
constexpr int NWAVES = 8, NTHR = 512;
constexpr int RING_BYTES = 131072, LDSCTL_OFF = RING_BYTES, LDS_BYTES = 147456;

#define XB_TMO      128
#define XB_XCNT(j)  (256  + 64 * (j))
#define XB_XSUB(j)  (1280 + 64 * (j))
#define XB_XGEN(j)  (2304 + 64 * (j))
#define XB_TOP      3328
#define XB_TOPGEN   3392
#define XCD_BAR_WORDS 3456
#define XB_SPIN_CAP (1u << 18)

__device__ __forceinline__ unsigned xb_ld(unsigned* p)              { return __hip_atomic_load(p, __ATOMIC_RELAXED, __HIP_MEMORY_SCOPE_AGENT); }
__device__ __forceinline__ unsigned xb_add(unsigned* p, unsigned v) { return __hip_atomic_fetch_add(p, v, __ATOMIC_RELAXED, __HIP_MEMORY_SCOPE_AGENT); }
__device__ __forceinline__ unsigned xb_xcc_id() { return (unsigned)__builtin_amdgcn_s_getreg((3 << 11) | 20) & 0xFu; }
#define XB_SPIN(cond, bar) do { unsigned _sp = 0; while (cond) { __builtin_amdgcn_s_sleep(1); \
    if ((++_sp & 255u) == 0u) { if (xb_ld(&(bar)[XB_TMO])) break; if (_sp > XB_SPIN_CAP) { atomicAdd(&(bar)[XB_TMO], 1u); break; } } } } while (0)

struct XcdBarrier {
    unsigned* bar; unsigned x;
    volatile LAS unsigned* st;
};

__device__ __forceinline__ XcdBarrier xcd_barrier_post(unsigned* bar, volatile LAS unsigned* st) {
    XcdBarrier b; b.bar = bar; b.x = xb_xcc_id(); b.st = st;
    if (threadIdx.x == 0) (void)xb_add(&bar[XB_XCNT(b.x)], 1u);
    return b;
}
__device__ __forceinline__ void xcd_barrier_complete(unsigned* bar, unsigned x, unsigned& nloc, unsigned& nx) {
    const unsigned G = gridDim.x * gridDim.y * gridDim.z;
    unsigned sum, cnt, mine, sp = 0u;
    for (;;) {
        sum = 0u; cnt = 0u; mine = 0u;
#pragma unroll
        for (unsigned j = 0; j < 16; ++j) { const unsigned c = xb_ld(&bar[XB_XCNT(j)]); sum += c; cnt += (c > 0u) ? 1u : 0u; mine = (j == x) ? c : mine; }
        if (sum == G) break;
        __builtin_amdgcn_s_sleep(1);
        if ((++sp & 255u) == 0u) { if (xb_ld(&bar[XB_TMO])) break; if (sp > XB_SPIN_CAP) { atomicAdd(&bar[XB_TMO], 1u); break; } }
    }
    nloc = mine > 0u ? mine : 1u; nx = cnt > 0u ? cnt : 1u;
}

__device__ __forceinline__ void xcd_barrier(const XcdBarrier& b) {
    asm volatile("s_waitcnt vmcnt(0)" ::: "memory");
    __syncthreads();
    if (threadIdx.x == 0) {
        unsigned* bar = b.bar;
        __builtin_amdgcn_s_waitcnt(0);
        unsigned nloc = b.st[0], nx = b.st[1];
        if (nloc == 0u) { xcd_barrier_complete(bar, b.x, nloc, nx); b.st[0] = nloc; b.st[1] = nx; }
        const unsigned old = xb_add(&bar[XB_XSUB(b.x)], 1u);
        const unsigned gen = old / nloc;
        if (old + 1u == (gen + 1u) * nloc) {
            __builtin_amdgcn_fence(__ATOMIC_RELEASE, "agent");
            asm volatile("s_waitcnt vmcnt(0)" ::: "memory");
            const unsigned og = xb_add(&bar[XB_TOP], 1u);
            const unsigned tg = og / nx;
            if (og + 1u == (tg + 1u) * nx) xb_add(&bar[XB_TOPGEN], 1u);
            else XB_SPIN(xb_ld(&bar[XB_TOPGEN]) == tg, bar);
            __builtin_amdgcn_fence(__ATOMIC_ACQUIRE, "agent");
            xb_add(&bar[XB_XGEN(b.x)], 1u);
            asm volatile("s_waitcnt vmcnt(0)" ::: "memory");
        } else {
            XB_SPIN(xb_ld(&bar[XB_XGEN(b.x)]) == gen, bar);
            __builtin_amdgcn_fence(__ATOMIC_ACQUIRE, "agent");
            asm volatile("s_waitcnt vmcnt(0)" ::: "memory");
        }
    }
    __syncthreads();
}


struct Args {
    const float* in[33]; float* out; unsigned char* ws; int ph_lo, ph_hi;
};
struct Frame {
    LAS unsigned char* lds; int G;
    const LAS unsigned long long* ptab; float* out; unsigned char* ws;
};
#define GAS __attribute__((address_space(1)))
__device__ __forceinline__ const float* ldptr(const LAS unsigned long long* tab, int k) { const unsigned long long v = tab[k]; const unsigned lo = __builtin_amdgcn_readfirstlane((unsigned)v), hi = __builtin_amdgcn_readfirstlane((unsigned)(v >> 32));
    return (const float*)(const GAS float*)(((unsigned long long)hi << 32) | lo); }
__device__ __forceinline__ unsigned char* fresh(unsigned char* p) { GAS unsigned char* q = (GAS unsigned char*)p; asm volatile("" : "+s"(q)); return (unsigned char*)q; }
__device__ __forceinline__ int fresh_i(int v) { asm volatile("" : "+s"(v)); return v; }
#define INP(k) ldptr(F.ptab, (k))
#define PHASE_L const int l = fresh_i(l_in); (void)l;
#define PHASE_IDS int tid_ = threadIdx.x; asm volatile("" : "+v"(tid_)); const int tid = tid_, lane = tid & 63, wave = __builtin_amdgcn_readfirstlane(tid >> 6), gtid = blockIdx.x * NTHR + tid, gw = blockIdx.x * NWAVES + wave; (void)lane; (void)wave; (void)gtid; (void)gw;
#define VM_WAIT() asm volatile("s_waitcnt vmcnt(0)" ::: "memory")
#define LDS_WAIT() asm volatile("s_waitcnt lgkmcnt(0)" ::: "memory")
constexpr int NT_ALL_SHIFT = 9;

__device__ __forceinline__ void row_info(int m, int& b, int& t, bool& samp) { samp = m >= MPR; if (samp) { b = (m - MPR) >> 6; t = (m - MPR) & 63; } else { b = m >> 11; t = m & 2047; } }

__device__ __forceinline__ void transpose_item(const float* W, int N, bf16_t* WT, int ldk, int k0, int n0, int drow0, LAS float* scr, int lane, const float* cscale = nullptr) {
    const float cs = cscale ? cscale[n0 + (lane & 31)] : 1.0f;
#pragma unroll 8
    for (int i = 0; i < 32; ++i) { const int kk = 2 * i + (lane >> 5); scr[kk * 33 + (lane & 31)] = W[(size_t)(k0 + kk) * N + n0 + (lane & 31)] * cs; }
    LDS_WAIT(); asm volatile("" ::: "memory");
    const int c = lane & 7;
#pragma unroll
    for (int j = 0; j < 4; ++j) { const int n = (lane >> 3) + 8 * j; const LAS float* s = scr + (8 * c) * 33 + n;
        u32x4 o; o.x = cvt_pk_bf16(s[0 * 33], s[1 * 33]); o.y = cvt_pk_bf16(s[2 * 33], s[3 * 33]); o.z = cvt_pk_bf16(s[4 * 33], s[5 * 33]); o.w = cvt_pk_bf16(s[6 * 33], s[7 * 33]);
        *(u32x4*)(WT + (size_t)(drow0 + n) * ldk + k0 + 8 * c) = o; }
    LDS_WAIT(); asm volatile("" ::: "memory");
}
__device__ __forceinline__ void convert_weights(Frame& F, int l_in) {
    PHASE_IDS
    unsigned char* const wsl = fresh(F.ws);
    PHASE_L
    LAS float* scr = (LAS float*)(F.lds + wave * 16384);
    const int NGW = fresh_i(F.G) * NWAVES;
    unsigned char* ws = wsl;
    constexpr int I_WIN = (DM / 64) * (ICOLS / 32), I_PW = 4 * (256 / 64) * (256 / 32), I_PP = (PWD / 64) * (DM / 32), I_WO = (DM / 64) * (DM / 32), I_FG = (DM / 64) * (FF / 32),
                  I_FD = (FF / 64) * (DM / 32), I_PL = (PLE / 64) * (DM / 32);
    constexpr int NITEMS = I_WIN + I_PW + 2 * I_PP + I_WO + 2 * I_FG + I_FD + I_WO + I_PL;
    for (int it = gw; it < NITEMS; it += NGW) {
        int r = it;
        if (r < I_WIN) { const int nblk = ICOLS / 32, kb = r / nblk, nb = r % nblk, n0 = nb * 32; transpose_item(INP(8) + (size_t)l * DM * ICOLS, ICOLS, (bf16_t*)(ws + WS_WIN), DM, kb * 64, n0, n0 < 4384 ? n0 : n0 + 224, scr, lane); continue; } r -= I_WIN;
        if (r < I_PW) { const int g = r >> 5, rr = r & 31, kb = rr >> 3, nb = rr & 7; transpose_item(INP(10) + ((size_t)l * 4 + g) * 65536, 256, (bf16_t*)(ws + WS_POOLW) + (size_t)g * 65536, 256, kb * 64, nb * 32, nb * 32, scr, lane, INP(11) + (size_t)l * PWD + g * 256); continue; } r -= I_PW;
        if (r < I_PP) { const int nblk = DM / 32, kb = r / nblk, nb = r % nblk; transpose_item(INP(22) + (size_t)l * PWD * DM, DM, (bf16_t*)(ws + WS_PPOOL), PWD, kb * 64, nb * 32, nb * 32, scr, lane); continue; } r -= I_PP;
        if (r < I_PP) { const int nblk = DM / 32, kb = r / nblk, nb = r % nblk; transpose_item(INP(23) + (size_t)l * RWD * DM, DM, (bf16_t*)(ws + WS_PRWKV), RWD, kb * 64, nb * 32, nb * 32, scr, lane); continue; } r -= I_PP;
        if (r < I_WO) { const int nblk = DM / 32, kb = r / nblk, nb = r % nblk; transpose_item(INP(24) + (size_t)l * DM * DM, DM, (bf16_t*)(ws + WS_WOUT), DM, kb * 64, nb * 32, nb * 32, scr, lane); continue; } r -= I_WO;
        if (r < I_FG) { const int nblk = FF / 32, kb = r / nblk, nb = r % nblk, n0 = nb * 32; transpose_item(INP(26) + (size_t)l * DM * FF, FF, (bf16_t*)(ws + WS_WGU), DM, kb * 64, n0, 256 * (n0 >> 7) + 64 * ((n0 & 127) >> 5), scr, lane); continue; } r -= I_FG;
        if (r < I_FG) { const int nblk = FF / 32, kb = r / nblk, nb = r % nblk, n0 = nb * 32; transpose_item(INP(27) + (size_t)l * DM * FF, FF, (bf16_t*)(ws + WS_WGU), DM, kb * 64, n0, 256 * (n0 >> 7) + 64 * ((n0 & 127) >> 5) + 32, scr, lane); continue; } r -= I_FG;
        if (r < I_FD) { const int nblk = DM / 32, kb = r / nblk, nb = r % nblk; transpose_item(INP(28) + (size_t)l * FF * DM, DM, (bf16_t*)(ws + WS_WDN), FF, kb * 64, nb * 32, nb * 32, scr, lane); continue; } r -= I_FD;
        if (r < I_WO) { const int nblk = DM / 32, kb = r / nblk, nb = r % nblk; transpose_item(INP(30) + (size_t)l * DM * DM, DM, (bf16_t*)(ws + WS_WPG), DM, kb * 64, nb * 32, nb * 32, scr, lane); continue; } r -= I_WO;
        { const int nblk = DM / 32, kb = r / nblk, nb = r % nblk; transpose_item(INP(31) + (size_t)l * PLE * DM, DM, (bf16_t*)(ws + WS_WPP), PLE, kb * 64, nb * 32, nb * 32, scr, lane); }
    }
    const int NT = fresh_i(F.G) * NTHR;
    { u32x4* z = (u32x4*)((bf16_t*)(ws + WS_WIN) + (size_t)4384 * DM); for (int i = gtid; i < 224 * DM * 2 / 16; i += NT) z[i] = (u32x4){0u, 0u, 0u, 0u}; }
    { bf16_t* LT = (bf16_t*)(ws + WS_LORA); const float* wd = INP(13) + (size_t)l * 64 * RWD; const float* wa = INP(15) + (size_t)l * 64 * RWD; const float* wg = INP(16) + (size_t)l * 160 * RWD;
      for (int i = gtid; i < 3072 * (LK / 8); i += NT) { const int n = i / (LK / 8), k0 = (i % (LK / 8)) * 8; const int kind = n >> 10, c = n & 1023; float f[8];
#pragma unroll
          for (int j = 0; j < 8; ++j) { const int k = k0 + j; float v = 0.f;
              if (kind == 0) { if (k < 64) v = wd[(size_t)k * RWD + c]; }
              else if (kind == 1) { if (k >= 64 && k < 128) v = wa[(size_t)(k - 64) * RWD + c]; }
              else { if (k >= 128 && k < 288) v = wg[(size_t)(k - 128) * RWD + c]; }
              f[j] = v; }
          *(u32x4*)(LT + (size_t)n * LK + k0) = pack8(f); } }
    { bf16_t* PB = (bf16_t*)(ws + WS_PB); const float* pp = INP(5) + (size_t)l * MPR * PLE; const float* ps = INP(6) + (size_t)l * (MT - MPR) * PLE;
      for (int i = gtid; i < MT * PLE / 8; i += NT) { const size_t e = (size_t)i * 8; const float* src = e < (size_t)MPR * PLE ? pp + e : ps + (e - (size_t)MPR * PLE);
          const f32x4 a = *(const f32x4*)src, b = *(const f32x4*)(src + 4); *(u32x4*)(PB + e) = pg8::pack_f4x2(a, b); } }
}

template <bool FROM_INPUT, bool FINAL>
__device__ __forceinline__ void norm_rows(Frame& F, const float* gain) {
    PHASE_IDS
    unsigned char* const wsl = fresh(F.ws);
    const int NGW = fresh_i(F.G) * NWAVES; float* X = F.out; bf16_t* XN = (bf16_t*)(wsl + WS_XN);
    f32x4 g[8];
#pragma unroll
    for (int j = 0; j < 8; ++j) g[j] = *(const f32x4*)(gain + 4 * lane + 256 * j);
    for (int m = gw; m < MT; m += NGW) {
        const float* src = FROM_INPUT ? (m < MPR ? INP(0) + (size_t)m * DM : INP(1) + (size_t)(m - MPR) * DM) : X + (size_t)m * DM;
        f32x4 v[8]; float s = 0.f;
#pragma unroll
        for (int j = 0; j < 8; ++j) { v[j] = *(const f32x4*)(src + 4 * lane + 256 * j); s += (v[j].x * v[j].x + v[j].y * v[j].y) + (v[j].z * v[j].z + v[j].w * v[j].w); }
        const float rstd = __builtin_amdgcn_rsqf(wave_sum(s) * (1.0f / DM) + NORM_EPS);
        if (FROM_INPUT) {
#pragma unroll
            for (int j = 0; j < 8; ++j) *(f32x4*)(X + (size_t)m * DM + 4 * lane + 256 * j) = v[j];
        }
        if (FINAL) {
#pragma unroll
            for (int j = 0; j < 8; ++j) *(f32x4*)(X + (size_t)m * DM + 4 * lane + 256 * j) = v[j] * rstd * g[j];
        } else {
#pragma unroll
            for (int j = 0; j < 8; ++j) { const f32x4 o = v[j] * rstd * g[j]; u32x2 w; w.x = cvt_pk_bf16(o.x, o.y); w.y = cvt_pk_bf16(o.z, o.w); *(u32x2*)(XN + (size_t)m * DM + 4 * lane + 256 * j) = w; }
        }
    }
}

__device__ __forceinline__ void load_z(float (&z)[8], const bf16_t* PROJ, const float* past, int m0, int t, bool samp, int c0) {
    if (t >= 0) { unpack8(*(const u32x4*)(PROJ + (size_t)(m0 + t) * ICP + c0), z); }
    else if (samp) { const float* p = past + (size_t)(15 + t) * PWD + c0; const f32x4 a = *(const f32x4*)p, b = *(const f32x4*)(p + 4); z[0] = a.x; z[1] = a.y; z[2] = a.z; z[3] = a.w; z[4] = b.x; z[5] = b.y; z[6] = b.z; z[7] = b.w; }
    else {
#pragma unroll
        for (int j = 0; j < 8; ++j) z[j] = 0.f; }
}
__device__ __forceinline__ void prep1_phase(Frame& F, int l_in) {
    PHASE_IDS
    unsigned char* const wsl = fresh(F.ws);
    PHASE_L
    const int NT = fresh_i(F.G) * NTHR; const bf16_t* PROJ = (const bf16_t*)(wsl + WS_PROJ);
    { bf16_t* D = (bf16_t*)(wsl + WS_D);
      for (int it = gtid; it < (MT / 16) * 128; it += NT) {
          const int oct = it & 127, run = it >> 7, mrow = run * 16, c0 = oct * 8, win = 2 << (c0 >> 8);
          int b, t0; bool samp; row_info(mrow, b, t0, samp);
          const int T = samp ? TS : TP, mseq = mrow - t0;
          const float* past = INP(3) + ((size_t)l * 8 + b) * 15 * PWD;
          float* npool = F.out + (samp ? O_POS : O_POP) + ((size_t)l * 8 + b) * 15 * PWD;
          float S[8], z[8];
#pragma unroll
          for (int j = 0; j < 8; ++j) S[j] = 0.f;
          for (int j = 1; j < win; ++j) { load_z(z, PROJ, past, mseq, t0 - j, samp, c0);
#pragma unroll
              for (int q = 0; q < 8; ++q) S[q] += z[q]; }
          for (int i = 0; i < 16; ++i) { const int t = t0 + i; float cur[8]; load_z(cur, PROJ, past, mseq, t, samp, c0);
              const int cnt = samp ? win : (t + 1 < win ? t + 1 : win); const float inv = 1.0f / (float)cnt; float d[8];
#pragma unroll
              for (int q = 0; q < 8; ++q) { S[q] += cur[q]; d[q] = S[q] * inv - cur[q]; }
              *(u32x4*)(D + (size_t)(mseq + t) * PWD + c0) = pack8(d);
              if (t >= T - 15) { float* o = npool + (size_t)(t - (T - 15)) * PWD + c0; *(f32x4*)o = (f32x4){cur[0], cur[1], cur[2], cur[3]}; *(f32x4*)(o + 4) = (f32x4){cur[4], cur[5], cur[6], cur[7]}; }
              load_z(z, PROJ, past, mseq, t - win + 1, samp, c0);
#pragma unroll
              for (int q = 0; q < 8; ++q) S[q] -= z[q]; }
      } }
    { bf16_t* LIN = (bf16_t*)(wsl + WS_LIN); const float* mu = INP(9) + (size_t)l * RPJ + 3072;
      for (int it = gtid; it < MT * (LK / 8); it += NT) {
          const int m = it / (LK / 8), c0 = (it % (LK / 8)) * 8; float o[8];
          if (c0 >= 288) {
#pragma unroll
              for (int j = 0; j < 8; ++j) o[j] = 0.f;
          } else {
              int b, t; bool samp; row_info(m, b, t, samp);
              float cur[8], prv[8]; unpack8(*(const u32x4*)(PROJ + (size_t)m * ICP + 4096 + c0), cur);
              if (t > 0) unpack8(*(const u32x4*)(PROJ + (size_t)(m - 1) * ICP + 4096 + c0), prv);
              else if (samp) { const float* p = INP(2) + ((size_t)l * 8 + b) * RPJ + 3072 + c0;
#pragma unroll
                  for (int j = 0; j < 8; ++j) prv[j] = p[j]; }
              else {
#pragma unroll
                  for (int j = 0; j < 8; ++j) prv[j] = 0.f; }
#pragma unroll
              for (int j = 0; j < 8; ++j) { const float xm = cur[j] + (prv[j] - cur[j]) * mu[c0 + j]; o[j] = c0 < 64 ? tanhf_(xm) : (c0 < 128 ? xm : sigmoidf_(xm)); }
          }
          *(u32x4*)(LIN + (size_t)m * LK + c0) = pack8(o);
      } }
    for (int it = gtid; it < 16 * RPJ; it += NT) { const int s = it / RPJ, c = it % RPJ; const int mlast = s < 8 ? s * TP + TP - 1 : MPR + (s - 8) * TS + TS - 1;
        F.out[(s < 8 ? O_SHP : O_SHS) + ((size_t)l * 8 + (s & 7)) * RPJ + c] = __uint_as_float((unsigned)PROJ[(size_t)mlast * ICP + 1024 + c] << 16); }
}

constexpr int SC_TC = 32, SC_STEP = 6 * 64;
__device__ __forceinline__ float sum16(float x) { x += dpp_f<0xB1>(x); x += dpp_f<0x4E>(x); x += dpp_f<0x141>(x); x += dpp_f<0x140>(x); return x; }
__device__ __forceinline__ void unpack4(const u32x2 w, float (&f)[4]) { f[0] = bf_lo(w.x); f[1] = bf_hi(w.x); f[2] = bf_lo(w.y); f[3] = bf_hi(w.y); }
__device__ __forceinline__ void scan_phase(Frame& F, int l_in) {
    PHASE_IDS
    unsigned char* const wsl = fresh(F.ws);
    PHASE_L
    LAS float* buf = (LAS float*)F.lds;
    LAS float* ybuf = (LAS float*)(F.lds + 2 * SC_TC * SC_STEP * 4);
    const float* DEC = (const float*)(wsl + WS_DEC); const bf16_t* PROJ = (const bf16_t*)(wsl + WS_PROJ); const bf16_t* AA = (const bf16_t*)(wsl + WS_AA);
    float* Y = (float*)(wsl + WS_Y); float* BS = (float*)(wsl + WS_BS);
    const int ks = lane & 15, k0 = ks * 4, rl = wave * 4 + (lane >> 4);
    const int st = tid >> 4, q4 = (tid & 15) * 4;
    for (int u = blockIdx.x; u < 512; u += fresh_i(F.G)) {
        const bool samp = u >= 256; const int half = u & 1, h = (u >> 1) & 15, b = (u >> 5) & 7;
        const int T = samp ? TS : TP, m0 = samp ? MPR + b * TS : b * TP, ch = h * 64 + q4, row = half * 32 + rl;
        const float* mu = INP(9) + (size_t)l * RPJ;
        const f32x4 mur = *(const f32x4*)(mu + ch), muk = *(const f32x4*)(mu + 1024 + ch), muv = *(const f32x4*)(mu + 2048 + ch);
        const f32x4 ckk = *(const f32x4*)(INP(17) + (size_t)l * RWD + ch), cka = *(const f32x4*)(INP(18) + (size_t)l * RWD + ch), crk = *(const f32x4*)(INP(19) + (size_t)l * RWD + ch);
        const float* shp = INP(2) + ((size_t)l * 8 + b) * RPJ + ch;
        f32x2 S01, S23;
        if (samp) { const f32x4 s0 = *(const f32x4*)(INP(4) + ((((size_t)l * 8 + b) * 16 + h) * 64 + row) * 64 + k0); S01 = (f32x2){s0.x, s0.y}; S23 = (f32x2){s0.z, s0.w}; }
        else { S01 = (f32x2){0.f, 0.f}; S23 = (f32x2){0.f, 0.f}; }
        const int nch = T / SC_TC;
        u32x2 cr, ck, cv, pr, pk, pv, ca; f32x4 cd;
#define SC_LOAD(c) do { const size_t mm = (size_t)(m0 + (c) * SC_TC + st); const bf16_t* pc = PROJ + mm * ICP + 1024 + ch; \
        cr = *(const u32x2*)pc; ck = *(const u32x2*)(pc + 1024); cv = *(const u32x2*)(pc + 2048); \
        if ((c) * SC_TC + st > 0) { pr = *(const u32x2*)(pc - ICP); pk = *(const u32x2*)(pc - ICP + 1024); pv = *(const u32x2*)(pc - ICP + 2048); } \
        else { pr = (u32x2){0u, 0u}; pk = pr; pv = pr; } \
        ca = *(const u32x2*)(AA + mm * RWD + ch); cd = *(const f32x4*)(DEC + mm * RWD + ch); } while (0)
#define SC_STORE(c, bufp) do { float xr[4], xk[4], xv[4], yr[4], yk[4], yv[4], av[4]; unpack4(cr, xr); unpack4(ck, xk); unpack4(cv, xv); unpack4(pr, yr); unpack4(pk, yk); unpack4(pv, yv); unpack4(ca, av); \
        if (samp && (c) * SC_TC + st == 0) { const f32x4 t0 = *(const f32x4*)shp, t1 = *(const f32x4*)(shp + 1024), t2 = *(const f32x4*)(shp + 2048); \
            _Pragma("unroll") for (int j = 0; j < 4; ++j) { yr[j] = t0[j]; yk[j] = t1[j]; yv[j] = t2[j]; } } \
        f32x4 vr, vk, vv4, vq, vb, vh; float ss = 0.f, bsum = 0.f; \
        _Pragma("unroll") for (int j = 0; j < 4; ++j) { vr[j] = xr[j] + (yr[j] - xr[j]) * mur[j]; vk[j] = xk[j] + (yk[j] - xk[j]) * muk[j]; vv4[j] = xv[j] + (yv[j] - xv[j]) * muv[j]; \
            vq[j] = vk[j] * ckk[j]; ss += vq[j] * vq[j]; vh[j] = vk[j] * (1.0f + (av[j] - 1.0f) * cka[j]); bsum += vr[j] * vh[j] * crk[j]; } \
        ss = sum16(ss); bsum = sum16(bsum); const float inv = 1.0f / fmaxf(sqrtf(ss), 1e-12f); \
        _Pragma("unroll") for (int j = 0; j < 4; ++j) { vq[j] *= inv; vb[j] = vq[j] * av[j]; } \
        LAS float* d = (bufp) + st * SC_STEP + q4; *(LAS f32x4*)d = cd; *(LAS f32x4*)(d + 64) = vq; *(LAS f32x4*)(d + 128) = vb; *(LAS f32x4*)(d + 192) = vh; *(LAS f32x4*)(d + 256) = vr; *(LAS f32x4*)(d + 320) = vv4; \
        if (half == 0 && q4 == 0) BS[(size_t)(m0 + (c) * SC_TC + st) * 16 + h] = bsum; } while (0)
        __syncthreads();
        SC_LOAD(0); SC_STORE(0, buf);
        __syncthreads();
        for (int c = 0; c < nch; ++c) {
            LAS float* cur = buf + (c & 1) * SC_TC * SC_STEP; LAS float* oth = buf + ((c + 1) & 1) * SC_TC * SC_STEP; LAS float* yb = ybuf + (c & 1) * SC_TC * 32;
            const bool more = c + 1 < nch;
            if (more) SC_LOAD(c + 1);
            if (c > 0) { const f32x2 yo = *(const LAS f32x2*)(ybuf + ((c - 1) & 1) * SC_TC * 32 + st * 32 + (tid & 15) * 2);
                *(f32x2*)(Y + (size_t)(m0 + (c - 1) * SC_TC + st) * RWD + h * 64 + half * 32 + (tid & 15) * 2) = yo; }
#define SC_STEP_BODY(s, DO_Y) do { const LAS float* p = cur + (s) * SC_STEP; \
                const f32x4 w4 = *(const LAS f32x4*)(p + k0), q4v = *(const LAS f32x4*)(p + 64 + k0), b4 = *(const LAS f32x4*)(p + 128 + k0), h4 = *(const LAS f32x4*)(p + 192 + k0), r4 = *(const LAS f32x4*)(p + 256 + k0); \
                const float vv = p[320 + row]; const f32x2 vv2 = (f32x2){vv, vv}; \
                f32x2 d2 = S01 * (f32x2){q4v.x, q4v.y}; d2 = S23 * (f32x2){q4v.z, q4v.w} + d2; float sa = d2.x + d2.y; \
                float yv = 0.f; if (DO_Y) { f32x2 y2 = S01 * (f32x2){rp.x, rp.y}; y2 = S23 * (f32x2){rp.z, rp.w} + y2; yv = y2.x + y2.y; } \
                const f32x2 t01 = S01 * (f32x2){w4.x, w4.y} + vv2 * (f32x2){h4.x, h4.y}, t23 = S23 * (f32x2){w4.z, w4.w} + vv2 * (f32x2){h4.z, h4.w}; \
                sa += dpp_f<0xB1>(sa); if (DO_Y) yv += dpp_f<0xB1>(yv); sa += dpp_f<0x4E>(sa); if (DO_Y) yv += dpp_f<0x4E>(yv); \
                sa += dpp_f<0x141>(sa); if (DO_Y) yv += dpp_f<0x141>(yv); sa += dpp_f<0x140>(sa); if (DO_Y) yv += dpp_f<0x140>(yv); \
                const f32x2 sa2 = (f32x2){-sa, -sa}; \
                S01 = sa2 * (f32x2){b4.x, b4.y} + t01; S23 = sa2 * (f32x2){b4.z, b4.w} + t23; \
                if (DO_Y) yb[((s) - 1) * 32 + rl] = yv; rp = r4; } while (0)
            f32x4 rp;
            SC_STEP_BODY(0, false);
#pragma unroll 4
            for (int s = 1; s < SC_TC; ++s) SC_STEP_BODY(s, true);
            { f32x2 y2 = S01 * (f32x2){rp.x, rp.y}; y2 = S23 * (f32x2){rp.z, rp.w} + y2; yb[(SC_TC - 1) * 32 + rl] = sum16(y2.x + y2.y); }
#undef SC_STEP_BODY
            if (more) SC_STORE(c + 1, oth);
            __syncthreads();
        }
        { const f32x2 yo = *(const LAS f32x2*)(ybuf + ((nch - 1) & 1) * SC_TC * 32 + st * 32 + (tid & 15) * 2);
          *(f32x2*)(Y + (size_t)(m0 + (nch - 1) * SC_TC + st) * RWD + h * 64 + half * 32 + (tid & 15) * 2) = yo; }
#undef SC_LOAD
#undef SC_STORE
        float* so = F.out + (samp ? O_WKS : O_WKP) + ((((size_t)l * 8 + b) * 16 + h) * 64 + row) * 64 + k0;
        *(f32x4*)so = (f32x4){S01.x, S01.y, S23.x, S23.y};
    }
}

__device__ __forceinline__ void post_phase(Frame& F, int l_in) {
    PHASE_IDS
    unsigned char* const wsl = fresh(F.ws);
    PHASE_L
    const int NT = fresh_i(F.G) * NTHR; const float* Y = (const float*)(wsl + WS_Y); const float* BS = (const float*)(wsl + WS_BS);
    const bf16_t* PROJ = (const bf16_t*)(wsl + WS_PROJ); const bf16_t* GG = (const bf16_t*)(wsl + WS_GG);
    bf16_t* YB = (bf16_t*)(wsl + WS_YB);
    const float* muv = INP(9) + (size_t)l * RPJ + 2048; const float* gng = INP(20) + (size_t)l * RWD; const float* gnb = INP(21) + (size_t)l * RWD;
    for (int it = gtid; it < MT * 128; it += NT) {
        const int m = it >> 7, c0 = (it & 127) * 8; const size_t o = (size_t)m * RWD + c0;
        int b, t; bool samp; row_info(m, b, t, samp);
        const f32x4 y0 = *(const f32x4*)(Y + o), y1 = *(const f32x4*)(Y + o + 4);
        float y[8] = {y0.x, y0.y, y0.z, y0.w, y1.x, y1.y, y1.z, y1.w};
        float cur[8], prv[8], g[8]; unpack8(*(const u32x4*)(PROJ + (size_t)m * ICP + 3072 + c0), cur); unpack8(*(const u32x4*)(GG + o), g);
        if (t > 0) unpack8(*(const u32x4*)(PROJ + (size_t)(m - 1) * ICP + 3072 + c0), prv);
        else if (samp) { const float* p = INP(2) + ((size_t)l * 8 + b) * RPJ + 2048 + c0;
#pragma unroll
            for (int j = 0; j < 8; ++j) prv[j] = p[j]; }
        else {
#pragma unroll
            for (int j = 0; j < 8; ++j) prv[j] = 0.f; }
        const float bs = BS[(size_t)m * 16 + (c0 >> 6)];
        float s = 0.f;
#pragma unroll
        for (int j = 0; j < 8; ++j) s += y[j];
        s = sum8(s);
        const float mean = s * (1.0f / 64.0f); float q = 0.f;
#pragma unroll
        for (int j = 0; j < 8; ++j) { const float d = y[j] - mean; q += d * d; }
        q = sum8(q);
        const float rstd = __builtin_amdgcn_rsqf(q * (1.0f / 64.0f) + GN_EPS);
        float outv[8];
#pragma unroll
        for (int j = 0; j < 8; ++j) { const float v = cur[j] + (prv[j] - cur[j]) * muv[c0 + j]; outv[j] = ((y[j] - mean) * rstd * gng[c0 + j] + gnb[c0 + j] + bs * v) * g[j]; }
        *(u32x4*)(YB + o) = pack8(outv);
    }
}

constexpr int PH_PER_LAYER = 13, N_PHASES = NL * PH_PER_LAYER + 1;
#ifndef MK_REP
#define MK_REP 0
#endif
__global__ void __launch_bounds__(NTHR, 2) mega_fwd(Args args) {
    extern __shared__ __attribute__((aligned(16))) unsigned char lds[];
    Frame F;
    F.lds = (LAS unsigned char*)lds;
    F.G = gridDim.x;
    F.out = args.out; F.ws = args.ws;
    { LAS unsigned long long* pt = (LAS unsigned long long*)(F.lds + LDSCTL_OFF + 1024); F.ptab = pt;
      if (threadIdx.x == 0) {
#define PT_(k) pt[k] = (unsigned long long)args.in[k];
          PT_(0) PT_(1) PT_(2) PT_(3) PT_(4) PT_(5) PT_(6) PT_(7) PT_(8) PT_(9) PT_(10) PT_(11) PT_(12) PT_(13) PT_(14) PT_(15) PT_(16) PT_(17) PT_(18) PT_(19) PT_(20) PT_(21) PT_(22) PT_(23) PT_(24) PT_(25) PT_(26) PT_(27) PT_(28) PT_(29) PT_(30) PT_(31) PT_(32)
#undef PT_
      } }
    volatile LAS unsigned* MISC = (volatile LAS unsigned*)(F.lds + LDSCTL_OFF);
    for (int u = threadIdx.x; u < 256; u += NTHR) ((LAS unsigned*)(F.lds + LDSCTL_OFF))[u] = 0u;
    __syncthreads();
    XcdBarrier bar; bar.bar = (unsigned*)(args.ws + WS_CTL) + CW_BAR; bar.x = 0; bar.st = nullptr;
    if (!MK_PER_PHASE) bar = xcd_barrier_post((unsigned*)(args.ws + WS_CTL) + CW_BAR, MISC + 8);
    const int lo = args.ph_lo, hi = args.ph_hi;
#define IN(k) (lo <= (k) && (k) < hi)
#define REP(k) (1 + ((MK_REP >> (k)) & 1))
#define PHASE(k, ...) do { if (IN(pb + (k))) { for (int rep = 0; rep < REP(k); ++rep) { if (rep) xcd_barrier(bar); __VA_ARGS__ } if (IN(pb + (k) + 1)) xcd_barrier(bar); } } while (0)
#define WSP(off) (fresh(F.ws) + (off))
#define UNPAREN(...) __VA_ARGS__
#define GEMM(EPI, EINIT, Aoff, Boff, N_, K_, lda_, ldb_, apn_) do { pg8::Gemm g{(const bf16_t*)WSP(Aoff), (const bf16_t*)WSP(Boff), MT, (N_), (K_), (lda_), (ldb_), (apn_)}; pg8::StaticOrder S; S.init(MT, (N_), fresh_i(F.G), fresh_i(cid)); \
        pg8::EPI E{UNPAREN EINIT}; pg8::gemm_phase<pg8::EPI, pg8::StaticOrder, true>(ring, g, S, E); } while (0)
    LAS unsigned char* ring = F.lds;
    const int cid = (int)blockIdx.x;
    for (int l = 0; l < NL; ++l) {
        const int pb = l * PH_PER_LAYER;
        PHASE(0, { convert_weights(F, l); if (l == 0) norm_rows<true, false>(F, INP(7) + (size_t)fresh_i(l) * DM); else norm_rows<false, false>(F, INP(7) + (size_t)fresh_i(l) * DM); });
        PHASE(1, { GEMM(EpiProj, ((bf16_t*)WSP(WS_PROJ)), WS_XN, WS_WIN, ICP, DM, DM, DM, 0); });
        PHASE(2, { prep1_phase(F, l); });
        PHASE(3, { GEMM(EpiBf16, ((bf16_t*)WSP(WS_YA), PWD), WS_D, WS_POOLW, PWD, 256, PWD, 256, 256);
                   GEMM(EpiLora, ((float*)WSP(WS_DEC), (bf16_t*)WSP(WS_AA), (bf16_t*)WSP(WS_GG), INP(12) + (size_t)fresh_i(l) * RWD, INP(14) + (size_t)fresh_i(l) * RWD), WS_LIN, WS_LORA, 3072, LK, LK, LK, 0); });
        PHASE(4, { scan_phase(F, l); });
        PHASE(5, { post_phase(F, l); });
        PHASE(6, { GEMM(EpiGate1, ((bf16_t*)WSP(WS_TMP), (const bf16_t*)WSP(WS_PROJ), PC_GP), WS_YA, WS_PPOOL, DM, PWD, PWD, PWD, 0);
                   GEMM(EpiGate2, ((const bf16_t*)WSP(WS_TMP), (const bf16_t*)WSP(WS_PROJ), PC_GR, (bf16_t*)WSP(WS_MRG)), WS_YB, WS_PRWKV, DM, RWD, RWD, RWD, 0); });
        PHASE(7, { GEMM(EpiResid, (F.out), WS_MRG, WS_WOUT, DM, DM, DM, DM, 0); });
        PHASE(8, { norm_rows<false, false>(F, INP(25) + (size_t)fresh_i(l) * DM); });
        PHASE(9, { GEMM(EpiSwiglu, ((bf16_t*)WSP(WS_HID)), WS_XN, WS_WGU, 2 * FF, DM, DM, DM, 0);
                   GEMM(EpiBf16, ((bf16_t*)WSP(WS_PP), DM), WS_PB, WS_WPP, DM, PLE, PLE, PLE, 0); });
        PHASE(10, { GEMM(EpiResid, (F.out), WS_HID, WS_WDN, DM, FF, FF, FF, 0); });
        PHASE(11, { norm_rows<false, false>(F, INP(29) + (size_t)fresh_i(l) * DM); });
        PHASE(12, { GEMM(EpiPle, (F.out, (const bf16_t*)WSP(WS_PP)), WS_XN, WS_WPG, DM, DM, DM, DM, 0); });
    }
    if (IN(NL * PH_PER_LAYER)) norm_rows<false, true>(F, INP(32));
#undef IN
#undef REP
#undef PHASE
#undef WSP
#undef GEMM
#undef UNPAREN
}

extern "C" void kernel_launch(void* const* d_in, const int* in_sizes, int n_in, void* d_out, int out_size, void* d_ws, size_t ws_size, hipStream_t stream) {
    static int grid = 0;
    if (grid == 0) {
        if (n_in != 33 || in_sizes[0] != MPR * DM || out_size != (int)O_END || ws_size < WS_END) {
            fprintf(stderr, "kernel_launch: unexpected shapes: n_in %d in0 %d out %d ws %zu (need %zu); nothing launched\n", n_in, n_in > 0 ? in_sizes[0] : -1, out_size, ws_size, (size_t)WS_END); grid = -1; return; }
        int dev = 0, cus = 0, per_cu = 0;
        if (hipGetDevice(&dev) != hipSuccess || hipDeviceGetAttribute(&cus, hipDeviceAttributeMultiprocessorCount, dev) != hipSuccess) { grid = -1; return; }
        if (hipFuncSetAttribute((const void*)mega_fwd, hipFuncAttributeMaxDynamicSharedMemorySize, LDS_BYTES) != hipSuccess) { fprintf(stderr, "kernel_launch: hipFuncSetAttribute failed\n"); grid = -1; return; }
        if (hipOccupancyMaxActiveBlocksPerMultiprocessor(&per_cu, (const void*)mega_fwd, NTHR, LDS_BYTES) != hipSuccess || per_cu < 1) { fprintf(stderr, "kernel_launch: occupancy query says %d\n", per_cu); (void)hipGetLastError(); grid = -1; return; }
        grid = cus;
    }
    if (grid < 0) return;
    (void)hipMemsetAsync((char*)d_ws + WS_CTL, 0, CTL_ZERO_BYTES, stream);
    Args a; memset(&a, 0, sizeof(a));
    for (int i = 0; i < 33; ++i) a.in[i] = (const float*)d_in[i];
    a.out = (float*)d_out; a.ws = (unsigned char*)d_ws;
#if MK_PER_PHASE
    for (int p = 0; p < N_PHASES; ++p) { a.ph_lo = p; a.ph_hi = p + 1; hipLaunchKernelGGL(mega_fwd, dim3(grid), dim3(NTHR), LDS_BYTES, stream, a); }
#else
    a.ph_lo = 0; a.ph_hi = N_PHASES; hipLaunchKernelGGL(mega_fwd, dim3(grid), dim3(NTHR), LDS_BYTES, stream, a);
#endif
}
```

```cpp
#include <hip/hip_runtime.h>
#include <cstdio>
#include <cstdint>
#include <cstring>

#ifndef MK_PER_PHASE
#define MK_PER_PHASE 0
#endif

#define LAS __attribute__((address_space(3)))
typedef unsigned short bf16_t;
typedef short bf16x8 __attribute__((ext_vector_type(8)));
typedef float f32x4 __attribute__((ext_vector_type(4)));
typedef float f32x2 __attribute__((ext_vector_type(2)));
typedef unsigned u32x4 __attribute__((ext_vector_type(4)));
typedef unsigned u32x2 __attribute__((ext_vector_type(2)));

constexpr int DM = 2048, NL = 4, MT = 16896, MPR = 16384, TP = 2048, TS = 64;
constexpr int PWD = 1024, RWD = 1024, RPJ = 3360, ICOLS = 8480, ICP = 8704, FF = 5632, PLE = 256, LK = 384;
constexpr int PC_GP = 4608, PC_GR = 6656;
constexpr float NORM_EPS = 1e-6f, GN_EPS = 64e-5f;
constexpr size_t O_YS = 33554432, O_SHP = 34603008, O_POP = 34710528, O_WKP = 35202048, O_SHS = 37299200, O_POS = 37406720, O_WKS = 37898240, O_END = 39995392;

__device__ __forceinline__ unsigned cvt_pk_bf16(float lo, float hi) { unsigned r; asm volatile("v_cvt_pk_bf16_f32 %0, %1, %2" : "=v"(r) : "v"(lo), "v"(hi)); return r; }
__device__ __forceinline__ float bf_lo(unsigned u) { return __uint_as_float(u << 16); }
__device__ __forceinline__ float bf_hi(unsigned u) { return __uint_as_float(u & 0xffff0000u); }
__device__ __forceinline__ void unpack8(const u32x4 w, float (&f)[8]) { f[0] = bf_lo(w.x); f[1] = bf_hi(w.x); f[2] = bf_lo(w.y); f[3] = bf_hi(w.y); f[4] = bf_lo(w.z); f[5] = bf_hi(w.z); f[6] = bf_lo(w.w); f[7] = bf_hi(w.w); }
__device__ __forceinline__ u32x4 pack8(const float (&f)[8]) { u32x4 w; w.x = cvt_pk_bf16(f[0], f[1]); w.y = cvt_pk_bf16(f[2], f[3]); w.z = cvt_pk_bf16(f[4], f[5]); w.w = cvt_pk_bf16(f[6], f[7]); return w; }
__device__ __forceinline__ float sigmoidf_(float x) { return __builtin_amdgcn_rcpf(1.0f + __expf(-x)); }
__device__ __forceinline__ f32x4 sigmoid4(f32x4 v) { f32x4 o; o.x = sigmoidf_(v.x); o.y = sigmoidf_(v.y); o.z = sigmoidf_(v.z); o.w = sigmoidf_(v.w); return o; }
__device__ __forceinline__ float tanhf_(float x) { const float e = __expf(2.0f * x); return 1.0f - 2.0f * __builtin_amdgcn_rcpf(e + 1.0f); }
template <int CTRL> __device__ __forceinline__ float dpp_f(float x) { return __uint_as_float((unsigned)__builtin_amdgcn_update_dpp(0, (int)__float_as_uint(x), CTRL, 0xF, 0xF, true)); }
__device__ __forceinline__ float sum8(float x) { x += dpp_f<0xB1>(x); x += dpp_f<0x4E>(x); x += dpp_f<0x141>(x); return x; }
__device__ __forceinline__ float wave_sum(float x) {
    x += dpp_f<0xB1>(x); x += dpp_f<0x4E>(x); x += dpp_f<0x141>(x); x += dpp_f<0x140>(x);
    x += __uint_as_float((unsigned)__builtin_amdgcn_ds_swizzle((int)__float_as_uint(x), 0x401F));
    return __uint_as_float((unsigned)__builtin_amdgcn_readlane((int)__float_as_uint(x), 0)) + __uint_as_float((unsigned)__builtin_amdgcn_readlane((int)__float_as_uint(x), 32));
}

namespace pg8 {
constexpr int BM = 256, BK = 64, HALF = 128, HTB = HALF * BK * 2  , STAGE_BYTES = 8 * HTB, NXCD = 8, WGM = 8;
__host__ __device__ __forceinline__ int lds_byte(int r, int c) { const int st = (r >> 4) * 2 + (c >> 5), rr = r & 15, cc = c & 31, ob = rr * 64 + cc * 2; return st * 1024 + (ob ^ (((ob >> 9) & 1) << 5)); }
__host__ __device__ __forceinline__ void stage_rc(int b, int& R, int& C) { const int st = b / 1024, sb = b % 1024, swz = sb ^ (((sb >> 9) & 1) << 5); R = (st >> 1) * 16 + swz / 64; C = (st & 1) * 32 + (swz % 64) / 2; }
__host__ __device__ __forceinline__ int perm32(int rho) { const int n = rho >> 4, i = rho & 15; return 8 * (i >> 2) + 4 * n + (i & 3); }

struct Unit { int pm, pn; };
struct Gemm { const bf16_t* A; const bf16_t* Bt; int M, N, K, lda, ldb, a_pn_off; };

struct StaticOrder {
    int nM, nN, nwg, G, c;
    __host__ __device__ void init(int M, int N, int G_, int c_) { nM = M / BM; nN = N / BM; nwg = nM * nN; G = G_; c = c_; }
    __host__ __device__ bool next(int i, Unit& u) const {
        const long L = (long)i * G + c; if (L >= nwg) return false;
        int wgid = (int)L; { const int q = nwg / NXCD, r = nwg % NXCD, xcd = wgid % NXCD, off = wgid / NXCD; wgid = (xcd < r ? xcd * (q + 1) : r * (q + 1) + (xcd - r) * q) + off; }
        const int nig = WGM * nN, gid = wgid / nig, fm = gid * WGM, gsz = (nM - fm) < WGM ? (nM - fm) : WGM;
        u.pm = fm + ((wgid % nig) % gsz); u.pn = (wgid % nig) / gsz; return true;
    }
    __device__ __forceinline__ void a_ready(const Unit&) const {}
    __device__ __forceinline__ void done(const Unit&) const {}
};

__device__ __forceinline__ void acc_zero(f32x4 (&acc)[2][2][4][2]) {
#pragma unroll
    for (int a = 0; a < 2; ++a)
#pragma unroll
        for (int b = 0; b < 2; ++b)
#pragma unroll
            for (int m = 0; m < 4; ++m)
#pragma unroll
                for (int n = 0; n < 2; ++n) acc[a][b][m][n] = (f32x4){0.f, 0.f, 0.f, 0.f};
}
struct RepeatOrder : StaticOrder {
    __host__ __device__ bool next(int i, Unit& u) const { if (i >= 6) return false; return StaticOrder::next(i % 3, u) || StaticOrder::next(0, u); }
};
#define EPI_ZERO_INIT __device__ __forceinline__ void init(f32x4 (&acc)[2][2][4][2], const Unit&, int, int, int, int) const { acc_zero(acc); }
template <class Epi, class Sched, bool ALIGN_EPI>
__device__ __forceinline__ void gemm_phase(LAS unsigned char* lds, const Gemm g, const Sched& S, const Epi& E) {
    int tid_ = threadIdx.x; asm volatile("" : "+v"(tid_));
    const int tid = tid_, wid = __builtin_amdgcn_readfirstlane(tid >> 6), lane = tid & 63, wr = wid >> 2, wc = wid & 3, fr = lane & 15, fq = lane >> 4;
    int K_ = g.K; asm volatile("" : "+s"(K_));
    const int K = K_, nt = K / BK;
    unsigned voffA[2], voffB[2];
#pragma unroll
    for (int i = 0; i < 2; ++i) { int R, C; stage_rc(tid * 16 + i * 8192, R, C); const int Rb = Epi::PERM ? (64 * (R >> 5) + perm32(R & 31)) : R;
        voffA[i] = (unsigned)(R * g.lda + C) * 2u; voffB[i] = (unsigned)(Rb * g.ldb + C) * 2u; }
    const size_t kstep = (size_t)(BK * 2);
    const size_t hstepA = (size_t)HALF * g.lda * 2, hstepB = (size_t)(Epi::PERM ? 32 : HALF) * g.ldb * 2;
    const unsigned ldsw = (unsigned)wid * 1024u;
    const int aoff = lds_byte(wr * 64 + fr, fq * 8), boff = lds_byte(wc * 32 + fr, fq * 8);
#define PG8_SA(b, h) (((b) * 2 + (h)) * HTB)
#define PG8_SB(b, h) ((4 + (b) * 2 + (h)) * HTB)
#define PG8_STAGE(bufoff, gbase, voff) do { _Pragma("unroll") for (int _i = 0; _i < 2; ++_i) \
        __builtin_amdgcn_global_load_lds((const unsigned*)((const char*)(gbase) + (voff)[_i]), (LAS unsigned*)(lds + (bufoff) + ldsw + _i * 8192), 16, 0, 0); } while (0)
#define PG8_LDA(dst, b, h) do { _Pragma("unroll") for (int m = 0; m < 4; ++m) _Pragma("unroll") for (int k = 0; k < 2; ++k) dst[m][k] = *(const LAS bf16x8*)(lds + PG8_SA(b, h) + aoff + m * 2048 + k * 1024); } while (0)
#define PG8_LDB(dst, b, h) do { _Pragma("unroll") for (int n = 0; n < 2; ++n) _Pragma("unroll") for (int k = 0; k < 2; ++k) dst[n][k] = *(const LAS bf16x8*)(lds + PG8_SB(b, h) + boff + n * 2048 + k * 1024); } while (0)
#define PG8_MMA(ai, bj, At, Bt) do { __builtin_amdgcn_s_setprio(1); _Pragma("unroll") for (int m = 0; m < 4; ++m) _Pragma("unroll") for (int n = 0; n < 2; ++n) _Pragma("unroll") for (int k = 0; k < 2; ++k) \
        acc[ai][bj][m][n] = __builtin_amdgcn_mfma_f32_16x16x32_bf16(Bt[n][k], At[m][k], acc[ai][bj][m][n], 0, 0, 0); __builtin_amdgcn_s_setprio(0); } while (0)
#define PG8_WAIT_V(n) asm volatile("s_waitcnt vmcnt(" #n ")" ::: "memory")
#define PG8_WAIT_L(n) asm volatile("s_waitcnt lgkmcnt(" #n ")" ::: "memory")
#define PG8_BAR __builtin_amdgcn_s_barrier()
#define PG8_SCHED __builtin_amdgcn_sched_barrier(0)
    Unit cur, nxt; int ui = 0;
    if (!S.next(0, cur)) return;
    f32x4 acc[2][2][4][2];
    E.init(acc, cur, wr, wc, fr, fq);
    bf16x8 At[4][2], B0[2][2], B1[2][2];
    const char* cA = (const char*)g.A + ((size_t)cur.pm * BM * g.lda + (size_t)cur.pn * g.a_pn_off) * 2; const char* cB = (const char*)g.Bt + (size_t)cur.pn * BM * g.ldb * 2;
    S.a_ready(cur);
    PG8_STAGE(PG8_SB(0, 0), cB, voffB); PG8_STAGE(PG8_SB(0, 1), cB + hstepB, voffB); PG8_STAGE(PG8_SA(0, 0), cA, voffA); PG8_STAGE(PG8_SA(0, 1), cA + hstepA, voffA);
    if (wr == 1) PG8_BAR;
    PG8_WAIT_V(2); PG8_BAR;
    PG8_STAGE(PG8_SB(1, 0), cB + kstep, voffB); PG8_STAGE(PG8_SA(1, 0), cA + kstep, voffA); PG8_STAGE(PG8_SB(1, 1), cB + hstepB + kstep, voffB);
    PG8_WAIT_V(6); PG8_BAR;
    for (;;) {
        const bool has_next = S.next(ui + 1, nxt);
        const char* nA = has_next ? (const char*)g.A + ((size_t)nxt.pm * BM * g.lda + (size_t)nxt.pn * g.a_pn_off) * 2 : cA; const char* nB = has_next ? (const char*)g.Bt + (size_t)nxt.pn * BM * g.ldb * 2 : cB;
#pragma unroll 1
        for (int t = 0; t < nt; t += 2) {
            const bool last = (t == nt - 2);
            const char* a1 = cA + (size_t)(t + 1) * kstep;
            const char* a2 = last ? nA : cA + (size_t)(t + 2) * kstep; const char* b2 = last ? nB : cB + (size_t)(t + 2) * kstep;
            const char* a3 = a2 + kstep; const char* b3 = b2 + kstep;
            if (last && has_next) S.a_ready(nxt);
            PG8_LDB(B0, 0, 0); PG8_LDB(B1, 0, 1); PG8_SCHED; PG8_LDA(At, 0, 0); PG8_STAGE(PG8_SA(1, 1), a1 + hstepA, voffA);
            PG8_WAIT_V(8); PG8_WAIT_L(0); PG8_BAR; PG8_MMA(0, 0, At, B0); PG8_MMA(0, 1, At, B1); PG8_BAR; PG8_SCHED;
            PG8_LDA(At, 0, 1); PG8_STAGE(PG8_SB(0, 0), b2, voffB); PG8_STAGE(PG8_SB(0, 1), b2 + hstepB, voffB); PG8_STAGE(PG8_SA(0, 0), a2, voffA);
            PG8_WAIT_V(8); PG8_WAIT_L(0); PG8_BAR; PG8_MMA(1, 0, At, B0); PG8_MMA(1, 1, At, B1); PG8_BAR; PG8_SCHED;
            PG8_LDB(B0, 1, 0); PG8_LDB(B1, 1, 1); PG8_SCHED; PG8_LDA(At, 1, 0); PG8_STAGE(PG8_SA(0, 1), a2 + hstepA, voffA);
            PG8_WAIT_V(8); PG8_WAIT_L(0); PG8_BAR; PG8_MMA(0, 0, At, B0); PG8_MMA(0, 1, At, B1); PG8_BAR; PG8_SCHED;
            PG8_LDA(At, 1, 1); PG8_STAGE(PG8_SB(1, 0), b3, voffB); PG8_STAGE(PG8_SB(1, 1), b3 + hstepB, voffB); PG8_STAGE(PG8_SA(1, 0), a3, voffA);
            PG8_WAIT_V(8); PG8_WAIT_L(0); PG8_BAR; PG8_MMA(1, 0, At, B0); PG8_MMA(1, 1, At, B1); PG8_BAR; PG8_SCHED;
        }
        if constexpr (ALIGN_EPI) { if (wr == 0) PG8_BAR; }
        E(acc, cur, wr, wc, fr, fq); S.done(cur);
        if (!has_next) break;
        E.init(acc, nxt, wr, wc, fr, fq);
        cur = nxt; cA = nA; cB = nB; ++ui;
        if constexpr (ALIGN_EPI) { if (wr == 1) PG8_BAR; }
    }
    PG8_WAIT_V(0);
    if constexpr (!ALIGN_EPI) { if (wr == 0) PG8_BAR; }
    PG8_BAR;
#undef PG8_SA
#undef PG8_SB
#undef PG8_STAGE
#undef PG8_LDA
#undef PG8_LDB
#undef PG8_MMA
#undef PG8_WAIT_V
#undef PG8_WAIT_L
#undef PG8_BAR
#undef PG8_SCHED
}

#define EPI_ROW0 (u.pm * BM + wr * 64 + fr)
#define EPI_FOR_AI_M _Pragma("unroll") for (int ai = 0; ai < 2; ++ai) _Pragma("unroll") for (int m = 0; m < 4; ++m)
__device__ __forceinline__ u32x4 pack_f4x2(f32x4 v0, f32x4 v1) { u32x4 w; w.x = cvt_pk_bf16(v0[0], v0[1]); w.y = cvt_pk_bf16(v0[2], v0[3]); w.z = cvt_pk_bf16(v1[0], v1[1]); w.w = cvt_pk_bf16(v1[2], v1[3]); return w; }
__device__ __forceinline__ void unpack_f4x2(u32x4 w, f32x4& v0, f32x4& v1) { v0[0] = bf_lo(w.x); v0[1] = bf_hi(w.x); v0[2] = bf_lo(w.y); v0[3] = bf_hi(w.y); v1[0] = bf_lo(w.z); v1[1] = bf_hi(w.z); v1[2] = bf_lo(w.w); v1[3] = bf_hi(w.w); }
__device__ __forceinline__ unsigned ror8(unsigned x) { return (unsigned)__builtin_amdgcn_update_dpp(0, (int)x, 0x128, 0xF, 0xF, true); }
__device__ __forceinline__ void st_pair(char* grp, size_t pitch, int fr, int fq, u32x4 vA, u32x4 vB) {
    const bool lo = fr < 8;
    u32x4 snd = lo ? vB : vA, rcv; rcv.x = ror8(snd.x); rcv.y = ror8(snd.y); rcv.z = ror8(snd.z); rcv.w = ror8(snd.w);
    char* p = grp + (size_t)(fr & 7) * pitch + (lo ? 0 : 64) + fq * 16;
    *(u32x4*)p = lo ? vA : rcv;
    *(u32x4*)(p + 8 * pitch) = lo ? rcv : vB;
}
__device__ __forceinline__ u32x4 as_u4(f32x4 v) { return __builtin_bit_cast(u32x4, v); }

struct EpiNull { static constexpr bool PERM = true; EPI_ZERO_INIT __device__ __forceinline__ void operator()(const f32x4 (&acc)[2][2][4][2], const Unit& u, int wr, int wc, int fr, int fq) const {
#pragma unroll
    for (int a = 0; a < 2; ++a)
#pragma unroll
        for (int b = 0; b < 2; ++b)
#pragma unroll
            for (int m = 0; m < 4; ++m)
#pragma unroll
                for (int n = 0; n < 2; ++n) asm volatile("" :: "v"(acc[a][b][m][n]));
} };
struct EpiProj { static constexpr bool PERM = true; EPI_ZERO_INIT
    bf16_t* O;
    __device__ __forceinline__ void operator()(const f32x4 (&acc)[2][2][4][2], const Unit& u, int wr, int wc, int fr, int fq) const {
        const bool sg = u.pn >= 18;
        EPI_FOR_AI_M { char* grp = (char*)(O + (size_t)(u.pm * BM + ai * HALF + wr * 64 + m * 16) * ICP + u.pn * BM + 64 * wc);
            f32x4 a0 = acc[ai][0][m][0], a1 = acc[ai][0][m][1], b0 = acc[ai][1][m][0], b1 = acc[ai][1][m][1];
            if (sg) { a0 = sigmoid4(a0); a1 = sigmoid4(a1); b0 = sigmoid4(b0); b1 = sigmoid4(b1); }
            st_pair(grp, (size_t)ICP * 2, fr, fq, pack_f4x2(a0, a1), pack_f4x2(b0, b1)); }
    }
};
struct EpiBf16 { static constexpr bool PERM = true; EPI_ZERO_INIT
    bf16_t* O; int ldc;
    __device__ __forceinline__ void operator()(const f32x4 (&acc)[2][2][4][2], const Unit& u, int wr, int wc, int fr, int fq) const {
        EPI_FOR_AI_M { char* grp = (char*)(O + (size_t)(u.pm * BM + ai * HALF + wr * 64 + m * 16) * ldc + u.pn * BM + 64 * wc);
            st_pair(grp, (size_t)ldc * 2, fr, fq, pack_f4x2(acc[ai][0][m][0], acc[ai][0][m][1]), pack_f4x2(acc[ai][1][m][0], acc[ai][1][m][1])); }
    }
};
struct EpiLora { static constexpr bool PERM = true; EPI_ZERO_INIT
    float* DEC; bf16_t* AA; bf16_t* GG; const float* w0; const float* a0;
    __device__ __forceinline__ void operator()(const f32x4 (&acc)[2][2][4][2], const Unit& u, int wr, int wc, int fr, int fq) const {
        const int row0 = EPI_ROW0, kind = u.pn >> 2, ct = (u.pn & 3) * BM + 64 * wc, col0 = ct + 8 * fq;
        if (kind == 0) {
            EPI_FOR_AI_M { float* rowp = DEC + (size_t)(row0 + ai * HALF + m * 16) * RWD + col0;
#pragma unroll
                for (int bj = 0; bj < 2; ++bj)
#pragma unroll
                    for (int n = 0; n < 2; ++n) { const f32x4 b = *(const f32x4*)(w0 + col0 + bj * 32 + 4 * n); const f32x4 x = acc[ai][bj][m][n] + b; f32x4 o;
#pragma unroll
                        for (int j = 0; j < 4; ++j) { const float z = -x[j]; const float sp = z > 15.f ? z : __logf(1.0f + __expf(z)); const float w = -sp - 0.5f; o[j] = __expf(-__expf(w)); }
                        *(f32x4*)(rowp + bj * 32 + 4 * n) = o; } asm volatile("" ::: "memory"); }
        } else if (kind == 1) {
            const f32x4 b00 = *(const f32x4*)(a0 + col0), b01 = *(const f32x4*)(a0 + col0 + 4), b10 = *(const f32x4*)(a0 + col0 + 32), b11 = *(const f32x4*)(a0 + col0 + 36);
            EPI_FOR_AI_M { char* grp = (char*)(AA + (size_t)(u.pm * BM + ai * HALF + wr * 64 + m * 16) * RWD + ct);
                st_pair(grp, (size_t)RWD * 2, fr, fq, pack_f4x2(sigmoid4(acc[ai][0][m][0] + b00), sigmoid4(acc[ai][0][m][1] + b01)), pack_f4x2(sigmoid4(acc[ai][1][m][0] + b10), sigmoid4(acc[ai][1][m][1] + b11))); }
        } else {
            EPI_FOR_AI_M { char* grp = (char*)(GG + (size_t)(u.pm * BM + ai * HALF + wr * 64 + m * 16) * RWD + ct);
                st_pair(grp, (size_t)RWD * 2, fr, fq, pack_f4x2(acc[ai][0][m][0], acc[ai][0][m][1]), pack_f4x2(acc[ai][1][m][0], acc[ai][1][m][1])); }
        }
    }
};
struct EpiGate1 { static constexpr bool PERM = true; EPI_ZERO_INIT
    bf16_t* TMP; const bf16_t* PROJ; int gcol0;
    __device__ __forceinline__ void operator()(const f32x4 (&acc)[2][2][4][2], const Unit& u, int wr, int wc, int fr, int fq) const {
        const int row0 = EPI_ROW0, ct = u.pn * BM + 64 * wc, col0 = ct + 8 * fq;
        EPI_FOR_AI_M { const size_t row = (size_t)(row0 + ai * HALF + m * 16);
            f32x4 g00, g01, g10, g11; unpack_f4x2(*(const u32x4*)(PROJ + row * ICP + gcol0 + col0), g00, g01); unpack_f4x2(*(const u32x4*)(PROJ + row * ICP + gcol0 + col0 + 32), g10, g11);
            st_pair((char*)(TMP + (size_t)(u.pm * BM + ai * HALF + wr * 64 + m * 16) * DM + ct), (size_t)DM * 2, fr, fq, pack_f4x2(acc[ai][0][m][0] * g00, acc[ai][0][m][1] * g01), pack_f4x2(acc[ai][1][m][0] * g10, acc[ai][1][m][1] * g11));
            if (m & 1) asm volatile("" ::: "memory"); }
    }
};
struct EpiGate2 { static constexpr bool PERM = true; EPI_ZERO_INIT
    const bf16_t* TMP; const bf16_t* PROJ; int gcol0; bf16_t* O;
    __device__ __forceinline__ void operator()(const f32x4 (&acc)[2][2][4][2], const Unit& u, int wr, int wc, int fr, int fq) const {
        const int row0 = EPI_ROW0, ct = u.pn * BM + 64 * wc, col0 = ct + 8 * fq;
        EPI_FOR_AI_M { const size_t row = (size_t)(row0 + ai * HALF + m * 16);
            f32x4 g00, g01, g10, g11, t00, t01, t10, t11; unpack_f4x2(*(const u32x4*)(PROJ + row * ICP + gcol0 + col0), g00, g01); unpack_f4x2(*(const u32x4*)(PROJ + row * ICP + gcol0 + col0 + 32), g10, g11);
            unpack_f4x2(*(const u32x4*)(TMP + row * DM + col0), t00, t01); unpack_f4x2(*(const u32x4*)(TMP + row * DM + col0 + 32), t10, t11);
            st_pair((char*)(O + (size_t)(u.pm * BM + ai * HALF + wr * 64 + m * 16) * DM + ct), (size_t)DM * 2, fr, fq, pack_f4x2(t00 + acc[ai][0][m][0] * g00, t01 + acc[ai][0][m][1] * g01), pack_f4x2(t10 + acc[ai][1][m][0] * g10, t11 + acc[ai][1][m][1] * g11));
            if (m & 1) asm volatile("" ::: "memory"); }
    }
};
struct EpiResid { static constexpr bool PERM = false;
    float* X;
    __device__ __forceinline__ void init(f32x4 (&acc)[2][2][4][2], const Unit& u, int wr, int wc, int fr, int fq) const {
        const int row0 = EPI_ROW0, col0 = u.pn * BM + wc * 32 + 4 * fq;
        EPI_FOR_AI_M { const float* rowp = X + (size_t)(row0 + ai * HALF + m * 16) * DM + col0;
#pragma unroll
            for (int bj = 0; bj < 2; ++bj) { acc[ai][bj][m][0] = *(const f32x4*)(rowp + bj * HALF); acc[ai][bj][m][1] = *(const f32x4*)(rowp + bj * HALF + 16); } }
    }
    __device__ __forceinline__ void operator()(const f32x4 (&acc)[2][2][4][2], const Unit& u, int wr, int wc, int fr, int fq) const {
        EPI_FOR_AI_M {
#pragma unroll
            for (int bj = 0; bj < 2; ++bj) st_pair((char*)(X + (size_t)(u.pm * BM + ai * HALF + wr * 64 + m * 16) * DM + u.pn * BM + bj * HALF + wc * 32), (size_t)DM * 4, fr, fq, as_u4(acc[ai][bj][m][0]), as_u4(acc[ai][bj][m][1])); }
    }
};
struct EpiSwiglu { static constexpr bool PERM = true; EPI_ZERO_INIT
    bf16_t* H;
    __device__ __forceinline__ void operator()(const f32x4 (&acc)[2][2][4][2], const Unit& u, int wr, int wc, int fr, int fq) const {
        const int row0 = EPI_ROW0, col0 = u.pn * HALF + wc * 32 + 8 * fq;
        EPI_FOR_AI_M { const f32x4 g0 = acc[ai][0][m][0], g1 = acc[ai][0][m][1], u0 = acc[ai][1][m][0], u1 = acc[ai][1][m][1];
            *(u32x4*)(H + (size_t)(row0 + ai * HALF + m * 16) * FF + col0) = pack_f4x2(g0 * sigmoid4(g0) * u0, g1 * sigmoid4(g1) * u1); }
    }
};
struct EpiPle { static constexpr bool PERM = false; EPI_ZERO_INIT
    float* X; const bf16_t* PP;
    __device__ __forceinline__ void operator()(const f32x4 (&acc)[2][2][4][2], const Unit& u, int wr, int wc, int fr, int fq) const {
        const int row0 = EPI_ROW0, col0 = u.pn * BM + wc * 32 + 4 * fq;
        EPI_FOR_AI_M { const size_t row = (size_t)(row0 + ai * HALF + m * 16);
#pragma unroll
            for (int bj = 0; bj < 2; ++bj) { const u32x2 q0 = *(const u32x2*)(PP + row * DM + col0 + bj * HALF), q1 = *(const u32x2*)(PP + row * DM + col0 + bj * HALF + 16);
                const f32x4 p0 = (f32x4){bf_lo(q0.x), bf_hi(q0.x), bf_lo(q0.y), bf_hi(q0.y)}, p1 = (f32x4){bf_lo(q1.x), bf_hi(q1.x), bf_lo(q1.y), bf_hi(q1.y)};
                const float* p = X + row * DM + col0 + bj * HALF; const f32x4 x0 = *(const f32x4*)p, x1 = *(const f32x4*)(p + 16);
                st_pair((char*)(X + (size_t)(u.pm * BM + ai * HALF + wr * 64 + m * 16) * DM + u.pn * BM + bj * HALF + wc * 32), (size_t)DM * 4, fr, fq, as_u4(x0 + sigmoid4(acc[ai][bj][m][0]) * p0), as_u4(x1 + sigmoid4(acc[ai][bj][m][1]) * p1)); }
            asm volatile("" ::: "memory"); }
    }
};
#undef EPI_ROW0
#undef EPI_FOR_AI_M
}

constexpr size_t MiB = 1u << 20;
constexpr size_t al1m(size_t x) { return (x + MiB - 1) / MiB * MiB; }
constexpr size_t WS_CTL = 0, CTL_ZERO_BYTES = 1 * MiB;
constexpr size_t SZ_WIN = (size_t)ICP * DM * 2, SZ_POOLW = (size_t)PWD * 256 * 2, SZ_LORA = (size_t)3072 * LK * 2, SZ_PPOOL = (size_t)DM * PWD * 2, SZ_PRWKV = (size_t)DM * RWD * 2,
                 SZ_WOUT = (size_t)DM * DM * 2, SZ_WGU = (size_t)2 * FF * DM * 2, SZ_WDN = (size_t)DM * FF * 2, SZ_WPG = (size_t)DM * DM * 2, SZ_WPP = (size_t)DM * PLE * 2;
constexpr size_t WS_WIN = 1 * MiB, WS_POOLW = WS_WIN + SZ_WIN, WS_LORA = WS_POOLW + SZ_POOLW, WS_PPOOL = WS_LORA + SZ_LORA, WS_PRWKV = WS_PPOOL + SZ_PPOOL, WS_WOUT = WS_PRWKV + SZ_PRWKV,
                 WS_WGU = WS_WOUT + SZ_WOUT, WS_WDN = WS_WGU + SZ_WGU, WS_WPG = WS_WDN + SZ_WDN, WS_WPP = WS_WPG + SZ_WPG, WS_WEND = WS_WPP + SZ_WPP;
constexpr size_t WS_PB = al1m(WS_WEND);
constexpr size_t WS_XN = al1m(WS_PB + (size_t)MT * PLE * 2);
constexpr size_t WS_AA = al1m(WS_XN + (size_t)MT * DM * 2);
constexpr size_t WS_GG = al1m(WS_AA + (size_t)MT * RWD * 2);
constexpr size_t WS_PP = al1m(WS_GG + (size_t)MT * RWD * 2);
constexpr size_t WS_PROJ = al1m(WS_PP + (size_t)MT * DM * 2);
constexpr size_t WS_HID = WS_PROJ;
constexpr size_t WS_D = al1m(WS_PROJ + (size_t)MT * ICP * 2);
constexpr size_t WS_LIN = al1m(WS_D + (size_t)MT * PWD * 2);
constexpr size_t WS_YA = al1m(WS_LIN + (size_t)MT * LK * 2);
constexpr size_t WS_DEC = al1m(WS_YA + (size_t)MT * PWD * 2);
constexpr size_t WS_BS = al1m(WS_DEC + (size_t)MT * RWD * 4);
constexpr size_t WS_Y = al1m(WS_BS + (size_t)MT * 16 * 4);
constexpr size_t SZ_BH = (size_t)MT * RWD * 2;
constexpr size_t WS_YB = al1m(WS_Y + (size_t)MT * RWD * 4);
constexpr size_t WS_TMP = al1m(WS_YB + SZ_BH);
constexpr size_t WS_MRG = al1m(WS_TMP + (size_t)MT * DM * 4);
constexpr size_t WS_END = al1m(WS_MRG + (size_t)MT * DM * 2);
static_assert((size_t)MT * FF * 2 <= (size_t)MT * ICP * 2, "HID overlay");

constexpr int CW_BAR = 4096;
constexpr int NWAVES = 8, NTHR = 512;
constexpr int RING_BYTES = 131072, LDSCTL_OFF = RING_BYTES, LDS_BYTES = 147456;

#define XB_TMO      128
#define XB_XCNT(j)  (256  + 64 * (j))
#define XB_XSUB(j)  (1280 + 64 * (j))
#define XB_XGEN(j)  (2304 + 64 * (j))
#define XB_TOP      3328
#define XB_TOPGEN   3392
#define XCD_BAR_WORDS 3456
#define XB_SPIN_CAP (1u << 18)

__device__ __forceinline__ unsigned xb_ld(unsigned* p)              { return __hip_atomic_load(p, __ATOMIC_RELAXED, __HIP_MEMORY_SCOPE_AGENT); }
__device__ __forceinline__ unsigned xb_add(unsigned* p, unsigned v) { return __hip_atomic_fetch_add(p, v, __ATOMIC_RELAXED, __HIP_MEMORY_SCOPE_AGENT); }
__device__ __forceinline__ unsigned xb_xcc_id() { return (unsigned)__builtin_amdgcn_s_getreg((3 << 11) | 20) & 0xFu; }
#define XB_SPIN(cond, bar) do { unsigned _sp = 0; while (cond) { __builtin_amdgcn_s_sleep(1); \
    if ((++_sp & 255u) == 0u) { if (xb_ld(&(bar)[XB_TMO])) break; if (_sp > XB_SPIN_CAP) { atomicAdd(&(bar)[XB_TMO], 1u); break; } } } } while (0)

struct XcdBarrier {
    unsigned* bar; unsigned x;
    volatile LAS unsigned* st;
};

__device__ __forceinline__ XcdBarrier xcd_barrier_post(unsigned* bar, volatile LAS unsigned* st) {
    XcdBarrier b; b.bar = bar; b.x = xb_xcc_id(); b.st = st;
    if (threadIdx.x == 0) (void)xb_add(&bar[XB_XCNT(b.x)], 1u);
    return b;
}
__device__ __forceinline__ void xcd_barrier_complete(unsigned* bar, unsigned x, unsigned& nloc, unsigned& nx) {
    const unsigned G = gridDim.x * gridDim.y * gridDim.z;
    unsigned sum, cnt, mine, sp = 0u;
    for (;;) {
        sum = 0u; cnt = 0u; mine = 0u;
#pragma unroll
        for (unsigned j = 0; j < 16; ++j) { const unsigned c = xb_ld(&bar[XB_XCNT(j)]); sum += c; cnt += (c > 0u) ? 1u : 0u; mine = (j == x) ? c : mine; }
        if (sum == G) break;
        __builtin_amdgcn_s_sleep(1);
        if ((++sp & 255u) == 0u) { if (xb_ld(&bar[XB_TMO])) break; if (sp > XB_SPIN_CAP) { atomicAdd(&bar[XB_TMO], 1u); break; } }
    }
    nloc = mine > 0u ? mine : 1u; nx = cnt > 0u ? cnt : 1u;
}

__device__ __forceinline__ void xcd_barrier(const XcdBarrier& b) {
    asm volatile("s_waitcnt vmcnt(0)" ::: "memory");
    __syncthreads();
    if (threadIdx.x == 0) {
        unsigned* bar = b.bar;
        __builtin_amdgcn_s_waitcnt(0);
        unsigned nloc = b.st[0], nx = b.st[1];
        if (nloc == 0u) { xcd_barrier_complete(bar, b.x, nloc, nx); b.st[0] = nloc; b.st[1] = nx; }
        const unsigned old = xb_add(&bar[XB_XSUB(b.x)], 1u);
        const unsigned gen = old / nloc;
        if (old + 1u == (gen + 1u) * nloc) {
            __builtin_amdgcn_fence(__ATOMIC_RELEASE, "agent");
            asm volatile("s_waitcnt vmcnt(0)" ::: "memory");
            const unsigned og = xb_add(&bar[XB_TOP], 1u);
            const unsigned tg = og / nx;
            if (og + 1u == (tg + 1u) * nx) xb_add(&bar[XB_TOPGEN], 1u);
            else XB_SPIN(xb_ld(&bar[XB_TOPGEN]) == tg, bar);
            __builtin_amdgcn_fence(__ATOMIC_ACQUIRE, "agent");
            xb_add(&bar[XB_XGEN(b.x)], 1u);
            asm volatile("s_waitcnt vmcnt(0)" ::: "memory");
        } else {
            XB_SPIN(xb_ld(&bar[XB_XGEN(b.x)]) == gen, bar);
            __builtin_amdgcn_fence(__ATOMIC_ACQUIRE, "agent");
            asm volatile("s_waitcnt vmcnt(0)" ::: "memory");
        }
    }
    __syncthreads();
}


struct Args {
    const float* in[33]; float* out; unsigned char* ws; int ph_lo, ph_hi;
};
struct Frame {
    LAS unsigned char* lds; int G;
    const LAS unsigned long long* ptab; float* out; unsigned char* ws;
};
#define GAS __attribute__((address_space(1)))
__device__ __forceinline__ const float* ldptr(const LAS unsigned long long* tab, int k) { const unsigned long long v = tab[k]; const unsigned lo = __builtin_amdgcn_readfirstlane((unsigned)v), hi = __builtin_amdgcn_readfirstlane((unsigned)(v >> 32));
    return (const float*)(const GAS float*)(((unsigned long long)hi << 32) | lo); }
__device__ __forceinline__ unsigned char* fresh(unsigned char* p) { GAS unsigned char* q = (GAS unsigned char*)p; asm volatile("" : "+s"(q)); return (unsigned char*)q; }
__device__ __forceinline__ int fresh_i(int v) { asm volatile("" : "+s"(v)); return v; }
#define INP(k) ldptr(F.ptab, (k))
#define PHASE_L const int l = fresh_i(l_in); (void)l;
#define PHASE_IDS int tid_ = threadIdx.x; asm volatile("" : "+v"(tid_)); const int tid = tid_, lane = tid & 63, wave = __builtin_amdgcn_readfirstlane(tid >> 6), gtid = blockIdx.x * NTHR + tid, gw = blockIdx.x * NWAVES + wave; (void)lane; (void)wave; (void)gtid; (void)gw;
#define VM_WAIT() asm volatile("s_waitcnt vmcnt(0)" ::: "memory")
#define LDS_WAIT() asm volatile("s_waitcnt lgkmcnt(0)" ::: "memory")
constexpr int NT_ALL_SHIFT = 9;

__device__ __forceinline__ void row_info(int m, int& b, int& t, bool& samp) { samp = m >= MPR; if (samp) { b = (m - MPR) >> 6; t = (m - MPR) & 63; } else { b = m >> 11; t = m & 2047; } }

__device__ __forceinline__ void transpose_item(const float* W, int N, bf16_t* WT, int ldk, int k0, int n0, int drow0, LAS float* scr, int lane, const float* cscale = nullptr) {
    const float cs = cscale ? cscale[n0 + (lane & 31)] : 1.0f;
#pragma unroll 8
    for (int i = 0; i < 32; ++i) { const int kk = 2 * i + (lane >> 5); scr[kk * 33 + (lane & 31)] = W[(size_t)(k0 + kk) * N + n0 + (lane & 31)] * cs; }
    LDS_WAIT(); asm volatile("" ::: "memory");
    const int c = lane & 7;
#pragma unroll
    for (int j = 0; j < 4; ++j) { const int n = (lane >> 3) + 8 * j; const LAS float* s = scr + (8 * c) * 33 + n;
        u32x4 o; o.x = cvt_pk_bf16(s[0 * 33], s[1 * 33]); o.y = cvt_pk_bf16(s[2 * 33], s[3 * 33]); o.z = cvt_pk_bf16(s[4 * 33], s[5 * 33]); o.w = cvt_pk_bf16(s[6 * 33], s[7 * 33]);
        *(u32x4*)(WT + (size_t)(drow0 + n) * ldk + k0 + 8 * c) = o; }
    LDS_WAIT(); asm volatile("" ::: "memory");
}
__device__ __forceinline__ void convert_weights(Frame& F, int l_in) {
    PHASE_IDS
    unsigned char* const wsl = fresh(F.ws);
    PHASE_L
    LAS float* scr = (LAS float*)(F.lds + wave * 16384);
    const int NGW = fresh_i(F.G) * NWAVES;
    unsigned char* ws = wsl;
    constexpr int I_WIN = (DM / 64) * (ICOLS / 32), I_PW = 4 * (256 / 64) * (256 / 32), I_PP = (PWD / 64) * (DM / 32), I_WO = (DM / 64) * (DM / 32), I_FG = (DM / 64) * (FF / 32),
                  I_FD = (FF / 64) * (DM / 32), I_PL = (PLE / 64) * (DM / 32);
    constexpr int NITEMS = I_WIN + I_PW + 2 * I_PP + I_WO + 2 * I_FG + I_FD + I_WO + I_PL;
    for (int it = gw; it < NITEMS; it += NGW) {
        int r = it;
        if (r < I_WIN) { const int nblk = ICOLS / 32, kb = r / nblk, nb = r % nblk, n0 = nb * 32; transpose_item(INP(8) + (size_t)l * DM * ICOLS, ICOLS, (bf16_t*)(ws + WS_WIN), DM, kb * 64, n0, n0 < 4384 ? n0 : n0 + 224, scr, lane); continue; } r -= I_WIN;
        if (r < I_PW) { const int g = r >> 5, rr = r & 31, kb = rr >> 3, nb = rr & 7; transpose_item(INP(10) + ((size_t)l * 4 + g) * 65536, 256, (bf16_t*)(ws + WS_POOLW) + (size_t)g * 65536, 256, kb * 64, nb * 32, nb * 32, scr, lane, INP(11) + (size_t)l * PWD + g * 256); continue; } r -= I_PW;
        if (r < I_PP) { const int nblk = DM / 32, kb = r / nblk, nb = r % nblk; transpose_item(INP(22) + (size_t)l * PWD * DM, DM, (bf16_t*)(ws + WS_PPOOL), PWD, kb * 64, nb * 32, nb * 32, scr, lane); continue; } r -= I_PP;
        if (r < I_PP) { const int nblk = DM / 32, kb = r / nblk, nb = r % nblk; transpose_item(INP(23) + (size_t)l * RWD * DM, DM, (bf16_t*)(ws + WS_PRWKV), RWD, kb * 64, nb * 32, nb * 32, scr, lane); continue; } r -= I_PP;
        if (r < I_WO) { const int nblk = DM / 32, kb = r / nblk, nb = r % nblk; transpose_item(INP(24) + (size_t)l * DM * DM, DM, (bf16_t*)(ws + WS_WOUT), DM, kb * 64, nb * 32, nb * 32, scr, lane); continue; } r -= I_WO;
        if (r < I_FG) { const int nblk = FF / 32, kb = r / nblk, nb = r % nblk, n0 = nb * 32; transpose_item(INP(26) + (size_t)l * DM * FF, FF, (bf16_t*)(ws + WS_WGU), DM, kb * 64, n0, 256 * (n0 >> 7) + 64 * ((n0 & 127) >> 5), scr, lane); continue; } r -= I_FG;
        if (r < I_FG) { const int nblk = FF / 32, kb = r / nblk, nb = r % nblk, n0 = nb * 32; transpose_item(INP(27) + (size_t)l * DM * FF, FF, (bf16_t*)(ws + WS_WGU), DM, kb * 64, n0, 256 * (n0 >> 7) + 64 * ((n0 & 127) >> 5) + 32, scr, lane); continue; } r -= I_FG;
        if (r < I_FD) { const int nblk = DM / 32, kb = r / nblk, nb = r % nblk; transpose_item(INP(28) + (size_t)l * FF * DM, DM, (bf16_t*)(ws + WS_WDN), FF, kb * 64, nb * 32, nb * 32, scr, lane); continue; } r -= I_FD;
        if (r < I_WO) { const int nblk = DM / 32, kb = r / nblk, nb = r % nblk; transpose_item(INP(30) + (size_t)l * DM * DM, DM, (bf16_t*)(ws + WS_WPG), DM, kb * 64, nb * 32, nb * 32, scr, lane); continue; } r -= I_WO;
        { const int nblk = DM / 32, kb = r / nblk, nb = r % nblk; transpose_item(INP(31) + (size_t)l * PLE * DM, DM, (bf16_t*)(ws + WS_WPP), PLE, kb * 64, nb * 32, nb * 32, scr, lane); }
    }
    const int NT = fresh_i(F.G) * NTHR;
    { u32x4* z = (u32x4*)((bf16_t*)(ws + WS_WIN) + (size_t)4384 * DM); for (int i = gtid; i < 224 * DM * 2 / 16; i += NT) z[i] = (u32x4){0u, 0u, 0u, 0u}; }
    { bf16_t* LT = (bf16_t*)(ws + WS_LORA); const float* wd = INP(13) + (size_t)l * 64 * RWD; const float* wa = INP(15) + (size_t)l * 64 * RWD; const float* wg = INP(16) + (size_t)l * 160 * RWD;
      for (int i = gtid; i < 3072 * (LK / 8); i += NT) { const int n = i / (LK / 8), k0 = (i % (LK / 8)) * 8; const int kind = n >> 10, c = n & 1023; float f[8];
#pragma unroll
          for (int j = 0; j < 8; ++j) { const int k = k0 + j; float v = 0.f;
              if (kind == 0) { if (k < 64) v = wd[(size_t)k * RWD + c]; }
              else if (kind == 1) { if (k >= 64 && k < 128) v = wa[(size_t)(k - 64) * RWD + c]; }
              else { if (k >= 128 && k < 288) v = wg[(size_t)(k - 128) * RWD + c]; }
              f[j] = v; }
          *(u32x4*)(LT + (size_t)n * LK + k0) = pack8(f); } }
    { bf16_t* PB = (bf16_t*)(ws + WS_PB); const float* pp = INP(5) + (size_t)l * MPR * PLE; const float* ps = INP(6) + (size_t)l * (MT - MPR) * PLE;
      for (int i = gtid; i < MT * PLE / 8; i += NT) { const size_t e = (size_t)i * 8; const float* src = e < (size_t)MPR * PLE ? pp + e : ps + (e - (size_t)MPR * PLE);
          const f32x4 a = *(const f32x4*)src, b = *(const f32x4*)(src + 4); *(u32x4*)(PB + e) = pg8::pack_f4x2(a, b); } }
}

template <bool FROM_INPUT, bool FINAL>
__device__ __forceinline__ void norm_rows(Frame& F, const float* gain) {
    PHASE_IDS
    unsigned char* const wsl = fresh(F.ws);
    const int NGW = fresh_i(F.G) * NWAVES; float* X = F.out; bf16_t* XN = (bf16_t*)(wsl + WS_XN);
    f32x4 g[8];
#pragma unroll
    for (int j = 0; j < 8; ++j) g[j] = *(const f32x4*)(gain + 4 * lane + 256 * j);
    for (int m = gw; m < MT; m += NGW) {
        const float* src = FROM_INPUT ? (m < MPR ? INP(0) + (size_t)m * DM : INP(1) + (size_t)(m - MPR) * DM) : X + (size_t)m * DM;
        f32x4 v[8]; float s = 0.f;
#pragma unroll
        for (int j = 0; j < 8; ++j) { v[j] = *(const f32x4*)(src + 4 * lane + 256 * j); s += (v[j].x * v[j].x + v[j].y * v[j].y) + (v[j].z * v[j].z + v[j].w * v[j].w); }
        const float rstd = __builtin_amdgcn_rsqf(wave_sum(s) * (1.0f / DM) + NORM_EPS);
        if (FROM_INPUT) {
#pragma unroll
            for (int j = 0; j < 8; ++j) *(f32x4*)(X + (size_t)m * DM + 4 * lane + 256 * j) = v[j];
        }
        if (FINAL) {
#pragma unroll
            for (int j = 0; j < 8; ++j) *(f32x4*)(X + (size_t)m * DM + 4 * lane + 256 * j) = v[j] * rstd * g[j];
        } else {
#pragma unroll
            for (int j = 0; j < 8; ++j) { const f32x4 o = v[j] * rstd * g[j]; u32x2 w; w.x = cvt_pk_bf16(o.x, o.y); w.y = cvt_pk_bf16(o.z, o.w); *(u32x2*)(XN + (size_t)m * DM + 4 * lane + 256 * j) = w; }
        }
    }
}

__device__ __forceinline__ void load_z(float (&z)[8], const bf16_t* PROJ, const float* past, int m0, int t, bool samp, int c0) {
    if (t >= 0) { unpack8(*(const u32x4*)(PROJ + (size_t)(m0 + t) * ICP + c0), z); }
    else if (samp) { const float* p = past + (size_t)(15 + t) * PWD + c0; const f32x4 a = *(const f32x4*)p, b = *(const f32x4*)(p + 4); z[0] = a.x; z[1] = a.y; z[2] = a.z; z[3] = a.w; z[4] = b.x; z[5] = b.y; z[6] = b.z; z[7] = b.w; }
    else {
#pragma unroll
        for (int j = 0; j < 8; ++j) z[j] = 0.f; }
}
__device__ __forceinline__ void prep1_phase(Frame& F, int l_in) {
    PHASE_IDS
    unsigned char* const wsl = fresh(F.ws);
    PHASE_L
    const int NT = fresh_i(F.G) * NTHR; const bf16_t* PROJ = (const bf16_t*)(wsl + WS_PROJ);
    { bf16_t* D = (bf16_t*)(wsl + WS_D);
      for (int it = gtid; it < (MT / 16) * 128; it += NT) {
          const int oct = it & 127, run = it >> 7, mrow = run * 16, c0 = oct * 8, win = 2 << (c0 >> 8);
          int b, t0; bool samp; row_info(mrow, b, t0, samp);
          const int T = samp ? TS : TP, mseq = mrow - t0;
          const float* past = INP(3) + ((size_t)l * 8 + b) * 15 * PWD;
          float* npool = F.out + (samp ? O_POS : O_POP) + ((size_t)l * 8 + b) * 15 * PWD;
          float S[8], z[8];
#pragma unroll
          for (int j = 0; j < 8; ++j) S[j] = 0.f;
          for (int j = 1; j < win; ++j) { load_z(z, PROJ, past, mseq, t0 - j, samp, c0);
#pragma unroll
              for (int q = 0; q < 8; ++q) S[q] += z[q]; }
          for (int i = 0; i < 16; ++i) { const int t = t0 + i; float cur[8]; load_z(cur, PROJ, past, mseq, t, samp, c0);
              const int cnt = samp ? win : (t + 1 < win ? t + 1 : win); const float inv = 1.0f / (float)cnt; float d[8];
#pragma unroll
              for (int q = 0; q < 8; ++q) { S[q] += cur[q]; d[q] = S[q] * inv - cur[q]; }
              *(u32x4*)(D + (size_t)(mseq + t) * PWD + c0) = pack8(d);
              if (t >= T - 15) { float* o = npool + (size_t)(t - (T - 15)) * PWD + c0; *(f32x4*)o = (f32x4){cur[0], cur[1], cur[2], cur[3]}; *(f32x4*)(o + 4) = (f32x4){cur[4], cur[5], cur[6], cur[7]}; }
              load_z(z, PROJ, past, mseq, t - win + 1, samp, c0);
#pragma unroll
              for (int q = 0; q < 8; ++q) S[q] -= z[q]; }
      } }
    { bf16_t* LIN = (bf16_t*)(wsl + WS_LIN); const float* mu = INP(9) + (size_t)l * RPJ + 3072;
      for (int it = gtid; it < MT * (LK / 8); it += NT) {
          const int m = it / (LK / 8), c0 = (it % (LK / 8)) * 8; float o[8];
          if (c0 >= 288) {
#pragma unroll
              for (int j = 0; j < 8; ++j) o[j] = 0.f;
          } else {
              int b, t; bool samp; row_info(m, b, t, samp);
              float cur[8], prv[8]; unpack8(*(const u32x4*)(PROJ + (size_t)m * ICP + 4096 + c0), cur);
              if (t > 0) unpack8(*(const u32x4*)(PROJ + (size_t)(m - 1) * ICP + 4096 + c0), prv);
              else if (samp) { const float* p = INP(2) + ((size_t)l * 8 + b) * RPJ + 3072 + c0;
#pragma unroll
                  for (int j = 0; j < 8; ++j) prv[j] = p[j]; }
              else {
#pragma unroll
                  for (int j = 0; j < 8; ++j) prv[j] = 0.f; }
#pragma unroll
              for (int j = 0; j < 8; ++j) { const float xm = cur[j] + (prv[j] - cur[j]) * mu[c0 + j]; o[j] = c0 < 64 ? tanhf_(xm) : (c0 < 128 ? xm : sigmoidf_(xm)); }
          }
          *(u32x4*)(LIN + (size_t)m * LK + c0) = pack8(o);
      } }
    for (int it = gtid; it < 16 * RPJ; it += NT) { const int s = it / RPJ, c = it % RPJ; const int mlast = s < 8 ? s * TP + TP - 1 : MPR + (s - 8) * TS + TS - 1;
        F.out[(s < 8 ? O_SHP : O_SHS) + ((size_t)l * 8 + (s & 7)) * RPJ + c] = __uint_as_float((unsigned)PROJ[(size_t)mlast * ICP + 1024 + c] << 16); }
}

constexpr int SC_TC = 32, SC_STEP = 6 * 64;
__device__ __forceinline__ float sum16(float x) { x += dpp_f<0xB1>(x); x += dpp_f<0x4E>(x); x += dpp_f<0x141>(x); x += dpp_f<0x140>(x); return x; }
__device__ __forceinline__ void unpack4(const u32x2 w, float (&f)[4]) { f[0] = bf_lo(w.x); f[1] = bf_hi(w.x); f[2] = bf_lo(w.y); f[3] = bf_hi(w.y); }
__device__ __forceinline__ void scan_phase(Frame& F, int l_in) {
    PHASE_IDS
    unsigned char* const wsl = fresh(F.ws);
    PHASE_L
    LAS float* buf = (LAS float*)F.lds;
    LAS float* ybuf = (LAS float*)(F.lds + 2 * SC_TC * SC_STEP * 4);
    const float* DEC = (const float*)(wsl + WS_DEC); const bf16_t* PROJ = (const bf16_t*)(wsl + WS_PROJ); const bf16_t* AA = (const bf16_t*)(wsl + WS_AA);
    float* Y = (float*)(wsl + WS_Y); float* BS = (float*)(wsl + WS_BS);
    const bool is_cons = wave < 4;
    const int ks = lane & 7, k0 = ks * 8, rl = (wave & 3) * 8 + (lane >> 3);
    const int ptid = tid & 255, st0 = ptid >> 4, q4 = (ptid & 15) * 4;
    for (int u = blockIdx.x; u < 512; u += fresh_i(F.G)) {
        const bool samp = u >= 256; const int half = u & 1, h = (u >> 1) & 15, b = (u >> 5) & 7;
        const int T = samp ? TS : TP, m0 = samp ? MPR + b * TS : b * TP, ch = h * 64 + q4, row = half * 32 + rl;
        const int nch = T / SC_TC;
        const float* mu = INP(9) + (size_t)l * RPJ;
        const f32x4 mur = *(const f32x4*)(mu + ch), muk = *(const f32x4*)(mu + 1024 + ch), muv = *(const f32x4*)(mu + 2048 + ch);
        const f32x4 ckk = *(const f32x4*)(INP(17) + (size_t)l * RWD + ch), cka = *(const f32x4*)(INP(18) + (size_t)l * RWD + ch), crk = *(const f32x4*)(INP(19) + (size_t)l * RWD + ch);
        const float* shp = INP(2) + ((size_t)l * 8 + b) * RPJ + ch;
        f32x2 S01, S23, S45, S67;
        if (samp) { const float* sp = INP(4) + ((((size_t)l * 8 + b) * 16 + h) * 64 + row) * 64 + k0; const f32x4 s0 = *(const f32x4*)sp, s1 = *(const f32x4*)(sp + 4);
            S01 = (f32x2){s0.x, s0.y}; S23 = (f32x2){s0.z, s0.w}; S45 = (f32x2){s1.x, s1.y}; S67 = (f32x2){s1.z, s1.w}; }
        else { S01 = (f32x2){0.f, 0.f}; S23 = S01; S45 = S01; S67 = S01; }
        u32x2 rw[2][7]; f32x4 rd[2];
#define SC_LOADRAW(c) do { _Pragma("unroll") for (int i2 = 0; i2 < 2; ++i2) { const int tt = (c) * SC_TC + st0 + 16 * i2; const size_t mm = (size_t)(m0 + tt); const bf16_t* pc = PROJ + mm * ICP + 1024 + ch; \
        rw[i2][0] = *(const u32x2*)pc; rw[i2][1] = *(const u32x2*)(pc + 1024); rw[i2][2] = *(const u32x2*)(pc + 2048); rw[i2][6] = *(const u32x2*)(AA + mm * RWD + ch); rd[i2] = *(const f32x4*)(DEC + mm * RWD + ch); \
        if (tt > 0) { rw[i2][3] = *(const u32x2*)(pc - ICP); rw[i2][4] = *(const u32x2*)(pc - ICP + 1024); rw[i2][5] = *(const u32x2*)(pc - ICP + 2048); } \
        else { rw[i2][3] = (u32x2){0u, 0u}; rw[i2][4] = rw[i2][3]; rw[i2][5] = rw[i2][3]; } } } while (0)
#define SC_BUILD(c, bufp) do { _Pragma("unroll") for (int i2 = 0; i2 < 2; ++i2) { const int st = st0 + 16 * i2, tt = (c) * SC_TC + st; const size_t mm = (size_t)(m0 + tt); \
        float xr[4], xk[4], xv[4], yr[4], yk[4], yv[4], av[4]; unpack4(rw[i2][0], xr); unpack4(rw[i2][1], xk); unpack4(rw[i2][2], xv); unpack4(rw[i2][3], yr); unpack4(rw[i2][4], yk); unpack4(rw[i2][5], yv); unpack4(rw[i2][6], av); \
        const f32x4 cd = rd[i2]; \
        if (samp && tt == 0) { const f32x4 t0 = *(const f32x4*)shp, t1 = *(const f32x4*)(shp + 1024), t2 = *(const f32x4*)(shp + 2048); _Pragma("unroll") for (int j = 0; j < 4; ++j) { yr[j] = t0[j]; yk[j] = t1[j]; yv[j] = t2[j]; } } \
        f32x4 vr, vk, vv4, vq, vb, vh; float ss = 0.f, bsum = 0.f; \
        _Pragma("unroll") for (int j = 0; j < 4; ++j) { vr[j] = xr[j] + (yr[j] - xr[j]) * mur[j]; vk[j] = xk[j] + (yk[j] - xk[j]) * muk[j]; vv4[j] = xv[j] + (yv[j] - xv[j]) * muv[j]; \
            vq[j] = vk[j] * ckk[j]; ss += vq[j] * vq[j]; vh[j] = vk[j] * (1.0f + (av[j] - 1.0f) * cka[j]); bsum += vr[j] * vh[j] * crk[j]; } \
        ss = sum16(ss); bsum = sum16(bsum); const float inv = 1.0f / fmaxf(sqrtf(ss), 1e-12f); \
        _Pragma("unroll") for (int j = 0; j < 4; ++j) { vq[j] *= inv; vb[j] = vq[j] * av[j]; } \
        LAS float* d = (bufp) + st * SC_STEP + q4; *(LAS f32x4*)d = cd; *(LAS f32x4*)(d + 64) = vq; *(LAS f32x4*)(d + 128) = vb; *(LAS f32x4*)(d + 192) = vh; *(LAS f32x4*)(d + 256) = vr; *(LAS f32x4*)(d + 320) = vv4; \
        if (half == 0 && q4 == 0) BS[mm * 16 + h] = bsum; } } while (0)
#define SC_FLUSH(c) do { const int fs = ptid >> 3, fj = (ptid & 7) * 4; const f32x4 yo = *(const LAS f32x4*)(ybuf + ((c) & 1) * SC_TC * 32 + fs * 32 + fj); \
        *(f32x4*)(Y + (size_t)(m0 + (c) * SC_TC + fs) * RWD + h * 64 + half * 32 + fj) = yo; } while (0)
        __syncthreads();
        if (!is_cons) { SC_LOADRAW(0); SC_BUILD(0, buf); if (nch > 1) SC_LOADRAW(1); }
        __syncthreads();
        for (int c = 0; c < nch; ++c) {
            LAS float* cur = buf + (c & 1) * SC_TC * SC_STEP; LAS float* oth = buf + ((c + 1) & 1) * SC_TC * SC_STEP; LAS float* yb = ybuf + (c & 1) * SC_TC * 32;
            if (is_cons) {
#define SC_STEP_BODY(s, DO_Y) do { const LAS float* p = cur + (s) * SC_STEP + k0; \
                const f32x4 wa = *(const LAS f32x4*)p, wb = *(const LAS f32x4*)(p + 4), qa = *(const LAS f32x4*)(p + 64), qb = *(const LAS f32x4*)(p + 68), ba = *(const LAS f32x4*)(p + 128), bb = *(const LAS f32x4*)(p + 132), \
                            ha = *(const LAS f32x4*)(p + 192), hb = *(const LAS f32x4*)(p + 196), ra = *(const LAS f32x4*)(p + 256), rb = *(const LAS f32x4*)(p + 260); \
                const float vv = cur[(s) * SC_STEP + 320 + row]; const f32x2 v2 = (f32x2){vv, vv}; \
                f32x2 d = S01 * (f32x2){qa.x, qa.y}; f32x2 d1 = S23 * (f32x2){qa.z, qa.w}; d = S45 * (f32x2){qb.x, qb.y} + d; d1 = S67 * (f32x2){qb.z, qb.w} + d1; d = d + d1; float sa = d.x + d.y; \
                float yv = 0.f; if (DO_Y) { f32x2 e = S01 * (f32x2){rpa.x, rpa.y}; f32x2 e1 = S23 * (f32x2){rpa.z, rpa.w}; e = S45 * (f32x2){rpb.x, rpb.y} + e; e1 = S67 * (f32x2){rpb.z, rpb.w} + e1; e = e + e1; yv = e.x + e.y; } \
                const f32x2 t01 = S01 * (f32x2){wa.x, wa.y} + v2 * (f32x2){ha.x, ha.y}, t23 = S23 * (f32x2){wa.z, wa.w} + v2 * (f32x2){ha.z, ha.w}, t45 = S45 * (f32x2){wb.x, wb.y} + v2 * (f32x2){hb.x, hb.y}, t67 = S67 * (f32x2){wb.z, wb.w} + v2 * (f32x2){hb.z, hb.w}; \
                sa += dpp_f<0xB1>(sa); if (DO_Y) yv += dpp_f<0xB1>(yv); sa += dpp_f<0x4E>(sa); if (DO_Y) yv += dpp_f<0x4E>(yv); sa += dpp_f<0x141>(sa); if (DO_Y) yv += dpp_f<0x141>(yv); \
                const f32x2 n2 = (f32x2){-sa, -sa}; \
                S01 = n2 * (f32x2){ba.x, ba.y} + t01; S23 = n2 * (f32x2){ba.z, ba.w} + t23; S45 = n2 * (f32x2){bb.x, bb.y} + t45; S67 = n2 * (f32x2){bb.z, bb.w} + t67; \
                if (DO_Y) yb[((s) - 1) * 32 + rl] = yv; rpa = ra; rpb = rb; } while (0)
                f32x4 rpa, rpb;
                SC_STEP_BODY(0, false);
#pragma unroll 2
                for (int s = 1; s < SC_TC; ++s) SC_STEP_BODY(s, true);
                { f32x2 e = S01 * (f32x2){rpa.x, rpa.y}; f32x2 e1 = S23 * (f32x2){rpa.z, rpa.w}; e = S45 * (f32x2){rpb.x, rpb.y} + e; e1 = S67 * (f32x2){rpb.z, rpb.w} + e1; e = e + e1; yb[(SC_TC - 1) * 32 + rl] = sum8(e.x + e.y); }
#undef SC_STEP_BODY
            } else {
                if (c + 1 < nch) SC_BUILD(c + 1, oth);
                if (c + 2 < nch) SC_LOADRAW(c + 2);
                if (c > 0) SC_FLUSH(c - 1);
            }
            __syncthreads();
        }
        if (!is_cons) SC_FLUSH(nch - 1);
#undef SC_BUILD
#undef SC_LOADRAW
#undef SC_FLUSH
        if (is_cons) { float* so = F.out + (samp ? O_WKS : O_WKP) + ((((size_t)l * 8 + b) * 16 + h) * 64 + row) * 64 + k0;
            *(f32x4*)so = (f32x4){S01.x, S01.y, S23.x, S23.y}; *(f32x4*)(so + 4) = (f32x4){S45.x, S45.y, S67.x, S67.y}; }
    }
}

__device__ __forceinline__ void post_phase(Frame& F, int l_in) {
    PHASE_IDS
    unsigned char* const wsl = fresh(F.ws);
    PHASE_L
    const int NT = fresh_i(F.G) * NTHR; const float* Y = (const float*)(wsl + WS_Y); const float* BS = (const float*)(wsl + WS_BS);
    const bf16_t* PROJ = (const bf16_t*)(wsl + WS_PROJ); const bf16_t* GG = (const bf16_t*)(wsl + WS_GG);
    bf16_t* YB = (bf16_t*)(wsl + WS_YB);
    const float* muv = INP(9) + (size_t)l * RPJ + 2048; const float* gng = INP(20) + (size_t)l * RWD; const float* gnb = INP(21) + (size_t)l * RWD;
    for (int it = gtid; it < MT * 128; it += NT) {
        const int m = it >> 7, c0 = (it & 127) * 8; const size_t o = (size_t)m * RWD + c0;
        int b, t; bool samp; row_info(m, b, t, samp);
        const f32x4 y0 = *(const f32x4*)(Y + o), y1 = *(const f32x4*)(Y + o + 4);
        float y[8] = {y0.x, y0.y, y0.z, y0.w, y1.x, y1.y, y1.z, y1.w};
        float cur[8], prv[8], g[8]; unpack8(*(const u32x4*)(PROJ + (size_t)m * ICP + 3072 + c0), cur); unpack8(*(const u32x4*)(GG + o), g);
        if (t > 0) unpack8(*(const u32x4*)(PROJ + (size_t)(m - 1) * ICP + 3072 + c0), prv);
        else if (samp) { const float* p = INP(2) + ((size_t)l * 8 + b) * RPJ + 2048 + c0;
#pragma unroll
            for (int j = 0; j < 8; ++j) prv[j] = p[j]; }
        else {
#pragma unroll
            for (int j = 0; j < 8; ++j) prv[j] = 0.f; }
        const float bs = BS[(size_t)m * 16 + (c0 >> 6)];
        float s = 0.f;
#pragma unroll
        for (int j = 0; j < 8; ++j) s += y[j];
        s = sum8(s);
        const float mean = s * (1.0f / 64.0f); float q = 0.f;
#pragma unroll
        for (int j = 0; j < 8; ++j) { const float d = y[j] - mean; q += d * d; }
        q = sum8(q);
        const float rstd = __builtin_amdgcn_rsqf(q * (1.0f / 64.0f) + GN_EPS);
        float outv[8];
#pragma unroll
        for (int j = 0; j < 8; ++j) { const float v = cur[j] + (prv[j] - cur[j]) * muv[c0 + j]; outv[j] = ((y[j] - mean) * rstd * gng[c0 + j] + gnb[c0 + j] + bs * v) * g[j]; }
        *(u32x4*)(YB + o) = pack8(outv);
    }
}

__device__ __forceinline__ void tile64_mma(const bf16_t* A, int lda, const bf16_t* Bt, int ldb, int K, int m0, int n0, int wave, int lane, f32x4 (&acc)[4][4]) {
    const int kq = K >> 3, kb = wave * kq, lr = lane & 15, lk = (lane >> 4) * 8;
    const bf16_t* ap = A + (size_t)(m0 + lr) * lda + kb + lk; const bf16_t* bp = Bt + (size_t)(n0 + lr) * ldb + kb + lk;
#pragma unroll 2
    for (int k = 0; k < kq; k += 32) {
        bf16x8 af[4], bf[4];
#pragma unroll
        for (int i = 0; i < 4; ++i) { af[i] = *(const bf16x8*)(ap + (size_t)(16 * i) * lda + k); bf[i] = *(const bf16x8*)(bp + (size_t)(16 * i) * ldb + k); }
#pragma unroll
        for (int mi = 0; mi < 4; ++mi)
#pragma unroll
            for (int ni = 0; ni < 4; ++ni) acc[mi][ni] = __builtin_amdgcn_mfma_f32_16x16x32_bf16(bf[ni], af[mi], acc[mi][ni], 0, 0, 0);
    }
}
__device__ __forceinline__ void tile64_reduce(LAS unsigned char* lds, int wave, int lane, const f32x4 (&acc)[4][4], f32x4 (&out)[2]) {
    LAS f32x4* red = (LAS f32x4*)lds;
    __syncthreads();
#pragma unroll
    for (int mi = 0; mi < 4; ++mi)
#pragma unroll
        for (int ni = 0; ni < 4; ++ni) red[(wave * 16 + mi * 4 + ni) * 64 + lane] = acc[mi][ni];
    __syncthreads();
#pragma unroll
    for (int j = 0; j < 2; ++j) { f32x4 s = red[(2 * wave + j) * 64 + lane];
#pragma unroll
        for (int w = 1; w < 8; ++w) s += red[(w * 16 + 2 * wave + j) * 64 + lane];
        out[j] = s; }
}
#define T64_ZERO(acc) do { _Pragma("unroll") for (int mi = 0; mi < 4; ++mi) _Pragma("unroll") for (int ni = 0; ni < 4; ++ni) acc[mi][ni] = (f32x4){0.f, 0.f, 0.f, 0.f}; } while (0)
template <int MODE>
__device__ __forceinline__ void sample_tiles(Frame& F, int l_in) {
    PHASE_IDS
    unsigned char* const wsl = fresh(F.ws);
    PHASE_L
    for (int t = blockIdx.x; t < 256; t += fresh_i(F.G)) {
        const int m0 = MPR + (t >> 5) * 64, n0 = (t & 31) * 64;
        f32x4 acc[4][4], o1[2], o2[2]; T64_ZERO(acc);
        if (MODE == 0) { tile64_mma((const bf16_t*)(wsl + WS_YA), PWD, (const bf16_t*)(wsl + WS_PPOOL), PWD, PWD, m0, n0, wave, lane, acc); tile64_reduce(F.lds, wave, lane, acc, o1);
                         T64_ZERO(acc); tile64_mma((const bf16_t*)(wsl + WS_YB), RWD, (const bf16_t*)(wsl + WS_PRWKV), RWD, RWD, m0, n0, wave, lane, acc); tile64_reduce(F.lds, wave, lane, acc, o2); }
        if (MODE == 1) { tile64_mma((const bf16_t*)(wsl + WS_MRG), DM, (const bf16_t*)(wsl + WS_WOUT), DM, DM, m0, n0, wave, lane, acc); tile64_reduce(F.lds, wave, lane, acc, o1); }
        if (MODE == 2) { tile64_mma((const bf16_t*)(wsl + WS_HID), FF, (const bf16_t*)(wsl + WS_WDN), FF, FF, m0, n0, wave, lane, acc); tile64_reduce(F.lds, wave, lane, acc, o1); }
        if (MODE == 3) { tile64_mma((const bf16_t*)(wsl + WS_XN), DM, (const bf16_t*)(wsl + WS_WPG), DM, DM, m0, n0, wave, lane, acc); tile64_reduce(F.lds, wave, lane, acc, o1); }
        if (MODE == 4) { tile64_mma((const bf16_t*)(wsl + WS_PB), PLE, (const bf16_t*)(wsl + WS_WPP), PLE, PLE, m0, n0, wave, lane, acc); tile64_reduce(F.lds, wave, lane, acc, o1); }
#pragma unroll
        for (int j = 0; j < 2; ++j) { const int blk = 2 * wave + j; const size_t row = (size_t)(m0 + 16 * (blk >> 2) + (lane & 15)); const int col = n0 + 16 * (blk & 3) + 4 * (lane >> 4);
            if (MODE == 0) { const bf16_t* PROJ = (const bf16_t*)(wsl + WS_PROJ); const u32x2 g1 = *(const u32x2*)(PROJ + row * ICP + PC_GP + col), g2 = *(const u32x2*)(PROJ + row * ICP + PC_GR + col);
                const f32x4 a = (f32x4){bf_lo(g1.x), bf_hi(g1.x), bf_lo(g1.y), bf_hi(g1.y)} * o1[j] + (f32x4){bf_lo(g2.x), bf_hi(g2.x), bf_lo(g2.y), bf_hi(g2.y)} * o2[j];
                *(u32x2*)((bf16_t*)(wsl + WS_MRG) + row * DM + col) = (u32x2){cvt_pk_bf16(a.x, a.y), cvt_pk_bf16(a.z, a.w)}; }
            if (MODE == 1 || MODE == 2) { float* p = F.out + row * DM + col; *(f32x4*)p = *(const f32x4*)p + o1[j]; }
            if (MODE == 3) { const u32x2 q = *(const u32x2*)((const bf16_t*)(wsl + WS_PP) + row * DM + col); float* p = F.out + row * DM + col;
                *(f32x4*)p = *(const f32x4*)p + sigmoid4(o1[j]) * (f32x4){bf_lo(q.x), bf_hi(q.x), bf_lo(q.y), bf_hi(q.y)}; }
            if (MODE == 4) *(u32x2*)((bf16_t*)(wsl + WS_PP) + row * DM + col) = (u32x2){cvt_pk_bf16(o1[j].x, o1[j].y), cvt_pk_bf16(o1[j].z, o1[j].w)};
        }
    }
    __syncthreads();
}

constexpr int PH_PER_LAYER = 13, N_PHASES = NL * PH_PER_LAYER + 1;
#ifndef MK_REP
#define MK_REP 0
#endif
__global__ void __launch_bounds__(NTHR, 2) mega_fwd(Args args) {
    extern __shared__ __attribute__((aligned(16))) unsigned char lds[];
    Frame F;
    F.lds = (LAS unsigned char*)lds;
    F.G = gridDim.x;
    F.out = args.out; F.ws = args.ws;
    { LAS unsigned long long* pt = (LAS unsigned long long*)(F.lds + LDSCTL_OFF + 1024); F.ptab = pt;
      if (threadIdx.x == 0) {
#define PT_(k) pt[k] = (unsigned long long)args.in[k];
          PT_(0) PT_(1) PT_(2) PT_(3) PT_(4) PT_(5) PT_(6) PT_(7) PT_(8) PT_(9) PT_(10) PT_(11) PT_(12) PT_(13) PT_(14) PT_(15) PT_(16) PT_(17) PT_(18) PT_(19) PT_(20) PT_(21) PT_(22) PT_(23) PT_(24) PT_(25) PT_(26) PT_(27) PT_(28) PT_(29) PT_(30) PT_(31) PT_(32)
#undef PT_
      } }
    volatile LAS unsigned* MISC = (volatile LAS unsigned*)(F.lds + LDSCTL_OFF);
    for (int u = threadIdx.x; u < 256; u += NTHR) ((LAS unsigned*)(F.lds + LDSCTL_OFF))[u] = 0u;
    __syncthreads();
    XcdBarrier bar; bar.bar = (unsigned*)(args.ws + WS_CTL) + CW_BAR; bar.x = 0; bar.st = nullptr;
    if (!MK_PER_PHASE) bar = xcd_barrier_post((unsigned*)(args.ws + WS_CTL) + CW_BAR, MISC + 8);
    const int lo = args.ph_lo, hi = args.ph_hi;
#define IN(k) (lo <= (k) && (k) < hi)
#define REP(k) (1 + ((MK_REP >> (k)) & 1))
#define PHASE(k, ...) do { if (IN(pb + (k))) { for (int rep = 0; rep < REP(k); ++rep) { if (rep) xcd_barrier(bar); __VA_ARGS__ } if (IN(pb + (k) + 1)) xcd_barrier(bar); } } while (0)
#define WSP(off) (fresh(F.ws) + (off))
#define UNPAREN(...) __VA_ARGS__
#define GEMM_M(M_, EPI, EINIT, Aoff, Boff, N_, K_, lda_, ldb_, apn_) do { pg8::Gemm g{(const bf16_t*)WSP(Aoff), (const bf16_t*)WSP(Boff), (M_), (N_), (K_), (lda_), (ldb_), (apn_)}; pg8::StaticOrder S; S.init((M_), (N_), fresh_i(F.G), fresh_i(cid)); \
        pg8::EPI E{UNPAREN EINIT}; pg8::gemm_phase<pg8::EPI, pg8::StaticOrder, true>(ring, g, S, E); } while (0)
#define GEMM(...) GEMM_M(MT, __VA_ARGS__)
    LAS unsigned char* ring = F.lds;
    const int cid = (int)blockIdx.x;
    for (int l = 0; l < NL; ++l) {
        const int pb = l * PH_PER_LAYER;
        PHASE(0, { convert_weights(F, l); if (l == 0) norm_rows<true, false>(F, INP(7) + (size_t)fresh_i(l) * DM); else norm_rows<false, false>(F, INP(7) + (size_t)fresh_i(l) * DM); });
        PHASE(1, { GEMM(EpiProj, ((bf16_t*)WSP(WS_PROJ)), WS_XN, WS_WIN, ICP, DM, DM, DM, 0); });
        PHASE(2, { prep1_phase(F, l); });
        PHASE(3, { GEMM(EpiBf16, ((bf16_t*)WSP(WS_YA), PWD), WS_D, WS_POOLW, PWD, 256, PWD, 256, 256);
                   GEMM(EpiLora, ((float*)WSP(WS_DEC), (bf16_t*)WSP(WS_AA), (bf16_t*)WSP(WS_GG), INP(12) + (size_t)fresh_i(l) * RWD, INP(14) + (size_t)fresh_i(l) * RWD), WS_LIN, WS_LORA, 3072, LK, LK, LK, 0); });
        PHASE(4, { scan_phase(F, l); });
        PHASE(5, { post_phase(F, l); });
        PHASE(6, { GEMM_M(MPR, EpiGate1, ((bf16_t*)WSP(WS_TMP), (const bf16_t*)WSP(WS_PROJ), PC_GP), WS_YA, WS_PPOOL, DM, PWD, PWD, PWD, 0);
                   GEMM_M(MPR, EpiGate2, ((const bf16_t*)WSP(WS_TMP), (const bf16_t*)WSP(WS_PROJ), PC_GR, (bf16_t*)WSP(WS_MRG)), WS_YB, WS_PRWKV, DM, RWD, RWD, RWD, 0);
                   sample_tiles<0>(F, l); });
        PHASE(7, { GEMM_M(MPR, EpiResid, (F.out), WS_MRG, WS_WOUT, DM, DM, DM, DM, 0); sample_tiles<1>(F, l); });
        PHASE(8, { norm_rows<false, false>(F, INP(25) + (size_t)fresh_i(l) * DM); });
        PHASE(9, { GEMM(EpiSwiglu, ((bf16_t*)WSP(WS_HID)), WS_XN, WS_WGU, 2 * FF, DM, DM, DM, 0);
                   GEMM_M(MPR, EpiBf16, ((bf16_t*)WSP(WS_PP), DM), WS_PB, WS_WPP, DM, PLE, PLE, PLE, 0); sample_tiles<4>(F, l); });
        PHASE(10, { GEMM_M(MPR, EpiResid, (F.out), WS_HID, WS_WDN, DM, FF, FF, FF, 0); sample_tiles<2>(F, l); });
        PHASE(11, { norm_rows<false, false>(F, INP(29) + (size_t)fresh_i(l) * DM); });
        PHASE(12, { GEMM_M(MPR, EpiPle, (F.out, (const bf16_t*)WSP(WS_PP)), WS_XN, WS_WPG, DM, DM, DM, DM, 0); sample_tiles<3>(F, l); });
    }
    if (IN(NL * PH_PER_LAYER)) norm_rows<false, true>(F, INP(32));
#undef IN
#undef REP
#undef PHASE
#undef WSP
#undef GEMM
#undef GEMM_M
#undef UNPAREN
}

extern "C" void kernel_launch(void* const* d_in, const int* in_sizes, int n_in, void* d_out, int out_size, void* d_ws, size_t ws_size, hipStream_t stream) {
    static int grid = 0;
    if (grid == 0) {
        if (n_in != 33 || in_sizes[0] != MPR * DM || out_size != (int)O_END || ws_size < WS_END) {
            fprintf(stderr, "kernel_launch: unexpected shapes: n_in %d in0 %d out %d ws %zu (need %zu); nothing launched\n", n_in, n_in > 0 ? in_sizes[0] : -1, out_size, ws_size, (size_t)WS_END); grid = -1; return; }
        int dev = 0, cus = 0, per_cu = 0;
        if (hipGetDevice(&dev) != hipSuccess || hipDeviceGetAttribute(&cus, hipDeviceAttributeMultiprocessorCount, dev) != hipSuccess) { grid = -1; return; }
        if (hipFuncSetAttribute((const void*)mega_fwd, hipFuncAttributeMaxDynamicSharedMemorySize, LDS_BYTES) != hipSuccess) { fprintf(stderr, "kernel_launch: hipFuncSetAttribute failed\n"); grid = -1; return; }
        if (hipOccupancyMaxActiveBlocksPerMultiprocessor(&per_cu, (const void*)mega_fwd, NTHR, LDS_BYTES) != hipSuccess || per_cu < 1) { fprintf(stderr, "kernel_launch: occupancy query says %d\n", per_cu); (void)hipGetLastError(); grid = -1; return; }
        grid = cus;
    }
    if (grid < 0) return;
    (void)hipMemsetAsync((char*)d_ws + WS_CTL, 0, CTL_ZERO_BYTES, stream);
    Args a; memset(&a, 0, sizeof(a));
    for (int i = 0; i < 33; ++i) a.in[i] = (const float*)d_in[i];
    a.out = (float*)d_out; a.ws = (unsigned char*)d_ws;
#if MK_PER_PHASE
    for (int p = 0; p < N_PHASES; ++p) { a.ph_lo = p; a.ph_hi = p + 1; hipLaunchKernelGGL(mega_fwd, dim3(grid), dim3(NTHR), LDS_BYTES, stream, a); }
#else
    a.ph_lo = 0; a.ph_hi = N_PHASES; hipLaunchKernelGGL(mega_fwd, dim3(grid), dim3(NTHR), LDS_BYTES, stream, a);
#endif
}
```

```cpp
#include <hip/hip_runtime.h>
#include <cstdio>
#include <cstdint>
#include <cstring>

#ifndef MK_PER_PHASE
#define MK_PER_PHASE 0
#endif

#define LAS __attribute__((address_space(3)))
typedef unsigned short bf16_t;
typedef short bf16x8 __attribute__((ext_vector_type(8)));
typedef float f32x4 __attribute__((ext_vector_type(4)));
typedef float f32x2 __attribute__((ext_vector_type(2)));
typedef unsigned u32x4 __attribute__((ext_vector_type(4)));
typedef unsigned u32x2 __attribute__((ext_vector_type(2)));

constexpr int DM = 2048, NL = 4, MT = 16896, MPR = 16384, TP = 2048, TS = 64;
constexpr int PWD = 1024, RWD = 1024, RPJ = 3360, ICOLS = 8480, ICP = 8704, FF = 5632, PLE = 256, LK = 384;
constexpr int PC_GP = 4608, PC_GR = 6656;
constexpr float NORM_EPS = 1e-6f, GN_EPS = 64e-5f;
constexpr size_t O_YS = 33554432, O_SHP = 34603008, O_POP = 34710528, O_WKP = 35202048, O_SHS = 37299200, O_POS = 37406720, O_WKS = 37898240, O_END = 39995392;

__device__ __forceinline__ unsigned cvt_pk_bf16(float lo, float hi) { unsigned r; asm volatile("v_cvt_pk_bf16_f32 %0, %1, %2" : "=v"(r) : "v"(lo), "v"(hi)); return r; }
__device__ __forceinline__ float bf_lo(unsigned u) { return __uint_as_float(u << 16); }
__device__ __forceinline__ float bf_hi(unsigned u) { return __uint_as_float(u & 0xffff0000u); }
__device__ __forceinline__ void unpack8(const u32x4 w, float (&f)[8]) { f[0] = bf_lo(w.x); f[1] = bf_hi(w.x); f[2] = bf_lo(w.y); f[3] = bf_hi(w.y); f[4] = bf_lo(w.z); f[5] = bf_hi(w.z); f[6] = bf_lo(w.w); f[7] = bf_hi(w.w); }
__device__ __forceinline__ u32x4 pack8(const float (&f)[8]) { u32x4 w; w.x = cvt_pk_bf16(f[0], f[1]); w.y = cvt_pk_bf16(f[2], f[3]); w.z = cvt_pk_bf16(f[4], f[5]); w.w = cvt_pk_bf16(f[6], f[7]); return w; }
__device__ __forceinline__ float sigmoidf_(float x) { return __builtin_amdgcn_rcpf(1.0f + __expf(-x)); }
__device__ __forceinline__ f32x4 sigmoid4(f32x4 v) { f32x4 o; o.x = sigmoidf_(v.x); o.y = sigmoidf_(v.y); o.z = sigmoidf_(v.z); o.w = sigmoidf_(v.w); return o; }
__device__ __forceinline__ float tanhf_(float x) { const float e = __expf(2.0f * x); return 1.0f - 2.0f * __builtin_amdgcn_rcpf(e + 1.0f); }
template <int CTRL> __device__ __forceinline__ float dpp_f(float x) { return __uint_as_float((unsigned)__builtin_amdgcn_update_dpp(0, (int)__float_as_uint(x), CTRL, 0xF, 0xF, true)); }
__device__ __forceinline__ float sum8(float x) { x += dpp_f<0xB1>(x); x += dpp_f<0x4E>(x); x += dpp_f<0x141>(x); return x; }
__device__ __forceinline__ float wave_sum(float x) {
    x += dpp_f<0xB1>(x); x += dpp_f<0x4E>(x); x += dpp_f<0x141>(x); x += dpp_f<0x140>(x);
    x += __uint_as_float((unsigned)__builtin_amdgcn_ds_swizzle((int)__float_as_uint(x), 0x401F));
    return __uint_as_float((unsigned)__builtin_amdgcn_readlane((int)__float_as_uint(x), 0)) + __uint_as_float((unsigned)__builtin_amdgcn_readlane((int)__float_as_uint(x), 32));
}

namespace pg8 {
typedef unsigned ss_t;
constexpr int BM = 256, BK = 64, HALF = 128, HTB = HALF * BK * 2  , STAGE_BYTES = 8 * HTB, NXCD = 8, WGM = 8;
__host__ __device__ __forceinline__ int lds_byte(int r, int c) { const int st = (r >> 4) * 2 + (c >> 5), rr = r & 15, cc = c & 31, ob = rr * 64 + cc * 2; return st * 1024 + (ob ^ (((ob >> 9) & 1) << 5)); }
__host__ __device__ __forceinline__ void stage_rc(int b, int& R, int& C) { const int st = b / 1024, sb = b % 1024, swz = sb ^ (((sb >> 9) & 1) << 5); R = (st >> 1) * 16 + swz / 64; C = (st & 1) * 32 + (swz % 64) / 2; }
__host__ __device__ __forceinline__ int perm32(int rho) { const int n = rho >> 4, i = rho & 15; return 8 * (i >> 2) + 4 * n + (i & 3); }

struct Unit { int pm, pn; };
struct Gemm { const bf16_t* A; const bf16_t* Bt; int M, N, K, lda, ldb, a_pn_off; };

struct StaticOrder {
    int nM, nN, nwg, G, c;
    __host__ __device__ void init(int M, int N, int G_, int c_) { nM = M / BM; nN = N / BM; nwg = nM * nN; G = G_; c = c_; }
    __host__ __device__ bool next(int i, Unit& u) const {
        const long L = (long)i * G + c; if (L >= nwg) return false;
        int wgid = (int)L; { const int q = nwg / NXCD, r = nwg % NXCD, xcd = wgid % NXCD, off = wgid / NXCD; wgid = (xcd < r ? xcd * (q + 1) : r * (q + 1) + (xcd - r) * q) + off; }
        const int nig = WGM * nN, gid = wgid / nig, fm = gid * WGM, gsz = (nM - fm) < WGM ? (nM - fm) : WGM;
        u.pm = fm + ((wgid % nig) % gsz); u.pn = (wgid % nig) / gsz; return true;
    }
    __device__ __forceinline__ void a_ready(const Unit&) const {}
    __device__ __forceinline__ void done(const Unit&) const {}
};

__device__ __forceinline__ void acc_zero(f32x4 (&acc)[2][2][4][2]) {
#pragma unroll
    for (int a = 0; a < 2; ++a)
#pragma unroll
        for (int b = 0; b < 2; ++b)
#pragma unroll
            for (int m = 0; m < 4; ++m)
#pragma unroll
                for (int n = 0; n < 2; ++n) acc[a][b][m][n] = (f32x4){0.f, 0.f, 0.f, 0.f};
}
struct RepeatOrder : StaticOrder {
    __host__ __device__ bool next(int i, Unit& u) const { if (i >= 6) return false; return StaticOrder::next(i % 3, u) || StaticOrder::next(0, u); }
};
#define EPI_ZERO_INIT __device__ __forceinline__ void init(f32x4 (&acc)[2][2][4][2], const Unit&, int, int, int, int) const { acc_zero(acc); }
#define EPI_NO_PRE __device__ __forceinline__ void preload(ss_t (&pre)[2], const Unit&, int, int, int) const {}
#define EPI_SS_PRE(SSPTR) __device__ __forceinline__ void preload(ss_t (&pre)[2], const Unit& u, int wr, int fr, int fq) const { _Pragma("unroll") for (int j = 0; j < 2; ++j) { const int g = 2 * fq + j; \
        pre[j] = (SSPTR)[(size_t)(u.pm * BM + (g >> 2) * HALF + wr * 64 + (g & 3) * 16 + fr)]; } }
__device__ __forceinline__ ss_t pre_get(const ss_t (&pre)[2], int g, int fr) { return (ss_t)__builtin_amdgcn_ds_bpermute((((g >> 1) << 4) + fr) << 2, (int)pre[g & 1]); }
template <class Epi, class Sched, bool ALIGN_EPI>
__device__ __forceinline__ void gemm_phase(LAS unsigned char* lds, const Gemm g, const Sched& S, const Epi& E) {
    int tid_ = threadIdx.x; asm volatile("" : "+v"(tid_));
    const int tid = tid_, wid = __builtin_amdgcn_readfirstlane(tid >> 6), lane = tid & 63, wr = wid >> 2, wc = wid & 3, fr = lane & 15, fq = lane >> 4;
    int K_ = g.K; asm volatile("" : "+s"(K_));
    const int K = K_, nt = K / BK;
    unsigned voffA[2], voffB[2];
#pragma unroll
    for (int i = 0; i < 2; ++i) { int R, C; stage_rc(tid * 16 + i * 8192, R, C); const int Rb = Epi::PERM ? (64 * (R >> 5) + perm32(R & 31)) : R;
        voffA[i] = (unsigned)(R * g.lda + C) * 2u; voffB[i] = (unsigned)(Rb * g.ldb + C) * 2u; }
    const size_t kstep = (size_t)(BK * 2);
    const size_t hstepA = (size_t)HALF * g.lda * 2, hstepB = (size_t)(Epi::PERM ? 32 : HALF) * g.ldb * 2;
    const unsigned ldsw = (unsigned)wid * 1024u;
    const int aoff = lds_byte(wr * 64 + fr, fq * 8), boff = lds_byte(wc * 32 + fr, fq * 8);
#define PG8_SA(b, h) (((b) * 2 + (h)) * HTB)
#define PG8_SB(b, h) ((4 + (b) * 2 + (h)) * HTB)
#define PG8_STAGE(bufoff, gbase, voff) do { _Pragma("unroll") for (int _i = 0; _i < 2; ++_i) \
        __builtin_amdgcn_global_load_lds((const unsigned*)((const char*)(gbase) + (voff)[_i]), (LAS unsigned*)(lds + (bufoff) + ldsw + _i * 8192), 16, 0, 0); } while (0)
#define PG8_LDA(dst, b, h) do { _Pragma("unroll") for (int m = 0; m < 4; ++m) _Pragma("unroll") for (int k = 0; k < 2; ++k) dst[m][k] = *(const LAS bf16x8*)(lds + PG8_SA(b, h) + aoff + m * 2048 + k * 1024); } while (0)
#define PG8_LDB(dst, b, h) do { _Pragma("unroll") for (int n = 0; n < 2; ++n) _Pragma("unroll") for (int k = 0; k < 2; ++k) dst[n][k] = *(const LAS bf16x8*)(lds + PG8_SB(b, h) + boff + n * 2048 + k * 1024); } while (0)
#define PG8_MMA(ai, bj, At, Bt) do { __builtin_amdgcn_s_setprio(1); _Pragma("unroll") for (int m = 0; m < 4; ++m) _Pragma("unroll") for (int n = 0; n < 2; ++n) _Pragma("unroll") for (int k = 0; k < 2; ++k) \
        acc[ai][bj][m][n] = __builtin_amdgcn_mfma_f32_16x16x32_bf16(Bt[n][k], At[m][k], acc[ai][bj][m][n], 0, 0, 0); __builtin_amdgcn_s_setprio(0); } while (0)
#define PG8_WAIT_V(n) asm volatile("s_waitcnt vmcnt(" #n ")" ::: "memory")
#define PG8_WAIT_L(n) asm volatile("s_waitcnt lgkmcnt(" #n ")" ::: "memory")
#define PG8_BAR __builtin_amdgcn_s_barrier()
#define PG8_SCHED __builtin_amdgcn_sched_barrier(0)
    Unit cur, nxt; int ui = 0;
    if (!S.next(0, cur)) return;
    f32x4 acc[2][2][4][2]; ss_t pre[2];
    E.init(acc, cur, wr, wc, fr, fq); E.preload(pre, cur, wr, fr, fq);
    bf16x8 At[4][2], B0[2][2], B1[2][2];
    const char* cA = (const char*)g.A + ((size_t)cur.pm * BM * g.lda + (size_t)cur.pn * g.a_pn_off) * 2; const char* cB = (const char*)g.Bt + (size_t)cur.pn * BM * g.ldb * 2;
    S.a_ready(cur);
    PG8_STAGE(PG8_SB(0, 0), cB, voffB); PG8_STAGE(PG8_SB(0, 1), cB + hstepB, voffB); PG8_STAGE(PG8_SA(0, 0), cA, voffA); PG8_STAGE(PG8_SA(0, 1), cA + hstepA, voffA);
    if (wr == 1) PG8_BAR;
    PG8_WAIT_V(2); PG8_BAR;
    PG8_STAGE(PG8_SB(1, 0), cB + kstep, voffB); PG8_STAGE(PG8_SA(1, 0), cA + kstep, voffA); PG8_STAGE(PG8_SB(1, 1), cB + hstepB + kstep, voffB);
    PG8_WAIT_V(6); PG8_BAR;
    for (;;) {
        const bool has_next = S.next(ui + 1, nxt);
        const char* nA = has_next ? (const char*)g.A + ((size_t)nxt.pm * BM * g.lda + (size_t)nxt.pn * g.a_pn_off) * 2 : cA; const char* nB = has_next ? (const char*)g.Bt + (size_t)nxt.pn * BM * g.ldb * 2 : cB;
#pragma unroll 1
        for (int t = 0; t < nt; t += 2) {
            const bool last = (t == nt - 2);
            const char* a1 = cA + (size_t)(t + 1) * kstep;
            const char* a2 = last ? nA : cA + (size_t)(t + 2) * kstep; const char* b2 = last ? nB : cB + (size_t)(t + 2) * kstep;
            const char* a3 = a2 + kstep; const char* b3 = b2 + kstep;
            if (last && has_next) S.a_ready(nxt);
            PG8_LDB(B0, 0, 0); PG8_LDB(B1, 0, 1); PG8_SCHED; PG8_LDA(At, 0, 0); PG8_STAGE(PG8_SA(1, 1), a1 + hstepA, voffA);
            PG8_WAIT_V(8); PG8_WAIT_L(0); PG8_BAR; PG8_MMA(0, 0, At, B0); PG8_MMA(0, 1, At, B1); PG8_BAR; PG8_SCHED;
            PG8_LDA(At, 0, 1); PG8_STAGE(PG8_SB(0, 0), b2, voffB); PG8_STAGE(PG8_SB(0, 1), b2 + hstepB, voffB); PG8_STAGE(PG8_SA(0, 0), a2, voffA);
            PG8_WAIT_V(8); PG8_WAIT_L(0); PG8_BAR; PG8_MMA(1, 0, At, B0); PG8_MMA(1, 1, At, B1); PG8_BAR; PG8_SCHED;
            PG8_LDB(B0, 1, 0); PG8_LDB(B1, 1, 1); PG8_SCHED; PG8_LDA(At, 1, 0); PG8_STAGE(PG8_SA(0, 1), a2 + hstepA, voffA);
            PG8_WAIT_V(8); PG8_WAIT_L(0); PG8_BAR; PG8_MMA(0, 0, At, B0); PG8_MMA(0, 1, At, B1); PG8_BAR; PG8_SCHED;
            PG8_LDA(At, 1, 1); PG8_STAGE(PG8_SB(1, 0), b3, voffB); PG8_STAGE(PG8_SB(1, 1), b3 + hstepB, voffB); PG8_STAGE(PG8_SA(1, 0), a3, voffA);
            PG8_WAIT_V(8); PG8_WAIT_L(0); PG8_BAR; PG8_MMA(1, 0, At, B0); PG8_MMA(1, 1, At, B1); PG8_BAR; PG8_SCHED;
        }
        if constexpr (ALIGN_EPI) { if (wr == 0) PG8_BAR; }
        E(acc, pre, cur, wr, wc, fr, fq); S.done(cur);
        if (!has_next) break;
        E.init(acc, nxt, wr, wc, fr, fq); E.preload(pre, nxt, wr, fr, fq);
        cur = nxt; cA = nA; cB = nB; ++ui;
        if constexpr (ALIGN_EPI) { if (wr == 1) PG8_BAR; }
    }
    PG8_WAIT_V(0);
    if constexpr (!ALIGN_EPI) { if (wr == 0) PG8_BAR; }
    PG8_BAR;
#undef PG8_SA
#undef PG8_SB
#undef PG8_STAGE
#undef PG8_LDA
#undef PG8_LDB
#undef PG8_MMA
#undef PG8_WAIT_V
#undef PG8_WAIT_L
#undef PG8_BAR
#undef PG8_SCHED
}

#define EPI_ROW0 (u.pm * BM + wr * 64 + fr)
#define EPI_FOR_AI_M _Pragma("unroll") for (int ai = 0; ai < 2; ++ai) _Pragma("unroll") for (int m = 0; m < 4; ++m)
__device__ __forceinline__ u32x4 pack_f4x2(f32x4 v0, f32x4 v1) { u32x4 w; w.x = cvt_pk_bf16(v0[0], v0[1]); w.y = cvt_pk_bf16(v0[2], v0[3]); w.z = cvt_pk_bf16(v1[0], v1[1]); w.w = cvt_pk_bf16(v1[2], v1[3]); return w; }
__device__ __forceinline__ void unpack_f4x2(u32x4 w, f32x4& v0, f32x4& v1) { v0[0] = bf_lo(w.x); v0[1] = bf_hi(w.x); v0[2] = bf_lo(w.y); v0[3] = bf_hi(w.y); v1[0] = bf_lo(w.z); v1[1] = bf_hi(w.z); v1[2] = bf_lo(w.w); v1[3] = bf_hi(w.w); }
__device__ __forceinline__ unsigned ror8(unsigned x) { return (unsigned)__builtin_amdgcn_update_dpp(0, (int)x, 0x128, 0xF, 0xF, true); }
__device__ __forceinline__ void st_pair(char* grp, size_t pitch, int fr, int fq, u32x4 vA, u32x4 vB) {
    const bool lo = fr < 8;
    u32x4 snd = lo ? vB : vA, rcv; rcv.x = ror8(snd.x); rcv.y = ror8(snd.y); rcv.z = ror8(snd.z); rcv.w = ror8(snd.w);
    char* p = grp + (size_t)(fr & 7) * pitch + (lo ? 0 : 64) + fq * 16;
    *(u32x4*)p = lo ? vA : rcv;
    *(u32x4*)(p + 8 * pitch) = lo ? rcv : vB;
}
__device__ __forceinline__ u32x4 as_u4(f32x4 v) { return __builtin_bit_cast(u32x4, v); }

__device__ __forceinline__ float rstd_raw(ss_t v) { return __builtin_amdgcn_rsqf((float)v * (1.0f / (256.0f * DM)) + NORM_EPS); }
__device__ __forceinline__ float rstd_of(const ss_t* SS, size_t row) { return rstd_raw(SS[row]); }
__device__ __forceinline__ ss_t ss_fix(float s) { return (ss_t)(s * 256.0f + 0.5f); }
__device__ __forceinline__ float sq8(f32x4 a, f32x4 b) { return (a.x * a.x + a.y * a.y) + (a.z * a.z + a.w * a.w) + (b.x * b.x + b.y * b.y) + (b.z * b.z + b.w * b.w); }
__device__ __forceinline__ void ss_add(ss_t* SS, size_t row, float s, int fq, int fr) { s += __uint_as_float((unsigned)__builtin_amdgcn_ds_swizzle((int)__float_as_uint(s), 0x401F));
    s += __uint_as_float((unsigned)__builtin_amdgcn_ds_bpermute((((fq ^ 2) << 4) + fr) << 2, (int)__float_as_uint(s)));
    if (fq == 0) __hip_atomic_fetch_add(SS + row, ss_fix(s), __ATOMIC_RELAXED, __HIP_MEMORY_SCOPE_AGENT); }
struct EpiNull { static constexpr bool PERM = true; EPI_NO_PRE EPI_ZERO_INIT __device__ __forceinline__ void operator()(const f32x4 (&acc)[2][2][4][2], const ss_t (&pre)[2], const Unit& u, int wr, int wc, int fr, int fq) const {
#pragma unroll
    for (int a = 0; a < 2; ++a)
#pragma unroll
        for (int b = 0; b < 2; ++b)
#pragma unroll
            for (int m = 0; m < 4; ++m)
#pragma unroll
                for (int n = 0; n < 2; ++n) asm volatile("" :: "v"(acc[a][b][m][n]));
} };
struct EpiProj { static constexpr bool PERM = true; EPI_ZERO_INIT
    bf16_t* O; const ss_t* SS; EPI_SS_PRE(SS)
    __device__ __forceinline__ void operator()(const f32x4 (&acc)[2][2][4][2], const ss_t (&pre)[2], const Unit& u, int wr, int wc, int fr, int fq) const {
        const bool sg = u.pn >= 18;
        EPI_FOR_AI_M { const size_t r0 = (size_t)(u.pm * BM + ai * HALF + wr * 64 + m * 16); char* grp = (char*)(O + r0 * ICP + u.pn * BM + 64 * wc); const float rs = rstd_raw(pre_get(pre, ai * 4 + m, fr));
            f32x4 a0 = acc[ai][0][m][0] * rs, a1 = acc[ai][0][m][1] * rs, b0 = acc[ai][1][m][0] * rs, b1 = acc[ai][1][m][1] * rs;
            if (sg) { a0 = sigmoid4(a0); a1 = sigmoid4(a1); b0 = sigmoid4(b0); b1 = sigmoid4(b1); }
            st_pair(grp, (size_t)ICP * 2, fr, fq, pack_f4x2(a0, a1), pack_f4x2(b0, b1)); }
    }
};
struct EpiBf16 { static constexpr bool PERM = true; EPI_NO_PRE EPI_ZERO_INIT
    bf16_t* O; int ldc;
    __device__ __forceinline__ void operator()(const f32x4 (&acc)[2][2][4][2], const ss_t (&pre)[2], const Unit& u, int wr, int wc, int fr, int fq) const {
        EPI_FOR_AI_M { char* grp = (char*)(O + (size_t)(u.pm * BM + ai * HALF + wr * 64 + m * 16) * ldc + u.pn * BM + 64 * wc);
            st_pair(grp, (size_t)ldc * 2, fr, fq, pack_f4x2(acc[ai][0][m][0], acc[ai][0][m][1]), pack_f4x2(acc[ai][1][m][0], acc[ai][1][m][1])); }
    }
};
struct EpiLora { static constexpr bool PERM = true; EPI_NO_PRE EPI_ZERO_INIT
    float* DEC; bf16_t* AA; bf16_t* GG; const float* w0; const float* a0;
    __device__ __forceinline__ void operator()(const f32x4 (&acc)[2][2][4][2], const ss_t (&pre)[2], const Unit& u, int wr, int wc, int fr, int fq) const {
        const int row0 = EPI_ROW0, kind = u.pn >> 2, ct = (u.pn & 3) * BM + 64 * wc, col0 = ct + 8 * fq;
        if (kind == 0) {
            EPI_FOR_AI_M { float* rowp = DEC + (size_t)(row0 + ai * HALF + m * 16) * RWD + col0;
#pragma unroll
                for (int bj = 0; bj < 2; ++bj)
#pragma unroll
                    for (int n = 0; n < 2; ++n) { const f32x4 b = *(const f32x4*)(w0 + col0 + bj * 32 + 4 * n); const f32x4 x = acc[ai][bj][m][n] + b; f32x4 o;
#pragma unroll
                        for (int j = 0; j < 4; ++j) { const float z = -x[j]; const float sp = z > 15.f ? z : __logf(1.0f + __expf(z)); const float w = -sp - 0.5f; o[j] = __expf(-__expf(w)); }
                        *(f32x4*)(rowp + bj * 32 + 4 * n) = o; } asm volatile("" ::: "memory"); }
        } else if (kind == 1) {
            const f32x4 b00 = *(const f32x4*)(a0 + col0), b01 = *(const f32x4*)(a0 + col0 + 4), b10 = *(const f32x4*)(a0 + col0 + 32), b11 = *(const f32x4*)(a0 + col0 + 36);
            EPI_FOR_AI_M { char* grp = (char*)(AA + (size_t)(u.pm * BM + ai * HALF + wr * 64 + m * 16) * RWD + ct);
                st_pair(grp, (size_t)RWD * 2, fr, fq, pack_f4x2(sigmoid4(acc[ai][0][m][0] + b00), sigmoid4(acc[ai][0][m][1] + b01)), pack_f4x2(sigmoid4(acc[ai][1][m][0] + b10), sigmoid4(acc[ai][1][m][1] + b11))); }
        } else {
            EPI_FOR_AI_M { char* grp = (char*)(GG + (size_t)(u.pm * BM + ai * HALF + wr * 64 + m * 16) * RWD + ct);
                st_pair(grp, (size_t)RWD * 2, fr, fq, pack_f4x2(acc[ai][0][m][0], acc[ai][0][m][1]), pack_f4x2(acc[ai][1][m][0], acc[ai][1][m][1])); }
        }
    }
};
struct EpiGate1 { static constexpr bool PERM = true; EPI_NO_PRE EPI_ZERO_INIT
    bf16_t* TMP; const bf16_t* PROJ; int gcol0;
    __device__ __forceinline__ void operator()(const f32x4 (&acc)[2][2][4][2], const ss_t (&pre)[2], const Unit& u, int wr, int wc, int fr, int fq) const {
        const int row0 = EPI_ROW0, ct = u.pn * BM + 64 * wc, col0 = ct + 8 * fq;
        EPI_FOR_AI_M { const size_t row = (size_t)(row0 + ai * HALF + m * 16);
            f32x4 g00, g01, g10, g11; unpack_f4x2(*(const u32x4*)(PROJ + row * ICP + gcol0 + col0), g00, g01); unpack_f4x2(*(const u32x4*)(PROJ + row * ICP + gcol0 + col0 + 32), g10, g11);
            st_pair((char*)(TMP + (size_t)(u.pm * BM + ai * HALF + wr * 64 + m * 16) * DM + ct), (size_t)DM * 2, fr, fq, pack_f4x2(acc[ai][0][m][0] * g00, acc[ai][0][m][1] * g01), pack_f4x2(acc[ai][1][m][0] * g10, acc[ai][1][m][1] * g11));
            if (m & 1) asm volatile("" ::: "memory"); }
    }
};
struct EpiGate2 { static constexpr bool PERM = true; EPI_NO_PRE EPI_ZERO_INIT
    const bf16_t* TMP; const bf16_t* PROJ; int gcol0; bf16_t* O;
    __device__ __forceinline__ void operator()(const f32x4 (&acc)[2][2][4][2], const ss_t (&pre)[2], const Unit& u, int wr, int wc, int fr, int fq) const {
        const int row0 = EPI_ROW0, ct = u.pn * BM + 64 * wc, col0 = ct + 8 * fq;
        EPI_FOR_AI_M { const size_t row = (size_t)(row0 + ai * HALF + m * 16);
            f32x4 g00, g01, g10, g11, t00, t01, t10, t11; unpack_f4x2(*(const u32x4*)(PROJ + row * ICP + gcol0 + col0), g00, g01); unpack_f4x2(*(const u32x4*)(PROJ + row * ICP + gcol0 + col0 + 32), g10, g11);
            unpack_f4x2(*(const u32x4*)(TMP + row * DM + col0), t00, t01); unpack_f4x2(*(const u32x4*)(TMP + row * DM + col0 + 32), t10, t11);
            st_pair((char*)(O + (size_t)(u.pm * BM + ai * HALF + wr * 64 + m * 16) * DM + ct), (size_t)DM * 2, fr, fq, pack_f4x2(t00 + acc[ai][0][m][0] * g00, t01 + acc[ai][0][m][1] * g01), pack_f4x2(t10 + acc[ai][1][m][0] * g10, t11 + acc[ai][1][m][1] * g11));
            if (m & 1) asm volatile("" ::: "memory"); }
    }
};
struct EpiResid { static constexpr bool PERM = true; EPI_NO_PRE
    bf16_t* XB; ss_t* SS;
    __device__ __forceinline__ void init(f32x4 (&acc)[2][2][4][2], const Unit& u, int wr, int wc, int fr, int fq) const {
        const int row0 = EPI_ROW0, col0 = u.pn * BM + 64 * wc + 8 * fq;
        EPI_FOR_AI_M { const bf16_t* rowp = XB + (size_t)(row0 + ai * HALF + m * 16) * DM + col0;
            unpack_f4x2(*(const u32x4*)rowp, acc[ai][0][m][0], acc[ai][0][m][1]); unpack_f4x2(*(const u32x4*)(rowp + 32), acc[ai][1][m][0], acc[ai][1][m][1]); }
    }
    __device__ __forceinline__ void operator()(const f32x4 (&acc)[2][2][4][2], const ss_t (&pre)[2], const Unit& u, int wr, int wc, int fr, int fq) const {
        EPI_FOR_AI_M { const size_t r0 = (size_t)(u.pm * BM + ai * HALF + wr * 64 + m * 16);
            st_pair((char*)(XB + r0 * DM + u.pn * BM + 64 * wc), (size_t)DM * 2, fr, fq, pack_f4x2(acc[ai][0][m][0], acc[ai][0][m][1]), pack_f4x2(acc[ai][1][m][0], acc[ai][1][m][1]));
            ss_add(SS, r0 + fr, sq8(acc[ai][0][m][0], acc[ai][0][m][1]) + sq8(acc[ai][1][m][0], acc[ai][1][m][1]), fq, fr); }
    }
};
struct EpiSwiglu { static constexpr bool PERM = true; EPI_ZERO_INIT
    bf16_t* H; const ss_t* SS; EPI_SS_PRE(SS)
    __device__ __forceinline__ void operator()(const f32x4 (&acc)[2][2][4][2], const ss_t (&pre)[2], const Unit& u, int wr, int wc, int fr, int fq) const {
        const int row0 = EPI_ROW0, col0 = u.pn * HALF + wc * 32 + 8 * fq;
        EPI_FOR_AI_M { const size_t row = (size_t)(row0 + ai * HALF + m * 16); const float rs = rstd_raw(pre_get(pre, ai * 4 + m, fr));
            const f32x4 g0 = acc[ai][0][m][0] * rs, g1 = acc[ai][0][m][1] * rs, u0 = acc[ai][1][m][0] * rs, u1 = acc[ai][1][m][1] * rs;
            *(u32x4*)(H + row * FF + col0) = pack_f4x2(g0 * sigmoid4(g0) * u0, g1 * sigmoid4(g1) * u1); }
    }
};
struct EpiPle { static constexpr bool PERM = true; EPI_ZERO_INIT EPI_SS_PRE(SSi)
    const bf16_t* XB; bf16_t* XO; const bf16_t* PP; const ss_t* SSi; ss_t* SSo;
    __device__ __forceinline__ void operator()(const f32x4 (&acc)[2][2][4][2], const ss_t (&pre)[2], const Unit& u, int wr, int wc, int fr, int fq) const {
        const int col0 = u.pn * BM + 64 * wc + 8 * fq;
        EPI_FOR_AI_M { const size_t r0 = (size_t)(u.pm * BM + ai * HALF + wr * 64 + m * 16), row = r0 + fr; const float rs = rstd_raw(pre_get(pre, ai * 4 + m, fr));
            f32x4 x00, x01, x10, x11, p00, p01, p10, p11; unpack_f4x2(*(const u32x4*)(XB + row * DM + col0), x00, x01); unpack_f4x2(*(const u32x4*)(XB + row * DM + col0 + 32), x10, x11);
            unpack_f4x2(*(const u32x4*)(PP + row * DM + col0), p00, p01); unpack_f4x2(*(const u32x4*)(PP + row * DM + col0 + 32), p10, p11);
            x00 += sigmoid4(acc[ai][0][m][0] * rs) * p00; x01 += sigmoid4(acc[ai][0][m][1] * rs) * p01; x10 += sigmoid4(acc[ai][1][m][0] * rs) * p10; x11 += sigmoid4(acc[ai][1][m][1] * rs) * p11;
            st_pair((char*)(XO + r0 * DM + u.pn * BM + 64 * wc), (size_t)DM * 2, fr, fq, pack_f4x2(x00, x01), pack_f4x2(x10, x11));
            ss_add(SSo, row, sq8(x00, x01) + sq8(x10, x11), fq, fr);
            if (m & 1) asm volatile("" ::: "memory"); }
    }
};
#undef EPI_ROW0
#undef EPI_FOR_AI_M
}

constexpr size_t MiB = 1u << 20;
constexpr size_t al1m(size_t x) { return (x + MiB - 1) / MiB * MiB; }
constexpr size_t WS_CTL = 0, CTL_ZERO_BYTES = 1 * MiB;
constexpr size_t SZ_WIN = (size_t)ICP * DM * 2, SZ_POOLW = (size_t)PWD * 256 * 2, SZ_LORA = (size_t)3072 * LK * 2, SZ_PPOOL = (size_t)DM * PWD * 2, SZ_PRWKV = (size_t)DM * RWD * 2,
                 SZ_WOUT = (size_t)DM * DM * 2, SZ_WGU = (size_t)2 * FF * DM * 2, SZ_WDN = (size_t)DM * FF * 2, SZ_WPG = (size_t)DM * DM * 2, SZ_WPP = (size_t)DM * PLE * 2;
constexpr size_t WS_WIN = 1 * MiB, WS_POOLW = WS_WIN + SZ_WIN, WS_LORA = WS_POOLW + SZ_POOLW, WS_PPOOL = WS_LORA + SZ_LORA, WS_PRWKV = WS_PPOOL + SZ_PPOOL, WS_WOUT = WS_PRWKV + SZ_PRWKV,
                 WS_WGU = WS_WOUT + SZ_WOUT, WS_WDN = WS_WGU + SZ_WGU, WS_WPG = WS_WDN + SZ_WDN, WS_WPP = WS_WPG + SZ_WPG, WS_WEND = WS_WPP + SZ_WPP;
constexpr size_t WS_PB = al1m(WS_WEND);
constexpr size_t WS_XN = al1m(WS_PB + (size_t)MT * PLE * 2);
constexpr size_t WS_AA = al1m(WS_XN + (size_t)MT * DM * 2);
constexpr size_t WS_GG = al1m(WS_AA + (size_t)MT * RWD * 2);
constexpr size_t WS_PP = al1m(WS_GG + (size_t)MT * RWD * 2);
constexpr size_t WS_PROJ = al1m(WS_PP + (size_t)MT * DM * 2);
constexpr size_t WS_HID = WS_PROJ;
constexpr size_t WS_D = al1m(WS_PROJ + (size_t)MT * ICP * 2);
constexpr size_t WS_LIN = al1m(WS_D + (size_t)MT * PWD * 2);
constexpr size_t WS_YA = al1m(WS_LIN + (size_t)MT * LK * 2);
constexpr size_t WS_DEC = al1m(WS_YA + (size_t)MT * PWD * 2);
constexpr size_t WS_BS = al1m(WS_DEC + (size_t)MT * RWD * 4);
constexpr size_t WS_Y = al1m(WS_BS + (size_t)MT * 16 * 4);
constexpr size_t SZ_BH = (size_t)MT * RWD * 2;
constexpr size_t WS_YB = al1m(WS_Y + (size_t)MT * RWD * 4);
constexpr size_t WS_TMP = al1m(WS_YB + SZ_BH);
constexpr size_t WS_MRG = al1m(WS_TMP + (size_t)MT * DM * 4);
constexpr size_t WS_SS = al1m(WS_MRG + (size_t)MT * DM * 2);
constexpr size_t WS_END_OLD = al1m(WS_MRG + (size_t)MT * DM * 2);
static_assert((size_t)MT * FF * 2 <= (size_t)MT * ICP * 2, "HID overlay");

constexpr size_t WS_XB2 = al1m(WS_SS + (size_t)3 * MT * 4);
constexpr size_t WS_END = al1m(WS_XB2 + (size_t)MT * DM * 2);
constexpr int CW_BAR = 4096;
constexpr int NWAVES = 8, NTHR = 512;
constexpr int RING_BYTES = 131072, LDSCTL_OFF = RING_BYTES, LDS_BYTES = 147456;

#define XB_TMO      128
#define XB_XCNT(j)  (256  + 64 * (j))
#define XB_XSUB(j)  (1280 + 64 * (j))
#define XB_XGEN(j)  (2304 + 64 * (j))
#define XB_TOP      3328
#define XB_TOPGEN   3392
#define XCD_BAR_WORDS 3456
#define XB_SPIN_CAP (1u << 18)

__device__ __forceinline__ unsigned xb_ld(unsigned* p)              { return __hip_atomic_load(p, __ATOMIC_RELAXED, __HIP_MEMORY_SCOPE_AGENT); }
__device__ __forceinline__ unsigned xb_add(unsigned* p, unsigned v) { return __hip_atomic_fetch_add(p, v, __ATOMIC_RELAXED, __HIP_MEMORY_SCOPE_AGENT); }
__device__ __forceinline__ unsigned xb_xcc_id() { return (unsigned)__builtin_amdgcn_s_getreg((3 << 11) | 20) & 0xFu; }
#define XB_SPIN(cond, bar) do { unsigned _sp = 0; while (cond) { __builtin_amdgcn_s_sleep(1); \
    if ((++_sp & 255u) == 0u) { if (xb_ld(&(bar)[XB_TMO])) break; if (_sp > XB_SPIN_CAP) { atomicAdd(&(bar)[XB_TMO], 1u); break; } } } } while (0)

struct XcdBarrier {
    unsigned* bar; unsigned x;
    volatile LAS unsigned* st;
};

__device__ __forceinline__ XcdBarrier xcd_barrier_post(unsigned* bar, volatile LAS unsigned* st) {
    XcdBarrier b; b.bar = bar; b.x = xb_xcc_id(); b.st = st;
    if (threadIdx.x == 0) (void)xb_add(&bar[XB_XCNT(b.x)], 1u);
    return b;
}
__device__ __forceinline__ void xcd_barrier_complete(unsigned* bar, unsigned x, unsigned& nloc, unsigned& nx) {
    const unsigned G = gridDim.x * gridDim.y * gridDim.z;
    unsigned sum, cnt, mine, sp = 0u;
    for (;;) {
        sum = 0u; cnt = 0u; mine = 0u;
#pragma unroll
        for (unsigned j = 0; j < 16; ++j) { const unsigned c = xb_ld(&bar[XB_XCNT(j)]); sum += c; cnt += (c > 0u) ? 1u : 0u; mine = (j == x) ? c : mine; }
        if (sum == G) break;
        __builtin_amdgcn_s_sleep(1);
        if ((++sp & 255u) == 0u) { if (xb_ld(&bar[XB_TMO])) break; if (sp > XB_SPIN_CAP) { atomicAdd(&bar[XB_TMO], 1u); break; } }
    }
    nloc = mine > 0u ? mine : 1u; nx = cnt > 0u ? cnt : 1u;
}

__device__ __forceinline__ void xcd_barrier(const XcdBarrier& b) {
    asm volatile("s_waitcnt vmcnt(0)" ::: "memory");
    __syncthreads();
    if (threadIdx.x == 0) {
        unsigned* bar = b.bar;
        __builtin_amdgcn_s_waitcnt(0);
        unsigned nloc = b.st[0], nx = b.st[1];
        if (nloc == 0u) { xcd_barrier_complete(bar, b.x, nloc, nx); b.st[0] = nloc; b.st[1] = nx; }
        const unsigned old = xb_add(&bar[XB_XSUB(b.x)], 1u);
        const unsigned gen = old / nloc;
        if (old + 1u == (gen + 1u) * nloc) {
            __builtin_amdgcn_fence(__ATOMIC_RELEASE, "agent");
            asm volatile("s_waitcnt vmcnt(0)" ::: "memory");
            const unsigned og = xb_add(&bar[XB_TOP], 1u);
            const unsigned tg = og / nx;
            if (og + 1u == (tg + 1u) * nx) xb_add(&bar[XB_TOPGEN], 1u);
            else XB_SPIN(xb_ld(&bar[XB_TOPGEN]) == tg, bar);
            __builtin_amdgcn_fence(__ATOMIC_ACQUIRE, "agent");
            xb_add(&bar[XB_XGEN(b.x)], 1u);
            asm volatile("s_waitcnt vmcnt(0)" ::: "memory");
        } else {
            XB_SPIN(xb_ld(&bar[XB_XGEN(b.x)]) == gen, bar);
            __builtin_amdgcn_fence(__ATOMIC_ACQUIRE, "agent");
            asm volatile("s_waitcnt vmcnt(0)" ::: "memory");
        }
    }
    __syncthreads();
}


struct Args {
    const float* in[33]; float* out; unsigned char* ws; int ph_lo, ph_hi;
};
struct Frame {
    LAS unsigned char* lds; int G;
    const LAS unsigned long long* ptab; float* out; unsigned char* ws;
};
#define GAS __attribute__((address_space(1)))
__device__ __forceinline__ const float* ldptr(const LAS unsigned long long* tab, int k) { const unsigned long long v = tab[k]; const unsigned lo = __builtin_amdgcn_readfirstlane((unsigned)v), hi = __builtin_amdgcn_readfirstlane((unsigned)(v >> 32));
    return (const float*)(const GAS float*)(((unsigned long long)hi << 32) | lo); }
__device__ __forceinline__ unsigned char* fresh(unsigned char* p) { GAS unsigned char* q = (GAS unsigned char*)p; asm volatile("" : "+s"(q)); return (unsigned char*)q; }
__device__ __forceinline__ int fresh_i(int v) { asm volatile("" : "+s"(v)); return v; }
#define INP(k) ldptr(F.ptab, (k))
#define PHASE_L const int l = fresh_i(l_in); (void)l;
#define PHASE_IDS int tid_ = threadIdx.x; asm volatile("" : "+v"(tid_)); const int tid = tid_, lane = tid & 63, wave = __builtin_amdgcn_readfirstlane(tid >> 6), gtid = blockIdx.x * NTHR + tid, gw = blockIdx.x * NWAVES + wave; (void)lane; (void)wave; (void)gtid; (void)gw;
#define VM_WAIT() asm volatile("s_waitcnt vmcnt(0)" ::: "memory")
#define LDS_WAIT() asm volatile("s_waitcnt lgkmcnt(0)" ::: "memory")
constexpr int NT_ALL_SHIFT = 9;

__device__ __forceinline__ void row_info(int m, int& b, int& t, bool& samp) { samp = m >= MPR; if (samp) { b = (m - MPR) >> 6; t = (m - MPR) & 63; } else { b = m >> 11; t = m & 2047; } }

__device__ __forceinline__ void transpose_item(const float* W, int N, bf16_t* WT, int ldk, int k0, int n0, int drow0, LAS float* scr, int lane, const float* cscale = nullptr, const float* rscale = nullptr) {
    const float cs = cscale ? cscale[n0 + (lane & 31)] : 1.0f;
#pragma unroll 8
    for (int i = 0; i < 32; ++i) { const int kk = 2 * i + (lane >> 5); scr[kk * 33 + (lane & 31)] = W[(size_t)(k0 + kk) * N + n0 + (lane & 31)] * (rscale ? cs * rscale[k0 + kk] : cs); }
    LDS_WAIT(); asm volatile("" ::: "memory");
    const int c = lane & 7;
#pragma unroll
    for (int j = 0; j < 4; ++j) { const int n = (lane >> 3) + 8 * j; const LAS float* s = scr + (8 * c) * 33 + n;
        u32x4 o; o.x = cvt_pk_bf16(s[0 * 33], s[1 * 33]); o.y = cvt_pk_bf16(s[2 * 33], s[3 * 33]); o.z = cvt_pk_bf16(s[4 * 33], s[5 * 33]); o.w = cvt_pk_bf16(s[6 * 33], s[7 * 33]);
        *(u32x4*)(WT + (size_t)(drow0 + n) * ldk + k0 + 8 * c) = o; }
    LDS_WAIT(); asm volatile("" ::: "memory");
}
__device__ __forceinline__ void convert_weights(Frame& F, int l_in) {
    PHASE_IDS
    unsigned char* const wsl = fresh(F.ws);
    PHASE_L
    LAS float* scr = (LAS float*)(F.lds + wave * 16384);
    const int NGW = fresh_i(F.G) * NWAVES;
    unsigned char* ws = wsl;
    constexpr int I_WIN = (DM / 64) * (ICOLS / 32), I_PW = 4 * (256 / 64) * (256 / 32), I_PP = (PWD / 64) * (DM / 32), I_WO = (DM / 64) * (DM / 32), I_FG = (DM / 64) * (FF / 32),
                  I_FD = (FF / 64) * (DM / 32), I_PL = (PLE / 64) * (DM / 32);
    constexpr int NITEMS = I_WIN + I_PW + 2 * I_PP + I_WO + 2 * I_FG + I_FD + I_WO + I_PL;
    for (int it = gw; it < NITEMS; it += NGW) {
        int r = it;
        if (r < I_WIN) { const int nblk = ICOLS / 32, kb = r / nblk, nb = r % nblk, n0 = nb * 32; transpose_item(INP(8) + (size_t)l * DM * ICOLS, ICOLS, (bf16_t*)(ws + WS_WIN), DM, kb * 64, n0, n0 < 4384 ? n0 : n0 + 224, scr, lane, nullptr, INP(7) + (size_t)l * DM); continue; } r -= I_WIN;
        if (r < I_PW) { const int g = r >> 5, rr = r & 31, kb = rr >> 3, nb = rr & 7; transpose_item(INP(10) + ((size_t)l * 4 + g) * 65536, 256, (bf16_t*)(ws + WS_POOLW) + (size_t)g * 65536, 256, kb * 64, nb * 32, nb * 32, scr, lane, INP(11) + (size_t)l * PWD + g * 256); continue; } r -= I_PW;
        if (r < I_PP) { const int nblk = DM / 32, kb = r / nblk, nb = r % nblk; transpose_item(INP(22) + (size_t)l * PWD * DM, DM, (bf16_t*)(ws + WS_PPOOL), PWD, kb * 64, nb * 32, nb * 32, scr, lane); continue; } r -= I_PP;
        if (r < I_PP) { const int nblk = DM / 32, kb = r / nblk, nb = r % nblk; transpose_item(INP(23) + (size_t)l * RWD * DM, DM, (bf16_t*)(ws + WS_PRWKV), RWD, kb * 64, nb * 32, nb * 32, scr, lane); continue; } r -= I_PP;
        if (r < I_WO) { const int nblk = DM / 32, kb = r / nblk, nb = r % nblk; transpose_item(INP(24) + (size_t)l * DM * DM, DM, (bf16_t*)(ws + WS_WOUT), DM, kb * 64, nb * 32, nb * 32, scr, lane); continue; } r -= I_WO;
        if (r < I_FG) { const int nblk = FF / 32, kb = r / nblk, nb = r % nblk, n0 = nb * 32; transpose_item(INP(26) + (size_t)l * DM * FF, FF, (bf16_t*)(ws + WS_WGU), DM, kb * 64, n0, 256 * (n0 >> 7) + 64 * ((n0 & 127) >> 5), scr, lane, nullptr, INP(25) + (size_t)l * DM); continue; } r -= I_FG;
        if (r < I_FG) { const int nblk = FF / 32, kb = r / nblk, nb = r % nblk, n0 = nb * 32; transpose_item(INP(27) + (size_t)l * DM * FF, FF, (bf16_t*)(ws + WS_WGU), DM, kb * 64, n0, 256 * (n0 >> 7) + 64 * ((n0 & 127) >> 5) + 32, scr, lane, nullptr, INP(25) + (size_t)l * DM); continue; } r -= I_FG;
        if (r < I_FD) { const int nblk = DM / 32, kb = r / nblk, nb = r % nblk; transpose_item(INP(28) + (size_t)l * FF * DM, DM, (bf16_t*)(ws + WS_WDN), FF, kb * 64, nb * 32, nb * 32, scr, lane); continue; } r -= I_FD;
        if (r < I_WO) { const int nblk = DM / 32, kb = r / nblk, nb = r % nblk; transpose_item(INP(30) + (size_t)l * DM * DM, DM, (bf16_t*)(ws + WS_WPG), DM, kb * 64, nb * 32, nb * 32, scr, lane, nullptr, INP(29) + (size_t)l * DM); continue; } r -= I_WO;
        { const int nblk = DM / 32, kb = r / nblk, nb = r % nblk; transpose_item(INP(31) + (size_t)l * PLE * DM, DM, (bf16_t*)(ws + WS_WPP), PLE, kb * 64, nb * 32, nb * 32, scr, lane); }
    }
    const int NT = fresh_i(F.G) * NTHR;
    { u32x4* z = (u32x4*)((bf16_t*)(ws + WS_WIN) + (size_t)4384 * DM); for (int i = gtid; i < 224 * DM * 2 / 16; i += NT) z[i] = (u32x4){0u, 0u, 0u, 0u}; }
    { bf16_t* LT = (bf16_t*)(ws + WS_LORA); const float* wd = INP(13) + (size_t)l * 64 * RWD; const float* wa = INP(15) + (size_t)l * 64 * RWD; const float* wg = INP(16) + (size_t)l * 160 * RWD;
      for (int i = gtid; i < 3072 * (LK / 8); i += NT) { const int n = i / (LK / 8), k0 = (i % (LK / 8)) * 8; const int kind = n >> 10, c = n & 1023; float f[8];
#pragma unroll
          for (int j = 0; j < 8; ++j) { const int k = k0 + j; float v = 0.f;
              if (kind == 0) { if (k < 64) v = wd[(size_t)k * RWD + c]; }
              else if (kind == 1) { if (k >= 64 && k < 128) v = wa[(size_t)(k - 64) * RWD + c]; }
              else { if (k >= 128 && k < 288) v = wg[(size_t)(k - 128) * RWD + c]; }
              f[j] = v; }
          *(u32x4*)(LT + (size_t)n * LK + k0) = pack8(f); } }
    { bf16_t* PB = (bf16_t*)(ws + WS_PB); const float* pp = INP(5) + (size_t)l * MPR * PLE; const float* ps = INP(6) + (size_t)l * (MT - MPR) * PLE;
      for (int i = gtid; i < MT * PLE / 8; i += NT) { const size_t e = (size_t)i * 8; const float* src = e < (size_t)MPR * PLE ? pp + e : ps + (e - (size_t)MPR * PLE);
          const f32x4 a = *(const f32x4*)src, b = *(const f32x4*)(src + 4); *(u32x4*)(PB + e) = pg8::pack_f4x2(a, b); } }
}

__device__ __forceinline__ void xb_from_input(Frame& F) {
    PHASE_IDS
    unsigned char* const wsl = fresh(F.ws);
    const int NGW = fresh_i(F.G) * NWAVES; bf16_t* XB = (bf16_t*)(wsl + WS_XN); pg8::ss_t* SS = (pg8::ss_t*)(wsl + WS_SS);
    for (int m = gw; m < MT; m += NGW) {
        const float* src = m < MPR ? INP(0) + (size_t)m * DM : INP(1) + (size_t)(m - MPR) * DM;
        f32x4 v[8]; float s = 0.f;
#pragma unroll
        for (int j = 0; j < 8; ++j) { v[j] = *(const f32x4*)(src + 4 * lane + 256 * j); s += (v[j].x * v[j].x + v[j].y * v[j].y) + (v[j].z * v[j].z + v[j].w * v[j].w); }
        s = wave_sum(s);
        if (lane == 0) SS[m] = pg8::ss_fix(s);
#pragma unroll
        for (int j = 0; j < 8; ++j) { u32x2 w; w.x = cvt_pk_bf16(v[j].x, v[j].y); w.y = cvt_pk_bf16(v[j].z, v[j].w); *(u32x2*)(XB + (size_t)m * DM + 4 * lane + 256 * j) = w; }
    }
}
__device__ __forceinline__ void final_norm(Frame& F, const float* gain) {
    PHASE_IDS
    unsigned char* const wsl = fresh(F.ws);
    const int NGW = fresh_i(F.G) * NWAVES; const bf16_t* XB = (const bf16_t*)(wsl + ((NL & 1) ? WS_XB2 : WS_XN));
    f32x4 g[8];
#pragma unroll
    for (int j = 0; j < 8; ++j) g[j] = *(const f32x4*)(gain + 4 * lane + 256 * j);
    for (int m = gw; m < MT; m += NGW) {
        f32x4 v[8]; float s = 0.f;
#pragma unroll
        for (int j = 0; j < 8; ++j) { const u32x2 w = *(const u32x2*)(XB + (size_t)m * DM + 4 * lane + 256 * j); v[j] = (f32x4){bf_lo(w.x), bf_hi(w.x), bf_lo(w.y), bf_hi(w.y)};
            s += (v[j].x * v[j].x + v[j].y * v[j].y) + (v[j].z * v[j].z + v[j].w * v[j].w); }
        const float rstd = __builtin_amdgcn_rsqf(wave_sum(s) * (1.0f / DM) + NORM_EPS);
#pragma unroll
        for (int j = 0; j < 8; ++j) *(f32x4*)(F.out + (size_t)m * DM + 4 * lane + 256 * j) = v[j] * rstd * g[j];
    }
}

__device__ __forceinline__ void load_z(float (&z)[8], const bf16_t* PROJ, const float* past, int m0, int t, bool samp, int c0) {
    if (t >= 0) { unpack8(*(const u32x4*)(PROJ + (size_t)(m0 + t) * ICP + c0), z); }
    else if (samp) { const float* p = past + (size_t)(15 + t) * PWD + c0; const f32x4 a = *(const f32x4*)p, b = *(const f32x4*)(p + 4); z[0] = a.x; z[1] = a.y; z[2] = a.z; z[3] = a.w; z[4] = b.x; z[5] = b.y; z[6] = b.z; z[7] = b.w; }
    else {
#pragma unroll
        for (int j = 0; j < 8; ++j) z[j] = 0.f; }
}
__device__ __forceinline__ void prep1_phase(Frame& F, int l_in) {
    PHASE_IDS
    unsigned char* const wsl = fresh(F.ws);
    PHASE_L
    const int NT = fresh_i(F.G) * NTHR; const bf16_t* PROJ = (const bf16_t*)(wsl + WS_PROJ);
    { bf16_t* D = (bf16_t*)(wsl + WS_D);
      for (int it = gtid; it < (MT / 16) * 128; it += NT) {
          const int oct = it & 127, run = it >> 7, mrow = run * 16, c0 = oct * 8, win = 2 << (c0 >> 8);
          int b, t0; bool samp; row_info(mrow, b, t0, samp);
          const int T = samp ? TS : TP, mseq = mrow - t0;
          const float* past = INP(3) + ((size_t)l * 8 + b) * 15 * PWD;
          float* npool = F.out + (samp ? O_POS : O_POP) + ((size_t)l * 8 + b) * 15 * PWD;
          float S[8], z[8];
#pragma unroll
          for (int j = 0; j < 8; ++j) S[j] = 0.f;
          for (int j = 1; j < win; ++j) { load_z(z, PROJ, past, mseq, t0 - j, samp, c0);
#pragma unroll
              for (int q = 0; q < 8; ++q) S[q] += z[q]; }
          for (int i = 0; i < 16; ++i) { const int t = t0 + i; float cur[8]; load_z(cur, PROJ, past, mseq, t, samp, c0);
              const int cnt = samp ? win : (t + 1 < win ? t + 1 : win); const float inv = 1.0f / (float)cnt; float d[8];
#pragma unroll
              for (int q = 0; q < 8; ++q) { S[q] += cur[q]; d[q] = S[q] * inv - cur[q]; }
              *(u32x4*)(D + (size_t)(mseq + t) * PWD + c0) = pack8(d);
              if (t >= T - 15) { float* o = npool + (size_t)(t - (T - 15)) * PWD + c0; *(f32x4*)o = (f32x4){cur[0], cur[1], cur[2], cur[3]}; *(f32x4*)(o + 4) = (f32x4){cur[4], cur[5], cur[6], cur[7]}; }
              load_z(z, PROJ, past, mseq, t - win + 1, samp, c0);
#pragma unroll
              for (int q = 0; q < 8; ++q) S[q] -= z[q]; }
      } }
    { bf16_t* LIN = (bf16_t*)(wsl + WS_LIN); const float* mu = INP(9) + (size_t)l * RPJ + 3072;
      for (int it = gtid; it < MT * (LK / 8); it += NT) {
          const int m = it / (LK / 8), c0 = (it % (LK / 8)) * 8; float o[8];
          if (c0 >= 288) {
#pragma unroll
              for (int j = 0; j < 8; ++j) o[j] = 0.f;
          } else {
              int b, t; bool samp; row_info(m, b, t, samp);
              float cur[8], prv[8]; unpack8(*(const u32x4*)(PROJ + (size_t)m * ICP + 4096 + c0), cur);
              if (t > 0) unpack8(*(const u32x4*)(PROJ + (size_t)(m - 1) * ICP + 4096 + c0), prv);
              else if (samp) { const float* p = INP(2) + ((size_t)l * 8 + b) * RPJ + 3072 + c0;
#pragma unroll
                  for (int j = 0; j < 8; ++j) prv[j] = p[j]; }
              else {
#pragma unroll
                  for (int j = 0; j < 8; ++j) prv[j] = 0.f; }
#pragma unroll
              for (int j = 0; j < 8; ++j) { const float xm = cur[j] + (prv[j] - cur[j]) * mu[c0 + j]; o[j] = c0 < 64 ? tanhf_(xm) : (c0 < 128 ? xm : sigmoidf_(xm)); }
          }
          *(u32x4*)(LIN + (size_t)m * LK + c0) = pack8(o);
      } }
    { pg8::ss_t* SS = (pg8::ss_t*)(wsl + WS_SS); for (int i = gtid; i < 3 * MT; i += NT) SS[i] = 0u; }
    for (int it = gtid; it < 16 * RPJ; it += NT) { const int s = it / RPJ, c = it % RPJ; const int mlast = s < 8 ? s * TP + TP - 1 : MPR + (s - 8) * TS + TS - 1;
        F.out[(s < 8 ? O_SHP : O_SHS) + ((size_t)l * 8 + (s & 7)) * RPJ + c] = __uint_as_float((unsigned)PROJ[(size_t)mlast * ICP + 1024 + c] << 16); }
}

constexpr int SC_TC = 32, SC_STEP = 6 * 64;
__device__ __forceinline__ float sum16(float x) { x += dpp_f<0xB1>(x); x += dpp_f<0x4E>(x); x += dpp_f<0x141>(x); x += dpp_f<0x140>(x); return x; }
__device__ __forceinline__ void unpack4(const u32x2 w, float (&f)[4]) { f[0] = bf_lo(w.x); f[1] = bf_hi(w.x); f[2] = bf_lo(w.y); f[3] = bf_hi(w.y); }
__device__ __forceinline__ void scan_phase(Frame& F, int l_in) {
    PHASE_IDS
    unsigned char* const wsl = fresh(F.ws);
    PHASE_L
    LAS float* buf = (LAS float*)F.lds;
    LAS float* ybuf = (LAS float*)(F.lds + 2 * SC_TC * SC_STEP * 4);
    const float* DEC = (const float*)(wsl + WS_DEC); const bf16_t* PROJ = (const bf16_t*)(wsl + WS_PROJ); const bf16_t* AA = (const bf16_t*)(wsl + WS_AA);
    float* Y = (float*)(wsl + WS_Y); float* BS = (float*)(wsl + WS_BS);
    const bool is_cons = wave < 4;
    const int ks = lane & 7, k0 = ks * 8, rl = (wave & 3) * 8 + (lane >> 3);
    const int ptid = tid & 255, st0 = ptid >> 4, q4 = (ptid & 15) * 4;
    for (int u = blockIdx.x; u < 512; u += fresh_i(F.G)) {
        const bool samp = u >= 256; const int half = u & 1, h = (u >> 1) & 15, b = (u >> 5) & 7;
        const int T = samp ? TS : TP, m0 = samp ? MPR + b * TS : b * TP, ch = h * 64 + q4, row = half * 32 + rl;
        const int nch = T / SC_TC;
        const float* mu = INP(9) + (size_t)l * RPJ;
        const f32x4 mur = *(const f32x4*)(mu + ch), muk = *(const f32x4*)(mu + 1024 + ch), muv = *(const f32x4*)(mu + 2048 + ch);
        const f32x4 ckk = *(const f32x4*)(INP(17) + (size_t)l * RWD + ch), cka = *(const f32x4*)(INP(18) + (size_t)l * RWD + ch), crk = *(const f32x4*)(INP(19) + (size_t)l * RWD + ch);
        const float* shp = INP(2) + ((size_t)l * 8 + b) * RPJ + ch;
        f32x2 S01, S23, S45, S67;
        if (samp) { const float* sp = INP(4) + ((((size_t)l * 8 + b) * 16 + h) * 64 + row) * 64 + k0; const f32x4 s0 = *(const f32x4*)sp, s1 = *(const f32x4*)(sp + 4);
            S01 = (f32x2){s0.x, s0.y}; S23 = (f32x2){s0.z, s0.w}; S45 = (f32x2){s1.x, s1.y}; S67 = (f32x2){s1.z, s1.w}; }
        else { S01 = (f32x2){0.f, 0.f}; S23 = S01; S45 = S01; S67 = S01; }
        u32x2 rw[2][7]; f32x4 rd[2];
#define SC_LOADRAW(c) do { _Pragma("unroll") for (int i2 = 0; i2 < 2; ++i2) { const int tt = (c) * SC_TC + st0 + 16 * i2; const size_t mm = (size_t)(m0 + tt); const bf16_t* pc = PROJ + mm * ICP + 1024 + ch; \
        rw[i2][0] = *(const u32x2*)pc; rw[i2][1] = *(const u32x2*)(pc + 1024); rw[i2][2] = *(const u32x2*)(pc + 2048); rw[i2][6] = *(const u32x2*)(AA + mm * RWD + ch); rd[i2] = *(const f32x4*)(DEC + mm * RWD + ch); \
        if (tt > 0) { rw[i2][3] = *(const u32x2*)(pc - ICP); rw[i2][4] = *(const u32x2*)(pc - ICP + 1024); rw[i2][5] = *(const u32x2*)(pc - ICP + 2048); } \
        else { rw[i2][3] = (u32x2){0u, 0u}; rw[i2][4] = rw[i2][3]; rw[i2][5] = rw[i2][3]; } } } while (0)
#define SC_BUILD(c, bufp) do { _Pragma("unroll") for (int i2 = 0; i2 < 2; ++i2) { const int st = st0 + 16 * i2, tt = (c) * SC_TC + st; const size_t mm = (size_t)(m0 + tt); \
        float xr[4], xk[4], xv[4], yr[4], yk[4], yv[4], av[4]; unpack4(rw[i2][0], xr); unpack4(rw[i2][1], xk); unpack4(rw[i2][2], xv); unpack4(rw[i2][3], yr); unpack4(rw[i2][4], yk); unpack4(rw[i2][5], yv); unpack4(rw[i2][6], av); \
        const f32x4 cd = rd[i2]; \
        if (samp && tt == 0) { const f32x4 t0 = *(const f32x4*)shp, t1 = *(const f32x4*)(shp + 1024), t2 = *(const f32x4*)(shp + 2048); _Pragma("unroll") for (int j = 0; j < 4; ++j) { yr[j] = t0[j]; yk[j] = t1[j]; yv[j] = t2[j]; } } \
        f32x4 vr, vk, vv4, vq, vb, vh; float ss = 0.f, bsum = 0.f; \
        _Pragma("unroll") for (int j = 0; j < 4; ++j) { vr[j] = xr[j] + (yr[j] - xr[j]) * mur[j]; vk[j] = xk[j] + (yk[j] - xk[j]) * muk[j]; vv4[j] = xv[j] + (yv[j] - xv[j]) * muv[j]; \
            vq[j] = vk[j] * ckk[j]; ss += vq[j] * vq[j]; vh[j] = vk[j] * (1.0f + (av[j] - 1.0f) * cka[j]); bsum += vr[j] * vh[j] * crk[j]; } \
        ss = sum16(ss); bsum = sum16(bsum); const float inv = 1.0f / fmaxf(sqrtf(ss), 1e-12f); \
        _Pragma("unroll") for (int j = 0; j < 4; ++j) { vq[j] *= inv; vb[j] = vq[j] * av[j]; } \
        LAS float* d = (bufp) + st * SC_STEP + q4; *(LAS f32x4*)d = cd; *(LAS f32x4*)(d + 64) = vq; *(LAS f32x4*)(d + 128) = vb; *(LAS f32x4*)(d + 192) = vh; *(LAS f32x4*)(d + 256) = vr; *(LAS f32x4*)(d + 320) = vv4; \
        if (half == 0 && q4 == 0) BS[mm * 16 + h] = bsum; } } while (0)
#define SC_FLUSH(c) do { const int fs = ptid >> 3, fj = (ptid & 7) * 4; const f32x4 yo = *(const LAS f32x4*)(ybuf + ((c) & 1) * SC_TC * 32 + fs * 32 + fj); \
        *(f32x4*)(Y + (size_t)(m0 + (c) * SC_TC + fs) * RWD + h * 64 + half * 32 + fj) = yo; } while (0)
        __syncthreads();
        if (!is_cons) { SC_LOADRAW(0); SC_BUILD(0, buf); if (nch > 1) SC_LOADRAW(1); }
        __syncthreads();
        for (int c = 0; c < nch; ++c) {
            LAS float* cur = buf + (c & 1) * SC_TC * SC_STEP; LAS float* oth = buf + ((c + 1) & 1) * SC_TC * SC_STEP; LAS float* yb = ybuf + (c & 1) * SC_TC * 32;
            if (is_cons) {
#define SC_STEP_BODY(s, DO_Y) do { const LAS float* p = cur + (s) * SC_STEP + k0; \
                const f32x4 wa = *(const LAS f32x4*)p, wb = *(const LAS f32x4*)(p + 4), qa = *(const LAS f32x4*)(p + 64), qb = *(const LAS f32x4*)(p + 68), ba = *(const LAS f32x4*)(p + 128), bb = *(const LAS f32x4*)(p + 132), \
                            ha = *(const LAS f32x4*)(p + 192), hb = *(const LAS f32x4*)(p + 196), ra = *(const LAS f32x4*)(p + 256), rb = *(const LAS f32x4*)(p + 260); \
                const float vv = cur[(s) * SC_STEP + 320 + row]; const f32x2 v2 = (f32x2){vv, vv}; \
                f32x2 d = S01 * (f32x2){qa.x, qa.y}; f32x2 d1 = S23 * (f32x2){qa.z, qa.w}; d = S45 * (f32x2){qb.x, qb.y} + d; d1 = S67 * (f32x2){qb.z, qb.w} + d1; d = d + d1; float sa = d.x + d.y; \
                float yv = 0.f; if (DO_Y) { f32x2 e = S01 * (f32x2){rpa.x, rpa.y}; f32x2 e1 = S23 * (f32x2){rpa.z, rpa.w}; e = S45 * (f32x2){rpb.x, rpb.y} + e; e1 = S67 * (f32x2){rpb.z, rpb.w} + e1; e = e + e1; yv = e.x + e.y; } \
                const f32x2 t01 = S01 * (f32x2){wa.x, wa.y} + v2 * (f32x2){ha.x, ha.y}, t23 = S23 * (f32x2){wa.z, wa.w} + v2 * (f32x2){ha.z, ha.w}, t45 = S45 * (f32x2){wb.x, wb.y} + v2 * (f32x2){hb.x, hb.y}, t67 = S67 * (f32x2){wb.z, wb.w} + v2 * (f32x2){hb.z, hb.w}; \
                sa += dpp_f<0xB1>(sa); if (DO_Y) yv += dpp_f<0xB1>(yv); sa += dpp_f<0x4E>(sa); if (DO_Y) yv += dpp_f<0x4E>(yv); sa += dpp_f<0x141>(sa); if (DO_Y) yv += dpp_f<0x141>(yv); \
                const f32x2 n2 = (f32x2){-sa, -sa}; \
                S01 = n2 * (f32x2){ba.x, ba.y} + t01; S23 = n2 * (f32x2){ba.z, ba.w} + t23; S45 = n2 * (f32x2){bb.x, bb.y} + t45; S67 = n2 * (f32x2){bb.z, bb.w} + t67; \
                if (DO_Y) yb[((s) - 1) * 32 + rl] = yv; rpa = ra; rpb = rb; } while (0)
                f32x4 rpa, rpb;
                SC_STEP_BODY(0, false);
#pragma unroll 2
                for (int s = 1; s < SC_TC; ++s) SC_STEP_BODY(s, true);
                { f32x2 e = S01 * (f32x2){rpa.x, rpa.y}; f32x2 e1 = S23 * (f32x2){rpa.z, rpa.w}; e = S45 * (f32x2){rpb.x, rpb.y} + e; e1 = S67 * (f32x2){rpb.z, rpb.w} + e1; e = e + e1; yb[(SC_TC - 1) * 32 + rl] = sum8(e.x + e.y); }
#undef SC_STEP_BODY
            } else {
                if (c + 1 < nch) SC_BUILD(c + 1, oth);
                if (c + 2 < nch) SC_LOADRAW(c + 2);
                if (c > 0) SC_FLUSH(c - 1);
            }
            __syncthreads();
        }
        if (!is_cons) SC_FLUSH(nch - 1);
#undef SC_BUILD
#undef SC_LOADRAW
#undef SC_FLUSH
        if (is_cons) { float* so = F.out + (samp ? O_WKS : O_WKP) + ((((size_t)l * 8 + b) * 16 + h) * 64 + row) * 64 + k0;
            *(f32x4*)so = (f32x4){S01.x, S01.y, S23.x, S23.y}; *(f32x4*)(so + 4) = (f32x4){S45.x, S45.y, S67.x, S67.y}; }
    }
}

__device__ __forceinline__ void post_phase(Frame& F, int l_in) {
    PHASE_IDS
    unsigned char* const wsl = fresh(F.ws);
    PHASE_L
    const int NT = fresh_i(F.G) * NTHR; const float* Y = (const float*)(wsl + WS_Y); const float* BS = (const float*)(wsl + WS_BS);
    const bf16_t* PROJ = (const bf16_t*)(wsl + WS_PROJ); const bf16_t* GG = (const bf16_t*)(wsl + WS_GG);
    bf16_t* YB = (bf16_t*)(wsl + WS_YB);
    const float* muv = INP(9) + (size_t)l * RPJ + 2048; const float* gng = INP(20) + (size_t)l * RWD; const float* gnb = INP(21) + (size_t)l * RWD;
#define PP_LOAD(it_, Y0, Y1, CU, PR, GV, BSV) do { const int m_ = (it_) >> 7, c_ = ((it_) & 127) * 8; const size_t o_ = (size_t)m_ * RWD + c_; int b_, t_; bool s_; row_info(m_, b_, t_, s_); \
        Y0 = *(const f32x4*)(Y + o_); Y1 = *(const f32x4*)(Y + o_ + 4); CU = *(const u32x4*)(PROJ + (size_t)m_ * ICP + 3072 + c_); PR = *(const u32x4*)(PROJ + (size_t)(t_ > 0 ? m_ - 1 : m_) * ICP + 3072 + c_); \
        GV = *(const u32x4*)(GG + o_); BSV = BS[(size_t)m_ * 16 + (c_ >> 6)]; } while (0)
    f32x4 y0, y1, ny0, ny1; u32x4 cu, pr, gv, ncu, npr, ngv; float bs, nbs;
    if (gtid < MT * 128) PP_LOAD(gtid, y0, y1, cu, pr, gv, bs);
    for (int it = gtid; it < MT * 128; it += NT) {
        const int itn = it + NT;
        if (itn < MT * 128) PP_LOAD(itn, ny0, ny1, ncu, npr, ngv, nbs);
        const int m = it >> 7, c0 = (it & 127) * 8; const size_t o = (size_t)m * RWD + c0;
        int b, t; bool samp; row_info(m, b, t, samp);
        float y[8] = {y0.x, y0.y, y0.z, y0.w, y1.x, y1.y, y1.z, y1.w};
        float cur[8], prv[8], g[8]; unpack8(cu, cur); unpack8(gv, g); unpack8(pr, prv);
        if (t == 0) {
            if (samp) { const float* p = INP(2) + ((size_t)l * 8 + b) * RPJ + 2048 + c0;
#pragma unroll
                for (int j = 0; j < 8; ++j) prv[j] = p[j]; }
            else {
#pragma unroll
                for (int j = 0; j < 8; ++j) prv[j] = 0.f; }
        }
        float s = 0.f;
#pragma unroll
        for (int j = 0; j < 8; ++j) s += y[j];
        s = sum8(s);
        const float mean = s * (1.0f / 64.0f); float q = 0.f;
#pragma unroll
        for (int j = 0; j < 8; ++j) { const float d = y[j] - mean; q += d * d; }
        q = sum8(q);
        const float rstd = __builtin_amdgcn_rsqf(q * (1.0f / 64.0f) + GN_EPS);
        float outv[8];
#pragma unroll
        for (int j = 0; j < 8; ++j) { const float v = cur[j] + (prv[j] - cur[j]) * muv[c0 + j]; outv[j] = ((y[j] - mean) * rstd * gng[c0 + j] + gnb[c0 + j] + bs * v) * g[j]; }
        *(u32x4*)(YB + o) = pack8(outv);
        y0 = ny0; y1 = ny1; cu = ncu; pr = npr; gv = ngv; bs = nbs;
    }
#undef PP_LOAD
}

__device__ __forceinline__ void tile64_mma(const bf16_t* A, int lda, const bf16_t* Bt, int ldb, int K, int m0, int n0, int wave, int lane, f32x4 (&acc)[4][4]) {
    const int kq = K >> 3, kb = wave * kq, lr = lane & 15, lk = (lane >> 4) * 8;
    const bf16_t* ap = A + (size_t)(m0 + lr) * lda + kb + lk; const bf16_t* bp = Bt + (size_t)(n0 + lr) * ldb + kb + lk;
#pragma unroll 2
    for (int k = 0; k < kq; k += 32) {
        bf16x8 af[4], bf[4];
#pragma unroll
        for (int i = 0; i < 4; ++i) { af[i] = *(const bf16x8*)(ap + (size_t)(16 * i) * lda + k); bf[i] = *(const bf16x8*)(bp + (size_t)(16 * i) * ldb + k); }
#pragma unroll
        for (int mi = 0; mi < 4; ++mi)
#pragma unroll
            for (int ni = 0; ni < 4; ++ni) acc[mi][ni] = __builtin_amdgcn_mfma_f32_16x16x32_bf16(bf[ni], af[mi], acc[mi][ni], 0, 0, 0);
    }
}
__device__ __forceinline__ void tile64_reduce(LAS unsigned char* lds, int wave, int lane, const f32x4 (&acc)[4][4], f32x4 (&out)[2]) {
    LAS f32x4* red = (LAS f32x4*)lds;
    __syncthreads();
#pragma unroll
    for (int mi = 0; mi < 4; ++mi)
#pragma unroll
        for (int ni = 0; ni < 4; ++ni) red[(wave * 16 + mi * 4 + ni) * 64 + lane] = acc[mi][ni];
    __syncthreads();
#pragma unroll
    for (int j = 0; j < 2; ++j) { f32x4 s = red[(2 * wave + j) * 64 + lane];
#pragma unroll
        for (int w = 1; w < 8; ++w) s += red[(w * 16 + 2 * wave + j) * 64 + lane];
        out[j] = s; }
}
#define T64_ZERO(acc) do { _Pragma("unroll") for (int mi = 0; mi < 4; ++mi) _Pragma("unroll") for (int ni = 0; ni < 4; ++ni) acc[mi][ni] = (f32x4){0.f, 0.f, 0.f, 0.f}; } while (0)
template <int MODE>
__device__ __forceinline__ void sample_tiles(Frame& F, int l_in) {
    PHASE_IDS
    unsigned char* const wsl = fresh(F.ws);
    PHASE_L
    const size_t xb_cur = (l & 1) ? WS_XB2 : WS_XN, xb_nxt = (l & 1) ? WS_XN : WS_XB2;
    for (int t = blockIdx.x; t < 256; t += fresh_i(F.G)) {
        const int m0 = MPR + (t >> 5) * 64, n0 = (t & 31) * 64;
        f32x4 acc[4][4], o1[2], o2[2]; T64_ZERO(acc);
        if (MODE == 0) { tile64_mma((const bf16_t*)(wsl + WS_YA), PWD, (const bf16_t*)(wsl + WS_PPOOL), PWD, PWD, m0, n0, wave, lane, acc); tile64_reduce(F.lds, wave, lane, acc, o1);
                         T64_ZERO(acc); tile64_mma((const bf16_t*)(wsl + WS_YB), RWD, (const bf16_t*)(wsl + WS_PRWKV), RWD, RWD, m0, n0, wave, lane, acc); tile64_reduce(F.lds, wave, lane, acc, o2); }
        if (MODE == 1) { tile64_mma((const bf16_t*)(wsl + WS_MRG), DM, (const bf16_t*)(wsl + WS_WOUT), DM, DM, m0, n0, wave, lane, acc); tile64_reduce(F.lds, wave, lane, acc, o1); }
        if (MODE == 2) { tile64_mma((const bf16_t*)(wsl + WS_HID), FF, (const bf16_t*)(wsl + WS_WDN), FF, FF, m0, n0, wave, lane, acc); tile64_reduce(F.lds, wave, lane, acc, o1); }
        if (MODE == 3) { tile64_mma((const bf16_t*)(wsl + xb_cur), DM, (const bf16_t*)(wsl + WS_WPG), DM, DM, m0, n0, wave, lane, acc); tile64_reduce(F.lds, wave, lane, acc, o1); }
        if (MODE == 4) { tile64_mma((const bf16_t*)(wsl + WS_PB), PLE, (const bf16_t*)(wsl + WS_WPP), PLE, PLE, m0, n0, wave, lane, acc); tile64_reduce(F.lds, wave, lane, acc, o1); }
#pragma unroll
        for (int j = 0; j < 2; ++j) { const int blk = 2 * wave + j; const size_t row = (size_t)(m0 + 16 * (blk >> 2) + (lane & 15)); const int col = n0 + 16 * (blk & 3) + 4 * (lane >> 4);
            if (MODE == 0) { const bf16_t* PROJ = (const bf16_t*)(wsl + WS_PROJ); const u32x2 g1 = *(const u32x2*)(PROJ + row * ICP + PC_GP + col), g2 = *(const u32x2*)(PROJ + row * ICP + PC_GR + col);
                const f32x4 a = (f32x4){bf_lo(g1.x), bf_hi(g1.x), bf_lo(g1.y), bf_hi(g1.y)} * o1[j] + (f32x4){bf_lo(g2.x), bf_hi(g2.x), bf_lo(g2.y), bf_hi(g2.y)} * o2[j];
                *(u32x2*)((bf16_t*)(wsl + WS_MRG) + row * DM + col) = (u32x2){cvt_pk_bf16(a.x, a.y), cvt_pk_bf16(a.z, a.w)}; }
            if (MODE == 1 || MODE == 2) { bf16_t* p = (bf16_t*)(wsl + xb_cur) + row * DM + col; const u32x2 q = *(const u32x2*)p; const f32x4 x = (f32x4){bf_lo(q.x), bf_hi(q.x), bf_lo(q.y), bf_hi(q.y)} + o1[j];
                *(u32x2*)p = (u32x2){cvt_pk_bf16(x.x, x.y), cvt_pk_bf16(x.z, x.w)}; __hip_atomic_fetch_add((pg8::ss_t*)(wsl + WS_SS) + (size_t)MODE * MT + row, pg8::ss_fix((x.x * x.x + x.y * x.y) + (x.z * x.z + x.w * x.w)), __ATOMIC_RELAXED, __HIP_MEMORY_SCOPE_AGENT); }
            if (MODE == 3) { const u32x2 q = *(const u32x2*)((const bf16_t*)(wsl + WS_PP) + row * DM + col); const u32x2 xq = *(const u32x2*)((const bf16_t*)(wsl + xb_cur) + row * DM + col); bf16_t* p = (bf16_t*)(wsl + xb_nxt) + row * DM + col;
                const float rs = pg8::rstd_of((const pg8::ss_t*)(wsl + WS_SS) + (size_t)2 * MT, row);
                const f32x4 x = (f32x4){bf_lo(xq.x), bf_hi(xq.x), bf_lo(xq.y), bf_hi(xq.y)} + sigmoid4(o1[j] * rs) * (f32x4){bf_lo(q.x), bf_hi(q.x), bf_lo(q.y), bf_hi(q.y)};
                *(u32x2*)p = (u32x2){cvt_pk_bf16(x.x, x.y), cvt_pk_bf16(x.z, x.w)}; __hip_atomic_fetch_add((pg8::ss_t*)(wsl + WS_SS) + row, pg8::ss_fix((x.x * x.x + x.y * x.y) + (x.z * x.z + x.w * x.w)), __ATOMIC_RELAXED, __HIP_MEMORY_SCOPE_AGENT); }
            if (MODE == 4) *(u32x2*)((bf16_t*)(wsl + WS_PP) + row * DM + col) = (u32x2){cvt_pk_bf16(o1[j].x, o1[j].y), cvt_pk_bf16(o1[j].z, o1[j].w)};
        }
    }
    __syncthreads();
}

constexpr int PH_PER_LAYER = 11, N_PHASES = NL * PH_PER_LAYER + 1;
#ifndef MK_REP
#define MK_REP 0
#endif
__global__ void __launch_bounds__(NTHR, 2) mega_fwd(Args args) {
    extern __shared__ __attribute__((aligned(16))) unsigned char lds[];
    Frame F;
    F.lds = (LAS unsigned char*)lds;
    F.G = gridDim.x;
    F.out = args.out; F.ws = args.ws;
    { LAS unsigned long long* pt = (LAS unsigned long long*)(F.lds + LDSCTL_OFF + 1024); F.ptab = pt;
      if (threadIdx.x == 0) {
#define PT_(k) pt[k] = (unsigned long long)args.in[k];
          PT_(0) PT_(1) PT_(2) PT_(3) PT_(4) PT_(5) PT_(6) PT_(7) PT_(8) PT_(9) PT_(10) PT_(11) PT_(12) PT_(13) PT_(14) PT_(15) PT_(16) PT_(17) PT_(18) PT_(19) PT_(20) PT_(21) PT_(22) PT_(23) PT_(24) PT_(25) PT_(26) PT_(27) PT_(28) PT_(29) PT_(30) PT_(31) PT_(32)
#undef PT_
      } }
    volatile LAS unsigned* MISC = (volatile LAS unsigned*)(F.lds + LDSCTL_OFF);
    for (int u = threadIdx.x; u < 256; u += NTHR) ((LAS unsigned*)(F.lds + LDSCTL_OFF))[u] = 0u;
    __syncthreads();
    XcdBarrier bar; bar.bar = (unsigned*)(args.ws + WS_CTL) + CW_BAR; bar.x = 0; bar.st = nullptr;
    if (!MK_PER_PHASE) bar = xcd_barrier_post((unsigned*)(args.ws + WS_CTL) + CW_BAR, MISC + 8);
    const int lo = args.ph_lo, hi = args.ph_hi;
#define IN(k) (lo <= (k) && (k) < hi)
#define REP(k) (1 + ((MK_REP >> (k)) & 1))
#define PHASE(k, ...) do { if (IN(pb + (k))) { for (int rep = 0; rep < REP(k); ++rep) { if (rep) xcd_barrier(bar); __VA_ARGS__ } if (IN(pb + (k) + 1)) xcd_barrier(bar); } } while (0)
#define WSP(off) (fresh(F.ws) + (off))
#define UNPAREN(...) __VA_ARGS__
#define GEMM_M(M_, EPI, EINIT, Aoff, Boff, N_, K_, lda_, ldb_, apn_) do { pg8::Gemm g{(const bf16_t*)WSP(Aoff), (const bf16_t*)WSP(Boff), (M_), (N_), (K_), (lda_), (ldb_), (apn_)}; pg8::StaticOrder S; S.init((M_), (N_), fresh_i(F.G), fresh_i(cid)); \
        pg8::EPI E{UNPAREN EINIT}; pg8::gemm_phase<pg8::EPI, pg8::StaticOrder, true>(ring, g, S, E); } while (0)
#define GEMM(...) GEMM_M(MT, __VA_ARGS__)
    LAS unsigned char* ring = F.lds;
    const int cid = (int)blockIdx.x;
    for (int l = 0; l < NL; ++l) {
        const int pb = l * PH_PER_LAYER;
#define SSP(i) ((pg8::ss_t*)WSP(WS_SS) + (size_t)(i) * MT)
        const size_t xb_cur = (l & 1) ? WS_XB2 : WS_XN, xb_nxt = (l & 1) ? WS_XN : WS_XB2;
        PHASE(0, { convert_weights(F, l); if (l == 0) xb_from_input(F); });
        PHASE(1, { GEMM(EpiProj, ((bf16_t*)WSP(WS_PROJ), SSP(0)), xb_cur, WS_WIN, ICP, DM, DM, DM, 0); });
        PHASE(2, { prep1_phase(F, l); });
        PHASE(3, { GEMM(EpiBf16, ((bf16_t*)WSP(WS_YA), PWD), WS_D, WS_POOLW, PWD, 256, PWD, 256, 256);
                   GEMM(EpiLora, ((float*)WSP(WS_DEC), (bf16_t*)WSP(WS_AA), (bf16_t*)WSP(WS_GG), INP(12) + (size_t)fresh_i(l) * RWD, INP(14) + (size_t)fresh_i(l) * RWD), WS_LIN, WS_LORA, 3072, LK, LK, LK, 0); });
        PHASE(4, { scan_phase(F, l); });
        PHASE(5, { post_phase(F, l); });
        PHASE(6, { GEMM_M(MPR, EpiGate1, ((bf16_t*)WSP(WS_TMP), (const bf16_t*)WSP(WS_PROJ), PC_GP), WS_YA, WS_PPOOL, DM, PWD, PWD, PWD, 0);
                   GEMM_M(MPR, EpiGate2, ((const bf16_t*)WSP(WS_TMP), (const bf16_t*)WSP(WS_PROJ), PC_GR, (bf16_t*)WSP(WS_MRG)), WS_YB, WS_PRWKV, DM, RWD, RWD, RWD, 0);
                   sample_tiles<0>(F, l); });
        PHASE(7, { GEMM_M(MPR, EpiResid, ((bf16_t*)WSP(xb_cur), SSP(1)), WS_MRG, WS_WOUT, DM, DM, DM, DM, 0); sample_tiles<1>(F, l); });
        PHASE(8, { GEMM(EpiSwiglu, ((bf16_t*)WSP(WS_HID), SSP(1)), xb_cur, WS_WGU, 2 * FF, DM, DM, DM, 0);
                   GEMM_M(MPR, EpiBf16, ((bf16_t*)WSP(WS_PP), DM), WS_PB, WS_WPP, DM, PLE, PLE, PLE, 0); sample_tiles<4>(F, l); });
        PHASE(9, { GEMM_M(MPR, EpiResid, ((bf16_t*)WSP(xb_cur), SSP(2)), WS_HID, WS_WDN, DM, FF, FF, FF, 0); sample_tiles<2>(F, l); });
        PHASE(10, { GEMM_M(MPR, EpiPle, ((const bf16_t*)WSP(xb_cur), (bf16_t*)WSP(xb_nxt), (const bf16_t*)WSP(WS_PP), SSP(2), SSP(0)), xb_cur, WS_WPG, DM, DM, DM, DM, 0); sample_tiles<3>(F, l); });
#undef SSP
    }
    if (IN(NL * PH_PER_LAYER)) final_norm(F, INP(32));
#undef IN
#undef REP
#undef PHASE
#undef WSP
#undef GEMM
#undef GEMM_M
#undef UNPAREN
}

extern "C" void kernel_launch(void* const* d_in, const int* in_sizes, int n_in, void* d_out, int out_size, void* d_ws, size_t ws_size, hipStream_t stream) {
    static int grid = 0;
    if (grid == 0) {
        if (n_in != 33 || in_sizes[0] != MPR * DM || out_size != (int)O_END || ws_size < WS_END) {
            fprintf(stderr, "kernel_launch: unexpected shapes: n_in %d in0 %d out %d ws %zu (need %zu); nothing launched\n", n_in, n_in > 0 ? in_sizes[0] : -1, out_size, ws_size, (size_t)WS_END); grid = -1; return; }
        int dev = 0, cus = 0, per_cu = 0;
        if (hipGetDevice(&dev) != hipSuccess || hipDeviceGetAttribute(&cus, hipDeviceAttributeMultiprocessorCount, dev) != hipSuccess) { grid = -1; return; }
        if (hipFuncSetAttribute((const void*)mega_fwd, hipFuncAttributeMaxDynamicSharedMemorySize, LDS_BYTES) != hipSuccess) { fprintf(stderr, "kernel_launch: hipFuncSetAttribute failed\n"); grid = -1; return; }
        if (hipOccupancyMaxActiveBlocksPerMultiprocessor(&per_cu, (const void*)mega_fwd, NTHR, LDS_BYTES) != hipSuccess || per_cu < 1) { fprintf(stderr, "kernel_launch: occupancy query says %d\n", per_cu); (void)hipGetLastError(); grid = -1; return; }
        grid = cus;
    }
    if (grid < 0) return;
    (void)hipMemsetAsync((char*)d_ws + WS_CTL, 0, CTL_ZERO_BYTES, stream);
    Args a; memset(&a, 0, sizeof(a));
    for (int i = 0; i < 33; ++i) a.in[i] = (const float*)d_in[i];
    a.out = (float*)d_out; a.ws = (unsigned char*)d_ws;
#if MK_PER_PHASE
    for (int p = 0; p < N_PHASES; ++p) { a.ph_lo = p; a.ph_hi = p + 1; hipLaunchKernelGGL(mega_fwd, dim3(grid), dim3(NTHR), LDS_BYTES, stream, a); }
#else
    a.ph_lo = 0; a.ph_hi = N_PHASES; hipLaunchKernelGGL(mega_fwd, dim3(grid), dim3(NTHR), LDS_BYTES, stream, a);
#endif
}
```

```cpp
#include <hip/hip_runtime.h>
#include <cstdio>
#include <cstdint>
#include <cstring>

#ifndef MK_PER_PHASE
#define MK_PER_PHASE 0
#endif

#define LAS __attribute__((address_space(3)))
typedef unsigned short bf16_t;
typedef short bf16x8 __attribute__((ext_vector_type(8)));
typedef float f32x4 __attribute__((ext_vector_type(4)));
typedef float f32x2 __attribute__((ext_vector_type(2)));
typedef unsigned u32x4 __attribute__((ext_vector_type(4)));
typedef unsigned u32x2 __attribute__((ext_vector_type(2)));

constexpr int DM = 2048, NL = 4, MT = 16896, MPR = 16384, TP = 2048, TS = 64;
constexpr int PWD = 1024, RWD = 1024, RPJ = 3360, ICOLS = 8480, ICP = 8704, FF = 5632, PLE = 256, LK = 384;
constexpr int PC_GP = 4608, PC_GR = 6656;
constexpr float NORM_EPS = 1e-6f, GN_EPS = 64e-5f;
constexpr size_t O_YS = 33554432, O_SHP = 34603008, O_POP = 34710528, O_WKP = 35202048, O_SHS = 37299200, O_POS = 37406720, O_WKS = 37898240, O_END = 39995392;

__device__ __forceinline__ unsigned cvt_pk_bf16(float lo, float hi) { unsigned r; asm volatile("v_cvt_pk_bf16_f32 %0, %1, %2" : "=v"(r) : "v"(lo), "v"(hi)); return r; }
__device__ __forceinline__ float bf_lo(unsigned u) { return __uint_as_float(u << 16); }
__device__ __forceinline__ float bf_hi(unsigned u) { return __uint_as_float(u & 0xffff0000u); }
__device__ __forceinline__ void unpack8(const u32x4 w, float (&f)[8]) { f[0] = bf_lo(w.x); f[1] = bf_hi(w.x); f[2] = bf_lo(w.y); f[3] = bf_hi(w.y); f[4] = bf_lo(w.z); f[5] = bf_hi(w.z); f[6] = bf_lo(w.w); f[7] = bf_hi(w.w); }
__device__ __forceinline__ u32x4 pack8(const float (&f)[8]) { u32x4 w; w.x = cvt_pk_bf16(f[0], f[1]); w.y = cvt_pk_bf16(f[2], f[3]); w.z = cvt_pk_bf16(f[4], f[5]); w.w = cvt_pk_bf16(f[6], f[7]); return w; }
__device__ __forceinline__ float sigmoidf_(float x) { return __builtin_amdgcn_rcpf(1.0f + __expf(-x)); }
__device__ __forceinline__ f32x4 sigmoid4(f32x4 v) { f32x4 o; o.x = sigmoidf_(v.x); o.y = sigmoidf_(v.y); o.z = sigmoidf_(v.z); o.w = sigmoidf_(v.w); return o; }
__device__ __forceinline__ float tanhf_(float x) { const float e = __expf(2.0f * x); return 1.0f - 2.0f * __builtin_amdgcn_rcpf(e + 1.0f); }
template <int CTRL> __device__ __forceinline__ float dpp_f(float x) { return __uint_as_float((unsigned)__builtin_amdgcn_update_dpp(0, (int)__float_as_uint(x), CTRL, 0xF, 0xF, true)); }
__device__ __forceinline__ float sum8(float x) { x += dpp_f<0xB1>(x); x += dpp_f<0x4E>(x); x += dpp_f<0x141>(x); return x; }
__device__ __forceinline__ float wave_sum(float x) {
    x += dpp_f<0xB1>(x); x += dpp_f<0x4E>(x); x += dpp_f<0x141>(x); x += dpp_f<0x140>(x);
    x += __uint_as_float((unsigned)__builtin_amdgcn_ds_swizzle((int)__float_as_uint(x), 0x401F));
    return __uint_as_float((unsigned)__builtin_amdgcn_readlane((int)__float_as_uint(x), 0)) + __uint_as_float((unsigned)__builtin_amdgcn_readlane((int)__float_as_uint(x), 32));
}

namespace pg8 {
typedef unsigned ss_t;
constexpr int BM = 256, BK = 64, HALF = 128, HTB = HALF * BK * 2  , STAGE_BYTES = 8 * HTB, NXCD = 8, WGM = 8;
__host__ __device__ __forceinline__ int lds_byte(int r, int c) { const int st = (r >> 4) * 2 + (c >> 5), rr = r & 15, cc = c & 31, ob = rr * 64 + cc * 2; return st * 1024 + (ob ^ (((ob >> 9) & 1) << 5)); }
__host__ __device__ __forceinline__ void stage_rc(int b, int& R, int& C) { const int st = b / 1024, sb = b % 1024, swz = sb ^ (((sb >> 9) & 1) << 5); R = (st >> 1) * 16 + swz / 64; C = (st & 1) * 32 + (swz % 64) / 2; }
__host__ __device__ __forceinline__ int perm32(int rho) { const int n = rho >> 4, i = rho & 15; return 8 * (i >> 2) + 4 * n + (i & 3); }

struct Unit { int pm, pn; };
struct Gemm { const bf16_t* A; const bf16_t* Bt; int M, N, K, lda, ldb, a_pn_off; };

struct StaticOrder {
    int nM, nN, nwg, G, c;
    __host__ __device__ void init(int M, int N, int G_, int c_) { nM = M / BM; nN = N / BM; nwg = nM * nN; G = G_; c = c_; }
    __host__ __device__ bool next(int i, Unit& u) const {
        const long L = (long)i * G + c; if (L >= nwg) return false;
        int wgid = (int)L; { const int q = nwg / NXCD, r = nwg % NXCD, xcd = wgid % NXCD, off = wgid / NXCD; wgid = (xcd < r ? xcd * (q + 1) : r * (q + 1) + (xcd - r) * q) + off; }
        const int nig = WGM * nN, gid = wgid / nig, fm = gid * WGM, gsz = (nM - fm) < WGM ? (nM - fm) : WGM;
        u.pm = fm + ((wgid % nig) % gsz); u.pn = (wgid % nig) / gsz; return true;
    }
    __device__ __forceinline__ void a_ready(const Unit&) const {}
    __device__ __forceinline__ void done(const Unit&) const {}
};

__device__ __forceinline__ void acc_zero(f32x4 (&acc)[2][2][4][2]) {
#pragma unroll
    for (int a = 0; a < 2; ++a)
#pragma unroll
        for (int b = 0; b < 2; ++b)
#pragma unroll
            for (int m = 0; m < 4; ++m)
#pragma unroll
                for (int n = 0; n < 2; ++n) acc[a][b][m][n] = (f32x4){0.f, 0.f, 0.f, 0.f};
}
struct RepeatOrder : StaticOrder {
    __host__ __device__ bool next(int i, Unit& u) const { if (i >= 6) return false; return StaticOrder::next(i % 3, u) || StaticOrder::next(0, u); }
};
#define EPI_ZERO_INIT __device__ __forceinline__ void init(f32x4 (&acc)[2][2][4][2], const Unit&, int, int, int, int) const { acc_zero(acc); }
#define EPI_NO_PRE __device__ __forceinline__ void preload(ss_t (&pre)[2], const Unit&, int, int, int) const {}
#define EPI_SS_PRE(SSPTR) __device__ __forceinline__ void preload(ss_t (&pre)[2], const Unit& u, int wr, int fr, int fq) const { _Pragma("unroll") for (int j = 0; j < 2; ++j) { const int g = 2 * fq + j; \
        pre[j] = (SSPTR)[(size_t)(u.pm * BM + (g >> 2) * HALF + wr * 64 + (g & 3) * 16 + fr)]; } }
__device__ __forceinline__ ss_t pre_get(const ss_t (&pre)[2], int g, int fr) { return (ss_t)__builtin_amdgcn_ds_bpermute((((g >> 1) << 4) + fr) << 2, (int)pre[g & 1]); }
template <class Epi, class Sched, bool ALIGN_EPI>
__device__ __forceinline__ void gemm_phase(LAS unsigned char* lds, const Gemm g, const Sched& S, const Epi& E) {
    int tid_ = threadIdx.x; asm volatile("" : "+v"(tid_));
    const int tid = tid_, wid = __builtin_amdgcn_readfirstlane(tid >> 6), lane = tid & 63, wr = wid >> 2, wc = wid & 3, fr = lane & 15, fq = lane >> 4;
    int K_ = g.K; asm volatile("" : "+s"(K_));
    const int K = K_, nt = K / BK;
    unsigned voffA[2], voffB[2];
#pragma unroll
    for (int i = 0; i < 2; ++i) { int R, C; stage_rc(tid * 16 + i * 8192, R, C); const int Rb = Epi::PERM ? (64 * (R >> 5) + perm32(R & 31)) : R;
        voffA[i] = (unsigned)(R * g.lda + C) * 2u; voffB[i] = (unsigned)(Rb * g.ldb + C) * 2u; }
    const size_t kstep = (size_t)(BK * 2);
    const size_t hstepA = (size_t)HALF * g.lda * 2, hstepB = (size_t)(Epi::PERM ? 32 : HALF) * g.ldb * 2;
    const unsigned ldsw = (unsigned)wid * 1024u;
    const int aoff = lds_byte(wr * 64 + fr, fq * 8), boff = lds_byte(wc * 32 + fr, fq * 8);
#define PG8_SA(b, h) (((b) * 2 + (h)) * HTB)
#define PG8_SB(b, h) ((4 + (b) * 2 + (h)) * HTB)
#define PG8_STAGE(bufoff, gbase, voff) do { _Pragma("unroll") for (int _i = 0; _i < 2; ++_i) \
        __builtin_amdgcn_global_load_lds((const unsigned*)((const char*)(gbase) + (voff)[_i]), (LAS unsigned*)(lds + (bufoff) + ldsw + _i * 8192), 16, 0, 0); } while (0)
#define PG8_LDA(dst, b, h) do { _Pragma("unroll") for (int m = 0; m < 4; ++m) _Pragma("unroll") for (int k = 0; k < 2; ++k) dst[m][k] = *(const LAS bf16x8*)(lds + PG8_SA(b, h) + aoff + m * 2048 + k * 1024); } while (0)
#define PG8_LDB(dst, b, h) do { _Pragma("unroll") for (int n = 0; n < 2; ++n) _Pragma("unroll") for (int k = 0; k < 2; ++k) dst[n][k] = *(const LAS bf16x8*)(lds + PG8_SB(b, h) + boff + n * 2048 + k * 1024); } while (0)
#define PG8_MMA(ai, bj, At, Bt) do { __builtin_amdgcn_s_setprio(1); _Pragma("unroll") for (int m = 0; m < 4; ++m) _Pragma("unroll") for (int n = 0; n < 2; ++n) _Pragma("unroll") for (int k = 0; k < 2; ++k) \
        acc[ai][bj][m][n] = __builtin_amdgcn_mfma_f32_16x16x32_bf16(Bt[n][k], At[m][k], acc[ai][bj][m][n], 0, 0, 0); __builtin_amdgcn_s_setprio(0); } while (0)
#define PG8_WAIT_V(n) asm volatile("s_waitcnt vmcnt(" #n ")" ::: "memory")
#define PG8_WAIT_L(n) asm volatile("s_waitcnt lgkmcnt(" #n ")" ::: "memory")
#define PG8_BAR __builtin_amdgcn_s_barrier()
#define PG8_SCHED __builtin_amdgcn_sched_barrier(0)
    Unit cur, nxt; int ui = 0;
    if (!S.next(0, cur)) return;
    f32x4 acc[2][2][4][2]; ss_t pre[2];
    E.init(acc, cur, wr, wc, fr, fq); E.preload(pre, cur, wr, fr, fq);
    bf16x8 At[4][2], B0[2][2], B1[2][2];
    const char* cA = (const char*)g.A + ((size_t)cur.pm * BM * g.lda + (size_t)cur.pn * g.a_pn_off) * 2; const char* cB = (const char*)g.Bt + (size_t)cur.pn * BM * g.ldb * 2;
    S.a_ready(cur);
    PG8_STAGE(PG8_SB(0, 0), cB, voffB); PG8_STAGE(PG8_SB(0, 1), cB + hstepB, voffB); PG8_STAGE(PG8_SA(0, 0), cA, voffA); PG8_STAGE(PG8_SA(0, 1), cA + hstepA, voffA);
    if (wr == 1) PG8_BAR;
    PG8_WAIT_V(2); PG8_BAR;
    PG8_STAGE(PG8_SB(1, 0), cB + kstep, voffB); PG8_STAGE(PG8_SA(1, 0), cA + kstep, voffA); PG8_STAGE(PG8_SB(1, 1), cB + hstepB + kstep, voffB);
    PG8_WAIT_V(6); PG8_BAR;
    for (;;) {
        const bool has_next = S.next(ui + 1, nxt);
        const char* nA = has_next ? (const char*)g.A + ((size_t)nxt.pm * BM * g.lda + (size_t)nxt.pn * g.a_pn_off) * 2 : cA; const char* nB = has_next ? (const char*)g.Bt + (size_t)nxt.pn * BM * g.ldb * 2 : cB;
#pragma unroll 1
        for (int t = 0; t < nt; t += 2) {
            const bool last = (t == nt - 2);
            const char* a1 = cA + (size_t)(t + 1) * kstep;
            const char* a2 = last ? nA : cA + (size_t)(t + 2) * kstep; const char* b2 = last ? nB : cB + (size_t)(t + 2) * kstep;
            const char* a3 = a2 + kstep; const char* b3 = b2 + kstep;
            if (last && has_next) S.a_ready(nxt);
            PG8_LDB(B0, 0, 0); PG8_LDB(B1, 0, 1); PG8_SCHED; PG8_LDA(At, 0, 0); PG8_STAGE(PG8_SA(1, 1), a1 + hstepA, voffA);
            PG8_WAIT_V(8); PG8_WAIT_L(0); PG8_BAR; PG8_MMA(0, 0, At, B0); PG8_MMA(0, 1, At, B1); PG8_BAR; PG8_SCHED;
            PG8_LDA(At, 0, 1); PG8_STAGE(PG8_SB(0, 0), b2, voffB); PG8_STAGE(PG8_SB(0, 1), b2 + hstepB, voffB); PG8_STAGE(PG8_SA(0, 0), a2, voffA);
            PG8_WAIT_V(8); PG8_WAIT_L(0); PG8_BAR; PG8_MMA(1, 0, At, B0); PG8_MMA(1, 1, At, B1); PG8_BAR; PG8_SCHED;
            PG8_LDB(B0, 1, 0); PG8_LDB(B1, 1, 1); PG8_SCHED; PG8_LDA(At, 1, 0); PG8_STAGE(PG8_SA(0, 1), a2 + hstepA, voffA);
            PG8_WAIT_V(8); PG8_WAIT_L(0); PG8_BAR; PG8_MMA(0, 0, At, B0); PG8_MMA(0, 1, At, B1); PG8_BAR; PG8_SCHED;
            PG8_LDA(At, 1, 1); PG8_STAGE(PG8_SB(1, 0), b3, voffB); PG8_STAGE(PG8_SB(1, 1), b3 + hstepB, voffB); PG8_STAGE(PG8_SA(1, 0), a3, voffA);
            PG8_WAIT_V(8); PG8_WAIT_L(0); PG8_BAR; PG8_MMA(1, 0, At, B0); PG8_MMA(1, 1, At, B1); PG8_BAR; PG8_SCHED;
        }
        if constexpr (ALIGN_EPI) { if (wr == 0) PG8_BAR; }
        E(acc, pre, cur, wr, wc, fr, fq); S.done(cur);
        if (!has_next) break;
        E.init(acc, nxt, wr, wc, fr, fq); E.preload(pre, nxt, wr, fr, fq);
        cur = nxt; cA = nA; cB = nB; ++ui;
        if constexpr (ALIGN_EPI) { if (wr == 1) PG8_BAR; }
    }
    PG8_WAIT_V(0);
    if constexpr (!ALIGN_EPI) { if (wr == 0) PG8_BAR; }
    PG8_BAR;
#undef PG8_SA
#undef PG8_SB
#undef PG8_STAGE
#undef PG8_LDA
#undef PG8_LDB
#undef PG8_MMA
#undef PG8_WAIT_V
#undef PG8_WAIT_L
#undef PG8_BAR
#undef PG8_SCHED
}

#define EPI_ROW0 (u.pm * BM + wr * 64 + fr)
#define EPI_FOR_AI_M _Pragma("unroll") for (int ai = 0; ai < 2; ++ai) _Pragma("unroll") for (int m = 0; m < 4; ++m)
__device__ __forceinline__ u32x4 pack_f4x2(f32x4 v0, f32x4 v1) { u32x4 w; w.x = cvt_pk_bf16(v0[0], v0[1]); w.y = cvt_pk_bf16(v0[2], v0[3]); w.z = cvt_pk_bf16(v1[0], v1[1]); w.w = cvt_pk_bf16(v1[2], v1[3]); return w; }
__device__ __forceinline__ void unpack_f4x2(u32x4 w, f32x4& v0, f32x4& v1) { v0[0] = bf_lo(w.x); v0[1] = bf_hi(w.x); v0[2] = bf_lo(w.y); v0[3] = bf_hi(w.y); v1[0] = bf_lo(w.z); v1[1] = bf_hi(w.z); v1[2] = bf_lo(w.w); v1[3] = bf_hi(w.w); }
__device__ __forceinline__ unsigned ror8(unsigned x) { return (unsigned)__builtin_amdgcn_update_dpp(0, (int)x, 0x128, 0xF, 0xF, true); }
__device__ __forceinline__ void st_pair(char* grp, size_t pitch, int fr, int fq, u32x4 vA, u32x4 vB) {
    const bool lo = fr < 8;
    u32x4 snd = lo ? vB : vA, rcv; rcv.x = ror8(snd.x); rcv.y = ror8(snd.y); rcv.z = ror8(snd.z); rcv.w = ror8(snd.w);
    char* p = grp + (size_t)(fr & 7) * pitch + (lo ? 0 : 64) + fq * 16;
    *(u32x4*)p = lo ? vA : rcv;
    *(u32x4*)(p + 8 * pitch) = lo ? rcv : vB;
}
__device__ __forceinline__ u32x4 as_u4(f32x4 v) { return __builtin_bit_cast(u32x4, v); }

__device__ __forceinline__ float rstd_raw(ss_t v) { return __builtin_amdgcn_rsqf((float)v * (1.0f / (256.0f * DM)) + NORM_EPS); }
__device__ __forceinline__ float rstd_of(const ss_t* SS, size_t row) { return rstd_raw(SS[row]); }
__device__ __forceinline__ ss_t ss_fix(float s) { return (ss_t)(s * 256.0f + 0.5f); }
__device__ __forceinline__ float sq8(f32x4 a, f32x4 b) { return (a.x * a.x + a.y * a.y) + (a.z * a.z + a.w * a.w) + (b.x * b.x + b.y * b.y) + (b.z * b.z + b.w * b.w); }
__device__ __forceinline__ void ss_add(ss_t* SS, size_t row, float s, int fq, int fr) { s += __uint_as_float((unsigned)__builtin_amdgcn_ds_swizzle((int)__float_as_uint(s), 0x401F));
    s += __uint_as_float((unsigned)__builtin_amdgcn_ds_bpermute((((fq ^ 2) << 4) + fr) << 2, (int)__float_as_uint(s)));
    if (fq == 0) __hip_atomic_fetch_add(SS + row, ss_fix(s), __ATOMIC_RELAXED, __HIP_MEMORY_SCOPE_AGENT); }
struct EpiNull { static constexpr bool PERM = true; EPI_NO_PRE EPI_ZERO_INIT __device__ __forceinline__ void operator()(const f32x4 (&acc)[2][2][4][2], const ss_t (&pre)[2], const Unit& u, int wr, int wc, int fr, int fq) const {
#pragma unroll
    for (int a = 0; a < 2; ++a)
#pragma unroll
        for (int b = 0; b < 2; ++b)
#pragma unroll
            for (int m = 0; m < 4; ++m)
#pragma unroll
                for (int n = 0; n < 2; ++n) asm volatile("" :: "v"(acc[a][b][m][n]));
} };
struct EpiProj { static constexpr bool PERM = true; EPI_ZERO_INIT
    bf16_t* O; const ss_t* SS; EPI_SS_PRE(SS)
    __device__ __forceinline__ void operator()(const f32x4 (&acc)[2][2][4][2], const ss_t (&pre)[2], const Unit& u, int wr, int wc, int fr, int fq) const {
        const bool sg = u.pn >= 18;
        EPI_FOR_AI_M { const size_t r0 = (size_t)(u.pm * BM + ai * HALF + wr * 64 + m * 16); char* grp = (char*)(O + r0 * ICP + u.pn * BM + 64 * wc); const float rs = rstd_raw(pre_get(pre, ai * 4 + m, fr));
            f32x4 a0 = acc[ai][0][m][0] * rs, a1 = acc[ai][0][m][1] * rs, b0 = acc[ai][1][m][0] * rs, b1 = acc[ai][1][m][1] * rs;
            if (sg) { a0 = sigmoid4(a0); a1 = sigmoid4(a1); b0 = sigmoid4(b0); b1 = sigmoid4(b1); }
            st_pair(grp, (size_t)ICP * 2, fr, fq, pack_f4x2(a0, a1), pack_f4x2(b0, b1)); }
    }
};
struct EpiBf16 { static constexpr bool PERM = true; EPI_NO_PRE EPI_ZERO_INIT
    bf16_t* O; int ldc;
    __device__ __forceinline__ void operator()(const f32x4 (&acc)[2][2][4][2], const ss_t (&pre)[2], const Unit& u, int wr, int wc, int fr, int fq) const {
        EPI_FOR_AI_M { char* grp = (char*)(O + (size_t)(u.pm * BM + ai * HALF + wr * 64 + m * 16) * ldc + u.pn * BM + 64 * wc);
            st_pair(grp, (size_t)ldc * 2, fr, fq, pack_f4x2(acc[ai][0][m][0], acc[ai][0][m][1]), pack_f4x2(acc[ai][1][m][0], acc[ai][1][m][1])); }
    }
};
struct EpiLora { static constexpr bool PERM = true; EPI_NO_PRE EPI_ZERO_INIT
    float* DEC; bf16_t* AA; bf16_t* GG; const float* w0; const float* a0;
    __device__ __forceinline__ void operator()(const f32x4 (&acc)[2][2][4][2], const ss_t (&pre)[2], const Unit& u, int wr, int wc, int fr, int fq) const {
        const int row0 = EPI_ROW0, kind = u.pn >> 2, ct = (u.pn & 3) * BM + 64 * wc, col0 = ct + 8 * fq;
        if (kind == 0) {
            EPI_FOR_AI_M { float* rowp = DEC + (size_t)(row0 + ai * HALF + m * 16) * RWD + col0;
#pragma unroll
                for (int bj = 0; bj < 2; ++bj)
#pragma unroll
                    for (int n = 0; n < 2; ++n) { const f32x4 b = *(const f32x4*)(w0 + col0 + bj * 32 + 4 * n); const f32x4 x = acc[ai][bj][m][n] + b; f32x4 o;
#pragma unroll
                        for (int j = 0; j < 4; ++j) { const float z = -x[j]; const float sp = z > 15.f ? z : __logf(1.0f + __expf(z)); const float w = -sp - 0.5f; o[j] = __expf(-__expf(w)); }
                        *(f32x4*)(rowp + bj * 32 + 4 * n) = o; } asm volatile("" ::: "memory"); }
        } else if (kind == 1) {
            const f32x4 b00 = *(const f32x4*)(a0 + col0), b01 = *(const f32x4*)(a0 + col0 + 4), b10 = *(const f32x4*)(a0 + col0 + 32), b11 = *(const f32x4*)(a0 + col0 + 36);
            EPI_FOR_AI_M { char* grp = (char*)(AA + (size_t)(u.pm * BM + ai * HALF + wr * 64 + m * 16) * RWD + ct);
                st_pair(grp, (size_t)RWD * 2, fr, fq, pack_f4x2(sigmoid4(acc[ai][0][m][0] + b00), sigmoid4(acc[ai][0][m][1] + b01)), pack_f4x2(sigmoid4(acc[ai][1][m][0] + b10), sigmoid4(acc[ai][1][m][1] + b11))); }
        } else {
            EPI_FOR_AI_M { char* grp = (char*)(GG + (size_t)(u.pm * BM + ai * HALF + wr * 64 + m * 16) * RWD + ct);
                st_pair(grp, (size_t)RWD * 2, fr, fq, pack_f4x2(acc[ai][0][m][0], acc[ai][0][m][1]), pack_f4x2(acc[ai][1][m][0], acc[ai][1][m][1])); }
        }
    }
};
struct EpiGate1 { static constexpr bool PERM = true; EPI_NO_PRE EPI_ZERO_INIT
    bf16_t* TMP; const bf16_t* PROJ; int gcol0;
    __device__ __forceinline__ void operator()(const f32x4 (&acc)[2][2][4][2], const ss_t (&pre)[2], const Unit& u, int wr, int wc, int fr, int fq) const {
        const int row0 = EPI_ROW0, ct = u.pn * BM + 64 * wc, col0 = ct + 8 * fq;
        EPI_FOR_AI_M { const size_t row = (size_t)(row0 + ai * HALF + m * 16);
            f32x4 g00, g01, g10, g11; unpack_f4x2(*(const u32x4*)(PROJ + row * ICP + gcol0 + col0), g00, g01); unpack_f4x2(*(const u32x4*)(PROJ + row * ICP + gcol0 + col0 + 32), g10, g11);
            st_pair((char*)(TMP + (size_t)(u.pm * BM + ai * HALF + wr * 64 + m * 16) * DM + ct), (size_t)DM * 2, fr, fq, pack_f4x2(acc[ai][0][m][0] * g00, acc[ai][0][m][1] * g01), pack_f4x2(acc[ai][1][m][0] * g10, acc[ai][1][m][1] * g11));
            if (m & 1) asm volatile("" ::: "memory"); }
    }
};
struct EpiGate2 { static constexpr bool PERM = true; EPI_NO_PRE EPI_ZERO_INIT
    const bf16_t* TMP; const bf16_t* PROJ; int gcol0; bf16_t* O;
    __device__ __forceinline__ void operator()(const f32x4 (&acc)[2][2][4][2], const ss_t (&pre)[2], const Unit& u, int wr, int wc, int fr, int fq) const {
        const int row0 = EPI_ROW0, ct = u.pn * BM + 64 * wc, col0 = ct + 8 * fq;
        EPI_FOR_AI_M { const size_t row = (size_t)(row0 + ai * HALF + m * 16);
            f32x4 g00, g01, g10, g11, t00, t01, t10, t11; unpack_f4x2(*(const u32x4*)(PROJ + row * ICP + gcol0 + col0), g00, g01); unpack_f4x2(*(const u32x4*)(PROJ + row * ICP + gcol0 + col0 + 32), g10, g11);
            unpack_f4x2(*(const u32x4*)(TMP + row * DM + col0), t00, t01); unpack_f4x2(*(const u32x4*)(TMP + row * DM + col0 + 32), t10, t11);
            st_pair((char*)(O + (size_t)(u.pm * BM + ai * HALF + wr * 64 + m * 16) * DM + ct), (size_t)DM * 2, fr, fq, pack_f4x2(t00 + acc[ai][0][m][0] * g00, t01 + acc[ai][0][m][1] * g01), pack_f4x2(t10 + acc[ai][1][m][0] * g10, t11 + acc[ai][1][m][1] * g11));
            if (m & 1) asm volatile("" ::: "memory"); }
    }
};
struct EpiResid { static constexpr bool PERM = true; EPI_NO_PRE
    bf16_t* XB; ss_t* SS;
    __device__ __forceinline__ void init(f32x4 (&acc)[2][2][4][2], const Unit& u, int wr, int wc, int fr, int fq) const {
        const int row0 = EPI_ROW0, col0 = u.pn * BM + 64 * wc + 8 * fq;
        EPI_FOR_AI_M { const bf16_t* rowp = XB + (size_t)(row0 + ai * HALF + m * 16) * DM + col0;
            unpack_f4x2(*(const u32x4*)rowp, acc[ai][0][m][0], acc[ai][0][m][1]); unpack_f4x2(*(const u32x4*)(rowp + 32), acc[ai][1][m][0], acc[ai][1][m][1]); }
    }
    __device__ __forceinline__ void operator()(const f32x4 (&acc)[2][2][4][2], const ss_t (&pre)[2], const Unit& u, int wr, int wc, int fr, int fq) const {
        EPI_FOR_AI_M { const size_t r0 = (size_t)(u.pm * BM + ai * HALF + wr * 64 + m * 16);
            st_pair((char*)(XB + r0 * DM + u.pn * BM + 64 * wc), (size_t)DM * 2, fr, fq, pack_f4x2(acc[ai][0][m][0], acc[ai][0][m][1]), pack_f4x2(acc[ai][1][m][0], acc[ai][1][m][1]));
            ss_add(SS, r0 + fr, sq8(acc[ai][0][m][0], acc[ai][0][m][1]) + sq8(acc[ai][1][m][0], acc[ai][1][m][1]), fq, fr); }
    }
};
struct EpiSwiglu { static constexpr bool PERM = true; EPI_ZERO_INIT
    bf16_t* H; const ss_t* SS; EPI_SS_PRE(SS)
    __device__ __forceinline__ void operator()(const f32x4 (&acc)[2][2][4][2], const ss_t (&pre)[2], const Unit& u, int wr, int wc, int fr, int fq) const {
        const int row0 = EPI_ROW0, col0 = u.pn * HALF + wc * 32 + 8 * fq;
        EPI_FOR_AI_M { const size_t row = (size_t)(row0 + ai * HALF + m * 16); const float rs = rstd_raw(pre_get(pre, ai * 4 + m, fr));
            const f32x4 g0 = acc[ai][0][m][0] * rs, g1 = acc[ai][0][m][1] * rs, u0 = acc[ai][1][m][0] * rs, u1 = acc[ai][1][m][1] * rs;
            *(u32x4*)(H + row * FF + col0) = pack_f4x2(g0 * sigmoid4(g0) * u0, g1 * sigmoid4(g1) * u1); }
    }
};
struct EpiPle { static constexpr bool PERM = true; EPI_ZERO_INIT EPI_SS_PRE(SSi)
    const bf16_t* XB; bf16_t* XO; const bf16_t* PP; const ss_t* SSi; ss_t* SSo;
    __device__ __forceinline__ void operator()(const f32x4 (&acc)[2][2][4][2], const ss_t (&pre)[2], const Unit& u, int wr, int wc, int fr, int fq) const {
        const int col0 = u.pn * BM + 64 * wc + 8 * fq;
        EPI_FOR_AI_M { const size_t r0 = (size_t)(u.pm * BM + ai * HALF + wr * 64 + m * 16), row = r0 + fr; const float rs = rstd_raw(pre_get(pre, ai * 4 + m, fr));
            f32x4 x00, x01, x10, x11, p00, p01, p10, p11; unpack_f4x2(*(const u32x4*)(XB + row * DM + col0), x00, x01); unpack_f4x2(*(const u32x4*)(XB + row * DM + col0 + 32), x10, x11);
            unpack_f4x2(*(const u32x4*)(PP + row * DM + col0), p00, p01); unpack_f4x2(*(const u32x4*)(PP + row * DM + col0 + 32), p10, p11);
            x00 += sigmoid4(acc[ai][0][m][0] * rs) * p00; x01 += sigmoid4(acc[ai][0][m][1] * rs) * p01; x10 += sigmoid4(acc[ai][1][m][0] * rs) * p10; x11 += sigmoid4(acc[ai][1][m][1] * rs) * p11;
            st_pair((char*)(XO + r0 * DM + u.pn * BM + 64 * wc), (size_t)DM * 2, fr, fq, pack_f4x2(x00, x01), pack_f4x2(x10, x11));
            ss_add(SSo, row, sq8(x00, x01) + sq8(x10, x11), fq, fr);
            if (m & 1) asm volatile("" ::: "memory"); }
    }
};
#undef EPI_ROW0
#undef EPI_FOR_AI_M
}

constexpr size_t MiB = 1u << 20;
constexpr size_t al1m(size_t x) { return (x + MiB - 1) / MiB * MiB; }
constexpr size_t WS_CTL = 0, CTL_ZERO_BYTES = 1 * MiB;
constexpr size_t SZ_WIN = (size_t)ICP * DM * 2, SZ_POOLW = (size_t)PWD * 256 * 2, SZ_LORA = (size_t)3072 * LK * 2, SZ_PPOOL = (size_t)DM * PWD * 2, SZ_PRWKV = (size_t)DM * RWD * 2,
                 SZ_WOUT = (size_t)DM * DM * 2, SZ_WGU = (size_t)2 * FF * DM * 2, SZ_WDN = (size_t)DM * FF * 2, SZ_WPG = (size_t)DM * DM * 2, SZ_WPP = (size_t)DM * PLE * 2;
constexpr size_t WS_WIN = 1 * MiB, WS_POOLW = WS_WIN + SZ_WIN, WS_LORA = WS_POOLW + SZ_POOLW, WS_PPOOL = WS_LORA + SZ_LORA, WS_PRWKV = WS_PPOOL + SZ_PPOOL, WS_WOUT = WS_PRWKV + SZ_PRWKV,
                 WS_WGU = WS_WOUT + SZ_WOUT, WS_WDN = WS_WGU + SZ_WGU, WS_WPG = WS_WDN + SZ_WDN, WS_WPP = WS_WPG + SZ_WPG, WS_WEND = WS_WPP + SZ_WPP;
constexpr size_t WS_PB = al1m(WS_WEND);
constexpr size_t WS_XN = al1m(WS_PB + (size_t)MT * PLE * 2);
constexpr size_t WS_AA = al1m(WS_XN + (size_t)MT * DM * 2);
constexpr size_t WS_GG = al1m(WS_AA + (size_t)MT * RWD * 2);
constexpr size_t WS_PP = al1m(WS_GG + (size_t)MT * RWD * 2);
constexpr size_t WS_PROJ = al1m(WS_PP + (size_t)MT * DM * 2);
constexpr size_t WS_HID = WS_PROJ;
constexpr size_t WS_D = al1m(WS_PROJ + (size_t)MT * ICP * 2);
constexpr size_t WS_LIN = al1m(WS_D + (size_t)MT * PWD * 2);
constexpr size_t WS_YA = al1m(WS_LIN + (size_t)MT * LK * 2);
constexpr size_t WS_DEC = al1m(WS_YA + (size_t)MT * PWD * 2);
constexpr size_t WS_BS = al1m(WS_DEC + (size_t)MT * RWD * 4);
constexpr size_t WS_Y = al1m(WS_BS + (size_t)MT * 16 * 4);
constexpr size_t SZ_BH = (size_t)MT * RWD * 2;
constexpr size_t WS_YB = al1m(WS_Y + (size_t)MT * RWD * 4);
constexpr size_t WS_TMP = al1m(WS_YB + SZ_BH);
constexpr size_t WS_MRG = al1m(WS_TMP + (size_t)MT * DM * 4);
constexpr size_t WS_SS = al1m(WS_MRG + (size_t)MT * DM * 2);
constexpr size_t WS_END_OLD = al1m(WS_MRG + (size_t)MT * DM * 2);
static_assert((size_t)MT * FF * 2 <= (size_t)MT * ICP * 2, "HID overlay");

constexpr size_t WS_XB2 = al1m(WS_SS + (size_t)3 * MT * 4);
constexpr size_t WS_END = al1m(WS_XB2 + (size_t)MT * DM * 2);
constexpr int CW_BAR = 4096;
constexpr int NWAVES = 8, NTHR = 512;
constexpr int RING_BYTES = 131072, LDSCTL_OFF = RING_BYTES, LDS_BYTES = 147456;

#define XB_TMO      128
#define XB_XCNT(j)  (256  + 64 * (j))
#define XB_XSUB(j)  (1280 + 64 * (j))
#define XB_XGEN(j)  (2304 + 64 * (j))
#define XB_TOP      3328
#define XB_TOPGEN   3392
#define XCD_BAR_WORDS 3456
#define XB_SPIN_CAP (1u << 18)

__device__ __forceinline__ unsigned xb_ld(unsigned* p)              { return __hip_atomic_load(p, __ATOMIC_RELAXED, __HIP_MEMORY_SCOPE_AGENT); }
__device__ __forceinline__ unsigned xb_add(unsigned* p, unsigned v) { return __hip_atomic_fetch_add(p, v, __ATOMIC_RELAXED, __HIP_MEMORY_SCOPE_AGENT); }
__device__ __forceinline__ unsigned xb_xcc_id() { return (unsigned)__builtin_amdgcn_s_getreg((3 << 11) | 20) & 0xFu; }
#define XB_SPIN(cond, bar) do { unsigned _sp = 0; while (cond) { __builtin_amdgcn_s_sleep(1); \
    if ((++_sp & 255u) == 0u) { if (xb_ld(&(bar)[XB_TMO])) break; if (_sp > XB_SPIN_CAP) { atomicAdd(&(bar)[XB_TMO], 1u); break; } } } } while (0)

struct XcdBarrier {
    unsigned* bar; unsigned x;
    volatile LAS unsigned* st;
};

__device__ __forceinline__ XcdBarrier xcd_barrier_post(unsigned* bar, volatile LAS unsigned* st) {
    XcdBarrier b; b.bar = bar; b.x = xb_xcc_id(); b.st = st;
    if (threadIdx.x == 0) (void)xb_add(&bar[XB_XCNT(b.x)], 1u);
    return b;
}
__device__ __forceinline__ void xcd_barrier_complete(unsigned* bar, unsigned x, unsigned& nloc, unsigned& nx) {
    const unsigned G = gridDim.x * gridDim.y * gridDim.z;
    unsigned sum, cnt, mine, sp = 0u;
    for (;;) {
        sum = 0u; cnt = 0u; mine = 0u;
#pragma unroll
        for (unsigned j = 0; j < 16; ++j) { const unsigned c = xb_ld(&bar[XB_XCNT(j)]); sum += c; cnt += (c > 0u) ? 1u : 0u; mine = (j == x) ? c : mine; }
        if (sum == G) break;
        __builtin_amdgcn_s_sleep(1);
        if ((++sp & 255u) == 0u) { if (xb_ld(&bar[XB_TMO])) break; if (sp > XB_SPIN_CAP) { atomicAdd(&bar[XB_TMO], 1u); break; } }
    }
    nloc = mine > 0u ? mine : 1u; nx = cnt > 0u ? cnt : 1u;
}

__device__ __forceinline__ void xcd_barrier(const XcdBarrier& b) {
    asm volatile("s_waitcnt vmcnt(0)" ::: "memory");
    __syncthreads();
    if (threadIdx.x == 0) {
        unsigned* bar = b.bar;
        __builtin_amdgcn_s_waitcnt(0);
        unsigned nloc = b.st[0], nx = b.st[1];
        if (nloc == 0u) { xcd_barrier_complete(bar, b.x, nloc, nx); b.st[0] = nloc; b.st[1] = nx; }
        const unsigned old = xb_add(&bar[XB_XSUB(b.x)], 1u);
        const unsigned gen = old / nloc;
        if (old + 1u == (gen + 1u) * nloc) {
            __builtin_amdgcn_fence(__ATOMIC_RELEASE, "agent");
            asm volatile("s_waitcnt vmcnt(0)" ::: "memory");
            const unsigned og = xb_add(&bar[XB_TOP], 1u);
            const unsigned tg = og / nx;
            if (og + 1u == (tg + 1u) * nx) xb_add(&bar[XB_TOPGEN], 1u);
            else XB_SPIN(xb_ld(&bar[XB_TOPGEN]) == tg, bar);
            __builtin_amdgcn_fence(__ATOMIC_ACQUIRE, "agent");
            xb_add(&bar[XB_XGEN(b.x)], 1u);
            asm volatile("s_waitcnt vmcnt(0)" ::: "memory");
        } else {
            XB_SPIN(xb_ld(&bar[XB_XGEN(b.x)]) == gen, bar);
            __builtin_amdgcn_fence(__ATOMIC_ACQUIRE, "agent");
            asm volatile("s_waitcnt vmcnt(0)" ::: "memory");
        }
    }
    __syncthreads();
}


struct Args {
    const float* in[33]; float* out; unsigned char* ws; int ph_lo, ph_hi;
};
struct Frame {
    LAS unsigned char* lds; int G;
    const LAS unsigned long long* ptab; float* out; unsigned char* ws;
};
#define GAS __attribute__((address_space(1)))
__device__ __forceinline__ const float* ldptr(const LAS unsigned long long* tab, int k) { const unsigned long long v = tab[k]; const unsigned lo = __builtin_amdgcn_readfirstlane((unsigned)v), hi = __builtin_amdgcn_readfirstlane((unsigned)(v >> 32));
    return (const float*)(const GAS float*)(((unsigned long long)hi << 32) | lo); }
__device__ __forceinline__ unsigned char* fresh(unsigned char* p) { GAS unsigned char* q = (GAS unsigned char*)p; asm volatile("" : "+s"(q)); return (unsigned char*)q; }
__device__ __forceinline__ int fresh_i(int v) { asm volatile("" : "+s"(v)); return v; }
#define INP(k) ldptr(F.ptab, (k))
#define PHASE_L const int l = fresh_i(l_in); (void)l;
#define PHASE_IDS int tid_ = threadIdx.x; asm volatile("" : "+v"(tid_)); const int tid = tid_, lane = tid & 63, wave = __builtin_amdgcn_readfirstlane(tid >> 6), gtid = blockIdx.x * NTHR + tid, gw = blockIdx.x * NWAVES + wave; (void)lane; (void)wave; (void)gtid; (void)gw;
#define VM_WAIT() asm volatile("s_waitcnt vmcnt(0)" ::: "memory")
#define LDS_WAIT() asm volatile("s_waitcnt lgkmcnt(0)" ::: "memory")
constexpr int NT_ALL_SHIFT = 9;

__device__ __forceinline__ void row_info(int m, int& b, int& t, bool& samp) { samp = m >= MPR; if (samp) { b = (m - MPR) >> 6; t = (m - MPR) & 63; } else { b = m >> 11; t = m & 2047; } }

__device__ __forceinline__ void transpose_item(const float* W, int N, bf16_t* WT, int ldk, int k0, int n0, int drow0, LAS float* scr, int lane, const float* cscale = nullptr, const float* rscale = nullptr) {
    f32x4 cs = (f32x4){1.f, 1.f, 1.f, 1.f}; if (cscale) cs = *(const f32x4*)(cscale + n0 + 4 * (lane & 7));
    const int c = lane & 7;
    f32x4 g0 = (f32x4){1.f, 1.f, 1.f, 1.f}, g1 = g0;
    if (rscale) { g0 = *(const f32x4*)(rscale + k0 + 8 * c); g1 = *(const f32x4*)(rscale + k0 + 8 * c + 4); }
    f32x4 v[8];
#pragma unroll
    for (int i = 0; i < 8; ++i) v[i] = *(const f32x4*)(W + (size_t)(k0 + 8 * i + (lane >> 3)) * N + n0 + 4 * (lane & 7));
#pragma unroll
    for (int i = 0; i < 8; ++i) { LAS float* d = scr + (8 * i + (lane >> 3)) * 33 + 4 * (lane & 7); const f32x4 t = v[i] * cs; d[0] = t.x; d[1] = t.y; d[2] = t.z; d[3] = t.w; }
    LDS_WAIT(); asm volatile("" ::: "memory");
#pragma unroll
    for (int j = 0; j < 4; ++j) { const int n = (lane >> 3) + 8 * j; const LAS float* sp = scr + (8 * c) * 33 + n;
        u32x4 o; o.x = cvt_pk_bf16(sp[0 * 33] * g0.x, sp[1 * 33] * g0.y); o.y = cvt_pk_bf16(sp[2 * 33] * g0.z, sp[3 * 33] * g0.w); o.z = cvt_pk_bf16(sp[4 * 33] * g1.x, sp[5 * 33] * g1.y); o.w = cvt_pk_bf16(sp[6 * 33] * g1.z, sp[7 * 33] * g1.w);
        *(u32x4*)(WT + (size_t)(drow0 + n) * ldk + k0 + 8 * c) = o; }
    LDS_WAIT(); asm volatile("" ::: "memory");
}
__device__ __forceinline__ void convert_weights(Frame& F, int l_in) {
    PHASE_IDS
    unsigned char* const wsl = fresh(F.ws);
    PHASE_L
    LAS float* scr = (LAS float*)(F.lds + wave * 16384);
    const int NGW = fresh_i(F.G) * NWAVES;
    unsigned char* ws = wsl;
    constexpr int I_WIN = (DM / 64) * (ICOLS / 32), I_PW = 4 * (256 / 64) * (256 / 32), I_PP = (PWD / 64) * (DM / 32), I_WO = (DM / 64) * (DM / 32), I_FG = (DM / 64) * (FF / 32),
                  I_FD = (FF / 64) * (DM / 32), I_PL = (PLE / 64) * (DM / 32);
    constexpr int NITEMS = I_WIN + I_PW + 2 * I_PP + I_WO + 2 * I_FG + I_FD + I_WO + I_PL;
    for (int it = gw; it < NITEMS; it += NGW) {
        int r = it;
        if (r < I_WIN) { const int nblk = ICOLS / 32, kb = r / nblk, nb = r % nblk, n0 = nb * 32; transpose_item(INP(8) + (size_t)l * DM * ICOLS, ICOLS, (bf16_t*)(ws + WS_WIN), DM, kb * 64, n0, n0 < 4384 ? n0 : n0 + 224, scr, lane, nullptr, INP(7) + (size_t)l * DM); continue; } r -= I_WIN;
        if (r < I_PW) { const int g = r >> 5, rr = r & 31, kb = rr >> 3, nb = rr & 7; transpose_item(INP(10) + ((size_t)l * 4 + g) * 65536, 256, (bf16_t*)(ws + WS_POOLW) + (size_t)g * 65536, 256, kb * 64, nb * 32, nb * 32, scr, lane, INP(11) + (size_t)l * PWD + g * 256); continue; } r -= I_PW;
        if (r < I_PP) { const int nblk = DM / 32, kb = r / nblk, nb = r % nblk; transpose_item(INP(22) + (size_t)l * PWD * DM, DM, (bf16_t*)(ws + WS_PPOOL), PWD, kb * 64, nb * 32, nb * 32, scr, lane); continue; } r -= I_PP;
        if (r < I_PP) { const int nblk = DM / 32, kb = r / nblk, nb = r % nblk; transpose_item(INP(23) + (size_t)l * RWD * DM, DM, (bf16_t*)(ws + WS_PRWKV), RWD, kb * 64, nb * 32, nb * 32, scr, lane); continue; } r -= I_PP;
        if (r < I_WO) { const int nblk = DM / 32, kb = r / nblk, nb = r % nblk; transpose_item(INP(24) + (size_t)l * DM * DM, DM, (bf16_t*)(ws + WS_WOUT), DM, kb * 64, nb * 32, nb * 32, scr, lane); continue; } r -= I_WO;
        if (r < I_FG) { const int nblk = FF / 32, kb = r / nblk, nb = r % nblk, n0 = nb * 32; transpose_item(INP(26) + (size_t)l * DM * FF, FF, (bf16_t*)(ws + WS_WGU), DM, kb * 64, n0, 256 * (n0 >> 7) + 64 * ((n0 & 127) >> 5), scr, lane, nullptr, INP(25) + (size_t)l * DM); continue; } r -= I_FG;
        if (r < I_FG) { const int nblk = FF / 32, kb = r / nblk, nb = r % nblk, n0 = nb * 32; transpose_item(INP(27) + (size_t)l * DM * FF, FF, (bf16_t*)(ws + WS_WGU), DM, kb * 64, n0, 256 * (n0 >> 7) + 64 * ((n0 & 127) >> 5) + 32, scr, lane, nullptr, INP(25) + (size_t)l * DM); continue; } r -= I_FG;
        if (r < I_FD) { const int nblk = DM / 32, kb = r / nblk, nb = r % nblk; transpose_item(INP(28) + (size_t)l * FF * DM, DM, (bf16_t*)(ws + WS_WDN), FF, kb * 64, nb * 32, nb * 32, scr, lane); continue; } r -= I_FD;
        if (r < I_WO) { const int nblk = DM / 32, kb = r / nblk, nb = r % nblk; transpose_item(INP(30) + (size_t)l * DM * DM, DM, (bf16_t*)(ws + WS_WPG), DM, kb * 64, nb * 32, nb * 32, scr, lane, nullptr, INP(29) + (size_t)l * DM); continue; } r -= I_WO;
        { const int nblk = DM / 32, kb = r / nblk, nb = r % nblk; transpose_item(INP(31) + (size_t)l * PLE * DM, DM, (bf16_t*)(ws + WS_WPP), PLE, kb * 64, nb * 32, nb * 32, scr, lane); }
    }
    const int NT = fresh_i(F.G) * NTHR;
    { u32x4* z = (u32x4*)((bf16_t*)(ws + WS_WIN) + (size_t)4384 * DM); for (int i = gtid; i < 224 * DM * 2 / 16; i += NT) z[i] = (u32x4){0u, 0u, 0u, 0u}; }
    { bf16_t* LT = (bf16_t*)(ws + WS_LORA); const float* wd = INP(13) + (size_t)l * 64 * RWD; const float* wa = INP(15) + (size_t)l * 64 * RWD; const float* wg = INP(16) + (size_t)l * 160 * RWD;
      for (int i = gtid; i < 3072 * (LK / 8); i += NT) { const int n = i / (LK / 8), k0 = (i % (LK / 8)) * 8; const int kind = n >> 10, c = n & 1023; float f[8];
#pragma unroll
          for (int j = 0; j < 8; ++j) { const int k = k0 + j; float v = 0.f;
              if (kind == 0) { if (k < 64) v = wd[(size_t)k * RWD + c]; }
              else if (kind == 1) { if (k >= 64 && k < 128) v = wa[(size_t)(k - 64) * RWD + c]; }
              else { if (k >= 128 && k < 288) v = wg[(size_t)(k - 128) * RWD + c]; }
              f[j] = v; }
          *(u32x4*)(LT + (size_t)n * LK + k0) = pack8(f); } }
    { bf16_t* PB = (bf16_t*)(ws + WS_PB); const float* pp = INP(5) + (size_t)l * MPR * PLE; const float* ps = INP(6) + (size_t)l * (MT - MPR) * PLE;
      for (int i = gtid; i < MT * PLE / 8; i += NT) { const size_t e = (size_t)i * 8; const float* src = e < (size_t)MPR * PLE ? pp + e : ps + (e - (size_t)MPR * PLE);
          const f32x4 a = *(const f32x4*)src, b = *(const f32x4*)(src + 4); *(u32x4*)(PB + e) = pg8::pack_f4x2(a, b); } }
}

__device__ __forceinline__ void xb_from_input(Frame& F) {
    PHASE_IDS
    unsigned char* const wsl = fresh(F.ws);
    const int NGW = fresh_i(F.G) * NWAVES; bf16_t* XB = (bf16_t*)(wsl + WS_XN); pg8::ss_t* SS = (pg8::ss_t*)(wsl + WS_SS);
    for (int m = gw; m < MT; m += NGW) {
        const float* src = m < MPR ? INP(0) + (size_t)m * DM : INP(1) + (size_t)(m - MPR) * DM;
        f32x4 v[8]; float s = 0.f;
#pragma unroll
        for (int j = 0; j < 8; ++j) { v[j] = *(const f32x4*)(src + 4 * lane + 256 * j); s += (v[j].x * v[j].x + v[j].y * v[j].y) + (v[j].z * v[j].z + v[j].w * v[j].w); }
        s = wave_sum(s);
        if (lane == 0) SS[m] = pg8::ss_fix(s);
#pragma unroll
        for (int j = 0; j < 8; ++j) { u32x2 w; w.x = cvt_pk_bf16(v[j].x, v[j].y); w.y = cvt_pk_bf16(v[j].z, v[j].w); *(u32x2*)(XB + (size_t)m * DM + 4 * lane + 256 * j) = w; }
    }
}
__device__ __forceinline__ void final_norm(Frame& F, const float* gain) {
    PHASE_IDS
    unsigned char* const wsl = fresh(F.ws);
    const int NGW = fresh_i(F.G) * NWAVES; const bf16_t* XB = (const bf16_t*)(wsl + ((NL & 1) ? WS_XB2 : WS_XN));
    f32x4 g[8];
#pragma unroll
    for (int j = 0; j < 8; ++j) g[j] = *(const f32x4*)(gain + 4 * lane + 256 * j);
    for (int m = gw; m < MT; m += NGW) {
        f32x4 v[8]; float s = 0.f;
#pragma unroll
        for (int j = 0; j < 8; ++j) { const u32x2 w = *(const u32x2*)(XB + (size_t)m * DM + 4 * lane + 256 * j); v[j] = (f32x4){bf_lo(w.x), bf_hi(w.x), bf_lo(w.y), bf_hi(w.y)};
            s += (v[j].x * v[j].x + v[j].y * v[j].y) + (v[j].z * v[j].z + v[j].w * v[j].w); }
        const float rstd = __builtin_amdgcn_rsqf(wave_sum(s) * (1.0f / DM) + NORM_EPS);
#pragma unroll
        for (int j = 0; j < 8; ++j) *(f32x4*)(F.out + (size_t)m * DM + 4 * lane + 256 * j) = v[j] * rstd * g[j];
    }
}

__device__ __forceinline__ void load_z(float (&z)[8], const bf16_t* PROJ, const float* past, int m0, int t, bool samp, int c0) {
    if (t >= 0) { unpack8(*(const u32x4*)(PROJ + (size_t)(m0 + t) * ICP + c0), z); }
    else if (samp) { const float* p = past + (size_t)(15 + t) * PWD + c0; const f32x4 a = *(const f32x4*)p, b = *(const f32x4*)(p + 4); z[0] = a.x; z[1] = a.y; z[2] = a.z; z[3] = a.w; z[4] = b.x; z[5] = b.y; z[6] = b.z; z[7] = b.w; }
    else {
#pragma unroll
        for (int j = 0; j < 8; ++j) z[j] = 0.f; }
}
__device__ __forceinline__ void prep1_phase(Frame& F, int l_in) {
    PHASE_IDS
    unsigned char* const wsl = fresh(F.ws);
    PHASE_L
    const int NT = fresh_i(F.G) * NTHR; const bf16_t* PROJ = (const bf16_t*)(wsl + WS_PROJ);
    { bf16_t* D = (bf16_t*)(wsl + WS_D);
      for (int it = gtid; it < (MT / 16) * 128; it += NT) {
          const int oct = it & 127, run = it >> 7, mrow = run * 16, c0 = oct * 8, win = 2 << (c0 >> 8);
          int b, t0; bool samp; row_info(mrow, b, t0, samp);
          const int T = samp ? TS : TP, mseq = mrow - t0;
          const float* past = INP(3) + ((size_t)l * 8 + b) * 15 * PWD;
          float* npool = F.out + (samp ? O_POS : O_POP) + ((size_t)l * 8 + b) * 15 * PWD;
          float S[8], z[8];
#pragma unroll
          for (int j = 0; j < 8; ++j) S[j] = 0.f;
          for (int j = 1; j < win; ++j) { load_z(z, PROJ, past, mseq, t0 - j, samp, c0);
#pragma unroll
              for (int q = 0; q < 8; ++q) S[q] += z[q]; }
          for (int i = 0; i < 16; ++i) { const int t = t0 + i; float cur[8]; load_z(cur, PROJ, past, mseq, t, samp, c0);
              const int cnt = samp ? win : (t + 1 < win ? t + 1 : win); const float inv = 1.0f / (float)cnt; float d[8];
#pragma unroll
              for (int q = 0; q < 8; ++q) { S[q] += cur[q]; d[q] = S[q] * inv - cur[q]; }
              *(u32x4*)(D + (size_t)(mseq + t) * PWD + c0) = pack8(d);
              if (t >= T - 15) { float* o = npool + (size_t)(t - (T - 15)) * PWD + c0; *(f32x4*)o = (f32x4){cur[0], cur[1], cur[2], cur[3]}; *(f32x4*)(o + 4) = (f32x4){cur[4], cur[5], cur[6], cur[7]}; }
              load_z(z, PROJ, past, mseq, t - win + 1, samp, c0);
#pragma unroll
              for (int q = 0; q < 8; ++q) S[q] -= z[q]; }
      } }
    { bf16_t* LIN = (bf16_t*)(wsl + WS_LIN); const float* mu = INP(9) + (size_t)l * RPJ + 3072;
      for (int it = gtid; it < MT * (LK / 8); it += NT) {
          const int m = it / (LK / 8), c0 = (it % (LK / 8)) * 8; float o[8];
          if (c0 >= 288) {
#pragma unroll
              for (int j = 0; j < 8; ++j) o[j] = 0.f;
          } else {
              int b, t; bool samp; row_info(m, b, t, samp);
              float cur[8], prv[8]; unpack8(*(const u32x4*)(PROJ + (size_t)m * ICP + 4096 + c0), cur);
              if (t > 0) unpack8(*(const u32x4*)(PROJ + (size_t)(m - 1) * ICP + 4096 + c0), prv);
              else if (samp) { const float* p = INP(2) + ((size_t)l * 8 + b) * RPJ + 3072 + c0;
#pragma unroll
                  for (int j = 0; j < 8; ++j) prv[j] = p[j]; }
              else {
#pragma unroll
                  for (int j = 0; j < 8; ++j) prv[j] = 0.f; }
#pragma unroll
              for (int j = 0; j < 8; ++j) { const float xm = cur[j] + (prv[j] - cur[j]) * mu[c0 + j]; o[j] = c0 < 64 ? tanhf_(xm) : (c0 < 128 ? xm : sigmoidf_(xm)); }
          }
          *(u32x4*)(LIN + (size_t)m * LK + c0) = pack8(o);
      } }
    { pg8::ss_t* SS = (pg8::ss_t*)(wsl + WS_SS); for (int i = gtid; i < 3 * MT; i += NT) SS[i] = 0u; }
    for (int it = gtid; it < 16 * RPJ; it += NT) { const int s = it / RPJ, c = it % RPJ; const int mlast = s < 8 ? s * TP + TP - 1 : MPR + (s - 8) * TS + TS - 1;
        F.out[(s < 8 ? O_SHP : O_SHS) + ((size_t)l * 8 + (s & 7)) * RPJ + c] = __uint_as_float((unsigned)PROJ[(size_t)mlast * ICP + 1024 + c] << 16); }
}

constexpr int SC_TC = 32, SC_STEP = 6 * 64;
__device__ __forceinline__ float sum16(float x) { x += dpp_f<0xB1>(x); x += dpp_f<0x4E>(x); x += dpp_f<0x141>(x); x += dpp_f<0x140>(x); return x; }
__device__ __forceinline__ void unpack4(const u32x2 w, float (&f)[4]) { f[0] = bf_lo(w.x); f[1] = bf_hi(w.x); f[2] = bf_lo(w.y); f[3] = bf_hi(w.y); }
__device__ __forceinline__ void scan_phase(Frame& F, int l_in) {
    PHASE_IDS
    unsigned char* const wsl = fresh(F.ws);
    PHASE_L
    LAS float* buf = (LAS float*)F.lds;
    LAS float* ybuf = (LAS float*)(F.lds + 2 * SC_TC * SC_STEP * 4);
    const float* DEC = (const float*)(wsl + WS_DEC); const bf16_t* PROJ = (const bf16_t*)(wsl + WS_PROJ); const bf16_t* AA = (const bf16_t*)(wsl + WS_AA);
    float* Y = (float*)(wsl + WS_Y); float* BS = (float*)(wsl + WS_BS);
    const bool is_cons = wave < 4;
    const int ks = lane & 7, k0 = ks * 8, rl = (wave & 3) * 8 + (lane >> 3);
    const int ptid = tid & 255, st0 = ptid >> 4, q4 = (ptid & 15) * 4;
    for (int u = blockIdx.x; u < 512; u += fresh_i(F.G)) {
        const bool samp = u >= 256; const int half = u & 1, h = (u >> 1) & 15, b = (u >> 5) & 7;
        const int T = samp ? TS : TP, m0 = samp ? MPR + b * TS : b * TP, ch = h * 64 + q4, row = half * 32 + rl;
        const int nch = T / SC_TC;
        const float* mu = INP(9) + (size_t)l * RPJ;
        const f32x4 mur = *(const f32x4*)(mu + ch), muk = *(const f32x4*)(mu + 1024 + ch), muv = *(const f32x4*)(mu + 2048 + ch);
        const f32x4 ckk = *(const f32x4*)(INP(17) + (size_t)l * RWD + ch), cka = *(const f32x4*)(INP(18) + (size_t)l * RWD + ch), crk = *(const f32x4*)(INP(19) + (size_t)l * RWD + ch);
        const float* shp = INP(2) + ((size_t)l * 8 + b) * RPJ + ch;
        f32x2 S01, S23, S45, S67;
        if (samp) { const float* sp = INP(4) + ((((size_t)l * 8 + b) * 16 + h) * 64 + row) * 64 + k0; const f32x4 s0 = *(const f32x4*)sp, s1 = *(const f32x4*)(sp + 4);
            S01 = (f32x2){s0.x, s0.y}; S23 = (f32x2){s0.z, s0.w}; S45 = (f32x2){s1.x, s1.y}; S67 = (f32x2){s1.z, s1.w}; }
        else { S01 = (f32x2){0.f, 0.f}; S23 = S01; S45 = S01; S67 = S01; }
        u32x2 rw[2][7]; f32x4 rd[2];
#define SC_LOADRAW(c) do { _Pragma("unroll") for (int i2 = 0; i2 < 2; ++i2) { const int tt = (c) * SC_TC + st0 + 16 * i2; const size_t mm = (size_t)(m0 + tt); const bf16_t* pc = PROJ + mm * ICP + 1024 + ch; \
        rw[i2][0] = *(const u32x2*)pc; rw[i2][1] = *(const u32x2*)(pc + 1024); rw[i2][2] = *(const u32x2*)(pc + 2048); rw[i2][6] = *(const u32x2*)(AA + mm * RWD + ch); rd[i2] = *(const f32x4*)(DEC + mm * RWD + ch); \
        if (tt > 0) { rw[i2][3] = *(const u32x2*)(pc - ICP); rw[i2][4] = *(const u32x2*)(pc - ICP + 1024); rw[i2][5] = *(const u32x2*)(pc - ICP + 2048); } \
        else { rw[i2][3] = (u32x2){0u, 0u}; rw[i2][4] = rw[i2][3]; rw[i2][5] = rw[i2][3]; } } } while (0)
#define SC_BUILD(c, bufp) do { _Pragma("unroll") for (int i2 = 0; i2 < 2; ++i2) { const int st = st0 + 16 * i2, tt = (c) * SC_TC + st; const size_t mm = (size_t)(m0 + tt); \
        float xr[4], xk[4], xv[4], yr[4], yk[4], yv[4], av[4]; unpack4(rw[i2][0], xr); unpack4(rw[i2][1], xk); unpack4(rw[i2][2], xv); unpack4(rw[i2][3], yr); unpack4(rw[i2][4], yk); unpack4(rw[i2][5], yv); unpack4(rw[i2][6], av); \
        const f32x4 cd = rd[i2]; \
        if (samp && tt == 0) { const f32x4 t0 = *(const f32x4*)shp, t1 = *(const f32x4*)(shp + 1024), t2 = *(const f32x4*)(shp + 2048); _Pragma("unroll") for (int j = 0; j < 4; ++j) { yr[j] = t0[j]; yk[j] = t1[j]; yv[j] = t2[j]; } } \
        f32x4 vr, vk, vv4, vq, vb, vh; float ss = 0.f, bsum = 0.f; \
        _Pragma("unroll") for (int j = 0; j < 4; ++j) { vr[j] = xr[j] + (yr[j] - xr[j]) * mur[j]; vk[j] = xk[j] + (yk[j] - xk[j]) * muk[j]; vv4[j] = xv[j] + (yv[j] - xv[j]) * muv[j]; \
            vq[j] = vk[j] * ckk[j]; ss += vq[j] * vq[j]; vh[j] = vk[j] * (1.0f + (av[j] - 1.0f) * cka[j]); bsum += vr[j] * vh[j] * crk[j]; } \
        ss = sum16(ss); bsum = sum16(bsum); const float inv = 1.0f / fmaxf(sqrtf(ss), 1e-12f); \
        _Pragma("unroll") for (int j = 0; j < 4; ++j) { vq[j] *= inv; vb[j] = vq[j] * av[j]; } \
        LAS float* d = (bufp) + st * SC_STEP + q4; *(LAS f32x4*)d = cd; *(LAS f32x4*)(d + 64) = vq; *(LAS f32x4*)(d + 128) = vb; *(LAS f32x4*)(d + 192) = vh; *(LAS f32x4*)(d + 256) = vr; *(LAS f32x4*)(d + 320) = vv4; \
        if (half == 0 && q4 == 0) BS[mm * 16 + h] = bsum; } } while (0)
#define SC_FLUSH(c) do { const int fs = ptid >> 3, fj = (ptid & 7) * 4; const f32x4 yo = *(const LAS f32x4*)(ybuf + ((c) & 1) * SC_TC * 32 + fs * 32 + fj); \
        *(f32x4*)(Y + (size_t)(m0 + (c) * SC_TC + fs) * RWD + h * 64 + half * 32 + fj) = yo; } while (0)
        __syncthreads();
        if (!is_cons) { SC_LOADRAW(0); SC_BUILD(0, buf); if (nch > 1) SC_LOADRAW(1); }
        __syncthreads();
        for (int c = 0; c < nch; ++c) {
            LAS float* cur = buf + (c & 1) * SC_TC * SC_STEP; LAS float* oth = buf + ((c + 1) & 1) * SC_TC * SC_STEP; LAS float* yb = ybuf + (c & 1) * SC_TC * 32;
            if (is_cons) {
#define SC_STEP_BODY(s, DO_Y) do { const LAS float* p = cur + (s) * SC_STEP + k0; \
                const f32x4 wa = *(const LAS f32x4*)p, wb = *(const LAS f32x4*)(p + 4), qa = *(const LAS f32x4*)(p + 64), qb = *(const LAS f32x4*)(p + 68), ba = *(const LAS f32x4*)(p + 128), bb = *(const LAS f32x4*)(p + 132), \
                            ha = *(const LAS f32x4*)(p + 192), hb = *(const LAS f32x4*)(p + 196), ra = *(const LAS f32x4*)(p + 256), rb = *(const LAS f32x4*)(p + 260); \
                const float vv = cur[(s) * SC_STEP + 320 + row]; const f32x2 v2 = (f32x2){vv, vv}; \
                f32x2 d = S01 * (f32x2){qa.x, qa.y}; f32x2 d1 = S23 * (f32x2){qa.z, qa.w}; d = S45 * (f32x2){qb.x, qb.y} + d; d1 = S67 * (f32x2){qb.z, qb.w} + d1; d = d + d1; float sa = d.x + d.y; \
                float yv = 0.f; if (DO_Y) { f32x2 e = S01 * (f32x2){rpa.x, rpa.y}; f32x2 e1 = S23 * (f32x2){rpa.z, rpa.w}; e = S45 * (f32x2){rpb.x, rpb.y} + e; e1 = S67 * (f32x2){rpb.z, rpb.w} + e1; e = e + e1; yv = e.x + e.y; } \
                const f32x2 t01 = S01 * (f32x2){wa.x, wa.y} + v2 * (f32x2){ha.x, ha.y}, t23 = S23 * (f32x2){wa.z, wa.w} + v2 * (f32x2){ha.z, ha.w}, t45 = S45 * (f32x2){wb.x, wb.y} + v2 * (f32x2){hb.x, hb.y}, t67 = S67 * (f32x2){wb.z, wb.w} + v2 * (f32x2){hb.z, hb.w}; \
                sa += dpp_f<0xB1>(sa); if (DO_Y) yv += dpp_f<0xB1>(yv); sa += dpp_f<0x4E>(sa); if (DO_Y) yv += dpp_f<0x4E>(yv); sa += dpp_f<0x141>(sa); if (DO_Y) yv += dpp_f<0x141>(yv); \
                const f32x2 n2 = (f32x2){-sa, -sa}; \
                S01 = n2 * (f32x2){ba.x, ba.y} + t01; S23 = n2 * (f32x2){ba.z, ba.w} + t23; S45 = n2 * (f32x2){bb.x, bb.y} + t45; S67 = n2 * (f32x2){bb.z, bb.w} + t67; \
                if (DO_Y) yb[((s) - 1) * 32 + rl] = yv; rpa = ra; rpb = rb; } while (0)
                f32x4 rpa, rpb;
                SC_STEP_BODY(0, false);
#pragma unroll 2
                for (int s = 1; s < SC_TC; ++s) SC_STEP_BODY(s, true);
                { f32x2 e = S01 * (f32x2){rpa.x, rpa.y}; f32x2 e1 = S23 * (f32x2){rpa.z, rpa.w}; e = S45 * (f32x2){rpb.x, rpb.y} + e; e1 = S67 * (f32x2){rpb.z, rpb.w} + e1; e = e + e1; yb[(SC_TC - 1) * 32 + rl] = sum8(e.x + e.y); }
#undef SC_STEP_BODY
            } else {
                if (c + 1 < nch) SC_BUILD(c + 1, oth);
                if (c + 2 < nch) SC_LOADRAW(c + 2);
                if (c > 0) SC_FLUSH(c - 1);
            }
            __syncthreads();
        }
        if (!is_cons) SC_FLUSH(nch - 1);
#undef SC_BUILD
#undef SC_LOADRAW
#undef SC_FLUSH
        if (is_cons) { float* so = F.out + (samp ? O_WKS : O_WKP) + ((((size_t)l * 8 + b) * 16 + h) * 64 + row) * 64 + k0;
            *(f32x4*)so = (f32x4){S01.x, S01.y, S23.x, S23.y}; *(f32x4*)(so + 4) = (f32x4){S45.x, S45.y, S67.x, S67.y}; }
    }
}

__device__ __forceinline__ void post_phase(Frame& F, int l_in) {
    PHASE_IDS
    unsigned char* const wsl = fresh(F.ws);
    PHASE_L
    const int NT = fresh_i(F.G) * NTHR; const float* Y = (const float*)(wsl + WS_Y); const float* BS = (const float*)(wsl + WS_BS);
    const bf16_t* PROJ = (const bf16_t*)(wsl + WS_PROJ); const bf16_t* GG = (const bf16_t*)(wsl + WS_GG);
    bf16_t* YB = (bf16_t*)(wsl + WS_YB);
    const float* muv = INP(9) + (size_t)l * RPJ + 2048; const float* gng = INP(20) + (size_t)l * RWD; const float* gnb = INP(21) + (size_t)l * RWD;
#define PP_LOAD(it_, Y0, Y1, CU, PR, GV, BSV) do { const int m_ = (it_) >> 7, c_ = ((it_) & 127) * 8; const size_t o_ = (size_t)m_ * RWD + c_; int b_, t_; bool s_; row_info(m_, b_, t_, s_); \
        Y0 = *(const f32x4*)(Y + o_); Y1 = *(const f32x4*)(Y + o_ + 4); CU = *(const u32x4*)(PROJ + (size_t)m_ * ICP + 3072 + c_); PR = *(const u32x4*)(PROJ + (size_t)(t_ > 0 ? m_ - 1 : m_) * ICP + 3072 + c_); \
        GV = *(const u32x4*)(GG + o_); BSV = BS[(size_t)m_ * 16 + (c_ >> 6)]; } while (0)
    f32x4 y0, y1, ny0, ny1; u32x4 cu, pr, gv, ncu, npr, ngv; float bs, nbs;
    if (gtid < MT * 128) PP_LOAD(gtid, y0, y1, cu, pr, gv, bs);
    for (int it = gtid; it < MT * 128; it += NT) {
        const int itn = it + NT;
        if (itn < MT * 128) PP_LOAD(itn, ny0, ny1, ncu, npr, ngv, nbs);
        const int m = it >> 7, c0 = (it & 127) * 8; const size_t o = (size_t)m * RWD + c0;
        int b, t; bool samp; row_info(m, b, t, samp);
        float y[8] = {y0.x, y0.y, y0.z, y0.w, y1.x, y1.y, y1.z, y1.w};
        float cur[8], prv[8], g[8]; unpack8(cu, cur); unpack8(gv, g); unpack8(pr, prv);
        if (t == 0) {
            if (samp) { const float* p = INP(2) + ((size_t)l * 8 + b) * RPJ + 2048 + c0;
#pragma unroll
                for (int j = 0; j < 8; ++j) prv[j] = p[j]; }
            else {
#pragma unroll
                for (int j = 0; j < 8; ++j) prv[j] = 0.f; }
        }
        float s = 0.f;
#pragma unroll
        for (int j = 0; j < 8; ++j) s += y[j];
        s = sum8(s);
        const float mean = s * (1.0f / 64.0f); float q = 0.f;
#pragma unroll
        for (int j = 0; j < 8; ++j) { const float d = y[j] - mean; q += d * d; }
        q = sum8(q);
        const float rstd = __builtin_amdgcn_rsqf(q * (1.0f / 64.0f) + GN_EPS);
        float outv[8];
#pragma unroll
        for (int j = 0; j < 8; ++j) { const float v = cur[j] + (prv[j] - cur[j]) * muv[c0 + j]; outv[j] = ((y[j] - mean) * rstd * gng[c0 + j] + gnb[c0 + j] + bs * v) * g[j]; }
        *(u32x4*)(YB + o) = pack8(outv);
        y0 = ny0; y1 = ny1; cu = ncu; pr = npr; gv = ngv; bs = nbs;
    }
#undef PP_LOAD
}

__device__ __forceinline__ void tile64_mma(const bf16_t* A, int lda, const bf16_t* Bt, int ldb, int K, int m0, int n0, int wave, int lane, f32x4 (&acc)[4][4]) {
    const int kq = K >> 3, kb = wave * kq, lr = lane & 15, lk = (lane >> 4) * 8;
    const bf16_t* ap = A + (size_t)(m0 + lr) * lda + kb + lk; const bf16_t* bp = Bt + (size_t)(n0 + lr) * ldb + kb + lk;
#pragma unroll 2
    for (int k = 0; k < kq; k += 32) {
        bf16x8 af[4], bf[4];
#pragma unroll
        for (int i = 0; i < 4; ++i) { af[i] = *(const bf16x8*)(ap + (size_t)(16 * i) * lda + k); bf[i] = *(const bf16x8*)(bp + (size_t)(16 * i) * ldb + k); }
#pragma unroll
        for (int mi = 0; mi < 4; ++mi)
#pragma unroll
            for (int ni = 0; ni < 4; ++ni) acc[mi][ni] = __builtin_amdgcn_mfma_f32_16x16x32_bf16(bf[ni], af[mi], acc[mi][ni], 0, 0, 0);
    }
}
__device__ __forceinline__ void tile64_reduce(LAS unsigned char* lds, int wave, int lane, const f32x4 (&acc)[4][4], f32x4 (&out)[2]) {
    LAS f32x4* red = (LAS f32x4*)lds;
    __syncthreads();
#pragma unroll
    for (int mi = 0; mi < 4; ++mi)
#pragma unroll
        for (int ni = 0; ni < 4; ++ni) red[(wave * 16 + mi * 4 + ni) * 64 + lane] = acc[mi][ni];
    __syncthreads();
#pragma unroll
    for (int j = 0; j < 2; ++j) { f32x4 s = red[(2 * wave + j) * 64 + lane];
#pragma unroll
        for (int w = 1; w < 8; ++w) s += red[(w * 16 + 2 * wave + j) * 64 + lane];
        out[j] = s; }
}
#define T64_ZERO(acc) do { _Pragma("unroll") for (int mi = 0; mi < 4; ++mi) _Pragma("unroll") for (int ni = 0; ni < 4; ++ni) acc[mi][ni] = (f32x4){0.f, 0.f, 0.f, 0.f}; } while (0)
template <int MODE>
__device__ __forceinline__ void sample_tiles(Frame& F, int l_in) {
    PHASE_IDS
    unsigned char* const wsl = fresh(F.ws);
    PHASE_L
    const size_t xb_cur = (l & 1) ? WS_XB2 : WS_XN, xb_nxt = (l & 1) ? WS_XN : WS_XB2;
    for (int t = blockIdx.x; t < 256; t += fresh_i(F.G)) {
        const int m0 = MPR + (t >> 5) * 64, n0 = (t & 31) * 64;
        f32x4 acc[4][4], o1[2], o2[2]; T64_ZERO(acc);
        if (MODE == 0) { tile64_mma((const bf16_t*)(wsl + WS_YA), PWD, (const bf16_t*)(wsl + WS_PPOOL), PWD, PWD, m0, n0, wave, lane, acc); tile64_reduce(F.lds, wave, lane, acc, o1);
                         T64_ZERO(acc); tile64_mma((const bf16_t*)(wsl + WS_YB), RWD, (const bf16_t*)(wsl + WS_PRWKV), RWD, RWD, m0, n0, wave, lane, acc); tile64_reduce(F.lds, wave, lane, acc, o2); }
        if (MODE == 1) { tile64_mma((const bf16_t*)(wsl + WS_MRG), DM, (const bf16_t*)(wsl + WS_WOUT), DM, DM, m0, n0, wave, lane, acc); tile64_reduce(F.lds, wave, lane, acc, o1); }
        if (MODE == 2) { tile64_mma((const bf16_t*)(wsl + WS_HID), FF, (const bf16_t*)(wsl + WS_WDN), FF, FF, m0, n0, wave, lane, acc); tile64_reduce(F.lds, wave, lane, acc, o1); }
        if (MODE == 3) { tile64_mma((const bf16_t*)(wsl + xb_cur), DM, (const bf16_t*)(wsl + WS_WPG), DM, DM, m0, n0, wave, lane, acc); tile64_reduce(F.lds, wave, lane, acc, o1); }
        if (MODE == 4) { tile64_mma((const bf16_t*)(wsl + WS_PB), PLE, (const bf16_t*)(wsl + WS_WPP), PLE, PLE, m0, n0, wave, lane, acc); tile64_reduce(F.lds, wave, lane, acc, o1); }
#pragma unroll
        for (int j = 0; j < 2; ++j) { const int blk = 2 * wave + j; const size_t row = (size_t)(m0 + 16 * (blk >> 2) + (lane & 15)); const int col = n0 + 16 * (blk & 3) + 4 * (lane >> 4);
            if (MODE == 0) { const bf16_t* PROJ = (const bf16_t*)(wsl + WS_PROJ); const u32x2 g1 = *(const u32x2*)(PROJ + row * ICP + PC_GP + col), g2 = *(const u32x2*)(PROJ + row * ICP + PC_GR + col);
                const f32x4 a = (f32x4){bf_lo(g1.x), bf_hi(g1.x), bf_lo(g1.y), bf_hi(g1.y)} * o1[j] + (f32x4){bf_lo(g2.x), bf_hi(g2.x), bf_lo(g2.y), bf_hi(g2.y)} * o2[j];
                *(u32x2*)((bf16_t*)(wsl + WS_MRG) + row * DM + col) = (u32x2){cvt_pk_bf16(a.x, a.y), cvt_pk_bf16(a.z, a.w)}; }
            if (MODE == 1 || MODE == 2) { bf16_t* p = (bf16_t*)(wsl + xb_cur) + row * DM + col; const u32x2 q = *(const u32x2*)p; const f32x4 x = (f32x4){bf_lo(q.x), bf_hi(q.x), bf_lo(q.y), bf_hi(q.y)} + o1[j];
                *(u32x2*)p = (u32x2){cvt_pk_bf16(x.x, x.y), cvt_pk_bf16(x.z, x.w)}; __hip_atomic_fetch_add((pg8::ss_t*)(wsl + WS_SS) + (size_t)MODE * MT + row, pg8::ss_fix((x.x * x.x + x.y * x.y) + (x.z * x.z + x.w * x.w)), __ATOMIC_RELAXED, __HIP_MEMORY_SCOPE_AGENT); }
            if (MODE == 3) { const u32x2 q = *(const u32x2*)((const bf16_t*)(wsl + WS_PP) + row * DM + col); const u32x2 xq = *(const u32x2*)((const bf16_t*)(wsl + xb_cur) + row * DM + col); bf16_t* p = (bf16_t*)(wsl + xb_nxt) + row * DM + col;
                const float rs = pg8::rstd_of((const pg8::ss_t*)(wsl + WS_SS) + (size_t)2 * MT, row);
                const f32x4 x = (f32x4){bf_lo(xq.x), bf_hi(xq.x), bf_lo(xq.y), bf_hi(xq.y)} + sigmoid4(o1[j] * rs) * (f32x4){bf_lo(q.x), bf_hi(q.x), bf_lo(q.y), bf_hi(q.y)};
                *(u32x2*)p = (u32x2){cvt_pk_bf16(x.x, x.y), cvt_pk_bf16(x.z, x.w)}; __hip_atomic_fetch_add((pg8::ss_t*)(wsl + WS_SS) + row, pg8::ss_fix((x.x * x.x + x.y * x.y) + (x.z * x.z + x.w * x.w)), __ATOMIC_RELAXED, __HIP_MEMORY_SCOPE_AGENT); }
            if (MODE == 4) *(u32x2*)((bf16_t*)(wsl + WS_PP) + row * DM + col) = (u32x2){cvt_pk_bf16(o1[j].x, o1[j].y), cvt_pk_bf16(o1[j].z, o1[j].w)};
        }
    }
    __syncthreads();
}

constexpr int PH_PER_LAYER = 11, N_PHASES = NL * PH_PER_LAYER + 1;
#ifndef MK_REP
#define MK_REP 0
#endif
__global__ void __launch_bounds__(NTHR, 2) mega_fwd(Args args) {
    extern __shared__ __attribute__((aligned(16))) unsigned char lds[];
    Frame F;
    F.lds = (LAS unsigned char*)lds;
    F.G = gridDim.x;
    F.out = args.out; F.ws = args.ws;
    { LAS unsigned long long* pt = (LAS unsigned long long*)(F.lds + LDSCTL_OFF + 1024); F.ptab = pt;
      if (threadIdx.x == 0) {
#define PT_(k) pt[k] = (unsigned long long)args.in[k];
          PT_(0) PT_(1) PT_(2) PT_(3) PT_(4) PT_(5) PT_(6) PT_(7) PT_(8) PT_(9) PT_(10) PT_(11) PT_(12) PT_(13) PT_(14) PT_(15) PT_(16) PT_(17) PT_(18) PT_(19) PT_(20) PT_(21) PT_(22) PT_(23) PT_(24) PT_(25) PT_(26) PT_(27) PT_(28) PT_(29) PT_(30) PT_(31) PT_(32)
#undef PT_
      } }
    volatile LAS unsigned* MISC = (volatile LAS unsigned*)(F.lds + LDSCTL_OFF);
    for (int u = threadIdx.x; u < 256; u += NTHR) ((LAS unsigned*)(F.lds + LDSCTL_OFF))[u] = 0u;
    __syncthreads();
    XcdBarrier bar; bar.bar = (unsigned*)(args.ws + WS_CTL) + CW_BAR; bar.x = 0; bar.st = nullptr;
    if (!MK_PER_PHASE) bar = xcd_barrier_post((unsigned*)(args.ws + WS_CTL) + CW_BAR, MISC + 8);
    const int lo = args.ph_lo, hi = args.ph_hi;
#define IN(k) (lo <= (k) && (k) < hi)
#define REP(k) (1 + ((MK_REP >> (k)) & 1))
#define PHASE(k, ...) do { if (IN(pb + (k))) { for (int rep = 0; rep < REP(k); ++rep) { if (rep) xcd_barrier(bar); __VA_ARGS__ } if (IN(pb + (k) + 1)) xcd_barrier(bar); } } while (0)
#define WSP(off) (fresh(F.ws) + (off))
#define UNPAREN(...) __VA_ARGS__
#define GEMM_M(M_, EPI, EINIT, Aoff, Boff, N_, K_, lda_, ldb_, apn_) do { pg8::Gemm g{(const bf16_t*)WSP(Aoff), (const bf16_t*)WSP(Boff), (M_), (N_), (K_), (lda_), (ldb_), (apn_)}; pg8::StaticOrder S; S.init((M_), (N_), fresh_i(F.G), fresh_i(cid)); \
        pg8::EPI E{UNPAREN EINIT}; pg8::gemm_phase<pg8::EPI, pg8::StaticOrder, true>(ring, g, S, E); } while (0)
#define GEMM(...) GEMM_M(MT, __VA_ARGS__)
    LAS unsigned char* ring = F.lds;
    const int cid = (int)blockIdx.x;
    for (int l = 0; l < NL; ++l) {
        const int pb = l * PH_PER_LAYER;
#define SSP(i) ((pg8::ss_t*)WSP(WS_SS) + (size_t)(i) * MT)
        const size_t xb_cur = (l & 1) ? WS_XB2 : WS_XN, xb_nxt = (l & 1) ? WS_XN : WS_XB2;
        PHASE(0, { convert_weights(F, l); if (l == 0) xb_from_input(F); });
        PHASE(1, { GEMM(EpiProj, ((bf16_t*)WSP(WS_PROJ), SSP(0)), xb_cur, WS_WIN, ICP, DM, DM, DM, 0); });
        PHASE(2, { prep1_phase(F, l); });
        PHASE(3, { GEMM(EpiBf16, ((bf16_t*)WSP(WS_YA), PWD), WS_D, WS_POOLW, PWD, 256, PWD, 256, 256);
                   GEMM(EpiLora, ((float*)WSP(WS_DEC), (bf16_t*)WSP(WS_AA), (bf16_t*)WSP(WS_GG), INP(12) + (size_t)fresh_i(l) * RWD, INP(14) + (size_t)fresh_i(l) * RWD), WS_LIN, WS_LORA, 3072, LK, LK, LK, 0); });
        PHASE(4, { scan_phase(F, l); });
        PHASE(5, { post_phase(F, l); });
        PHASE(6, { GEMM_M(MPR, EpiGate1, ((bf16_t*)WSP(WS_TMP), (const bf16_t*)WSP(WS_PROJ), PC_GP), WS_YA, WS_PPOOL, DM, PWD, PWD, PWD, 0);
                   GEMM_M(MPR, EpiGate2, ((const bf16_t*)WSP(WS_TMP), (const bf16_t*)WSP(WS_PROJ), PC_GR, (bf16_t*)WSP(WS_MRG)), WS_YB, WS_PRWKV, DM, RWD, RWD, RWD, 0);
                   sample_tiles<0>(F, l); });
        PHASE(7, { GEMM_M(MPR, EpiResid, ((bf16_t*)WSP(xb_cur), SSP(1)), WS_MRG, WS_WOUT, DM, DM, DM, DM, 0); sample_tiles<1>(F, l); });
        PHASE(8, { GEMM(EpiSwiglu, ((bf16_t*)WSP(WS_HID), SSP(1)), xb_cur, WS_WGU, 2 * FF, DM, DM, DM, 0);
                   GEMM_M(MPR, EpiBf16, ((bf16_t*)WSP(WS_PP), DM), WS_PB, WS_WPP, DM, PLE, PLE, PLE, 0); sample_tiles<4>(F, l); });
        PHASE(9, { GEMM_M(MPR, EpiResid, ((bf16_t*)WSP(xb_cur), SSP(2)), WS_HID, WS_WDN, DM, FF, FF, FF, 0); sample_tiles<2>(F, l); });
        PHASE(10, { GEMM_M(MPR, EpiPle, ((const bf16_t*)WSP(xb_cur), (bf16_t*)WSP(xb_nxt), (const bf16_t*)WSP(WS_PP), SSP(2), SSP(0)), xb_cur, WS_WPG, DM, DM, DM, DM, 0); sample_tiles<3>(F, l); });
#undef SSP
    }
    if (IN(NL * PH_PER_LAYER)) final_norm(F, INP(32));
#undef IN
#undef REP
#undef PHASE
#undef WSP
#undef GEMM
#undef GEMM_M
#undef UNPAREN
}

extern "C" void kernel_launch(void* const* d_in, const int* in_sizes, int n_in, void* d_out, int out_size, void* d_ws, size_t ws_size, hipStream_t stream) {
    static int grid = 0;
    if (grid == 0) {
        if (n_in != 33 || in_sizes[0] != MPR * DM || out_size != (int)O_END || ws_size < WS_END) {
            fprintf(stderr, "kernel_launch: unexpected shapes: n_in %d in0 %d out %d ws %zu (need %zu); nothing launched\n", n_in, n_in > 0 ? in_sizes[0] : -1, out_size, ws_size, (size_t)WS_END); grid = -1; return; }
        int dev = 0, cus = 0, per_cu = 0;
        if (hipGetDevice(&dev) != hipSuccess || hipDeviceGetAttribute(&cus, hipDeviceAttributeMultiprocessorCount, dev) != hipSuccess) { grid = -1; return; }
        if (hipFuncSetAttribute((const void*)mega_fwd, hipFuncAttributeMaxDynamicSharedMemorySize, LDS_BYTES) != hipSuccess) { fprintf(stderr, "kernel_launch: hipFuncSetAttribute failed\n"); grid = -1; return; }
        if (hipOccupancyMaxActiveBlocksPerMultiprocessor(&per_cu, (const void*)mega_fwd, NTHR, LDS_BYTES) != hipSuccess || per_cu < 1) { fprintf(stderr, "kernel_launch: occupancy query says %d\n", per_cu); (void)hipGetLastError(); grid = -1; return; }
        grid = cus;
    }
    if (grid < 0) return;
    (void)hipMemsetAsync((char*)d_ws + WS_CTL, 0, CTL_ZERO_BYTES, stream);
    Args a; memset(&a, 0, sizeof(a));
    for (int i = 0; i < 33; ++i) a.in[i] = (const float*)d_in[i];
    a.out = (float*)d_out; a.ws = (unsigned char*)d_ws;
#if MK_PER_PHASE
    for (int p = 0; p < N_PHASES; ++p) { a.ph_lo = p; a.ph_hi = p + 1; hipLaunchKernelGGL(mega_fwd, dim3(grid), dim3(NTHR), LDS_BYTES, stream, a); }
#else
    a.ph_lo = 0; a.ph_hi = N_PHASES; hipLaunchKernelGGL(mega_fwd, dim3(grid), dim3(NTHR), LDS_BYTES, stream, a);
#endif
}
```

```cpp
#include <hip/hip_runtime.h>
#include <cstdio>
#include <cstdint>
#include <cstring>

#ifndef MK_PER_PHASE
#define MK_PER_PHASE 0
#endif

#define LAS __attribute__((address_space(3)))
typedef unsigned short bf16_t;
typedef short bf16x8 __attribute__((ext_vector_type(8)));
typedef float f32x4 __attribute__((ext_vector_type(4)));
typedef float f32x2 __attribute__((ext_vector_type(2)));
typedef unsigned u32x4 __attribute__((ext_vector_type(4)));
typedef unsigned u32x2 __attribute__((ext_vector_type(2)));

constexpr int DM = 2048, NL = 4, MT = 16896, MPR = 16384, TP = 2048, TS = 64;
constexpr int PWD = 1024, RWD = 1024, RPJ = 3360, ICOLS = 8480, ICP = 8704, FF = 5632, PLE = 256, LK = 384;
constexpr int PC_GP = 4608, PC_GR = 6656;
constexpr float NORM_EPS = 1e-6f, GN_EPS = 64e-5f;
constexpr size_t O_YS = 33554432, O_SHP = 34603008, O_POP = 34710528, O_WKP = 35202048, O_SHS = 37299200, O_POS = 37406720, O_WKS = 37898240, O_END = 39995392;

__device__ __forceinline__ unsigned cvt_pk_bf16(float lo, float hi) { unsigned r; asm volatile("v_cvt_pk_bf16_f32 %0, %1, %2" : "=v"(r) : "v"(lo), "v"(hi)); return r; }
__device__ __forceinline__ float bf_lo(unsigned u) { return __uint_as_float(u << 16); }
__device__ __forceinline__ float bf_hi(unsigned u) { return __uint_as_float(u & 0xffff0000u); }
__device__ __forceinline__ void unpack8(const u32x4 w, float (&f)[8]) { f[0] = bf_lo(w.x); f[1] = bf_hi(w.x); f[2] = bf_lo(w.y); f[3] = bf_hi(w.y); f[4] = bf_lo(w.z); f[5] = bf_hi(w.z); f[6] = bf_lo(w.w); f[7] = bf_hi(w.w); }
__device__ __forceinline__ u32x4 pack8(const float (&f)[8]) { u32x4 w; w.x = cvt_pk_bf16(f[0], f[1]); w.y = cvt_pk_bf16(f[2], f[3]); w.z = cvt_pk_bf16(f[4], f[5]); w.w = cvt_pk_bf16(f[6], f[7]); return w; }
__device__ __forceinline__ float sigmoidf_(float x) { return __builtin_amdgcn_rcpf(1.0f + __expf(-x)); }
__device__ __forceinline__ f32x4 sigmoid4(f32x4 v) { f32x4 o; o.x = sigmoidf_(v.x); o.y = sigmoidf_(v.y); o.z = sigmoidf_(v.z); o.w = sigmoidf_(v.w); return o; }
__device__ __forceinline__ float tanhf_(float x) { const float e = __expf(2.0f * x); return 1.0f - 2.0f * __builtin_amdgcn_rcpf(e + 1.0f); }
template <int CTRL> __device__ __forceinline__ float dpp_f(float x) { return __uint_as_float((unsigned)__builtin_amdgcn_update_dpp(0, (int)__float_as_uint(x), CTRL, 0xF, 0xF, true)); }
__device__ __forceinline__ float sum8(float x) { x += dpp_f<0xB1>(x); x += dpp_f<0x4E>(x); x += dpp_f<0x141>(x); return x; }
__device__ __forceinline__ float wave_sum(float x) {
    x += dpp_f<0xB1>(x); x += dpp_f<0x4E>(x); x += dpp_f<0x141>(x); x += dpp_f<0x140>(x);
    x += __uint_as_float((unsigned)__builtin_amdgcn_ds_swizzle((int)__float_as_uint(x), 0x401F));
    return __uint_as_float((unsigned)__builtin_amdgcn_readlane((int)__float_as_uint(x), 0)) + __uint_as_float((unsigned)__builtin_amdgcn_readlane((int)__float_as_uint(x), 32));
}

namespace pg8 {
typedef unsigned ss_t;
constexpr int BM = 256, BK = 64, HALF = 128, HTB = HALF * BK * 2  , STAGE_BYTES = 8 * HTB, NXCD = 8, WGM = 8;
__host__ __device__ __forceinline__ int lds_byte(int r, int c) { const int st = (r >> 4) * 2 + (c >> 5), rr = r & 15, cc = c & 31, ob = rr * 64 + cc * 2; return st * 1024 + (ob ^ (((ob >> 9) & 1) << 5)); }
__host__ __device__ __forceinline__ void stage_rc(int b, int& R, int& C) { const int st = b / 1024, sb = b % 1024, swz = sb ^ (((sb >> 9) & 1) << 5); R = (st >> 1) * 16 + swz / 64; C = (st & 1) * 32 + (swz % 64) / 2; }
__host__ __device__ __forceinline__ int perm32(int rho) { const int n = rho >> 4, i = rho & 15; return 8 * (i >> 2) + 4 * n + (i & 3); }

struct Unit { int pm, pn; };
struct Gemm { const bf16_t* A; const bf16_t* Bt; int M, N, K, lda, ldb, a_pn_off; };

struct StaticOrder {
    int nM, nN, nwg, G, c;
    __host__ __device__ void init(int M, int N, int G_, int c_) { nM = M / BM; nN = N / BM; nwg = nM * nN; G = G_; c = c_; }
    __host__ __device__ bool next(int i, Unit& u) const {
        const long L = (long)i * G + c; if (L >= nwg) return false;
        int wgid = (int)L; { const int q = nwg / NXCD, r = nwg % NXCD, xcd = wgid % NXCD, off = wgid / NXCD; wgid = (xcd < r ? xcd * (q + 1) : r * (q + 1) + (xcd - r) * q) + off; }
        const int nig = WGM * nN, gid = wgid / nig, fm = gid * WGM, gsz = (nM - fm) < WGM ? (nM - fm) : WGM;
        u.pm = fm + ((wgid % nig) % gsz); u.pn = (wgid % nig) / gsz; return true;
    }
    __device__ __forceinline__ void a_ready(const Unit&) const {}
    __device__ __forceinline__ void done(const Unit&) const {}
};

__device__ __forceinline__ void acc_zero(f32x4 (&acc)[2][2][4][2]) {
#pragma unroll
    for (int a = 0; a < 2; ++a)
#pragma unroll
        for (int b = 0; b < 2; ++b)
#pragma unroll
            for (int m = 0; m < 4; ++m)
#pragma unroll
                for (int n = 0; n < 2; ++n) acc[a][b][m][n] = (f32x4){0.f, 0.f, 0.f, 0.f};
}
struct RepeatOrder : StaticOrder {
    __host__ __device__ bool next(int i, Unit& u) const { if (i >= 6) return false; return StaticOrder::next(i % 3, u) || StaticOrder::next(0, u); }
};
#define EPI_ZERO_INIT __device__ __forceinline__ void init(f32x4 (&acc)[2][2][4][2], const Unit&, int, int, int, int) const { acc_zero(acc); }
#define EPI_NO_PRE __device__ __forceinline__ void preload(ss_t (&pre)[2], const Unit&, int, int, int) const {}
#define EPI_SS_PRE(SSPTR) __device__ __forceinline__ void preload(ss_t (&pre)[2], const Unit& u, int wr, int fr, int fq) const { _Pragma("unroll") for (int j = 0; j < 2; ++j) { const int g = 2 * fq + j; \
        pre[j] = (SSPTR)[(size_t)(u.pm * BM + (g >> 2) * HALF + wr * 64 + (g & 3) * 16 + fr)]; } }
__device__ __forceinline__ ss_t pre_get(const ss_t (&pre)[2], int g, int fr) { return (ss_t)__builtin_amdgcn_ds_bpermute((((g >> 1) << 4) + fr) << 2, (int)pre[g & 1]); }
template <class Epi, class Sched, bool ALIGN_EPI>
__device__ __forceinline__ void gemm_phase(LAS unsigned char* lds, const Gemm g, const Sched& S, const Epi& E) {
    int tid_ = threadIdx.x; asm volatile("" : "+v"(tid_));
    const int tid = tid_, wid = __builtin_amdgcn_readfirstlane(tid >> 6), lane = tid & 63, wr = wid >> 2, wc = wid & 3, fr = lane & 15, fq = lane >> 4;
    int K_ = g.K; asm volatile("" : "+s"(K_));
    const int K = K_, nt = K / BK;
    unsigned voffA[2], voffB[2];
#pragma unroll
    for (int i = 0; i < 2; ++i) { int R, C; stage_rc(tid * 16 + i * 8192, R, C); const int Rb = Epi::PERM ? (64 * (R >> 5) + perm32(R & 31)) : R;
        voffA[i] = (unsigned)(R * g.lda + C) * 2u; voffB[i] = (unsigned)(Rb * g.ldb + C) * 2u; }
    const size_t kstep = (size_t)(BK * 2);
    const size_t hstepA = (size_t)HALF * g.lda * 2, hstepB = (size_t)(Epi::PERM ? 32 : HALF) * g.ldb * 2;
    const unsigned ldsw = (unsigned)wid * 1024u;
    const int aoff = lds_byte(wr * 64 + fr, fq * 8), boff = lds_byte(wc * 32 + fr, fq * 8);
#define PG8_SA(b, h) (((b) * 2 + (h)) * HTB)
#define PG8_SB(b, h) ((4 + (b) * 2 + (h)) * HTB)
#define PG8_STAGE(bufoff, gbase, voff) do { _Pragma("unroll") for (int _i = 0; _i < 2; ++_i) \
        __builtin_amdgcn_global_load_lds((const unsigned*)((const char*)(gbase) + (voff)[_i]), (LAS unsigned*)(lds + (bufoff) + ldsw + _i * 8192), 16, 0, 0); } while (0)
#define PG8_LDA(dst, b, h) do { _Pragma("unroll") for (int m = 0; m < 4; ++m) _Pragma("unroll") for (int k = 0; k < 2; ++k) dst[m][k] = *(const LAS bf16x8*)(lds + PG8_SA(b, h) + aoff + m * 2048 + k * 1024); } while (0)
#define PG8_LDB(dst, b, h) do { _Pragma("unroll") for (int n = 0; n < 2; ++n) _Pragma("unroll") for (int k = 0; k < 2; ++k) dst[n][k] = *(const LAS bf16x8*)(lds + PG8_SB(b, h) + boff + n * 2048 + k * 1024); } while (0)
#define PG8_MMA(ai, bj, At, Bt) do { __builtin_amdgcn_s_setprio(1); _Pragma("unroll") for (int m = 0; m < 4; ++m) _Pragma("unroll") for (int n = 0; n < 2; ++n) _Pragma("unroll") for (int k = 0; k < 2; ++k) \
        acc[ai][bj][m][n] = __builtin_amdgcn_mfma_f32_16x16x32_bf16(Bt[n][k], At[m][k], acc[ai][bj][m][n], 0, 0, 0); __builtin_amdgcn_s_setprio(0); } while (0)
#define PG8_WAIT_V(n) asm volatile("s_waitcnt vmcnt(" #n ")" ::: "memory")
#define PG8_WAIT_L(n) asm volatile("s_waitcnt lgkmcnt(" #n ")" ::: "memory")
#define PG8_BAR __builtin_amdgcn_s_barrier()
#define PG8_SCHED __builtin_amdgcn_sched_barrier(0)
    Unit cur, nxt; int ui = 0;
    if (!S.next(0, cur)) return;
    f32x4 acc[2][2][4][2]; ss_t pre[2];
    E.init(acc, cur, wr, wc, fr, fq); E.preload(pre, cur, wr, fr, fq);
    bf16x8 At[4][2], B0[2][2], B1[2][2];
    const char* cA = (const char*)g.A + ((size_t)cur.pm * BM * g.lda + (size_t)cur.pn * g.a_pn_off) * 2; const char* cB = (const char*)g.Bt + (size_t)cur.pn * BM * g.ldb * 2;
    S.a_ready(cur);
    PG8_STAGE(PG8_SB(0, 0), cB, voffB); PG8_STAGE(PG8_SB(0, 1), cB + hstepB, voffB); PG8_STAGE(PG8_SA(0, 0), cA, voffA); PG8_STAGE(PG8_SA(0, 1), cA + hstepA, voffA);
    if (wr == 1) PG8_BAR;
    PG8_WAIT_V(2); PG8_BAR;
    PG8_STAGE(PG8_SB(1, 0), cB + kstep, voffB); PG8_STAGE(PG8_SA(1, 0), cA + kstep, voffA); PG8_STAGE(PG8_SB(1, 1), cB + hstepB + kstep, voffB);
    PG8_WAIT_V(6); PG8_BAR;
    for (;;) {
        const bool has_next = S.next(ui + 1, nxt);
        const char* nA = has_next ? (const char*)g.A + ((size_t)nxt.pm * BM * g.lda + (size_t)nxt.pn * g.a_pn_off) * 2 : cA; const char* nB = has_next ? (const char*)g.Bt + (size_t)nxt.pn * BM * g.ldb * 2 : cB;
#pragma unroll 1
        for (int t = 0; t < nt; t += 2) {
            const bool last = (t == nt - 2);
            const char* a1 = cA + (size_t)(t + 1) * kstep;
            const char* a2 = last ? nA : cA + (size_t)(t + 2) * kstep; const char* b2 = last ? nB : cB + (size_t)(t + 2) * kstep;
            const char* a3 = a2 + kstep; const char* b3 = b2 + kstep;
            if (last && has_next) S.a_ready(nxt);
            PG8_LDB(B0, 0, 0); PG8_LDB(B1, 0, 1); PG8_SCHED; PG8_LDA(At, 0, 0); PG8_STAGE(PG8_SA(1, 1), a1 + hstepA, voffA);
            PG8_WAIT_V(8); PG8_WAIT_L(0); PG8_BAR; PG8_MMA(0, 0, At, B0); PG8_MMA(0, 1, At, B1); PG8_BAR; PG8_SCHED;
            PG8_LDA(At, 0, 1); PG8_STAGE(PG8_SB(0, 0), b2, voffB); PG8_STAGE(PG8_SB(0, 1), b2 + hstepB, voffB); PG8_STAGE(PG8_SA(0, 0), a2, voffA);
            PG8_WAIT_V(8); PG8_WAIT_L(0); PG8_BAR; PG8_MMA(1, 0, At, B0); PG8_MMA(1, 1, At, B1); PG8_BAR; PG8_SCHED;
            PG8_LDB(B0, 1, 0); PG8_LDB(B1, 1, 1); PG8_SCHED; PG8_LDA(At, 1, 0); PG8_STAGE(PG8_SA(0, 1), a2 + hstepA, voffA);
            PG8_WAIT_V(8); PG8_WAIT_L(0); PG8_BAR; PG8_MMA(0, 0, At, B0); PG8_MMA(0, 1, At, B1); PG8_BAR; PG8_SCHED;
            PG8_LDA(At, 1, 1); PG8_STAGE(PG8_SB(1, 0), b3, voffB); PG8_STAGE(PG8_SB(1, 1), b3 + hstepB, voffB); PG8_STAGE(PG8_SA(1, 0), a3, voffA);
            PG8_WAIT_V(8); PG8_WAIT_L(0); PG8_BAR; PG8_MMA(1, 0, At, B0); PG8_MMA(1, 1, At, B1); PG8_BAR; PG8_SCHED;
        }
        if constexpr (ALIGN_EPI) { if (wr == 0) PG8_BAR; }
        E(acc, pre, cur, wr, wc, fr, fq); S.done(cur);
        if (!has_next) break;
        E.init(acc, nxt, wr, wc, fr, fq); E.preload(pre, nxt, wr, fr, fq);
        cur = nxt; cA = nA; cB = nB; ++ui;
        if constexpr (ALIGN_EPI) { if (wr == 1) PG8_BAR; }
    }
    PG8_WAIT_V(0);
    if constexpr (!ALIGN_EPI) { if (wr == 0) PG8_BAR; }
    PG8_BAR;
#undef PG8_SA
#undef PG8_SB
#undef PG8_STAGE
#undef PG8_LDA
#undef PG8_LDB
#undef PG8_MMA
#undef PG8_WAIT_V
#undef PG8_WAIT_L
#undef PG8_BAR
#undef PG8_SCHED
}

#define EPI_ROW0 (u.pm * BM + wr * 64 + fr)
#define EPI_FOR_AI_M _Pragma("unroll") for (int ai = 0; ai < 2; ++ai) _Pragma("unroll") for (int m = 0; m < 4; ++m)
__device__ __forceinline__ u32x4 pack_f4x2(f32x4 v0, f32x4 v1) { u32x4 w; w.x = cvt_pk_bf16(v0[0], v0[1]); w.y = cvt_pk_bf16(v0[2], v0[3]); w.z = cvt_pk_bf16(v1[0], v1[1]); w.w = cvt_pk_bf16(v1[2], v1[3]); return w; }
__device__ __forceinline__ void unpack_f4x2(u32x4 w, f32x4& v0, f32x4& v1) { v0[0] = bf_lo(w.x); v0[1] = bf_hi(w.x); v0[2] = bf_lo(w.y); v0[3] = bf_hi(w.y); v1[0] = bf_lo(w.z); v1[1] = bf_hi(w.z); v1[2] = bf_lo(w.w); v1[3] = bf_hi(w.w); }
__device__ __forceinline__ unsigned ror8(unsigned x) { return (unsigned)__builtin_amdgcn_update_dpp(0, (int)x, 0x128, 0xF, 0xF, true); }
__device__ __forceinline__ void st_pair(char* grp, size_t pitch, int fr, int fq, u32x4 vA, u32x4 vB) {
    const bool lo = fr < 8;
    u32x4 snd = lo ? vB : vA, rcv; rcv.x = ror8(snd.x); rcv.y = ror8(snd.y); rcv.z = ror8(snd.z); rcv.w = ror8(snd.w);
    char* p = grp + (size_t)(fr & 7) * pitch + (lo ? 0 : 64) + fq * 16;
    *(u32x4*)p = lo ? vA : rcv;
    *(u32x4*)(p + 8 * pitch) = lo ? rcv : vB;
}
__device__ __forceinline__ u32x4 as_u4(f32x4 v) { return __builtin_bit_cast(u32x4, v); }

__device__ __forceinline__ float rstd_raw(ss_t v) { return __builtin_amdgcn_rsqf((float)v * (1.0f / (256.0f * DM)) + NORM_EPS); }
__device__ __forceinline__ float rstd_of(const ss_t* SS, size_t row) { return rstd_raw(SS[row]); }
__device__ __forceinline__ ss_t ss_fix(float s) { return (ss_t)(s * 256.0f + 0.5f); }
__device__ __forceinline__ float sq8(f32x4 a, f32x4 b) { return (a.x * a.x + a.y * a.y) + (a.z * a.z + a.w * a.w) + (b.x * b.x + b.y * b.y) + (b.z * b.z + b.w * b.w); }
__device__ __forceinline__ void ss_add(ss_t* SS, size_t row, float s, int fq, int fr) { s += __uint_as_float((unsigned)__builtin_amdgcn_ds_swizzle((int)__float_as_uint(s), 0x401F));
    s += __uint_as_float((unsigned)__builtin_amdgcn_ds_bpermute((((fq ^ 2) << 4) + fr) << 2, (int)__float_as_uint(s)));
    if (fq == 0) __hip_atomic_fetch_add(SS + row, ss_fix(s), __ATOMIC_RELAXED, __HIP_MEMORY_SCOPE_AGENT); }
struct EpiNull { static constexpr bool PERM = true; EPI_NO_PRE EPI_ZERO_INIT __device__ __forceinline__ void operator()(const f32x4 (&acc)[2][2][4][2], const ss_t (&pre)[2], const Unit& u, int wr, int wc, int fr, int fq) const {
#pragma unroll
    for (int a = 0; a < 2; ++a)
#pragma unroll
        for (int b = 0; b < 2; ++b)
#pragma unroll
            for (int m = 0; m < 4; ++m)
#pragma unroll
                for (int n = 0; n < 2; ++n) asm volatile("" :: "v"(acc[a][b][m][n]));
} };
struct EpiProj { static constexpr bool PERM = true; EPI_ZERO_INIT
    bf16_t* O; const ss_t* SS; EPI_SS_PRE(SS)
    __device__ __forceinline__ void operator()(const f32x4 (&acc)[2][2][4][2], const ss_t (&pre)[2], const Unit& u, int wr, int wc, int fr, int fq) const {
        const bool sg = u.pn >= 18;
        EPI_FOR_AI_M { const size_t r0 = (size_t)(u.pm * BM + ai * HALF + wr * 64 + m * 16); char* grp = (char*)(O + r0 * ICP + u.pn * BM + 64 * wc); const float rs = rstd_raw(pre_get(pre, ai * 4 + m, fr));
            f32x4 a0 = acc[ai][0][m][0] * rs, a1 = acc[ai][0][m][1] * rs, b0 = acc[ai][1][m][0] * rs, b1 = acc[ai][1][m][1] * rs;
            if (sg) { a0 = sigmoid4(a0); a1 = sigmoid4(a1); b0 = sigmoid4(b0); b1 = sigmoid4(b1); }
            st_pair(grp, (size_t)ICP * 2, fr, fq, pack_f4x2(a0, a1), pack_f4x2(b0, b1)); }
    }
};
struct EpiBf16 { static constexpr bool PERM = true; EPI_NO_PRE EPI_ZERO_INIT
    bf16_t* O; int ldc;
    __device__ __forceinline__ void operator()(const f32x4 (&acc)[2][2][4][2], const ss_t (&pre)[2], const Unit& u, int wr, int wc, int fr, int fq) const {
        EPI_FOR_AI_M { char* grp = (char*)(O + (size_t)(u.pm * BM + ai * HALF + wr * 64 + m * 16) * ldc + u.pn * BM + 64 * wc);
            st_pair(grp, (size_t)ldc * 2, fr, fq, pack_f4x2(acc[ai][0][m][0], acc[ai][0][m][1]), pack_f4x2(acc[ai][1][m][0], acc[ai][1][m][1])); }
    }
};
struct EpiLora { static constexpr bool PERM = true; EPI_NO_PRE EPI_ZERO_INIT
    float* DEC; bf16_t* AA; bf16_t* GG; const float* w0; const float* a0;
    __device__ __forceinline__ void operator()(const f32x4 (&acc)[2][2][4][2], const ss_t (&pre)[2], const Unit& u, int wr, int wc, int fr, int fq) const {
        const int row0 = EPI_ROW0, kind = u.pn >> 2, ct = (u.pn & 3) * BM + 64 * wc, col0 = ct + 8 * fq;
        if (kind == 0) {
            EPI_FOR_AI_M { float* rowp = DEC + (size_t)(row0 + ai * HALF + m * 16) * RWD + col0;
#pragma unroll
                for (int bj = 0; bj < 2; ++bj)
#pragma unroll
                    for (int n = 0; n < 2; ++n) { const f32x4 b = *(const f32x4*)(w0 + col0 + bj * 32 + 4 * n); const f32x4 x = acc[ai][bj][m][n] + b; f32x4 o;
#pragma unroll
                        for (int j = 0; j < 4; ++j) { const float z = -x[j]; const float sp = z > 15.f ? z : __logf(1.0f + __expf(z)); const float w = -sp - 0.5f; o[j] = __expf(-__expf(w)); }
                        *(f32x4*)(rowp + bj * 32 + 4 * n) = o; } asm volatile("" ::: "memory"); }
        } else if (kind == 1) {
            const f32x4 b00 = *(const f32x4*)(a0 + col0), b01 = *(const f32x4*)(a0 + col0 + 4), b10 = *(const f32x4*)(a0 + col0 + 32), b11 = *(const f32x4*)(a0 + col0 + 36);
            EPI_FOR_AI_M { char* grp = (char*)(AA + (size_t)(u.pm * BM + ai * HALF + wr * 64 + m * 16) * RWD + ct);
                st_pair(grp, (size_t)RWD * 2, fr, fq, pack_f4x2(sigmoid4(acc[ai][0][m][0] + b00), sigmoid4(acc[ai][0][m][1] + b01)), pack_f4x2(sigmoid4(acc[ai][1][m][0] + b10), sigmoid4(acc[ai][1][m][1] + b11))); }
        } else {
            EPI_FOR_AI_M { char* grp = (char*)(GG + (size_t)(u.pm * BM + ai * HALF + wr * 64 + m * 16) * RWD + ct);
                st_pair(grp, (size_t)RWD * 2, fr, fq, pack_f4x2(acc[ai][0][m][0], acc[ai][0][m][1]), pack_f4x2(acc[ai][1][m][0], acc[ai][1][m][1])); }
        }
    }
};
struct EpiGate1 { static constexpr bool PERM = true; EPI_NO_PRE EPI_ZERO_INIT
    bf16_t* TMP; const bf16_t* PROJ; int gcol0;
    __device__ __forceinline__ void operator()(const f32x4 (&acc)[2][2][4][2], const ss_t (&pre)[2], const Unit& u, int wr, int wc, int fr, int fq) const {
        const int row0 = EPI_ROW0, ct = u.pn * BM + 64 * wc, col0 = ct + 8 * fq;
        EPI_FOR_AI_M { const size_t row = (size_t)(row0 + ai * HALF + m * 16);
            f32x4 g00, g01, g10, g11; unpack_f4x2(*(const u32x4*)(PROJ + row * ICP + gcol0 + col0), g00, g01); unpack_f4x2(*(const u32x4*)(PROJ + row * ICP + gcol0 + col0 + 32), g10, g11);
            st_pair((char*)(TMP + (size_t)(u.pm * BM + ai * HALF + wr * 64 + m * 16) * DM + ct), (size_t)DM * 2, fr, fq, pack_f4x2(acc[ai][0][m][0] * g00, acc[ai][0][m][1] * g01), pack_f4x2(acc[ai][1][m][0] * g10, acc[ai][1][m][1] * g11));
            if (m & 1) asm volatile("" ::: "memory"); }
    }
};
struct EpiGate2 { static constexpr bool PERM = true; EPI_NO_PRE EPI_ZERO_INIT
    const bf16_t* TMP; const bf16_t* PROJ; int gcol0; bf16_t* O;
    __device__ __forceinline__ void operator()(const f32x4 (&acc)[2][2][4][2], const ss_t (&pre)[2], const Unit& u, int wr, int wc, int fr, int fq) const {
        const int row0 = EPI_ROW0, ct = u.pn * BM + 64 * wc, col0 = ct + 8 * fq;
        EPI_FOR_AI_M { const size_t row = (size_t)(row0 + ai * HALF + m * 16);
            f32x4 g00, g01, g10, g11, t00, t01, t10, t11; unpack_f4x2(*(const u32x4*)(PROJ + row * ICP + gcol0 + col0), g00, g01); unpack_f4x2(*(const u32x4*)(PROJ + row * ICP + gcol0 + col0 + 32), g10, g11);
            unpack_f4x2(*(const u32x4*)(TMP + row * DM + col0), t00, t01); unpack_f4x2(*(const u32x4*)(TMP + row * DM + col0 + 32), t10, t11);
            st_pair((char*)(O + (size_t)(u.pm * BM + ai * HALF + wr * 64 + m * 16) * DM + ct), (size_t)DM * 2, fr, fq, pack_f4x2(t00 + acc[ai][0][m][0] * g00, t01 + acc[ai][0][m][1] * g01), pack_f4x2(t10 + acc[ai][1][m][0] * g10, t11 + acc[ai][1][m][1] * g11));
            if (m & 1) asm volatile("" ::: "memory"); }
    }
};
struct EpiResid { static constexpr bool PERM = true; EPI_NO_PRE
    bf16_t* XB; ss_t* SS;
    __device__ __forceinline__ void init(f32x4 (&acc)[2][2][4][2], const Unit& u, int wr, int wc, int fr, int fq) const {
        const int row0 = EPI_ROW0, col0 = u.pn * BM + 64 * wc + 8 * fq;
        EPI_FOR_AI_M { const bf16_t* rowp = XB + (size_t)(row0 + ai * HALF + m * 16) * DM + col0;
            unpack_f4x2(*(const u32x4*)rowp, acc[ai][0][m][0], acc[ai][0][m][1]); unpack_f4x2(*(const u32x4*)(rowp + 32), acc[ai][1][m][0], acc[ai][1][m][1]); }
    }
    __device__ __forceinline__ void operator()(const f32x4 (&acc)[2][2][4][2], const ss_t (&pre)[2], const Unit& u, int wr, int wc, int fr, int fq) const {
        EPI_FOR_AI_M { const size_t r0 = (size_t)(u.pm * BM + ai * HALF + wr * 64 + m * 16);
            st_pair((char*)(XB + r0 * DM + u.pn * BM + 64 * wc), (size_t)DM * 2, fr, fq, pack_f4x2(acc[ai][0][m][0], acc[ai][0][m][1]), pack_f4x2(acc[ai][1][m][0], acc[ai][1][m][1]));
            ss_add(SS, r0 + fr, sq8(acc[ai][0][m][0], acc[ai][0][m][1]) + sq8(acc[ai][1][m][0], acc[ai][1][m][1]), fq, fr); }
    }
};
struct EpiSwiglu { static constexpr bool PERM = true; EPI_ZERO_INIT
    bf16_t* H; const ss_t* SS; EPI_SS_PRE(SS)
    __device__ __forceinline__ void operator()(const f32x4 (&acc)[2][2][4][2], const ss_t (&pre)[2], const Unit& u, int wr, int wc, int fr, int fq) const {
        const int row0 = EPI_ROW0, col0 = u.pn * HALF + wc * 32 + 8 * fq;
        EPI_FOR_AI_M { const size_t row = (size_t)(row0 + ai * HALF + m * 16); const float rs = rstd_raw(pre_get(pre, ai * 4 + m, fr));
            const f32x4 g0 = acc[ai][0][m][0] * rs, g1 = acc[ai][0][m][1] * rs, u0 = acc[ai][1][m][0] * rs, u1 = acc[ai][1][m][1] * rs;
            *(u32x4*)(H + row * FF + col0) = pack_f4x2(g0 * sigmoid4(g0) * u0, g1 * sigmoid4(g1) * u1); }
    }
};
struct EpiPle { static constexpr bool PERM = true; EPI_ZERO_INIT EPI_SS_PRE(SSi)
    const bf16_t* XB; bf16_t* XO; const bf16_t* PP; const ss_t* SSi; ss_t* SSo;
    __device__ __forceinline__ void operator()(const f32x4 (&acc)[2][2][4][2], const ss_t (&pre)[2], const Unit& u, int wr, int wc, int fr, int fq) const {
        const int col0 = u.pn * BM + 64 * wc + 8 * fq;
        EPI_FOR_AI_M { const size_t r0 = (size_t)(u.pm * BM + ai * HALF + wr * 64 + m * 16), row = r0 + fr; const float rs = rstd_raw(pre_get(pre, ai * 4 + m, fr));
            f32x4 x00, x01, x10, x11, p00, p01, p10, p11; unpack_f4x2(*(const u32x4*)(XB + row * DM + col0), x00, x01); unpack_f4x2(*(const u32x4*)(XB + row * DM + col0 + 32), x10, x11);
            unpack_f4x2(*(const u32x4*)(PP + row * DM + col0), p00, p01); unpack_f4x2(*(const u32x4*)(PP + row * DM + col0 + 32), p10, p11);
            x00 += sigmoid4(acc[ai][0][m][0] * rs) * p00; x01 += sigmoid4(acc[ai][0][m][1] * rs) * p01; x10 += sigmoid4(acc[ai][1][m][0] * rs) * p10; x11 += sigmoid4(acc[ai][1][m][1] * rs) * p11;
            st_pair((char*)(XO + r0 * DM + u.pn * BM + 64 * wc), (size_t)DM * 2, fr, fq, pack_f4x2(x00, x01), pack_f4x2(x10, x11));
            ss_add(SSo, row, sq8(x00, x01) + sq8(x10, x11), fq, fr);
            if (m & 1) asm volatile("" ::: "memory"); }
    }
};
#undef EPI_ROW0
#undef EPI_FOR_AI_M
}

constexpr size_t MiB = 1u << 20;
constexpr size_t al1m(size_t x) { return (x + MiB - 1) / MiB * MiB; }
constexpr size_t WS_CTL = 0, CTL_ZERO_BYTES = 1 * MiB;
constexpr size_t SZ_WIN = (size_t)ICP * DM * 2, SZ_POOLW = (size_t)PWD * 256 * 2, SZ_LORA = (size_t)3072 * LK * 2, SZ_PPOOL = (size_t)DM * PWD * 2, SZ_PRWKV = (size_t)DM * RWD * 2,
                 SZ_WOUT = (size_t)DM * DM * 2, SZ_WGU = (size_t)2 * FF * DM * 2, SZ_WDN = (size_t)DM * FF * 2, SZ_WPG = (size_t)DM * DM * 2, SZ_WPP = (size_t)DM * PLE * 2;
constexpr size_t WS_WIN = 1 * MiB, WS_POOLW = WS_WIN + SZ_WIN, WS_LORA = WS_POOLW + SZ_POOLW, WS_PPOOL = WS_LORA + SZ_LORA, WS_PRWKV = WS_PPOOL + SZ_PPOOL, WS_WOUT = WS_PRWKV + SZ_PRWKV,
                 WS_WGU = WS_WOUT + SZ_WOUT, WS_WDN = WS_WGU + SZ_WGU, WS_WPG = WS_WDN + SZ_WDN, WS_WPP = WS_WPG + SZ_WPG, WS_WEND = WS_WPP + SZ_WPP;
constexpr size_t WS_PB = al1m(WS_WEND);
constexpr size_t WS_XN = al1m(WS_PB + (size_t)MT * PLE * 2);
constexpr size_t WS_AA = al1m(WS_XN + (size_t)MT * DM * 2);
constexpr size_t WS_GG = al1m(WS_AA + (size_t)MT * RWD * 2);
constexpr size_t WS_PP = al1m(WS_GG + (size_t)MT * RWD * 2);
constexpr size_t WS_PROJ = al1m(WS_PP + (size_t)MT * DM * 2);
constexpr size_t WS_HID = WS_PROJ;
constexpr size_t WS_D = al1m(WS_PROJ + (size_t)MT * ICP * 2);
constexpr size_t WS_LIN = al1m(WS_D + (size_t)MT * PWD * 2);
constexpr size_t WS_YA = al1m(WS_LIN + (size_t)MT * LK * 2);
constexpr size_t WS_DEC = al1m(WS_YA + (size_t)MT * PWD * 2);
constexpr size_t WS_BS = al1m(WS_DEC + (size_t)MT * RWD * 4);
constexpr size_t WS_Y = al1m(WS_BS + (size_t)MT * 16 * 4);
constexpr size_t SZ_BH = (size_t)MT * RWD * 2;
constexpr size_t WS_YB = al1m(WS_Y + (size_t)MT * RWD * 4);
constexpr size_t WS_TMP = al1m(WS_YB + SZ_BH);
constexpr size_t WS_MRG = al1m(WS_TMP + (size_t)MT * DM * 4);
constexpr size_t WS_SS = al1m(WS_MRG + (size_t)MT * DM * 2);
constexpr size_t WS_END_OLD = al1m(WS_MRG + (size_t)MT * DM * 2);
static_assert((size_t)MT * FF * 2 <= (size_t)MT * ICP * 2, "HID overlay");

constexpr size_t WS_XB2 = al1m(WS_SS + (size_t)3 * MT * 4);
constexpr size_t CBSZ = 12032, CB_P1T = 0, CB_RT = 2048, CB_BK = 4096, CB_VT = 8192, CB_P2T = 10240, CB_MBT = 10752, CB_MKT = 11264, CB_GC = 11776;
constexpr size_t CB_N = (size_t)(MT / 16) * 16;
static_assert(WS_MRG + (size_t)MT * DM * 2 - WS_TMP >= CB_N * CBSZ, "chunk blocks fit in TMP | MRG");
constexpr size_t WS_END = al1m(WS_XB2 + (size_t)MT * DM * 2);
constexpr int CW_BAR = 4096;
constexpr int NWAVES = 8, NTHR = 512;
constexpr int RING_BYTES = 131072, LDSCTL_OFF = RING_BYTES, LDS_BYTES = 147456;

#define XB_TMO      128
#define XB_XCNT(j)  (256  + 64 * (j))
#define XB_XSUB(j)  (1280 + 64 * (j))
#define XB_XGEN(j)  (2304 + 64 * (j))
#define XB_TOP      3328
#define XB_TOPGEN   3392
#define XCD_BAR_WORDS 3456
#define XB_SPIN_CAP (1u << 18)

__device__ __forceinline__ unsigned xb_ld(unsigned* p)              { return __hip_atomic_load(p, __ATOMIC_RELAXED, __HIP_MEMORY_SCOPE_AGENT); }
__device__ __forceinline__ unsigned xb_add(unsigned* p, unsigned v) { return __hip_atomic_fetch_add(p, v, __ATOMIC_RELAXED, __HIP_MEMORY_SCOPE_AGENT); }
__device__ __forceinline__ unsigned xb_xcc_id() { return (unsigned)__builtin_amdgcn_s_getreg((3 << 11) | 20) & 0xFu; }
#define XB_SPIN(cond, bar) do { unsigned _sp = 0; while (cond) { __builtin_amdgcn_s_sleep(1); \
    if ((++_sp & 255u) == 0u) { if (xb_ld(&(bar)[XB_TMO])) break; if (_sp > XB_SPIN_CAP) { atomicAdd(&(bar)[XB_TMO], 1u); break; } } } } while (0)

struct XcdBarrier {
    unsigned* bar; unsigned x;
    volatile LAS unsigned* st;
};

__device__ __forceinline__ XcdBarrier xcd_barrier_post(unsigned* bar, volatile LAS unsigned* st) {
    XcdBarrier b; b.bar = bar; b.x = xb_xcc_id(); b.st = st;
    if (threadIdx.x == 0) (void)xb_add(&bar[XB_XCNT(b.x)], 1u);
    return b;
}
__device__ __forceinline__ void xcd_barrier_complete(unsigned* bar, unsigned x, unsigned& nloc, unsigned& nx) {
    const unsigned G = gridDim.x * gridDim.y * gridDim.z;
    unsigned sum, cnt, mine, sp = 0u;
    for (;;) {
        sum = 0u; cnt = 0u; mine = 0u;
#pragma unroll
        for (unsigned j = 0; j < 16; ++j) { const unsigned c = xb_ld(&bar[XB_XCNT(j)]); sum += c; cnt += (c > 0u) ? 1u : 0u; mine = (j == x) ? c : mine; }
        if (sum == G) break;
        __builtin_amdgcn_s_sleep(1);
        if ((++sp & 255u) == 0u) { if (xb_ld(&bar[XB_TMO])) break; if (sp > XB_SPIN_CAP) { atomicAdd(&bar[XB_TMO], 1u); break; } }
    }
    nloc = mine > 0u ? mine : 1u; nx = cnt > 0u ? cnt : 1u;
}

__device__ __forceinline__ void xcd_barrier(const XcdBarrier& b) {
    asm volatile("s_waitcnt vmcnt(0)" ::: "memory");
    __syncthreads();
    if (threadIdx.x == 0) {
        unsigned* bar = b.bar;
        __builtin_amdgcn_s_waitcnt(0);
        unsigned nloc = b.st[0], nx = b.st[1];
        if (nloc == 0u) { xcd_barrier_complete(bar, b.x, nloc, nx); b.st[0] = nloc; b.st[1] = nx; }
        const unsigned old = xb_add(&bar[XB_XSUB(b.x)], 1u);
        const unsigned gen = old / nloc;
        if (old + 1u == (gen + 1u) * nloc) {
            __builtin_amdgcn_fence(__ATOMIC_RELEASE, "agent");
            asm volatile("s_waitcnt vmcnt(0)" ::: "memory");
            const unsigned og = xb_add(&bar[XB_TOP], 1u);
            const unsigned tg = og / nx;
            if (og + 1u == (tg + 1u) * nx) xb_add(&bar[XB_TOPGEN], 1u);
            else XB_SPIN(xb_ld(&bar[XB_TOPGEN]) == tg, bar);
            __builtin_amdgcn_fence(__ATOMIC_ACQUIRE, "agent");
            xb_add(&bar[XB_XGEN(b.x)], 1u);
            asm volatile("s_waitcnt vmcnt(0)" ::: "memory");
        } else {
            XB_SPIN(xb_ld(&bar[XB_XGEN(b.x)]) == gen, bar);
            __builtin_amdgcn_fence(__ATOMIC_ACQUIRE, "agent");
            asm volatile("s_waitcnt vmcnt(0)" ::: "memory");
        }
    }
    __syncthreads();
}


struct Args {
    const float* in[33]; float* out; unsigned char* ws; int ph_lo, ph_hi;
};
struct Frame {
    LAS unsigned char* lds; int G;
    const LAS unsigned long long* ptab; float* out; unsigned char* ws;
};
#define GAS __attribute__((address_space(1)))
__device__ __forceinline__ const float* ldptr(const LAS unsigned long long* tab, int k) { const unsigned long long v = tab[k]; const unsigned lo = __builtin_amdgcn_readfirstlane((unsigned)v), hi = __builtin_amdgcn_readfirstlane((unsigned)(v >> 32));
    return (const float*)(const GAS float*)(((unsigned long long)hi << 32) | lo); }
__device__ __forceinline__ unsigned char* fresh(unsigned char* p) { GAS unsigned char* q = (GAS unsigned char*)p; asm volatile("" : "+s"(q)); return (unsigned char*)q; }
__device__ __forceinline__ int fresh_i(int v) { asm volatile("" : "+s"(v)); return v; }
#define INP(k) ldptr(F.ptab, (k))
#define PHASE_L const int l = fresh_i(l_in); (void)l;
#define PHASE_IDS int tid_ = threadIdx.x; asm volatile("" : "+v"(tid_)); const int tid = tid_, lane = tid & 63, wave = __builtin_amdgcn_readfirstlane(tid >> 6), gtid = blockIdx.x * NTHR + tid, gw = blockIdx.x * NWAVES + wave; (void)lane; (void)wave; (void)gtid; (void)gw;
#define VM_WAIT() asm volatile("s_waitcnt vmcnt(0)" ::: "memory")
#define LDS_WAIT() asm volatile("s_waitcnt lgkmcnt(0)" ::: "memory")
constexpr int NT_ALL_SHIFT = 9;

__device__ __forceinline__ void row_info(int m, int& b, int& t, bool& samp) { samp = m >= MPR; if (samp) { b = (m - MPR) >> 6; t = (m - MPR) & 63; } else { b = m >> 11; t = m & 2047; } }

__device__ __forceinline__ void transpose_item(const float* W, int N, bf16_t* WT, int ldk, int k0, int n0, int drow0, LAS float* scr, int lane, const float* cscale = nullptr, const float* rscale = nullptr) {
    f32x4 cs = (f32x4){1.f, 1.f, 1.f, 1.f}; if (cscale) cs = *(const f32x4*)(cscale + n0 + 4 * (lane & 7));
    const int c = lane & 7;
    f32x4 g0 = (f32x4){1.f, 1.f, 1.f, 1.f}, g1 = g0;
    if (rscale) { g0 = *(const f32x4*)(rscale + k0 + 8 * c); g1 = *(const f32x4*)(rscale + k0 + 8 * c + 4); }
    f32x4 v[8];
#pragma unroll
    for (int i = 0; i < 8; ++i) v[i] = *(const f32x4*)(W + (size_t)(k0 + 8 * i + (lane >> 3)) * N + n0 + 4 * (lane & 7));
#pragma unroll
    for (int i = 0; i < 8; ++i) { LAS float* d = scr + (8 * i + (lane >> 3)) * 33 + 4 * (lane & 7); const f32x4 t = v[i] * cs; d[0] = t.x; d[1] = t.y; d[2] = t.z; d[3] = t.w; }
    LDS_WAIT(); asm volatile("" ::: "memory");
#pragma unroll
    for (int j = 0; j < 4; ++j) { const int n = (lane >> 3) + 8 * j; const LAS float* sp = scr + (8 * c) * 33 + n;
        u32x4 o; o.x = cvt_pk_bf16(sp[0 * 33] * g0.x, sp[1 * 33] * g0.y); o.y = cvt_pk_bf16(sp[2 * 33] * g0.z, sp[3 * 33] * g0.w); o.z = cvt_pk_bf16(sp[4 * 33] * g1.x, sp[5 * 33] * g1.y); o.w = cvt_pk_bf16(sp[6 * 33] * g1.z, sp[7 * 33] * g1.w);
        *(u32x4*)(WT + (size_t)(drow0 + n) * ldk + k0 + 8 * c) = o; }
    LDS_WAIT(); asm volatile("" ::: "memory");
}
__device__ __forceinline__ void convert_weights(Frame& F, int l_in) {
    PHASE_IDS
    unsigned char* const wsl = fresh(F.ws);
    PHASE_L
    LAS float* scr = (LAS float*)(F.lds + wave * 16384);
    const int NGW = fresh_i(F.G) * NWAVES;
    unsigned char* ws = wsl;
    constexpr int I_WIN = (DM / 64) * (ICOLS / 32), I_PW = 4 * (256 / 64) * (256 / 32), I_PP = (PWD / 64) * (DM / 32), I_WO = (DM / 64) * (DM / 32), I_FG = (DM / 64) * (FF / 32),
                  I_FD = (FF / 64) * (DM / 32), I_PL = (PLE / 64) * (DM / 32);
    constexpr int NITEMS = I_WIN + I_PW + 2 * I_PP + I_WO + 2 * I_FG + I_FD + I_WO + I_PL;
    for (int it = gw; it < NITEMS; it += NGW) {
        int r = it;
        if (r < I_WIN) { const int nblk = ICOLS / 32, kb = r / nblk, nb = r % nblk, n0 = nb * 32; transpose_item(INP(8) + (size_t)l * DM * ICOLS, ICOLS, (bf16_t*)(ws + WS_WIN), DM, kb * 64, n0, n0 < 4384 ? n0 : n0 + 224, scr, lane, nullptr, INP(7) + (size_t)l * DM); continue; } r -= I_WIN;
        if (r < I_PW) { const int g = r >> 5, rr = r & 31, kb = rr >> 3, nb = rr & 7; transpose_item(INP(10) + ((size_t)l * 4 + g) * 65536, 256, (bf16_t*)(ws + WS_POOLW) + (size_t)g * 65536, 256, kb * 64, nb * 32, nb * 32, scr, lane, INP(11) + (size_t)l * PWD + g * 256); continue; } r -= I_PW;
        if (r < I_PP) { const int nblk = DM / 32, kb = r / nblk, nb = r % nblk; transpose_item(INP(22) + (size_t)l * PWD * DM, DM, (bf16_t*)(ws + WS_PPOOL), PWD, kb * 64, nb * 32, nb * 32, scr, lane); continue; } r -= I_PP;
        if (r < I_PP) { const int nblk = DM / 32, kb = r / nblk, nb = r % nblk; transpose_item(INP(23) + (size_t)l * RWD * DM, DM, (bf16_t*)(ws + WS_PRWKV), RWD, kb * 64, nb * 32, nb * 32, scr, lane); continue; } r -= I_PP;
        if (r < I_WO) { const int nblk = DM / 32, kb = r / nblk, nb = r % nblk; transpose_item(INP(24) + (size_t)l * DM * DM, DM, (bf16_t*)(ws + WS_WOUT), DM, kb * 64, nb * 32, nb * 32, scr, lane); continue; } r -= I_WO;
        if (r < I_FG) { const int nblk = FF / 32, kb = r / nblk, nb = r % nblk, n0 = nb * 32; transpose_item(INP(26) + (size_t)l * DM * FF, FF, (bf16_t*)(ws + WS_WGU), DM, kb * 64, n0, 256 * (n0 >> 7) + 64 * ((n0 & 127) >> 5), scr, lane, nullptr, INP(25) + (size_t)l * DM); continue; } r -= I_FG;
        if (r < I_FG) { const int nblk = FF / 32, kb = r / nblk, nb = r % nblk, n0 = nb * 32; transpose_item(INP(27) + (size_t)l * DM * FF, FF, (bf16_t*)(ws + WS_WGU), DM, kb * 64, n0, 256 * (n0 >> 7) + 64 * ((n0 & 127) >> 5) + 32, scr, lane, nullptr, INP(25) + (size_t)l * DM); continue; } r -= I_FG;
        if (r < I_FD) { const int nblk = DM / 32, kb = r / nblk, nb = r % nblk; transpose_item(INP(28) + (size_t)l * FF * DM, DM, (bf16_t*)(ws + WS_WDN), FF, kb * 64, nb * 32, nb * 32, scr, lane); continue; } r -= I_FD;
        if (r < I_WO) { const int nblk = DM / 32, kb = r / nblk, nb = r % nblk; transpose_item(INP(30) + (size_t)l * DM * DM, DM, (bf16_t*)(ws + WS_WPG), DM, kb * 64, nb * 32, nb * 32, scr, lane, nullptr, INP(29) + (size_t)l * DM); continue; } r -= I_WO;
        { const int nblk = DM / 32, kb = r / nblk, nb = r % nblk; transpose_item(INP(31) + (size_t)l * PLE * DM, DM, (bf16_t*)(ws + WS_WPP), PLE, kb * 64, nb * 32, nb * 32, scr, lane); }
    }
    const int NT = fresh_i(F.G) * NTHR;
    { u32x4* z = (u32x4*)((bf16_t*)(ws + WS_WIN) + (size_t)4384 * DM); for (int i = gtid; i < 224 * DM * 2 / 16; i += NT) z[i] = (u32x4){0u, 0u, 0u, 0u}; }
    { bf16_t* LT = (bf16_t*)(ws + WS_LORA); const float* wd = INP(13) + (size_t)l * 64 * RWD; const float* wa = INP(15) + (size_t)l * 64 * RWD; const float* wg = INP(16) + (size_t)l * 160 * RWD;
      for (int i = gtid; i < 3072 * (LK / 8); i += NT) { const int n = i / (LK / 8), k0 = (i % (LK / 8)) * 8; const int kind = n >> 10, c = n & 1023; float f[8];
#pragma unroll
          for (int j = 0; j < 8; ++j) { const int k = k0 + j; float v = 0.f;
              if (kind == 0) { if (k < 64) v = wd[(size_t)k * RWD + c]; }
              else if (kind == 1) { if (k >= 64 && k < 128) v = wa[(size_t)(k - 64) * RWD + c]; }
              else { if (k >= 128 && k < 288) v = wg[(size_t)(k - 128) * RWD + c]; }
              f[j] = v; }
          *(u32x4*)(LT + (size_t)n * LK + k0) = pack8(f); } }
    { bf16_t* PB = (bf16_t*)(ws + WS_PB); const float* pp = INP(5) + (size_t)l * MPR * PLE; const float* ps = INP(6) + (size_t)l * (MT - MPR) * PLE;
      for (int i = gtid; i < MT * PLE / 8; i += NT) { const size_t e = (size_t)i * 8; const float* src = e < (size_t)MPR * PLE ? pp + e : ps + (e - (size_t)MPR * PLE);
          const f32x4 a = *(const f32x4*)src, b = *(const f32x4*)(src + 4); *(u32x4*)(PB + e) = pg8::pack_f4x2(a, b); } }
}

__device__ __forceinline__ void xb_from_input(Frame& F) {
    PHASE_IDS
    unsigned char* const wsl = fresh(F.ws);
    const int NGW = fresh_i(F.G) * NWAVES; bf16_t* XB = (bf16_t*)(wsl + WS_XN); pg8::ss_t* SS = (pg8::ss_t*)(wsl + WS_SS);
    for (int m = gw; m < MT; m += NGW) {
        const float* src = m < MPR ? INP(0) + (size_t)m * DM : INP(1) + (size_t)(m - MPR) * DM;
        f32x4 v[8]; float s = 0.f;
#pragma unroll
        for (int j = 0; j < 8; ++j) { v[j] = *(const f32x4*)(src + 4 * lane + 256 * j); s += (v[j].x * v[j].x + v[j].y * v[j].y) + (v[j].z * v[j].z + v[j].w * v[j].w); }
        s = wave_sum(s);
        if (lane == 0) SS[m] = pg8::ss_fix(s);
#pragma unroll
        for (int j = 0; j < 8; ++j) { u32x2 w; w.x = cvt_pk_bf16(v[j].x, v[j].y); w.y = cvt_pk_bf16(v[j].z, v[j].w); *(u32x2*)(XB + (size_t)m * DM + 4 * lane + 256 * j) = w; }
    }
}
__device__ __forceinline__ void final_norm(Frame& F, const float* gain) {
    PHASE_IDS
    unsigned char* const wsl = fresh(F.ws);
    const int NGW = fresh_i(F.G) * NWAVES; const bf16_t* XB = (const bf16_t*)(wsl + ((NL & 1) ? WS_XB2 : WS_XN));
    f32x4 g[8];
#pragma unroll
    for (int j = 0; j < 8; ++j) g[j] = *(const f32x4*)(gain + 4 * lane + 256 * j);
    for (int m = gw; m < MT; m += NGW) {
        f32x4 v[8]; float s = 0.f;
#pragma unroll
        for (int j = 0; j < 8; ++j) { const u32x2 w = *(const u32x2*)(XB + (size_t)m * DM + 4 * lane + 256 * j); v[j] = (f32x4){bf_lo(w.x), bf_hi(w.x), bf_lo(w.y), bf_hi(w.y)};
            s += (v[j].x * v[j].x + v[j].y * v[j].y) + (v[j].z * v[j].z + v[j].w * v[j].w); }
        const float rstd = __builtin_amdgcn_rsqf(wave_sum(s) * (1.0f / DM) + NORM_EPS);
#pragma unroll
        for (int j = 0; j < 8; ++j) *(f32x4*)(F.out + (size_t)m * DM + 4 * lane + 256 * j) = v[j] * rstd * g[j];
    }
}

__device__ __forceinline__ void load_z(float (&z)[8], const bf16_t* PROJ, const float* past, int m0, int t, bool samp, int c0) {
    if (t >= 0) { unpack8(*(const u32x4*)(PROJ + (size_t)(m0 + t) * ICP + c0), z); }
    else if (samp) { const float* p = past + (size_t)(15 + t) * PWD + c0; const f32x4 a = *(const f32x4*)p, b = *(const f32x4*)(p + 4); z[0] = a.x; z[1] = a.y; z[2] = a.z; z[3] = a.w; z[4] = b.x; z[5] = b.y; z[6] = b.z; z[7] = b.w; }
    else {
#pragma unroll
        for (int j = 0; j < 8; ++j) z[j] = 0.f; }
}
__device__ __forceinline__ void prep1_phase(Frame& F, int l_in) {
    PHASE_IDS
    unsigned char* const wsl = fresh(F.ws);
    PHASE_L
    const int NT = fresh_i(F.G) * NTHR; const bf16_t* PROJ = (const bf16_t*)(wsl + WS_PROJ);
    { bf16_t* D = (bf16_t*)(wsl + WS_D);
      for (int it = gtid; it < (MT / 16) * 128; it += NT) {
          const int oct = it & 127, run = it >> 7, mrow = run * 16, c0 = oct * 8, win = 2 << (c0 >> 8);
          int b, t0; bool samp; row_info(mrow, b, t0, samp);
          const int T = samp ? TS : TP, mseq = mrow - t0;
          const float* past = INP(3) + ((size_t)l * 8 + b) * 15 * PWD;
          float* npool = F.out + (samp ? O_POS : O_POP) + ((size_t)l * 8 + b) * 15 * PWD;
          float S[8], z[8];
#pragma unroll
          for (int j = 0; j < 8; ++j) S[j] = 0.f;
          for (int j = 1; j < win; ++j) { load_z(z, PROJ, past, mseq, t0 - j, samp, c0);
#pragma unroll
              for (int q = 0; q < 8; ++q) S[q] += z[q]; }
          for (int i = 0; i < 16; ++i) { const int t = t0 + i; float cur[8]; load_z(cur, PROJ, past, mseq, t, samp, c0);
              const int cnt = samp ? win : (t + 1 < win ? t + 1 : win); const float inv = 1.0f / (float)cnt; float d[8];
#pragma unroll
              for (int q = 0; q < 8; ++q) { S[q] += cur[q]; d[q] = S[q] * inv - cur[q]; }
              *(u32x4*)(D + (size_t)(mseq + t) * PWD + c0) = pack8(d);
              if (t >= T - 15) { float* o = npool + (size_t)(t - (T - 15)) * PWD + c0; *(f32x4*)o = (f32x4){cur[0], cur[1], cur[2], cur[3]}; *(f32x4*)(o + 4) = (f32x4){cur[4], cur[5], cur[6], cur[7]}; }
              load_z(z, PROJ, past, mseq, t - win + 1, samp, c0);
#pragma unroll
              for (int q = 0; q < 8; ++q) S[q] -= z[q]; }
      } }
    { bf16_t* LIN = (bf16_t*)(wsl + WS_LIN); const float* mu = INP(9) + (size_t)l * RPJ + 3072;
      for (int it = gtid; it < MT * (LK / 8); it += NT) {
          const int m = it / (LK / 8), c0 = (it % (LK / 8)) * 8; float o[8];
          if (c0 >= 288) {
#pragma unroll
              for (int j = 0; j < 8; ++j) o[j] = 0.f;
          } else {
              int b, t; bool samp; row_info(m, b, t, samp);
              float cur[8], prv[8]; unpack8(*(const u32x4*)(PROJ + (size_t)m * ICP + 4096 + c0), cur);
              if (t > 0) unpack8(*(const u32x4*)(PROJ + (size_t)(m - 1) * ICP + 4096 + c0), prv);
              else if (samp) { const float* p = INP(2) + ((size_t)l * 8 + b) * RPJ + 3072 + c0;
#pragma unroll
                  for (int j = 0; j < 8; ++j) prv[j] = p[j]; }
              else {
#pragma unroll
                  for (int j = 0; j < 8; ++j) prv[j] = 0.f; }
#pragma unroll
              for (int j = 0; j < 8; ++j) { const float xm = cur[j] + (prv[j] - cur[j]) * mu[c0 + j]; o[j] = c0 < 64 ? tanhf_(xm) : (c0 < 128 ? xm : sigmoidf_(xm)); }
          }
          *(u32x4*)(LIN + (size_t)m * LK + c0) = pack8(o);
      } }
    { pg8::ss_t* SS = (pg8::ss_t*)(wsl + WS_SS); for (int i = gtid; i < 3 * MT; i += NT) SS[i] = 0u; }
    for (int it = gtid; it < 16 * RPJ; it += NT) { const int s = it / RPJ, c = it % RPJ; const int mlast = s < 8 ? s * TP + TP - 1 : MPR + (s - 8) * TS + TS - 1;
        F.out[(s < 8 ? O_SHP : O_SHS) + ((size_t)l * 8 + (s & 7)) * RPJ + c] = __uint_as_float((unsigned)PROJ[(size_t)mlast * ICP + 1024 + c] << 16); }
}

__device__ __forceinline__ unsigned char* cb_ptr(unsigned char* ws, size_t i) { return ws + WS_TMP + i * CBSZ; }
__device__ __forceinline__ f32x4 mfma16(bf16x8 a, bf16x8 b, f32x4 c) { return __builtin_amdgcn_mfma_f32_16x16x32_bf16(a, b, c, 0, 0, 0); }
__device__ __forceinline__ bf16x8 mk8(u32x2 lo, u32x2 hi) { u32x4 w = (u32x4){lo.x, lo.y, hi.x, hi.y}; return __builtin_bit_cast(bf16x8, w); }
typedef __bf16 bf16x2_c __attribute__((ext_vector_type(2)));
__device__ __forceinline__ unsigned cvt_pk_c(float lo, float hi) { const f32x2 v = (f32x2){lo, hi}; const bf16x2_c b = __builtin_convertvector(v, bf16x2_c); return __builtin_bit_cast(unsigned, b); }
__device__ __forceinline__ u32x2 pk4(f32x4 v) { return (u32x2){cvt_pk_c(v.x, v.y), cvt_pk_c(v.z, v.w)}; }
__device__ __forceinline__ unsigned short bf1(float f) { return (unsigned short)(cvt_pk_c(f, 0.f) & 0xffffu); }

__device__ __forceinline__ void spre_phase(Frame& F, int l_in) {
    PHASE_IDS
    unsigned char* const wsl = fresh(F.ws);
    PHASE_L
    const int NGW = fresh_i(F.G) * NWAVES;
    LAS unsigned char* L = F.lds + wave * 16384;
    const bf16_t* PROJ = (const bf16_t*)(wsl + WS_PROJ); const bf16_t* AA = (const bf16_t*)(wsl + WS_AA); const float* DEC = (const float*)(wsl + WS_DEC); float* BS = (float*)(wsl + WS_BS);
    const int fr = lane & 15, fq = lane >> 4;
    const float* mu = INP(9) + (size_t)l * RPJ;
    for (int it = gw; it < (int)CB_N; it += NGW) {
        const int h = it & 15, crow = it >> 4, m0 = crow * 16, ch = h * 64 + lane;
        int b, t0; bool samp; row_info(m0, b, t0, samp);
        unsigned char* cb = cb_ptr(wsl, (size_t)it);
        const float mur = mu[ch], muk = mu[1024 + ch], muv = mu[2048 + ch];
        const float ckk = (INP(17) + (size_t)l * RWD)[ch], cka = (INP(18) + (size_t)l * RWD)[ch], crk = (INP(19) + (size_t)l * RWD)[ch];
        unsigned short cr[16], ck[16], cv[16], ca[16]; float cw[16];
#pragma unroll
        for (int t = 0; t < 16; ++t) { const size_t mm = (size_t)(m0 + t); const bf16_t* pc = PROJ + mm * ICP + 1024 + ch; cr[t] = pc[0]; ck[t] = pc[1024]; cv[t] = pc[2048]; ca[t] = AA[mm * RWD + ch]; cw[t] = DEC[mm * RWD + ch]; }
        float pr, pk, pv;
        if (t0 > 0) { const bf16_t* pc = PROJ + (size_t)(m0 - 1) * ICP + 1024 + ch; pr = __uint_as_float((unsigned)pc[0] << 16); pk = __uint_as_float((unsigned)pc[1024] << 16); pv = __uint_as_float((unsigned)pc[2048] << 16); }
        else if (samp) { const float* sp = INP(2) + ((size_t)l * 8 + b) * RPJ + ch; pr = sp[0]; pk = sp[1024]; pv = sp[2048]; }
        else { pr = 0.f; pk = 0.f; pv = 0.f; }
        float g = 1.0f; unsigned at2[8], bt2[8], kt2[8], vt2[8]; float hold_a = 0.f, hold_b = 0.f, hold_k = 0.f, hold_v = 0.f;
#pragma unroll
        for (int t = 0; t < 16; ++t) {
            const float xr = __uint_as_float((unsigned)cr[t] << 16), xk = __uint_as_float((unsigned)ck[t] << 16), xv = __uint_as_float((unsigned)cv[t] << 16), av = __uint_as_float((unsigned)ca[t] << 16);
            const float r = xr + (pr - xr) * mur, kx = xk + (pk - xk) * muk, vv = xv + (pv - xv) * muv; pr = xr; pk = xk; pv = xv;
            float kkv = kx * ckk; const float ss = wave_sum(kkv * kkv); kkv *= 1.0f / fmaxf(sqrtf(ss), 1e-12f);
            const float kh = kx * (1.0f + (av - 1.0f) * cka), bb = kkv * av; const float bsum = wave_sum(r * kh * crk);
            if (lane == 0) BS[(size_t)(m0 + t) * 16 + h] = bsum;
            const float a_t = -kkv * g; g *= cw[t]; const float ig = 1.0f / g; const float b_t = bb * ig, k_t = kh * ig, r_t = r * g;
            *(LAS unsigned short*)(L + t * 128 + lane * 2) = bf1(a_t); *(LAS unsigned short*)(L + 2048 + t * 128 + lane * 2) = bf1(b_t);
            *(LAS unsigned short*)(L + 4096 + t * 128 + lane * 2) = bf1(k_t); *(LAS unsigned short*)(L + 6144 + t * 128 + lane * 2) = bf1(r_t);
            if (t & 1) { at2[t >> 1] = cvt_pk_c(hold_a, a_t); bt2[t >> 1] = cvt_pk_c(hold_b, b_t); kt2[t >> 1] = cvt_pk_c(hold_k, k_t); vt2[t >> 1] = cvt_pk_c(hold_v, vv); }
            else { hold_a = a_t; hold_b = b_t; hold_k = k_t; hold_v = vv; }
        }
        *(LAS u32x4*)(L + 8192 + lane * 32) = (u32x4){at2[0], at2[1], at2[2], at2[3]}; *(LAS u32x4*)(L + 8192 + lane * 32 + 16) = (u32x4){at2[4], at2[5], at2[6], at2[7]};
        { u32x4* o = (u32x4*)(cb + CB_BK + lane * 64);
#pragma unroll
          for (int q = 0; q < 4; ++q) o[q] = (u32x4){bt2[2 * q], bt2[2 * q + 1], kt2[2 * q], kt2[2 * q + 1]}; }
        { u32x4* o = (u32x4*)(cb + CB_VT + lane * 32); o[0] = (u32x4){vt2[0], vt2[1], vt2[2], vt2[3]}; o[1] = (u32x4){vt2[4], vt2[5], vt2[6], vt2[7]}; }
        *(float*)(cb + CB_GC + lane * 4) = g;
        asm volatile("" ::: "memory");
#define SP_ROWS(off, j) (*(const LAS bf16x8*)(L + (off) + fr * 128 + (j) * 64 + fq * 16))
        f32x4 nD = (f32x4){0.f, 0.f, 0.f, 0.f}, makD = nD, mrbD = nD, mrkD = nD;
#pragma unroll
        for (int j = 0; j < 2; ++j) { const bf16x8 fa = SP_ROWS(0, j), fb = SP_ROWS(2048, j), fk = SP_ROWS(4096, j), fR = SP_ROWS(6144, j);
            nD = mfma16(fb, fa, nD); makD = mfma16(fk, fa, makD); mrbD = mfma16(fb, fR, mrbD); mrkD = mfma16(fk, fR, mrkD); }
#pragma unroll
        for (int rr = 0; rr < 4; ++rr) { const int s = 4 * fq + rr; if (s >= fr) { nD[rr] = 0.f; makD[rr] = 0.f; } if (s > fr) { mrbD[rr] = 0.f; mrkD[rr] = 0.f; } }
        { const u32x2 mb = pk4(mrbD), mk = pk4(mrkD); *(u32x4*)(cb + CB_MBT + (fr * 4 + fq) * 16) = (u32x4){mb.x, mb.y, mk.x, mk.y}; }
#define SP_WR_RM(off, D) do { _Pragma("unroll") for (int rr = 0; rr < 4; ++rr) *(LAS unsigned short*)(L + (off) + (4 * fq + rr) * 32 + fr * 2) = bf1((D)[rr]); } while (0)
#define SP_WR_TR(off, D) do { *(LAS u32x2*)(L + (off) + fr * 32 + fq * 8) = pk4(D); } while (0)
#define SP_FRAG16(off) (fq < 2 ? *(const LAS bf16x8*)(L + (off) + fr * 32 + fq * 16) : (bf16x8){0, 0, 0, 0, 0, 0, 0, 0})
        SP_WR_RM(12288, nD); SP_WR_TR(12800, nD); SP_WR_RM(14336, makD); asm volatile("" ::: "memory");
        f32x4 TD = nD;
#pragma unroll
        for (int rr = 0; rr < 4; ++rr) if (4 * fq + rr == fr) TD[rr] += 1.0f;
#pragma unroll
        for (int itp = 0; itp < 3; ++itp) {
            SP_WR_RM(13312, TD); asm volatile("" ::: "memory");
            const f32x4 p2 = mfma16(SP_FRAG16(12288), SP_FRAG16(12800), (f32x4){0.f, 0.f, 0.f, 0.f}); asm volatile("" ::: "memory");
            SP_WR_RM(12288, p2); SP_WR_TR(12800, p2); asm volatile("" ::: "memory");
            TD = mfma16(SP_FRAG16(13312), SP_FRAG16(12800), TD); asm volatile("" ::: "memory");
        }
        SP_WR_TR(13824, TD); asm volatile("" ::: "memory");
        { const bf16x8 ftt = SP_FRAG16(13824);
#pragma unroll
          for (int blk = 0; blk < 4; ++blk) { const bf16x8 fb = fq < 2 ? *(const LAS bf16x8*)(L + 8192 + (16 * blk + fr) * 32 + fq * 16) : (bf16x8){0, 0, 0, 0, 0, 0, 0, 0};
              const f32x4 d = mfma16(ftt, fb, (f32x4){0.f, 0.f, 0.f, 0.f});
#pragma unroll
              for (int rr = 0; rr < 4; ++rr) *(LAS unsigned short*)(L + 10240 + (4 * fq + rr) * 128 + (16 * blk + fr) * 2) = bf1(d[rr]); }
          const f32x4 p2 = mfma16(SP_FRAG16(14336), ftt, (f32x4){0.f, 0.f, 0.f, 0.f});
          *(u32x2*)(cb + CB_P2T + fr * 32 + fq * 8) = pk4(p2); }
        asm volatile("" ::: "memory");
#pragma unroll
        for (int q = 0; q < 2; ++q) { const int pc = lane + 64 * q, pcc = pc >> 6, pt = (pc >> 2) & 15, pf = pc & 3;
            const u32x2 a0 = *(const LAS u32x2*)(L + 10240 + pt * 128 + (32 * pcc + 4 * pf) * 2), a1 = *(const LAS u32x2*)(L + 10240 + pt * 128 + (32 * pcc + 16 + 4 * pf) * 2);
            const u32x2 r0 = *(const LAS u32x2*)(L + 6144 + pt * 128 + (32 * pcc + 4 * pf) * 2), r1 = *(const LAS u32x2*)(L + 6144 + pt * 128 + (32 * pcc + 16 + 4 * pf) * 2);
            *(u32x4*)(cb + CB_P1T + pc * 16) = (u32x4){a0.x, a0.y, a1.x, a1.y}; *(u32x4*)(cb + CB_RT + pc * 16) = (u32x4){r0.x, r0.y, r1.x, r1.y}; }
        asm volatile("" ::: "memory");
#undef SP_ROWS
#undef SP_WR_RM
#undef SP_WR_TR
#undef SP_FRAG16
    }
}

__device__ __forceinline__ void sseq_phase(Frame& F, int l_in) {
    PHASE_IDS
    unsigned char* const wsl = fresh(F.ws);
    PHASE_L
    float* Y = (float*)(wsl + WS_Y);
    const bool is_cons = wave < 4;
    const int fr = lane & 15, fq = lane >> 4, vrow = (wave & 3) * 16 + fr, ptid = tid & 255;
    for (int u = blockIdx.x; u < 256; u += fresh_i(F.G)) {
        const bool samp = u >= 128; const int h = u & 15, b = (u >> 4) & 7;
        const int T = samp ? TS : TP, m0 = samp ? MPR + b * TS : b * TP, nch = T / 16, crow0 = m0 / 16;
        f32x4 sreg[4];
        if (samp) { const float* sp = INP(4) + ((((size_t)l * 8 + b) * 16 + h) * 64 + vrow) * 64 + 4 * fq;
#pragma unroll
            for (int kb = 0; kb < 4; ++kb) sreg[kb] = *(const f32x4*)(sp + 16 * kb); }
        else {
#pragma unroll
            for (int kb = 0; kb < 4; ++kb) sreg[kb] = (f32x4){0.f, 0.f, 0.f, 0.f}; }
#define SQ_ISSUE(c) do { const unsigned char* src = cb_ptr(wsl, (size_t)(crow0 + (c)) * 16 + h) + ((wave & 3) * 3) * 1024 + lane * 16; LAS unsigned char* dst = F.lds + ((c) % (SQ_D + 1)) * 12288 + ((wave & 3) * 3) * 1024; \
        _Pragma("unroll") for (int i = 0; i < 3; ++i) __builtin_amdgcn_global_load_lds((const unsigned*)(src + i * 1024), (LAS unsigned*)(dst + i * 1024), 16, 0, 0); } while (0)
#define SQ_WAIT(k) do { switch (k) { case 0: asm volatile("s_waitcnt vmcnt(0)" ::: "memory"); break; case 1: asm volatile("s_waitcnt vmcnt(3)" ::: "memory"); break; case 2: asm volatile("s_waitcnt vmcnt(6)" ::: "memory"); break; \
        case 3: asm volatile("s_waitcnt vmcnt(9)" ::: "memory"); break; case 4: asm volatile("s_waitcnt vmcnt(12)" ::: "memory"); break; default: asm volatile("s_waitcnt vmcnt(15)" ::: "memory"); break; } } while (0)
        constexpr int SQ_D = 6;
        __syncthreads();
        if (!is_cons) { const int np = nch < SQ_D ? nch : SQ_D; for (int c = 0; c < np; ++c) SQ_ISSUE(c); SQ_WAIT(np - 1); }
        __syncthreads();
        for (int c = 0; c < nch; ++c) {
            if (is_cons) {
                const LAS unsigned char* B = F.lds + (c % (SQ_D + 1)) * 12288;
#define SQ_KA(off, cc) (*(const LAS bf16x8*)(B + (off) + (((cc) * 16 + fr) * 4 + fq) * 16))
                const u32x2 vt = *(const LAS u32x2*)(B + CB_VT + vrow * 32 + fq * 8), z2 = (u32x2){0u, 0u};
                const bf16x8 aP2 = mk8(*(const LAS u32x2*)(B + CB_P2T + fr * 32 + fq * 8), z2), aP10 = SQ_KA(CB_P1T, 0), aP11 = SQ_KA(CB_P1T, 1), aR0 = SQ_KA(CB_RT, 0), aR1 = SQ_KA(CB_RT, 1);
                const bf16x8 aM = *(const LAS bf16x8*)(B + CB_MBT + (fr * 4 + fq) * 16);
                bf16x8 aBK[4]; f32x4 gc[4];
#pragma unroll
                for (int kb = 0; kb < 4; ++kb) { aBK[kb] = *(const LAS bf16x8*)(B + CB_BK + ((16 * kb + fr) * 4 + fq) * 16); gc[kb] = *(const LAS f32x4*)(B + CB_GC + (16 * kb + 4 * fq) * 4); }
                __builtin_amdgcn_sched_barrier(0);
                const bf16x8 sB0 = mk8(pk4(sreg[0]), pk4(sreg[1])), sB1 = mk8(pk4(sreg[2]), pk4(sreg[3]));
                f32x4 uD = mfma16(aP2, mk8(vt, z2), (f32x4){0.f, 0.f, 0.f, 0.f});
                uD = mfma16(aP10, sB0, uD); uD = mfma16(aP11, sB1, uD);
                const bf16x8 uvB = mk8(pk4(uD), vt);
                f32x4 nS[4];
#pragma unroll
                for (int kb = 0; kb < 4; ++kb) nS[kb] = mfma16(aBK[kb], uvB, sreg[kb]);
                f32x4 yD = mfma16(aM, uvB, (f32x4){0.f, 0.f, 0.f, 0.f});
                yD = mfma16(aR0, sB0, yD); yD = mfma16(aR1, sB1, yD);
#pragma unroll
                for (int kb = 0; kb < 4; ++kb) sreg[kb] = nS[kb] * gc[kb];
                { float* yo = Y + (size_t)(m0 + c * 16 + 4 * fq) * RWD + h * 64 + vrow; yo[0] = yD[0]; yo[RWD] = yD[1]; yo[2 * RWD] = yD[2]; yo[3 * RWD] = yD[3]; }
#undef SQ_KA
            } else {
                if (c + SQ_D < nch) SQ_ISSUE(c + SQ_D);
                if (c + 1 < nch) { const int last = c + SQ_D < nch ? c + SQ_D : nch - 1; SQ_WAIT(last - (c + 1)); }
            }
            asm volatile("s_waitcnt lgkmcnt(0)" ::: "memory"); __builtin_amdgcn_s_barrier(); asm volatile("" ::: "memory");
        }
#undef SQ_ISSUE
#undef SQ_WAIT
        if (is_cons) { float* so = F.out + (samp ? O_WKS : O_WKP) + ((((size_t)l * 8 + b) * 16 + h) * 64 + vrow) * 64 + 4 * fq;
#pragma unroll
            for (int kb = 0; kb < 4; ++kb) *(f32x4*)(so + 16 * kb) = sreg[kb]; }
    }
}

constexpr int SC_TC = 32, SC_STEP = 6 * 64;
__device__ __forceinline__ float sum16(float x) { x += dpp_f<0xB1>(x); x += dpp_f<0x4E>(x); x += dpp_f<0x141>(x); x += dpp_f<0x140>(x); return x; }
__device__ __forceinline__ void unpack4(const u32x2 w, float (&f)[4]) { f[0] = bf_lo(w.x); f[1] = bf_hi(w.x); f[2] = bf_lo(w.y); f[3] = bf_hi(w.y); }
__device__ __forceinline__ void scan_phase(Frame& F, int l_in) {
    PHASE_IDS
    unsigned char* const wsl = fresh(F.ws);
    PHASE_L
    LAS float* buf = (LAS float*)F.lds;
    LAS float* ybuf = (LAS float*)(F.lds + 2 * SC_TC * SC_STEP * 4);
    const float* DEC = (const float*)(wsl + WS_DEC); const bf16_t* PROJ = (const bf16_t*)(wsl + WS_PROJ); const bf16_t* AA = (const bf16_t*)(wsl + WS_AA);
    float* Y = (float*)(wsl + WS_Y); float* BS = (float*)(wsl + WS_BS);
    const bool is_cons = wave < 4;
    const int ks = lane & 7, k0 = ks * 8, rl = (wave & 3) * 8 + (lane >> 3);
    const int ptid = tid & 255, st0 = ptid >> 4, q4 = (ptid & 15) * 4;
    for (int u = blockIdx.x; u < 512; u += fresh_i(F.G)) {
        const bool samp = u >= 256; const int half = u & 1, h = (u >> 1) & 15, b = (u >> 5) & 7;
        const int T = samp ? TS : TP, m0 = samp ? MPR + b * TS : b * TP, ch = h * 64 + q4, row = half * 32 + rl;
        const int nch = T / SC_TC;
        const float* mu = INP(9) + (size_t)l * RPJ;
        const f32x4 mur = *(const f32x4*)(mu + ch), muk = *(const f32x4*)(mu + 1024 + ch), muv = *(const f32x4*)(mu + 2048 + ch);
        const f32x4 ckk = *(const f32x4*)(INP(17) + (size_t)l * RWD + ch), cka = *(const f32x4*)(INP(18) + (size_t)l * RWD + ch), crk = *(const f32x4*)(INP(19) + (size_t)l * RWD + ch);
        const float* shp = INP(2) + ((size_t)l * 8 + b) * RPJ + ch;
        f32x2 S01, S23, S45, S67;
        if (samp) { const float* sp = INP(4) + ((((size_t)l * 8 + b) * 16 + h) * 64 + row) * 64 + k0; const f32x4 s0 = *(const f32x4*)sp, s1 = *(const f32x4*)(sp + 4);
            S01 = (f32x2){s0.x, s0.y}; S23 = (f32x2){s0.z, s0.w}; S45 = (f32x2){s1.x, s1.y}; S67 = (f32x2){s1.z, s1.w}; }
        else { S01 = (f32x2){0.f, 0.f}; S23 = S01; S45 = S01; S67 = S01; }
        u32x2 rw[2][7]; f32x4 rd[2];
#define SC_LOADRAW(c) do { _Pragma("unroll") for (int i2 = 0; i2 < 2; ++i2) { const int tt = (c) * SC_TC + st0 + 16 * i2; const size_t mm = (size_t)(m0 + tt); const bf16_t* pc = PROJ + mm * ICP + 1024 + ch; \
        rw[i2][0] = *(const u32x2*)pc; rw[i2][1] = *(const u32x2*)(pc + 1024); rw[i2][2] = *(const u32x2*)(pc + 2048); rw[i2][6] = *(const u32x2*)(AA + mm * RWD + ch); rd[i2] = *(const f32x4*)(DEC + mm * RWD + ch); \
        if (tt > 0) { rw[i2][3] = *(const u32x2*)(pc - ICP); rw[i2][4] = *(const u32x2*)(pc - ICP + 1024); rw[i2][5] = *(const u32x2*)(pc - ICP + 2048); } \
        else { rw[i2][3] = (u32x2){0u, 0u}; rw[i2][4] = rw[i2][3]; rw[i2][5] = rw[i2][3]; } } } while (0)
#define SC_BUILD(c, bufp) do { _Pragma("unroll") for (int i2 = 0; i2 < 2; ++i2) { const int st = st0 + 16 * i2, tt = (c) * SC_TC + st; const size_t mm = (size_t)(m0 + tt); \
        float xr[4], xk[4], xv[4], yr[4], yk[4], yv[4], av[4]; unpack4(rw[i2][0], xr); unpack4(rw[i2][1], xk); unpack4(rw[i2][2], xv); unpack4(rw[i2][3], yr); unpack4(rw[i2][4], yk); unpack4(rw[i2][5], yv); unpack4(rw[i2][6], av); \
        const f32x4 cd = rd[i2]; \
        if (samp && tt == 0) { const f32x4 t0 = *(const f32x4*)shp, t1 = *(const f32x4*)(shp + 1024), t2 = *(const f32x4*)(shp + 2048); _Pragma("unroll") for (int j = 0; j < 4; ++j) { yr[j] = t0[j]; yk[j] = t1[j]; yv[j] = t2[j]; } } \
        f32x4 vr, vk, vv4, vq, vb, vh; float ss = 0.f, bsum = 0.f; \
        _Pragma("unroll") for (int j = 0; j < 4; ++j) { vr[j] = xr[j] + (yr[j] - xr[j]) * mur[j]; vk[j] = xk[j] + (yk[j] - xk[j]) * muk[j]; vv4[j] = xv[j] + (yv[j] - xv[j]) * muv[j]; \
            vq[j] = vk[j] * ckk[j]; ss += vq[j] * vq[j]; vh[j] = vk[j] * (1.0f + (av[j] - 1.0f) * cka[j]); bsum += vr[j] * vh[j] * crk[j]; } \
        ss = sum16(ss); bsum = sum16(bsum); const float inv = 1.0f / fmaxf(sqrtf(ss), 1e-12f); \
        _Pragma("unroll") for (int j = 0; j < 4; ++j) { vq[j] *= inv; vb[j] = vq[j] * av[j]; } \
        LAS float* d = (bufp) + st * SC_STEP + q4; *(LAS f32x4*)d = cd; *(LAS f32x4*)(d + 64) = vq; *(LAS f32x4*)(d + 128) = vb; *(LAS f32x4*)(d + 192) = vh; *(LAS f32x4*)(d + 256) = vr; *(LAS f32x4*)(d + 320) = vv4; \
        if (half == 0 && q4 == 0) BS[mm * 16 + h] = bsum; } } while (0)
#define SC_FLUSH(c) do { const int fs = ptid >> 3, fj = (ptid & 7) * 4; const f32x4 yo = *(const LAS f32x4*)(ybuf + ((c) & 1) * SC_TC * 32 + fs * 32 + fj); \
        *(f32x4*)(Y + (size_t)(m0 + (c) * SC_TC + fs) * RWD + h * 64 + half * 32 + fj) = yo; } while (0)
        __syncthreads();
        if (!is_cons) { SC_LOADRAW(0); SC_BUILD(0, buf); if (nch > 1) SC_LOADRAW(1); }
        __syncthreads();
        for (int c = 0; c < nch; ++c) {
            LAS float* cur = buf + (c & 1) * SC_TC * SC_STEP; LAS float* oth = buf + ((c + 1) & 1) * SC_TC * SC_STEP; LAS float* yb = ybuf + (c & 1) * SC_TC * 32;
            if (is_cons) {
#define SC_STEP_BODY(s, DO_Y) do { const LAS float* p = cur + (s) * SC_STEP + k0; \
                const f32x4 wa = *(const LAS f32x4*)p, wb = *(const LAS f32x4*)(p + 4), qa = *(const LAS f32x4*)(p + 64), qb = *(const LAS f32x4*)(p + 68), ba = *(const LAS f32x4*)(p + 128), bb = *(const LAS f32x4*)(p + 132), \
                            ha = *(const LAS f32x4*)(p + 192), hb = *(const LAS f32x4*)(p + 196), ra = *(const LAS f32x4*)(p + 256), rb = *(const LAS f32x4*)(p + 260); \
                const float vv = cur[(s) * SC_STEP + 320 + row]; const f32x2 v2 = (f32x2){vv, vv}; \
                f32x2 d = S01 * (f32x2){qa.x, qa.y}; f32x2 d1 = S23 * (f32x2){qa.z, qa.w}; d = S45 * (f32x2){qb.x, qb.y} + d; d1 = S67 * (f32x2){qb.z, qb.w} + d1; d = d + d1; float sa = d.x + d.y; \
                float yv = 0.f; if (DO_Y) { f32x2 e = S01 * (f32x2){rpa.x, rpa.y}; f32x2 e1 = S23 * (f32x2){rpa.z, rpa.w}; e = S45 * (f32x2){rpb.x, rpb.y} + e; e1 = S67 * (f32x2){rpb.z, rpb.w} + e1; e = e + e1; yv = e.x + e.y; } \
                const f32x2 t01 = S01 * (f32x2){wa.x, wa.y} + v2 * (f32x2){ha.x, ha.y}, t23 = S23 * (f32x2){wa.z, wa.w} + v2 * (f32x2){ha.z, ha.w}, t45 = S45 * (f32x2){wb.x, wb.y} + v2 * (f32x2){hb.x, hb.y}, t67 = S67 * (f32x2){wb.z, wb.w} + v2 * (f32x2){hb.z, hb.w}; \
                sa += dpp_f<0xB1>(sa); if (DO_Y) yv += dpp_f<0xB1>(yv); sa += dpp_f<0x4E>(sa); if (DO_Y) yv += dpp_f<0x4E>(yv); sa += dpp_f<0x141>(sa); if (DO_Y) yv += dpp_f<0x141>(yv); \
                const f32x2 n2 = (f32x2){-sa, -sa}; \
                S01 = n2 * (f32x2){ba.x, ba.y} + t01; S23 = n2 * (f32x2){ba.z, ba.w} + t23; S45 = n2 * (f32x2){bb.x, bb.y} + t45; S67 = n2 * (f32x2){bb.z, bb.w} + t67; \
                if (DO_Y) yb[((s) - 1) * 32 + rl] = yv; rpa = ra; rpb = rb; } while (0)
                f32x4 rpa, rpb;
                SC_STEP_BODY(0, false);
#pragma unroll 2
                for (int s = 1; s < SC_TC; ++s) SC_STEP_BODY(s, true);
                { f32x2 e = S01 * (f32x2){rpa.x, rpa.y}; f32x2 e1 = S23 * (f32x2){rpa.z, rpa.w}; e = S45 * (f32x2){rpb.x, rpb.y} + e; e1 = S67 * (f32x2){rpb.z, rpb.w} + e1; e = e + e1; yb[(SC_TC - 1) * 32 + rl] = sum8(e.x + e.y); }
#undef SC_STEP_BODY
            } else {
                if (c + 1 < nch) SC_BUILD(c + 1, oth);
                if (c + 2 < nch) SC_LOADRAW(c + 2);
                if (c > 0) SC_FLUSH(c - 1);
            }
            __syncthreads();
        }
        if (!is_cons) SC_FLUSH(nch - 1);
#undef SC_BUILD
#undef SC_LOADRAW
#undef SC_FLUSH
        if (is_cons) { float* so = F.out + (samp ? O_WKS : O_WKP) + ((((size_t)l * 8 + b) * 16 + h) * 64 + row) * 64 + k0;
            *(f32x4*)so = (f32x4){S01.x, S01.y, S23.x, S23.y}; *(f32x4*)(so + 4) = (f32x4){S45.x, S45.y, S67.x, S67.y}; }
    }
}

__device__ __forceinline__ void post_phase(Frame& F, int l_in) {
    PHASE_IDS
    unsigned char* const wsl = fresh(F.ws);
    PHASE_L
    const int NT = fresh_i(F.G) * NTHR; const float* Y = (const float*)(wsl + WS_Y); const float* BS = (const float*)(wsl + WS_BS);
    const bf16_t* PROJ = (const bf16_t*)(wsl + WS_PROJ); const bf16_t* GG = (const bf16_t*)(wsl + WS_GG);
    bf16_t* YB = (bf16_t*)(wsl + WS_YB);
    const float* muv = INP(9) + (size_t)l * RPJ + 2048; const float* gng = INP(20) + (size_t)l * RWD; const float* gnb = INP(21) + (size_t)l * RWD;
#define PP_LOAD(it_, Y0, Y1, CU, PR, GV, BSV) do { const int m_ = (it_) >> 7, c_ = ((it_) & 127) * 8; const size_t o_ = (size_t)m_ * RWD + c_; int b_, t_; bool s_; row_info(m_, b_, t_, s_); \
        Y0 = *(const f32x4*)(Y + o_); Y1 = *(const f32x4*)(Y + o_ + 4); CU = *(const u32x4*)(PROJ + (size_t)m_ * ICP + 3072 + c_); PR = *(const u32x4*)(PROJ + (size_t)(t_ > 0 ? m_ - 1 : m_) * ICP + 3072 + c_); \
        GV = *(const u32x4*)(GG + o_); BSV = BS[(size_t)m_ * 16 + (c_ >> 6)]; } while (0)
    f32x4 y0, y1, ny0, ny1; u32x4 cu, pr, gv, ncu, npr, ngv; float bs, nbs;
    if (gtid < MT * 128) PP_LOAD(gtid, y0, y1, cu, pr, gv, bs);
    for (int it = gtid; it < MT * 128; it += NT) {
        const int itn = it + NT;
        if (itn < MT * 128) PP_LOAD(itn, ny0, ny1, ncu, npr, ngv, nbs);
        const int m = it >> 7, c0 = (it & 127) * 8; const size_t o = (size_t)m * RWD + c0;
        int b, t; bool samp; row_info(m, b, t, samp);
        float y[8] = {y0.x, y0.y, y0.z, y0.w, y1.x, y1.y, y1.z, y1.w};
        float cur[8], prv[8], g[8]; unpack8(cu, cur); unpack8(gv, g); unpack8(pr, prv);
        if (t == 0) {
            if (samp) { const float* p = INP(2) + ((size_t)l * 8 + b) * RPJ + 2048 + c0;
#pragma unroll
                for (int j = 0; j < 8; ++j) prv[j] = p[j]; }
            else {
#pragma unroll
                for (int j = 0; j < 8; ++j) prv[j] = 0.f; }
        }
        float s = 0.f;
#pragma unroll
        for (int j = 0; j < 8; ++j) s += y[j];
        s = sum8(s);
        const float mean = s * (1.0f / 64.0f); float q = 0.f;
#pragma unroll
        for (int j = 0; j < 8; ++j) { const float d = y[j] - mean; q += d * d; }
        q = sum8(q);
        const float rstd = __builtin_amdgcn_rsqf(q * (1.0f / 64.0f) + GN_EPS);
        float outv[8];
#pragma unroll
        for (int j = 0; j < 8; ++j) { const float v = cur[j] + (prv[j] - cur[j]) * muv[c0 + j]; outv[j] = ((y[j] - mean) * rstd * gng[c0 + j] + gnb[c0 + j] + bs * v) * g[j]; }
        *(u32x4*)(YB + o) = pack8(outv);
        y0 = ny0; y1 = ny1; cu = ncu; pr = npr; gv = ngv; bs = nbs;
    }
#undef PP_LOAD
}

__device__ __forceinline__ void tile64_mma(const bf16_t* A, int lda, const bf16_t* Bt, int ldb, int K, int m0, int n0, int wave, int lane, f32x4 (&acc)[4][4]) {
    const int kq = K >> 3, kb = wave * kq, lr = lane & 15, lk = (lane >> 4) * 8;
    const bf16_t* ap = A + (size_t)(m0 + lr) * lda + kb + lk; const bf16_t* bp = Bt + (size_t)(n0 + lr) * ldb + kb + lk;
#pragma unroll 2
    for (int k = 0; k < kq; k += 32) {
        bf16x8 af[4], bf[4];
#pragma unroll
        for (int i = 0; i < 4; ++i) { af[i] = *(const bf16x8*)(ap + (size_t)(16 * i) * lda + k); bf[i] = *(const bf16x8*)(bp + (size_t)(16 * i) * ldb + k); }
#pragma unroll
        for (int mi = 0; mi < 4; ++mi)
#pragma unroll
            for (int ni = 0; ni < 4; ++ni) acc[mi][ni] = __builtin_amdgcn_mfma_f32_16x16x32_bf16(bf[ni], af[mi], acc[mi][ni], 0, 0, 0);
    }
}
__device__ __forceinline__ void tile64_reduce(LAS unsigned char* lds, int wave, int lane, const f32x4 (&acc)[4][4], f32x4 (&out)[2]) {
    LAS f32x4* red = (LAS f32x4*)lds;
    __syncthreads();
#pragma unroll
    for (int mi = 0; mi < 4; ++mi)
#pragma unroll
        for (int ni = 0; ni < 4; ++ni) red[(wave * 16 + mi * 4 + ni) * 64 + lane] = acc[mi][ni];
    __syncthreads();
#pragma unroll
    for (int j = 0; j < 2; ++j) { f32x4 s = red[(2 * wave + j) * 64 + lane];
#pragma unroll
        for (int w = 1; w < 8; ++w) s += red[(w * 16 + 2 * wave + j) * 64 + lane];
        out[j] = s; }
}
#define T64_ZERO(acc) do { _Pragma("unroll") for (int mi = 0; mi < 4; ++mi) _Pragma("unroll") for (int ni = 0; ni < 4; ++ni) acc[mi][ni] = (f32x4){0.f, 0.f, 0.f, 0.f}; } while (0)
template <int MODE>
__device__ __forceinline__ void sample_tiles(Frame& F, int l_in) {
    PHASE_IDS
    unsigned char* const wsl = fresh(F.ws);
    PHASE_L
    const size_t xb_cur = (l & 1) ? WS_XB2 : WS_XN, xb_nxt = (l & 1) ? WS_XN : WS_XB2;
    for (int t = blockIdx.x; t < 256; t += fresh_i(F.G)) {
        const int m0 = MPR + (t >> 5) * 64, n0 = (t & 31) * 64;
        f32x4 acc[4][4], o1[2], o2[2]; T64_ZERO(acc);
        if (MODE == 0) { tile64_mma((const bf16_t*)(wsl + WS_YA), PWD, (const bf16_t*)(wsl + WS_PPOOL), PWD, PWD, m0, n0, wave, lane, acc); tile64_reduce(F.lds, wave, lane, acc, o1);
                         T64_ZERO(acc); tile64_mma((const bf16_t*)(wsl + WS_YB), RWD, (const bf16_t*)(wsl + WS_PRWKV), RWD, RWD, m0, n0, wave, lane, acc); tile64_reduce(F.lds, wave, lane, acc, o2); }
        if (MODE == 1) { tile64_mma((const bf16_t*)(wsl + WS_MRG), DM, (const bf16_t*)(wsl + WS_WOUT), DM, DM, m0, n0, wave, lane, acc); tile64_reduce(F.lds, wave, lane, acc, o1); }
        if (MODE == 2) { tile64_mma((const bf16_t*)(wsl + WS_HID), FF, (const bf16_t*)(wsl + WS_WDN), FF, FF, m0, n0, wave, lane, acc); tile64_reduce(F.lds, wave, lane, acc, o1); }
        if (MODE == 3) { tile64_mma((const bf16_t*)(wsl + xb_cur), DM, (const bf16_t*)(wsl + WS_WPG), DM, DM, m0, n0, wave, lane, acc); tile64_reduce(F.lds, wave, lane, acc, o1); }
        if (MODE == 4) { tile64_mma((const bf16_t*)(wsl + WS_PB), PLE, (const bf16_t*)(wsl + WS_WPP), PLE, PLE, m0, n0, wave, lane, acc); tile64_reduce(F.lds, wave, lane, acc, o1); }
#pragma unroll
        for (int j = 0; j < 2; ++j) { const int blk = 2 * wave + j; const size_t row = (size_t)(m0 + 16 * (blk >> 2) + (lane & 15)); const int col = n0 + 16 * (blk & 3) + 4 * (lane >> 4);
            if (MODE == 0) { const bf16_t* PROJ = (const bf16_t*)(wsl + WS_PROJ); const u32x2 g1 = *(const u32x2*)(PROJ + row * ICP + PC_GP + col), g2 = *(const u32x2*)(PROJ + row * ICP + PC_GR + col);
                const f32x4 a = (f32x4){bf_lo(g1.x), bf_hi(g1.x), bf_lo(g1.y), bf_hi(g1.y)} * o1[j] + (f32x4){bf_lo(g2.x), bf_hi(g2.x), bf_lo(g2.y), bf_hi(g2.y)} * o2[j];
                *(u32x2*)((bf16_t*)(wsl + WS_MRG) + row * DM + col) = (u32x2){cvt_pk_bf16(a.x, a.y), cvt_pk_bf16(a.z, a.w)}; }
            if (MODE == 1 || MODE == 2) { bf16_t* p = (bf16_t*)(wsl + xb_cur) + row * DM + col; const u32x2 q = *(const u32x2*)p; const f32x4 x = (f32x4){bf_lo(q.x), bf_hi(q.x), bf_lo(q.y), bf_hi(q.y)} + o1[j];
                *(u32x2*)p = (u32x2){cvt_pk_bf16(x.x, x.y), cvt_pk_bf16(x.z, x.w)}; __hip_atomic_fetch_add((pg8::ss_t*)(wsl + WS_SS) + (size_t)MODE * MT + row, pg8::ss_fix((x.x * x.x + x.y * x.y) + (x.z * x.z + x.w * x.w)), __ATOMIC_RELAXED, __HIP_MEMORY_SCOPE_AGENT); }
            if (MODE == 3) { const u32x2 q = *(const u32x2*)((const bf16_t*)(wsl + WS_PP) + row * DM + col); const u32x2 xq = *(const u32x2*)((const bf16_t*)(wsl + xb_cur) + row * DM + col); bf16_t* p = (bf16_t*)(wsl + xb_nxt) + row * DM + col;
                const float rs = pg8::rstd_of((const pg8::ss_t*)(wsl + WS_SS) + (size_t)2 * MT, row);
                const f32x4 x = (f32x4){bf_lo(xq.x), bf_hi(xq.x), bf_lo(xq.y), bf_hi(xq.y)} + sigmoid4(o1[j] * rs) * (f32x4){bf_lo(q.x), bf_hi(q.x), bf_lo(q.y), bf_hi(q.y)};
                *(u32x2*)p = (u32x2){cvt_pk_bf16(x.x, x.y), cvt_pk_bf16(x.z, x.w)}; __hip_atomic_fetch_add((pg8::ss_t*)(wsl + WS_SS) + row, pg8::ss_fix((x.x * x.x + x.y * x.y) + (x.z * x.z + x.w * x.w)), __ATOMIC_RELAXED, __HIP_MEMORY_SCOPE_AGENT); }
            if (MODE == 4) *(u32x2*)((bf16_t*)(wsl + WS_PP) + row * DM + col) = (u32x2){cvt_pk_bf16(o1[j].x, o1[j].y), cvt_pk_bf16(o1[j].z, o1[j].w)};
        }
    }
    __syncthreads();
}

constexpr int PH_PER_LAYER = 12, N_PHASES = NL * PH_PER_LAYER + 1;
#ifndef MK_AB
#define MK_AB 0
#endif
#ifndef MK_REP
#define MK_REP 0
#endif
__global__ void __launch_bounds__(NTHR, 2) mega_fwd(Args args) {
    extern __shared__ __attribute__((aligned(16))) unsigned char lds[];
    Frame F;
    F.lds = (LAS unsigned char*)lds;
    F.G = gridDim.x;
    F.out = args.out; F.ws = args.ws;
    { LAS unsigned long long* pt = (LAS unsigned long long*)(F.lds + LDSCTL_OFF + 1024); F.ptab = pt;
      if (threadIdx.x == 0) {
#define PT_(k) pt[k] = (unsigned long long)args.in[k];
          PT_(0) PT_(1) PT_(2) PT_(3) PT_(4) PT_(5) PT_(6) PT_(7) PT_(8) PT_(9) PT_(10) PT_(11) PT_(12) PT_(13) PT_(14) PT_(15) PT_(16) PT_(17) PT_(18) PT_(19) PT_(20) PT_(21) PT_(22) PT_(23) PT_(24) PT_(25) PT_(26) PT_(27) PT_(28) PT_(29) PT_(30) PT_(31) PT_(32)
#undef PT_
      } }
    volatile LAS unsigned* MISC = (volatile LAS unsigned*)(F.lds + LDSCTL_OFF);
    for (int u = threadIdx.x; u < 256; u += NTHR) ((LAS unsigned*)(F.lds + LDSCTL_OFF))[u] = 0u;
    __syncthreads();
    XcdBarrier bar; bar.bar = (unsigned*)(args.ws + WS_CTL) + CW_BAR; bar.x = 0; bar.st = nullptr;
    if (!MK_PER_PHASE) bar = xcd_barrier_post((unsigned*)(args.ws + WS_CTL) + CW_BAR, MISC + 8);
    const int lo = args.ph_lo, hi = args.ph_hi;
#define IN(k) (lo <= (k) && (k) < hi)
#define REP(k) (1 + ((MK_REP >> (k)) & 1))
#define PHASE(k, ...) do { if (IN(pb + (k))) { for (int rep = 0; rep < REP(k); ++rep) { if (rep) xcd_barrier(bar); __VA_ARGS__ } if (IN(pb + (k) + 1)) xcd_barrier(bar); } } while (0)
#define WSP(off) (fresh(F.ws) + (off))
#define UNPAREN(...) __VA_ARGS__
#define GEMM_M(M_, EPI, EINIT, Aoff, Boff, N_, K_, lda_, ldb_, apn_) do { pg8::Gemm g{(const bf16_t*)WSP(Aoff), (const bf16_t*)WSP(Boff), (M_), (N_), (K_), (lda_), (ldb_), (apn_)}; pg8::StaticOrder S; S.init((M_), (N_), fresh_i(F.G), fresh_i(cid)); \
        pg8::EPI E{UNPAREN EINIT}; pg8::gemm_phase<pg8::EPI, pg8::StaticOrder, true>(ring, g, S, E); } while (0)
#define GEMM(...) GEMM_M(MT, __VA_ARGS__)
    LAS unsigned char* ring = F.lds;
    const int cid = (int)blockIdx.x;
    for (int l = 0; l < NL; ++l) {
        const int pb = l * PH_PER_LAYER;
#define SSP(i) ((pg8::ss_t*)WSP(WS_SS) + (size_t)(i) * MT)
        const size_t xb_cur = (l & 1) ? WS_XB2 : WS_XN, xb_nxt = (l & 1) ? WS_XN : WS_XB2;
        PHASE(0, { convert_weights(F, l); if (l == 0) xb_from_input(F); });
        PHASE(1, { GEMM(EpiProj, ((bf16_t*)WSP(WS_PROJ), SSP(0)), xb_cur, WS_WIN, ICP, DM, DM, DM, 0); });
        PHASE(2, { prep1_phase(F, l); });
        PHASE(3, { GEMM(EpiBf16, ((bf16_t*)WSP(WS_YA), PWD), WS_D, WS_POOLW, PWD, 256, PWD, 256, 256);
                   GEMM(EpiLora, ((float*)WSP(WS_DEC), (bf16_t*)WSP(WS_AA), (bf16_t*)WSP(WS_GG), INP(12) + (size_t)fresh_i(l) * RWD, INP(14) + (size_t)fresh_i(l) * RWD), WS_LIN, WS_LORA, 3072, LK, LK, LK, 0); });
        PHASE(4, { spre_phase(F, l); });
        PHASE(5, { sseq_phase(F, l); if (MK_AB) { xcd_barrier(bar); scan_phase(F, l); } });
        PHASE(6, { post_phase(F, l); });
        PHASE(7, { GEMM_M(MPR, EpiGate1, ((bf16_t*)WSP(WS_TMP), (const bf16_t*)WSP(WS_PROJ), PC_GP), WS_YA, WS_PPOOL, DM, PWD, PWD, PWD, 0);
                   GEMM_M(MPR, EpiGate2, ((const bf16_t*)WSP(WS_TMP), (const bf16_t*)WSP(WS_PROJ), PC_GR, (bf16_t*)WSP(WS_MRG)), WS_YB, WS_PRWKV, DM, RWD, RWD, RWD, 0);
                   sample_tiles<0>(F, l); });
        PHASE(8, { GEMM_M(MPR, EpiResid, ((bf16_t*)WSP(xb_cur), SSP(1)), WS_MRG, WS_WOUT, DM, DM, DM, DM, 0); sample_tiles<1>(F, l); });
        PHASE(9, { GEMM(EpiSwiglu, ((bf16_t*)WSP(WS_HID), SSP(1)), xb_cur, WS_WGU, 2 * FF, DM, DM, DM, 0);
                   GEMM_M(MPR, EpiBf16, ((bf16_t*)WSP(WS_PP), DM), WS_PB, WS_WPP, DM, PLE, PLE, PLE, 0); sample_tiles<4>(F, l); });
        PHASE(10, { GEMM_M(MPR, EpiResid, ((bf16_t*)WSP(xb_cur), SSP(2)), WS_HID, WS_WDN, DM, FF, FF, FF, 0); sample_tiles<2>(F, l); });
        PHASE(11, { GEMM_M(MPR, EpiPle, ((const bf16_t*)WSP(xb_cur), (bf16_t*)WSP(xb_nxt), (const bf16_t*)WSP(WS_PP), SSP(2), SSP(0)), xb_cur, WS_WPG, DM, DM, DM, DM, 0); sample_tiles<3>(F, l); });
#undef SSP
    }
    if (IN(NL * PH_PER_LAYER)) final_norm(F, INP(32));
#undef IN
#undef REP
#undef PHASE
#undef WSP
#undef GEMM
#undef GEMM_M
#undef UNPAREN
}

extern "C" void kernel_launch(void* const* d_in, const int* in_sizes, int n_in, void* d_out, int out_size, void* d_ws, size_t ws_size, hipStream_t stream) {
    static int grid = 0;
    if (grid == 0) {
        if (n_in != 33 || in_sizes[0] != MPR * DM || out_size != (int)O_END || ws_size < WS_END) {
            fprintf(stderr, "kernel_launch: unexpected shapes: n_in %d in0 %d out %d ws %zu (need %zu); nothing launched\n", n_in, n_in > 0 ? in_sizes[0] : -1, out_size, ws_size, (size_t)WS_END); grid = -1; return; }
        int dev = 0, cus = 0, per_cu = 0;
        if (hipGetDevice(&dev) != hipSuccess || hipDeviceGetAttribute(&cus, hipDeviceAttributeMultiprocessorCount, dev) != hipSuccess) { grid = -1; return; }
        if (hipFuncSetAttribute((const void*)mega_fwd, hipFuncAttributeMaxDynamicSharedMemorySize, LDS_BYTES) != hipSuccess) { fprintf(stderr, "kernel_launch: hipFuncSetAttribute failed\n"); grid = -1; return; }
        if (hipOccupancyMaxActiveBlocksPerMultiprocessor(&per_cu, (const void*)mega_fwd, NTHR, LDS_BYTES) != hipSuccess || per_cu < 1) { fprintf(stderr, "kernel_launch: occupancy query says %d\n", per_cu); (void)hipGetLastError(); grid = -1; return; }
        grid = cus;
    }
    if (grid < 0) return;
    (void)hipMemsetAsync((char*)d_ws + WS_CTL, 0, CTL_ZERO_BYTES, stream);
    Args a; memset(&a, 0, sizeof(a));
    for (int i = 0; i < 33; ++i) a.in[i] = (const float*)d_in[i];
    a.out = (float*)d_out; a.ws = (unsigned char*)d_ws;
#if MK_PER_PHASE
    for (int p = 0; p < N_PHASES; ++p) { a.ph_lo = p; a.ph_hi = p + 1; hipLaunchKernelGGL(mega_fwd, dim3(grid), dim3(NTHR), LDS_BYTES, stream, a); }
#else
    a.ph_lo = 0; a.ph_hi = N_PHASES; hipLaunchKernelGGL(mega_fwd, dim3(grid), dim3(NTHR), LDS_BYTES, stream, a);
#endif
}
```

```cpp
#include <hip/hip_runtime.h>
#include <cstdio>
#include <cstdint>
#include <cstring>

#ifndef MK_PER_PHASE
#define MK_PER_PHASE 0
#endif

#define LAS __attribute__((address_space(3)))
typedef unsigned short bf16_t;
typedef short bf16x8 __attribute__((ext_vector_type(8)));
typedef float f32x4 __attribute__((ext_vector_type(4)));
typedef float f32x2 __attribute__((ext_vector_type(2)));
typedef unsigned u32x4 __attribute__((ext_vector_type(4)));
typedef unsigned u32x2 __attribute__((ext_vector_type(2)));

constexpr int DM = 2048, NL = 4, MT = 16896, MPR = 16384, TP = 2048, TS = 64;
constexpr int PWD = 1024, RWD = 1024, RPJ = 3360, ICOLS = 8480, ICP = 8704, FF = 5632, PLE = 256, LK = 384;
constexpr int PC_GP = 4608, PC_GR = 6656;
constexpr float NORM_EPS = 1e-6f, GN_EPS = 64e-5f;
constexpr size_t O_YS = 33554432, O_SHP = 34603008, O_POP = 34710528, O_WKP = 35202048, O_SHS = 37299200, O_POS = 37406720, O_WKS = 37898240, O_END = 39995392;

__device__ __forceinline__ unsigned cvt_pk_bf16(float lo, float hi) { unsigned r; asm volatile("v_cvt_pk_bf16_f32 %0, %1, %2" : "=v"(r) : "v"(lo), "v"(hi)); return r; }
__device__ __forceinline__ float bf_lo(unsigned u) { return __uint_as_float(u << 16); }
__device__ __forceinline__ float bf_hi(unsigned u) { return __uint_as_float(u & 0xffff0000u); }
__device__ __forceinline__ void unpack8(const u32x4 w, float (&f)[8]) { f[0] = bf_lo(w.x); f[1] = bf_hi(w.x); f[2] = bf_lo(w.y); f[3] = bf_hi(w.y); f[4] = bf_lo(w.z); f[5] = bf_hi(w.z); f[6] = bf_lo(w.w); f[7] = bf_hi(w.w); }
__device__ __forceinline__ u32x4 pack8(const float (&f)[8]) { u32x4 w; w.x = cvt_pk_bf16(f[0], f[1]); w.y = cvt_pk_bf16(f[2], f[3]); w.z = cvt_pk_bf16(f[4], f[5]); w.w = cvt_pk_bf16(f[6], f[7]); return w; }
__device__ __forceinline__ float sigmoidf_(float x) { return __builtin_amdgcn_rcpf(1.0f + __expf(-x)); }
__device__ __forceinline__ f32x4 sigmoid4(f32x4 v) { f32x4 o; o.x = sigmoidf_(v.x); o.y = sigmoidf_(v.y); o.z = sigmoidf_(v.z); o.w = sigmoidf_(v.w); return o; }
__device__ __forceinline__ float tanhf_(float x) { const float e = __expf(2.0f * x); return 1.0f - 2.0f * __builtin_amdgcn_rcpf(e + 1.0f); }
template <int CTRL> __device__ __forceinline__ float dpp_f(float x) { return __uint_as_float((unsigned)__builtin_amdgcn_update_dpp(0, (int)__float_as_uint(x), CTRL, 0xF, 0xF, true)); }
__device__ __forceinline__ float sum8(float x) { x += dpp_f<0xB1>(x); x += dpp_f<0x4E>(x); x += dpp_f<0x141>(x); return x; }
__device__ __forceinline__ float wave_sum(float x) {
    x += dpp_f<0xB1>(x); x += dpp_f<0x4E>(x); x += dpp_f<0x141>(x); x += dpp_f<0x140>(x);
    x += __uint_as_float((unsigned)__builtin_amdgcn_ds_swizzle((int)__float_as_uint(x), 0x401F));
    return __uint_as_float((unsigned)__builtin_amdgcn_readlane((int)__float_as_uint(x), 0)) + __uint_as_float((unsigned)__builtin_amdgcn_readlane((int)__float_as_uint(x), 32));
}

namespace pg8 {
typedef unsigned ss_t;
constexpr int BM = 256, BK = 64, HALF = 128, HTB = HALF * BK * 2  , STAGE_BYTES = 8 * HTB, NXCD = 8, WGM = 8;
__host__ __device__ __forceinline__ int lds_byte(int r, int c) { const int st = (r >> 4) * 2 + (c >> 5), rr = r & 15, cc = c & 31, ob = rr * 64 + cc * 2; return st * 1024 + (ob ^ (((ob >> 9) & 1) << 5)); }
__host__ __device__ __forceinline__ void stage_rc(int b, int& R, int& C) { const int st = b / 1024, sb = b % 1024, swz = sb ^ (((sb >> 9) & 1) << 5); R = (st >> 1) * 16 + swz / 64; C = (st & 1) * 32 + (swz % 64) / 2; }
__host__ __device__ __forceinline__ int perm32(int rho) { const int n = rho >> 4, i = rho & 15; return 8 * (i >> 2) + 4 * n + (i & 3); }

struct Unit { int pm, pn; };
struct Gemm { const bf16_t* A; const bf16_t* Bt; int M, N, K, lda, ldb, a_pn_off; };

struct StaticOrder {
    int nM, nN, nwg, G, c;
    __host__ __device__ void init(int M, int N, int G_, int c_) { nM = M / BM; nN = N / BM; nwg = nM * nN; G = G_; c = c_; }
    __host__ __device__ bool next(int i, Unit& u) const {
        if (c < 0) return false;
        const long L = (long)i * G + c; if (L >= nwg) return false;
        int wgid = (int)L; { const int q = nwg / NXCD, r = nwg % NXCD, xcd = wgid % NXCD, off = wgid / NXCD; wgid = (xcd < r ? xcd * (q + 1) : r * (q + 1) + (xcd - r) * q) + off; }
        const int nig = WGM * nN, gid = wgid / nig, fm = gid * WGM, gsz = (nM - fm) < WGM ? (nM - fm) : WGM;
        u.pm = fm + ((wgid % nig) % gsz); u.pn = (wgid % nig) / gsz; return true;
    }
    __device__ __forceinline__ void a_ready(const Unit&) const {}
    __device__ __forceinline__ void done(const Unit&) const {}
};

__device__ __forceinline__ void acc_zero(f32x4 (&acc)[2][2][4][2]) {
#pragma unroll
    for (int a = 0; a < 2; ++a)
#pragma unroll
        for (int b = 0; b < 2; ++b)
#pragma unroll
            for (int m = 0; m < 4; ++m)
#pragma unroll
                for (int n = 0; n < 2; ++n) acc[a][b][m][n] = (f32x4){0.f, 0.f, 0.f, 0.f};
}
struct RepeatOrder : StaticOrder {
    __host__ __device__ bool next(int i, Unit& u) const { if (i >= 6) return false; return StaticOrder::next(i % 3, u) || StaticOrder::next(0, u); }
};
#define EPI_ZERO_INIT __device__ __forceinline__ void init(f32x4 (&acc)[2][2][4][2], const Unit&, int, int, int, int) const { acc_zero(acc); }
#define EPI_NO_PRE __device__ __forceinline__ void preload(ss_t (&pre)[2], const Unit&, int, int, int) const {}
#define EPI_SS_PRE(SSPTR) __device__ __forceinline__ void preload(ss_t (&pre)[2], const Unit& u, int wr, int fr, int fq) const { _Pragma("unroll") for (int j = 0; j < 2; ++j) { const int g = 2 * fq + j; \
        pre[j] = (SSPTR)[(size_t)(u.pm * BM + (g >> 2) * HALF + wr * 64 + (g & 3) * 16 + fr)]; } }
__device__ __forceinline__ ss_t pre_get(const ss_t (&pre)[2], int g, int fr) { return (ss_t)__builtin_amdgcn_ds_bpermute((((g >> 1) << 4) + fr) << 2, (int)pre[g & 1]); }
template <class Epi, class Sched, bool ALIGN_EPI>
__device__ __forceinline__ void gemm_phase(LAS unsigned char* lds, const Gemm g, const Sched& S, const Epi& E) {
    int tid_ = threadIdx.x; asm volatile("" : "+v"(tid_));
    const int tid = tid_, wid = __builtin_amdgcn_readfirstlane(tid >> 6), lane = tid & 63, wr = wid >> 2, wc = wid & 3, fr = lane & 15, fq = lane >> 4;
    int K_ = g.K; asm volatile("" : "+s"(K_));
    const int K = K_, nt = K / BK;
    unsigned voffA[2], voffB[2];
#pragma unroll
    for (int i = 0; i < 2; ++i) { int R, C; stage_rc(tid * 16 + i * 8192, R, C); const int Rb = Epi::PERM ? (64 * (R >> 5) + perm32(R & 31)) : R;
        voffA[i] = (unsigned)(R * g.lda + C) * 2u; voffB[i] = (unsigned)(Rb * g.ldb + C) * 2u; }
    const size_t kstep = (size_t)(BK * 2);
    const size_t hstepA = (size_t)HALF * g.lda * 2, hstepB = (size_t)(Epi::PERM ? 32 : HALF) * g.ldb * 2;
    const unsigned ldsw = (unsigned)wid * 1024u;
    const int aoff = lds_byte(wr * 64 + fr, fq * 8), boff = lds_byte(wc * 32 + fr, fq * 8);
#define PG8_SA(b, h) (((b) * 2 + (h)) * HTB)
#define PG8_SB(b, h) ((4 + (b) * 2 + (h)) * HTB)
#define PG8_STAGE(bufoff, gbase, voff) do { _Pragma("unroll") for (int _i = 0; _i < 2; ++_i) \
        __builtin_amdgcn_global_load_lds((const unsigned*)((const char*)(gbase) + (voff)[_i]), (LAS unsigned*)(lds + (bufoff) + ldsw + _i * 8192), 16, 0, 0); } while (0)
#define PG8_LDA(dst, b, h) do { _Pragma("unroll") for (int m = 0; m < 4; ++m) _Pragma("unroll") for (int k = 0; k < 2; ++k) dst[m][k] = *(const LAS bf16x8*)(lds + PG8_SA(b, h) + aoff + m * 2048 + k * 1024); } while (0)
#define PG8_LDB(dst, b, h) do { _Pragma("unroll") for (int n = 0; n < 2; ++n) _Pragma("unroll") for (int k = 0; k < 2; ++k) dst[n][k] = *(const LAS bf16x8*)(lds + PG8_SB(b, h) + boff + n * 2048 + k * 1024); } while (0)
#define PG8_MMA(ai, bj, At, Bt) do { __builtin_amdgcn_s_setprio(1); _Pragma("unroll") for (int m = 0; m < 4; ++m) _Pragma("unroll") for (int n = 0; n < 2; ++n) _Pragma("unroll") for (int k = 0; k < 2; ++k) \
        acc[ai][bj][m][n] = __builtin_amdgcn_mfma_f32_16x16x32_bf16(Bt[n][k], At[m][k], acc[ai][bj][m][n], 0, 0, 0); __builtin_amdgcn_s_setprio(0); } while (0)
#define PG8_WAIT_V(n) asm volatile("s_waitcnt vmcnt(" #n ")" ::: "memory")
#define PG8_WAIT_L(n) asm volatile("s_waitcnt lgkmcnt(" #n ")" ::: "memory")
#define PG8_BAR __builtin_amdgcn_s_barrier()
#define PG8_SCHED __builtin_amdgcn_sched_barrier(0)
    Unit cur, nxt; int ui = 0;
    if (!S.next(0, cur)) return;
    f32x4 acc[2][2][4][2]; ss_t pre[2];
    E.init(acc, cur, wr, wc, fr, fq); E.preload(pre, cur, wr, fr, fq);
    bf16x8 At[4][2], B0[2][2], B1[2][2];
    const char* cA = (const char*)g.A + ((size_t)cur.pm * BM * g.lda + (size_t)cur.pn * g.a_pn_off) * 2; const char* cB = (const char*)g.Bt + (size_t)cur.pn * BM * g.ldb * 2;
    S.a_ready(cur);
    PG8_STAGE(PG8_SB(0, 0), cB, voffB); PG8_STAGE(PG8_SB(0, 1), cB + hstepB, voffB); PG8_STAGE(PG8_SA(0, 0), cA, voffA); PG8_STAGE(PG8_SA(0, 1), cA + hstepA, voffA);
    if (wr == 1) PG8_BAR;
    PG8_WAIT_V(2); PG8_BAR;
    PG8_STAGE(PG8_SB(1, 0), cB + kstep, voffB); PG8_STAGE(PG8_SA(1, 0), cA + kstep, voffA); PG8_STAGE(PG8_SB(1, 1), cB + hstepB + kstep, voffB);
    PG8_WAIT_V(6); PG8_BAR;
    for (;;) {
        const bool has_next = S.next(ui + 1, nxt);
        const char* nA = has_next ? (const char*)g.A + ((size_t)nxt.pm * BM * g.lda + (size_t)nxt.pn * g.a_pn_off) * 2 : cA; const char* nB = has_next ? (const char*)g.Bt + (size_t)nxt.pn * BM * g.ldb * 2 : cB;
#pragma unroll 1
        for (int t = 0; t < nt; t += 2) {
            const bool last = (t == nt - 2);
            const char* a1 = cA + (size_t)(t + 1) * kstep;
            const char* a2 = last ? nA : cA + (size_t)(t + 2) * kstep; const char* b2 = last ? nB : cB + (size_t)(t + 2) * kstep;
            const char* a3 = a2 + kstep; const char* b3 = b2 + kstep;
            if (last && has_next) S.a_ready(nxt);
            PG8_LDB(B0, 0, 0); PG8_LDB(B1, 0, 1); PG8_SCHED; PG8_LDA(At, 0, 0); PG8_STAGE(PG8_SA(1, 1), a1 + hstepA, voffA);
            PG8_WAIT_V(8); PG8_WAIT_L(0); PG8_BAR; PG8_MMA(0, 0, At, B0); PG8_MMA(0, 1, At, B1); PG8_BAR; PG8_SCHED;
            PG8_LDA(At, 0, 1); PG8_STAGE(PG8_SB(0, 0), b2, voffB); PG8_STAGE(PG8_SB(0, 1), b2 + hstepB, voffB); PG8_STAGE(PG8_SA(0, 0), a2, voffA);
            PG8_WAIT_V(8); PG8_WAIT_L(0); PG8_BAR; PG8_MMA(1, 0, At, B0); PG8_MMA(1, 1, At, B1); PG8_BAR; PG8_SCHED;
            PG8_LDB(B0, 1, 0); PG8_LDB(B1, 1, 1); PG8_SCHED; PG8_LDA(At, 1, 0); PG8_STAGE(PG8_SA(0, 1), a2 + hstepA, voffA);
            PG8_WAIT_V(8); PG8_WAIT_L(0); PG8_BAR; PG8_MMA(0, 0, At, B0); PG8_MMA(0, 1, At, B1); PG8_BAR; PG8_SCHED;
            PG8_LDA(At, 1, 1); PG8_STAGE(PG8_SB(1, 0), b3, voffB); PG8_STAGE(PG8_SB(1, 1), b3 + hstepB, voffB); PG8_STAGE(PG8_SA(1, 0), a3, voffA);
            PG8_WAIT_V(8); PG8_WAIT_L(0); PG8_BAR; PG8_MMA(1, 0, At, B0); PG8_MMA(1, 1, At, B1); PG8_BAR; PG8_SCHED;
        }
        if constexpr (ALIGN_EPI) { if (wr == 0) PG8_BAR; }
        E(acc, pre, cur, wr, wc, fr, fq); S.done(cur);
        if (!has_next) break;
        E.init(acc, nxt, wr, wc, fr, fq); E.preload(pre, nxt, wr, fr, fq);
        cur = nxt; cA = nA; cB = nB; ++ui;
        if constexpr (ALIGN_EPI) { if (wr == 1) PG8_BAR; }
    }
    PG8_WAIT_V(0);
    if constexpr (!ALIGN_EPI) { if (wr == 0) PG8_BAR; }
    PG8_BAR;
#undef PG8_SA
#undef PG8_SB
#undef PG8_STAGE
#undef PG8_LDA
#undef PG8_LDB
#undef PG8_MMA
#undef PG8_WAIT_V
#undef PG8_WAIT_L
#undef PG8_BAR
#undef PG8_SCHED
}

#define EPI_ROW0 (u.pm * BM + wr * 64 + fr)
#define EPI_FOR_AI_M _Pragma("unroll") for (int ai = 0; ai < 2; ++ai) _Pragma("unroll") for (int m = 0; m < 4; ++m)
__device__ __forceinline__ u32x4 pack_f4x2(f32x4 v0, f32x4 v1) { u32x4 w; w.x = cvt_pk_bf16(v0[0], v0[1]); w.y = cvt_pk_bf16(v0[2], v0[3]); w.z = cvt_pk_bf16(v1[0], v1[1]); w.w = cvt_pk_bf16(v1[2], v1[3]); return w; }
__device__ __forceinline__ void unpack_f4x2(u32x4 w, f32x4& v0, f32x4& v1) { v0[0] = bf_lo(w.x); v0[1] = bf_hi(w.x); v0[2] = bf_lo(w.y); v0[3] = bf_hi(w.y); v1[0] = bf_lo(w.z); v1[1] = bf_hi(w.z); v1[2] = bf_lo(w.w); v1[3] = bf_hi(w.w); }
__device__ __forceinline__ unsigned ror8(unsigned x) { return (unsigned)__builtin_amdgcn_update_dpp(0, (int)x, 0x128, 0xF, 0xF, true); }
__device__ __forceinline__ void st_pair(char* grp, size_t pitch, int fr, int fq, u32x4 vA, u32x4 vB) {
    const bool lo = fr < 8;
    u32x4 snd = lo ? vB : vA, rcv; rcv.x = ror8(snd.x); rcv.y = ror8(snd.y); rcv.z = ror8(snd.z); rcv.w = ror8(snd.w);
    char* p = grp + (size_t)(fr & 7) * pitch + (lo ? 0 : 64) + fq * 16;
    *(u32x4*)p = lo ? vA : rcv;
    *(u32x4*)(p + 8 * pitch) = lo ? rcv : vB;
}
__device__ __forceinline__ u32x4 as_u4(f32x4 v) { return __builtin_bit_cast(u32x4, v); }

__device__ __forceinline__ float rstd_raw(ss_t v) { return __builtin_amdgcn_rsqf((float)v * (1.0f / (256.0f * DM)) + NORM_EPS); }
__device__ __forceinline__ float rstd_of(const ss_t* SS, size_t row) { return rstd_raw(SS[row]); }
__device__ __forceinline__ ss_t ss_fix(float s) { return (ss_t)(s * 256.0f + 0.5f); }
__device__ __forceinline__ float sq8(f32x4 a, f32x4 b) { return (a.x * a.x + a.y * a.y) + (a.z * a.z + a.w * a.w) + (b.x * b.x + b.y * b.y) + (b.z * b.z + b.w * b.w); }
__device__ __forceinline__ void ss_add(ss_t* SS, size_t row, float s, int fq, int fr) { s += __uint_as_float((unsigned)__builtin_amdgcn_ds_swizzle((int)__float_as_uint(s), 0x401F));
    s += __uint_as_float((unsigned)__builtin_amdgcn_ds_bpermute((((fq ^ 2) << 4) + fr) << 2, (int)__float_as_uint(s)));
    if (fq == 0) __hip_atomic_fetch_add(SS + row, ss_fix(s), __ATOMIC_RELAXED, __HIP_MEMORY_SCOPE_AGENT); }
struct EpiNull { static constexpr bool PERM = true; EPI_NO_PRE EPI_ZERO_INIT __device__ __forceinline__ void operator()(const f32x4 (&acc)[2][2][4][2], const ss_t (&pre)[2], const Unit& u, int wr, int wc, int fr, int fq) const {
#pragma unroll
    for (int a = 0; a < 2; ++a)
#pragma unroll
        for (int b = 0; b < 2; ++b)
#pragma unroll
            for (int m = 0; m < 4; ++m)
#pragma unroll
                for (int n = 0; n < 2; ++n) asm volatile("" :: "v"(acc[a][b][m][n]));
} };
struct EpiProj { static constexpr bool PERM = true; EPI_ZERO_INIT
    bf16_t* O; const ss_t* SS; EPI_SS_PRE(SS)
    __device__ __forceinline__ void operator()(const f32x4 (&acc)[2][2][4][2], const ss_t (&pre)[2], const Unit& u, int wr, int wc, int fr, int fq) const {
        const bool sg = u.pn >= 18;
        EPI_FOR_AI_M { const size_t r0 = (size_t)(u.pm * BM + ai * HALF + wr * 64 + m * 16); char* grp = (char*)(O + r0 * ICP + u.pn * BM + 64 * wc); const float rs = rstd_raw(pre_get(pre, ai * 4 + m, fr));
            f32x4 a0 = acc[ai][0][m][0] * rs, a1 = acc[ai][0][m][1] * rs, b0 = acc[ai][1][m][0] * rs, b1 = acc[ai][1][m][1] * rs;
            if (sg) { a0 = sigmoid4(a0); a1 = sigmoid4(a1); b0 = sigmoid4(b0); b1 = sigmoid4(b1); }
            st_pair(grp, (size_t)ICP * 2, fr, fq, pack_f4x2(a0, a1), pack_f4x2(b0, b1)); }
    }
};
struct EpiBf16 { static constexpr bool PERM = true; EPI_NO_PRE EPI_ZERO_INIT
    bf16_t* O; int ldc;
    __device__ __forceinline__ void operator()(const f32x4 (&acc)[2][2][4][2], const ss_t (&pre)[2], const Unit& u, int wr, int wc, int fr, int fq) const {
        EPI_FOR_AI_M { char* grp = (char*)(O + (size_t)(u.pm * BM + ai * HALF + wr * 64 + m * 16) * ldc + u.pn * BM + 64 * wc);
            st_pair(grp, (size_t)ldc * 2, fr, fq, pack_f4x2(acc[ai][0][m][0], acc[ai][0][m][1]), pack_f4x2(acc[ai][1][m][0], acc[ai][1][m][1])); }
    }
};
struct EpiLora { static constexpr bool PERM = true; EPI_NO_PRE EPI_ZERO_INIT
    float* DEC; bf16_t* AA; bf16_t* GG; const float* w0; const float* a0;
    __device__ __forceinline__ void operator()(const f32x4 (&acc)[2][2][4][2], const ss_t (&pre)[2], const Unit& u, int wr, int wc, int fr, int fq) const {
        const int row0 = EPI_ROW0, kind = u.pn >> 2, ct = (u.pn & 3) * BM + 64 * wc, col0 = ct + 8 * fq;
        if (kind == 0) {
            EPI_FOR_AI_M { float* rowp = DEC + (size_t)(row0 + ai * HALF + m * 16) * RWD + col0;
#pragma unroll
                for (int bj = 0; bj < 2; ++bj)
#pragma unroll
                    for (int n = 0; n < 2; ++n) { const f32x4 b = *(const f32x4*)(w0 + col0 + bj * 32 + 4 * n); const f32x4 x = acc[ai][bj][m][n] + b; f32x4 o;
#pragma unroll
                        for (int j = 0; j < 4; ++j) { const float z = -x[j]; const float sp = z > 15.f ? z : __logf(1.0f + __expf(z)); const float w = -sp - 0.5f; o[j] = __expf(-__expf(w)); }
                        *(f32x4*)(rowp + bj * 32 + 4 * n) = o; } asm volatile("" ::: "memory"); }
        } else if (kind == 1) {
            const f32x4 b00 = *(const f32x4*)(a0 + col0), b01 = *(const f32x4*)(a0 + col0 + 4), b10 = *(const f32x4*)(a0 + col0 + 32), b11 = *(const f32x4*)(a0 + col0 + 36);
            EPI_FOR_AI_M { char* grp = (char*)(AA + (size_t)(u.pm * BM + ai * HALF + wr * 64 + m * 16) * RWD + ct);
                st_pair(grp, (size_t)RWD * 2, fr, fq, pack_f4x2(sigmoid4(acc[ai][0][m][0] + b00), sigmoid4(acc[ai][0][m][1] + b01)), pack_f4x2(sigmoid4(acc[ai][1][m][0] + b10), sigmoid4(acc[ai][1][m][1] + b11))); }
        } else {
            EPI_FOR_AI_M { char* grp = (char*)(GG + (size_t)(u.pm * BM + ai * HALF + wr * 64 + m * 16) * RWD + ct);
                st_pair(grp, (size_t)RWD * 2, fr, fq, pack_f4x2(acc[ai][0][m][0], acc[ai][0][m][1]), pack_f4x2(acc[ai][1][m][0], acc[ai][1][m][1])); }
        }
    }
};
struct EpiGate1 { static constexpr bool PERM = true; EPI_NO_PRE EPI_ZERO_INIT
    bf16_t* TMP; const bf16_t* PROJ; int gcol0;
    __device__ __forceinline__ void operator()(const f32x4 (&acc)[2][2][4][2], const ss_t (&pre)[2], const Unit& u, int wr, int wc, int fr, int fq) const {
        const int row0 = EPI_ROW0, ct = u.pn * BM + 64 * wc, col0 = ct + 8 * fq;
        EPI_FOR_AI_M { const size_t row = (size_t)(row0 + ai * HALF + m * 16);
            f32x4 g00, g01, g10, g11; unpack_f4x2(*(const u32x4*)(PROJ + row * ICP + gcol0 + col0), g00, g01); unpack_f4x2(*(const u32x4*)(PROJ + row * ICP + gcol0 + col0 + 32), g10, g11);
            st_pair((char*)(TMP + (size_t)(u.pm * BM + ai * HALF + wr * 64 + m * 16) * DM + ct), (size_t)DM * 2, fr, fq, pack_f4x2(acc[ai][0][m][0] * g00, acc[ai][0][m][1] * g01), pack_f4x2(acc[ai][1][m][0] * g10, acc[ai][1][m][1] * g11));
            if (m & 1) asm volatile("" ::: "memory"); }
    }
};
struct EpiGate2 { static constexpr bool PERM = true; EPI_NO_PRE EPI_ZERO_INIT
    const bf16_t* TMP; const bf16_t* PROJ; int gcol0; bf16_t* O;
    __device__ __forceinline__ void operator()(const f32x4 (&acc)[2][2][4][2], const ss_t (&pre)[2], const Unit& u, int wr, int wc, int fr, int fq) const {
        const int row0 = EPI_ROW0, ct = u.pn * BM + 64 * wc, col0 = ct + 8 * fq;
        EPI_FOR_AI_M { const size_t row = (size_t)(row0 + ai * HALF + m * 16);
            f32x4 g00, g01, g10, g11, t00, t01, t10, t11; unpack_f4x2(*(const u32x4*)(PROJ + row * ICP + gcol0 + col0), g00, g01); unpack_f4x2(*(const u32x4*)(PROJ + row * ICP + gcol0 + col0 + 32), g10, g11);
            unpack_f4x2(*(const u32x4*)(TMP + row * DM + col0), t00, t01); unpack_f4x2(*(const u32x4*)(TMP + row * DM + col0 + 32), t10, t11);
            st_pair((char*)(O + (size_t)(u.pm * BM + ai * HALF + wr * 64 + m * 16) * DM + ct), (size_t)DM * 2, fr, fq, pack_f4x2(t00 + acc[ai][0][m][0] * g00, t01 + acc[ai][0][m][1] * g01), pack_f4x2(t10 + acc[ai][1][m][0] * g10, t11 + acc[ai][1][m][1] * g11));
            if (m & 1) asm volatile("" ::: "memory"); }
    }
};
struct EpiResid { static constexpr bool PERM = true; EPI_NO_PRE
    bf16_t* XB; ss_t* SS;
    __device__ __forceinline__ void init(f32x4 (&acc)[2][2][4][2], const Unit& u, int wr, int wc, int fr, int fq) const {
        const int row0 = EPI_ROW0, col0 = u.pn * BM + 64 * wc + 8 * fq;
        EPI_FOR_AI_M { const bf16_t* rowp = XB + (size_t)(row0 + ai * HALF + m * 16) * DM + col0;
            unpack_f4x2(*(const u32x4*)rowp, acc[ai][0][m][0], acc[ai][0][m][1]); unpack_f4x2(*(const u32x4*)(rowp + 32), acc[ai][1][m][0], acc[ai][1][m][1]); }
    }
    __device__ __forceinline__ void operator()(const f32x4 (&acc)[2][2][4][2], const ss_t (&pre)[2], const Unit& u, int wr, int wc, int fr, int fq) const {
        EPI_FOR_AI_M { const size_t r0 = (size_t)(u.pm * BM + ai * HALF + wr * 64 + m * 16);
            st_pair((char*)(XB + r0 * DM + u.pn * BM + 64 * wc), (size_t)DM * 2, fr, fq, pack_f4x2(acc[ai][0][m][0], acc[ai][0][m][1]), pack_f4x2(acc[ai][1][m][0], acc[ai][1][m][1]));
            ss_add(SS, r0 + fr, sq8(acc[ai][0][m][0], acc[ai][0][m][1]) + sq8(acc[ai][1][m][0], acc[ai][1][m][1]), fq, fr); }
    }
};
struct EpiSwiglu { static constexpr bool PERM = true; EPI_ZERO_INIT
    bf16_t* H; const ss_t* SS; EPI_SS_PRE(SS)
    __device__ __forceinline__ void operator()(const f32x4 (&acc)[2][2][4][2], const ss_t (&pre)[2], const Unit& u, int wr, int wc, int fr, int fq) const {
        const int row0 = EPI_ROW0, col0 = u.pn * HALF + wc * 32 + 8 * fq;
        EPI_FOR_AI_M { const size_t row = (size_t)(row0 + ai * HALF + m * 16); const float rs = rstd_raw(pre_get(pre, ai * 4 + m, fr));
            const f32x4 g0 = acc[ai][0][m][0] * rs, g1 = acc[ai][0][m][1] * rs, u0 = acc[ai][1][m][0] * rs, u1 = acc[ai][1][m][1] * rs;
            *(u32x4*)(H + row * FF + col0) = pack_f4x2(g0 * sigmoid4(g0) * u0, g1 * sigmoid4(g1) * u1); }
    }
};
struct EpiPle { static constexpr bool PERM = true; EPI_ZERO_INIT EPI_SS_PRE(SSi)
    const bf16_t* XB; bf16_t* XO; const bf16_t* PP; const ss_t* SSi; ss_t* SSo;
    __device__ __forceinline__ void operator()(const f32x4 (&acc)[2][2][4][2], const ss_t (&pre)[2], const Unit& u, int wr, int wc, int fr, int fq) const {
        const int col0 = u.pn * BM + 64 * wc + 8 * fq;
        EPI_FOR_AI_M { const size_t r0 = (size_t)(u.pm * BM + ai * HALF + wr * 64 + m * 16), row = r0 + fr; const float rs = rstd_raw(pre_get(pre, ai * 4 + m, fr));
            f32x4 x00, x01, x10, x11, p00, p01, p10, p11; unpack_f4x2(*(const u32x4*)(XB + row * DM + col0), x00, x01); unpack_f4x2(*(const u32x4*)(XB + row * DM + col0 + 32), x10, x11);
            unpack_f4x2(*(const u32x4*)(PP + row * DM + col0), p00, p01); unpack_f4x2(*(const u32x4*)(PP + row * DM + col0 + 32), p10, p11);
            x00 += sigmoid4(acc[ai][0][m][0] * rs) * p00; x01 += sigmoid4(acc[ai][0][m][1] * rs) * p01; x10 += sigmoid4(acc[ai][1][m][0] * rs) * p10; x11 += sigmoid4(acc[ai][1][m][1] * rs) * p11;
            st_pair((char*)(XO + r0 * DM + u.pn * BM + 64 * wc), (size_t)DM * 2, fr, fq, pack_f4x2(x00, x01), pack_f4x2(x10, x11));
            ss_add(SSo, row, sq8(x00, x01) + sq8(x10, x11), fq, fr);
            if (m & 1) asm volatile("" ::: "memory"); }
    }
};
#undef EPI_ROW0
#undef EPI_FOR_AI_M
}

constexpr size_t MiB = 1u << 20;
constexpr size_t al1m(size_t x) { return (x + MiB - 1) / MiB * MiB; }
constexpr size_t WS_CTL = 0, CTL_ZERO_BYTES = 1 * MiB;
constexpr size_t SZ_WIN = (size_t)ICP * DM * 2, SZ_POOLW = (size_t)PWD * 256 * 2, SZ_LORA = (size_t)3072 * LK * 2, SZ_PPOOL = (size_t)DM * PWD * 2, SZ_PRWKV = (size_t)DM * RWD * 2,
                 SZ_WOUT = (size_t)DM * DM * 2, SZ_WGU = (size_t)2 * FF * DM * 2, SZ_WDN = (size_t)DM * FF * 2, SZ_WPG = (size_t)DM * DM * 2, SZ_WPP = (size_t)DM * PLE * 2;
constexpr size_t WS_WIN = 1 * MiB, WS_POOLW = WS_WIN + SZ_WIN, WS_LORA = WS_POOLW + SZ_POOLW, WS_PPOOL = WS_LORA + SZ_LORA, WS_PRWKV = WS_PPOOL + SZ_PPOOL, WS_WOUT = WS_PRWKV + SZ_PRWKV,
                 WS_WGU = WS_WOUT + SZ_WOUT, WS_WDN = WS_WGU + SZ_WGU, WS_WPG = WS_WDN + SZ_WDN, WS_WPP = WS_WPG + SZ_WPG, WS_WEND = WS_WPP + SZ_WPP;
constexpr size_t WS_PB = al1m(WS_WEND);
constexpr size_t WS_XN = al1m(WS_PB + (size_t)MT * PLE * 2);
constexpr size_t WS_AA = al1m(WS_XN + (size_t)MT * DM * 2);
constexpr size_t WS_GG = al1m(WS_AA + (size_t)MT * RWD * 2);
constexpr size_t WS_PP = al1m(WS_GG + (size_t)MT * RWD * 2);
constexpr size_t WS_PROJ = al1m(WS_PP + (size_t)MT * DM * 2);
constexpr size_t WS_HID = WS_PROJ;
constexpr size_t WS_D = al1m(WS_PROJ + (size_t)MT * ICP * 2);
constexpr size_t WS_LIN = al1m(WS_D + (size_t)MT * PWD * 2);
constexpr size_t WS_YA = al1m(WS_LIN + (size_t)MT * LK * 2);
constexpr size_t WS_DEC = al1m(WS_YA + (size_t)MT * PWD * 2);
constexpr size_t WS_BS = al1m(WS_DEC + (size_t)MT * RWD * 4);
constexpr size_t WS_Y = al1m(WS_BS + (size_t)MT * 16 * 4);
constexpr size_t SZ_BH = (size_t)MT * RWD * 2;
constexpr size_t WS_YB = al1m(WS_Y + (size_t)MT * RWD * 4);
constexpr size_t WS_TMP = al1m(WS_YB + SZ_BH);
constexpr size_t WS_MRG = al1m(WS_TMP + (size_t)MT * DM * 4);
constexpr size_t WS_SS = al1m(WS_MRG + (size_t)MT * DM * 2);
constexpr size_t WS_END_OLD = al1m(WS_MRG + (size_t)MT * DM * 2);
static_assert((size_t)MT * FF * 2 <= (size_t)MT * ICP * 2, "HID overlay");

constexpr size_t WS_XB2 = al1m(WS_SS + (size_t)3 * MT * 4);
constexpr size_t CBSZ = 12032, CB_P1T = 0, CB_RT = 2048, CB_BK = 4096, CB_VT = 8192, CB_P2T = 10240, CB_MBT = 10752, CB_MKT = 11264, CB_GC = 11776;
constexpr size_t CB_N = (size_t)(MT / 16) * 16;
static_assert(WS_MRG + (size_t)MT * DM * 2 - WS_TMP >= CB_N * CBSZ, "chunk blocks fit in TMP | MRG");
constexpr size_t WS_END = al1m(WS_XB2 + (size_t)MT * DM * 2);
constexpr int CW_BAR = 4096;
constexpr int NWAVES = 8, NTHR = 512;
constexpr int RING_BYTES = 131072, LDSCTL_OFF = RING_BYTES, LDS_BYTES = 147456;

#define XB_TMO      128
#define XB_XCNT(j)  (256  + 64 * (j))
#define XB_XSUB(j)  (1280 + 64 * (j))
#define XB_XGEN(j)  (2304 + 64 * (j))
#define XB_TOP      3328
#define XB_TOPGEN   3392
#define XCD_BAR_WORDS 3456
#define XB_SPIN_CAP (1u << 18)

__device__ __forceinline__ unsigned xb_ld(unsigned* p)              { return __hip_atomic_load(p, __ATOMIC_RELAXED, __HIP_MEMORY_SCOPE_AGENT); }
__device__ __forceinline__ unsigned xb_add(unsigned* p, unsigned v) { return __hip_atomic_fetch_add(p, v, __ATOMIC_RELAXED, __HIP_MEMORY_SCOPE_AGENT); }
__device__ __forceinline__ unsigned xb_xcc_id() { return (unsigned)__builtin_amdgcn_s_getreg((3 << 11) | 20) & 0xFu; }
#define XB_SPIN(cond, bar) do { unsigned _sp = 0; while (cond) { __builtin_amdgcn_s_sleep(1); \
    if ((++_sp & 255u) == 0u) { if (xb_ld(&(bar)[XB_TMO])) break; if (_sp > XB_SPIN_CAP) { atomicAdd(&(bar)[XB_TMO], 1u); break; } } } } while (0)

struct XcdBarrier {
    unsigned* bar; unsigned x;
    volatile LAS unsigned* st;
};

__device__ __forceinline__ XcdBarrier xcd_barrier_post(unsigned* bar, volatile LAS unsigned* st) {
    XcdBarrier b; b.bar = bar; b.x = xb_xcc_id(); b.st = st;
    if (threadIdx.x == 0) (void)xb_add(&bar[XB_XCNT(b.x)], 1u);
    return b;
}
__device__ __forceinline__ void xcd_barrier_complete(unsigned* bar, unsigned x, unsigned& nloc, unsigned& nx) {
    const unsigned G = gridDim.x * gridDim.y * gridDim.z;
    unsigned sum, cnt, mine, sp = 0u;
    for (;;) {
        sum = 0u; cnt = 0u; mine = 0u;
#pragma unroll
        for (unsigned j = 0; j < 16; ++j) { const unsigned c = xb_ld(&bar[XB_XCNT(j)]); sum += c; cnt += (c > 0u) ? 1u : 0u; mine = (j == x) ? c : mine; }
        if (sum == G) break;
        __builtin_amdgcn_s_sleep(1);
        if ((++sp & 255u) == 0u) { if (xb_ld(&bar[XB_TMO])) break; if (sp > XB_SPIN_CAP) { atomicAdd(&bar[XB_TMO], 1u); break; } }
    }
    nloc = mine > 0u ? mine : 1u; nx = cnt > 0u ? cnt : 1u;
}

__device__ __forceinline__ void xcd_barrier(const XcdBarrier& b) {
    asm volatile("s_waitcnt vmcnt(0)" ::: "memory");
    __syncthreads();
    if (threadIdx.x == 0) {
        unsigned* bar = b.bar;
        __builtin_amdgcn_s_waitcnt(0);
        unsigned nloc = b.st[0], nx = b.st[1];
        if (nloc == 0u) { xcd_barrier_complete(bar, b.x, nloc, nx); b.st[0] = nloc; b.st[1] = nx; }
        const unsigned old = xb_add(&bar[XB_XSUB(b.x)], 1u);
        const unsigned gen = old / nloc;
        if (old + 1u == (gen + 1u) * nloc) {
            __builtin_amdgcn_fence(__ATOMIC_RELEASE, "agent");
            asm volatile("s_waitcnt vmcnt(0)" ::: "memory");
            const unsigned og = xb_add(&bar[XB_TOP], 1u);
            const unsigned tg = og / nx;
            if (og + 1u == (tg + 1u) * nx) xb_add(&bar[XB_TOPGEN], 1u);
            else XB_SPIN(xb_ld(&bar[XB_TOPGEN]) == tg, bar);
            __builtin_amdgcn_fence(__ATOMIC_ACQUIRE, "agent");
            xb_add(&bar[XB_XGEN(b.x)], 1u);
            asm volatile("s_waitcnt vmcnt(0)" ::: "memory");
        } else {
            XB_SPIN(xb_ld(&bar[XB_XGEN(b.x)]) == gen, bar);
            __builtin_amdgcn_fence(__ATOMIC_ACQUIRE, "agent");
            asm volatile("s_waitcnt vmcnt(0)" ::: "memory");
        }
    }
    __syncthreads();
}


struct Args {
    const float* in[33]; float* out; unsigned char* ws; int ph_lo, ph_hi;
};
struct Frame {
    LAS unsigned char* lds; int G;
    const LAS unsigned long long* ptab; float* out; unsigned char* ws;
};
#define GAS __attribute__((address_space(1)))
__device__ __forceinline__ const float* ldptr(const LAS unsigned long long* tab, int k) { const unsigned long long v = tab[k]; const unsigned lo = __builtin_amdgcn_readfirstlane((unsigned)v), hi = __builtin_amdgcn_readfirstlane((unsigned)(v >> 32));
    return (const float*)(const GAS float*)(((unsigned long long)hi << 32) | lo); }
__device__ __forceinline__ unsigned char* fresh(unsigned char* p) { GAS unsigned char* q = (GAS unsigned char*)p; asm volatile("" : "+s"(q)); return (unsigned char*)q; }
__device__ __forceinline__ int fresh_i(int v) { asm volatile("" : "+s"(v)); return v; }
#define INP(k) ldptr(F.ptab, (k))
#define PHASE_L const int l = fresh_i(l_in); (void)l;
#define PHASE_IDS int tid_ = threadIdx.x; asm volatile("" : "+v"(tid_)); const int tid = tid_, lane = tid & 63, wave = __builtin_amdgcn_readfirstlane(tid >> 6), gtid = blockIdx.x * NTHR + tid, gw = blockIdx.x * NWAVES + wave; (void)lane; (void)wave; (void)gtid; (void)gw;
#define VM_WAIT() asm volatile("s_waitcnt vmcnt(0)" ::: "memory")
#define LDS_WAIT() asm volatile("s_waitcnt lgkmcnt(0)" ::: "memory")
constexpr int NT_ALL_SHIFT = 9;

__device__ __forceinline__ void row_info(int m, int& b, int& t, bool& samp) { samp = m >= MPR; if (samp) { b = (m - MPR) >> 6; t = (m - MPR) & 63; } else { b = m >> 11; t = m & 2047; } }

__device__ __forceinline__ void transpose_item(const float* W, int N, bf16_t* WT, int ldk, int k0, int n0, int drow0, LAS float* scr, int lane, const float* cscale = nullptr, const float* rscale = nullptr) {
    f32x4 cs = (f32x4){1.f, 1.f, 1.f, 1.f}; if (cscale) cs = *(const f32x4*)(cscale + n0 + 4 * (lane & 7));
    const int c = lane & 7;
    f32x4 g0 = (f32x4){1.f, 1.f, 1.f, 1.f}, g1 = g0;
    if (rscale) { g0 = *(const f32x4*)(rscale + k0 + 8 * c); g1 = *(const f32x4*)(rscale + k0 + 8 * c + 4); }
    f32x4 v[8];
#pragma unroll
    for (int i = 0; i < 8; ++i) v[i] = *(const f32x4*)(W + (size_t)(k0 + 8 * i + (lane >> 3)) * N + n0 + 4 * (lane & 7));
#pragma unroll
    for (int i = 0; i < 8; ++i) { LAS float* d = scr + (8 * i + (lane >> 3)) * 33 + 4 * (lane & 7); const f32x4 t = v[i] * cs; d[0] = t.x; d[1] = t.y; d[2] = t.z; d[3] = t.w; }
    LDS_WAIT(); asm volatile("" ::: "memory");
#pragma unroll
    for (int j = 0; j < 4; ++j) { const int n = (lane >> 3) + 8 * j; const LAS float* sp = scr + (8 * c) * 33 + n;
        u32x4 o; o.x = cvt_pk_bf16(sp[0 * 33] * g0.x, sp[1 * 33] * g0.y); o.y = cvt_pk_bf16(sp[2 * 33] * g0.z, sp[3 * 33] * g0.w); o.z = cvt_pk_bf16(sp[4 * 33] * g1.x, sp[5 * 33] * g1.y); o.w = cvt_pk_bf16(sp[6 * 33] * g1.z, sp[7 * 33] * g1.w);
        *(u32x4*)(WT + (size_t)(drow0 + n) * ldk + k0 + 8 * c) = o; }
    LDS_WAIT(); asm volatile("" ::: "memory");
}
__device__ __forceinline__ void convert_weights(Frame& F, int l_in) {
    PHASE_IDS
    unsigned char* const wsl = fresh(F.ws);
    PHASE_L
    LAS float* scr = (LAS float*)(F.lds + wave * 16384);
    const int NGW = fresh_i(F.G) * NWAVES;
    unsigned char* ws = wsl;
    constexpr int I_WIN = (DM / 64) * (ICOLS / 32), I_PW = 4 * (256 / 64) * (256 / 32), I_PP = (PWD / 64) * (DM / 32), I_WO = (DM / 64) * (DM / 32), I_FG = (DM / 64) * (FF / 32),
                  I_FD = (FF / 64) * (DM / 32), I_PL = (PLE / 64) * (DM / 32);
    constexpr int NITEMS = I_WIN + I_PW + 2 * I_PP + I_WO + 2 * I_FG + I_FD + I_WO + I_PL;
    for (int it = gw; it < NITEMS; it += NGW) {
        int r = it;
        if (r < I_WIN) { const int nblk = ICOLS / 32, kb = r / nblk, nb = r % nblk, n0 = nb * 32; transpose_item(INP(8) + (size_t)l * DM * ICOLS, ICOLS, (bf16_t*)(ws + WS_WIN), DM, kb * 64, n0, n0 < 4384 ? n0 : n0 + 224, scr, lane, nullptr, INP(7) + (size_t)l * DM); continue; } r -= I_WIN;
        if (r < I_PW) { const int g = r >> 5, rr = r & 31, kb = rr >> 3, nb = rr & 7; transpose_item(INP(10) + ((size_t)l * 4 + g) * 65536, 256, (bf16_t*)(ws + WS_POOLW) + (size_t)g * 65536, 256, kb * 64, nb * 32, nb * 32, scr, lane, INP(11) + (size_t)l * PWD + g * 256); continue; } r -= I_PW;
        if (r < I_PP) { const int nblk = DM / 32, kb = r / nblk, nb = r % nblk; transpose_item(INP(22) + (size_t)l * PWD * DM, DM, (bf16_t*)(ws + WS_PPOOL), PWD, kb * 64, nb * 32, nb * 32, scr, lane); continue; } r -= I_PP;
        if (r < I_PP) { const int nblk = DM / 32, kb = r / nblk, nb = r % nblk; transpose_item(INP(23) + (size_t)l * RWD * DM, DM, (bf16_t*)(ws + WS_PRWKV), RWD, kb * 64, nb * 32, nb * 32, scr, lane); continue; } r -= I_PP;
        if (r < I_WO) { const int nblk = DM / 32, kb = r / nblk, nb = r % nblk; transpose_item(INP(24) + (size_t)l * DM * DM, DM, (bf16_t*)(ws + WS_WOUT), DM, kb * 64, nb * 32, nb * 32, scr, lane); continue; } r -= I_WO;
        if (r < I_FG) { const int nblk = FF / 32, kb = r / nblk, nb = r % nblk, n0 = nb * 32; transpose_item(INP(26) + (size_t)l * DM * FF, FF, (bf16_t*)(ws + WS_WGU), DM, kb * 64, n0, 256 * (n0 >> 7) + 64 * ((n0 & 127) >> 5), scr, lane, nullptr, INP(25) + (size_t)l * DM); continue; } r -= I_FG;
        if (r < I_FG) { const int nblk = FF / 32, kb = r / nblk, nb = r % nblk, n0 = nb * 32; transpose_item(INP(27) + (size_t)l * DM * FF, FF, (bf16_t*)(ws + WS_WGU), DM, kb * 64, n0, 256 * (n0 >> 7) + 64 * ((n0 & 127) >> 5) + 32, scr, lane, nullptr, INP(25) + (size_t)l * DM); continue; } r -= I_FG;
        if (r < I_FD) { const int nblk = DM / 32, kb = r / nblk, nb = r % nblk; transpose_item(INP(28) + (size_t)l * FF * DM, DM, (bf16_t*)(ws + WS_WDN), FF, kb * 64, nb * 32, nb * 32, scr, lane); continue; } r -= I_FD;
        if (r < I_WO) { const int nblk = DM / 32, kb = r / nblk, nb = r % nblk; transpose_item(INP(30) + (size_t)l * DM * DM, DM, (bf16_t*)(ws + WS_WPG), DM, kb * 64, nb * 32, nb * 32, scr, lane, nullptr, INP(29) + (size_t)l * DM); continue; } r -= I_WO;
        { const int nblk = DM / 32, kb = r / nblk, nb = r % nblk; transpose_item(INP(31) + (size_t)l * PLE * DM, DM, (bf16_t*)(ws + WS_WPP), PLE, kb * 64, nb * 32, nb * 32, scr, lane); }
    }
    const int NT = fresh_i(F.G) * NTHR;
    { u32x4* z = (u32x4*)((bf16_t*)(ws + WS_WIN) + (size_t)4384 * DM); for (int i = gtid; i < 224 * DM * 2 / 16; i += NT) z[i] = (u32x4){0u, 0u, 0u, 0u}; }
    { bf16_t* LT = (bf16_t*)(ws + WS_LORA); const float* wd = INP(13) + (size_t)l * 64 * RWD; const float* wa = INP(15) + (size_t)l * 64 * RWD; const float* wg = INP(16) + (size_t)l * 160 * RWD;
      for (int i = gtid; i < 3072 * (LK / 8); i += NT) { const int n = i / (LK / 8), k0 = (i % (LK / 8)) * 8; const int kind = n >> 10, c = n & 1023; float f[8];
#pragma unroll
          for (int j = 0; j < 8; ++j) { const int k = k0 + j; float v = 0.f;
              if (kind == 0) { if (k < 64) v = wd[(size_t)k * RWD + c]; }
              else if (kind == 1) { if (k >= 64 && k < 128) v = wa[(size_t)(k - 64) * RWD + c]; }
              else { if (k >= 128 && k < 288) v = wg[(size_t)(k - 128) * RWD + c]; }
              f[j] = v; }
          *(u32x4*)(LT + (size_t)n * LK + k0) = pack8(f); } }
    { bf16_t* PB = (bf16_t*)(ws + WS_PB); const float* pp = INP(5) + (size_t)l * MPR * PLE; const float* ps = INP(6) + (size_t)l * (MT - MPR) * PLE;
      for (int i = gtid; i < MT * PLE / 8; i += NT) { const size_t e = (size_t)i * 8; const float* src = e < (size_t)MPR * PLE ? pp + e : ps + (e - (size_t)MPR * PLE);
          const f32x4 a = *(const f32x4*)src, b = *(const f32x4*)(src + 4); *(u32x4*)(PB + e) = pg8::pack_f4x2(a, b); } }
}

__device__ __forceinline__ void xb_from_input(Frame& F) {
    PHASE_IDS
    unsigned char* const wsl = fresh(F.ws);
    const int NGW = fresh_i(F.G) * NWAVES; bf16_t* XB = (bf16_t*)(wsl + WS_XN); pg8::ss_t* SS = (pg8::ss_t*)(wsl + WS_SS);
    for (int m = gw; m < MT; m += NGW) {
        const float* src = m < MPR ? INP(0) + (size_t)m * DM : INP(1) + (size_t)(m - MPR) * DM;
        f32x4 v[8]; float s = 0.f;
#pragma unroll
        for (int j = 0; j < 8; ++j) { v[j] = *(const f32x4*)(src + 4 * lane + 256 * j); s += (v[j].x * v[j].x + v[j].y * v[j].y) + (v[j].z * v[j].z + v[j].w * v[j].w); }
        s = wave_sum(s);
        if (lane == 0) SS[m] = pg8::ss_fix(s);
#pragma unroll
        for (int j = 0; j < 8; ++j) { u32x2 w; w.x = cvt_pk_bf16(v[j].x, v[j].y); w.y = cvt_pk_bf16(v[j].z, v[j].w); *(u32x2*)(XB + (size_t)m * DM + 4 * lane + 256 * j) = w; }
    }
}
__device__ __forceinline__ void final_norm(Frame& F, const float* gain) {
    PHASE_IDS
    unsigned char* const wsl = fresh(F.ws);
    const int NGW = fresh_i(F.G) * NWAVES; const bf16_t* XB = (const bf16_t*)(wsl + ((NL & 1) ? WS_XB2 : WS_XN));
    f32x4 g[8];
#pragma unroll
    for (int j = 0; j < 8; ++j) g[j] = *(const f32x4*)(gain + 4 * lane + 256 * j);
    for (int m = gw; m < MT; m += NGW) {
        f32x4 v[8]; float s = 0.f;
#pragma unroll
        for (int j = 0; j < 8; ++j) { const u32x2 w = *(const u32x2*)(XB + (size_t)m * DM + 4 * lane + 256 * j); v[j] = (f32x4){bf_lo(w.x), bf_hi(w.x), bf_lo(w.y), bf_hi(w.y)};
            s += (v[j].x * v[j].x + v[j].y * v[j].y) + (v[j].z * v[j].z + v[j].w * v[j].w); }
        const float rstd = __builtin_amdgcn_rsqf(wave_sum(s) * (1.0f / DM) + NORM_EPS);
#pragma unroll
        for (int j = 0; j < 8; ++j) *(f32x4*)(F.out + (size_t)m * DM + 4 * lane + 256 * j) = v[j] * rstd * g[j];
    }
}

__device__ __forceinline__ void load_z(float (&z)[8], const bf16_t* PROJ, const float* past, int m0, int t, bool samp, int c0) {
    if (t >= 0) { unpack8(*(const u32x4*)(PROJ + (size_t)(m0 + t) * ICP + c0), z); }
    else if (samp) { const float* p = past + (size_t)(15 + t) * PWD + c0; const f32x4 a = *(const f32x4*)p, b = *(const f32x4*)(p + 4); z[0] = a.x; z[1] = a.y; z[2] = a.z; z[3] = a.w; z[4] = b.x; z[5] = b.y; z[6] = b.z; z[7] = b.w; }
    else {
#pragma unroll
        for (int j = 0; j < 8; ++j) z[j] = 0.f; }
}
__device__ __forceinline__ void prep1_phase(Frame& F, int l_in) {
    PHASE_IDS
    unsigned char* const wsl = fresh(F.ws);
    PHASE_L
    const int NT = fresh_i(F.G) * NTHR; const bf16_t* PROJ = (const bf16_t*)(wsl + WS_PROJ);
    { bf16_t* D = (bf16_t*)(wsl + WS_D);
      for (int it = gtid; it < (MT / 16) * 128; it += NT) {
          const int oct = it & 127, run = it >> 7, mrow = run * 16, c0 = oct * 8, win = 2 << (c0 >> 8);
          int b, t0; bool samp; row_info(mrow, b, t0, samp);
          const int T = samp ? TS : TP, mseq = mrow - t0;
          const float* past = INP(3) + ((size_t)l * 8 + b) * 15 * PWD;
          float* npool = F.out + (samp ? O_POS : O_POP) + ((size_t)l * 8 + b) * 15 * PWD;
          float S[8], z[8];
#pragma unroll
          for (int j = 0; j < 8; ++j) S[j] = 0.f;
          for (int j = 1; j < win; ++j) { load_z(z, PROJ, past, mseq, t0 - j, samp, c0);
#pragma unroll
              for (int q = 0; q < 8; ++q) S[q] += z[q]; }
          for (int i = 0; i < 16; ++i) { const int t = t0 + i; float cur[8]; load_z(cur, PROJ, past, mseq, t, samp, c0);
              const int cnt = samp ? win : (t + 1 < win ? t + 1 : win); const float inv = 1.0f / (float)cnt; float d[8];
#pragma unroll
              for (int q = 0; q < 8; ++q) { S[q] += cur[q]; d[q] = S[q] * inv - cur[q]; }
              *(u32x4*)(D + (size_t)(mseq + t) * PWD + c0) = pack8(d);
              if (t >= T - 15) { float* o = npool + (size_t)(t - (T - 15)) * PWD + c0; *(f32x4*)o = (f32x4){cur[0], cur[1], cur[2], cur[3]}; *(f32x4*)(o + 4) = (f32x4){cur[4], cur[5], cur[6], cur[7]}; }
              load_z(z, PROJ, past, mseq, t - win + 1, samp, c0);
#pragma unroll
              for (int q = 0; q < 8; ++q) S[q] -= z[q]; }
      } }
    { bf16_t* LIN = (bf16_t*)(wsl + WS_LIN); const float* mu = INP(9) + (size_t)l * RPJ + 3072;
      for (int it = gtid; it < MT * (LK / 8); it += NT) {
          const int m = it / (LK / 8), c0 = (it % (LK / 8)) * 8; float o[8];
          if (c0 >= 288) {
#pragma unroll
              for (int j = 0; j < 8; ++j) o[j] = 0.f;
          } else {
              int b, t; bool samp; row_info(m, b, t, samp);
              float cur[8], prv[8]; unpack8(*(const u32x4*)(PROJ + (size_t)m * ICP + 4096 + c0), cur);
              if (t > 0) unpack8(*(const u32x4*)(PROJ + (size_t)(m - 1) * ICP + 4096 + c0), prv);
              else if (samp) { const float* p = INP(2) + ((size_t)l * 8 + b) * RPJ + 3072 + c0;
#pragma unroll
                  for (int j = 0; j < 8; ++j) prv[j] = p[j]; }
              else {
#pragma unroll
                  for (int j = 0; j < 8; ++j) prv[j] = 0.f; }
#pragma unroll
              for (int j = 0; j < 8; ++j) { const float xm = cur[j] + (prv[j] - cur[j]) * mu[c0 + j]; o[j] = c0 < 64 ? tanhf_(xm) : (c0 < 128 ? xm : sigmoidf_(xm)); }
          }
          *(u32x4*)(LIN + (size_t)m * LK + c0) = pack8(o);
      } }
    { pg8::ss_t* SS = (pg8::ss_t*)(wsl + WS_SS); for (int i = gtid; i < 3 * MT; i += NT) SS[i] = 0u; }
    for (int it = gtid; it < 16 * RPJ; it += NT) { const int s = it / RPJ, c = it % RPJ; const int mlast = s < 8 ? s * TP + TP - 1 : MPR + (s - 8) * TS + TS - 1;
        F.out[(s < 8 ? O_SHP : O_SHS) + ((size_t)l * 8 + (s & 7)) * RPJ + c] = __uint_as_float((unsigned)PROJ[(size_t)mlast * ICP + 1024 + c] << 16); }
}

__device__ __forceinline__ unsigned char* cb_ptr(unsigned char* ws, size_t i) { return ws + WS_TMP + i * CBSZ; }
__device__ __forceinline__ f32x4 mfma16(bf16x8 a, bf16x8 b, f32x4 c) { return __builtin_amdgcn_mfma_f32_16x16x32_bf16(a, b, c, 0, 0, 0); }
__device__ __forceinline__ bf16x8 mk8(u32x2 lo, u32x2 hi) { u32x4 w = (u32x4){lo.x, lo.y, hi.x, hi.y}; return __builtin_bit_cast(bf16x8, w); }
typedef __bf16 bf16x2_c __attribute__((ext_vector_type(2)));
__device__ __forceinline__ unsigned cvt_pk_c(float lo, float hi) { const f32x2 v = (f32x2){lo, hi}; const bf16x2_c b = __builtin_convertvector(v, bf16x2_c); return __builtin_bit_cast(unsigned, b); }
__device__ __forceinline__ u32x2 pk4(f32x4 v) { return (u32x2){cvt_pk_c(v.x, v.y), cvt_pk_c(v.z, v.w)}; }
__device__ __forceinline__ unsigned short bf1(float f) { return (unsigned short)(cvt_pk_c(f, 0.f) & 0xffffu); }

__device__ __forceinline__ void spre_phase(Frame& F, int l_in) {
    PHASE_IDS
    unsigned char* const wsl = fresh(F.ws);
    PHASE_L
    const int NGW = fresh_i(F.G) * NWAVES;
    LAS unsigned char* L = F.lds + wave * 16384;
    const bf16_t* PROJ = (const bf16_t*)(wsl + WS_PROJ); const bf16_t* AA = (const bf16_t*)(wsl + WS_AA); const float* DEC = (const float*)(wsl + WS_DEC); float* BS = (float*)(wsl + WS_BS);
    const int fr = lane & 15, fq = lane >> 4;
    const float* mu = INP(9) + (size_t)l * RPJ;
#define SP_LOAD(it_, R, K, V, A, W, PR, PK, PV) do { const int h_ = (it_) & 15, m0_ = ((it_) >> 4) * 16, ch_ = h_ * 64 + lane; int b_, t0_; bool samp_; row_info(m0_, b_, t0_, samp_); \
        _Pragma("unroll") for (int t = 0; t < 16; ++t) { const size_t mm = (size_t)(m0_ + t); const bf16_t* pc = PROJ + mm * ICP + 1024 + ch_; R[t] = pc[0]; K[t] = pc[1024]; V[t] = pc[2048]; A[t] = AA[mm * RWD + ch_]; W[t] = DEC[mm * RWD + ch_]; } \
        if (t0_ > 0) { const bf16_t* pc = PROJ + (size_t)(m0_ - 1) * ICP + 1024 + ch_; PR = __uint_as_float((unsigned)pc[0] << 16); PK = __uint_as_float((unsigned)pc[1024] << 16); PV = __uint_as_float((unsigned)pc[2048] << 16); } \
        else if (samp_) { const float* sp = INP(2) + ((size_t)l * 8 + b_) * RPJ + ch_; PR = sp[0]; PK = sp[1024]; PV = sp[2048]; } \
        else { PR = 0.f; PK = 0.f; PV = 0.f; } } while (0)
    unsigned short cr[16], ck[16], cv[16], ca[16], nr[16], nk[16], nv[16], na[16]; float cw[16], nw[16]; float pr = 0.f, pk = 0.f, pv = 0.f, npr = 0.f, npk = 0.f, npv = 0.f;
    if (gw < (int)CB_N) SP_LOAD(gw, cr, ck, cv, ca, cw, pr, pk, pv);
    for (int it = gw; it < (int)CB_N; it += NGW) {
        const int h = it & 15, crow = it >> 4, m0 = crow * 16, ch = h * 64 + lane;
        unsigned char* cb = cb_ptr(wsl, (size_t)it);
        const float mur = mu[ch], muk = mu[1024 + ch], muv = mu[2048 + ch];
        const float ckk = (INP(17) + (size_t)l * RWD)[ch], cka = (INP(18) + (size_t)l * RWD)[ch], crk = (INP(19) + (size_t)l * RWD)[ch];
        { const int itn = it + NGW; if (itn < (int)CB_N) SP_LOAD(itn, nr, nk, nv, na, nw, npr, npk, npv); }
        float g = 1.0f; unsigned at2[8], bt2[8], kt2[8], vt2[8]; float hold_a = 0.f, hold_b = 0.f, hold_k = 0.f, hold_v = 0.f;
#pragma unroll
        for (int t = 0; t < 16; ++t) {
            const float xr = __uint_as_float((unsigned)cr[t] << 16), xk = __uint_as_float((unsigned)ck[t] << 16), xv = __uint_as_float((unsigned)cv[t] << 16), av = __uint_as_float((unsigned)ca[t] << 16);
            const float r = xr + (pr - xr) * mur, kx = xk + (pk - xk) * muk, vv = xv + (pv - xv) * muv; pr = xr; pk = xk; pv = xv;
            float kkv = kx * ckk; const float ss = wave_sum(kkv * kkv); kkv *= __builtin_amdgcn_rsqf(fmaxf(ss, 1e-24f));
            const float kh = kx * (1.0f + (av - 1.0f) * cka), bb = kkv * av; const float bsum = wave_sum(r * kh * crk);
            if (lane == 0) BS[(size_t)(m0 + t) * 16 + h] = bsum;
            const float a_t = -kkv * g; g *= cw[t]; const float ig = __builtin_amdgcn_rcpf(g); const float b_t = bb * ig, k_t = kh * ig, r_t = r * g;
            *(LAS unsigned short*)(L + t * 144 + lane * 2) = bf1(a_t); *(LAS unsigned short*)(L + 2304 + t * 144 + lane * 2) = bf1(b_t);
            *(LAS unsigned short*)(L + 4608 + t * 144 + lane * 2) = bf1(k_t); *(LAS unsigned short*)(L + 6912 + t * 144 + lane * 2) = bf1(r_t);
            if (t & 1) { at2[t >> 1] = cvt_pk_c(hold_a, a_t); bt2[t >> 1] = cvt_pk_c(hold_b, b_t); kt2[t >> 1] = cvt_pk_c(hold_k, k_t); vt2[t >> 1] = cvt_pk_c(hold_v, vv); }
            else { hold_a = a_t; hold_b = b_t; hold_k = k_t; hold_v = vv; }
        }
        *(LAS u32x4*)(L + 9216 + lane * 32) = (u32x4){at2[0], at2[1], at2[2], at2[3]}; *(LAS u32x4*)(L + 9216 + lane * 32 + 16) = (u32x4){at2[4], at2[5], at2[6], at2[7]};
        { u32x4* o = (u32x4*)(cb + CB_BK + lane * 64);
#pragma unroll
          for (int q = 0; q < 4; ++q) o[q] = (u32x4){bt2[2 * q], bt2[2 * q + 1], kt2[2 * q], kt2[2 * q + 1]}; }
        { u32x4* o = (u32x4*)(cb + CB_VT + lane * 32); o[0] = (u32x4){vt2[0], vt2[1], vt2[2], vt2[3]}; o[1] = (u32x4){vt2[4], vt2[5], vt2[6], vt2[7]}; }
        *(float*)(cb + CB_GC + lane * 4) = g;
        asm volatile("" ::: "memory");
#define SP_ROWS(off, j) (*(const LAS bf16x8*)(L + (off) + fr * 144 + (j) * 64 + fq * 16))
        f32x4 nD = (f32x4){0.f, 0.f, 0.f, 0.f}, makD = nD, mrbD = nD, mrkD = nD;
#pragma unroll
        for (int j = 0; j < 2; ++j) { const bf16x8 fa = SP_ROWS(0, j), fb = SP_ROWS(2304, j), fk = SP_ROWS(4608, j), fR = SP_ROWS(6912, j);
            nD = mfma16(fb, fa, nD); makD = mfma16(fk, fa, makD); mrbD = mfma16(fb, fR, mrbD); mrkD = mfma16(fk, fR, mrkD); }
#pragma unroll
        for (int rr = 0; rr < 4; ++rr) { const int s = 4 * fq + rr; if (s >= fr) { nD[rr] = 0.f; makD[rr] = 0.f; } if (s > fr) { mrbD[rr] = 0.f; mrkD[rr] = 0.f; } }
        { const u32x2 mb = pk4(mrbD), mk = pk4(mrkD); *(u32x4*)(cb + CB_MBT + (fr * 4 + fq) * 16) = (u32x4){mb.x, mb.y, mk.x, mk.y}; }
#define SP_WR_RM(off, D) do { _Pragma("unroll") for (int rr = 0; rr < 4; ++rr) *(LAS unsigned short*)(L + (off) + (4 * fq + rr) * 32 + fr * 2) = bf1((D)[rr]); } while (0)
#define SP_WR_TR(off, D) do { *(LAS u32x2*)(L + (off) + fr * 32 + fq * 8) = pk4(D); } while (0)
#define SP_FRAG16(off) (fq < 2 ? *(const LAS bf16x8*)(L + (off) + fr * 32 + fq * 16) : (bf16x8){0, 0, 0, 0, 0, 0, 0, 0})
        SP_WR_RM(13568, nD); SP_WR_TR(14080, nD); SP_WR_RM(15616, makD); asm volatile("" ::: "memory");
        f32x4 TD = nD;
#pragma unroll
        for (int rr = 0; rr < 4; ++rr) if (4 * fq + rr == fr) TD[rr] += 1.0f;
#pragma unroll
        for (int itp = 0; itp < 3; ++itp) {
            SP_WR_RM(14592, TD); asm volatile("" ::: "memory");
            const f32x4 p2 = mfma16(SP_FRAG16(13568), SP_FRAG16(14080), (f32x4){0.f, 0.f, 0.f, 0.f}); asm volatile("" ::: "memory");
            SP_WR_RM(13568, p2); SP_WR_TR(14080, p2); asm volatile("" ::: "memory");
            TD = mfma16(SP_FRAG16(14592), SP_FRAG16(14080), TD); asm volatile("" ::: "memory");
        }
        SP_WR_TR(15104, TD); asm volatile("" ::: "memory");
        { const bf16x8 ftt = SP_FRAG16(15104);
#pragma unroll
          for (int blk = 0; blk < 4; ++blk) { const bf16x8 fb = fq < 2 ? *(const LAS bf16x8*)(L + 9216 + (16 * blk + fr) * 32 + fq * 16) : (bf16x8){0, 0, 0, 0, 0, 0, 0, 0};
              const f32x4 d = mfma16(ftt, fb, (f32x4){0.f, 0.f, 0.f, 0.f});
#pragma unroll
              for (int rr = 0; rr < 4; ++rr) *(LAS unsigned short*)(L + 11264 + (4 * fq + rr) * 144 + (16 * blk + fr) * 2) = bf1(d[rr]); }
          const f32x4 p2 = mfma16(SP_FRAG16(15616), ftt, (f32x4){0.f, 0.f, 0.f, 0.f});
          *(u32x2*)(cb + CB_P2T + fr * 32 + fq * 8) = pk4(p2); }
        asm volatile("" ::: "memory");
#pragma unroll
        for (int q = 0; q < 2; ++q) { const int pc = lane + 64 * q, pcc = pc >> 6, pt = (pc >> 2) & 15, pf = pc & 3;
            const u32x2 a0 = *(const LAS u32x2*)(L + 11264 + pt * 144 + (32 * pcc + 4 * pf) * 2), a1 = *(const LAS u32x2*)(L + 11264 + pt * 144 + (32 * pcc + 16 + 4 * pf) * 2);
            const u32x2 r0 = *(const LAS u32x2*)(L + 6912 + pt * 144 + (32 * pcc + 4 * pf) * 2), r1 = *(const LAS u32x2*)(L + 6912 + pt * 144 + (32 * pcc + 16 + 4 * pf) * 2);
            *(u32x4*)(cb + CB_P1T + pc * 16) = (u32x4){a0.x, a0.y, a1.x, a1.y}; *(u32x4*)(cb + CB_RT + pc * 16) = (u32x4){r0.x, r0.y, r1.x, r1.y}; }
        asm volatile("" ::: "memory");
#pragma unroll
        for (int t = 0; t < 16; ++t) { cr[t] = nr[t]; ck[t] = nk[t]; cv[t] = nv[t]; ca[t] = na[t]; cw[t] = nw[t]; }
        pr = npr; pk = npk; pv = npv;
#undef SP_ROWS
#undef SP_LOAD
#undef SP_WR_RM
#undef SP_WR_TR
#undef SP_FRAG16
    }
}

__device__ __forceinline__ void sseq_phase(Frame& F, int l_in) {
    PHASE_IDS
    unsigned char* const wsl = fresh(F.ws);
    PHASE_L
    float* Y = (float*)(wsl + WS_Y);
    const bool is_cons = wave < 4;
    const int fr = lane & 15, fq = lane >> 4, vrow = (wave & 3) * 16 + fr, ptid = tid & 255;
    for (int u = blockIdx.x; u < 256; u += fresh_i(F.G)) {
        const bool samp = u >= 128; const int h = u & 15, b = (u >> 4) & 7;
        const int T = samp ? TS : TP, m0 = samp ? MPR + b * TS : b * TP, nch = T / 16, crow0 = m0 / 16;
        f32x4 sreg[4];
        if (samp) { const float* sp = INP(4) + ((((size_t)l * 8 + b) * 16 + h) * 64 + vrow) * 64 + 4 * fq;
#pragma unroll
            for (int kb = 0; kb < 4; ++kb) sreg[kb] = *(const f32x4*)(sp + 16 * kb); }
        else {
#pragma unroll
            for (int kb = 0; kb < 4; ++kb) sreg[kb] = (f32x4){0.f, 0.f, 0.f, 0.f}; }
#define SQ_ISSUE(c) do { const unsigned char* src = cb_ptr(wsl, (size_t)(crow0 + (c)) * 16 + h) + ((wave & 3) * 3) * 1024 + lane * 16; LAS unsigned char* dst = F.lds + ((c) % (SQ_D + 1)) * 12288 + ((wave & 3) * 3) * 1024; \
        _Pragma("unroll") for (int i = 0; i < 3; ++i) __builtin_amdgcn_global_load_lds((const unsigned*)(src + i * 1024), (LAS unsigned*)(dst + i * 1024), 16, 0, 0); } while (0)
#define SQ_WAIT(k) do { switch (k) { case 0: asm volatile("s_waitcnt vmcnt(0)" ::: "memory"); break; case 1: asm volatile("s_waitcnt vmcnt(3)" ::: "memory"); break; case 2: asm volatile("s_waitcnt vmcnt(6)" ::: "memory"); break; \
        case 3: asm volatile("s_waitcnt vmcnt(9)" ::: "memory"); break; case 4: asm volatile("s_waitcnt vmcnt(12)" ::: "memory"); break; default: asm volatile("s_waitcnt vmcnt(15)" ::: "memory"); break; } } while (0)
        constexpr int SQ_D = 6;
        __syncthreads();
        if (!is_cons) { const int np = nch < SQ_D ? nch : SQ_D; for (int c = 0; c < np; ++c) SQ_ISSUE(c); SQ_WAIT(np - 1); }
        __syncthreads();
        for (int c = 0; c < nch; ++c) {
            if (is_cons) {
                const LAS unsigned char* B = F.lds + (c % (SQ_D + 1)) * 12288;
#define SQ_KA(off, cc) (*(const LAS bf16x8*)(B + (off) + (((cc) * 16 + fr) * 4 + fq) * 16))
                const u32x2 vt = *(const LAS u32x2*)(B + CB_VT + vrow * 32 + fq * 8), z2 = (u32x2){0u, 0u};
                const bf16x8 aP2 = mk8(*(const LAS u32x2*)(B + CB_P2T + fr * 32 + fq * 8), z2), aP10 = SQ_KA(CB_P1T, 0), aP11 = SQ_KA(CB_P1T, 1), aR0 = SQ_KA(CB_RT, 0), aR1 = SQ_KA(CB_RT, 1);
                const bf16x8 aM = *(const LAS bf16x8*)(B + CB_MBT + (fr * 4 + fq) * 16);
                bf16x8 aBK[4]; f32x4 gc[4];
#pragma unroll
                for (int kb = 0; kb < 4; ++kb) { aBK[kb] = *(const LAS bf16x8*)(B + CB_BK + ((16 * kb + fr) * 4 + fq) * 16); gc[kb] = *(const LAS f32x4*)(B + CB_GC + (16 * kb + 4 * fq) * 4); }
                __builtin_amdgcn_sched_barrier(0);
                const bf16x8 sB0 = mk8(pk4(sreg[0]), pk4(sreg[1])), sB1 = mk8(pk4(sreg[2]), pk4(sreg[3]));
                f32x4 uD = mfma16(aP2, mk8(vt, z2), (f32x4){0.f, 0.f, 0.f, 0.f});
                uD = mfma16(aP10, sB0, uD); uD = mfma16(aP11, sB1, uD);
                const bf16x8 uvB = mk8(pk4(uD), vt);
                f32x4 nS[4];
#pragma unroll
                for (int kb = 0; kb < 4; ++kb) nS[kb] = mfma16(aBK[kb], uvB, sreg[kb]);
                f32x4 yD = mfma16(aM, uvB, (f32x4){0.f, 0.f, 0.f, 0.f});
                yD = mfma16(aR0, sB0, yD); yD = mfma16(aR1, sB1, yD);
#pragma unroll
                for (int kb = 0; kb < 4; ++kb) sreg[kb] = nS[kb] * gc[kb];
                { float* yo = Y + (size_t)(m0 + c * 16 + 4 * fq) * RWD + h * 64 + vrow; yo[0] = yD[0]; yo[RWD] = yD[1]; yo[2 * RWD] = yD[2]; yo[3 * RWD] = yD[3]; }
#undef SQ_KA
            } else {
                if (c + SQ_D < nch) SQ_ISSUE(c + SQ_D);
                if (c + 1 < nch) { const int last = c + SQ_D < nch ? c + SQ_D : nch - 1; SQ_WAIT(last - (c + 1)); }
            }
            asm volatile("s_waitcnt lgkmcnt(0)" ::: "memory"); __builtin_amdgcn_s_barrier(); asm volatile("" ::: "memory");
        }
#undef SQ_ISSUE
#undef SQ_WAIT
        if (is_cons) { float* so = F.out + (samp ? O_WKS : O_WKP) + ((((size_t)l * 8 + b) * 16 + h) * 64 + vrow) * 64 + 4 * fq;
#pragma unroll
            for (int kb = 0; kb < 4; ++kb) *(f32x4*)(so + 16 * kb) = sreg[kb]; }
    }
}

constexpr int SC_TC = 32, SC_STEP = 6 * 64;
__device__ __forceinline__ float sum16(float x) { x += dpp_f<0xB1>(x); x += dpp_f<0x4E>(x); x += dpp_f<0x141>(x); x += dpp_f<0x140>(x); return x; }
__device__ __forceinline__ void unpack4(const u32x2 w, float (&f)[4]) { f[0] = bf_lo(w.x); f[1] = bf_hi(w.x); f[2] = bf_lo(w.y); f[3] = bf_hi(w.y); }
__device__ __forceinline__ void scan_phase(Frame& F, int l_in) {
    PHASE_IDS
    unsigned char* const wsl = fresh(F.ws);
    PHASE_L
    LAS float* buf = (LAS float*)F.lds;
    LAS float* ybuf = (LAS float*)(F.lds + 2 * SC_TC * SC_STEP * 4);
    const float* DEC = (const float*)(wsl + WS_DEC); const bf16_t* PROJ = (const bf16_t*)(wsl + WS_PROJ); const bf16_t* AA = (const bf16_t*)(wsl + WS_AA);
    float* Y = (float*)(wsl + WS_Y); float* BS = (float*)(wsl + WS_BS);
    const bool is_cons = wave < 4;
    const int ks = lane & 7, k0 = ks * 8, rl = (wave & 3) * 8 + (lane >> 3);
    const int ptid = tid & 255, st0 = ptid >> 4, q4 = (ptid & 15) * 4;
    for (int u = blockIdx.x; u < 512; u += fresh_i(F.G)) {
        const bool samp = u >= 256; const int half = u & 1, h = (u >> 1) & 15, b = (u >> 5) & 7;
        const int T = samp ? TS : TP, m0 = samp ? MPR + b * TS : b * TP, ch = h * 64 + q4, row = half * 32 + rl;
        const int nch = T / SC_TC;
        const float* mu = INP(9) + (size_t)l * RPJ;
        const f32x4 mur = *(const f32x4*)(mu + ch), muk = *(const f32x4*)(mu + 1024 + ch), muv = *(const f32x4*)(mu + 2048 + ch);
        const f32x4 ckk = *(const f32x4*)(INP(17) + (size_t)l * RWD + ch), cka = *(const f32x4*)(INP(18) + (size_t)l * RWD + ch), crk = *(const f32x4*)(INP(19) + (size_t)l * RWD + ch);
        const float* shp = INP(2) + ((size_t)l * 8 + b) * RPJ + ch;
        f32x2 S01, S23, S45, S67;
        if (samp) { const float* sp = INP(4) + ((((size_t)l * 8 + b) * 16 + h) * 64 + row) * 64 + k0; const f32x4 s0 = *(const f32x4*)sp, s1 = *(const f32x4*)(sp + 4);
            S01 = (f32x2){s0.x, s0.y}; S23 = (f32x2){s0.z, s0.w}; S45 = (f32x2){s1.x, s1.y}; S67 = (f32x2){s1.z, s1.w}; }
        else { S01 = (f32x2){0.f, 0.f}; S23 = S01; S45 = S01; S67 = S01; }
        u32x2 rw[2][7]; f32x4 rd[2];
#define SC_LOADRAW(c) do { _Pragma("unroll") for (int i2 = 0; i2 < 2; ++i2) { const int tt = (c) * SC_TC + st0 + 16 * i2; const size_t mm = (size_t)(m0 + tt); const bf16_t* pc = PROJ + mm * ICP + 1024 + ch; \
        rw[i2][0] = *(const u32x2*)pc; rw[i2][1] = *(const u32x2*)(pc + 1024); rw[i2][2] = *(const u32x2*)(pc + 2048); rw[i2][6] = *(const u32x2*)(AA + mm * RWD + ch); rd[i2] = *(const f32x4*)(DEC + mm * RWD + ch); \
        if (tt > 0) { rw[i2][3] = *(const u32x2*)(pc - ICP); rw[i2][4] = *(const u32x2*)(pc - ICP + 1024); rw[i2][5] = *(const u32x2*)(pc - ICP + 2048); } \
        else { rw[i2][3] = (u32x2){0u, 0u}; rw[i2][4] = rw[i2][3]; rw[i2][5] = rw[i2][3]; } } } while (0)
#define SC_BUILD(c, bufp) do { _Pragma("unroll") for (int i2 = 0; i2 < 2; ++i2) { const int st = st0 + 16 * i2, tt = (c) * SC_TC + st; const size_t mm = (size_t)(m0 + tt); \
        float xr[4], xk[4], xv[4], yr[4], yk[4], yv[4], av[4]; unpack4(rw[i2][0], xr); unpack4(rw[i2][1], xk); unpack4(rw[i2][2], xv); unpack4(rw[i2][3], yr); unpack4(rw[i2][4], yk); unpack4(rw[i2][5], yv); unpack4(rw[i2][6], av); \
        const f32x4 cd = rd[i2]; \
        if (samp && tt == 0) { const f32x4 t0 = *(const f32x4*)shp, t1 = *(const f32x4*)(shp + 1024), t2 = *(const f32x4*)(shp + 2048); _Pragma("unroll") for (int j = 0; j < 4; ++j) { yr[j] = t0[j]; yk[j] = t1[j]; yv[j] = t2[j]; } } \
        f32x4 vr, vk, vv4, vq, vb, vh; float ss = 0.f, bsum = 0.f; \
        _Pragma("unroll") for (int j = 0; j < 4; ++j) { vr[j] = xr[j] + (yr[j] - xr[j]) * mur[j]; vk[j] = xk[j] + (yk[j] - xk[j]) * muk[j]; vv4[j] = xv[j] + (yv[j] - xv[j]) * muv[j]; \
            vq[j] = vk[j] * ckk[j]; ss += vq[j] * vq[j]; vh[j] = vk[j] * (1.0f + (av[j] - 1.0f) * cka[j]); bsum += vr[j] * vh[j] * crk[j]; } \
        ss = sum16(ss); bsum = sum16(bsum); const float inv = 1.0f / fmaxf(sqrtf(ss), 1e-12f); \
        _Pragma("unroll") for (int j = 0; j < 4; ++j) { vq[j] *= inv; vb[j] = vq[j] * av[j]; } \
        LAS float* d = (bufp) + st * SC_STEP + q4; *(LAS f32x4*)d = cd; *(LAS f32x4*)(d + 64) = vq; *(LAS f32x4*)(d + 128) = vb; *(LAS f32x4*)(d + 192) = vh; *(LAS f32x4*)(d + 256) = vr; *(LAS f32x4*)(d + 320) = vv4; \
        if (half == 0 && q4 == 0) BS[mm * 16 + h] = bsum; } } while (0)
#define SC_FLUSH(c) do { const int fs = ptid >> 3, fj = (ptid & 7) * 4; const f32x4 yo = *(const LAS f32x4*)(ybuf + ((c) & 1) * SC_TC * 32 + fs * 32 + fj); \
        *(f32x4*)(Y + (size_t)(m0 + (c) * SC_TC + fs) * RWD + h * 64 + half * 32 + fj) = yo; } while (0)
        __syncthreads();
        if (!is_cons) { SC_LOADRAW(0); SC_BUILD(0, buf); if (nch > 1) SC_LOADRAW(1); }
        __syncthreads();
        for (int c = 0; c < nch; ++c) {
            LAS float* cur = buf + (c & 1) * SC_TC * SC_STEP; LAS float* oth = buf + ((c + 1) & 1) * SC_TC * SC_STEP; LAS float* yb = ybuf + (c & 1) * SC_TC * 32;
            if (is_cons) {
#define SC_STEP_BODY(s, DO_Y) do { const LAS float* p = cur + (s) * SC_STEP + k0; \
                const f32x4 wa = *(const LAS f32x4*)p, wb = *(const LAS f32x4*)(p + 4), qa = *(const LAS f32x4*)(p + 64), qb = *(const LAS f32x4*)(p + 68), ba = *(const LAS f32x4*)(p + 128), bb = *(const LAS f32x4*)(p + 132), \
                            ha = *(const LAS f32x4*)(p + 192), hb = *(const LAS f32x4*)(p + 196), ra = *(const LAS f32x4*)(p + 256), rb = *(const LAS f32x4*)(p + 260); \
                const float vv = cur[(s) * SC_STEP + 320 + row]; const f32x2 v2 = (f32x2){vv, vv}; \
                f32x2 d = S01 * (f32x2){qa.x, qa.y}; f32x2 d1 = S23 * (f32x2){qa.z, qa.w}; d = S45 * (f32x2){qb.x, qb.y} + d; d1 = S67 * (f32x2){qb.z, qb.w} + d1; d = d + d1; float sa = d.x + d.y; \
                float yv = 0.f; if (DO_Y) { f32x2 e = S01 * (f32x2){rpa.x, rpa.y}; f32x2 e1 = S23 * (f32x2){rpa.z, rpa.w}; e = S45 * (f32x2){rpb.x, rpb.y} + e; e1 = S67 * (f32x2){rpb.z, rpb.w} + e1; e = e + e1; yv = e.x + e.y; } \
                const f32x2 t01 = S01 * (f32x2){wa.x, wa.y} + v2 * (f32x2){ha.x, ha.y}, t23 = S23 * (f32x2){wa.z, wa.w} + v2 * (f32x2){ha.z, ha.w}, t45 = S45 * (f32x2){wb.x, wb.y} + v2 * (f32x2){hb.x, hb.y}, t67 = S67 * (f32x2){wb.z, wb.w} + v2 * (f32x2){hb.z, hb.w}; \
                sa += dpp_f<0xB1>(sa); if (DO_Y) yv += dpp_f<0xB1>(yv); sa += dpp_f<0x4E>(sa); if (DO_Y) yv += dpp_f<0x4E>(yv); sa += dpp_f<0x141>(sa); if (DO_Y) yv += dpp_f<0x141>(yv); \
                const f32x2 n2 = (f32x2){-sa, -sa}; \
                S01 = n2 * (f32x2){ba.x, ba.y} + t01; S23 = n2 * (f32x2){ba.z, ba.w} + t23; S45 = n2 * (f32x2){bb.x, bb.y} + t45; S67 = n2 * (f32x2){bb.z, bb.w} + t67; \
                if (DO_Y) yb[((s) - 1) * 32 + rl] = yv; rpa = ra; rpb = rb; } while (0)
                f32x4 rpa, rpb;
                SC_STEP_BODY(0, false);
#pragma unroll 2
                for (int s = 1; s < SC_TC; ++s) SC_STEP_BODY(s, true);
                { f32x2 e = S01 * (f32x2){rpa.x, rpa.y}; f32x2 e1 = S23 * (f32x2){rpa.z, rpa.w}; e = S45 * (f32x2){rpb.x, rpb.y} + e; e1 = S67 * (f32x2){rpb.z, rpb.w} + e1; e = e + e1; yb[(SC_TC - 1) * 32 + rl] = sum8(e.x + e.y); }
#undef SC_STEP_BODY
            } else {
                if (c + 1 < nch) SC_BUILD(c + 1, oth);
                if (c + 2 < nch) SC_LOADRAW(c + 2);
                if (c > 0) SC_FLUSH(c - 1);
            }
            __syncthreads();
        }
        if (!is_cons) SC_FLUSH(nch - 1);
#undef SC_BUILD
#undef SC_LOADRAW
#undef SC_FLUSH
        if (is_cons) { float* so = F.out + (samp ? O_WKS : O_WKP) + ((((size_t)l * 8 + b) * 16 + h) * 64 + row) * 64 + k0;
            *(f32x4*)so = (f32x4){S01.x, S01.y, S23.x, S23.y}; *(f32x4*)(so + 4) = (f32x4){S45.x, S45.y, S67.x, S67.y}; }
    }
}

__device__ __forceinline__ void post_phase(Frame& F, int l_in) {
    PHASE_IDS
    unsigned char* const wsl = fresh(F.ws);
    PHASE_L
    const int NT = fresh_i(F.G) * NTHR; const float* Y = (const float*)(wsl + WS_Y); const float* BS = (const float*)(wsl + WS_BS);
    const bf16_t* PROJ = (const bf16_t*)(wsl + WS_PROJ); const bf16_t* GG = (const bf16_t*)(wsl + WS_GG);
    bf16_t* YB = (bf16_t*)(wsl + WS_YB);
    const float* muv = INP(9) + (size_t)l * RPJ + 2048; const float* gng = INP(20) + (size_t)l * RWD; const float* gnb = INP(21) + (size_t)l * RWD;
#define PP_LOAD(it_, Y0, Y1, CU, PR, GV, BSV) do { const int m_ = (it_) >> 7, c_ = ((it_) & 127) * 8; const size_t o_ = (size_t)m_ * RWD + c_; int b_, t_; bool s_; row_info(m_, b_, t_, s_); \
        Y0 = *(const f32x4*)(Y + o_); Y1 = *(const f32x4*)(Y + o_ + 4); CU = *(const u32x4*)(PROJ + (size_t)m_ * ICP + 3072 + c_); PR = *(const u32x4*)(PROJ + (size_t)(t_ > 0 ? m_ - 1 : m_) * ICP + 3072 + c_); \
        GV = *(const u32x4*)(GG + o_); BSV = BS[(size_t)m_ * 16 + (c_ >> 6)]; } while (0)
    f32x4 y0, y1, ny0, ny1; u32x4 cu, pr, gv, ncu, npr, ngv; float bs, nbs;
    if (gtid < MT * 128) PP_LOAD(gtid, y0, y1, cu, pr, gv, bs);
    for (int it = gtid; it < MT * 128; it += NT) {
        const int itn = it + NT;
        if (itn < MT * 128) PP_LOAD(itn, ny0, ny1, ncu, npr, ngv, nbs);
        const int m = it >> 7, c0 = (it & 127) * 8; const size_t o = (size_t)m * RWD + c0;
        int b, t; bool samp; row_info(m, b, t, samp);
        float y[8] = {y0.x, y0.y, y0.z, y0.w, y1.x, y1.y, y1.z, y1.w};
        float cur[8], prv[8], g[8]; unpack8(cu, cur); unpack8(gv, g); unpack8(pr, prv);
        if (t == 0) {
            if (samp) { const float* p = INP(2) + ((size_t)l * 8 + b) * RPJ + 2048 + c0;
#pragma unroll
                for (int j = 0; j < 8; ++j) prv[j] = p[j]; }
            else {
#pragma unroll
                for (int j = 0; j < 8; ++j) prv[j] = 0.f; }
        }
        float s = 0.f;
#pragma unroll
        for (int j = 0; j < 8; ++j) s += y[j];
        s = sum8(s);
        const float mean = s * (1.0f / 64.0f); float q = 0.f;
#pragma unroll
        for (int j = 0; j < 8; ++j) { const float d = y[j] - mean; q += d * d; }
        q = sum8(q);
        const float rstd = __builtin_amdgcn_rsqf(q * (1.0f / 64.0f) + GN_EPS);
        float outv[8];
#pragma unroll
        for (int j = 0; j < 8; ++j) { const float v = cur[j] + (prv[j] - cur[j]) * muv[c0 + j]; outv[j] = ((y[j] - mean) * rstd * gng[c0 + j] + gnb[c0 + j] + bs * v) * g[j]; }
        *(u32x4*)(YB + o) = pack8(outv);
        y0 = ny0; y1 = ny1; cu = ncu; pr = npr; gv = ngv; bs = nbs;
    }
#undef PP_LOAD
}

__device__ __forceinline__ void tile64_mma(const bf16_t* A, int lda, const bf16_t* Bt, int ldb, int K, int m0, int n0, int wave, int lane, f32x4 (&acc)[4][4]) {
    const int kq = K >> 3, kb = wave * kq, lr = lane & 15, lk = (lane >> 4) * 8;
    const bf16_t* ap = A + (size_t)(m0 + lr) * lda + kb + lk; const bf16_t* bp = Bt + (size_t)(n0 + lr) * ldb + kb + lk;
#pragma unroll 2
    for (int k = 0; k < kq; k += 32) {
        bf16x8 af[4], bf[4];
#pragma unroll
        for (int i = 0; i < 4; ++i) { af[i] = *(const bf16x8*)(ap + (size_t)(16 * i) * lda + k); bf[i] = *(const bf16x8*)(bp + (size_t)(16 * i) * ldb + k); }
#pragma unroll
        for (int mi = 0; mi < 4; ++mi)
#pragma unroll
            for (int ni = 0; ni < 4; ++ni) acc[mi][ni] = __builtin_amdgcn_mfma_f32_16x16x32_bf16(bf[ni], af[mi], acc[mi][ni], 0, 0, 0);
    }
}
__device__ __forceinline__ void tile64_reduce(LAS unsigned char* lds, int wave, int lane, const f32x4 (&acc)[4][4], f32x4 (&out)[2]) {
    LAS f32x4* red = (LAS f32x4*)lds;
    __syncthreads();
#pragma unroll
    for (int mi = 0; mi < 4; ++mi)
#pragma unroll
        for (int ni = 0; ni < 4; ++ni) red[(wave * 16 + mi * 4 + ni) * 64 + lane] = acc[mi][ni];
    __syncthreads();
#pragma unroll
    for (int j = 0; j < 2; ++j) { f32x4 s = red[(2 * wave + j) * 64 + lane];
#pragma unroll
        for (int w = 1; w < 8; ++w) s += red[(w * 16 + 2 * wave + j) * 64 + lane];
        out[j] = s; }
}
#define T64_ZERO(acc) do { _Pragma("unroll") for (int mi = 0; mi < 4; ++mi) _Pragma("unroll") for (int ni = 0; ni < 4; ++ni) acc[mi][ni] = (f32x4){0.f, 0.f, 0.f, 0.f}; } while (0)
template <int MODE>
__device__ __forceinline__ void sample_tiles(Frame& F, int l_in) {
    PHASE_IDS
    unsigned char* const wsl = fresh(F.ws);
    PHASE_L
    const size_t xb_cur = (l & 1) ? WS_XB2 : WS_XN, xb_nxt = (l & 1) ? WS_XN : WS_XB2;
    for (int t = blockIdx.x; t < 256; t += fresh_i(F.G)) {
        const int m0 = MPR + (t >> 5) * 64, n0 = (t & 31) * 64;
        f32x4 acc[4][4], o1[2], o2[2]; T64_ZERO(acc);
        if (MODE == 0) { tile64_mma((const bf16_t*)(wsl + WS_YA), PWD, (const bf16_t*)(wsl + WS_PPOOL), PWD, PWD, m0, n0, wave, lane, acc); tile64_reduce(F.lds, wave, lane, acc, o1);
                         T64_ZERO(acc); tile64_mma((const bf16_t*)(wsl + WS_YB), RWD, (const bf16_t*)(wsl + WS_PRWKV), RWD, RWD, m0, n0, wave, lane, acc); tile64_reduce(F.lds, wave, lane, acc, o2); }
        if (MODE == 1) { tile64_mma((const bf16_t*)(wsl + WS_MRG), DM, (const bf16_t*)(wsl + WS_WOUT), DM, DM, m0, n0, wave, lane, acc); tile64_reduce(F.lds, wave, lane, acc, o1); }
        if (MODE == 2) { tile64_mma((const bf16_t*)(wsl + WS_HID), FF, (const bf16_t*)(wsl + WS_WDN), FF, FF, m0, n0, wave, lane, acc); tile64_reduce(F.lds, wave, lane, acc, o1); }
        if (MODE == 3) { tile64_mma((const bf16_t*)(wsl + xb_cur), DM, (const bf16_t*)(wsl + WS_WPG), DM, DM, m0, n0, wave, lane, acc); tile64_reduce(F.lds, wave, lane, acc, o1); }
        if (MODE == 4) { tile64_mma((const bf16_t*)(wsl + WS_PB), PLE, (const bf16_t*)(wsl + WS_WPP), PLE, PLE, m0, n0, wave, lane, acc); tile64_reduce(F.lds, wave, lane, acc, o1); }
#pragma unroll
        for (int j = 0; j < 2; ++j) { const int blk = 2 * wave + j; const size_t row = (size_t)(m0 + 16 * (blk >> 2) + (lane & 15)); const int col = n0 + 16 * (blk & 3) + 4 * (lane >> 4);
            if (MODE == 0) { const bf16_t* PROJ = (const bf16_t*)(wsl + WS_PROJ); const u32x2 g1 = *(const u32x2*)(PROJ + row * ICP + PC_GP + col), g2 = *(const u32x2*)(PROJ + row * ICP + PC_GR + col);
                const f32x4 a = (f32x4){bf_lo(g1.x), bf_hi(g1.x), bf_lo(g1.y), bf_hi(g1.y)} * o1[j] + (f32x4){bf_lo(g2.x), bf_hi(g2.x), bf_lo(g2.y), bf_hi(g2.y)} * o2[j];
                *(u32x2*)((bf16_t*)(wsl + WS_MRG) + row * DM + col) = (u32x2){cvt_pk_bf16(a.x, a.y), cvt_pk_bf16(a.z, a.w)}; }
            if (MODE == 1 || MODE == 2) { bf16_t* p = (bf16_t*)(wsl + xb_cur) + row * DM + col; const u32x2 q = *(const u32x2*)p; const f32x4 x = (f32x4){bf_lo(q.x), bf_hi(q.x), bf_lo(q.y), bf_hi(q.y)} + o1[j];
                *(u32x2*)p = (u32x2){cvt_pk_bf16(x.x, x.y), cvt_pk_bf16(x.z, x.w)}; __hip_atomic_fetch_add((pg8::ss_t*)(wsl + WS_SS) + (size_t)MODE * MT + row, pg8::ss_fix((x.x * x.x + x.y * x.y) + (x.z * x.z + x.w * x.w)), __ATOMIC_RELAXED, __HIP_MEMORY_SCOPE_AGENT); }
            if (MODE == 3) { const u32x2 q = *(const u32x2*)((const bf16_t*)(wsl + WS_PP) + row * DM + col); const u32x2 xq = *(const u32x2*)((const bf16_t*)(wsl + xb_cur) + row * DM + col); bf16_t* p = (bf16_t*)(wsl + xb_nxt) + row * DM + col;
                const float rs = pg8::rstd_of((const pg8::ss_t*)(wsl + WS_SS) + (size_t)2 * MT, row);
                const f32x4 x = (f32x4){bf_lo(xq.x), bf_hi(xq.x), bf_lo(xq.y), bf_hi(xq.y)} + sigmoid4(o1[j] * rs) * (f32x4){bf_lo(q.x), bf_hi(q.x), bf_lo(q.y), bf_hi(q.y)};
                *(u32x2*)p = (u32x2){cvt_pk_bf16(x.x, x.y), cvt_pk_bf16(x.z, x.w)}; __hip_atomic_fetch_add((pg8::ss_t*)(wsl + WS_SS) + row, pg8::ss_fix((x.x * x.x + x.y * x.y) + (x.z * x.z + x.w * x.w)), __ATOMIC_RELAXED, __HIP_MEMORY_SCOPE_AGENT); }
            if (MODE == 4) *(u32x2*)((bf16_t*)(wsl + WS_PP) + row * DM + col) = (u32x2){cvt_pk_bf16(o1[j].x, o1[j].y), cvt_pk_bf16(o1[j].z, o1[j].w)};
        }
    }
    __syncthreads();
}

constexpr int PH_PER_LAYER = 12, N_PHASES = NL * PH_PER_LAYER + 1;
#ifndef MK_AB
#define MK_AB 0
#endif
#ifndef MK_REP
#define MK_REP 0
#endif
__global__ void __launch_bounds__(NTHR, 2) mega_fwd(Args args) {
    extern __shared__ __attribute__((aligned(16))) unsigned char lds[];
    Frame F;
    F.lds = (LAS unsigned char*)lds;
    F.G = gridDim.x;
    F.out = args.out; F.ws = args.ws;
    { LAS unsigned long long* pt = (LAS unsigned long long*)(F.lds + LDSCTL_OFF + 1024); F.ptab = pt;
      if (threadIdx.x == 0) {
#define PT_(k) pt[k] = (unsigned long long)args.in[k];
          PT_(0) PT_(1) PT_(2) PT_(3) PT_(4) PT_(5) PT_(6) PT_(7) PT_(8) PT_(9) PT_(10) PT_(11) PT_(12) PT_(13) PT_(14) PT_(15) PT_(16) PT_(17) PT_(18) PT_(19) PT_(20) PT_(21) PT_(22) PT_(23) PT_(24) PT_(25) PT_(26) PT_(27) PT_(28) PT_(29) PT_(30) PT_(31) PT_(32)
#undef PT_
      } }
    volatile LAS unsigned* MISC = (volatile LAS unsigned*)(F.lds + LDSCTL_OFF);
    for (int u = threadIdx.x; u < 256; u += NTHR) ((LAS unsigned*)(F.lds + LDSCTL_OFF))[u] = 0u;
    __syncthreads();
    XcdBarrier bar; bar.bar = (unsigned*)(args.ws + WS_CTL) + CW_BAR; bar.x = 0; bar.st = nullptr;
    if (!MK_PER_PHASE) bar = xcd_barrier_post((unsigned*)(args.ws + WS_CTL) + CW_BAR, MISC + 8);
    const int lo = args.ph_lo, hi = args.ph_hi;
#define IN(k) (lo <= (k) && (k) < hi)
#define REP(k) (1 + ((MK_REP >> (k)) & 1))
#define PHASE(k, ...) do { if (IN(pb + (k))) { for (int rep = 0; rep < REP(k); ++rep) { if (rep) xcd_barrier(bar); __VA_ARGS__ } if (IN(pb + (k) + 1)) xcd_barrier(bar); } } while (0)
#define WSP(off) (fresh(F.ws) + (off))
#define UNPAREN(...) __VA_ARGS__
#define GEMM_M(M_, EPI, EINIT, Aoff, Boff, N_, K_, lda_, ldb_, apn_) do { pg8::Gemm g{(const bf16_t*)WSP(Aoff), (const bf16_t*)WSP(Boff), (M_), (N_), (K_), (lda_), (ldb_), (apn_)}; pg8::StaticOrder S; S.init((M_), (N_), fresh_i(F.G), fresh_i(cid)); \
        pg8::EPI E{UNPAREN EINIT}; pg8::gemm_phase<pg8::EPI, pg8::StaticOrder, true>(ring, g, S, E); } while (0)
#define GEMM(...) GEMM_M(MT, __VA_ARGS__)
#define GEMM_SUB(c0_, M_, EPI, EINIT, Aoff, Boff, N_, K_, lda_, ldb_, apn_) do { pg8::Gemm g{(const bf16_t*)WSP(Aoff), (const bf16_t*)WSP(Boff), (M_), (N_), (K_), (lda_), (ldb_), (apn_)}; pg8::StaticOrder S; \
        const int c0v = (c0_); S.init((M_), (N_), fresh_i(F.G) - c0v, fresh_i(cid) >= c0v ? fresh_i(cid) - c0v : -1); pg8::EPI E{UNPAREN EINIT}; pg8::gemm_phase<pg8::EPI, pg8::StaticOrder, true>(ring, g, S, E); } while (0)
    LAS unsigned char* ring = F.lds;
    const int cid = (int)blockIdx.x;
    for (int l = 0; l < NL; ++l) {
        const int pb = l * PH_PER_LAYER;
#define SSP(i) ((pg8::ss_t*)WSP(WS_SS) + (size_t)(i) * MT)
        const size_t xb_cur = (l & 1) ? WS_XB2 : WS_XN, xb_nxt = (l & 1) ? WS_XN : WS_XB2;
        PHASE(0, { convert_weights(F, l); if (l == 0) xb_from_input(F); });
        PHASE(1, { GEMM(EpiProj, ((bf16_t*)WSP(WS_PROJ), SSP(0)), xb_cur, WS_WIN, ICP, DM, DM, DM, 0); });
        PHASE(2, { prep1_phase(F, l); });
        PHASE(3, { GEMM(EpiBf16, ((bf16_t*)WSP(WS_YA), PWD), WS_D, WS_POOLW, PWD, 256, PWD, 256, 256);
                   GEMM(EpiLora, ((float*)WSP(WS_DEC), (bf16_t*)WSP(WS_AA), (bf16_t*)WSP(WS_GG), INP(12) + (size_t)fresh_i(l) * RWD, INP(14) + (size_t)fresh_i(l) * RWD), WS_LIN, WS_LORA, 3072, LK, LK, LK, 0); });
        PHASE(4, { spre_phase(F, l); });
        PHASE(5, { sseq_phase(F, l); if (MK_AB) { xcd_barrier(bar); scan_phase(F, l); } });
        PHASE(6, { post_phase(F, l); });
        PHASE(7, { GEMM_M(MPR, EpiGate1, ((bf16_t*)WSP(WS_TMP), (const bf16_t*)WSP(WS_PROJ), PC_GP), WS_YA, WS_PPOOL, DM, PWD, PWD, PWD, 0);
                   GEMM_M(MPR, EpiGate2, ((const bf16_t*)WSP(WS_TMP), (const bf16_t*)WSP(WS_PROJ), PC_GR, (bf16_t*)WSP(WS_MRG)), WS_YB, WS_PRWKV, DM, RWD, RWD, RWD, 0);
                   sample_tiles<0>(F, l); });
        PHASE(8, { GEMM_M(MPR, EpiResid, ((bf16_t*)WSP(xb_cur), SSP(1)), WS_MRG, WS_WOUT, DM, DM, DM, DM, 0); sample_tiles<1>(F, l); });
        PHASE(9, { GEMM(EpiSwiglu, ((bf16_t*)WSP(WS_HID), SSP(1)), xb_cur, WS_WGU, 2 * FF, DM, DM, DM, 0);
                   GEMM_SUB((((MT / 256) * (2 * FF / 256)) % fresh_i(F.G)) & ~7, MPR, EpiBf16, ((bf16_t*)WSP(WS_PP), DM), WS_PB, WS_WPP, DM, PLE, PLE, PLE, 0); sample_tiles<4>(F, l); });
        PHASE(10, { GEMM_M(MPR, EpiResid, ((bf16_t*)WSP(xb_cur), SSP(2)), WS_HID, WS_WDN, DM, FF, FF, FF, 0); sample_tiles<2>(F, l); });
        PHASE(11, { GEMM_M(MPR, EpiPle, ((const bf16_t*)WSP(xb_cur), (bf16_t*)WSP(xb_nxt), (const bf16_t*)WSP(WS_PP), SSP(2), SSP(0)), xb_cur, WS_WPG, DM, DM, DM, DM, 0); sample_tiles<3>(F, l); });
#undef SSP
    }
    if (IN(NL * PH_PER_LAYER)) final_norm(F, INP(32));
#undef IN
#undef REP
#undef PHASE
#undef WSP
#undef GEMM
#undef GEMM_M
#undef GEMM_SUB
#undef UNPAREN
}

extern "C" void kernel_launch(void* const* d_in, const int* in_sizes, int n_in, void* d_out, int out_size, void* d_ws, size_t ws_size, hipStream_t stream) {
    static int grid = 0;
    if (grid == 0) {
        if (n_in != 33 || in_sizes[0] != MPR * DM || out_size != (int)O_END || ws_size < WS_END) {
            fprintf(stderr, "kernel_launch: unexpected shapes: n_in %d in0 %d out %d ws %zu (need %zu); nothing launched\n", n_in, n_in > 0 ? in_sizes[0] : -1, out_size, ws_size, (size_t)WS_END); grid = -1; return; }
        int dev = 0, cus = 0, per_cu = 0;
        if (hipGetDevice(&dev) != hipSuccess || hipDeviceGetAttribute(&cus, hipDeviceAttributeMultiprocessorCount, dev) != hipSuccess) { grid = -1; return; }
        if (hipFuncSetAttribute((const void*)mega_fwd, hipFuncAttributeMaxDynamicSharedMemorySize, LDS_BYTES) != hipSuccess) { fprintf(stderr, "kernel_launch: hipFuncSetAttribute failed\n"); grid = -1; return; }
        if (hipOccupancyMaxActiveBlocksPerMultiprocessor(&per_cu, (const void*)mega_fwd, NTHR, LDS_BYTES) != hipSuccess || per_cu < 1) { fprintf(stderr, "kernel_launch: occupancy query says %d\n", per_cu); (void)hipGetLastError(); grid = -1; return; }
        grid = cus;
    }
    if (grid < 0) return;
    (void)hipMemsetAsync((char*)d_ws + WS_CTL, 0, CTL_ZERO_BYTES, stream);
    Args a; memset(&a, 0, sizeof(a));
    for (int i = 0; i < 33; ++i) a.in[i] = (const float*)d_in[i];
    a.out = (float*)d_out; a.ws = (unsigned char*)d_ws;
#if MK_PER_PHASE
    for (int p = 0; p < N_PHASES; ++p) { a.ph_lo = p; a.ph_hi = p + 1; hipLaunchKernelGGL(mega_fwd, dim3(grid), dim3(NTHR), LDS_BYTES, stream, a); }
#else
    a.ph_lo = 0; a.ph_hi = N_PHASES; hipLaunchKernelGGL(mega_fwd, dim3(grid), dim3(NTHR), LDS_BYTES, stream, a);
#endif
}
```

```cpp
#include <hip/hip_runtime.h>
#include <cstdio>
#include <cstdint>
#include <cstring>

#ifndef MK_PER_PHASE
#define MK_PER_PHASE 0
#endif

#define LAS __attribute__((address_space(3)))
typedef unsigned short bf16_t;
typedef short bf16x8 __attribute__((ext_vector_type(8)));
typedef float f32x4 __attribute__((ext_vector_type(4)));
typedef float f32x2 __attribute__((ext_vector_type(2)));
typedef unsigned u32x4 __attribute__((ext_vector_type(4)));
typedef unsigned u32x2 __attribute__((ext_vector_type(2)));

constexpr int DM = 2048, NL = 4, MT = 16896, MPR = 16384, TP = 2048, TS = 64;
constexpr int PWD = 1024, RWD = 1024, RPJ = 3360, ICOLS = 8480, ICP = 8704, FF = 5632, PLE = 256, LK = 384;
constexpr int PC_GP = 4608, PC_GR = 6656;
constexpr float NORM_EPS = 1e-6f, GN_EPS = 64e-5f;
constexpr size_t O_YS = 33554432, O_SHP = 34603008, O_POP = 34710528, O_WKP = 35202048, O_SHS = 37299200, O_POS = 37406720, O_WKS = 37898240, O_END = 39995392;

__device__ __forceinline__ unsigned cvt_pk_bf16(float lo, float hi) { unsigned r; asm volatile("v_cvt_pk_bf16_f32 %0, %1, %2" : "=v"(r) : "v"(lo), "v"(hi)); return r; }
__device__ __forceinline__ float bf_lo(unsigned u) { return __uint_as_float(u << 16); }
__device__ __forceinline__ float bf_hi(unsigned u) { return __uint_as_float(u & 0xffff0000u); }
__device__ __forceinline__ void unpack8(const u32x4 w, float (&f)[8]) { f[0] = bf_lo(w.x); f[1] = bf_hi(w.x); f[2] = bf_lo(w.y); f[3] = bf_hi(w.y); f[4] = bf_lo(w.z); f[5] = bf_hi(w.z); f[6] = bf_lo(w.w); f[7] = bf_hi(w.w); }
__device__ __forceinline__ u32x4 pack8(const float (&f)[8]) { u32x4 w; w.x = cvt_pk_bf16(f[0], f[1]); w.y = cvt_pk_bf16(f[2], f[3]); w.z = cvt_pk_bf16(f[4], f[5]); w.w = cvt_pk_bf16(f[6], f[7]); return w; }
__device__ __forceinline__ float sigmoidf_(float x) { return __builtin_amdgcn_rcpf(1.0f + __expf(-x)); }
__device__ __forceinline__ f32x4 sigmoid4(f32x4 v) { f32x4 o; o.x = sigmoidf_(v.x); o.y = sigmoidf_(v.y); o.z = sigmoidf_(v.z); o.w = sigmoidf_(v.w); return o; }
__device__ __forceinline__ float tanhf_(float x) { const float e = __expf(2.0f * x); return 1.0f - 2.0f * __builtin_amdgcn_rcpf(e + 1.0f); }
template <int CTRL> __device__ __forceinline__ float dpp_f(float x) { return __uint_as_float((unsigned)__builtin_amdgcn_update_dpp(0, (int)__float_as_uint(x), CTRL, 0xF, 0xF, true)); }
__device__ __forceinline__ float sum8(float x) { x += dpp_f<0xB1>(x); x += dpp_f<0x4E>(x); x += dpp_f<0x141>(x); return x; }
__device__ __forceinline__ float wave_sum(float x) {
    x += dpp_f<0xB1>(x); x += dpp_f<0x4E>(x); x += dpp_f<0x141>(x); x += dpp_f<0x140>(x);
    x += __uint_as_float((unsigned)__builtin_amdgcn_ds_swizzle((int)__float_as_uint(x), 0x401F));
    return __uint_as_float((unsigned)__builtin_amdgcn_readlane((int)__float_as_uint(x), 0)) + __uint_as_float((unsigned)__builtin_amdgcn_readlane((int)__float_as_uint(x), 32));
}

namespace pg8 {
typedef unsigned ss_t;
constexpr int BM = 256, BK = 64, HALF = 128, HTB = HALF * BK * 2  , STAGE_BYTES = 8 * HTB, NXCD = 8, WGM = 8;
__host__ __device__ __forceinline__ int lds_byte(int r, int c) { const int st = (r >> 4) * 2 + (c >> 5), rr = r & 15, cc = c & 31, ob = rr * 64 + cc * 2; return st * 1024 + (ob ^ (((ob >> 9) & 1) << 5)); }
__host__ __device__ __forceinline__ void stage_rc(int b, int& R, int& C) { const int st = b / 1024, sb = b % 1024, swz = sb ^ (((sb >> 9) & 1) << 5); R = (st >> 1) * 16 + swz / 64; C = (st & 1) * 32 + (swz % 64) / 2; }
__host__ __device__ __forceinline__ int perm32(int rho) { const int n = rho >> 4, i = rho & 15; return 8 * (i >> 2) + 4 * n + (i & 3); }

struct Unit { int pm, pn; };
struct Gemm { const bf16_t* A; const bf16_t* Bt; int M, N, K, lda, ldb, a_pn_off; };

struct StaticOrder {
    int nM, nN, nwg, G, c;
    __host__ __device__ void init(int M, int N, int G_, int c_) { nM = M / BM; nN = N / BM; nwg = nM * nN; G = G_; c = c_; }
    __host__ __device__ bool next(int i, Unit& u) const {
        if (c < 0) return false;
        const long L = (long)i * G + c; if (L >= nwg) return false;
        int wgid = (int)L; { const int q = nwg / NXCD, r = nwg % NXCD, xcd = wgid % NXCD, off = wgid / NXCD; wgid = (xcd < r ? xcd * (q + 1) : r * (q + 1) + (xcd - r) * q) + off; }
        const int nig = WGM * nN, gid = wgid / nig, fm = gid * WGM, gsz = (nM - fm) < WGM ? (nM - fm) : WGM;
        u.pm = fm + ((wgid % nig) % gsz); u.pn = (wgid % nig) / gsz; return true;
    }
    __device__ __forceinline__ void a_ready(const Unit&) const {}
    __device__ __forceinline__ void done(const Unit&) const {}
};

__device__ __forceinline__ void acc_zero(f32x4 (&acc)[2][2][4][2]) {
#pragma unroll
    for (int a = 0; a < 2; ++a)
#pragma unroll
        for (int b = 0; b < 2; ++b)
#pragma unroll
            for (int m = 0; m < 4; ++m)
#pragma unroll
                for (int n = 0; n < 2; ++n) acc[a][b][m][n] = (f32x4){0.f, 0.f, 0.f, 0.f};
}
struct RepeatOrder : StaticOrder {
    __host__ __device__ bool next(int i, Unit& u) const { if (i >= 6) return false; return StaticOrder::next(i % 3, u) || StaticOrder::next(0, u); }
};
#define EPI_ZERO_INIT __device__ __forceinline__ void init(f32x4 (&acc)[2][2][4][2], const Unit&, int, int, int, int) const { acc_zero(acc); }
#define EPI_NO_PRE __device__ __forceinline__ void preload(ss_t (&pre)[2], const Unit&, int, int, int) const {}
#define EPI_SS_PRE(SSPTR) __device__ __forceinline__ void preload(ss_t (&pre)[2], const Unit& u, int wr, int fr, int fq) const { _Pragma("unroll") for (int j = 0; j < 2; ++j) { const int g = 2 * fq + j; \
        pre[j] = (SSPTR)[(size_t)(u.pm * BM + (g >> 2) * HALF + wr * 64 + (g & 3) * 16 + fr)]; } }
__device__ __forceinline__ ss_t pre_get(const ss_t (&pre)[2], int g, int fr) { return (ss_t)__builtin_amdgcn_ds_bpermute((((g >> 1) << 4) + fr) << 2, (int)pre[g & 1]); }
template <class Epi, class Sched, bool ALIGN_EPI>
__device__ __forceinline__ void gemm_phase(LAS unsigned char* lds, const Gemm g, const Sched& S, const Epi& E) {
    int tid_ = threadIdx.x; asm volatile("" : "+v"(tid_));
    const int tid = tid_, wid = __builtin_amdgcn_readfirstlane(tid >> 6), lane = tid & 63, wr = wid >> 2, wc = wid & 3, fr = lane & 15, fq = lane >> 4;
    int K_ = g.K; asm volatile("" : "+s"(K_));
    const int K = K_, nt = K / BK;
    unsigned voffA[2], voffB[2];
#pragma unroll
    for (int i = 0; i < 2; ++i) { int R, C; stage_rc(tid * 16 + i * 8192, R, C); const int Rb = Epi::PERM ? (64 * (R >> 5) + perm32(R & 31)) : R;
        voffA[i] = (unsigned)(R * g.lda + C) * 2u; voffB[i] = (unsigned)(Rb * g.ldb + C) * 2u; }
    const size_t kstep = (size_t)(BK * 2);
    const size_t hstepA = (size_t)HALF * g.lda * 2, hstepB = (size_t)(Epi::PERM ? 32 : HALF) * g.ldb * 2;
    const unsigned ldsw = (unsigned)wid * 1024u;
    const int aoff = lds_byte(wr * 64 + fr, fq * 8), boff = lds_byte(wc * 32 + fr, fq * 8);
#define PG8_SA(b, h) (((b) * 2 + (h)) * HTB)
#define PG8_SB(b, h) ((4 + (b) * 2 + (h)) * HTB)
#define PG8_STAGE(bufoff, gbase, voff) do { _Pragma("unroll") for (int _i = 0; _i < 2; ++_i) \
        __builtin_amdgcn_global_load_lds((const unsigned*)((const char*)(gbase) + (voff)[_i]), (LAS unsigned*)(lds + (bufoff) + ldsw + _i * 8192), 16, 0, 0); } while (0)
#define PG8_LDA(dst, b, h) do { _Pragma("unroll") for (int m = 0; m < 4; ++m) _Pragma("unroll") for (int k = 0; k < 2; ++k) dst[m][k] = *(const LAS bf16x8*)(lds + PG8_SA(b, h) + aoff + m * 2048 + k * 1024); } while (0)
#define PG8_LDB(dst, b, h) do { _Pragma("unroll") for (int n = 0; n < 2; ++n) _Pragma("unroll") for (int k = 0; k < 2; ++k) dst[n][k] = *(const LAS bf16x8*)(lds + PG8_SB(b, h) + boff + n * 2048 + k * 1024); } while (0)
#define PG8_MMA(ai, bj, At, Bt) do { __builtin_amdgcn_s_setprio(1); _Pragma("unroll") for (int m = 0; m < 4; ++m) _Pragma("unroll") for (int n = 0; n < 2; ++n) _Pragma("unroll") for (int k = 0; k < 2; ++k) \
        acc[ai][bj][m][n] = __builtin_amdgcn_mfma_f32_16x16x32_bf16(Bt[n][k], At[m][k], acc[ai][bj][m][n], 0, 0, 0); __builtin_amdgcn_s_setprio(0); } while (0)
#define PG8_WAIT_V(n) asm volatile("s_waitcnt vmcnt(" #n ")" ::: "memory")
#define PG8_WAIT_L(n) asm volatile("s_waitcnt lgkmcnt(" #n ")" ::: "memory")
#define PG8_BAR __builtin_amdgcn_s_barrier()
#define PG8_SCHED __builtin_amdgcn_sched_barrier(0)
    Unit cur, nxt; int ui = 0;
    if (!S.next(0, cur)) return;
    f32x4 acc[2][2][4][2]; ss_t pre[2];
    E.init(acc, cur, wr, wc, fr, fq); E.preload(pre, cur, wr, fr, fq);
    bf16x8 At[4][2], B0[2][2], B1[2][2];
    const char* cA = (const char*)g.A + ((size_t)cur.pm * BM * g.lda + (size_t)cur.pn * g.a_pn_off) * 2; const char* cB = (const char*)g.Bt + (size_t)cur.pn * BM * g.ldb * 2;
    S.a_ready(cur);
    PG8_STAGE(PG8_SB(0, 0), cB, voffB); PG8_STAGE(PG8_SB(0, 1), cB + hstepB, voffB); PG8_STAGE(PG8_SA(0, 0), cA, voffA); PG8_STAGE(PG8_SA(0, 1), cA + hstepA, voffA);
    if (wr == 1) PG8_BAR;
    PG8_WAIT_V(2); PG8_BAR;
    PG8_STAGE(PG8_SB(1, 0), cB + kstep, voffB); PG8_STAGE(PG8_SA(1, 0), cA + kstep, voffA); PG8_STAGE(PG8_SB(1, 1), cB + hstepB + kstep, voffB);
    PG8_WAIT_V(6); PG8_BAR;
    for (;;) {
        const bool has_next = S.next(ui + 1, nxt);
        const char* nA = has_next ? (const char*)g.A + ((size_t)nxt.pm * BM * g.lda + (size_t)nxt.pn * g.a_pn_off) * 2 : cA; const char* nB = has_next ? (const char*)g.Bt + (size_t)nxt.pn * BM * g.ldb * 2 : cB;
#pragma unroll 1
        for (int t = 0; t < nt; t += 2) {
            const bool last = (t == nt - 2);
            const char* a1 = cA + (size_t)(t + 1) * kstep;
            const char* a2 = last ? nA : cA + (size_t)(t + 2) * kstep; const char* b2 = last ? nB : cB + (size_t)(t + 2) * kstep;
            const char* a3 = a2 + kstep; const char* b3 = b2 + kstep;
            if (last && has_next) S.a_ready(nxt);
            PG8_LDB(B0, 0, 0); PG8_LDB(B1, 0, 1); PG8_SCHED; PG8_LDA(At, 0, 0); PG8_STAGE(PG8_SA(1, 1), a1 + hstepA, voffA);
            PG8_WAIT_V(8); PG8_WAIT_L(0); PG8_BAR; PG8_MMA(0, 0, At, B0); PG8_MMA(0, 1, At, B1); PG8_BAR; PG8_SCHED;
            PG8_LDA(At, 0, 1); PG8_STAGE(PG8_SB(0, 0), b2, voffB); PG8_STAGE(PG8_SB(0, 1), b2 + hstepB, voffB); PG8_STAGE(PG8_SA(0, 0), a2, voffA);
            PG8_WAIT_V(8); PG8_WAIT_L(0); PG8_BAR; PG8_MMA(1, 0, At, B0); PG8_MMA(1, 1, At, B1); PG8_BAR; PG8_SCHED;
            PG8_LDB(B0, 1, 0); PG8_LDB(B1, 1, 1); PG8_SCHED; PG8_LDA(At, 1, 0); PG8_STAGE(PG8_SA(0, 1), a2 + hstepA, voffA);
            PG8_WAIT_V(8); PG8_WAIT_L(0); PG8_BAR; PG8_MMA(0, 0, At, B0); PG8_MMA(0, 1, At, B1); PG8_BAR; PG8_SCHED;
            PG8_LDA(At, 1, 1); PG8_STAGE(PG8_SB(1, 0), b3, voffB); PG8_STAGE(PG8_SB(1, 1), b3 + hstepB, voffB); PG8_STAGE(PG8_SA(1, 0), a3, voffA);
            PG8_WAIT_V(8); PG8_WAIT_L(0); PG8_BAR; PG8_MMA(1, 0, At, B0); PG8_MMA(1, 1, At, B1); PG8_BAR; PG8_SCHED;
        }
        if constexpr (ALIGN_EPI) { if (wr == 0) PG8_BAR; }
        E(acc, pre, cur, wr, wc, fr, fq); S.done(cur);
        if (!has_next) break;
        E.init(acc, nxt, wr, wc, fr, fq); E.preload(pre, nxt, wr, fr, fq);
        cur = nxt; cA = nA; cB = nB; ++ui;
        if constexpr (ALIGN_EPI) { if (wr == 1) PG8_BAR; }
    }
    PG8_WAIT_V(0);
    if constexpr (!ALIGN_EPI) { if (wr == 0) PG8_BAR; }
    PG8_BAR;
#undef PG8_SA
#undef PG8_SB
#undef PG8_STAGE
#undef PG8_LDA
#undef PG8_LDB
#undef PG8_MMA
#undef PG8_WAIT_V
#undef PG8_WAIT_L
#undef PG8_BAR
#undef PG8_SCHED
}

#define EPI_ROW0 (u.pm * BM + wr * 64 + fr)
#define EPI_FOR_AI_M _Pragma("unroll") for (int ai = 0; ai < 2; ++ai) _Pragma("unroll") for (int m = 0; m < 4; ++m)
__device__ __forceinline__ u32x4 pack_f4x2(f32x4 v0, f32x4 v1) { u32x4 w; w.x = cvt_pk_bf16(v0[0], v0[1]); w.y = cvt_pk_bf16(v0[2], v0[3]); w.z = cvt_pk_bf16(v1[0], v1[1]); w.w = cvt_pk_bf16(v1[2], v1[3]); return w; }
__device__ __forceinline__ void unpack_f4x2(u32x4 w, f32x4& v0, f32x4& v1) { v0[0] = bf_lo(w.x); v0[1] = bf_hi(w.x); v0[2] = bf_lo(w.y); v0[3] = bf_hi(w.y); v1[0] = bf_lo(w.z); v1[1] = bf_hi(w.z); v1[2] = bf_lo(w.w); v1[3] = bf_hi(w.w); }
__device__ __forceinline__ unsigned ror8(unsigned x) { return (unsigned)__builtin_amdgcn_update_dpp(0, (int)x, 0x128, 0xF, 0xF, true); }
__device__ __forceinline__ void st_pair(char* grp, size_t pitch, int fr, int fq, u32x4 vA, u32x4 vB) {
    const bool lo = fr < 8;
    u32x4 snd = lo ? vB : vA, rcv; rcv.x = ror8(snd.x); rcv.y = ror8(snd.y); rcv.z = ror8(snd.z); rcv.w = ror8(snd.w);
    char* p = grp + (size_t)(fr & 7) * pitch + (lo ? 0 : 64) + fq * 16;
    *(u32x4*)p = lo ? vA : rcv;
    *(u32x4*)(p + 8 * pitch) = lo ? rcv : vB;
}
__device__ __forceinline__ u32x4 as_u4(f32x4 v) { return __builtin_bit_cast(u32x4, v); }

__device__ __forceinline__ float rstd_raw(ss_t v) { return __builtin_amdgcn_rsqf((float)v * (1.0f / (256.0f * DM)) + NORM_EPS); }
__device__ __forceinline__ float rstd_of(const ss_t* SS, size_t row) { return rstd_raw(SS[row]); }
__device__ __forceinline__ ss_t ss_fix(float s) { return (ss_t)(s * 256.0f + 0.5f); }
__device__ __forceinline__ float sq8(f32x4 a, f32x4 b) { return (a.x * a.x + a.y * a.y) + (a.z * a.z + a.w * a.w) + (b.x * b.x + b.y * b.y) + (b.z * b.z + b.w * b.w); }
__device__ __forceinline__ void ss_add(ss_t* SS, size_t row, float s, int fq, int fr) { s += __uint_as_float((unsigned)__builtin_amdgcn_ds_swizzle((int)__float_as_uint(s), 0x401F));
    s += __uint_as_float((unsigned)__builtin_amdgcn_ds_bpermute((((fq ^ 2) << 4) + fr) << 2, (int)__float_as_uint(s)));
    if (fq == 0) __hip_atomic_fetch_add(SS + row, ss_fix(s), __ATOMIC_RELAXED, __HIP_MEMORY_SCOPE_AGENT); }
struct EpiNull { static constexpr bool PERM = true; EPI_NO_PRE EPI_ZERO_INIT __device__ __forceinline__ void operator()(const f32x4 (&acc)[2][2][4][2], const ss_t (&pre)[2], const Unit& u, int wr, int wc, int fr, int fq) const {
#pragma unroll
    for (int a = 0; a < 2; ++a)
#pragma unroll
        for (int b = 0; b < 2; ++b)
#pragma unroll
            for (int m = 0; m < 4; ++m)
#pragma unroll
                for (int n = 0; n < 2; ++n) asm volatile("" :: "v"(acc[a][b][m][n]));
} };
struct EpiProj { static constexpr bool PERM = true; EPI_ZERO_INIT
    bf16_t* O; const ss_t* SS; EPI_SS_PRE(SS)
    __device__ __forceinline__ void operator()(const f32x4 (&acc)[2][2][4][2], const ss_t (&pre)[2], const Unit& u, int wr, int wc, int fr, int fq) const {
        const bool sg = u.pn >= 18;
        EPI_FOR_AI_M { const size_t r0 = (size_t)(u.pm * BM + ai * HALF + wr * 64 + m * 16); char* grp = (char*)(O + r0 * ICP + u.pn * BM + 64 * wc); const float rs = rstd_raw(pre_get(pre, ai * 4 + m, fr));
            f32x4 a0 = acc[ai][0][m][0] * rs, a1 = acc[ai][0][m][1] * rs, b0 = acc[ai][1][m][0] * rs, b1 = acc[ai][1][m][1] * rs;
            if (sg) { a0 = sigmoid4(a0); a1 = sigmoid4(a1); b0 = sigmoid4(b0); b1 = sigmoid4(b1); }
            st_pair(grp, (size_t)ICP * 2, fr, fq, pack_f4x2(a0, a1), pack_f4x2(b0, b1)); }
    }
};
struct EpiBf16 { static constexpr bool PERM = true; EPI_NO_PRE EPI_ZERO_INIT
    bf16_t* O; int ldc;
    __device__ __forceinline__ void operator()(const f32x4 (&acc)[2][2][4][2], const ss_t (&pre)[2], const Unit& u, int wr, int wc, int fr, int fq) const {
        EPI_FOR_AI_M { char* grp = (char*)(O + (size_t)(u.pm * BM + ai * HALF + wr * 64 + m * 16) * ldc + u.pn * BM + 64 * wc);
            st_pair(grp, (size_t)ldc * 2, fr, fq, pack_f4x2(acc[ai][0][m][0], acc[ai][0][m][1]), pack_f4x2(acc[ai][1][m][0], acc[ai][1][m][1])); }
    }
};
struct EpiLora { static constexpr bool PERM = true; EPI_NO_PRE EPI_ZERO_INIT
    float* DEC; bf16_t* AA; bf16_t* GG; const float* w0; const float* a0;
    __device__ __forceinline__ void operator()(const f32x4 (&acc)[2][2][4][2], const ss_t (&pre)[2], const Unit& u, int wr, int wc, int fr, int fq) const {
        const int row0 = EPI_ROW0, kind = u.pn >> 2, ct = (u.pn & 3) * BM + 64 * wc, col0 = ct + 8 * fq;
        if (kind == 0) {
            EPI_FOR_AI_M { float* rowp = DEC + (size_t)(row0 + ai * HALF + m * 16) * RWD + col0;
#pragma unroll
                for (int bj = 0; bj < 2; ++bj)
#pragma unroll
                    for (int n = 0; n < 2; ++n) { const f32x4 b = *(const f32x4*)(w0 + col0 + bj * 32 + 4 * n); const f32x4 x = acc[ai][bj][m][n] + b; f32x4 o;
#pragma unroll
                        for (int j = 0; j < 4; ++j) { const float z = -x[j]; const float sp = z > 15.f ? z : __logf(1.0f + __expf(z)); const float w = -sp - 0.5f; o[j] = __expf(-__expf(w)); }
                        *(f32x4*)(rowp + bj * 32 + 4 * n) = o; } asm volatile("" ::: "memory"); }
        } else if (kind == 1) {
            const f32x4 b00 = *(const f32x4*)(a0 + col0), b01 = *(const f32x4*)(a0 + col0 + 4), b10 = *(const f32x4*)(a0 + col0 + 32), b11 = *(const f32x4*)(a0 + col0 + 36);
            EPI_FOR_AI_M { char* grp = (char*)(AA + (size_t)(u.pm * BM + ai * HALF + wr * 64 + m * 16) * RWD + ct);
                st_pair(grp, (size_t)RWD * 2, fr, fq, pack_f4x2(sigmoid4(acc[ai][0][m][0] + b00), sigmoid4(acc[ai][0][m][1] + b01)), pack_f4x2(sigmoid4(acc[ai][1][m][0] + b10), sigmoid4(acc[ai][1][m][1] + b11))); }
        } else {
            EPI_FOR_AI_M { char* grp = (char*)(GG + (size_t)(u.pm * BM + ai * HALF + wr * 64 + m * 16) * RWD + ct);
                st_pair(grp, (size_t)RWD * 2, fr, fq, pack_f4x2(acc[ai][0][m][0], acc[ai][0][m][1]), pack_f4x2(acc[ai][1][m][0], acc[ai][1][m][1])); }
        }
    }
};
struct EpiGate1 { static constexpr bool PERM = true; EPI_NO_PRE EPI_ZERO_INIT
    bf16_t* TMP; const bf16_t* PROJ; int gcol0;
    __device__ __forceinline__ void operator()(const f32x4 (&acc)[2][2][4][2], const ss_t (&pre)[2], const Unit& u, int wr, int wc, int fr, int fq) const {
        const int row0 = EPI_ROW0, ct = u.pn * BM + 64 * wc, col0 = ct + 8 * fq;
        EPI_FOR_AI_M { const size_t row = (size_t)(row0 + ai * HALF + m * 16);
            f32x4 g00, g01, g10, g11; unpack_f4x2(*(const u32x4*)(PROJ + row * ICP + gcol0 + col0), g00, g01); unpack_f4x2(*(const u32x4*)(PROJ + row * ICP + gcol0 + col0 + 32), g10, g11);
            st_pair((char*)(TMP + (size_t)(u.pm * BM + ai * HALF + wr * 64 + m * 16) * DM + ct), (size_t)DM * 2, fr, fq, pack_f4x2(acc[ai][0][m][0] * g00, acc[ai][0][m][1] * g01), pack_f4x2(acc[ai][1][m][0] * g10, acc[ai][1][m][1] * g11));
            if (m & 1) asm volatile("" ::: "memory"); }
    }
};
struct EpiGate2 { static constexpr bool PERM = true; EPI_NO_PRE EPI_ZERO_INIT
    const bf16_t* TMP; const bf16_t* PROJ; int gcol0; bf16_t* O;
    __device__ __forceinline__ void operator()(const f32x4 (&acc)[2][2][4][2], const ss_t (&pre)[2], const Unit& u, int wr, int wc, int fr, int fq) const {
        const int row0 = EPI_ROW0, ct = u.pn * BM + 64 * wc, col0 = ct + 8 * fq;
        EPI_FOR_AI_M { const size_t row = (size_t)(row0 + ai * HALF + m * 16);
            f32x4 g00, g01, g10, g11, t00, t01, t10, t11; unpack_f4x2(*(const u32x4*)(PROJ + row * ICP + gcol0 + col0), g00, g01); unpack_f4x2(*(const u32x4*)(PROJ + row * ICP + gcol0 + col0 + 32), g10, g11);
            unpack_f4x2(*(const u32x4*)(TMP + row * DM + col0), t00, t01); unpack_f4x2(*(const u32x4*)(TMP + row * DM + col0 + 32), t10, t11);
            st_pair((char*)(O + (size_t)(u.pm * BM + ai * HALF + wr * 64 + m * 16) * DM + ct), (size_t)DM * 2, fr, fq, pack_f4x2(t00 + acc[ai][0][m][0] * g00, t01 + acc[ai][0][m][1] * g01), pack_f4x2(t10 + acc[ai][1][m][0] * g10, t11 + acc[ai][1][m][1] * g11));
            if (m & 1) asm volatile("" ::: "memory"); }
    }
};
struct EpiResid { static constexpr bool PERM = true; EPI_NO_PRE
    bf16_t* XB; ss_t* SS;
    __device__ __forceinline__ void init(f32x4 (&acc)[2][2][4][2], const Unit& u, int wr, int wc, int fr, int fq) const {
        const int row0 = EPI_ROW0, col0 = u.pn * BM + 64 * wc + 8 * fq;
        EPI_FOR_AI_M { const bf16_t* rowp = XB + (size_t)(row0 + ai * HALF + m * 16) * DM + col0;
            unpack_f4x2(*(const u32x4*)rowp, acc[ai][0][m][0], acc[ai][0][m][1]); unpack_f4x2(*(const u32x4*)(rowp + 32), acc[ai][1][m][0], acc[ai][1][m][1]); }
    }
    __device__ __forceinline__ void operator()(const f32x4 (&acc)[2][2][4][2], const ss_t (&pre)[2], const Unit& u, int wr, int wc, int fr, int fq) const {
        EPI_FOR_AI_M { const size_t r0 = (size_t)(u.pm * BM + ai * HALF + wr * 64 + m * 16);
            st_pair((char*)(XB + r0 * DM + u.pn * BM + 64 * wc), (size_t)DM * 2, fr, fq, pack_f4x2(acc[ai][0][m][0], acc[ai][0][m][1]), pack_f4x2(acc[ai][1][m][0], acc[ai][1][m][1]));
            ss_add(SS, r0 + fr, sq8(acc[ai][0][m][0], acc[ai][0][m][1]) + sq8(acc[ai][1][m][0], acc[ai][1][m][1]), fq, fr); }
    }
};
struct EpiSwiglu { static constexpr bool PERM = true; EPI_ZERO_INIT
    bf16_t* H; const ss_t* SS; EPI_SS_PRE(SS)
    __device__ __forceinline__ void operator()(const f32x4 (&acc)[2][2][4][2], const ss_t (&pre)[2], const Unit& u, int wr, int wc, int fr, int fq) const {
        const int row0 = EPI_ROW0, col0 = u.pn * HALF + wc * 32 + 8 * fq;
        EPI_FOR_AI_M { const size_t row = (size_t)(row0 + ai * HALF + m * 16); const float rs = rstd_raw(pre_get(pre, ai * 4 + m, fr));
            const f32x4 g0 = acc[ai][0][m][0] * rs, g1 = acc[ai][0][m][1] * rs, u0 = acc[ai][1][m][0] * rs, u1 = acc[ai][1][m][1] * rs;
            *(u32x4*)(H + row * FF + col0) = pack_f4x2(g0 * sigmoid4(g0) * u0, g1 * sigmoid4(g1) * u1); }
    }
};
struct EpiPle { static constexpr bool PERM = true; EPI_ZERO_INIT EPI_SS_PRE(SSi)
    const bf16_t* XB; bf16_t* XO; const bf16_t* PP; const ss_t* SSi; ss_t* SSo;
    __device__ __forceinline__ void operator()(const f32x4 (&acc)[2][2][4][2], const ss_t (&pre)[2], const Unit& u, int wr, int wc, int fr, int fq) const {
        const int col0 = u.pn * BM + 64 * wc + 8 * fq;
        EPI_FOR_AI_M { const size_t r0 = (size_t)(u.pm * BM + ai * HALF + wr * 64 + m * 16), row = r0 + fr; const float rs = rstd_raw(pre_get(pre, ai * 4 + m, fr));
            f32x4 x00, x01, x10, x11, p00, p01, p10, p11; unpack_f4x2(*(const u32x4*)(XB + row * DM + col0), x00, x01); unpack_f4x2(*(const u32x4*)(XB + row * DM + col0 + 32), x10, x11);
            unpack_f4x2(*(const u32x4*)(PP + row * DM + col0), p00, p01); unpack_f4x2(*(const u32x4*)(PP + row * DM + col0 + 32), p10, p11);
            x00 += sigmoid4(acc[ai][0][m][0] * rs) * p00; x01 += sigmoid4(acc[ai][0][m][1] * rs) * p01; x10 += sigmoid4(acc[ai][1][m][0] * rs) * p10; x11 += sigmoid4(acc[ai][1][m][1] * rs) * p11;
            st_pair((char*)(XO + r0 * DM + u.pn * BM + 64 * wc), (size_t)DM * 2, fr, fq, pack_f4x2(x00, x01), pack_f4x2(x10, x11));
            ss_add(SSo, row, sq8(x00, x01) + sq8(x10, x11), fq, fr);
            if (m & 1) asm volatile("" ::: "memory"); }
    }
};
#undef EPI_ROW0
#undef EPI_FOR_AI_M
}

constexpr size_t MiB = 1u << 20;
constexpr size_t al1m(size_t x) { return (x + MiB - 1) / MiB * MiB; }
constexpr size_t WS_CTL = 0, CTL_ZERO_BYTES = 1 * MiB;
constexpr size_t SZ_WIN = (size_t)ICP * DM * 2, SZ_POOLW = (size_t)PWD * 256 * 2, SZ_LORA = (size_t)3072 * LK * 2, SZ_PPOOL = (size_t)DM * PWD * 2, SZ_PRWKV = (size_t)DM * RWD * 2,
                 SZ_WOUT = (size_t)DM * DM * 2, SZ_WGU = (size_t)2 * FF * DM * 2, SZ_WDN = (size_t)DM * FF * 2, SZ_WPG = (size_t)DM * DM * 2, SZ_WPP = (size_t)DM * PLE * 2;
constexpr size_t WS_WIN = 1 * MiB, WS_POOLW = WS_WIN + SZ_WIN, WS_LORA = WS_POOLW + SZ_POOLW, WS_PPOOL = WS_LORA + SZ_LORA, WS_PRWKV = WS_PPOOL + SZ_PPOOL, WS_WOUT = WS_PRWKV + SZ_PRWKV,
                 WS_WGU = WS_WOUT + SZ_WOUT, WS_WDN = WS_WGU + SZ_WGU, WS_WPG = WS_WDN + SZ_WDN, WS_WPP = WS_WPG + SZ_WPG, WS_WEND = WS_WPP + SZ_WPP;
constexpr size_t WS_PB = al1m(WS_WEND);
constexpr size_t WS_XN = al1m(WS_PB + (size_t)MT * PLE * 2);
constexpr size_t WS_AA = al1m(WS_XN + (size_t)MT * DM * 2);
constexpr size_t WS_GG = al1m(WS_AA + (size_t)MT * RWD * 2);
constexpr size_t WS_PP = al1m(WS_GG + (size_t)MT * RWD * 2);
constexpr size_t WS_PROJ = al1m(WS_PP + (size_t)MT * DM * 2);
constexpr size_t WS_HID = WS_PROJ;
constexpr size_t WS_D = al1m(WS_PROJ + (size_t)MT * ICP * 2);
constexpr size_t WS_LIN = al1m(WS_D + (size_t)MT * PWD * 2);
constexpr size_t WS_YA = al1m(WS_LIN + (size_t)MT * LK * 2);
constexpr size_t WS_DEC = al1m(WS_YA + (size_t)MT * PWD * 2);
constexpr size_t WS_BS = al1m(WS_DEC + (size_t)MT * RWD * 4);
constexpr size_t WS_Y = al1m(WS_BS + (size_t)MT * 16 * 4);
constexpr size_t SZ_BH = (size_t)MT * RWD * 2;
constexpr size_t WS_YB = al1m(WS_Y + (size_t)MT * RWD * 4);
constexpr size_t WS_TMP = al1m(WS_YB + SZ_BH);
constexpr size_t WS_MRG = al1m(WS_TMP + (size_t)MT * DM * 4);
constexpr size_t WS_SS = al1m(WS_MRG + (size_t)MT * DM * 2);
constexpr size_t WS_END_OLD = al1m(WS_MRG + (size_t)MT * DM * 2);
static_assert((size_t)MT * FF * 2 <= (size_t)MT * ICP * 2, "HID overlay");

constexpr size_t WS_XB2 = al1m(WS_SS + (size_t)3 * MT * 4);
constexpr size_t CBSZ = 12032, CB_P1T = 0, CB_RT = 2048, CB_BK = 4096, CB_VT = 8192, CB_P2T = 10240, CB_MBT = 10752, CB_MKT = 11264, CB_GC = 11776;
constexpr size_t CB_N = (size_t)(MT / 16) * 16;
static_assert(WS_MRG + (size_t)MT * DM * 2 - WS_TMP >= CB_N * CBSZ, "chunk blocks fit in TMP | MRG");
constexpr size_t WS_END = al1m(WS_XB2 + (size_t)MT * DM * 2);
constexpr int CW_BAR = 4096;
constexpr int NWAVES = 8, NTHR = 512;
constexpr int RING_BYTES = 131072, LDSCTL_OFF = RING_BYTES, LDS_BYTES = 147456;

#define XB_TMO      128
#define XB_XCNT(j)  (256  + 64 * (j))
#define XB_XSUB(j)  (1280 + 64 * (j))
#define XB_XGEN(j)  (2304 + 64 * (j))
#define XB_TOP      3328
#define XB_TOPGEN   3392
#define XCD_BAR_WORDS 3456
#define XB_SPIN_CAP (1u << 18)

__device__ __forceinline__ unsigned xb_ld(unsigned* p)              { return __hip_atomic_load(p, __ATOMIC_RELAXED, __HIP_MEMORY_SCOPE_AGENT); }
__device__ __forceinline__ unsigned xb_add(unsigned* p, unsigned v) { return __hip_atomic_fetch_add(p, v, __ATOMIC_RELAXED, __HIP_MEMORY_SCOPE_AGENT); }
__device__ __forceinline__ unsigned xb_xcc_id() { return (unsigned)__builtin_amdgcn_s_getreg((3 << 11) | 20) & 0xFu; }
#define XB_SPIN(cond, bar) do { unsigned _sp = 0; while (cond) { __builtin_amdgcn_s_sleep(1); \
    if ((++_sp & 255u) == 0u) { if (xb_ld(&(bar)[XB_TMO])) break; if (_sp > XB_SPIN_CAP) { atomicAdd(&(bar)[XB_TMO], 1u); break; } } } } while (0)

struct XcdBarrier {
    unsigned* bar; unsigned x;
    volatile LAS unsigned* st;
};

__device__ __forceinline__ XcdBarrier xcd_barrier_post(unsigned* bar, volatile LAS unsigned* st) {
    XcdBarrier b; b.bar = bar; b.x = xb_xcc_id(); b.st = st;
    if (threadIdx.x == 0) (void)xb_add(&bar[XB_XCNT(b.x)], 1u);
    return b;
}
__device__ __forceinline__ void xcd_barrier_complete(unsigned* bar, unsigned x, unsigned& nloc, unsigned& nx) {
    const unsigned G = gridDim.x * gridDim.y * gridDim.z;
    unsigned sum, cnt, mine, sp = 0u;
    for (;;) {
        sum = 0u; cnt = 0u; mine = 0u;
#pragma unroll
        for (unsigned j = 0; j < 16; ++j) { const unsigned c = xb_ld(&bar[XB_XCNT(j)]); sum += c; cnt += (c > 0u) ? 1u : 0u; mine = (j == x) ? c : mine; }
        if (sum == G) break;
        __builtin_amdgcn_s_sleep(1);
        if ((++sp & 255u) == 0u) { if (xb_ld(&bar[XB_TMO])) break; if (sp > XB_SPIN_CAP) { atomicAdd(&bar[XB_TMO], 1u); break; } }
    }
    nloc = mine > 0u ? mine : 1u; nx = cnt > 0u ? cnt : 1u;
}

__device__ __forceinline__ void xcd_barrier(const XcdBarrier& b) {
    asm volatile("s_waitcnt vmcnt(0)" ::: "memory");
    __syncthreads();
    if (threadIdx.x == 0) {
        unsigned* bar = b.bar;
        __builtin_amdgcn_s_waitcnt(0);
        unsigned nloc = b.st[0], nx = b.st[1];
        if (nloc == 0u) { xcd_barrier_complete(bar, b.x, nloc, nx); b.st[0] = nloc; b.st[1] = nx; }
        const unsigned old = xb_add(&bar[XB_XSUB(b.x)], 1u);
        const unsigned gen = old / nloc;
        if (old + 1u == (gen + 1u) * nloc) {
            __builtin_amdgcn_fence(__ATOMIC_RELEASE, "agent");
            asm volatile("s_waitcnt vmcnt(0)" ::: "memory");
            const unsigned og = xb_add(&bar[XB_TOP], 1u);
            const unsigned tg = og / nx;
            if (og + 1u == (tg + 1u) * nx) xb_add(&bar[XB_TOPGEN], 1u);
            else XB_SPIN(xb_ld(&bar[XB_TOPGEN]) == tg, bar);
            __builtin_amdgcn_fence(__ATOMIC_ACQUIRE, "agent");
            xb_add(&bar[XB_XGEN(b.x)], 1u);
            asm volatile("s_waitcnt vmcnt(0)" ::: "memory");
        } else {
            XB_SPIN(xb_ld(&bar[XB_XGEN(b.x)]) == gen, bar);
            __builtin_amdgcn_fence(__ATOMIC_ACQUIRE, "agent");
            asm volatile("s_waitcnt vmcnt(0)" ::: "memory");
        }
    }
    __syncthreads();
}


struct Args {
    const float* in[33]; float* out; unsigned char* ws; int ph_lo, ph_hi;
};
struct Frame {
    LAS unsigned char* lds; int G;
    const LAS unsigned long long* ptab; float* out; unsigned char* ws;
};
#define GAS __attribute__((address_space(1)))
__device__ __forceinline__ const float* ldptr(const LAS unsigned long long* tab, int k) { const unsigned long long v = tab[k]; const unsigned lo = __builtin_amdgcn_readfirstlane((unsigned)v), hi = __builtin_amdgcn_readfirstlane((unsigned)(v >> 32));
    return (const float*)(const GAS float*)(((unsigned long long)hi << 32) | lo); }
__device__ __forceinline__ unsigned char* fresh(unsigned char* p) { GAS unsigned char* q = (GAS unsigned char*)p; asm volatile("" : "+s"(q)); return (unsigned char*)q; }
__device__ __forceinline__ int fresh_i(int v) { asm volatile("" : "+s"(v)); return v; }
#define INP(k) ldptr(F.ptab, (k))
#define PHASE_L const int l = fresh_i(l_in); (void)l;
#define PHASE_IDS int tid_ = threadIdx.x; asm volatile("" : "+v"(tid_)); const int tid = tid_, lane = tid & 63, wave = __builtin_amdgcn_readfirstlane(tid >> 6), gtid = blockIdx.x * NTHR + tid, gw = blockIdx.x * NWAVES + wave; (void)lane; (void)wave; (void)gtid; (void)gw;
#define VM_WAIT() asm volatile("s_waitcnt vmcnt(0)" ::: "memory")
#define LDS_WAIT() asm volatile("s_waitcnt lgkmcnt(0)" ::: "memory")
constexpr int NT_ALL_SHIFT = 9;

__device__ __forceinline__ void row_info(int m, int& b, int& t, bool& samp) { samp = m >= MPR; if (samp) { b = (m - MPR) >> 6; t = (m - MPR) & 63; } else { b = m >> 11; t = m & 2047; } }

__device__ __forceinline__ void transpose_item(const float* W, int N, bf16_t* WT, int ldk, int k0, int n0, int drow0, LAS float* scr, int lane, const float* cscale = nullptr, const float* rscale = nullptr) {
    f32x4 cs = (f32x4){1.f, 1.f, 1.f, 1.f}; if (cscale) cs = *(const f32x4*)(cscale + n0 + 4 * (lane & 7));
    const int c = lane & 7;
    f32x4 g0 = (f32x4){1.f, 1.f, 1.f, 1.f}, g1 = g0;
    if (rscale) { g0 = *(const f32x4*)(rscale + k0 + 8 * c); g1 = *(const f32x4*)(rscale + k0 + 8 * c + 4); }
    f32x4 v[8];
#pragma unroll
    for (int i = 0; i < 8; ++i) v[i] = *(const f32x4*)(W + (size_t)(k0 + 8 * i + (lane >> 3)) * N + n0 + 4 * (lane & 7));
#pragma unroll
    for (int i = 0; i < 8; ++i) { LAS float* d = scr + (8 * i + (lane >> 3)) * 33 + 4 * (lane & 7); const f32x4 t = v[i] * cs; d[0] = t.x; d[1] = t.y; d[2] = t.z; d[3] = t.w; }
    LDS_WAIT(); asm volatile("" ::: "memory");
#pragma unroll
    for (int j = 0; j < 4; ++j) { const int n = (lane >> 3) + 8 * j; const LAS float* sp = scr + (8 * c) * 33 + n;
        u32x4 o; o.x = cvt_pk_bf16(sp[0 * 33] * g0.x, sp[1 * 33] * g0.y); o.y = cvt_pk_bf16(sp[2 * 33] * g0.z, sp[3 * 33] * g0.w); o.z = cvt_pk_bf16(sp[4 * 33] * g1.x, sp[5 * 33] * g1.y); o.w = cvt_pk_bf16(sp[6 * 33] * g1.z, sp[7 * 33] * g1.w);
        *(u32x4*)(WT + (size_t)(drow0 + n) * ldk + k0 + 8 * c) = o; }
    LDS_WAIT(); asm volatile("" ::: "memory");
}
__device__ __forceinline__ void convert_weights(Frame& F, int l_in) {
    PHASE_IDS
    unsigned char* const wsl = fresh(F.ws);
    PHASE_L
    LAS float* scr = (LAS float*)(F.lds + wave * 16384);
    const int NGW = fresh_i(F.G) * NWAVES;
    unsigned char* ws = wsl;
    constexpr int I_WIN = (DM / 64) * (ICOLS / 32), I_PW = 4 * (256 / 64) * (256 / 32), I_PP = (PWD / 64) * (DM / 32), I_WO = (DM / 64) * (DM / 32), I_FG = (DM / 64) * (FF / 32),
                  I_FD = (FF / 64) * (DM / 32), I_PL = (PLE / 64) * (DM / 32);
    constexpr int NITEMS = I_WIN + I_PW + 2 * I_PP + I_WO + 2 * I_FG + I_FD + I_WO + I_PL;
    for (int it = gw; it < NITEMS; it += NGW) {
        int r = it;
        if (r < I_WIN) { const int nblk = ICOLS / 32, kb = r / nblk, nb = r % nblk, n0 = nb * 32; transpose_item(INP(8) + (size_t)l * DM * ICOLS, ICOLS, (bf16_t*)(ws + WS_WIN), DM, kb * 64, n0, n0 < 4384 ? n0 : n0 + 224, scr, lane, nullptr, INP(7) + (size_t)l * DM); continue; } r -= I_WIN;
        if (r < I_PW) { const int g = r >> 5, rr = r & 31, kb = rr >> 3, nb = rr & 7; transpose_item(INP(10) + ((size_t)l * 4 + g) * 65536, 256, (bf16_t*)(ws + WS_POOLW) + (size_t)g * 65536, 256, kb * 64, nb * 32, nb * 32, scr, lane, INP(11) + (size_t)l * PWD + g * 256); continue; } r -= I_PW;
        if (r < I_PP) { const int nblk = DM / 32, kb = r / nblk, nb = r % nblk; transpose_item(INP(22) + (size_t)l * PWD * DM, DM, (bf16_t*)(ws + WS_PPOOL), PWD, kb * 64, nb * 32, nb * 32, scr, lane); continue; } r -= I_PP;
        if (r < I_PP) { const int nblk = DM / 32, kb = r / nblk, nb = r % nblk; transpose_item(INP(23) + (size_t)l * RWD * DM, DM, (bf16_t*)(ws + WS_PRWKV), RWD, kb * 64, nb * 32, nb * 32, scr, lane); continue; } r -= I_PP;
        if (r < I_WO) { const int nblk = DM / 32, kb = r / nblk, nb = r % nblk; transpose_item(INP(24) + (size_t)l * DM * DM, DM, (bf16_t*)(ws + WS_WOUT), DM, kb * 64, nb * 32, nb * 32, scr, lane); continue; } r -= I_WO;
        if (r < I_FG) { const int nblk = FF / 32, kb = r / nblk, nb = r % nblk, n0 = nb * 32; transpose_item(INP(26) + (size_t)l * DM * FF, FF, (bf16_t*)(ws + WS_WGU), DM, kb * 64, n0, 256 * (n0 >> 7) + 64 * ((n0 & 127) >> 5), scr, lane, nullptr, INP(25) + (size_t)l * DM); continue; } r -= I_FG;
        if (r < I_FG) { const int nblk = FF / 32, kb = r / nblk, nb = r % nblk, n0 = nb * 32; transpose_item(INP(27) + (size_t)l * DM * FF, FF, (bf16_t*)(ws + WS_WGU), DM, kb * 64, n0, 256 * (n0 >> 7) + 64 * ((n0 & 127) >> 5) + 32, scr, lane, nullptr, INP(25) + (size_t)l * DM); continue; } r -= I_FG;
        if (r < I_FD) { const int nblk = DM / 32, kb = r / nblk, nb = r % nblk; transpose_item(INP(28) + (size_t)l * FF * DM, DM, (bf16_t*)(ws + WS_WDN), FF, kb * 64, nb * 32, nb * 32, scr, lane); continue; } r -= I_FD;
        if (r < I_WO) { const int nblk = DM / 32, kb = r / nblk, nb = r % nblk; transpose_item(INP(30) + (size_t)l * DM * DM, DM, (bf16_t*)(ws + WS_WPG), DM, kb * 64, nb * 32, nb * 32, scr, lane, nullptr, INP(29) + (size_t)l * DM); continue; } r -= I_WO;
        { const int nblk = DM / 32, kb = r / nblk, nb = r % nblk; transpose_item(INP(31) + (size_t)l * PLE * DM, DM, (bf16_t*)(ws + WS_WPP), PLE, kb * 64, nb * 32, nb * 32, scr, lane); }
    }
    const int NT = fresh_i(F.G) * NTHR;
    { u32x4* z = (u32x4*)((bf16_t*)(ws + WS_WIN) + (size_t)4384 * DM); for (int i = gtid; i < 224 * DM * 2 / 16; i += NT) z[i] = (u32x4){0u, 0u, 0u, 0u}; }
    { bf16_t* LT = (bf16_t*)(ws + WS_LORA); const float* wd = INP(13) + (size_t)l * 64 * RWD; const float* wa = INP(15) + (size_t)l * 64 * RWD; const float* wg = INP(16) + (size_t)l * 160 * RWD;
      for (int i = gtid; i < 3072 * (LK / 8); i += NT) { const int n = i / (LK / 8), k0 = (i % (LK / 8)) * 8; const int kind = n >> 10, c = n & 1023; float f[8];
#pragma unroll
          for (int j = 0; j < 8; ++j) { const int k = k0 + j; float v = 0.f;
              if (kind == 0) { if (k < 64) v = wd[(size_t)k * RWD + c]; }
              else if (kind == 1) { if (k >= 64 && k < 128) v = wa[(size_t)(k - 64) * RWD + c]; }
              else { if (k >= 128 && k < 288) v = wg[(size_t)(k - 128) * RWD + c]; }
              f[j] = v; }
          *(u32x4*)(LT + (size_t)n * LK + k0) = pack8(f); } }
    { bf16_t* PB = (bf16_t*)(ws + WS_PB); const float* pp = INP(5) + (size_t)l * MPR * PLE; const float* ps = INP(6) + (size_t)l * (MT - MPR) * PLE;
      for (int i = gtid; i < MT * PLE / 8; i += NT) { const size_t e = (size_t)i * 8; const float* src = e < (size_t)MPR * PLE ? pp + e : ps + (e - (size_t)MPR * PLE);
          const f32x4 a = *(const f32x4*)src, b = *(const f32x4*)(src + 4); *(u32x4*)(PB + e) = pg8::pack_f4x2(a, b); } }
}

__device__ __forceinline__ void xb_from_input(Frame& F) {
    PHASE_IDS
    unsigned char* const wsl = fresh(F.ws);
    const int NGW = fresh_i(F.G) * NWAVES; bf16_t* XB = (bf16_t*)(wsl + WS_XN); pg8::ss_t* SS = (pg8::ss_t*)(wsl + WS_SS);
    for (int m = gw; m < MT; m += NGW) {
        const float* src = m < MPR ? INP(0) + (size_t)m * DM : INP(1) + (size_t)(m - MPR) * DM;
        f32x4 v[8]; float s = 0.f;
#pragma unroll
        for (int j = 0; j < 8; ++j) { v[j] = *(const f32x4*)(src + 4 * lane + 256 * j); s += (v[j].x * v[j].x + v[j].y * v[j].y) + (v[j].z * v[j].z + v[j].w * v[j].w); }
        s = wave_sum(s);
        if (lane == 0) SS[m] = pg8::ss_fix(s);
#pragma unroll
        for (int j = 0; j < 8; ++j) { u32x2 w; w.x = cvt_pk_bf16(v[j].x, v[j].y); w.y = cvt_pk_bf16(v[j].z, v[j].w); *(u32x2*)(XB + (size_t)m * DM + 4 * lane + 256 * j) = w; }
    }
}
__device__ __forceinline__ void final_norm(Frame& F, const float* gain) {
    PHASE_IDS
    unsigned char* const wsl = fresh(F.ws);
    const int NGW = fresh_i(F.G) * NWAVES; const bf16_t* XB = (const bf16_t*)(wsl + ((NL & 1) ? WS_XB2 : WS_XN));
    f32x4 g[8];
#pragma unroll
    for (int j = 0; j < 8; ++j) g[j] = *(const f32x4*)(gain + 4 * lane + 256 * j);
    for (int m = gw; m < MT; m += NGW) {
        f32x4 v[8]; float s = 0.f;
#pragma unroll
        for (int j = 0; j < 8; ++j) { const u32x2 w = *(const u32x2*)(XB + (size_t)m * DM + 4 * lane + 256 * j); v[j] = (f32x4){bf_lo(w.x), bf_hi(w.x), bf_lo(w.y), bf_hi(w.y)};
            s += (v[j].x * v[j].x + v[j].y * v[j].y) + (v[j].z * v[j].z + v[j].w * v[j].w); }
        const float rstd = __builtin_amdgcn_rsqf(wave_sum(s) * (1.0f / DM) + NORM_EPS);
#pragma unroll
        for (int j = 0; j < 8; ++j) *(f32x4*)(F.out + (size_t)m * DM + 4 * lane + 256 * j) = v[j] * rstd * g[j];
    }
}

__device__ __forceinline__ void load_z(float (&z)[8], const bf16_t* PROJ, const float* past, int m0, int t, bool samp, int c0) {
    if (t >= 0) { unpack8(*(const u32x4*)(PROJ + (size_t)(m0 + t) * ICP + c0), z); }
    else if (samp) { const float* p = past + (size_t)(15 + t) * PWD + c0; const f32x4 a = *(const f32x4*)p, b = *(const f32x4*)(p + 4); z[0] = a.x; z[1] = a.y; z[2] = a.z; z[3] = a.w; z[4] = b.x; z[5] = b.y; z[6] = b.z; z[7] = b.w; }
    else {
#pragma unroll
        for (int j = 0; j < 8; ++j) z[j] = 0.f; }
}
__device__ __forceinline__ void prep1_phase(Frame& F, int l_in) {
    PHASE_IDS
    unsigned char* const wsl = fresh(F.ws);
    PHASE_L
    const int NT = fresh_i(F.G) * NTHR; const bf16_t* PROJ = (const bf16_t*)(wsl + WS_PROJ);
    { bf16_t* D = (bf16_t*)(wsl + WS_D);
      for (int it = gtid; it < (MT / 16) * 128; it += NT) {
          const int oct = it & 127, run = it >> 7, mrow = run * 16, c0 = oct * 8, win = 2 << (c0 >> 8);
          int b, t0; bool samp; row_info(mrow, b, t0, samp);
          const int T = samp ? TS : TP, mseq = mrow - t0;
          const float* past = INP(3) + ((size_t)l * 8 + b) * 15 * PWD;
          float* npool = F.out + (samp ? O_POS : O_POP) + ((size_t)l * 8 + b) * 15 * PWD;
          float S[8], z[8];
#pragma unroll
          for (int j = 0; j < 8; ++j) S[j] = 0.f;
          for (int j = 1; j < win; ++j) { load_z(z, PROJ, past, mseq, t0 - j, samp, c0);
#pragma unroll
              for (int q = 0; q < 8; ++q) S[q] += z[q]; }
          for (int i = 0; i < 16; ++i) { const int t = t0 + i; float cur[8]; load_z(cur, PROJ, past, mseq, t, samp, c0);
              const int cnt = samp ? win : (t + 1 < win ? t + 1 : win); const float inv = 1.0f / (float)cnt; float d[8];
#pragma unroll
              for (int q = 0; q < 8; ++q) { S[q] += cur[q]; d[q] = S[q] * inv - cur[q]; }
              *(u32x4*)(D + (size_t)(mseq + t) * PWD + c0) = pack8(d);
              if (t >= T - 15) { float* o = npool + (size_t)(t - (T - 15)) * PWD + c0; *(f32x4*)o = (f32x4){cur[0], cur[1], cur[2], cur[3]}; *(f32x4*)(o + 4) = (f32x4){cur[4], cur[5], cur[6], cur[7]}; }
              load_z(z, PROJ, past, mseq, t - win + 1, samp, c0);
#pragma unroll
              for (int q = 0; q < 8; ++q) S[q] -= z[q]; }
      } }
    { bf16_t* LIN = (bf16_t*)(wsl + WS_LIN); const float* mu = INP(9) + (size_t)l * RPJ + 3072;
      for (int it = gtid; it < MT * (LK / 8); it += NT) {
          const int m = it / (LK / 8), c0 = (it % (LK / 8)) * 8; float o[8];
          if (c0 >= 288) {
#pragma unroll
              for (int j = 0; j < 8; ++j) o[j] = 0.f;
          } else {
              int b, t; bool samp; row_info(m, b, t, samp);
              float cur[8], prv[8]; unpack8(*(const u32x4*)(PROJ + (size_t)m * ICP + 4096 + c0), cur);
              if (t > 0) unpack8(*(const u32x4*)(PROJ + (size_t)(m - 1) * ICP + 4096 + c0), prv);
              else if (samp) { const float* p = INP(2) + ((size_t)l * 8 + b) * RPJ + 3072 + c0;
#pragma unroll
                  for (int j = 0; j < 8; ++j) prv[j] = p[j]; }
              else {
#pragma unroll
                  for (int j = 0; j < 8; ++j) prv[j] = 0.f; }
#pragma unroll
              for (int j = 0; j < 8; ++j) { const float xm = cur[j] + (prv[j] - cur[j]) * mu[c0 + j]; o[j] = c0 < 64 ? tanhf_(xm) : (c0 < 128 ? xm : sigmoidf_(xm)); }
          }
          *(u32x4*)(LIN + (size_t)m * LK + c0) = pack8(o);
      } }
    { pg8::ss_t* SS = (pg8::ss_t*)(wsl + WS_SS); for (int i = gtid; i < 3 * MT; i += NT) SS[i] = 0u; }
    for (int it = gtid; it < 16 * RPJ; it += NT) { const int s = it / RPJ, c = it % RPJ; const int mlast = s < 8 ? s * TP + TP - 1 : MPR + (s - 8) * TS + TS - 1;
        F.out[(s < 8 ? O_SHP : O_SHS) + ((size_t)l * 8 + (s & 7)) * RPJ + c] = __uint_as_float((unsigned)PROJ[(size_t)mlast * ICP + 1024 + c] << 16); }
}

__device__ __forceinline__ unsigned char* cb_ptr(unsigned char* ws, size_t i) { return ws + WS_TMP + i * CBSZ; }
__device__ __forceinline__ f32x4 mfma16(bf16x8 a, bf16x8 b, f32x4 c) { return __builtin_amdgcn_mfma_f32_16x16x32_bf16(a, b, c, 0, 0, 0); }
__device__ __forceinline__ bf16x8 mk8(u32x2 lo, u32x2 hi) { u32x4 w = (u32x4){lo.x, lo.y, hi.x, hi.y}; return __builtin_bit_cast(bf16x8, w); }
typedef __bf16 bf16x2_c __attribute__((ext_vector_type(2)));
__device__ __forceinline__ unsigned cvt_pk_c(float lo, float hi) { const f32x2 v = (f32x2){lo, hi}; const bf16x2_c b = __builtin_convertvector(v, bf16x2_c); return __builtin_bit_cast(unsigned, b); }
__device__ __forceinline__ u32x2 pk4(f32x4 v) { return (u32x2){cvt_pk_c(v.x, v.y), cvt_pk_c(v.z, v.w)}; }
__device__ __forceinline__ unsigned short bf1(float f) { return (unsigned short)(cvt_pk_c(f, 0.f) & 0xffffu); }

__device__ __forceinline__ void spre_phase(Frame& F, int l_in) {
    PHASE_IDS
    unsigned char* const wsl = fresh(F.ws);
    PHASE_L
    const int NGW = fresh_i(F.G) * NWAVES;
    LAS unsigned char* L = F.lds + wave * 16384;
    const bf16_t* PROJ = (const bf16_t*)(wsl + WS_PROJ); const bf16_t* AA = (const bf16_t*)(wsl + WS_AA); const float* DEC = (const float*)(wsl + WS_DEC); float* BS = (float*)(wsl + WS_BS);
    const int fr = lane & 15, fq = lane >> 4;
    const float* mu = INP(9) + (size_t)l * RPJ;
#define SP_LOAD(it_, R, K, V, A, W, PR, PK, PV) do { const int h_ = (it_) & 15, m0_ = ((it_) >> 4) * 16, ch_ = h_ * 64 + lane; int b_, t0_; bool samp_; row_info(m0_, b_, t0_, samp_); \
        _Pragma("unroll") for (int t = 0; t < 16; ++t) { const size_t mm = (size_t)(m0_ + t); const bf16_t* pc = PROJ + mm * ICP + 1024 + ch_; R[t] = pc[0]; K[t] = pc[1024]; V[t] = pc[2048]; A[t] = AA[mm * RWD + ch_]; W[t] = DEC[mm * RWD + ch_]; } \
        if (t0_ > 0) { const bf16_t* pc = PROJ + (size_t)(m0_ - 1) * ICP + 1024 + ch_; PR = __uint_as_float((unsigned)pc[0] << 16); PK = __uint_as_float((unsigned)pc[1024] << 16); PV = __uint_as_float((unsigned)pc[2048] << 16); } \
        else if (samp_) { const float* sp = INP(2) + ((size_t)l * 8 + b_) * RPJ + ch_; PR = sp[0]; PK = sp[1024]; PV = sp[2048]; } \
        else { PR = 0.f; PK = 0.f; PV = 0.f; } } while (0)
    unsigned short cr[16], ck[16], cv[16], ca[16], nr[16], nk[16], nv[16], na[16]; float cw[16], nw[16]; float pr = 0.f, pk = 0.f, pv = 0.f, npr = 0.f, npk = 0.f, npv = 0.f;
    if (gw < (int)CB_N) SP_LOAD(gw, cr, ck, cv, ca, cw, pr, pk, pv);
    for (int it = gw; it < (int)CB_N; it += NGW) {
        const int h = it & 15, crow = it >> 4, m0 = crow * 16, ch = h * 64 + lane;
        unsigned char* cb = cb_ptr(wsl, (size_t)it);
        const float mur = mu[ch], muk = mu[1024 + ch], muv = mu[2048 + ch];
        const float ckk = (INP(17) + (size_t)l * RWD)[ch], cka = (INP(18) + (size_t)l * RWD)[ch], crk = (INP(19) + (size_t)l * RWD)[ch];
        { const int itn = it + NGW; if (itn < (int)CB_N) SP_LOAD(itn, nr, nk, nv, na, nw, npr, npk, npv); }
        float g = 1.0f; unsigned at2[8], bt2[8], kt2[8], vt2[8]; float hold_a = 0.f, hold_b = 0.f, hold_k = 0.f, hold_v = 0.f;
#pragma unroll
        for (int t = 0; t < 16; ++t) {
            const float xr = __uint_as_float((unsigned)cr[t] << 16), xk = __uint_as_float((unsigned)ck[t] << 16), xv = __uint_as_float((unsigned)cv[t] << 16), av = __uint_as_float((unsigned)ca[t] << 16);
            const float r = xr + (pr - xr) * mur, kx = xk + (pk - xk) * muk, vv = xv + (pv - xv) * muv; pr = xr; pk = xk; pv = xv;
            float kkv = kx * ckk; const float ss = wave_sum(kkv * kkv); kkv *= __builtin_amdgcn_rsqf(fmaxf(ss, 1e-24f));
            const float kh = kx * (1.0f + (av - 1.0f) * cka), bb = kkv * av; const float bsum = wave_sum(r * kh * crk);
            if (lane == 0) BS[(size_t)(m0 + t) * 16 + h] = bsum;
            const float a_t = -kkv * g; g *= cw[t]; const float ig = __builtin_amdgcn_rcpf(g); const float b_t = bb * ig, k_t = kh * ig, r_t = r * g;
            *(LAS unsigned short*)(L + t * 144 + lane * 2) = bf1(a_t); *(LAS unsigned short*)(L + 2304 + t * 144 + lane * 2) = bf1(b_t);
            *(LAS unsigned short*)(L + 4608 + t * 144 + lane * 2) = bf1(k_t); *(LAS unsigned short*)(L + 6912 + t * 144 + lane * 2) = bf1(r_t);
            if (t & 1) { at2[t >> 1] = cvt_pk_c(hold_a, a_t); bt2[t >> 1] = cvt_pk_c(hold_b, b_t); kt2[t >> 1] = cvt_pk_c(hold_k, k_t); vt2[t >> 1] = cvt_pk_c(hold_v, vv); }
            else { hold_a = a_t; hold_b = b_t; hold_k = k_t; hold_v = vv; }
        }
        *(LAS u32x4*)(L + 9216 + lane * 32) = (u32x4){at2[0], at2[1], at2[2], at2[3]}; *(LAS u32x4*)(L + 9216 + lane * 32 + 16) = (u32x4){at2[4], at2[5], at2[6], at2[7]};
        { u32x4* o = (u32x4*)(cb + CB_BK + lane * 64);
#pragma unroll
          for (int q = 0; q < 4; ++q) o[q] = (u32x4){bt2[2 * q], bt2[2 * q + 1], kt2[2 * q], kt2[2 * q + 1]}; }
        { u32x4* o = (u32x4*)(cb + CB_VT + lane * 32); o[0] = (u32x4){vt2[0], vt2[1], vt2[2], vt2[3]}; o[1] = (u32x4){vt2[4], vt2[5], vt2[6], vt2[7]}; }
        *(float*)(cb + CB_GC + lane * 4) = g;
        asm volatile("" ::: "memory");
#define SP_ROWS(off, j) (*(const LAS bf16x8*)(L + (off) + fr * 144 + (j) * 64 + fq * 16))
        f32x4 nD = (f32x4){0.f, 0.f, 0.f, 0.f}, makD = nD, mrbD = nD, mrkD = nD;
#pragma unroll
        for (int j = 0; j < 2; ++j) { const bf16x8 fa = SP_ROWS(0, j), fb = SP_ROWS(2304, j), fk = SP_ROWS(4608, j), fR = SP_ROWS(6912, j);
            nD = mfma16(fb, fa, nD); makD = mfma16(fk, fa, makD); mrbD = mfma16(fb, fR, mrbD); mrkD = mfma16(fk, fR, mrkD); }
#pragma unroll
        for (int rr = 0; rr < 4; ++rr) { const int s = 4 * fq + rr; if (s >= fr) { nD[rr] = 0.f; makD[rr] = 0.f; } if (s > fr) { mrbD[rr] = 0.f; mrkD[rr] = 0.f; } }
        { const u32x2 mb = pk4(mrbD), mk = pk4(mrkD); *(u32x4*)(cb + CB_MBT + (fr * 4 + fq) * 16) = (u32x4){mb.x, mb.y, mk.x, mk.y}; }
#define SP_WR_RM(off, D) do { _Pragma("unroll") for (int rr = 0; rr < 4; ++rr) *(LAS unsigned short*)(L + (off) + (4 * fq + rr) * 32 + fr * 2) = bf1((D)[rr]); } while (0)
#define SP_WR_TR(off, D) do { *(LAS u32x2*)(L + (off) + fr * 32 + fq * 8) = pk4(D); } while (0)
#define SP_FRAG16(off) (fq < 2 ? *(const LAS bf16x8*)(L + (off) + fr * 32 + fq * 16) : (bf16x8){0, 0, 0, 0, 0, 0, 0, 0})
        SP_WR_RM(13568, nD); SP_WR_TR(14080, nD); SP_WR_RM(15616, makD); asm volatile("" ::: "memory");
        f32x4 TD = nD;
#pragma unroll
        for (int rr = 0; rr < 4; ++rr) if (4 * fq + rr == fr) TD[rr] += 1.0f;
#pragma unroll
        for (int itp = 0; itp < 3; ++itp) {
            SP_WR_RM(14592, TD); asm volatile("" ::: "memory");
            const f32x4 p2 = mfma16(SP_FRAG16(13568), SP_FRAG16(14080), (f32x4){0.f, 0.f, 0.f, 0.f}); asm volatile("" ::: "memory");
            SP_WR_RM(13568, p2); SP_WR_TR(14080, p2); asm volatile("" ::: "memory");
            TD = mfma16(SP_FRAG16(14592), SP_FRAG16(14080), TD); asm volatile("" ::: "memory");
        }
        SP_WR_TR(15104, TD); asm volatile("" ::: "memory");
        { const bf16x8 ftt = SP_FRAG16(15104);
#pragma unroll
          for (int blk = 0; blk < 4; ++blk) { const bf16x8 fb = fq < 2 ? *(const LAS bf16x8*)(L + 9216 + (16 * blk + fr) * 32 + fq * 16) : (bf16x8){0, 0, 0, 0, 0, 0, 0, 0};
              const f32x4 d = mfma16(ftt, fb, (f32x4){0.f, 0.f, 0.f, 0.f});
#pragma unroll
              for (int rr = 0; rr < 4; ++rr) *(LAS unsigned short*)(L + 11264 + (4 * fq + rr) * 144 + (16 * blk + fr) * 2) = bf1(d[rr]); }
          const f32x4 p2 = mfma16(SP_FRAG16(15616), ftt, (f32x4){0.f, 0.f, 0.f, 0.f});
          *(u32x2*)(cb + CB_P2T + fr * 32 + fq * 8) = pk4(p2); }
        asm volatile("" ::: "memory");
#pragma unroll
        for (int q = 0; q < 2; ++q) { const int pc = lane + 64 * q, pcc = pc >> 6, pt = (pc >> 2) & 15, pf = pc & 3;
            const u32x2 a0 = *(const LAS u32x2*)(L + 11264 + pt * 144 + (32 * pcc + 4 * pf) * 2), a1 = *(const LAS u32x2*)(L + 11264 + pt * 144 + (32 * pcc + 16 + 4 * pf) * 2);
            const u32x2 r0 = *(const LAS u32x2*)(L + 6912 + pt * 144 + (32 * pcc + 4 * pf) * 2), r1 = *(const LAS u32x2*)(L + 6912 + pt * 144 + (32 * pcc + 16 + 4 * pf) * 2);
            *(u32x4*)(cb + CB_P1T + pc * 16) = (u32x4){a0.x, a0.y, a1.x, a1.y}; *(u32x4*)(cb + CB_RT + pc * 16) = (u32x4){r0.x, r0.y, r1.x, r1.y}; }
        asm volatile("" ::: "memory");
#pragma unroll
        for (int t = 0; t < 16; ++t) { cr[t] = nr[t]; ck[t] = nk[t]; cv[t] = nv[t]; ca[t] = na[t]; cw[t] = nw[t]; }
        pr = npr; pk = npk; pv = npv;
#undef SP_ROWS
#undef SP_LOAD
#undef SP_WR_RM
#undef SP_WR_TR
#undef SP_FRAG16
    }
}

__device__ __forceinline__ void sseq_phase(Frame& F, int l_in) {
    PHASE_IDS
    unsigned char* const wsl = fresh(F.ws);
    PHASE_L
    float* Y = (float*)(wsl + WS_Y);
    const bool is_cons = wave < 4;
    const int fr = lane & 15, fq = lane >> 4, vrow = (wave & 3) * 16 + fr, ptid = tid & 255;
    for (int u = blockIdx.x; u < 256; u += fresh_i(F.G)) {
        const bool samp = u >= 128; const int h = u & 15, b = (u >> 4) & 7;
        const int T = samp ? TS : TP, m0 = samp ? MPR + b * TS : b * TP, nch = T / 16, crow0 = m0 / 16;
        f32x4 sreg[4];
        if (samp) { const float* sp = INP(4) + ((((size_t)l * 8 + b) * 16 + h) * 64 + vrow) * 64 + 4 * fq;
#pragma unroll
            for (int kb = 0; kb < 4; ++kb) sreg[kb] = *(const f32x4*)(sp + 16 * kb); }
        else {
#pragma unroll
            for (int kb = 0; kb < 4; ++kb) sreg[kb] = (f32x4){0.f, 0.f, 0.f, 0.f}; }
#define SQ_ISSUE(c) do { const unsigned char* src = cb_ptr(wsl, (size_t)(crow0 + (c)) * 16 + h) + ((wave & 3) * 3) * 1024 + lane * 16; LAS unsigned char* dst = F.lds + ((c) % (SQ_D + 1)) * 12288 + ((wave & 3) * 3) * 1024; \
        _Pragma("unroll") for (int i = 0; i < 3; ++i) __builtin_amdgcn_global_load_lds((const unsigned*)(src + i * 1024), (LAS unsigned*)(dst + i * 1024), 16, 0, 0); } while (0)
#define SQ_WAIT(k) do { switch (k) { case 0: asm volatile("s_waitcnt vmcnt(0)" ::: "memory"); break; case 1: asm volatile("s_waitcnt vmcnt(3)" ::: "memory"); break; case 2: asm volatile("s_waitcnt vmcnt(6)" ::: "memory"); break; \
        case 3: asm volatile("s_waitcnt vmcnt(9)" ::: "memory"); break; case 4: asm volatile("s_waitcnt vmcnt(12)" ::: "memory"); break; default: asm volatile("s_waitcnt vmcnt(15)" ::: "memory"); break; } } while (0)
        constexpr int SQ_D = 6;
        __syncthreads();
        if (!is_cons) { const int np = nch < SQ_D ? nch : SQ_D; for (int c = 0; c < np; ++c) SQ_ISSUE(c); SQ_WAIT(np - 1); }
        __syncthreads();
        for (int c = 0; c < nch; ++c) {
            if (is_cons) {
                const LAS unsigned char* B = F.lds + (c % (SQ_D + 1)) * 12288;
#define SQ_KA(off, cc) (*(const LAS bf16x8*)(B + (off) + (((cc) * 16 + fr) * 4 + fq) * 16))
                const u32x2 vt = *(const LAS u32x2*)(B + CB_VT + vrow * 32 + fq * 8), z2 = (u32x2){0u, 0u};
                const bf16x8 aP2 = mk8(*(const LAS u32x2*)(B + CB_P2T + fr * 32 + fq * 8), z2), aP10 = SQ_KA(CB_P1T, 0), aP11 = SQ_KA(CB_P1T, 1), aR0 = SQ_KA(CB_RT, 0), aR1 = SQ_KA(CB_RT, 1);
                const bf16x8 aM = *(const LAS bf16x8*)(B + CB_MBT + (fr * 4 + fq) * 16);
                bf16x8 aBK[4]; f32x4 gc[4];
#pragma unroll
                for (int kb = 0; kb < 4; ++kb) { aBK[kb] = *(const LAS bf16x8*)(B + CB_BK + ((16 * kb + fr) * 4 + fq) * 16); gc[kb] = *(const LAS f32x4*)(B + CB_GC + (16 * kb + 4 * fq) * 4); }
                __builtin_amdgcn_sched_barrier(0);
                const bf16x8 sB0 = mk8(pk4(sreg[0]), pk4(sreg[1])), sB1 = mk8(pk4(sreg[2]), pk4(sreg[3]));
                f32x4 uD = mfma16(aP2, mk8(vt, z2), (f32x4){0.f, 0.f, 0.f, 0.f});
                uD = mfma16(aP10, sB0, uD); uD = mfma16(aP11, sB1, uD);
                const bf16x8 uvB = mk8(pk4(uD), vt);
                f32x4 nS[4];
#pragma unroll
                for (int kb = 0; kb < 4; ++kb) nS[kb] = mfma16(aBK[kb], uvB, sreg[kb]);
                f32x4 yD = mfma16(aM, uvB, (f32x4){0.f, 0.f, 0.f, 0.f});
                yD = mfma16(aR0, sB0, yD); yD = mfma16(aR1, sB1, yD);
#pragma unroll
                for (int kb = 0; kb < 4; ++kb) sreg[kb] = nS[kb] * gc[kb];
                { float* yo = Y + (size_t)(m0 + c * 16 + 4 * fq) * RWD + h * 64 + vrow; yo[0] = yD[0]; yo[RWD] = yD[1]; yo[2 * RWD] = yD[2]; yo[3 * RWD] = yD[3]; }
#undef SQ_KA
            } else {
                if (c + SQ_D < nch) SQ_ISSUE(c + SQ_D);
                if (c + 1 < nch) { const int last = c + SQ_D < nch ? c + SQ_D : nch - 1; SQ_WAIT(last - (c + 1)); }
            }
            asm volatile("s_waitcnt lgkmcnt(0)" ::: "memory"); __builtin_amdgcn_s_barrier(); asm volatile("" ::: "memory");
        }
#undef SQ_ISSUE
#undef SQ_WAIT
        if (is_cons) { float* so = F.out + (samp ? O_WKS : O_WKP) + ((((size_t)l * 8 + b) * 16 + h) * 64 + vrow) * 64 + 4 * fq;
#pragma unroll
            for (int kb = 0; kb < 4; ++kb) *(f32x4*)(so + 16 * kb) = sreg[kb]; }
    }
}

__device__ __forceinline__ void post_phase(Frame& F, int l_in) {
    PHASE_IDS
    unsigned char* const wsl = fresh(F.ws);
    PHASE_L
    const int NT = fresh_i(F.G) * NTHR; const float* Y = (const float*)(wsl + WS_Y); const float* BS = (const float*)(wsl + WS_BS);
    const bf16_t* PROJ = (const bf16_t*)(wsl + WS_PROJ); const bf16_t* GG = (const bf16_t*)(wsl + WS_GG);
    bf16_t* YB = (bf16_t*)(wsl + WS_YB);
    const float* muv = INP(9) + (size_t)l * RPJ + 2048; const float* gng = INP(20) + (size_t)l * RWD; const float* gnb = INP(21) + (size_t)l * RWD;
#define PP_LOAD(it_, Y0, Y1, CU, PR, GV, BSV) do { const int m_ = (it_) >> 7, c_ = ((it_) & 127) * 8; const size_t o_ = (size_t)m_ * RWD + c_; int b_, t_; bool s_; row_info(m_, b_, t_, s_); \
        Y0 = *(const f32x4*)(Y + o_); Y1 = *(const f32x4*)(Y + o_ + 4); CU = *(const u32x4*)(PROJ + (size_t)m_ * ICP + 3072 + c_); PR = *(const u32x4*)(PROJ + (size_t)(t_ > 0 ? m_ - 1 : m_) * ICP + 3072 + c_); \
        GV = *(const u32x4*)(GG + o_); BSV = BS[(size_t)m_ * 16 + (c_ >> 6)]; } while (0)
    f32x4 y0, y1, ny0, ny1; u32x4 cu, pr, gv, ncu, npr, ngv; float bs, nbs;
    if (gtid < MT * 128) PP_LOAD(gtid, y0, y1, cu, pr, gv, bs);
    for (int it = gtid; it < MT * 128; it += NT) {
        const int itn = it + NT;
        if (itn < MT * 128) PP_LOAD(itn, ny0, ny1, ncu, npr, ngv, nbs);
        const int m = it >> 7, c0 = (it & 127) * 8; const size_t o = (size_t)m * RWD + c0;
        int b, t; bool samp; row_info(m, b, t, samp);
        float y[8] = {y0.x, y0.y, y0.z, y0.w, y1.x, y1.y, y1.z, y1.w};
        float cur[8], prv[8], g[8]; unpack8(cu, cur); unpack8(gv, g); unpack8(pr, prv);
        if (t == 0) {
            if (samp) { const float* p = INP(2) + ((size_t)l * 8 + b) * RPJ + 2048 + c0;
#pragma unroll
                for (int j = 0; j < 8; ++j) prv[j] = p[j]; }
            else {
#pragma unroll
                for (int j = 0; j < 8; ++j) prv[j] = 0.f; }
        }
        float s = 0.f;
#pragma unroll
        for (int j = 0; j < 8; ++j) s += y[j];
        s = sum8(s);
        const float mean = s * (1.0f / 64.0f); float q = 0.f;
#pragma unroll
        for (int j = 0; j < 8; ++j) { const float d = y[j] - mean; q += d * d; }
        q = sum8(q);
        const float rstd = __builtin_amdgcn_rsqf(q * (1.0f / 64.0f) + GN_EPS);
        float outv[8];
#pragma unroll
        for (int j = 0; j < 8; ++j) { const float v = cur[j] + (prv[j] - cur[j]) * muv[c0 + j]; outv[j] = ((y[j] - mean) * rstd * gng[c0 + j] + gnb[c0 + j] + bs * v) * g[j]; }
        *(u32x4*)(YB + o) = pack8(outv);
        y0 = ny0; y1 = ny1; cu = ncu; pr = npr; gv = ngv; bs = nbs;
    }
#undef PP_LOAD
}

__device__ __forceinline__ void tile64_mma(const bf16_t* A, int lda, const bf16_t* Bt, int ldb, int K, int m0, int n0, int wave, int lane, f32x4 (&acc)[4][4]) {
    const int kq = K >> 3, kb = wave * kq, lr = lane & 15, lk = (lane >> 4) * 8;
    const bf16_t* ap = A + (size_t)(m0 + lr) * lda + kb + lk; const bf16_t* bp = Bt + (size_t)(n0 + lr) * ldb + kb + lk;
#pragma unroll 2
    for (int k = 0; k < kq; k += 32) {
        bf16x8 af[4], bf[4];
#pragma unroll
        for (int i = 0; i < 4; ++i) { af[i] = *(const bf16x8*)(ap + (size_t)(16 * i) * lda + k); bf[i] = *(const bf16x8*)(bp + (size_t)(16 * i) * ldb + k); }
#pragma unroll
        for (int mi = 0; mi < 4; ++mi)
#pragma unroll
            for (int ni = 0; ni < 4; ++ni) acc[mi][ni] = __builtin_amdgcn_mfma_f32_16x16x32_bf16(bf[ni], af[mi], acc[mi][ni], 0, 0, 0);
    }
}
__device__ __forceinline__ void tile64_reduce(LAS unsigned char* lds, int wave, int lane, const f32x4 (&acc)[4][4], f32x4 (&out)[2]) {
    LAS f32x4* red = (LAS f32x4*)lds;
    __syncthreads();
#pragma unroll
    for (int mi = 0; mi < 4; ++mi)
#pragma unroll
        for (int ni = 0; ni < 4; ++ni) red[(wave * 16 + mi * 4 + ni) * 64 + lane] = acc[mi][ni];
    __syncthreads();
#pragma unroll
    for (int j = 0; j < 2; ++j) { f32x4 s = red[(2 * wave + j) * 64 + lane];
#pragma unroll
        for (int w = 1; w < 8; ++w) s += red[(w * 16 + 2 * wave + j) * 64 + lane];
        out[j] = s; }
}
#define T64_ZERO(acc) do { _Pragma("unroll") for (int mi = 0; mi < 4; ++mi) _Pragma("unroll") for (int ni = 0; ni < 4; ++ni) acc[mi][ni] = (f32x4){0.f, 0.f, 0.f, 0.f}; } while (0)
template <int MODE>
__device__ __forceinline__ void sample_tiles(Frame& F, int l_in) {
    PHASE_IDS
    unsigned char* const wsl = fresh(F.ws);
    PHASE_L
    const size_t xb_cur = (l & 1) ? WS_XB2 : WS_XN, xb_nxt = (l & 1) ? WS_XN : WS_XB2;
    for (int t = blockIdx.x; t < 256; t += fresh_i(F.G)) {
        const int m0 = MPR + (t >> 5) * 64, n0 = (t & 31) * 64;
        f32x4 acc[4][4], o1[2], o2[2]; T64_ZERO(acc);
        if (MODE == 0) { tile64_mma((const bf16_t*)(wsl + WS_YA), PWD, (const bf16_t*)(wsl + WS_PPOOL), PWD, PWD, m0, n0, wave, lane, acc); tile64_reduce(F.lds, wave, lane, acc, o1);
                         T64_ZERO(acc); tile64_mma((const bf16_t*)(wsl + WS_YB), RWD, (const bf16_t*)(wsl + WS_PRWKV), RWD, RWD, m0, n0, wave, lane, acc); tile64_reduce(F.lds, wave, lane, acc, o2); }
        if (MODE == 1) { tile64_mma((const bf16_t*)(wsl + WS_MRG), DM, (const bf16_t*)(wsl + WS_WOUT), DM, DM, m0, n0, wave, lane, acc); tile64_reduce(F.lds, wave, lane, acc, o1); }
        if (MODE == 2) { tile64_mma((const bf16_t*)(wsl + WS_HID), FF, (const bf16_t*)(wsl + WS_WDN), FF, FF, m0, n0, wave, lane, acc); tile64_reduce(F.lds, wave, lane, acc, o1); }
        if (MODE == 3) { tile64_mma((const bf16_t*)(wsl + xb_cur), DM, (const bf16_t*)(wsl + WS_WPG), DM, DM, m0, n0, wave, lane, acc); tile64_reduce(F.lds, wave, lane, acc, o1); }
        if (MODE == 4) { tile64_mma((const bf16_t*)(wsl + WS_PB), PLE, (const bf16_t*)(wsl + WS_WPP), PLE, PLE, m0, n0, wave, lane, acc); tile64_reduce(F.lds, wave, lane, acc, o1); }
#pragma unroll
        for (int j = 0; j < 2; ++j) { const int blk = 2 * wave + j; const size_t row = (size_t)(m0 + 16 * (blk >> 2) + (lane & 15)); const int col = n0 + 16 * (blk & 3) + 4 * (lane >> 4);
            if (MODE == 0) { const bf16_t* PROJ = (const bf16_t*)(wsl + WS_PROJ); const u32x2 g1 = *(const u32x2*)(PROJ + row * ICP + PC_GP + col), g2 = *(const u32x2*)(PROJ + row * ICP + PC_GR + col);
                const f32x4 a = (f32x4){bf_lo(g1.x), bf_hi(g1.x), bf_lo(g1.y), bf_hi(g1.y)} * o1[j] + (f32x4){bf_lo(g2.x), bf_hi(g2.x), bf_lo(g2.y), bf_hi(g2.y)} * o2[j];
                *(u32x2*)((bf16_t*)(wsl + WS_MRG) + row * DM + col) = (u32x2){cvt_pk_bf16(a.x, a.y), cvt_pk_bf16(a.z, a.w)}; }
            if (MODE == 1 || MODE == 2) { bf16_t* p = (bf16_t*)(wsl + xb_cur) + row * DM + col; const u32x2 q = *(const u32x2*)p; const f32x4 x = (f32x4){bf_lo(q.x), bf_hi(q.x), bf_lo(q.y), bf_hi(q.y)} + o1[j];
                *(u32x2*)p = (u32x2){cvt_pk_bf16(x.x, x.y), cvt_pk_bf16(x.z, x.w)}; __hip_atomic_fetch_add((pg8::ss_t*)(wsl + WS_SS) + (size_t)MODE * MT + row, pg8::ss_fix((x.x * x.x + x.y * x.y) + (x.z * x.z + x.w * x.w)), __ATOMIC_RELAXED, __HIP_MEMORY_SCOPE_AGENT); }
            if (MODE == 3) { const u32x2 q = *(const u32x2*)((const bf16_t*)(wsl + WS_PP) + row * DM + col); const u32x2 xq = *(const u32x2*)((const bf16_t*)(wsl + xb_cur) + row * DM + col); bf16_t* p = (bf16_t*)(wsl + xb_nxt) + row * DM + col;
                const float rs = pg8::rstd_of((const pg8::ss_t*)(wsl + WS_SS) + (size_t)2 * MT, row);
                const f32x4 x = (f32x4){bf_lo(xq.x), bf_hi(xq.x), bf_lo(xq.y), bf_hi(xq.y)} + sigmoid4(o1[j] * rs) * (f32x4){bf_lo(q.x), bf_hi(q.x), bf_lo(q.y), bf_hi(q.y)};
                *(u32x2*)p = (u32x2){cvt_pk_bf16(x.x, x.y), cvt_pk_bf16(x.z, x.w)}; __hip_atomic_fetch_add((pg8::ss_t*)(wsl + WS_SS) + row, pg8::ss_fix((x.x * x.x + x.y * x.y) + (x.z * x.z + x.w * x.w)), __ATOMIC_RELAXED, __HIP_MEMORY_SCOPE_AGENT); }
            if (MODE == 4) *(u32x2*)((bf16_t*)(wsl + WS_PP) + row * DM + col) = (u32x2){cvt_pk_bf16(o1[j].x, o1[j].y), cvt_pk_bf16(o1[j].z, o1[j].w)};
        }
    }
    __syncthreads();
}

constexpr int PH_PER_LAYER = 12, N_PHASES = NL * PH_PER_LAYER + 1;
#ifndef MK_REP
#define MK_REP 0
#endif
__global__ void __launch_bounds__(NTHR, 2) mega_fwd(Args args) {
    extern __shared__ __attribute__((aligned(16))) unsigned char lds[];
    Frame F;
    F.lds = (LAS unsigned char*)lds;
    F.G = gridDim.x;
    F.out = args.out; F.ws = args.ws;
    { LAS unsigned long long* pt = (LAS unsigned long long*)(F.lds + LDSCTL_OFF + 1024); F.ptab = pt;
      if (threadIdx.x == 0) {
#define PT_(k) pt[k] = (unsigned long long)args.in[k];
          PT_(0) PT_(1) PT_(2) PT_(3) PT_(4) PT_(5) PT_(6) PT_(7) PT_(8) PT_(9) PT_(10) PT_(11) PT_(12) PT_(13) PT_(14) PT_(15) PT_(16) PT_(17) PT_(18) PT_(19) PT_(20) PT_(21) PT_(22) PT_(23) PT_(24) PT_(25) PT_(26) PT_(27) PT_(28) PT_(29) PT_(30) PT_(31) PT_(32)
#undef PT_
      } }
    volatile LAS unsigned* MISC = (volatile LAS unsigned*)(F.lds + LDSCTL_OFF);
    for (int u = threadIdx.x; u < 256; u += NTHR) ((LAS unsigned*)(F.lds + LDSCTL_OFF))[u] = 0u;
    __syncthreads();
    XcdBarrier bar; bar.bar = (unsigned*)(args.ws + WS_CTL) + CW_BAR; bar.x = 0; bar.st = nullptr;
    if (!MK_PER_PHASE) bar = xcd_barrier_post((unsigned*)(args.ws + WS_CTL) + CW_BAR, MISC + 8);
    const int lo = args.ph_lo, hi = args.ph_hi;
#define IN(k) (lo <= (k) && (k) < hi)
#define REP(k) (1 + ((MK_REP >> (k)) & 1))
#define PHASE(k, ...) do { if (IN(pb + (k))) { for (int rep = 0; rep < REP(k); ++rep) { if (rep) xcd_barrier(bar); __VA_ARGS__ } if (IN(pb + (k) + 1)) xcd_barrier(bar); } } while (0)
#define WSP(off) (fresh(F.ws) + (off))
#define UNPAREN(...) __VA_ARGS__
#define GEMM_M(M_, EPI, EINIT, Aoff, Boff, N_, K_, lda_, ldb_, apn_) do { pg8::Gemm g{(const bf16_t*)WSP(Aoff), (const bf16_t*)WSP(Boff), (M_), (N_), (K_), (lda_), (ldb_), (apn_)}; pg8::StaticOrder S; S.init((M_), (N_), fresh_i(F.G), fresh_i(cid)); \
        pg8::EPI E{UNPAREN EINIT}; pg8::gemm_phase<pg8::EPI, pg8::StaticOrder, true>(ring, g, S, E); } while (0)
#define GEMM(...) GEMM_M(MT, __VA_ARGS__)
#define GEMM_SUB(c0_, M_, EPI, EINIT, Aoff, Boff, N_, K_, lda_, ldb_, apn_) do { pg8::Gemm g{(const bf16_t*)WSP(Aoff), (const bf16_t*)WSP(Boff), (M_), (N_), (K_), (lda_), (ldb_), (apn_)}; pg8::StaticOrder S; \
        const int c0v = (c0_); S.init((M_), (N_), fresh_i(F.G) - c0v, fresh_i(cid) >= c0v ? fresh_i(cid) - c0v : -1); pg8::EPI E{UNPAREN EINIT}; pg8::gemm_phase<pg8::EPI, pg8::StaticOrder, true>(ring, g, S, E); } while (0)
    LAS unsigned char* ring = F.lds;
    const int cid = (int)blockIdx.x;
    for (int l = 0; l < NL; ++l) {
        const int pb = l * PH_PER_LAYER;
#define SSP(i) ((pg8::ss_t*)WSP(WS_SS) + (size_t)(i) * MT)
        const size_t xb_cur = (l & 1) ? WS_XB2 : WS_XN, xb_nxt = (l & 1) ? WS_XN : WS_XB2;
        PHASE(0, { convert_weights(F, l); if (l == 0) xb_from_input(F); });
        PHASE(1, { GEMM(EpiProj, ((bf16_t*)WSP(WS_PROJ), SSP(0)), xb_cur, WS_WIN, ICP, DM, DM, DM, 0); });
        PHASE(2, { prep1_phase(F, l); });
        PHASE(3, { GEMM(EpiBf16, ((bf16_t*)WSP(WS_YA), PWD), WS_D, WS_POOLW, PWD, 256, PWD, 256, 256);
                   GEMM(EpiLora, ((float*)WSP(WS_DEC), (bf16_t*)WSP(WS_AA), (bf16_t*)WSP(WS_GG), INP(12) + (size_t)fresh_i(l) * RWD, INP(14) + (size_t)fresh_i(l) * RWD), WS_LIN, WS_LORA, 3072, LK, LK, LK, 0); });
        PHASE(4, { spre_phase(F, l); });
        PHASE(5, { sseq_phase(F, l); });
        PHASE(6, { post_phase(F, l); });
        PHASE(7, { GEMM_M(MPR, EpiGate1, ((bf16_t*)WSP(WS_TMP), (const bf16_t*)WSP(WS_PROJ), PC_GP), WS_YA, WS_PPOOL, DM, PWD, PWD, PWD, 0);
                   GEMM_M(MPR, EpiGate2, ((const bf16_t*)WSP(WS_TMP), (const bf16_t*)WSP(WS_PROJ), PC_GR, (bf16_t*)WSP(WS_MRG)), WS_YB, WS_PRWKV, DM, RWD, RWD, RWD, 0);
                   sample_tiles<0>(F, l); });
        PHASE(8, { GEMM_M(MPR, EpiResid, ((bf16_t*)WSP(xb_cur), SSP(1)), WS_MRG, WS_WOUT, DM, DM, DM, DM, 0); sample_tiles<1>(F, l); });
        PHASE(9, { GEMM(EpiSwiglu, ((bf16_t*)WSP(WS_HID), SSP(1)), xb_cur, WS_WGU, 2 * FF, DM, DM, DM, 0);
                   GEMM_SUB((((MT / 256) * (2 * FF / 256)) % fresh_i(F.G)) & ~7, MPR, EpiBf16, ((bf16_t*)WSP(WS_PP), DM), WS_PB, WS_WPP, DM, PLE, PLE, PLE, 0); sample_tiles<4>(F, l); });
        PHASE(10, { GEMM_M(MPR, EpiResid, ((bf16_t*)WSP(xb_cur), SSP(2)), WS_HID, WS_WDN, DM, FF, FF, FF, 0); sample_tiles<2>(F, l); });
        PHASE(11, { GEMM_M(MPR, EpiPle, ((const bf16_t*)WSP(xb_cur), (bf16_t*)WSP(xb_nxt), (const bf16_t*)WSP(WS_PP), SSP(2), SSP(0)), xb_cur, WS_WPG, DM, DM, DM, DM, 0); sample_tiles<3>(F, l); });
#undef SSP
    }
    if (IN(NL * PH_PER_LAYER)) final_norm(F, INP(32));
#undef IN
#undef REP
#undef PHASE
#undef WSP
#undef GEMM
#undef GEMM_M
#undef GEMM_SUB
#undef UNPAREN
}

extern "C" void kernel_launch(void* const* d_in, const int* in_sizes, int n_in, void* d_out, int out_size, void* d_ws, size_t ws_size, hipStream_t stream) {
    static int grid = 0;
    if (grid == 0) {
        if (n_in != 33 || in_sizes[0] != MPR * DM || out_size != (int)O_END || ws_size < WS_END) {
            fprintf(stderr, "kernel_launch: unexpected shapes: n_in %d in0 %d out %d ws %zu (need %zu); nothing launched\n", n_in, n_in > 0 ? in_sizes[0] : -1, out_size, ws_size, (size_t)WS_END); grid = -1; return; }
        int dev = 0, cus = 0, per_cu = 0;
        if (hipGetDevice(&dev) != hipSuccess || hipDeviceGetAttribute(&cus, hipDeviceAttributeMultiprocessorCount, dev) != hipSuccess) { grid = -1; return; }
        if (hipFuncSetAttribute((const void*)mega_fwd, hipFuncAttributeMaxDynamicSharedMemorySize, LDS_BYTES) != hipSuccess) { fprintf(stderr, "kernel_launch: hipFuncSetAttribute failed\n"); grid = -1; return; }
        if (hipOccupancyMaxActiveBlocksPerMultiprocessor(&per_cu, (const void*)mega_fwd, NTHR, LDS_BYTES) != hipSuccess || per_cu < 1) { fprintf(stderr, "kernel_launch: occupancy query says %d\n", per_cu); (void)hipGetLastError(); grid = -1; return; }
        grid = cus;
    }
    if (grid < 0) return;
    (void)hipMemsetAsync((char*)d_ws + WS_CTL, 0, CTL_ZERO_BYTES, stream);
    Args a; memset(&a, 0, sizeof(a));
    for (int i = 0; i < 33; ++i) a.in[i] = (const float*)d_in[i];
    a.out = (float*)d_out; a.ws = (unsigned char*)d_ws;
#if MK_PER_PHASE
    for (int p = 0; p < N_PHASES; ++p) { a.ph_lo = p; a.ph_hi = p + 1; hipLaunchKernelGGL(mega_fwd, dim3(grid), dim3(NTHR), LDS_BYTES, stream, a); }
#else
    a.ph_lo = 0; a.ph_hi = N_PHASES; hipLaunchKernelGGL(mega_fwd, dim3(grid), dim3(NTHR), LDS_BYTES, stream, a);
#endif
}
```

```cpp
#include <hip/hip_runtime.h>
#include <cstdio>
#include <cstdint>
#include <cstring>

#ifndef MK_PER_PHASE
#define MK_PER_PHASE 0
#endif

#define LAS __attribute__((address_space(3)))
typedef unsigned short bf16_t;
typedef short bf16x8 __attribute__((ext_vector_type(8)));
typedef float f32x4 __attribute__((ext_vector_type(4)));
typedef float f32x2 __attribute__((ext_vector_type(2)));
typedef unsigned u32x4 __attribute__((ext_vector_type(4)));
typedef unsigned u32x2 __attribute__((ext_vector_type(2)));

constexpr int DM = 2048, NL = 4, MT = 16896, MPR = 16384, TP = 2048, TS = 64;
constexpr int PWD = 1024, RWD = 1024, RPJ = 3360, ICOLS = 8480, ICP = 8704, FF = 5632, PLE = 256, LK = 384;
constexpr int PC_GP = 4608, PC_GR = 6656;
constexpr float NORM_EPS = 1e-6f, GN_EPS = 64e-5f;
constexpr size_t O_YS = 33554432, O_SHP = 34603008, O_POP = 34710528, O_WKP = 35202048, O_SHS = 37299200, O_POS = 37406720, O_WKS = 37898240, O_END = 39995392;

__device__ __forceinline__ unsigned cvt_pk_bf16(float lo, float hi) { unsigned r; asm volatile("v_cvt_pk_bf16_f32 %0, %1, %2" : "=v"(r) : "v"(lo), "v"(hi)); return r; }
__device__ __forceinline__ float bf_lo(unsigned u) { return __uint_as_float(u << 16); }
__device__ __forceinline__ float bf_hi(unsigned u) { return __uint_as_float(u & 0xffff0000u); }
__device__ __forceinline__ void unpack8(const u32x4 w, float (&f)[8]) { f[0] = bf_lo(w.x); f[1] = bf_hi(w.x); f[2] = bf_lo(w.y); f[3] = bf_hi(w.y); f[4] = bf_lo(w.z); f[5] = bf_hi(w.z); f[6] = bf_lo(w.w); f[7] = bf_hi(w.w); }
__device__ __forceinline__ u32x4 pack8(const float (&f)[8]) { u32x4 w; w.x = cvt_pk_bf16(f[0], f[1]); w.y = cvt_pk_bf16(f[2], f[3]); w.z = cvt_pk_bf16(f[4], f[5]); w.w = cvt_pk_bf16(f[6], f[7]); return w; }
__device__ __forceinline__ float sigmoidf_(float x) { return __builtin_amdgcn_rcpf(1.0f + __expf(-x)); }
__device__ __forceinline__ f32x4 sigmoid4(f32x4 v) { f32x4 o; o.x = sigmoidf_(v.x); o.y = sigmoidf_(v.y); o.z = sigmoidf_(v.z); o.w = sigmoidf_(v.w); return o; }
__device__ __forceinline__ float tanhf_(float x) { const float e = __expf(2.0f * x); return 1.0f - 2.0f * __builtin_amdgcn_rcpf(e + 1.0f); }
template <int CTRL> __device__ __forceinline__ float dpp_f(float x) { return __uint_as_float((unsigned)__builtin_amdgcn_update_dpp(0, (int)__float_as_uint(x), CTRL, 0xF, 0xF, true)); }
__device__ __forceinline__ float sum8(float x) { x += dpp_f<0xB1>(x); x += dpp_f<0x4E>(x); x += dpp_f<0x141>(x); return x; }
__device__ __forceinline__ float wave_sum(float x) {
    x += dpp_f<0xB1>(x); x += dpp_f<0x4E>(x); x += dpp_f<0x141>(x); x += dpp_f<0x140>(x);
    x += __uint_as_float((unsigned)__builtin_amdgcn_ds_swizzle((int)__float_as_uint(x), 0x401F));
    return __uint_as_float((unsigned)__builtin_amdgcn_readlane((int)__float_as_uint(x), 0)) + __uint_as_float((unsigned)__builtin_amdgcn_readlane((int)__float_as_uint(x), 32));
}

namespace pg8 {
typedef unsigned ss_t;
constexpr int BM = 256, BK = 64, HALF = 128, HTB = HALF * BK * 2  , STAGE_BYTES = 8 * HTB, NXCD = 8, WGM = 8;
__host__ __device__ __forceinline__ int lds_byte(int r, int c) { const int st = (r >> 4) * 2 + (c >> 5), rr = r & 15, cc = c & 31, ob = rr * 64 + cc * 2; return st * 1024 + (ob ^ (((ob >> 9) & 1) << 5)); }
__host__ __device__ __forceinline__ void stage_rc(int b, int& R, int& C) { const int st = b / 1024, sb = b % 1024, swz = sb ^ (((sb >> 9) & 1) << 5); R = (st >> 1) * 16 + swz / 64; C = (st & 1) * 32 + (swz % 64) / 2; }
__host__ __device__ __forceinline__ int perm32(int rho) { const int n = rho >> 4, i = rho & 15; return 8 * (i >> 2) + 4 * n + (i & 3); }

struct Unit { int pm, pn; };
struct Gemm { const bf16_t* A; const bf16_t* Bt; int M, N, K, lda, ldb, a_pn_off; };

struct StaticOrder {
    int nM, nN, nwg, G, c;
    __host__ __device__ void init(int M, int N, int G_, int c_) { nM = M / BM; nN = N / BM; nwg = nM * nN; G = G_; c = c_; }
    __host__ __device__ bool next(int i, Unit& u) const {
        if (c < 0) return false;
        const long L = (long)i * G + c; if (L >= nwg) return false;
        int wgid = (int)L; { const int q = nwg / NXCD, r = nwg % NXCD, xcd = wgid % NXCD, off = wgid / NXCD; wgid = (xcd < r ? xcd * (q + 1) : r * (q + 1) + (xcd - r) * q) + off; }
        const int nig = WGM * nN, gid = wgid / nig, fm = gid * WGM, gsz = (nM - fm) < WGM ? (nM - fm) : WGM;
        u.pm = fm + ((wgid % nig) % gsz); u.pn = (wgid % nig) / gsz; return true;
    }
    __device__ __forceinline__ void a_ready(const Unit&) const {}
    __device__ __forceinline__ void done(const Unit&) const {}
};

__device__ __forceinline__ void acc_zero(f32x4 (&acc)[2][2][4][2]) {
#pragma unroll
    for (int a = 0; a < 2; ++a)
#pragma unroll
        for (int b = 0; b < 2; ++b)
#pragma unroll
            for (int m = 0; m < 4; ++m)
#pragma unroll
                for (int n = 0; n < 2; ++n) acc[a][b][m][n] = (f32x4){0.f, 0.f, 0.f, 0.f};
}
struct RepeatOrder : StaticOrder {
    __host__ __device__ bool next(int i, Unit& u) const { if (i >= 6) return false; return StaticOrder::next(i % 3, u) || StaticOrder::next(0, u); }
};
#define EPI_ZERO_INIT __device__ __forceinline__ void init(f32x4 (&acc)[2][2][4][2], const Unit&, int, int, int, int) const { acc_zero(acc); }
#define EPI_NO_PRE __device__ __forceinline__ void preload(ss_t (&pre)[2], const Unit&, int, int, int) const {}
#define EPI_SS_PRE(SSPTR) __device__ __forceinline__ void preload(ss_t (&pre)[2], const Unit& u, int wr, int fr, int fq) const { _Pragma("unroll") for (int j = 0; j < 2; ++j) { const int g = 2 * fq + j; \
        pre[j] = (SSPTR)[(size_t)(u.pm * BM + (g >> 2) * HALF + wr * 64 + (g & 3) * 16 + fr)]; } }
__device__ __forceinline__ ss_t pre_get(const ss_t (&pre)[2], int g, int fr) { return (ss_t)__builtin_amdgcn_ds_bpermute((((g >> 1) << 4) + fr) << 2, (int)pre[g & 1]); }
template <class Epi, class Sched, bool ALIGN_EPI>
__device__ __forceinline__ void gemm_phase(LAS unsigned char* lds, const Gemm g, const Sched& S, const Epi& E) {
    int tid_ = threadIdx.x; asm volatile("" : "+v"(tid_));
    const int tid = tid_, wid = __builtin_amdgcn_readfirstlane(tid >> 6), lane = tid & 63, wr = wid >> 2, wc = wid & 3, fr = lane & 15, fq = lane >> 4;
    int K_ = g.K; asm volatile("" : "+s"(K_));
    const int K = K_, nt = K / BK;
    unsigned voffA[2], voffB[2];
#pragma unroll
    for (int i = 0; i < 2; ++i) { int R, C; stage_rc(tid * 16 + i * 8192, R, C); const int Rb = Epi::PERM ? (64 * (R >> 5) + perm32(R & 31)) : R;
        voffA[i] = (unsigned)(R * g.lda + C) * 2u; voffB[i] = (unsigned)(Rb * g.ldb + C) * 2u; }
    const size_t kstep = (size_t)(BK * 2);
    const size_t hstepA = (size_t)HALF * g.lda * 2, hstepB = (size_t)(Epi::PERM ? 32 : HALF) * g.ldb * 2;
    const unsigned ldsw = (unsigned)wid * 1024u;
    const int aoff = lds_byte(wr * 64 + fr, fq * 8), boff = lds_byte(wc * 32 + fr, fq * 8);
#define PG8_SA(b, h) (((b) * 2 + (h)) * HTB)
#define PG8_SB(b, h) ((4 + (b) * 2 + (h)) * HTB)
#define PG8_STAGE(bufoff, gbase, voff) do { _Pragma("unroll") for (int _i = 0; _i < 2; ++_i) \
        __builtin_amdgcn_global_load_lds((const unsigned*)((const char*)(gbase) + (voff)[_i]), (LAS unsigned*)(lds + (bufoff) + ldsw + _i * 8192), 16, 0, 0); } while (0)
#define PG8_LDA(dst, b, h) do { _Pragma("unroll") for (int m = 0; m < 4; ++m) _Pragma("unroll") for (int k = 0; k < 2; ++k) dst[m][k] = *(const LAS bf16x8*)(lds + PG8_SA(b, h) + aoff + m * 2048 + k * 1024); } while (0)
#define PG8_LDB(dst, b, h) do { _Pragma("unroll") for (int n = 0; n < 2; ++n) _Pragma("unroll") for (int k = 0; k < 2; ++k) dst[n][k] = *(const LAS bf16x8*)(lds + PG8_SB(b, h) + boff + n * 2048 + k * 1024); } while (0)
#define PG8_MMA(ai, bj, At, Bt) do { __builtin_amdgcn_s_setprio(1); _Pragma("unroll") for (int m = 0; m < 4; ++m) _Pragma("unroll") for (int n = 0; n < 2; ++n) _Pragma("unroll") for (int k = 0; k < 2; ++k) \
        acc[ai][bj][m][n] = __builtin_amdgcn_mfma_f32_16x16x32_bf16(Bt[n][k], At[m][k], acc[ai][bj][m][n], 0, 0, 0); __builtin_amdgcn_s_setprio(0); } while (0)
#define PG8_WAIT_V(n) asm volatile("s_waitcnt vmcnt(" #n ")" ::: "memory")
#define PG8_WAIT_L(n) asm volatile("s_waitcnt lgkmcnt(" #n ")" ::: "memory")
#define PG8_BAR __builtin_amdgcn_s_barrier()
#define PG8_SCHED __builtin_amdgcn_sched_barrier(0)
    Unit cur, nxt; int ui = 0;
    if (!S.next(0, cur)) return;
    f32x4 acc[2][2][4][2]; ss_t pre[2];
    E.init(acc, cur, wr, wc, fr, fq); E.preload(pre, cur, wr, fr, fq);
    bf16x8 At[4][2], B0[2][2], B1[2][2];
    const char* cA = (const char*)g.A + ((size_t)cur.pm * BM * g.lda + (size_t)cur.pn * g.a_pn_off) * 2; const char* cB = (const char*)g.Bt + (size_t)cur.pn * BM * g.ldb * 2;
    S.a_ready(cur);
    PG8_STAGE(PG8_SB(0, 0), cB, voffB); PG8_STAGE(PG8_SB(0, 1), cB + hstepB, voffB); PG8_STAGE(PG8_SA(0, 0), cA, voffA); PG8_STAGE(PG8_SA(0, 1), cA + hstepA, voffA);
    if (wr == 1) PG8_BAR;
    PG8_WAIT_V(2); PG8_BAR;
    PG8_STAGE(PG8_SB(1, 0), cB + kstep, voffB); PG8_STAGE(PG8_SA(1, 0), cA + kstep, voffA); PG8_STAGE(PG8_SB(1, 1), cB + hstepB + kstep, voffB);
    PG8_WAIT_V(6); PG8_BAR;
    for (;;) {
        const bool has_next = S.next(ui + 1, nxt);
        const char* nA = has_next ? (const char*)g.A + ((size_t)nxt.pm * BM * g.lda + (size_t)nxt.pn * g.a_pn_off) * 2 : cA; const char* nB = has_next ? (const char*)g.Bt + (size_t)nxt.pn * BM * g.ldb * 2 : cB;
#pragma unroll 1
        for (int t = 0; t < nt; t += 2) {
            const bool last = (t == nt - 2);
            const char* a1 = cA + (size_t)(t + 1) * kstep;
            const char* a2 = last ? nA : cA + (size_t)(t + 2) * kstep; const char* b2 = last ? nB : cB + (size_t)(t + 2) * kstep;
            const char* a3 = a2 + kstep; const char* b3 = b2 + kstep;
            if (last && has_next) S.a_ready(nxt);
            PG8_LDB(B0, 0, 0); PG8_LDB(B1, 0, 1); PG8_SCHED; PG8_LDA(At, 0, 0); PG8_STAGE(PG8_SA(1, 1), a1 + hstepA, voffA);
            PG8_WAIT_V(8); PG8_WAIT_L(0); PG8_BAR; PG8_MMA(0, 0, At, B0); PG8_MMA(0, 1, At, B1); PG8_BAR; PG8_SCHED;
            PG8_LDA(At, 0, 1); PG8_STAGE(PG8_SB(0, 0), b2, voffB); PG8_STAGE(PG8_SB(0, 1), b2 + hstepB, voffB); PG8_STAGE(PG8_SA(0, 0), a2, voffA);
            PG8_WAIT_V(8); PG8_WAIT_L(0); PG8_BAR; PG8_MMA(1, 0, At, B0); PG8_MMA(1, 1, At, B1); PG8_BAR; PG8_SCHED;
            PG8_LDB(B0, 1, 0); PG8_LDB(B1, 1, 1); PG8_SCHED; PG8_LDA(At, 1, 0); PG8_STAGE(PG8_SA(0, 1), a2 + hstepA, voffA);
            PG8_WAIT_V(8); PG8_WAIT_L(0); PG8_BAR; PG8_MMA(0, 0, At, B0); PG8_MMA(0, 1, At, B1); PG8_BAR; PG8_SCHED;
            PG8_LDA(At, 1, 1); PG8_STAGE(PG8_SB(1, 0), b3, voffB); PG8_STAGE(PG8_SB(1, 1), b3 + hstepB, voffB); PG8_STAGE(PG8_SA(1, 0), a3, voffA);
            PG8_WAIT_V(8); PG8_WAIT_L(0); PG8_BAR; PG8_MMA(1, 0, At, B0); PG8_MMA(1, 1, At, B1); PG8_BAR; PG8_SCHED;
        }
        if constexpr (ALIGN_EPI) { if (wr == 0) PG8_BAR; }
        E(acc, pre, cur, wr, wc, fr, fq); S.done(cur);
        if (!has_next) break;
        E.init(acc, nxt, wr, wc, fr, fq); E.preload(pre, nxt, wr, fr, fq);
        cur = nxt; cA = nA; cB = nB; ++ui;
        if constexpr (ALIGN_EPI) { if (wr == 1) PG8_BAR; }
    }
    PG8_WAIT_V(0);
    if constexpr (!ALIGN_EPI) { if (wr == 0) PG8_BAR; }
    PG8_BAR;
#undef PG8_SA
#undef PG8_SB
#undef PG8_STAGE
#undef PG8_LDA
#undef PG8_LDB
#undef PG8_MMA
#undef PG8_WAIT_V
#undef PG8_WAIT_L
#undef PG8_BAR
#undef PG8_SCHED
}

#define EPI_ROW0 (u.pm * BM + wr * 64 + fr)
#define EPI_FOR_AI_M _Pragma("unroll") for (int ai = 0; ai < 2; ++ai) _Pragma("unroll") for (int m = 0; m < 4; ++m)
__device__ __forceinline__ u32x4 pack_f4x2(f32x4 v0, f32x4 v1) { u32x4 w; w.x = cvt_pk_bf16(v0[0], v0[1]); w.y = cvt_pk_bf16(v0[2], v0[3]); w.z = cvt_pk_bf16(v1[0], v1[1]); w.w = cvt_pk_bf16(v1[2], v1[3]); return w; }
__device__ __forceinline__ void unpack_f4x2(u32x4 w, f32x4& v0, f32x4& v1) { v0[0] = bf_lo(w.x); v0[1] = bf_hi(w.x); v0[2] = bf_lo(w.y); v0[3] = bf_hi(w.y); v1[0] = bf_lo(w.z); v1[1] = bf_hi(w.z); v1[2] = bf_lo(w.w); v1[3] = bf_hi(w.w); }
__device__ __forceinline__ unsigned ror8(unsigned x) { return (unsigned)__builtin_amdgcn_update_dpp(0, (int)x, 0x128, 0xF, 0xF, true); }
__device__ __forceinline__ void st_pair(char* grp, size_t pitch, int fr, int fq, u32x4 vA, u32x4 vB) {
    const bool lo = fr < 8;
    u32x4 snd = lo ? vB : vA, rcv; rcv.x = ror8(snd.x); rcv.y = ror8(snd.y); rcv.z = ror8(snd.z); rcv.w = ror8(snd.w);
    char* p = grp + (size_t)(fr & 7) * pitch + (lo ? 0 : 64) + fq * 16;
    *(u32x4*)p = lo ? vA : rcv;
    *(u32x4*)(p + 8 * pitch) = lo ? rcv : vB;
}
__device__ __forceinline__ u32x4 as_u4(f32x4 v) { return __builtin_bit_cast(u32x4, v); }

__device__ __forceinline__ float rstd_raw(ss_t v) { return __builtin_amdgcn_rsqf((float)v * (1.0f / (256.0f * DM)) + NORM_EPS); }
__device__ __forceinline__ float rstd_of(const ss_t* SS, size_t row) { return rstd_raw(SS[row]); }
__device__ __forceinline__ ss_t ss_fix(float s) { return (ss_t)(s * 256.0f + 0.5f); }
__device__ __forceinline__ float sq8(f32x4 a, f32x4 b) { return (a.x * a.x + a.y * a.y) + (a.z * a.z + a.w * a.w) + (b.x * b.x + b.y * b.y) + (b.z * b.z + b.w * b.w); }
__device__ __forceinline__ void ss_add(ss_t* SS, size_t row, float s, int fq, int fr) { s += __uint_as_float((unsigned)__builtin_amdgcn_ds_swizzle((int)__float_as_uint(s), 0x401F));
    s += __uint_as_float((unsigned)__builtin_amdgcn_ds_bpermute((((fq ^ 2) << 4) + fr) << 2, (int)__float_as_uint(s)));
    if (fq == 0) __hip_atomic_fetch_add(SS + row, ss_fix(s), __ATOMIC_RELAXED, __HIP_MEMORY_SCOPE_AGENT); }
struct EpiNull { static constexpr bool PERM = true; EPI_NO_PRE EPI_ZERO_INIT __device__ __forceinline__ void operator()(const f32x4 (&acc)[2][2][4][2], const ss_t (&pre)[2], const Unit& u, int wr, int wc, int fr, int fq) const {
#pragma unroll
    for (int a = 0; a < 2; ++a)
#pragma unroll
        for (int b = 0; b < 2; ++b)
#pragma unroll
            for (int m = 0; m < 4; ++m)
#pragma unroll
                for (int n = 0; n < 2; ++n) asm volatile("" :: "v"(acc[a][b][m][n]));
} };
struct EpiProj { static constexpr bool PERM = true; EPI_ZERO_INIT
    bf16_t* O; const ss_t* SS; EPI_SS_PRE(SS)
    __device__ __forceinline__ void operator()(const f32x4 (&acc)[2][2][4][2], const ss_t (&pre)[2], const Unit& u, int wr, int wc, int fr, int fq) const {
        const bool sg = u.pn >= 18;
        EPI_FOR_AI_M { const size_t r0 = (size_t)(u.pm * BM + ai * HALF + wr * 64 + m * 16); char* grp = (char*)(O + r0 * ICP + u.pn * BM + 64 * wc); const float rs = rstd_raw(pre_get(pre, ai * 4 + m, fr));
            f32x4 a0 = acc[ai][0][m][0] * rs, a1 = acc[ai][0][m][1] * rs, b0 = acc[ai][1][m][0] * rs, b1 = acc[ai][1][m][1] * rs;
            if (sg) { a0 = sigmoid4(a0); a1 = sigmoid4(a1); b0 = sigmoid4(b0); b1 = sigmoid4(b1); }
            st_pair(grp, (size_t)ICP * 2, fr, fq, pack_f4x2(a0, a1), pack_f4x2(b0, b1)); }
    }
};
struct EpiBf16 { static constexpr bool PERM = true; EPI_NO_PRE EPI_ZERO_INIT
    bf16_t* O; int ldc;
    __device__ __forceinline__ void operator()(const f32x4 (&acc)[2][2][4][2], const ss_t (&pre)[2], const Unit& u, int wr, int wc, int fr, int fq) const {
        EPI_FOR_AI_M { char* grp = (char*)(O + (size_t)(u.pm * BM + ai * HALF + wr * 64 + m * 16) * ldc + u.pn * BM + 64 * wc);
            st_pair(grp, (size_t)ldc * 2, fr, fq, pack_f4x2(acc[ai][0][m][0], acc[ai][0][m][1]), pack_f4x2(acc[ai][1][m][0], acc[ai][1][m][1])); }
    }
};
struct EpiLora { static constexpr bool PERM = true; EPI_NO_PRE EPI_ZERO_INIT
    float* DEC; bf16_t* AA; bf16_t* GG; const float* w0; const float* a0;
    __device__ __forceinline__ void operator()(const f32x4 (&acc)[2][2][4][2], const ss_t (&pre)[2], const Unit& u, int wr, int wc, int fr, int fq) const {
        const int row0 = EPI_ROW0, kind = u.pn >> 2, ct = (u.pn & 3) * BM + 64 * wc, col0 = ct + 8 * fq;
        if (kind == 0) {
            EPI_FOR_AI_M { float* rowp = DEC + (size_t)(row0 + ai * HALF + m * 16) * RWD + col0;
#pragma unroll
                for (int bj = 0; bj < 2; ++bj)
#pragma unroll
                    for (int n = 0; n < 2; ++n) { const f32x4 b = *(const f32x4*)(w0 + col0 + bj * 32 + 4 * n); const f32x4 x = acc[ai][bj][m][n] + b; f32x4 o;
#pragma unroll
                        for (int j = 0; j < 4; ++j) { const float z = -x[j]; const float sp = z > 15.f ? z : __logf(1.0f + __expf(z)); const float w = -sp - 0.5f; o[j] = __expf(-__expf(w)); }
                        *(f32x4*)(rowp + bj * 32 + 4 * n) = o; } asm volatile("" ::: "memory"); }
        } else if (kind == 1) {
            const f32x4 b00 = *(const f32x4*)(a0 + col0), b01 = *(const f32x4*)(a0 + col0 + 4), b10 = *(const f32x4*)(a0 + col0 + 32), b11 = *(const f32x4*)(a0 + col0 + 36);
            EPI_FOR_AI_M { char* grp = (char*)(AA + (size_t)(u.pm * BM + ai * HALF + wr * 64 + m * 16) * RWD + ct);
                st_pair(grp, (size_t)RWD * 2, fr, fq, pack_f4x2(sigmoid4(acc[ai][0][m][0] + b00), sigmoid4(acc[ai][0][m][1] + b01)), pack_f4x2(sigmoid4(acc[ai][1][m][0] + b10), sigmoid4(acc[ai][1][m][1] + b11))); }
        } else {
            EPI_FOR_AI_M { char* grp = (char*)(GG + (size_t)(u.pm * BM + ai * HALF + wr * 64 + m * 16) * RWD + ct);
                st_pair(grp, (size_t)RWD * 2, fr, fq, pack_f4x2(acc[ai][0][m][0], acc[ai][0][m][1]), pack_f4x2(acc[ai][1][m][0], acc[ai][1][m][1])); }
        }
    }
};
struct EpiGate1 { static constexpr bool PERM = true; EPI_NO_PRE EPI_ZERO_INIT
    bf16_t* TMP; const bf16_t* PROJ; int gcol0;
    __device__ __forceinline__ void operator()(const f32x4 (&acc)[2][2][4][2], const ss_t (&pre)[2], const Unit& u, int wr, int wc, int fr, int fq) const {
        const int row0 = EPI_ROW0, ct = u.pn * BM + 64 * wc, col0 = ct + 8 * fq;
        EPI_FOR_AI_M { const size_t row = (size_t)(row0 + ai * HALF + m * 16);
            f32x4 g00, g01, g10, g11; unpack_f4x2(*(const u32x4*)(PROJ + row * ICP + gcol0 + col0), g00, g01); unpack_f4x2(*(const u32x4*)(PROJ + row * ICP + gcol0 + col0 + 32), g10, g11);
            st_pair((char*)(TMP + (size_t)(u.pm * BM + ai * HALF + wr * 64 + m * 16) * DM + ct), (size_t)DM * 2, fr, fq, pack_f4x2(acc[ai][0][m][0] * g00, acc[ai][0][m][1] * g01), pack_f4x2(acc[ai][1][m][0] * g10, acc[ai][1][m][1] * g11));
            if (m & 1) asm volatile("" ::: "memory"); }
    }
};
struct EpiGate2 { static constexpr bool PERM = true; EPI_NO_PRE EPI_ZERO_INIT
    const bf16_t* TMP; const bf16_t* PROJ; int gcol0; bf16_t* O;
    __device__ __forceinline__ void operator()(const f32x4 (&acc)[2][2][4][2], const ss_t (&pre)[2], const Unit& u, int wr, int wc, int fr, int fq) const {
        const int row0 = EPI_ROW0, ct = u.pn * BM + 64 * wc, col0 = ct + 8 * fq;
        EPI_FOR_AI_M { const size_t row = (size_t)(row0 + ai * HALF + m * 16);
            f32x4 g00, g01, g10, g11, t00, t01, t10, t11; unpack_f4x2(*(const u32x4*)(PROJ + row * ICP + gcol0 + col0), g00, g01); unpack_f4x2(*(const u32x4*)(PROJ + row * ICP + gcol0 + col0 + 32), g10, g11);
            unpack_f4x2(*(const u32x4*)(TMP + row * DM + col0), t00, t01); unpack_f4x2(*(const u32x4*)(TMP + row * DM + col0 + 32), t10, t11);
            st_pair((char*)(O + (size_t)(u.pm * BM + ai * HALF + wr * 64 + m * 16) * DM + ct), (size_t)DM * 2, fr, fq, pack_f4x2(t00 + acc[ai][0][m][0] * g00, t01 + acc[ai][0][m][1] * g01), pack_f4x2(t10 + acc[ai][1][m][0] * g10, t11 + acc[ai][1][m][1] * g11));
            if (m & 1) asm volatile("" ::: "memory"); }
    }
};
struct EpiResid { static constexpr bool PERM = true; EPI_NO_PRE
    bf16_t* XB; ss_t* SS;
    __device__ __forceinline__ void init(f32x4 (&acc)[2][2][4][2], const Unit& u, int wr, int wc, int fr, int fq) const {
        const int row0 = EPI_ROW0, col0 = u.pn * BM + 64 * wc + 8 * fq;
        EPI_FOR_AI_M { const bf16_t* rowp = XB + (size_t)(row0 + ai * HALF + m * 16) * DM + col0;
            unpack_f4x2(*(const u32x4*)rowp, acc[ai][0][m][0], acc[ai][0][m][1]); unpack_f4x2(*(const u32x4*)(rowp + 32), acc[ai][1][m][0], acc[ai][1][m][1]); }
    }
    __device__ __forceinline__ void operator()(const f32x4 (&acc)[2][2][4][2], const ss_t (&pre)[2], const Unit& u, int wr, int wc, int fr, int fq) const {
        EPI_FOR_AI_M { const size_t r0 = (size_t)(u.pm * BM + ai * HALF + wr * 64 + m * 16);
            st_pair((char*)(XB + r0 * DM + u.pn * BM + 64 * wc), (size_t)DM * 2, fr, fq, pack_f4x2(acc[ai][0][m][0], acc[ai][0][m][1]), pack_f4x2(acc[ai][1][m][0], acc[ai][1][m][1]));
            ss_add(SS, r0 + fr, sq8(acc[ai][0][m][0], acc[ai][0][m][1]) + sq8(acc[ai][1][m][0], acc[ai][1][m][1]), fq, fr); }
    }
};
struct EpiSwiglu { static constexpr bool PERM = true; EPI_ZERO_INIT
    bf16_t* H; const ss_t* SS; EPI_SS_PRE(SS)
    __device__ __forceinline__ void operator()(const f32x4 (&acc)[2][2][4][2], const ss_t (&pre)[2], const Unit& u, int wr, int wc, int fr, int fq) const {
        const int row0 = EPI_ROW0, col0 = u.pn * HALF + wc * 32 + 8 * fq;
        EPI_FOR_AI_M { const size_t row = (size_t)(row0 + ai * HALF + m * 16); const float rs = rstd_raw(pre_get(pre, ai * 4 + m, fr));
            const f32x4 g0 = acc[ai][0][m][0] * rs, g1 = acc[ai][0][m][1] * rs, u0 = acc[ai][1][m][0] * rs, u1 = acc[ai][1][m][1] * rs;
            *(u32x4*)(H + row * FF + col0) = pack_f4x2(g0 * sigmoid4(g0) * u0, g1 * sigmoid4(g1) * u1); }
    }
};
struct EpiPle { static constexpr bool PERM = true; EPI_ZERO_INIT EPI_SS_PRE(SSi)
    const bf16_t* XB; bf16_t* XO; const bf16_t* PP; const ss_t* SSi; ss_t* SSo;
    __device__ __forceinline__ void operator()(const f32x4 (&acc)[2][2][4][2], const ss_t (&pre)[2], const Unit& u, int wr, int wc, int fr, int fq) const {
        const int col0 = u.pn * BM + 64 * wc + 8 * fq;
        EPI_FOR_AI_M { const size_t r0 = (size_t)(u.pm * BM + ai * HALF + wr * 64 + m * 16), row = r0 + fr; const float rs = rstd_raw(pre_get(pre, ai * 4 + m, fr));
            f32x4 x00, x01, x10, x11, p00, p01, p10, p11; unpack_f4x2(*(const u32x4*)(XB + row * DM + col0), x00, x01); unpack_f4x2(*(const u32x4*)(XB + row * DM + col0 + 32), x10, x11);
            unpack_f4x2(*(const u32x4*)(PP + row * DM + col0), p00, p01); unpack_f4x2(*(const u32x4*)(PP + row * DM + col0 + 32), p10, p11);
            x00 += sigmoid4(acc[ai][0][m][0] * rs) * p00; x01 += sigmoid4(acc[ai][0][m][1] * rs) * p01; x10 += sigmoid4(acc[ai][1][m][0] * rs) * p10; x11 += sigmoid4(acc[ai][1][m][1] * rs) * p11;
            st_pair((char*)(XO + r0 * DM + u.pn * BM + 64 * wc), (size_t)DM * 2, fr, fq, pack_f4x2(x00, x01), pack_f4x2(x10, x11));
            ss_add(SSo, row, sq8(x00, x01) + sq8(x10, x11), fq, fr);
            if (m & 1) asm volatile("" ::: "memory"); }
    }
};
#undef EPI_ROW0
#undef EPI_FOR_AI_M
}

constexpr size_t MiB = 1u << 20;
constexpr size_t al1m(size_t x) { return (x + MiB - 1) / MiB * MiB; }
constexpr size_t WS_CTL = 0, CTL_ZERO_BYTES = 1 * MiB;
constexpr size_t SZ_WIN = (size_t)ICP * DM * 2, SZ_POOLW = (size_t)PWD * 256 * 2, SZ_LORA = (size_t)3072 * LK * 2, SZ_PPOOL = (size_t)DM * PWD * 2, SZ_PRWKV = (size_t)DM * RWD * 2,
                 SZ_WOUT = (size_t)DM * DM * 2, SZ_WGU = (size_t)2 * FF * DM * 2, SZ_WDN = (size_t)DM * FF * 2, SZ_WPG = (size_t)DM * DM * 2, SZ_WPP = (size_t)DM * PLE * 2;
constexpr size_t WS_WIN = 1 * MiB, WS_POOLW = WS_WIN + SZ_WIN, WS_LORA = WS_POOLW + SZ_POOLW, WS_PPOOL = WS_LORA + SZ_LORA, WS_PRWKV = WS_PPOOL + SZ_PPOOL, WS_WOUT = WS_PRWKV + SZ_PRWKV,
                 WS_WGU = WS_WOUT + SZ_WOUT, WS_WDN = WS_WGU + SZ_WGU, WS_WPG = WS_WDN + SZ_WDN, WS_WPP = WS_WPG + SZ_WPG, WS_WEND = WS_WPP + SZ_WPP;
constexpr size_t WS_PB = al1m(WS_WEND);
constexpr size_t WS_XN = al1m(WS_PB + (size_t)MT * PLE * 2);
constexpr size_t WS_AA = al1m(WS_XN + (size_t)MT * DM * 2);
constexpr size_t WS_GG = al1m(WS_AA + (size_t)MT * RWD * 2);
constexpr size_t WS_PP = al1m(WS_GG + (size_t)MT * RWD * 2);
constexpr size_t WS_PROJ = al1m(WS_PP + (size_t)MT * DM * 2);
constexpr size_t WS_HID = WS_PROJ;
constexpr size_t WS_D = al1m(WS_PROJ + (size_t)MT * ICP * 2);
constexpr size_t WS_LIN = al1m(WS_D + (size_t)MT * PWD * 2);
constexpr size_t WS_YA = al1m(WS_LIN + (size_t)MT * LK * 2);
constexpr size_t WS_DEC = al1m(WS_YA + (size_t)MT * PWD * 2);
constexpr size_t WS_BS = al1m(WS_DEC + (size_t)MT * RWD * 4);
constexpr size_t WS_Y = al1m(WS_BS + (size_t)MT * 16 * 4);
constexpr size_t SZ_BH = (size_t)MT * RWD * 2;
constexpr size_t WS_YB = al1m(WS_Y + (size_t)MT * RWD * 4);
constexpr size_t WS_TMP = al1m(WS_YB + SZ_BH);
constexpr size_t WS_MRG = al1m(WS_TMP + (size_t)MT * DM * 4);
constexpr size_t WS_SS = al1m(WS_MRG + (size_t)MT * DM * 2);
constexpr size_t WS_END_OLD = al1m(WS_MRG + (size_t)MT * DM * 2);
static_assert((size_t)MT * FF * 2 <= (size_t)MT * ICP * 2, "HID overlay");

constexpr size_t WS_XB2 = al1m(WS_SS + (size_t)3 * MT * 4);
constexpr size_t CBSZ = 12096, CB_BS = 12032, CB_P1T = 0, CB_RT = 2048, CB_BK = 4096, CB_VT = 8192, CB_P2T = 10240, CB_MBT = 10752, CB_MKT = 11264, CB_GC = 11776;
constexpr size_t CB_N = (size_t)(MT / 16) * 16;
static_assert(WS_MRG + (size_t)MT * DM * 2 - WS_TMP >= CB_N * CBSZ, "chunk blocks fit in TMP | MRG");
constexpr size_t WS_END = al1m(WS_XB2 + (size_t)MT * DM * 2);
constexpr int CW_BAR = 4096;
constexpr int NWAVES = 8, NTHR = 512;
constexpr int RING_BYTES = 131072, LDSCTL_OFF = RING_BYTES, LDS_BYTES = 147456;

#define XB_TMO      128
#define XB_XCNT(j)  (256  + 64 * (j))
#define XB_XSUB(j)  (1280 + 64 * (j))
#define XB_XGEN(j)  (2304 + 64 * (j))
#define XB_TOP      3328
#define XB_TOPGEN   3392
#define XCD_BAR_WORDS 3456
#define XB_SPIN_CAP (1u << 18)

__device__ __forceinline__ unsigned xb_ld(unsigned* p)              { return __hip_atomic_load(p, __ATOMIC_RELAXED, __HIP_MEMORY_SCOPE_AGENT); }
__device__ __forceinline__ unsigned xb_add(unsigned* p, unsigned v) { return __hip_atomic_fetch_add(p, v, __ATOMIC_RELAXED, __HIP_MEMORY_SCOPE_AGENT); }
__device__ __forceinline__ unsigned xb_xcc_id() { return (unsigned)__builtin_amdgcn_s_getreg((3 << 11) | 20) & 0xFu; }
#define XB_SPIN(cond, bar) do { unsigned _sp = 0; while (cond) { __builtin_amdgcn_s_sleep(1); \
    if ((++_sp & 255u) == 0u) { if (xb_ld(&(bar)[XB_TMO])) break; if (_sp > XB_SPIN_CAP) { atomicAdd(&(bar)[XB_TMO], 1u); break; } } } } while (0)

struct XcdBarrier {
    unsigned* bar; unsigned x;
    volatile LAS unsigned* st;
};

__device__ __forceinline__ XcdBarrier xcd_barrier_post(unsigned* bar, volatile LAS unsigned* st) {
    XcdBarrier b; b.bar = bar; b.x = xb_xcc_id(); b.st = st;
    if (threadIdx.x == 0) (void)xb_add(&bar[XB_XCNT(b.x)], 1u);
    return b;
}
__device__ __forceinline__ void xcd_barrier_complete(unsigned* bar, unsigned x, unsigned& nloc, unsigned& nx) {
    const unsigned G = gridDim.x * gridDim.y * gridDim.z;
    unsigned sum, cnt, mine, sp = 0u;
    for (;;) {
        sum = 0u; cnt = 0u; mine = 0u;
#pragma unroll
        for (unsigned j = 0; j < 16; ++j) { const unsigned c = xb_ld(&bar[XB_XCNT(j)]); sum += c; cnt += (c > 0u) ? 1u : 0u; mine = (j == x) ? c : mine; }
        if (sum == G) break;
        __builtin_amdgcn_s_sleep(1);
        if ((++sp & 255u) == 0u) { if (xb_ld(&bar[XB_TMO])) break; if (sp > XB_SPIN_CAP) { atomicAdd(&bar[XB_TMO], 1u); break; } }
    }
    nloc = mine > 0u ? mine : 1u; nx = cnt > 0u ? cnt : 1u;
}

__device__ __forceinline__ void xcd_barrier(const XcdBarrier& b) {
    asm volatile("s_waitcnt vmcnt(0)" ::: "memory");
    __syncthreads();
    if (threadIdx.x == 0) {
        unsigned* bar = b.bar;
        __builtin_amdgcn_s_waitcnt(0);
        unsigned nloc = b.st[0], nx = b.st[1];
        if (nloc == 0u) { xcd_barrier_complete(bar, b.x, nloc, nx); b.st[0] = nloc; b.st[1] = nx; }
        const unsigned old = xb_add(&bar[XB_XSUB(b.x)], 1u);
        const unsigned gen = old / nloc;
        if (old + 1u == (gen + 1u) * nloc) {
            __builtin_amdgcn_fence(__ATOMIC_RELEASE, "agent");
            asm volatile("s_waitcnt vmcnt(0)" ::: "memory");
            const unsigned og = xb_add(&bar[XB_TOP], 1u);
            const unsigned tg = og / nx;
            if (og + 1u == (tg + 1u) * nx) xb_add(&bar[XB_TOPGEN], 1u);
            else XB_SPIN(xb_ld(&bar[XB_TOPGEN]) == tg, bar);
            __builtin_amdgcn_fence(__ATOMIC_ACQUIRE, "agent");
            xb_add(&bar[XB_XGEN(b.x)], 1u);
            asm volatile("s_waitcnt vmcnt(0)" ::: "memory");
        } else {
            XB_SPIN(xb_ld(&bar[XB_XGEN(b.x)]) == gen, bar);
            __builtin_amdgcn_fence(__ATOMIC_ACQUIRE, "agent");
            asm volatile("s_waitcnt vmcnt(0)" ::: "memory");
        }
    }
    __syncthreads();
}


struct Args {
    const float* in[33]; float* out; unsigned char* ws; int ph_lo, ph_hi;
};
struct Frame {
    LAS unsigned char* lds; int G;
    const LAS unsigned long long* ptab; float* out; unsigned char* ws;
};
#define GAS __attribute__((address_space(1)))
__device__ __forceinline__ const float* ldptr(const LAS unsigned long long* tab, int k) { const unsigned long long v = tab[k]; const unsigned lo = __builtin_amdgcn_readfirstlane((unsigned)v), hi = __builtin_amdgcn_readfirstlane((unsigned)(v >> 32));
    return (const float*)(const GAS float*)(((unsigned long long)hi << 32) | lo); }
__device__ __forceinline__ unsigned char* fresh(unsigned char* p) { GAS unsigned char* q = (GAS unsigned char*)p; asm volatile("" : "+s"(q)); return (unsigned char*)q; }
__device__ __forceinline__ int fresh_i(int v) { asm volatile("" : "+s"(v)); return v; }
#define INP(k) ldptr(F.ptab, (k))
#define PHASE_L const int l = fresh_i(l_in); (void)l;
#define PHASE_IDS int tid_ = threadIdx.x; asm volatile("" : "+v"(tid_)); const int tid = tid_, lane = tid & 63, wave = __builtin_amdgcn_readfirstlane(tid >> 6), gtid = blockIdx.x * NTHR + tid, gw = blockIdx.x * NWAVES + wave; (void)lane; (void)wave; (void)gtid; (void)gw;
#define VM_WAIT() asm volatile("s_waitcnt vmcnt(0)" ::: "memory")
#define LDS_WAIT() asm volatile("s_waitcnt lgkmcnt(0)" ::: "memory")
constexpr int NT_ALL_SHIFT = 9;

__device__ __forceinline__ void row_info(int m, int& b, int& t, bool& samp) { samp = m >= MPR; if (samp) { b = (m - MPR) >> 6; t = (m - MPR) & 63; } else { b = m >> 11; t = m & 2047; } }

__device__ __forceinline__ void transpose_item(const float* W, int N, bf16_t* WT, int ldk, int k0, int n0, int drow0, LAS float* scr, int lane, const float* cscale = nullptr, const float* rscale = nullptr) {
    f32x4 cs = (f32x4){1.f, 1.f, 1.f, 1.f}; if (cscale) cs = *(const f32x4*)(cscale + n0 + 4 * (lane & 7));
    const int c = lane & 7;
    f32x4 g0 = (f32x4){1.f, 1.f, 1.f, 1.f}, g1 = g0;
    if (rscale) { g0 = *(const f32x4*)(rscale + k0 + 8 * c); g1 = *(const f32x4*)(rscale + k0 + 8 * c + 4); }
    f32x4 v[8];
#pragma unroll
    for (int i = 0; i < 8; ++i) v[i] = *(const f32x4*)(W + (size_t)(k0 + 8 * i + (lane >> 3)) * N + n0 + 4 * (lane & 7));
#pragma unroll
    for (int i = 0; i < 8; ++i) { LAS float* d = scr + (8 * i + (lane >> 3)) * 33 + 4 * (lane & 7); const f32x4 t = v[i] * cs; d[0] = t.x; d[1] = t.y; d[2] = t.z; d[3] = t.w; }
    LDS_WAIT(); asm volatile("" ::: "memory");
#pragma unroll
    for (int j = 0; j < 4; ++j) { const int n = (lane >> 3) + 8 * j; const LAS float* sp = scr + (8 * c) * 33 + n;
        u32x4 o; o.x = cvt_pk_bf16(sp[0 * 33] * g0.x, sp[1 * 33] * g0.y); o.y = cvt_pk_bf16(sp[2 * 33] * g0.z, sp[3 * 33] * g0.w); o.z = cvt_pk_bf16(sp[4 * 33] * g1.x, sp[5 * 33] * g1.y); o.w = cvt_pk_bf16(sp[6 * 33] * g1.z, sp[7 * 33] * g1.w);
        *(u32x4*)(WT + (size_t)(drow0 + n) * ldk + k0 + 8 * c) = o; }
    LDS_WAIT(); asm volatile("" ::: "memory");
}
__device__ __forceinline__ void convert_weights(Frame& F, int l_in) {
    PHASE_IDS
    unsigned char* const wsl = fresh(F.ws);
    PHASE_L
    LAS float* scr = (LAS float*)(F.lds + wave * 16384);
    const int NGW = fresh_i(F.G) * NWAVES;
    unsigned char* ws = wsl;
    constexpr int I_WIN = (DM / 64) * (ICOLS / 32), I_PW = 4 * (256 / 64) * (256 / 32), I_PP = (PWD / 64) * (DM / 32), I_WO = (DM / 64) * (DM / 32), I_FG = (DM / 64) * (FF / 32),
                  I_FD = (FF / 64) * (DM / 32), I_PL = (PLE / 64) * (DM / 32);
    constexpr int NITEMS = I_WIN + I_PW + 2 * I_PP + I_WO + 2 * I_FG + I_FD + I_WO + I_PL;
    for (int it = gw; it < NITEMS; it += NGW) {
        int r = it;
        if (r < I_WIN) { const int nblk = ICOLS / 32, kb = r / nblk, nb = r % nblk, n0 = nb * 32; transpose_item(INP(8) + (size_t)l * DM * ICOLS, ICOLS, (bf16_t*)(ws + WS_WIN), DM, kb * 64, n0, n0 < 4384 ? n0 : n0 + 224, scr, lane, nullptr, INP(7) + (size_t)l * DM); continue; } r -= I_WIN;
        if (r < I_PW) { const int g = r >> 5, rr = r & 31, kb = rr >> 3, nb = rr & 7; transpose_item(INP(10) + ((size_t)l * 4 + g) * 65536, 256, (bf16_t*)(ws + WS_POOLW) + (size_t)g * 65536, 256, kb * 64, nb * 32, nb * 32, scr, lane, INP(11) + (size_t)l * PWD + g * 256); continue; } r -= I_PW;
        if (r < I_PP) { const int nblk = DM / 32, kb = r / nblk, nb = r % nblk; transpose_item(INP(22) + (size_t)l * PWD * DM, DM, (bf16_t*)(ws + WS_PPOOL), PWD, kb * 64, nb * 32, nb * 32, scr, lane); continue; } r -= I_PP;
        if (r < I_PP) { const int nblk = DM / 32, kb = r / nblk, nb = r % nblk; transpose_item(INP(23) + (size_t)l * RWD * DM, DM, (bf16_t*)(ws + WS_PRWKV), RWD, kb * 64, nb * 32, nb * 32, scr, lane); continue; } r -= I_PP;
        if (r < I_WO) { const int nblk = DM / 32, kb = r / nblk, nb = r % nblk; transpose_item(INP(24) + (size_t)l * DM * DM, DM, (bf16_t*)(ws + WS_WOUT), DM, kb * 64, nb * 32, nb * 32, scr, lane); continue; } r -= I_WO;
        if (r < I_FG) { const int nblk = FF / 32, kb = r / nblk, nb = r % nblk, n0 = nb * 32; transpose_item(INP(26) + (size_t)l * DM * FF, FF, (bf16_t*)(ws + WS_WGU), DM, kb * 64, n0, 256 * (n0 >> 7) + 64 * ((n0 & 127) >> 5), scr, lane, nullptr, INP(25) + (size_t)l * DM); continue; } r -= I_FG;
        if (r < I_FG) { const int nblk = FF / 32, kb = r / nblk, nb = r % nblk, n0 = nb * 32; transpose_item(INP(27) + (size_t)l * DM * FF, FF, (bf16_t*)(ws + WS_WGU), DM, kb * 64, n0, 256 * (n0 >> 7) + 64 * ((n0 & 127) >> 5) + 32, scr, lane, nullptr, INP(25) + (size_t)l * DM); continue; } r -= I_FG;
        if (r < I_FD) { const int nblk = DM / 32, kb = r / nblk, nb = r % nblk; transpose_item(INP(28) + (size_t)l * FF * DM, DM, (bf16_t*)(ws + WS_WDN), FF, kb * 64, nb * 32, nb * 32, scr, lane); continue; } r -= I_FD;
        if (r < I_WO) { const int nblk = DM / 32, kb = r / nblk, nb = r % nblk; transpose_item(INP(30) + (size_t)l * DM * DM, DM, (bf16_t*)(ws + WS_WPG), DM, kb * 64, nb * 32, nb * 32, scr, lane, nullptr, INP(29) + (size_t)l * DM); continue; } r -= I_WO;
        { const int nblk = DM / 32, kb = r / nblk, nb = r % nblk; transpose_item(INP(31) + (size_t)l * PLE * DM, DM, (bf16_t*)(ws + WS_WPP), PLE, kb * 64, nb * 32, nb * 32, scr, lane); }
    }
    const int NT = fresh_i(F.G) * NTHR;
    { u32x4* z = (u32x4*)((bf16_t*)(ws + WS_WIN) + (size_t)4384 * DM); for (int i = gtid; i < 224 * DM * 2 / 16; i += NT) z[i] = (u32x4){0u, 0u, 0u, 0u}; }
    { bf16_t* LT = (bf16_t*)(ws + WS_LORA); const float* wd = INP(13) + (size_t)l * 64 * RWD; const float* wa = INP(15) + (size_t)l * 64 * RWD; const float* wg = INP(16) + (size_t)l * 160 * RWD;
      for (int i = gtid; i < 3072 * (LK / 8); i += NT) { const int n = i / (LK / 8), k0 = (i % (LK / 8)) * 8; const int kind = n >> 10, c = n & 1023; float f[8];
#pragma unroll
          for (int j = 0; j < 8; ++j) { const int k = k0 + j; float v = 0.f;
              if (kind == 0) { if (k < 64) v = wd[(size_t)k * RWD + c]; }
              else if (kind == 1) { if (k >= 64 && k < 128) v = wa[(size_t)(k - 64) * RWD + c]; }
              else { if (k >= 128 && k < 288) v = wg[(size_t)(k - 128) * RWD + c]; }
              f[j] = v; }
          *(u32x4*)(LT + (size_t)n * LK + k0) = pack8(f); } }
    { bf16_t* PB = (bf16_t*)(ws + WS_PB); const float* pp = INP(5) + (size_t)l * MPR * PLE; const float* ps = INP(6) + (size_t)l * (MT - MPR) * PLE;
      for (int i = gtid; i < MT * PLE / 8; i += NT) { const size_t e = (size_t)i * 8; const float* src = e < (size_t)MPR * PLE ? pp + e : ps + (e - (size_t)MPR * PLE);
          const f32x4 a = *(const f32x4*)src, b = *(const f32x4*)(src + 4); *(u32x4*)(PB + e) = pg8::pack_f4x2(a, b); } }
}

__device__ __forceinline__ void xb_from_input(Frame& F) {
    PHASE_IDS
    unsigned char* const wsl = fresh(F.ws);
    const int NGW = fresh_i(F.G) * NWAVES; bf16_t* XB = (bf16_t*)(wsl + WS_XN); pg8::ss_t* SS = (pg8::ss_t*)(wsl + WS_SS);
    for (int m = gw; m < MT; m += NGW) {
        const float* src = m < MPR ? INP(0) + (size_t)m * DM : INP(1) + (size_t)(m - MPR) * DM;
        f32x4 v[8]; float s = 0.f;
#pragma unroll
        for (int j = 0; j < 8; ++j) { v[j] = *(const f32x4*)(src + 4 * lane + 256 * j); s += (v[j].x * v[j].x + v[j].y * v[j].y) + (v[j].z * v[j].z + v[j].w * v[j].w); }
        s = wave_sum(s);
        if (lane == 0) SS[m] = pg8::ss_fix(s);
#pragma unroll
        for (int j = 0; j < 8; ++j) { u32x2 w; w.x = cvt_pk_bf16(v[j].x, v[j].y); w.y = cvt_pk_bf16(v[j].z, v[j].w); *(u32x2*)(XB + (size_t)m * DM + 4 * lane + 256 * j) = w; }
    }
}
__device__ __forceinline__ void final_norm(Frame& F, const float* gain) {
    PHASE_IDS
    unsigned char* const wsl = fresh(F.ws);
    const int NGW = fresh_i(F.G) * NWAVES; const bf16_t* XB = (const bf16_t*)(wsl + ((NL & 1) ? WS_XB2 : WS_XN));
    f32x4 g[8];
#pragma unroll
    for (int j = 0; j < 8; ++j) g[j] = *(const f32x4*)(gain + 4 * lane + 256 * j);
    for (int m = gw; m < MT; m += NGW) {
        f32x4 v[8]; float s = 0.f;
#pragma unroll
        for (int j = 0; j < 8; ++j) { const u32x2 w = *(const u32x2*)(XB + (size_t)m * DM + 4 * lane + 256 * j); v[j] = (f32x4){bf_lo(w.x), bf_hi(w.x), bf_lo(w.y), bf_hi(w.y)};
            s += (v[j].x * v[j].x + v[j].y * v[j].y) + (v[j].z * v[j].z + v[j].w * v[j].w); }
        const float rstd = __builtin_amdgcn_rsqf(wave_sum(s) * (1.0f / DM) + NORM_EPS);
#pragma unroll
        for (int j = 0; j < 8; ++j) *(f32x4*)(F.out + (size_t)m * DM + 4 * lane + 256 * j) = v[j] * rstd * g[j];
    }
}

__device__ __forceinline__ void load_z(float (&z)[8], const bf16_t* PROJ, const float* past, int m0, int t, bool samp, int c0) {
    if (t >= 0) { unpack8(*(const u32x4*)(PROJ + (size_t)(m0 + t) * ICP + c0), z); }
    else if (samp) { const float* p = past + (size_t)(15 + t) * PWD + c0; const f32x4 a = *(const f32x4*)p, b = *(const f32x4*)(p + 4); z[0] = a.x; z[1] = a.y; z[2] = a.z; z[3] = a.w; z[4] = b.x; z[5] = b.y; z[6] = b.z; z[7] = b.w; }
    else {
#pragma unroll
        for (int j = 0; j < 8; ++j) z[j] = 0.f; }
}
__device__ __forceinline__ void prep1_phase(Frame& F, int l_in) {
    PHASE_IDS
    unsigned char* const wsl = fresh(F.ws);
    PHASE_L
    const int NT = fresh_i(F.G) * NTHR; const bf16_t* PROJ = (const bf16_t*)(wsl + WS_PROJ);
    { bf16_t* D = (bf16_t*)(wsl + WS_D);
      for (int it = gtid; it < (MT / 16) * 128; it += NT) {
          const int oct = it & 127, run = it >> 7, mrow = run * 16, c0 = oct * 8, win = 2 << (c0 >> 8);
          int b, t0; bool samp; row_info(mrow, b, t0, samp);
          const int T = samp ? TS : TP, mseq = mrow - t0;
          const float* past = INP(3) + ((size_t)l * 8 + b) * 15 * PWD;
          float* npool = F.out + (samp ? O_POS : O_POP) + ((size_t)l * 8 + b) * 15 * PWD;
          float S[8], z[8];
#pragma unroll
          for (int j = 0; j < 8; ++j) S[j] = 0.f;
          for (int j = 1; j < win; ++j) { load_z(z, PROJ, past, mseq, t0 - j, samp, c0);
#pragma unroll
              for (int q = 0; q < 8; ++q) S[q] += z[q]; }
          for (int i = 0; i < 16; ++i) { const int t = t0 + i; float cur[8]; load_z(cur, PROJ, past, mseq, t, samp, c0);
              const int cnt = samp ? win : (t + 1 < win ? t + 1 : win); const float inv = 1.0f / (float)cnt; float d[8];
#pragma unroll
              for (int q = 0; q < 8; ++q) { S[q] += cur[q]; d[q] = S[q] * inv - cur[q]; }
              *(u32x4*)(D + (size_t)(mseq + t) * PWD + c0) = pack8(d);
              if (t >= T - 15) { float* o = npool + (size_t)(t - (T - 15)) * PWD + c0; *(f32x4*)o = (f32x4){cur[0], cur[1], cur[2], cur[3]}; *(f32x4*)(o + 4) = (f32x4){cur[4], cur[5], cur[6], cur[7]}; }
              load_z(z, PROJ, past, mseq, t - win + 1, samp, c0);
#pragma unroll
              for (int q = 0; q < 8; ++q) S[q] -= z[q]; }
      } }
    { bf16_t* LIN = (bf16_t*)(wsl + WS_LIN); const float* mu = INP(9) + (size_t)l * RPJ + 3072;
      for (int it = gtid; it < MT * (LK / 8); it += NT) {
          const int m = it / (LK / 8), c0 = (it % (LK / 8)) * 8; float o[8];
          if (c0 >= 288) {
#pragma unroll
              for (int j = 0; j < 8; ++j) o[j] = 0.f;
          } else {
              int b, t; bool samp; row_info(m, b, t, samp);
              float cur[8], prv[8]; unpack8(*(const u32x4*)(PROJ + (size_t)m * ICP + 4096 + c0), cur);
              if (t > 0) unpack8(*(const u32x4*)(PROJ + (size_t)(m - 1) * ICP + 4096 + c0), prv);
              else if (samp) { const float* p = INP(2) + ((size_t)l * 8 + b) * RPJ + 3072 + c0;
#pragma unroll
                  for (int j = 0; j < 8; ++j) prv[j] = p[j]; }
              else {
#pragma unroll
                  for (int j = 0; j < 8; ++j) prv[j] = 0.f; }
#pragma unroll
              for (int j = 0; j < 8; ++j) { const float xm = cur[j] + (prv[j] - cur[j]) * mu[c0 + j]; o[j] = c0 < 64 ? tanhf_(xm) : (c0 < 128 ? xm : sigmoidf_(xm)); }
          }
          *(u32x4*)(LIN + (size_t)m * LK + c0) = pack8(o);
      } }
    { pg8::ss_t* SS = (pg8::ss_t*)(wsl + WS_SS); for (int i = gtid; i < 3 * MT; i += NT) SS[i] = 0u; }
    for (int it = gtid; it < 16 * RPJ; it += NT) { const int s = it / RPJ, c = it % RPJ; const int mlast = s < 8 ? s * TP + TP - 1 : MPR + (s - 8) * TS + TS - 1;
        F.out[(s < 8 ? O_SHP : O_SHS) + ((size_t)l * 8 + (s & 7)) * RPJ + c] = __uint_as_float((unsigned)PROJ[(size_t)mlast * ICP + 1024 + c] << 16); }
}

__device__ __forceinline__ unsigned char* cb_ptr(unsigned char* ws, size_t i) { return ws + WS_TMP + i * CBSZ; }
__device__ __forceinline__ float sum16(float x) { x += dpp_f<0xB1>(x); x += dpp_f<0x4E>(x); x += dpp_f<0x141>(x); x += dpp_f<0x140>(x); return x; }
__device__ __forceinline__ f32x4 mfma16(bf16x8 a, bf16x8 b, f32x4 c) { return __builtin_amdgcn_mfma_f32_16x16x32_bf16(a, b, c, 0, 0, 0); }
__device__ __forceinline__ bf16x8 mk8(u32x2 lo, u32x2 hi) { u32x4 w = (u32x4){lo.x, lo.y, hi.x, hi.y}; return __builtin_bit_cast(bf16x8, w); }
typedef __bf16 bf16x2_c __attribute__((ext_vector_type(2)));
__device__ __forceinline__ unsigned cvt_pk_c(float lo, float hi) { const f32x2 v = (f32x2){lo, hi}; const bf16x2_c b = __builtin_convertvector(v, bf16x2_c); return __builtin_bit_cast(unsigned, b); }
__device__ __forceinline__ u32x2 pk4(f32x4 v) { return (u32x2){cvt_pk_c(v.x, v.y), cvt_pk_c(v.z, v.w)}; }
__device__ __forceinline__ unsigned short bf1(float f) { return (unsigned short)(cvt_pk_c(f, 0.f) & 0xffffu); }

__device__ __forceinline__ void spre_phase(Frame& F, int l_in) {
    PHASE_IDS
    unsigned char* const wsl = fresh(F.ws);
    PHASE_L
    const int NGW = fresh_i(F.G) * NWAVES;
    LAS unsigned char* L = F.lds + wave * 16384;
    const bf16_t* PROJ = (const bf16_t*)(wsl + WS_PROJ); const bf16_t* AA = (const bf16_t*)(wsl + WS_AA); const float* DEC = (const float*)(wsl + WS_DEC);
    const int fr = lane & 15, fq = lane >> 4;
    const float* mu = INP(9) + (size_t)l * RPJ;
#define SP_LOAD(it_, R, K, V, A, W, PR, PK, PV) do { const int h_ = (it_) & 15, m0_ = ((it_) >> 4) * 16, ch_ = h_ * 64 + lane; int b_, t0_; bool samp_; row_info(m0_, b_, t0_, samp_); \
        _Pragma("unroll") for (int t = 0; t < 16; ++t) { const size_t mm = (size_t)(m0_ + t); const bf16_t* pc = PROJ + mm * ICP + 1024 + ch_; R[t] = pc[0]; K[t] = pc[1024]; V[t] = pc[2048]; A[t] = AA[mm * RWD + ch_]; W[t] = DEC[mm * RWD + ch_]; } \
        if (t0_ > 0) { const bf16_t* pc = PROJ + (size_t)(m0_ - 1) * ICP + 1024 + ch_; PR = __uint_as_float((unsigned)pc[0] << 16); PK = __uint_as_float((unsigned)pc[1024] << 16); PV = __uint_as_float((unsigned)pc[2048] << 16); } \
        else if (samp_) { const float* sp = INP(2) + ((size_t)l * 8 + b_) * RPJ + ch_; PR = sp[0]; PK = sp[1024]; PV = sp[2048]; } \
        else { PR = 0.f; PK = 0.f; PV = 0.f; } } while (0)
    unsigned short cr[16], ck[16], cv[16], ca[16], nr[16], nk[16], nv[16], na[16]; float cw[16], nw[16]; float pr = 0.f, pk = 0.f, pv = 0.f, npr = 0.f, npk = 0.f, npv = 0.f;
    if (gw < (int)CB_N) SP_LOAD(gw, cr, ck, cv, ca, cw, pr, pk, pv);
    for (int it = gw; it < (int)CB_N; it += NGW) {
        const int h = it & 15, crow = it >> 4, m0 = crow * 16, ch = h * 64 + lane;
        unsigned char* cb = cb_ptr(wsl, (size_t)it);
        const float mur = mu[ch], muk = mu[1024 + ch], muv = mu[2048 + ch];
        const float ckk = (INP(17) + (size_t)l * RWD)[ch], cka = (INP(18) + (size_t)l * RWD)[ch], crk = (INP(19) + (size_t)l * RWD)[ch];
        { const int itn = it + NGW; if (itn < (int)CB_N) SP_LOAD(itn, nr, nk, nv, na, nw, npr, npk, npv); }
        float g = 1.0f; unsigned at2[8], bt2[8], kt2[8], vt2[8]; float hold_a = 0.f, hold_b = 0.f, hold_k = 0.f, hold_v = 0.f;
#pragma unroll
        for (int t = 0; t < 16; ++t) {
            const float xr = __uint_as_float((unsigned)cr[t] << 16), xk = __uint_as_float((unsigned)ck[t] << 16), xv = __uint_as_float((unsigned)cv[t] << 16), av = __uint_as_float((unsigned)ca[t] << 16);
            const float r = xr + (pr - xr) * mur, kx = xk + (pk - xk) * muk, vv = xv + (pv - xv) * muv; pr = xr; pk = xk; pv = xv;
            float kkv = kx * ckk; const float ss = wave_sum(kkv * kkv); kkv *= __builtin_amdgcn_rsqf(fmaxf(ss, 1e-24f));
            const float kh = kx * (1.0f + (av - 1.0f) * cka), bb = kkv * av; const float bsum = wave_sum(r * kh * crk);
            if (lane == 0) *(float*)(cb + CB_BS + t * 4) = bsum;
            const float a_t = -kkv * g; g *= cw[t]; const float ig = __builtin_amdgcn_rcpf(g); const float b_t = bb * ig, k_t = kh * ig, r_t = r * g;
            *(LAS unsigned short*)(L + t * 144 + lane * 2) = bf1(a_t); *(LAS unsigned short*)(L + 2304 + t * 144 + lane * 2) = bf1(b_t);
            *(LAS unsigned short*)(L + 4608 + t * 144 + lane * 2) = bf1(k_t); *(LAS unsigned short*)(L + 6912 + t * 144 + lane * 2) = bf1(r_t);
            if (t & 1) { at2[t >> 1] = cvt_pk_c(hold_a, a_t); bt2[t >> 1] = cvt_pk_c(hold_b, b_t); kt2[t >> 1] = cvt_pk_c(hold_k, k_t); vt2[t >> 1] = cvt_pk_c(hold_v, vv); }
            else { hold_a = a_t; hold_b = b_t; hold_k = k_t; hold_v = vv; }
        }
        *(LAS u32x4*)(L + 9216 + lane * 32) = (u32x4){at2[0], at2[1], at2[2], at2[3]}; *(LAS u32x4*)(L + 9216 + lane * 32 + 16) = (u32x4){at2[4], at2[5], at2[6], at2[7]};
        { u32x4* o = (u32x4*)(cb + CB_BK + lane * 64);
#pragma unroll
          for (int q = 0; q < 4; ++q) o[q] = (u32x4){bt2[2 * q], bt2[2 * q + 1], kt2[2 * q], kt2[2 * q + 1]}; }
        { u32x4* o = (u32x4*)(cb + CB_VT + lane * 32); o[0] = (u32x4){vt2[0], vt2[1], vt2[2], vt2[3]}; o[1] = (u32x4){vt2[4], vt2[5], vt2[6], vt2[7]}; }
        *(float*)(cb + CB_GC + lane * 4) = g;
        asm volatile("" ::: "memory");
#define SP_ROWS(off, j) (*(const LAS bf16x8*)(L + (off) + fr * 144 + (j) * 64 + fq * 16))
        f32x4 nD = (f32x4){0.f, 0.f, 0.f, 0.f}, makD = nD, mrbD = nD, mrkD = nD;
#pragma unroll
        for (int j = 0; j < 2; ++j) { const bf16x8 fa = SP_ROWS(0, j), fb = SP_ROWS(2304, j), fk = SP_ROWS(4608, j), fR = SP_ROWS(6912, j);
            nD = mfma16(fb, fa, nD); makD = mfma16(fk, fa, makD); mrbD = mfma16(fb, fR, mrbD); mrkD = mfma16(fk, fR, mrkD); }
#pragma unroll
        for (int rr = 0; rr < 4; ++rr) { const int s = 4 * fq + rr; if (s >= fr) { nD[rr] = 0.f; makD[rr] = 0.f; } if (s > fr) { mrbD[rr] = 0.f; mrkD[rr] = 0.f; } }
        { const u32x2 mb = pk4(mrbD), mk = pk4(mrkD); *(u32x4*)(cb + CB_MBT + (fr * 4 + fq) * 16) = (u32x4){mb.x, mb.y, mk.x, mk.y}; }
#define SP_WR_RM(off, D) do { _Pragma("unroll") for (int rr = 0; rr < 4; ++rr) *(LAS unsigned short*)(L + (off) + (4 * fq + rr) * 32 + fr * 2) = bf1((D)[rr]); } while (0)
#define SP_WR_TR(off, D) do { *(LAS u32x2*)(L + (off) + fr * 32 + fq * 8) = pk4(D); } while (0)
#define SP_FRAG16(off) (fq < 2 ? *(const LAS bf16x8*)(L + (off) + fr * 32 + fq * 16) : (bf16x8){0, 0, 0, 0, 0, 0, 0, 0})
        SP_WR_RM(13568, nD); SP_WR_TR(14080, nD); SP_WR_RM(15616, makD); asm volatile("" ::: "memory");
        f32x4 TD = nD;
#pragma unroll
        for (int rr = 0; rr < 4; ++rr) if (4 * fq + rr == fr) TD[rr] += 1.0f;
#pragma unroll
        for (int itp = 0; itp < 3; ++itp) {
            SP_WR_RM(14592, TD); asm volatile("" ::: "memory");
            const f32x4 p2 = mfma16(SP_FRAG16(13568), SP_FRAG16(14080), (f32x4){0.f, 0.f, 0.f, 0.f}); asm volatile("" ::: "memory");
            SP_WR_RM(13568, p2); SP_WR_TR(14080, p2); asm volatile("" ::: "memory");
            TD = mfma16(SP_FRAG16(14592), SP_FRAG16(14080), TD); asm volatile("" ::: "memory");
        }
        SP_WR_TR(15104, TD); asm volatile("" ::: "memory");
        { const bf16x8 ftt = SP_FRAG16(15104);
#pragma unroll
          for (int blk = 0; blk < 4; ++blk) { const bf16x8 fb = fq < 2 ? *(const LAS bf16x8*)(L + 9216 + (16 * blk + fr) * 32 + fq * 16) : (bf16x8){0, 0, 0, 0, 0, 0, 0, 0};
              const f32x4 d = mfma16(ftt, fb, (f32x4){0.f, 0.f, 0.f, 0.f});
#pragma unroll
              for (int rr = 0; rr < 4; ++rr) *(LAS unsigned short*)(L + 11264 + (4 * fq + rr) * 144 + (16 * blk + fr) * 2) = bf1(d[rr]); }
          const f32x4 p2 = mfma16(SP_FRAG16(15616), ftt, (f32x4){0.f, 0.f, 0.f, 0.f});
          *(u32x2*)(cb + CB_P2T + fr * 32 + fq * 8) = pk4(p2); }
        asm volatile("" ::: "memory");
#pragma unroll
        for (int q = 0; q < 2; ++q) { const int pc = lane + 64 * q, pcc = pc >> 6, pt = (pc >> 2) & 15, pf = pc & 3;
            const u32x2 a0 = *(const LAS u32x2*)(L + 11264 + pt * 144 + (32 * pcc + 4 * pf) * 2), a1 = *(const LAS u32x2*)(L + 11264 + pt * 144 + (32 * pcc + 16 + 4 * pf) * 2);
            const u32x2 r0 = *(const LAS u32x2*)(L + 6912 + pt * 144 + (32 * pcc + 4 * pf) * 2), r1 = *(const LAS u32x2*)(L + 6912 + pt * 144 + (32 * pcc + 16 + 4 * pf) * 2);
            *(u32x4*)(cb + CB_P1T + pc * 16) = (u32x4){a0.x, a0.y, a1.x, a1.y}; *(u32x4*)(cb + CB_RT + pc * 16) = (u32x4){r0.x, r0.y, r1.x, r1.y}; }
        asm volatile("" ::: "memory");
#pragma unroll
        for (int t = 0; t < 16; ++t) { cr[t] = nr[t]; ck[t] = nk[t]; cv[t] = nv[t]; ca[t] = na[t]; cw[t] = nw[t]; }
        pr = npr; pk = npk; pv = npv;
#undef SP_ROWS
#undef SP_LOAD
#undef SP_WR_RM
#undef SP_WR_TR
#undef SP_FRAG16
    }
}

constexpr int SQ_D = 5, SQ_SLOT = 14336, SQ_NSLOT = 7, SQ_DUMP = SQ_NSLOT * SQ_SLOT, SQ_YBUF = SQ_DUMP + 2048;
__device__ __forceinline__ void sseq_phase(Frame& F, int l_in) {
    PHASE_IDS
    unsigned char* const wsl = fresh(F.ws);
    PHASE_L
    const bf16_t* GG = (const bf16_t*)(wsl + WS_GG); bf16_t* YB = (bf16_t*)(wsl + WS_YB);
    const bool is_cons = wave < 4;
    const int fr = lane & 15, fq = lane >> 4, vrow = (wave & 3) * 16 + fr, lw = wave & 3;
    for (int u = blockIdx.x; u < 256; u += fresh_i(F.G)) {
        const bool samp = u >= 128; const int h = u & 15, b = (u >> 4) & 7;
        const int T = samp ? TS : TP, m0 = samp ? MPR + b * TS : b * TP, nch = T / 16, crow0 = m0 / 16;
        f32x4 sreg[4];
        if (samp) { const float* sp = INP(4) + ((((size_t)l * 8 + b) * 16 + h) * 64 + vrow) * 64 + 4 * fq;
#pragma unroll
            for (int kb = 0; kb < 4; ++kb) sreg[kb] = *(const f32x4*)(sp + 16 * kb); }
        else {
#pragma unroll
            for (int kb = 0; kb < 4; ++kb) sreg[kb] = (f32x4){0.f, 0.f, 0.f, 0.f}; }
        const f32x4 gng = *(const f32x4*)(INP(20) + (size_t)l * RWD + h * 64 + 4 * fr), gnb = *(const f32x4*)(INP(21) + (size_t)l * RWD + h * 64 + 4 * fr);
#define SQ_ISSUE(c) do { const unsigned char* src = cb_ptr(wsl, (size_t)(crow0 + (c)) * 16 + h) + (lw * 3) * 1024 + lane * 16; LAS unsigned char* dst = F.lds + ((c) % SQ_NSLOT) * SQ_SLOT + (lw * 3) * 1024; \
        _Pragma("unroll") for (int i = 0; i < 3; ++i) __builtin_amdgcn_global_load_lds((const unsigned*)(src + i * 1024), (LAS unsigned*)(dst + i * 1024), 16, 0, 0); \
        if (lw < 2) __builtin_amdgcn_global_load_lds((const unsigned*)((const unsigned char*)(GG + (size_t)(m0 + (c) * 16 + 8 * lw + (lane >> 3)) * RWD + h * 64) + (lane & 7) * 16), (LAS unsigned*)(F.lds + ((c) % SQ_NSLOT) * SQ_SLOT + 12288 + lw * 1024), 16, 0, 0); \
        else __builtin_amdgcn_global_load_lds((const unsigned*)src, (LAS unsigned*)(F.lds + SQ_DUMP + (lw - 2) * 1024), 16, 0, 0); } while (0)
#define SQ_WAIT(k) do { switch (k) { case 0: asm volatile("s_waitcnt vmcnt(0)" ::: "memory"); break; case 1: asm volatile("s_waitcnt vmcnt(4)" ::: "memory"); break; case 2: asm volatile("s_waitcnt vmcnt(8)" ::: "memory"); break; \
        case 3: asm volatile("s_waitcnt vmcnt(12)" ::: "memory"); break; default: asm volatile("s_waitcnt vmcnt(16)" ::: "memory"); break; } } while (0)
#define SQ_POST(c) do { const LAS unsigned char* Bp = F.lds + ((c) % SQ_NSLOT) * SQ_SLOT; const int tt = 4 * lw + fq; \
        const f32x4 y4 = *(const LAS f32x4*)(F.lds + SQ_YBUF + ((c) & 1) * 4096 + (tt * 64 + 4 * fr) * 4); \
        const float mean = sum16((y4.x + y4.y) + (y4.z + y4.w)) * (1.0f / 64.0f); const f32x4 dv = y4 - mean; \
        const float rstd = __builtin_amdgcn_rsqf(sum16((dv.x * dv.x + dv.y * dv.y) + (dv.z * dv.z + dv.w * dv.w)) * (1.0f / 64.0f) + GN_EPS); \
        const float bs = *(const LAS float*)(Bp + CB_BS + tt * 4); const u32x2 gq = *(const LAS u32x2*)(Bp + 12288 + tt * 128 + fr * 8); \
        f32x4 vv; _Pragma("unroll") for (int j = 0; j < 4; ++j) vv[j] = __uint_as_float((unsigned)(*(const LAS unsigned short*)(Bp + CB_VT + (4 * fr + j) * 32 + tt * 2)) << 16); \
        const f32x4 o = (dv * rstd * gng + gnb + bs * vv) * (f32x4){bf_lo(gq.x), bf_hi(gq.x), bf_lo(gq.y), bf_hi(gq.y)}; \
        *(u32x2*)(YB + (size_t)(m0 + (c) * 16 + tt) * RWD + h * 64 + 4 * fr) = (u32x2){cvt_pk_bf16(o.x, o.y), cvt_pk_bf16(o.z, o.w)}; } while (0)
        __syncthreads();
        if (!is_cons) { const int np = nch < SQ_D ? nch : SQ_D; for (int c = 0; c < np; ++c) SQ_ISSUE(c); SQ_WAIT(np - 1); }
        __syncthreads();
        for (int c = 0; c < nch; ++c) {
            if (is_cons) {
                const LAS unsigned char* B = F.lds + (c % SQ_NSLOT) * SQ_SLOT;
#define SQ_KA(off, cc) (*(const LAS bf16x8*)(B + (off) + (((cc) * 16 + fr) * 4 + fq) * 16))
                const u32x2 vt = *(const LAS u32x2*)(B + CB_VT + vrow * 32 + fq * 8), z2 = (u32x2){0u, 0u};
                const bf16x8 aP2 = mk8(*(const LAS u32x2*)(B + CB_P2T + fr * 32 + fq * 8), z2), aP10 = SQ_KA(CB_P1T, 0), aP11 = SQ_KA(CB_P1T, 1), aR0 = SQ_KA(CB_RT, 0), aR1 = SQ_KA(CB_RT, 1);
                const bf16x8 aM = *(const LAS bf16x8*)(B + CB_MBT + (fr * 4 + fq) * 16);
                bf16x8 aBK[4]; f32x4 gc[4];
#pragma unroll
                for (int kb = 0; kb < 4; ++kb) { aBK[kb] = *(const LAS bf16x8*)(B + CB_BK + ((16 * kb + fr) * 4 + fq) * 16); gc[kb] = *(const LAS f32x4*)(B + CB_GC + (16 * kb + 4 * fq) * 4); }
                __builtin_amdgcn_sched_barrier(0);
                const bf16x8 sB0 = mk8(pk4(sreg[0]), pk4(sreg[1])), sB1 = mk8(pk4(sreg[2]), pk4(sreg[3]));
                f32x4 uD = mfma16(aP2, mk8(vt, z2), (f32x4){0.f, 0.f, 0.f, 0.f});
                uD = mfma16(aP10, sB0, uD); uD = mfma16(aP11, sB1, uD);
                const bf16x8 uvB = mk8(pk4(uD), vt);
                f32x4 nS[4];
#pragma unroll
                for (int kb = 0; kb < 4; ++kb) nS[kb] = mfma16(aBK[kb], uvB, sreg[kb]);
                f32x4 yD = mfma16(aM, uvB, (f32x4){0.f, 0.f, 0.f, 0.f});
                yD = mfma16(aR0, sB0, yD); yD = mfma16(aR1, sB1, yD);
#pragma unroll
                for (int kb = 0; kb < 4; ++kb) sreg[kb] = nS[kb] * gc[kb];
                { LAS float* yo = (LAS float*)(F.lds + SQ_YBUF + (c & 1) * 4096) + (4 * fq) * 64 + vrow; yo[0] = yD[0]; yo[64] = yD[1]; yo[128] = yD[2]; yo[192] = yD[3]; }
#undef SQ_KA
            } else {
                if (c + SQ_D < nch) SQ_ISSUE(c + SQ_D);
                if (c + 1 < nch) { const int last = c + SQ_D < nch ? c + SQ_D : nch - 1; SQ_WAIT(last - (c + 1)); }
                if (c > 0) SQ_POST(c - 1);
            }
            asm volatile("s_waitcnt lgkmcnt(0)" ::: "memory"); __builtin_amdgcn_s_barrier(); asm volatile("" ::: "memory");
        }
        if (!is_cons) SQ_POST(nch - 1);
#undef SQ_ISSUE
#undef SQ_WAIT
#undef SQ_POST
        if (is_cons) { float* so = F.out + (samp ? O_WKS : O_WKP) + ((((size_t)l * 8 + b) * 16 + h) * 64 + vrow) * 64 + 4 * fq;
#pragma unroll
            for (int kb = 0; kb < 4; ++kb) *(f32x4*)(so + 16 * kb) = sreg[kb]; }
    }
}

__device__ __forceinline__ void tile64_mma(const bf16_t* A, int lda, const bf16_t* Bt, int ldb, int K, int m0, int n0, int wave, int lane, f32x4 (&acc)[4][4]) {
    const int kq = K >> 3, kb = wave * kq, lr = lane & 15, lk = (lane >> 4) * 8;
    const bf16_t* ap = A + (size_t)(m0 + lr) * lda + kb + lk; const bf16_t* bp = Bt + (size_t)(n0 + lr) * ldb + kb + lk;
#pragma unroll 2
    for (int k = 0; k < kq; k += 32) {
        bf16x8 af[4], bf[4];
#pragma unroll
        for (int i = 0; i < 4; ++i) { af[i] = *(const bf16x8*)(ap + (size_t)(16 * i) * lda + k); bf[i] = *(const bf16x8*)(bp + (size_t)(16 * i) * ldb + k); }
#pragma unroll
        for (int mi = 0; mi < 4; ++mi)
#pragma unroll
            for (int ni = 0; ni < 4; ++ni) acc[mi][ni] = __builtin_amdgcn_mfma_f32_16x16x32_bf16(bf[ni], af[mi], acc[mi][ni], 0, 0, 0);
    }
}
__device__ __forceinline__ void tile64_reduce(LAS unsigned char* lds, int wave, int lane, const f32x4 (&acc)[4][4], f32x4 (&out)[2]) {
    LAS f32x4* red = (LAS f32x4*)lds;
    __syncthreads();
#pragma unroll
    for (int mi = 0; mi < 4; ++mi)
#pragma unroll
        for (int ni = 0; ni < 4; ++ni) red[(wave * 16 + mi * 4 + ni) * 64 + lane] = acc[mi][ni];
    __syncthreads();
#pragma unroll
    for (int j = 0; j < 2; ++j) { f32x4 s = red[(2 * wave + j) * 64 + lane];
#pragma unroll
        for (int w = 1; w < 8; ++w) s += red[(w * 16 + 2 * wave + j) * 64 + lane];
        out[j] = s; }
}
#define T64_ZERO(acc) do { _Pragma("unroll") for (int mi = 0; mi < 4; ++mi) _Pragma("unroll") for (int ni = 0; ni < 4; ++ni) acc[mi][ni] = (f32x4){0.f, 0.f, 0.f, 0.f}; } while (0)
template <int MODE>
__device__ __forceinline__ void sample_tiles(Frame& F, int l_in) {
    PHASE_IDS
    unsigned char* const wsl = fresh(F.ws);
    PHASE_L
    const size_t xb_cur = (l & 1) ? WS_XB2 : WS_XN, xb_nxt = (l & 1) ? WS_XN : WS_XB2;
    for (int t = blockIdx.x; t < 256; t += fresh_i(F.G)) {
        const int m0 = MPR + (t >> 5) * 64, n0 = (t & 31) * 64;
        f32x4 acc[4][4], o1[2], o2[2]; T64_ZERO(acc);
        if (MODE == 0) { tile64_mma((const bf16_t*)(wsl + WS_YA), PWD, (const bf16_t*)(wsl + WS_PPOOL), PWD, PWD, m0, n0, wave, lane, acc); tile64_reduce(F.lds, wave, lane, acc, o1);
                         T64_ZERO(acc); tile64_mma((const bf16_t*)(wsl + WS_YB), RWD, (const bf16_t*)(wsl + WS_PRWKV), RWD, RWD, m0, n0, wave, lane, acc); tile64_reduce(F.lds, wave, lane, acc, o2); }
        if (MODE == 1) { tile64_mma((const bf16_t*)(wsl + WS_MRG), DM, (const bf16_t*)(wsl + WS_WOUT), DM, DM, m0, n0, wave, lane, acc); tile64_reduce(F.lds, wave, lane, acc, o1); }
        if (MODE == 2) { tile64_mma((const bf16_t*)(wsl + WS_HID), FF, (const bf16_t*)(wsl + WS_WDN), FF, FF, m0, n0, wave, lane, acc); tile64_reduce(F.lds, wave, lane, acc, o1); }
        if (MODE == 3) { tile64_mma((const bf16_t*)(wsl + xb_cur), DM, (const bf16_t*)(wsl + WS_WPG), DM, DM, m0, n0, wave, lane, acc); tile64_reduce(F.lds, wave, lane, acc, o1); }
        if (MODE == 4) { tile64_mma((const bf16_t*)(wsl + WS_PB), PLE, (const bf16_t*)(wsl + WS_WPP), PLE, PLE, m0, n0, wave, lane, acc); tile64_reduce(F.lds, wave, lane, acc, o1); }
#pragma unroll
        for (int j = 0; j < 2; ++j) { const int blk = 2 * wave + j; const size_t row = (size_t)(m0 + 16 * (blk >> 2) + (lane & 15)); const int col = n0 + 16 * (blk & 3) + 4 * (lane >> 4);
            if (MODE == 0) { const bf16_t* PROJ = (const bf16_t*)(wsl + WS_PROJ); const u32x2 g1 = *(const u32x2*)(PROJ + row * ICP + PC_GP + col), g2 = *(const u32x2*)(PROJ + row * ICP + PC_GR + col);
                const f32x4 a = (f32x4){bf_lo(g1.x), bf_hi(g1.x), bf_lo(g1.y), bf_hi(g1.y)} * o1[j] + (f32x4){bf_lo(g2.x), bf_hi(g2.x), bf_lo(g2.y), bf_hi(g2.y)} * o2[j];
                *(u32x2*)((bf16_t*)(wsl + WS_MRG) + row * DM + col) = (u32x2){cvt_pk_bf16(a.x, a.y), cvt_pk_bf16(a.z, a.w)}; }
            if (MODE == 1 || MODE == 2) { bf16_t* p = (bf16_t*)(wsl + xb_cur) + row * DM + col; const u32x2 q = *(const u32x2*)p; const f32x4 x = (f32x4){bf_lo(q.x), bf_hi(q.x), bf_lo(q.y), bf_hi(q.y)} + o1[j];
                *(u32x2*)p = (u32x2){cvt_pk_bf16(x.x, x.y), cvt_pk_bf16(x.z, x.w)}; __hip_atomic_fetch_add((pg8::ss_t*)(wsl + WS_SS) + (size_t)MODE * MT + row, pg8::ss_fix((x.x * x.x + x.y * x.y) + (x.z * x.z + x.w * x.w)), __ATOMIC_RELAXED, __HIP_MEMORY_SCOPE_AGENT); }
            if (MODE == 3) { const u32x2 q = *(const u32x2*)((const bf16_t*)(wsl + WS_PP) + row * DM + col); const u32x2 xq = *(const u32x2*)((const bf16_t*)(wsl + xb_cur) + row * DM + col); bf16_t* p = (bf16_t*)(wsl + xb_nxt) + row * DM + col;
                const float rs = pg8::rstd_of((const pg8::ss_t*)(wsl + WS_SS) + (size_t)2 * MT, row);
                const f32x4 x = (f32x4){bf_lo(xq.x), bf_hi(xq.x), bf_lo(xq.y), bf_hi(xq.y)} + sigmoid4(o1[j] * rs) * (f32x4){bf_lo(q.x), bf_hi(q.x), bf_lo(q.y), bf_hi(q.y)};
                *(u32x2*)p = (u32x2){cvt_pk_bf16(x.x, x.y), cvt_pk_bf16(x.z, x.w)}; __hip_atomic_fetch_add((pg8::ss_t*)(wsl + WS_SS) + row, pg8::ss_fix((x.x * x.x + x.y * x.y) + (x.z * x.z + x.w * x.w)), __ATOMIC_RELAXED, __HIP_MEMORY_SCOPE_AGENT); }
            if (MODE == 4) *(u32x2*)((bf16_t*)(wsl + WS_PP) + row * DM + col) = (u32x2){cvt_pk_bf16(o1[j].x, o1[j].y), cvt_pk_bf16(o1[j].z, o1[j].w)};
        }
    }
    __syncthreads();
}

constexpr int PH_PER_LAYER = 11, N_PHASES = NL * PH_PER_LAYER + 1;
#ifndef MK_REP
#define MK_REP 0
#endif
__global__ void __launch_bounds__(NTHR, 2) mega_fwd(Args args) {
    extern __shared__ __attribute__((aligned(16))) unsigned char lds[];
    Frame F;
    F.lds = (LAS unsigned char*)lds;
    F.G = gridDim.x;
    F.out = args.out; F.ws = args.ws;
    { LAS unsigned long long* pt = (LAS unsigned long long*)(F.lds + LDSCTL_OFF + 1024); F.ptab = pt;
      if (threadIdx.x == 0) {
#define PT_(k) pt[k] = (unsigned long long)args.in[k];
          PT_(0) PT_(1) PT_(2) PT_(3) PT_(4) PT_(5) PT_(6) PT_(7) PT_(8) PT_(9) PT_(10) PT_(11) PT_(12) PT_(13) PT_(14) PT_(15) PT_(16) PT_(17) PT_(18) PT_(19) PT_(20) PT_(21) PT_(22) PT_(23) PT_(24) PT_(25) PT_(26) PT_(27) PT_(28) PT_(29) PT_(30) PT_(31) PT_(32)
#undef PT_
      } }
    volatile LAS unsigned* MISC = (volatile LAS unsigned*)(F.lds + LDSCTL_OFF);
    for (int u = threadIdx.x; u < 256; u += NTHR) ((LAS unsigned*)(F.lds + LDSCTL_OFF))[u] = 0u;
    __syncthreads();
    XcdBarrier bar; bar.bar = (unsigned*)(args.ws + WS_CTL) + CW_BAR; bar.x = 0; bar.st = nullptr;
    if (!MK_PER_PHASE) bar = xcd_barrier_post((unsigned*)(args.ws + WS_CTL) + CW_BAR, MISC + 8);
    const int lo = args.ph_lo, hi = args.ph_hi;
#define IN(k) (lo <= (k) && (k) < hi)
#define REP(k) (1 + ((MK_REP >> (k)) & 1))
#define PHASE(k, ...) do { if (IN(pb + (k))) { for (int rep = 0; rep < REP(k); ++rep) { if (rep) xcd_barrier(bar); __VA_ARGS__ } if (IN(pb + (k) + 1)) xcd_barrier(bar); } } while (0)
#define WSP(off) (fresh(F.ws) + (off))
#define UNPAREN(...) __VA_ARGS__
#define GEMM_M(M_, EPI, EINIT, Aoff, Boff, N_, K_, lda_, ldb_, apn_) do { pg8::Gemm g{(const bf16_t*)WSP(Aoff), (const bf16_t*)WSP(Boff), (M_), (N_), (K_), (lda_), (ldb_), (apn_)}; pg8::StaticOrder S; S.init((M_), (N_), fresh_i(F.G), fresh_i(cid)); \
        pg8::EPI E{UNPAREN EINIT}; pg8::gemm_phase<pg8::EPI, pg8::StaticOrder, true>(ring, g, S, E); } while (0)
#define GEMM(...) GEMM_M(MT, __VA_ARGS__)
#define GEMM_SUB(c0_, M_, EPI, EINIT, Aoff, Boff, N_, K_, lda_, ldb_, apn_) do { pg8::Gemm g{(const bf16_t*)WSP(Aoff), (const bf16_t*)WSP(Boff), (M_), (N_), (K_), (lda_), (ldb_), (apn_)}; pg8::StaticOrder S; \
        const int c0v = (c0_); S.init((M_), (N_), fresh_i(F.G) - c0v, fresh_i(cid) >= c0v ? fresh_i(cid) - c0v : -1); pg8::EPI E{UNPAREN EINIT}; pg8::gemm_phase<pg8::EPI, pg8::StaticOrder, true>(ring, g, S, E); } while (0)
    LAS unsigned char* ring = F.lds;
    const int cid = (int)blockIdx.x;
    for (int l = 0; l < NL; ++l) {
        const int pb = l * PH_PER_LAYER;
#define SSP(i) ((pg8::ss_t*)WSP(WS_SS) + (size_t)(i) * MT)
        const size_t xb_cur = (l & 1) ? WS_XB2 : WS_XN, xb_nxt = (l & 1) ? WS_XN : WS_XB2;
        PHASE(0, { convert_weights(F, l); if (l == 0) xb_from_input(F); });
        PHASE(1, { GEMM(EpiProj, ((bf16_t*)WSP(WS_PROJ), SSP(0)), xb_cur, WS_WIN, ICP, DM, DM, DM, 0); });
        PHASE(2, { prep1_phase(F, l); });
        PHASE(3, { GEMM(EpiBf16, ((bf16_t*)WSP(WS_YA), PWD), WS_D, WS_POOLW, PWD, 256, PWD, 256, 256);
                   GEMM(EpiLora, ((float*)WSP(WS_DEC), (bf16_t*)WSP(WS_AA), (bf16_t*)WSP(WS_GG), INP(12) + (size_t)fresh_i(l) * RWD, INP(14) + (size_t)fresh_i(l) * RWD), WS_LIN, WS_LORA, 3072, LK, LK, LK, 0); });
        PHASE(4, { spre_phase(F, l); });
        PHASE(5, { sseq_phase(F, l); });
        PHASE(6, { GEMM_M(MPR, EpiGate1, ((bf16_t*)WSP(WS_TMP), (const bf16_t*)WSP(WS_PROJ), PC_GP), WS_YA, WS_PPOOL, DM, PWD, PWD, PWD, 0);
                   GEMM_M(MPR, EpiGate2, ((const bf16_t*)WSP(WS_TMP), (const bf16_t*)WSP(WS_PROJ), PC_GR, (bf16_t*)WSP(WS_MRG)), WS_YB, WS_PRWKV, DM, RWD, RWD, RWD, 0);
                   sample_tiles<0>(F, l); });
        PHASE(7, { GEMM_M(MPR, EpiResid, ((bf16_t*)WSP(xb_cur), SSP(1)), WS_MRG, WS_WOUT, DM, DM, DM, DM, 0); sample_tiles<1>(F, l); });
        PHASE(8, { GEMM(EpiSwiglu, ((bf16_t*)WSP(WS_HID), SSP(1)), xb_cur, WS_WGU, 2 * FF, DM, DM, DM, 0);
                   GEMM_SUB((((MT / 256) * (2 * FF / 256)) % fresh_i(F.G)) & ~7, MPR, EpiBf16, ((bf16_t*)WSP(WS_PP), DM), WS_PB, WS_WPP, DM, PLE, PLE, PLE, 0); sample_tiles<4>(F, l); });
        PHASE(9, { GEMM_M(MPR, EpiResid, ((bf16_t*)WSP(xb_cur), SSP(2)), WS_HID, WS_WDN, DM, FF, FF, FF, 0); sample_tiles<2>(F, l); });
        PHASE(10, { GEMM_M(MPR, EpiPle, ((const bf16_t*)WSP(xb_cur), (bf16_t*)WSP(xb_nxt), (const bf16_t*)WSP(WS_PP), SSP(2), SSP(0)), xb_cur, WS_WPG, DM, DM, DM, DM, 0); sample_tiles<3>(F, l); });
#undef SSP
    }
    if (IN(NL * PH_PER_LAYER)) final_norm(F, INP(32));
#undef IN
#undef REP
#undef PHASE
#undef WSP
#undef GEMM
#undef GEMM_M
#undef GEMM_SUB
#undef UNPAREN
}

extern "C" void kernel_launch(void* const* d_in, const int* in_sizes, int n_in, void* d_out, int out_size, void* d_ws, size_t ws_size, hipStream_t stream) {
    static int grid = 0;
    if (grid == 0) {
        if (n_in != 33 || in_sizes[0] != MPR * DM || out_size != (int)O_END || ws_size < WS_END) {
            fprintf(stderr, "kernel_launch: unexpected shapes: n_in %d in0 %d out %d ws %zu (need %zu); nothing launched\n", n_in, n_in > 0 ? in_sizes[0] : -1, out_size, ws_size, (size_t)WS_END); grid = -1; return; }
        int dev = 0, cus = 0, per_cu = 0;
        if (hipGetDevice(&dev) != hipSuccess || hipDeviceGetAttribute(&cus, hipDeviceAttributeMultiprocessorCount, dev) != hipSuccess) { grid = -1; return; }
        if (hipFuncSetAttribute((const void*)mega_fwd, hipFuncAttributeMaxDynamicSharedMemorySize, LDS_BYTES) != hipSuccess) { fprintf(stderr, "kernel_launch: hipFuncSetAttribute failed\n"); grid = -1; return; }
        if (hipOccupancyMaxActiveBlocksPerMultiprocessor(&per_cu, (const void*)mega_fwd, NTHR, LDS_BYTES) != hipSuccess || per_cu < 1) { fprintf(stderr, "kernel_launch: occupancy query says %d\n", per_cu); (void)hipGetLastError(); grid = -1; return; }
        grid = cus;
    }
    if (grid < 0) return;
    (void)hipMemsetAsync((char*)d_ws + WS_CTL, 0, CTL_ZERO_BYTES, stream);
    Args a; memset(&a, 0, sizeof(a));
    for (int i = 0; i < 33; ++i) a.in[i] = (const float*)d_in[i];
    a.out = (float*)d_out; a.ws = (unsigned char*)d_ws;
#if MK_PER_PHASE
    for (int p = 0; p < N_PHASES; ++p) { a.ph_lo = p; a.ph_hi = p + 1; hipLaunchKernelGGL(mega_fwd, dim3(grid), dim3(NTHR), LDS_BYTES, stream, a); }
#else
    a.ph_lo = 0; a.ph_hi = N_PHASES; hipLaunchKernelGGL(mega_fwd, dim3(grid), dim3(NTHR), LDS_BYTES, stream, a);
#endif
}
```

```cpp
#include <hip/hip_runtime.h>
#include <cstdio>
#include <cstdint>
#include <cstring>

#ifndef MK_PER_PHASE
#define MK_PER_PHASE 0
#endif

#define LAS __attribute__((address_space(3)))
typedef unsigned short bf16_t;
typedef short bf16x8 __attribute__((ext_vector_type(8)));
typedef float f32x4 __attribute__((ext_vector_type(4)));
typedef float f32x2 __attribute__((ext_vector_type(2)));
typedef unsigned u32x4 __attribute__((ext_vector_type(4)));
typedef unsigned u32x2 __attribute__((ext_vector_type(2)));

constexpr int DM = 2048, NL = 4, MT = 16896, MPR = 16384, TP = 2048, TS = 64;
constexpr int PWD = 1024, RWD = 1024, RPJ = 3360, ICOLS = 8480, ICP = 8704, FF = 5632, PLE = 256, LK = 384;
constexpr int PC_GP = 4608, PC_GR = 6656;
constexpr float NORM_EPS = 1e-6f, GN_EPS = 64e-5f;
constexpr size_t O_YS = 33554432, O_SHP = 34603008, O_POP = 34710528, O_WKP = 35202048, O_SHS = 37299200, O_POS = 37406720, O_WKS = 37898240, O_END = 39995392;

__device__ __forceinline__ unsigned cvt_pk_bf16(float lo, float hi) { unsigned r; asm volatile("v_cvt_pk_bf16_f32 %0, %1, %2" : "=v"(r) : "v"(lo), "v"(hi)); return r; }
__device__ __forceinline__ float bf_lo(unsigned u) { return __uint_as_float(u << 16); }
__device__ __forceinline__ float bf_hi(unsigned u) { return __uint_as_float(u & 0xffff0000u); }
__device__ __forceinline__ void unpack8(const u32x4 w, float (&f)[8]) { f[0] = bf_lo(w.x); f[1] = bf_hi(w.x); f[2] = bf_lo(w.y); f[3] = bf_hi(w.y); f[4] = bf_lo(w.z); f[5] = bf_hi(w.z); f[6] = bf_lo(w.w); f[7] = bf_hi(w.w); }
__device__ __forceinline__ u32x4 pack8(const float (&f)[8]) { u32x4 w; w.x = cvt_pk_bf16(f[0], f[1]); w.y = cvt_pk_bf16(f[2], f[3]); w.z = cvt_pk_bf16(f[4], f[5]); w.w = cvt_pk_bf16(f[6], f[7]); return w; }
__device__ __forceinline__ float sigmoidf_(float x) { return __builtin_amdgcn_rcpf(1.0f + __expf(-x)); }
__device__ __forceinline__ f32x4 sigmoid4(f32x4 v) { f32x4 o; o.x = sigmoidf_(v.x); o.y = sigmoidf_(v.y); o.z = sigmoidf_(v.z); o.w = sigmoidf_(v.w); return o; }
__device__ __forceinline__ f32x4 rcp4(f32x4 v) { f32x4 o; o.x = __builtin_amdgcn_rcpf(v.x); o.y = __builtin_amdgcn_rcpf(v.y); o.z = __builtin_amdgcn_rcpf(v.z); o.w = __builtin_amdgcn_rcpf(v.w); return o; }
__device__ __forceinline__ f32x4 fmax4(f32x4 a, f32x4 b) { f32x4 o; o.x = fmaxf(a.x, b.x); o.y = fmaxf(a.y, b.y); o.z = fmaxf(a.z, b.z); o.w = fmaxf(a.w, b.w); return o; }
__device__ __forceinline__ float tanhf_(float x) { const float e = __expf(2.0f * x); return 1.0f - 2.0f * __builtin_amdgcn_rcpf(e + 1.0f); }
template <int CTRL> __device__ __forceinline__ float dpp_f(float x) { return __uint_as_float((unsigned)__builtin_amdgcn_update_dpp(0, (int)__float_as_uint(x), CTRL, 0xF, 0xF, true)); }
__device__ __forceinline__ float sum8(float x) { x += dpp_f<0xB1>(x); x += dpp_f<0x4E>(x); x += dpp_f<0x141>(x); return x; }
__device__ __forceinline__ float wave_sum(float x) {
    x += dpp_f<0xB1>(x); x += dpp_f<0x4E>(x); x += dpp_f<0x141>(x); x += dpp_f<0x140>(x);
    x += __uint_as_float((unsigned)__builtin_amdgcn_ds_swizzle((int)__float_as_uint(x), 0x401F));
    return __uint_as_float((unsigned)__builtin_amdgcn_readlane((int)__float_as_uint(x), 0)) + __uint_as_float((unsigned)__builtin_amdgcn_readlane((int)__float_as_uint(x), 32));
}

namespace pg8 {
typedef unsigned ss_t;
constexpr int BM = 256, BK = 64, HALF = 128, HTB = HALF * BK * 2  , STAGE_BYTES = 8 * HTB, NXCD = 8, WGM = 8;
__host__ __device__ __forceinline__ int lds_g2(int fr) { return (0x1230 >> (4 * (fr >> 2))) & 3; }
__host__ __device__ __forceinline__ int lds_byte(int r, int c) { const int fr = r & 15, h = (c >> 5) & 1, q = (c >> 3) & 3; return (r >> 3) * 1024 + (r & 7) * 128 + ((h ^ ((fr >> 1) & 1)) * 64) + ((q ^ lds_g2(fr)) * 16); }
__host__ __device__ __forceinline__ void stage_rc(int b, int& R, int& C) { const int blk = b / 1024, sl = (b % 1024) / 16, rr8 = sl >> 3, fr = (blk & 1) * 8 + rr8, h = ((sl >> 2) & 1) ^ ((fr >> 1) & 1), q = (sl & 3) ^ lds_g2(fr); R = blk * 8 + rr8; C = 8 * (4 * h + q); }
__host__ __device__ __forceinline__ int perm32(int rho) { const int n = rho >> 4, i = rho & 15; return 8 * (i >> 2) + 4 * n + (i & 3); }

struct Unit { int pm, pn; };
struct Gemm { const bf16_t* A; const bf16_t* Bt; int M, N, K, lda, ldb, a_pn_off; };

struct StaticOrder {
    int nM, nN, nwg, G, c;
    __host__ __device__ void init(int M, int N, int G_, int c_) { nM = M / BM; nN = N / BM; nwg = nM * nN; G = G_; c = c_; }
    __host__ __device__ bool next(int i, Unit& u) const {
        if (c < 0) return false;
        const long L = (long)i * G + c; if (L >= nwg) return false;
        int wgid = (int)L; { const int q = nwg / NXCD, r = nwg % NXCD, xcd = wgid % NXCD, off = wgid / NXCD; wgid = (xcd < r ? xcd * (q + 1) : r * (q + 1) + (xcd - r) * q) + off; }
        const int nig = WGM * nN, gid = wgid / nig, fm = gid * WGM, gsz = (nM - fm) < WGM ? (nM - fm) : WGM;
        u.pm = fm + ((wgid % nig) % gsz); u.pn = ((wgid % nig) / gsz + gid) % nN; return true;
    }
    __device__ __forceinline__ void a_ready(const Unit&) const {}
    __device__ __forceinline__ void done(const Unit&) const {}
};

struct PairOrder : StaticOrder {
    __host__ __device__ bool next(int i, Unit& u) const { if (!StaticOrder::next(i >> 1, u)) return false; u.pn += (i & 1) * 8; return true; }
};
template <class T, class = void> struct paired_t { static constexpr bool v = false; };
template <class T> struct paired_t<T, decltype((void)T::PAIRED)> { static constexpr bool v = true; };

__device__ __forceinline__ void acc_zero(f32x4 (&acc)[2][2][4][2]) {
#pragma unroll
    for (int a = 0; a < 2; ++a)
#pragma unroll
        for (int b = 0; b < 2; ++b)
#pragma unroll
            for (int m = 0; m < 4; ++m)
#pragma unroll
                for (int n = 0; n < 2; ++n) acc[a][b][m][n] = (f32x4){0.f, 0.f, 0.f, 0.f};
}
struct RepeatOrder : StaticOrder {
    __host__ __device__ bool next(int i, Unit& u) const { if (i >= 6) return false; return StaticOrder::next(i % 3, u) || StaticOrder::next(0, u); }
};
#define EPI_ZERO_INIT __device__ __forceinline__ void init(f32x4 (&acc)[2][2][4][2], const Unit&, int, int, int, int) const { acc_zero(acc); }
#define EPI_NO_PRE __device__ __forceinline__ void preload(ss_t (&pre)[2], const Unit&, int, int, int) const {}
#define EPI_SS_PRE(SSPTR) __device__ __forceinline__ void preload(ss_t (&pre)[2], const Unit& u, int wr, int fr, int fq) const { _Pragma("unroll") for (int j = 0; j < 2; ++j) { const int g = 2 * fq + j; \
        pre[j] = (SSPTR)[(size_t)(u.pm * BM + (g >> 2) * HALF + wr * 64 + (g & 3) * 16 + fr)]; } }
__device__ __forceinline__ ss_t pre_get(const ss_t (&pre)[2], int g, int fr) { return (ss_t)__builtin_amdgcn_ds_bpermute((((g >> 1) << 4) + fr) << 2, (int)pre[g & 1]); }
template <class Epi, class Sched, bool ALIGN_EPI>
__device__ __forceinline__ void gemm_phase(LAS unsigned char* lds, const Gemm g, const Sched& S, const Epi& E) {
    int tid_ = threadIdx.x; asm volatile("" : "+v"(tid_));
    const int tid = tid_, wid = __builtin_amdgcn_readfirstlane(tid >> 6), lane = tid & 63, wr = wid >> 2, wc = wid & 3, fr = lane & 15, fq = lane >> 4;
    int K_ = g.K; asm volatile("" : "+s"(K_));
    const int K = K_, nt = K / BK;
    unsigned voffA[2], voffB[2];
#pragma unroll
    for (int i = 0; i < 2; ++i) { int R, C; stage_rc(tid * 16 + i * 8192, R, C); const int Rb = Epi::PERM ? (64 * (R >> 5) + perm32(R & 31)) : R;
        voffA[i] = (unsigned)(R * g.lda + C) * 2u; voffB[i] = (unsigned)(Rb * g.ldb + C) * 2u; }
    const size_t kstep = (size_t)(BK * 2);
    const size_t hstepA = (size_t)HALF * g.lda * 2, hstepB = (size_t)(Epi::PERM ? 32 : HALF) * g.ldb * 2;
    const unsigned ldsw = (unsigned)wid * 1024u;
    int aoff = lds_byte(wr * 64 + fr, fq * 8), boff = lds_byte(wc * 32 + fr, fq * 8);
#define PG8_SA(b, h) (((b) * 2 + (h)) * HTB)
#define PG8_APN(u) (paired_t<Epi>::v ? ((u).pn >> 3) : (u).pn)
#define PG8_SB(b, h) ((4 + (b) * 2 + (h)) * HTB)
#define PG8_STAGE(bufoff, gbase, voff) do { _Pragma("unroll") for (int _i = 0; _i < 2; ++_i) \
        __builtin_amdgcn_global_load_lds((const unsigned*)((const char*)(gbase) + (voff)[_i]), (LAS unsigned*)(lds + (bufoff) + ldsw + _i * 8192), 16, 0, 0); } while (0)
#define PG8_TOG(x) asm volatile("v_xor_b32 %0, 64, %0" : "+v"(x))
#define PG8_LDA(dst, b, h) do { _Pragma("unroll") for (int m = 0; m < 4; ++m) dst[m][0] = *(const LAS bf16x8*)(lds + PG8_SA(b, h) + aoff + m * 2048); PG8_TOG(aoff); \
        _Pragma("unroll") for (int m = 0; m < 4; ++m) dst[m][1] = *(const LAS bf16x8*)(lds + PG8_SA(b, h) + aoff + m * 2048); PG8_TOG(aoff); } while (0)
#define PG8_LDB(dst, b, h) do { _Pragma("unroll") for (int n = 0; n < 2; ++n) dst[n][0] = *(const LAS bf16x8*)(lds + PG8_SB(b, h) + boff + n * 2048); PG8_TOG(boff); \
        _Pragma("unroll") for (int n = 0; n < 2; ++n) dst[n][1] = *(const LAS bf16x8*)(lds + PG8_SB(b, h) + boff + n * 2048); PG8_TOG(boff); } while (0)
#define PG8_MMA(ai, bj, At, Bt) do { __builtin_amdgcn_s_setprio(1); _Pragma("unroll") for (int m = 0; m < 4; ++m) _Pragma("unroll") for (int n = 0; n < 2; ++n) _Pragma("unroll") for (int k = 0; k < 2; ++k) \
        acc[ai][bj][m][n] = __builtin_amdgcn_mfma_f32_16x16x32_bf16(Bt[n][k], At[m][k], acc[ai][bj][m][n], 0, 0, 0); __builtin_amdgcn_s_setprio(0); } while (0)
#define PG8_WAIT_V(n) asm volatile("s_waitcnt vmcnt(" #n ")" ::: "memory")
#define PG8_WAIT_L(n) asm volatile("s_waitcnt lgkmcnt(" #n ")" ::: "memory")
#define PG8_BAR __builtin_amdgcn_s_barrier()
#define PG8_SCHED __builtin_amdgcn_sched_barrier(0)
    Unit cur, nxt; int ui = 0;
    if (!S.next(0, cur)) return;
    f32x4 acc[2][2][4][2]; ss_t pre[2];
    E.init(acc, cur, wr, wc, fr, fq); E.preload(pre, cur, wr, fr, fq);
    bf16x8 At[4][2], B0[2][2], B1[2][2];
    const char* cA = (const char*)g.A + ((size_t)cur.pm * BM * g.lda + (size_t)PG8_APN(cur) * g.a_pn_off) * 2; const char* cB = (const char*)g.Bt + (size_t)cur.pn * BM * g.ldb * 2;
    S.a_ready(cur);
    PG8_STAGE(PG8_SB(0, 0), cB, voffB); PG8_STAGE(PG8_SB(0, 1), cB + hstepB, voffB); PG8_STAGE(PG8_SA(0, 0), cA, voffA); PG8_STAGE(PG8_SA(0, 1), cA + hstepA, voffA);
    if (wr == 1) PG8_BAR;
    PG8_WAIT_V(2); PG8_BAR;
    PG8_STAGE(PG8_SB(1, 0), cB + kstep, voffB); PG8_STAGE(PG8_SA(1, 0), cA + kstep, voffA); PG8_STAGE(PG8_SB(1, 1), cB + hstepB + kstep, voffB);
    PG8_WAIT_V(6); PG8_BAR;
    for (;;) {
        const bool has_next = S.next(ui + 1, nxt);
        const char* nA = has_next ? (const char*)g.A + ((size_t)nxt.pm * BM * g.lda + (size_t)PG8_APN(nxt) * g.a_pn_off) * 2 : cA; const char* nB = has_next ? (const char*)g.Bt + (size_t)nxt.pn * BM * g.ldb * 2 : cB;
#pragma unroll 1
        for (int t = 0; t < nt; t += 2) {
            const bool last = (t == nt - 2);
            const char* a1 = cA + (size_t)(t + 1) * kstep;
            const char* a2 = last ? nA : cA + (size_t)(t + 2) * kstep; const char* b2 = last ? nB : cB + (size_t)(t + 2) * kstep;
            const char* a3 = a2 + kstep; const char* b3 = b2 + kstep;
            if (last && has_next) S.a_ready(nxt);
            PG8_LDB(B0, 0, 0); PG8_LDB(B1, 0, 1); PG8_SCHED; PG8_LDA(At, 0, 0); PG8_STAGE(PG8_SA(1, 1), a1 + hstepA, voffA);
            PG8_WAIT_V(8); PG8_WAIT_L(0); PG8_BAR; PG8_MMA(0, 0, At, B0); PG8_MMA(0, 1, At, B1); PG8_BAR; PG8_SCHED;
            PG8_LDA(At, 0, 1); PG8_STAGE(PG8_SB(0, 0), b2, voffB); PG8_STAGE(PG8_SB(0, 1), b2 + hstepB, voffB); PG8_STAGE(PG8_SA(0, 0), a2, voffA);
            PG8_WAIT_V(8); PG8_WAIT_L(0); PG8_BAR; PG8_MMA(1, 0, At, B0); PG8_MMA(1, 1, At, B1); PG8_BAR; PG8_SCHED;
            PG8_LDB(B0, 1, 0); PG8_LDB(B1, 1, 1); PG8_SCHED; PG8_LDA(At, 1, 0); PG8_STAGE(PG8_SA(0, 1), a2 + hstepA, voffA);
            PG8_WAIT_V(8); PG8_WAIT_L(0); PG8_BAR; PG8_MMA(0, 0, At, B0); PG8_MMA(0, 1, At, B1); PG8_BAR; PG8_SCHED;
            PG8_LDA(At, 1, 1); PG8_STAGE(PG8_SB(1, 0), b3, voffB); PG8_STAGE(PG8_SB(1, 1), b3 + hstepB, voffB); PG8_STAGE(PG8_SA(1, 0), a3, voffA);
            PG8_WAIT_V(8); PG8_WAIT_L(0); PG8_BAR; PG8_MMA(1, 0, At, B0); PG8_MMA(1, 1, At, B1); PG8_BAR; PG8_SCHED;
        }
        if constexpr (ALIGN_EPI) { if (wr == 0) PG8_BAR; }
        E(acc, pre, cur, wr, wc, fr, fq); S.done(cur);
        if (!has_next) break;
        E.init(acc, nxt, wr, wc, fr, fq); E.preload(pre, nxt, wr, fr, fq);
        cur = nxt; cA = nA; cB = nB; ++ui;
        if constexpr (ALIGN_EPI) { if (wr == 1) PG8_BAR; }
    }
    PG8_WAIT_V(0);
    if constexpr (!ALIGN_EPI) { if (wr == 0) PG8_BAR; }
    PG8_BAR;
#undef PG8_SA
#undef PG8_APN
#undef PG8_SB
#undef PG8_STAGE
#undef PG8_LDA
#undef PG8_TOG
#undef PG8_LDB
#undef PG8_MMA
#undef PG8_WAIT_V
#undef PG8_WAIT_L
#undef PG8_BAR
#undef PG8_SCHED
}

#define EPI_ROW0 (u.pm * BM + wr * 64 + fr)
#define EPI_FOR_AI_M _Pragma("unroll") for (int ai = 0; ai < 2; ++ai) _Pragma("unroll") for (int m = 0; m < 4; ++m)
__device__ __forceinline__ u32x4 pack_f4x2(f32x4 v0, f32x4 v1) { u32x4 w; w.x = cvt_pk_bf16(v0[0], v0[1]); w.y = cvt_pk_bf16(v0[2], v0[3]); w.z = cvt_pk_bf16(v1[0], v1[1]); w.w = cvt_pk_bf16(v1[2], v1[3]); return w; }
__device__ __forceinline__ void unpack_f4x2(u32x4 w, f32x4& v0, f32x4& v1) { v0[0] = bf_lo(w.x); v0[1] = bf_hi(w.x); v0[2] = bf_lo(w.y); v0[3] = bf_hi(w.y); v1[0] = bf_lo(w.z); v1[1] = bf_hi(w.z); v1[2] = bf_lo(w.w); v1[3] = bf_hi(w.w); }
__device__ __forceinline__ unsigned ror8(unsigned x) { return (unsigned)__builtin_amdgcn_update_dpp(0, (int)x, 0x128, 0xF, 0xF, true); }
__device__ __forceinline__ void st_pair(char* grp, size_t pitch, int fr, int fq, u32x4 vA, u32x4 vB) {
    const bool lo = fr < 8;
    u32x4 snd = lo ? vB : vA, rcv; rcv.x = ror8(snd.x); rcv.y = ror8(snd.y); rcv.z = ror8(snd.z); rcv.w = ror8(snd.w);
    char* p = grp + (size_t)(fr & 7) * pitch + (lo ? 0 : 64) + fq * 16;
    *(u32x4*)p = lo ? vA : rcv;
    *(u32x4*)(p + 8 * pitch) = lo ? rcv : vB;
}
__device__ __forceinline__ u32x4 as_u4(f32x4 v) { return __builtin_bit_cast(u32x4, v); }

__device__ __forceinline__ float rstd_raw(ss_t v) { return __builtin_amdgcn_rsqf((float)v * (1.0f / (256.0f * DM)) + NORM_EPS); }
__device__ __forceinline__ float rstd_of(const ss_t* SS, size_t row) { return rstd_raw(SS[row]); }
__device__ __forceinline__ ss_t ss_fix(float s) { return (ss_t)(s * 256.0f + 0.5f); }
__device__ __forceinline__ float sq8(f32x4 a, f32x4 b) { return (a.x * a.x + a.y * a.y) + (a.z * a.z + a.w * a.w) + (b.x * b.x + b.y * b.y) + (b.z * b.z + b.w * b.w); }
__device__ __forceinline__ void ss_add(ss_t* SS, size_t row, float s, int fq, int fr) { s += __uint_as_float((unsigned)__builtin_amdgcn_ds_swizzle((int)__float_as_uint(s), 0x401F));
    s += __uint_as_float((unsigned)__builtin_amdgcn_ds_bpermute((((fq ^ 2) << 4) + fr) << 2, (int)__float_as_uint(s)));
    if (fq == 0) __hip_atomic_fetch_add(SS + row, ss_fix(s), __ATOMIC_RELAXED, __HIP_MEMORY_SCOPE_AGENT); }
struct EpiNull { static constexpr bool PERM = true; EPI_NO_PRE EPI_ZERO_INIT __device__ __forceinline__ void operator()(const f32x4 (&acc)[2][2][4][2], const ss_t (&pre)[2], const Unit& u, int wr, int wc, int fr, int fq) const {
#pragma unroll
    for (int a = 0; a < 2; ++a)
#pragma unroll
        for (int b = 0; b < 2; ++b)
#pragma unroll
            for (int m = 0; m < 4; ++m)
#pragma unroll
                for (int n = 0; n < 2; ++n) asm volatile("" :: "v"(acc[a][b][m][n]));
} };
struct EpiProj { static constexpr bool PERM = true; EPI_ZERO_INIT
    bf16_t* O; const ss_t* SS; EPI_SS_PRE(SS)
    __device__ __forceinline__ void operator()(const f32x4 (&acc)[2][2][4][2], const ss_t (&pre)[2], const Unit& u, int wr, int wc, int fr, int fq) const {
        const bool sg = u.pn >= 18;
        EPI_FOR_AI_M { const size_t r0 = (size_t)(u.pm * BM + ai * HALF + wr * 64 + m * 16); char* grp = (char*)(O + r0 * ICP + u.pn * BM + 64 * wc); const float rs = rstd_raw(pre_get(pre, ai * 4 + m, fr));
            f32x4 a0 = acc[ai][0][m][0] * rs, a1 = acc[ai][0][m][1] * rs, b0 = acc[ai][1][m][0] * rs, b1 = acc[ai][1][m][1] * rs;
            if (sg) { a0 = sigmoid4(a0); a1 = sigmoid4(a1); b0 = sigmoid4(b0); b1 = sigmoid4(b1); }
            st_pair(grp, (size_t)ICP * 2, fr, fq, pack_f4x2(a0, a1), pack_f4x2(b0, b1)); }
    }
};
struct EpiBf16 { static constexpr bool PERM = true; EPI_NO_PRE EPI_ZERO_INIT
    bf16_t* O; int ldc;
    __device__ __forceinline__ void operator()(const f32x4 (&acc)[2][2][4][2], const ss_t (&pre)[2], const Unit& u, int wr, int wc, int fr, int fq) const {
        EPI_FOR_AI_M { char* grp = (char*)(O + (size_t)(u.pm * BM + ai * HALF + wr * 64 + m * 16) * ldc + u.pn * BM + 64 * wc);
            st_pair(grp, (size_t)ldc * 2, fr, fq, pack_f4x2(acc[ai][0][m][0], acc[ai][0][m][1]), pack_f4x2(acc[ai][1][m][0], acc[ai][1][m][1])); }
    }
};
struct EpiLora { static constexpr bool PERM = true; EPI_NO_PRE EPI_ZERO_INIT
    float* DEC; bf16_t* AA; bf16_t* GG; const float* w0; const float* a0;
    __device__ __forceinline__ void operator()(const f32x4 (&acc)[2][2][4][2], const ss_t (&pre)[2], const Unit& u, int wr, int wc, int fr, int fq) const {
        const int row0 = EPI_ROW0, kind = u.pn >> 2, ct = (u.pn & 3) * BM + 64 * wc, col0 = ct + 8 * fq;
        if (kind == 0) {
            EPI_FOR_AI_M { float* rowp = DEC + (size_t)(row0 + ai * HALF + m * 16) * RWD + col0;
#pragma unroll
                for (int bj = 0; bj < 2; ++bj)
#pragma unroll
                    for (int n = 0; n < 2; ++n) { const f32x4 b = *(const f32x4*)(w0 + col0 + bj * 32 + 4 * n); const f32x4 x = acc[ai][bj][m][n] + b; f32x4 o;
#pragma unroll
                        for (int j = 0; j < 4; ++j) { const float z = -x[j]; const float sp = z > 15.f ? z : __logf(1.0f + __expf(z)); const float w = -sp - 0.5f; o[j] = __expf(-__expf(w)); }
                        *(f32x4*)(rowp + bj * 32 + 4 * n) = o; } asm volatile("" ::: "memory"); }
        } else if (kind == 1) {
            const f32x4 b00 = *(const f32x4*)(a0 + col0), b01 = *(const f32x4*)(a0 + col0 + 4), b10 = *(const f32x4*)(a0 + col0 + 32), b11 = *(const f32x4*)(a0 + col0 + 36);
            EPI_FOR_AI_M { char* grp = (char*)(AA + (size_t)(u.pm * BM + ai * HALF + wr * 64 + m * 16) * RWD + ct);
                st_pair(grp, (size_t)RWD * 2, fr, fq, pack_f4x2(sigmoid4(acc[ai][0][m][0] + b00), sigmoid4(acc[ai][0][m][1] + b01)), pack_f4x2(sigmoid4(acc[ai][1][m][0] + b10), sigmoid4(acc[ai][1][m][1] + b11))); }
        } else {
            EPI_FOR_AI_M { char* grp = (char*)(GG + (size_t)(u.pm * BM + ai * HALF + wr * 64 + m * 16) * RWD + ct);
                st_pair(grp, (size_t)RWD * 2, fr, fq, pack_f4x2(acc[ai][0][m][0], acc[ai][0][m][1]), pack_f4x2(acc[ai][1][m][0], acc[ai][1][m][1])); }
        }
    }
};
struct EpiGate1 { static constexpr bool PERM = true; EPI_NO_PRE EPI_ZERO_INIT
    bf16_t* TMP; const bf16_t* PROJ; int gcol0;
    __device__ __forceinline__ void operator()(const f32x4 (&acc)[2][2][4][2], const ss_t (&pre)[2], const Unit& u, int wr, int wc, int fr, int fq) const {
        const int row0 = EPI_ROW0, ct = u.pn * BM + 64 * wc, col0 = ct + 8 * fq;
        EPI_FOR_AI_M { const size_t row = (size_t)(row0 + ai * HALF + m * 16);
            f32x4 g00, g01, g10, g11; unpack_f4x2(*(const u32x4*)(PROJ + row * ICP + gcol0 + col0), g00, g01); unpack_f4x2(*(const u32x4*)(PROJ + row * ICP + gcol0 + col0 + 32), g10, g11);
            st_pair((char*)(TMP + (size_t)(u.pm * BM + ai * HALF + wr * 64 + m * 16) * DM + ct), (size_t)DM * 2, fr, fq, pack_f4x2(acc[ai][0][m][0] * g00, acc[ai][0][m][1] * g01), pack_f4x2(acc[ai][1][m][0] * g10, acc[ai][1][m][1] * g11));
            if (m & 1) asm volatile("" ::: "memory"); }
    }
};
struct EpiGate2 { static constexpr bool PERM = true; EPI_NO_PRE EPI_ZERO_INIT
    const bf16_t* TMP; const bf16_t* PROJ; int gcol0; bf16_t* O;
    __device__ __forceinline__ void operator()(const f32x4 (&acc)[2][2][4][2], const ss_t (&pre)[2], const Unit& u, int wr, int wc, int fr, int fq) const {
        const int row0 = EPI_ROW0, ct = u.pn * BM + 64 * wc, col0 = ct + 8 * fq;
        EPI_FOR_AI_M { const size_t row = (size_t)(row0 + ai * HALF + m * 16);
            f32x4 g00, g01, g10, g11, t00, t01, t10, t11; unpack_f4x2(*(const u32x4*)(PROJ + row * ICP + gcol0 + col0), g00, g01); unpack_f4x2(*(const u32x4*)(PROJ + row * ICP + gcol0 + col0 + 32), g10, g11);
            unpack_f4x2(*(const u32x4*)(TMP + row * DM + col0), t00, t01); unpack_f4x2(*(const u32x4*)(TMP + row * DM + col0 + 32), t10, t11);
            st_pair((char*)(O + (size_t)(u.pm * BM + ai * HALF + wr * 64 + m * 16) * DM + ct), (size_t)DM * 2, fr, fq, pack_f4x2(t00 + acc[ai][0][m][0] * g00, t01 + acc[ai][0][m][1] * g01), pack_f4x2(t10 + acc[ai][1][m][0] * g10, t11 + acc[ai][1][m][1] * g11));
            if (m & 1) asm volatile("" ::: "memory"); }
    }
};
struct EpiGatePair { static constexpr bool PERM = true; static constexpr bool PAIRED = true; EPI_NO_PRE
    const bf16_t* PROJ; int gc1, gc2; bf16_t* O;
    __device__ __forceinline__ void init(f32x4 (&acc)[2][2][4][2], const Unit& u, int, int, int, int) const { if (u.pn < 8) acc_zero(acc); }
    __device__ __forceinline__ void operator()(f32x4 (&acc)[2][2][4][2], const ss_t (&pre)[2], const Unit& u, int wr, int wc, int fr, int fq) const {
        const int row0 = EPI_ROW0, ct = (u.pn & 7) * BM + 64 * wc, col0 = ct + 8 * fq;
        const f32x4 flo = (f32x4){0x1p-60f, 0x1p-60f, 0x1p-60f, 0x1p-60f};
        if (u.pn < 8) {
#pragma unroll
            for (int ai = 0; ai < 2; ++ai) { u32x4 q[4][4];
#pragma unroll
                for (int m = 0; m < 4; ++m) { const bf16_t* p = PROJ + (size_t)(row0 + ai * HALF + m * 16) * ICP + col0; q[m][0] = *(const u32x4*)(p + gc1); q[m][1] = *(const u32x4*)(p + gc1 + 32); q[m][2] = *(const u32x4*)(p + gc2); q[m][3] = *(const u32x4*)(p + gc2 + 32); }
                __builtin_amdgcn_sched_barrier(0);
#pragma unroll
                for (int m = 0; m < 4; ++m) { f32x4 g00, g01, g10, g11, h00, h01, h10, h11; unpack_f4x2(q[m][0], g00, g01); unpack_f4x2(q[m][1], g10, g11); unpack_f4x2(q[m][2], h00, h01); unpack_f4x2(q[m][3], h10, h11);
                    acc[ai][0][m][0] *= g00 * rcp4(fmax4(h00, flo)); acc[ai][0][m][1] *= g01 * rcp4(fmax4(h01, flo)); acc[ai][1][m][0] *= g10 * rcp4(fmax4(h10, flo)); acc[ai][1][m][1] *= g11 * rcp4(fmax4(h11, flo)); }
                __builtin_amdgcn_sched_barrier(0); }
        } else {
            u32x4 q[2][4][2];
#pragma unroll
            for (int ai = 0; ai < 2; ++ai)
#pragma unroll
                for (int m = 0; m < 4; ++m) { const bf16_t* p = PROJ + (size_t)(row0 + ai * HALF + m * 16) * ICP + gc2 + col0; q[ai][m][0] = *(const u32x4*)p; q[ai][m][1] = *(const u32x4*)(p + 32); }
            __builtin_amdgcn_sched_barrier(0);
            EPI_FOR_AI_M { f32x4 h00, h01, h10, h11; unpack_f4x2(q[ai][m][0], h00, h01); unpack_f4x2(q[ai][m][1], h10, h11);
                st_pair((char*)(O + (size_t)(u.pm * BM + ai * HALF + wr * 64 + m * 16) * DM + ct), (size_t)DM * 2, fr, fq, pack_f4x2(acc[ai][0][m][0] * fmax4(h00, flo), acc[ai][0][m][1] * fmax4(h01, flo)),
                        pack_f4x2(acc[ai][1][m][0] * fmax4(h10, flo), acc[ai][1][m][1] * fmax4(h11, flo)));
                if (m & 1) __builtin_amdgcn_sched_barrier(0); }
        }
    }
};
struct EpiResid { static constexpr bool PERM = true; EPI_NO_PRE
    bf16_t* XB; ss_t* SS;
    __device__ __forceinline__ void init(f32x4 (&acc)[2][2][4][2], const Unit& u, int wr, int wc, int fr, int fq) const {
        const int row0 = EPI_ROW0, col0 = u.pn * BM + 64 * wc + 8 * fq;
        EPI_FOR_AI_M { const bf16_t* rowp = XB + (size_t)(row0 + ai * HALF + m * 16) * DM + col0;
            unpack_f4x2(*(const u32x4*)rowp, acc[ai][0][m][0], acc[ai][0][m][1]); unpack_f4x2(*(const u32x4*)(rowp + 32), acc[ai][1][m][0], acc[ai][1][m][1]); }
    }
    __device__ __forceinline__ void operator()(const f32x4 (&acc)[2][2][4][2], const ss_t (&pre)[2], const Unit& u, int wr, int wc, int fr, int fq) const {
        EPI_FOR_AI_M { const size_t r0 = (size_t)(u.pm * BM + ai * HALF + wr * 64 + m * 16);
            st_pair((char*)(XB + r0 * DM + u.pn * BM + 64 * wc), (size_t)DM * 2, fr, fq, pack_f4x2(acc[ai][0][m][0], acc[ai][0][m][1]), pack_f4x2(acc[ai][1][m][0], acc[ai][1][m][1]));
            ss_add(SS, r0 + fr, sq8(acc[ai][0][m][0], acc[ai][0][m][1]) + sq8(acc[ai][1][m][0], acc[ai][1][m][1]), fq, fr); }
    }
};
struct EpiSwiglu { static constexpr bool PERM = true; EPI_ZERO_INIT
    bf16_t* H; const ss_t* SS; EPI_SS_PRE(SS)
    __device__ __forceinline__ void operator()(const f32x4 (&acc)[2][2][4][2], const ss_t (&pre)[2], const Unit& u, int wr, int wc, int fr, int fq) const {
        const int row0 = EPI_ROW0, col0 = u.pn * HALF + wc * 32 + 8 * fq;
        EPI_FOR_AI_M { const size_t row = (size_t)(row0 + ai * HALF + m * 16); const float rs = rstd_raw(pre_get(pre, ai * 4 + m, fr));
            const f32x4 g0 = acc[ai][0][m][0] * rs, g1 = acc[ai][0][m][1] * rs, u0 = acc[ai][1][m][0] * rs, u1 = acc[ai][1][m][1] * rs;
            *(u32x4*)(H + row * FF + col0) = pack_f4x2(g0 * sigmoid4(g0) * u0, g1 * sigmoid4(g1) * u1); }
    }
};
struct EpiPle { static constexpr bool PERM = true; EPI_ZERO_INIT EPI_SS_PRE(SSi)
    const bf16_t* XB; bf16_t* XO; const bf16_t* PP; const ss_t* SSi; ss_t* SSo;
    __device__ __forceinline__ void operator()(const f32x4 (&acc)[2][2][4][2], const ss_t (&pre)[2], const Unit& u, int wr, int wc, int fr, int fq) const {
        const int col0 = u.pn * BM + 64 * wc + 8 * fq;
        EPI_FOR_AI_M { const size_t r0 = (size_t)(u.pm * BM + ai * HALF + wr * 64 + m * 16), row = r0 + fr; const float rs = rstd_raw(pre_get(pre, ai * 4 + m, fr));
            f32x4 x00, x01, x10, x11, p00, p01, p10, p11; unpack_f4x2(*(const u32x4*)(XB + row * DM + col0), x00, x01); unpack_f4x2(*(const u32x4*)(XB + row * DM + col0 + 32), x10, x11);
            unpack_f4x2(*(const u32x4*)(PP + row * DM + col0), p00, p01); unpack_f4x2(*(const u32x4*)(PP + row * DM + col0 + 32), p10, p11);
            x00 += sigmoid4(acc[ai][0][m][0] * rs) * p00; x01 += sigmoid4(acc[ai][0][m][1] * rs) * p01; x10 += sigmoid4(acc[ai][1][m][0] * rs) * p10; x11 += sigmoid4(acc[ai][1][m][1] * rs) * p11;
            st_pair((char*)(XO + r0 * DM + u.pn * BM + 64 * wc), (size_t)DM * 2, fr, fq, pack_f4x2(x00, x01), pack_f4x2(x10, x11));
            ss_add(SSo, row, sq8(x00, x01) + sq8(x10, x11), fq, fr);
            if (m & 1) asm volatile("" ::: "memory"); }
    }
};
#undef EPI_ROW0
#undef EPI_FOR_AI_M
}

constexpr size_t MiB = 1u << 20;
constexpr size_t al1m(size_t x) { return (x + MiB - 1) / MiB * MiB; }
constexpr size_t WS_CTL = 0, CTL_ZERO_BYTES = 1 * MiB;
constexpr size_t SZ_WIN = (size_t)ICP * DM * 2, SZ_POOLW = (size_t)PWD * 256 * 2, SZ_LORA = (size_t)3072 * LK * 2, SZ_PPOOL = (size_t)DM * PWD * 2, SZ_PRWKV = (size_t)DM * RWD * 2,
                 SZ_WOUT = (size_t)DM * DM * 2, SZ_WGU = (size_t)2 * FF * DM * 2, SZ_WDN = (size_t)DM * FF * 2, SZ_WPG = (size_t)DM * DM * 2, SZ_WPP = (size_t)DM * PLE * 2;
constexpr size_t WS_WIN = 1 * MiB, WS_POOLW = WS_WIN + SZ_WIN, WS_LORA = WS_POOLW + SZ_POOLW, WS_PPOOL = WS_LORA + SZ_LORA, WS_PRWKV = WS_PPOOL + SZ_PPOOL, WS_WOUT = WS_PRWKV + SZ_PRWKV,
                 WS_WGU = WS_WOUT + SZ_WOUT, WS_WDN = WS_WGU + SZ_WGU, WS_WPG = WS_WDN + SZ_WDN, WS_WPP = WS_WPG + SZ_WPG, WS_WEND = WS_WPP + SZ_WPP;
constexpr size_t WS_PB = al1m(WS_WEND);
constexpr size_t WS_XN = al1m(WS_PB + (size_t)MT * PLE * 2);
constexpr size_t WS_AA = al1m(WS_XN + (size_t)MT * DM * 2);
constexpr size_t WS_GG = al1m(WS_AA + (size_t)MT * RWD * 2);
constexpr size_t WS_PP = al1m(WS_GG + (size_t)MT * RWD * 2);
constexpr size_t WS_PROJ = al1m(WS_PP + (size_t)MT * DM * 2);
constexpr size_t WS_HID = WS_PROJ;
constexpr size_t WS_D = al1m(WS_PROJ + (size_t)MT * ICP * 2);
constexpr size_t WS_LIN = al1m(WS_D + (size_t)MT * PWD * 2);
constexpr size_t WS_YA = al1m(WS_LIN + (size_t)MT * LK * 2);
constexpr size_t WS_DEC = al1m(WS_YA + (size_t)MT * PWD * 2);
constexpr size_t WS_BS = al1m(WS_DEC + (size_t)MT * RWD * 4);
constexpr size_t WS_Y = al1m(WS_BS + (size_t)MT * 16 * 4);
constexpr size_t SZ_BH = (size_t)MT * RWD * 2;
constexpr size_t WS_YB = al1m(WS_Y + (size_t)MT * RWD * 4);
constexpr size_t WS_TMP = al1m(WS_YB + SZ_BH);
constexpr size_t WS_MRG = al1m(WS_TMP + (size_t)MT * DM * 4);
constexpr size_t WS_SS = al1m(WS_MRG + (size_t)MT * DM * 2);
constexpr size_t WS_END_OLD = al1m(WS_MRG + (size_t)MT * DM * 2);
static_assert((size_t)MT * FF * 2 <= (size_t)MT * ICP * 2, "HID overlay");

constexpr size_t WS_XB2 = al1m(WS_SS + (size_t)3 * MT * 4);
constexpr size_t CBSZ = 12096, CB_BS = 12032, CB_P1T = 0, CB_RT = 2048, CB_BK = 4096, CB_VT = 8192, CB_P2T = 10240, CB_MBT = 10752, CB_MKT = 11264, CB_GC = 11776;
constexpr size_t CB_N = (size_t)(MT / 16) * 16;
static_assert(WS_MRG + (size_t)MT * DM * 2 - WS_TMP >= CB_N * CBSZ, "chunk blocks fit in TMP | MRG");
static_assert(WS_PRWKV == WS_PPOOL + (size_t)8 * 256 * PWD * 2 && PWD == RWD && (WS_YB - WS_YA) / 2 < (size_t)0x7fffffff, "the paired gate GEMM walks proj_pool | proj_rwkv as one [4096][1024] matrix");
constexpr size_t WS_END = al1m(WS_XB2 + (size_t)MT * DM * 2);
constexpr int CW_BAR = 4096;
constexpr int NWAVES = 8, NTHR = 512;
constexpr int RING_BYTES = 131072, LDSCTL_OFF = RING_BYTES, LDS_BYTES = 147456;

#define XB_TMO      128
#define XB_XCNT(j)  (256  + 64 * (j))
#define XB_XSUB(j)  (1280 + 64 * (j))
#define XB_XGEN(j)  (2304 + 64 * (j))
#define XB_TOP      3328
#define XB_TOPGEN   3392
#define XCD_BAR_WORDS 3456
#define XB_SPIN_CAP (1u << 18)

__device__ __forceinline__ unsigned xb_ld(unsigned* p)              { return __hip_atomic_load(p, __ATOMIC_RELAXED, __HIP_MEMORY_SCOPE_AGENT); }
__device__ __forceinline__ unsigned xb_add(unsigned* p, unsigned v) { return __hip_atomic_fetch_add(p, v, __ATOMIC_RELAXED, __HIP_MEMORY_SCOPE_AGENT); }
__device__ __forceinline__ unsigned xb_xcc_id() { return (unsigned)__builtin_amdgcn_s_getreg((3 << 11) | 20) & 0xFu; }
#define XB_SPIN(cond, bar) do { unsigned _sp = 0; while (cond) { __builtin_amdgcn_s_sleep(1); \
    if ((++_sp & 255u) == 0u) { if (xb_ld(&(bar)[XB_TMO])) break; if (_sp > XB_SPIN_CAP) { atomicAdd(&(bar)[XB_TMO], 1u); break; } } } } while (0)

struct XcdBarrier {
    unsigned* bar; unsigned x;
    volatile LAS unsigned* st;
};

__device__ __forceinline__ XcdBarrier xcd_barrier_post(unsigned* bar, volatile LAS unsigned* st) {
    XcdBarrier b; b.bar = bar; b.x = xb_xcc_id(); b.st = st;
    if (threadIdx.x == 0) (void)xb_add(&bar[XB_XCNT(b.x)], 1u);
    return b;
}
__device__ __forceinline__ void xcd_barrier_complete(unsigned* bar, unsigned x, unsigned& nloc, unsigned& nx) {
    const unsigned G = gridDim.x * gridDim.y * gridDim.z;
    unsigned sum, cnt, mine, sp = 0u;
    for (;;) {
        sum = 0u; cnt = 0u; mine = 0u;
#pragma unroll
        for (unsigned j = 0; j < 16; ++j) { const unsigned c = xb_ld(&bar[XB_XCNT(j)]); sum += c; cnt += (c > 0u) ? 1u : 0u; mine = (j == x) ? c : mine; }
        if (sum == G) break;
        __builtin_amdgcn_s_sleep(1);
        if ((++sp & 255u) == 0u) { if (xb_ld(&bar[XB_TMO])) break; if (sp > XB_SPIN_CAP) { atomicAdd(&bar[XB_TMO], 1u); break; } }
    }
    nloc = mine > 0u ? mine : 1u; nx = cnt > 0u ? cnt : 1u;
}

__device__ __forceinline__ void xcd_barrier(const XcdBarrier& b) {
    asm volatile("s_waitcnt vmcnt(0)" ::: "memory");
    __syncthreads();
    if (threadIdx.x == 0) {
        unsigned* bar = b.bar;
        __builtin_amdgcn_s_waitcnt(0);
        unsigned nloc = b.st[0], nx = b.st[1];
        if (nloc == 0u) { xcd_barrier_complete(bar, b.x, nloc, nx); b.st[0] = nloc; b.st[1] = nx; }
        const unsigned old = xb_add(&bar[XB_XSUB(b.x)], 1u);
        const unsigned gen = old / nloc;
        if (old + 1u == (gen + 1u) * nloc) {
            __builtin_amdgcn_fence(__ATOMIC_RELEASE, "agent");
            asm volatile("s_waitcnt vmcnt(0)" ::: "memory");
            const unsigned og = xb_add(&bar[XB_TOP], 1u);
            const unsigned tg = og / nx;
            if (og + 1u == (tg + 1u) * nx) xb_add(&bar[XB_TOPGEN], 1u);
            else XB_SPIN(xb_ld(&bar[XB_TOPGEN]) == tg, bar);
            __builtin_amdgcn_fence(__ATOMIC_ACQUIRE, "agent");
            xb_add(&bar[XB_XGEN(b.x)], 1u);
            asm volatile("s_waitcnt vmcnt(0)" ::: "memory");
        } else {
            XB_SPIN(xb_ld(&bar[XB_XGEN(b.x)]) == gen, bar);
            __builtin_amdgcn_fence(__ATOMIC_ACQUIRE, "agent");
            asm volatile("s_waitcnt vmcnt(0)" ::: "memory");
        }
    }
    __syncthreads();
}


struct Args {
    const float* in[33]; float* out; unsigned char* ws; int ph_lo, ph_hi;
};
struct Frame {
    LAS unsigned char* lds; int G;
    const LAS unsigned long long* ptab; float* out; unsigned char* ws;
};
#define GAS __attribute__((address_space(1)))
__device__ __forceinline__ const float* ldptr(const LAS unsigned long long* tab, int k) { const unsigned long long v = tab[k]; const unsigned lo = __builtin_amdgcn_readfirstlane((unsigned)v), hi = __builtin_amdgcn_readfirstlane((unsigned)(v >> 32));
    return (const float*)(const GAS float*)(((unsigned long long)hi << 32) | lo); }
__device__ __forceinline__ unsigned char* fresh(unsigned char* p) { GAS unsigned char* q = (GAS unsigned char*)p; asm volatile("" : "+s"(q)); return (unsigned char*)q; }
__device__ __forceinline__ int fresh_i(int v) { asm volatile("" : "+s"(v)); return v; }
#define INP(k) ldptr(F.ptab, (k))
#define PHASE_L const int l = fresh_i(l_in); (void)l;
#define PHASE_IDS int tid_ = threadIdx.x; asm volatile("" : "+v"(tid_)); const int tid = tid_, lane = tid & 63, wave = __builtin_amdgcn_readfirstlane(tid >> 6), gtid = blockIdx.x * NTHR + tid, gw = blockIdx.x * NWAVES + wave; (void)lane; (void)wave; (void)gtid; (void)gw;
#define VM_WAIT() asm volatile("s_waitcnt vmcnt(0)" ::: "memory")
#define LDS_WAIT() asm volatile("s_waitcnt lgkmcnt(0)" ::: "memory")
constexpr int NT_ALL_SHIFT = 9;

__device__ __forceinline__ void row_info(int m, int& b, int& t, bool& samp) { samp = m >= MPR; if (samp) { b = (m - MPR) >> 6; t = (m - MPR) & 63; } else { b = m >> 11; t = m & 2047; } }

__device__ __forceinline__ void transpose_item(const float* W, int N, bf16_t* WT, int ldk, int k0, int n0, int drow0, LAS float* scr, int lane, const float* cscale = nullptr, const float* rscale = nullptr) {
    f32x4 cs = (f32x4){1.f, 1.f, 1.f, 1.f}; if (cscale) cs = *(const f32x4*)(cscale + n0 + 4 * (lane & 7));
    const int c = lane & 7;
    f32x4 g0 = (f32x4){1.f, 1.f, 1.f, 1.f}, g1 = g0;
    if (rscale) { g0 = *(const f32x4*)(rscale + k0 + 8 * c); g1 = *(const f32x4*)(rscale + k0 + 8 * c + 4); }
    f32x4 v[8];
#pragma unroll
    for (int i = 0; i < 8; ++i) v[i] = *(const f32x4*)(W + (size_t)(k0 + 8 * i + (lane >> 3)) * N + n0 + 4 * (lane & 7));
#pragma unroll
    for (int i = 0; i < 8; ++i) { LAS float* d = scr + (8 * i + (lane >> 3)) * 33 + 4 * (lane & 7); const f32x4 t = v[i] * cs; d[0] = t.x; d[1] = t.y; d[2] = t.z; d[3] = t.w; }
    LDS_WAIT(); asm volatile("" ::: "memory");
#pragma unroll
    for (int j = 0; j < 4; ++j) { const int n = (lane >> 3) + 8 * j; const LAS float* sp = scr + (8 * c) * 33 + n;
        u32x4 o; o.x = cvt_pk_bf16(sp[0 * 33] * g0.x, sp[1 * 33] * g0.y); o.y = cvt_pk_bf16(sp[2 * 33] * g0.z, sp[3 * 33] * g0.w); o.z = cvt_pk_bf16(sp[4 * 33] * g1.x, sp[5 * 33] * g1.y); o.w = cvt_pk_bf16(sp[6 * 33] * g1.z, sp[7 * 33] * g1.w);
        *(u32x4*)(WT + (size_t)(drow0 + n) * ldk + k0 + 8 * c) = o; }
    LDS_WAIT(); asm volatile("" ::: "memory");
}
__device__ __forceinline__ void convert_weights(Frame& F, int l_in) {
    PHASE_IDS
    unsigned char* const wsl = fresh(F.ws);
    PHASE_L
    LAS float* scr = (LAS float*)(F.lds + wave * 16384);
    const int NGW = fresh_i(F.G) * NWAVES;
    unsigned char* ws = wsl;
    constexpr int I_WIN = (DM / 64) * (ICOLS / 32), I_PW = 4 * (256 / 64) * (256 / 32), I_PP = (PWD / 64) * (DM / 32), I_WO = (DM / 64) * (DM / 32), I_FG = (DM / 64) * (FF / 32),
                  I_FD = (FF / 64) * (DM / 32), I_PL = (PLE / 64) * (DM / 32);
    constexpr int NITEMS = I_WIN + I_PW + 2 * I_PP + I_WO + 2 * I_FG + I_FD + I_WO + I_PL;
    for (int it = gw; it < NITEMS; it += NGW) {
        int r = it;
        if (r < I_WIN) { const int nblk = ICOLS / 32, kb = r / nblk, nb = r % nblk, n0 = nb * 32; transpose_item(INP(8) + (size_t)l * DM * ICOLS, ICOLS, (bf16_t*)(ws + WS_WIN), DM, kb * 64, n0, n0 < 4384 ? n0 : n0 + 224, scr, lane, nullptr, INP(7) + (size_t)l * DM); continue; } r -= I_WIN;
        if (r < I_PW) { const int g = r >> 5, rr = r & 31, kb = rr >> 3, nb = rr & 7; transpose_item(INP(10) + ((size_t)l * 4 + g) * 65536, 256, (bf16_t*)(ws + WS_POOLW) + (size_t)g * 65536, 256, kb * 64, nb * 32, nb * 32, scr, lane, INP(11) + (size_t)l * PWD + g * 256); continue; } r -= I_PW;
        if (r < I_PP) { const int nblk = DM / 32, kb = r / nblk, nb = r % nblk; transpose_item(INP(22) + (size_t)l * PWD * DM, DM, (bf16_t*)(ws + WS_PPOOL), PWD, kb * 64, nb * 32, nb * 32, scr, lane); continue; } r -= I_PP;
        if (r < I_PP) { const int nblk = DM / 32, kb = r / nblk, nb = r % nblk; transpose_item(INP(23) + (size_t)l * RWD * DM, DM, (bf16_t*)(ws + WS_PRWKV), RWD, kb * 64, nb * 32, nb * 32, scr, lane); continue; } r -= I_PP;
        if (r < I_WO) { const int nblk = DM / 32, kb = r / nblk, nb = r % nblk; transpose_item(INP(24) + (size_t)l * DM * DM, DM, (bf16_t*)(ws + WS_WOUT), DM, kb * 64, nb * 32, nb * 32, scr, lane); continue; } r -= I_WO;
        if (r < I_FG) { const int nblk = FF / 32, kb = r / nblk, nb = r % nblk, n0 = nb * 32; transpose_item(INP(26) + (size_t)l * DM * FF, FF, (bf16_t*)(ws + WS_WGU), DM, kb * 64, n0, 256 * (n0 >> 7) + 64 * ((n0 & 127) >> 5), scr, lane, nullptr, INP(25) + (size_t)l * DM); continue; } r -= I_FG;
        if (r < I_FG) { const int nblk = FF / 32, kb = r / nblk, nb = r % nblk, n0 = nb * 32; transpose_item(INP(27) + (size_t)l * DM * FF, FF, (bf16_t*)(ws + WS_WGU), DM, kb * 64, n0, 256 * (n0 >> 7) + 64 * ((n0 & 127) >> 5) + 32, scr, lane, nullptr, INP(25) + (size_t)l * DM); continue; } r -= I_FG;
        if (r < I_FD) { const int nblk = DM / 32, kb = r / nblk, nb = r % nblk; transpose_item(INP(28) + (size_t)l * FF * DM, DM, (bf16_t*)(ws + WS_WDN), FF, kb * 64, nb * 32, nb * 32, scr, lane); continue; } r -= I_FD;
        if (r < I_WO) { const int nblk = DM / 32, kb = r / nblk, nb = r % nblk; transpose_item(INP(30) + (size_t)l * DM * DM, DM, (bf16_t*)(ws + WS_WPG), DM, kb * 64, nb * 32, nb * 32, scr, lane, nullptr, INP(29) + (size_t)l * DM); continue; } r -= I_WO;
        { const int nblk = DM / 32, kb = r / nblk, nb = r % nblk; transpose_item(INP(31) + (size_t)l * PLE * DM, DM, (bf16_t*)(ws + WS_WPP), PLE, kb * 64, nb * 32, nb * 32, scr, lane); }
    }
    const int NT = fresh_i(F.G) * NTHR;
    { u32x4* z = (u32x4*)((bf16_t*)(ws + WS_WIN) + (size_t)4384 * DM); for (int i = gtid; i < 224 * DM * 2 / 16; i += NT) z[i] = (u32x4){0u, 0u, 0u, 0u}; }
    { bf16_t* LT = (bf16_t*)(ws + WS_LORA); const float* wd = INP(13) + (size_t)l * 64 * RWD; const float* wa = INP(15) + (size_t)l * 64 * RWD; const float* wg = INP(16) + (size_t)l * 160 * RWD;
      for (int i = gtid; i < 3072 * (LK / 8); i += NT) { const int n = i / (LK / 8), k0 = (i % (LK / 8)) * 8; const int kind = n >> 10, c = n & 1023; float f[8];
#pragma unroll
          for (int j = 0; j < 8; ++j) { const int k = k0 + j; float v = 0.f;
              if (kind == 0) { if (k < 64) v = wd[(size_t)k * RWD + c]; }
              else if (kind == 1) { if (k >= 64 && k < 128) v = wa[(size_t)(k - 64) * RWD + c]; }
              else { if (k >= 128 && k < 288) v = wg[(size_t)(k - 128) * RWD + c]; }
              f[j] = v; }
          *(u32x4*)(LT + (size_t)n * LK + k0) = pack8(f); } }
    { bf16_t* PB = (bf16_t*)(ws + WS_PB); const float* pp = INP(5) + (size_t)l * MPR * PLE; const float* ps = INP(6) + (size_t)l * (MT - MPR) * PLE;
      for (int i = gtid; i < MT * PLE / 8; i += NT) { const size_t e = (size_t)i * 8; const float* src = e < (size_t)MPR * PLE ? pp + e : ps + (e - (size_t)MPR * PLE);
          const f32x4 a = *(const f32x4*)src, b = *(const f32x4*)(src + 4); *(u32x4*)(PB + e) = pg8::pack_f4x2(a, b); } }
}

__device__ __forceinline__ void xb_from_input(Frame& F) {
    PHASE_IDS
    unsigned char* const wsl = fresh(F.ws);
    const int NGW = fresh_i(F.G) * NWAVES; bf16_t* XB = (bf16_t*)(wsl + WS_XN); pg8::ss_t* SS = (pg8::ss_t*)(wsl + WS_SS);
    for (int m = gw; m < MT; m += NGW) {
        const float* src = m < MPR ? INP(0) + (size_t)m * DM : INP(1) + (size_t)(m - MPR) * DM;
        f32x4 v[8]; float s = 0.f;
#pragma unroll
        for (int j = 0; j < 8; ++j) { v[j] = *(const f32x4*)(src + 4 * lane + 256 * j); s += (v[j].x * v[j].x + v[j].y * v[j].y) + (v[j].z * v[j].z + v[j].w * v[j].w); }
        s = wave_sum(s);
        if (lane == 0) SS[m] = pg8::ss_fix(s);
#pragma unroll
        for (int j = 0; j < 8; ++j) { u32x2 w; w.x = cvt_pk_bf16(v[j].x, v[j].y); w.y = cvt_pk_bf16(v[j].z, v[j].w); *(u32x2*)(XB + (size_t)m * DM + 4 * lane + 256 * j) = w; }
    }
}
__device__ __forceinline__ void final_norm(Frame& F, const float* gain) {
    PHASE_IDS
    unsigned char* const wsl = fresh(F.ws);
    const int NGW = fresh_i(F.G) * NWAVES; const bf16_t* XB = (const bf16_t*)(wsl + ((NL & 1) ? WS_XB2 : WS_XN));
    f32x4 g[8];
#pragma unroll
    for (int j = 0; j < 8; ++j) g[j] = *(const f32x4*)(gain + 4 * lane + 256 * j);
    for (int m = gw; m < MT; m += NGW) {
        f32x4 v[8]; float s = 0.f;
#pragma unroll
        for (int j = 0; j < 8; ++j) { const u32x2 w = *(const u32x2*)(XB + (size_t)m * DM + 4 * lane + 256 * j); v[j] = (f32x4){bf_lo(w.x), bf_hi(w.x), bf_lo(w.y), bf_hi(w.y)};
            s += (v[j].x * v[j].x + v[j].y * v[j].y) + (v[j].z * v[j].z + v[j].w * v[j].w); }
        const float rstd = __builtin_amdgcn_rsqf(wave_sum(s) * (1.0f / DM) + NORM_EPS);
#pragma unroll
        for (int j = 0; j < 8; ++j) *(f32x4*)(F.out + (size_t)m * DM + 4 * lane + 256 * j) = v[j] * rstd * g[j];
    }
}

__device__ __forceinline__ void load_z(float (&z)[8], const bf16_t* PROJ, const float* past, int m0, int t, bool samp, int c0) {
    if (t >= 0) { unpack8(*(const u32x4*)(PROJ + (size_t)(m0 + t) * ICP + c0), z); }
    else if (samp) { const float* p = past + (size_t)(15 + t) * PWD + c0; const f32x4 a = *(const f32x4*)p, b = *(const f32x4*)(p + 4); z[0] = a.x; z[1] = a.y; z[2] = a.z; z[3] = a.w; z[4] = b.x; z[5] = b.y; z[6] = b.z; z[7] = b.w; }
    else {
#pragma unroll
        for (int j = 0; j < 8; ++j) z[j] = 0.f; }
}
__device__ __forceinline__ void prep1_phase(Frame& F, int l_in) {
    PHASE_IDS
    unsigned char* const wsl = fresh(F.ws);
    PHASE_L
    const int NT = fresh_i(F.G) * NTHR; const bf16_t* PROJ = (const bf16_t*)(wsl + WS_PROJ);
    { bf16_t* D = (bf16_t*)(wsl + WS_D);
      for (int it = gtid; it < (MT / 16) * 128; it += NT) {
          const int oct = it & 127, run = it >> 7, mrow = run * 16, c0 = oct * 8, win = 2 << (c0 >> 8);
          int b, t0; bool samp; row_info(mrow, b, t0, samp);
          const int T = samp ? TS : TP, mseq = mrow - t0;
          const float* past = INP(3) + ((size_t)l * 8 + b) * 15 * PWD;
          float* npool = F.out + (samp ? O_POS : O_POP) + ((size_t)l * 8 + b) * 15 * PWD;
          float S[8], z[8];
#pragma unroll
          for (int j = 0; j < 8; ++j) S[j] = 0.f;
          for (int j = 1; j < win; ++j) { load_z(z, PROJ, past, mseq, t0 - j, samp, c0);
#pragma unroll
              for (int q = 0; q < 8; ++q) S[q] += z[q]; }
          for (int i = 0; i < 16; ++i) { const int t = t0 + i; float cur[8]; load_z(cur, PROJ, past, mseq, t, samp, c0);
              const int cnt = samp ? win : (t + 1 < win ? t + 1 : win); const float inv = 1.0f / (float)cnt; float d[8];
#pragma unroll
              for (int q = 0; q < 8; ++q) { S[q] += cur[q]; d[q] = S[q] * inv - cur[q]; }
              *(u32x4*)(D + (size_t)(mseq + t) * PWD + c0) = pack8(d);
              if (t >= T - 15) { float* o = npool + (size_t)(t - (T - 15)) * PWD + c0; *(f32x4*)o = (f32x4){cur[0], cur[1], cur[2], cur[3]}; *(f32x4*)(o + 4) = (f32x4){cur[4], cur[5], cur[6], cur[7]}; }
              load_z(z, PROJ, past, mseq, t - win + 1, samp, c0);
#pragma unroll
              for (int q = 0; q < 8; ++q) S[q] -= z[q]; }
      } }
    { bf16_t* LIN = (bf16_t*)(wsl + WS_LIN); const float* mu = INP(9) + (size_t)l * RPJ + 3072;
      for (int it = gtid; it < MT * (LK / 8); it += NT) {
          const int m = it / (LK / 8), c0 = (it % (LK / 8)) * 8; float o[8];
          if (c0 >= 288) {
#pragma unroll
              for (int j = 0; j < 8; ++j) o[j] = 0.f;
          } else {
              int b, t; bool samp; row_info(m, b, t, samp);
              float cur[8], prv[8]; unpack8(*(const u32x4*)(PROJ + (size_t)m * ICP + 4096 + c0), cur);
              if (t > 0) unpack8(*(const u32x4*)(PROJ + (size_t)(m - 1) * ICP + 4096 + c0), prv);
              else if (samp) { const float* p = INP(2) + ((size_t)l * 8 + b) * RPJ + 3072 + c0;
#pragma unroll
                  for (int j = 0; j < 8; ++j) prv[j] = p[j]; }
              else {
#pragma unroll
                  for (int j = 0; j < 8; ++j) prv[j] = 0.f; }
#pragma unroll
              for (int j = 0; j < 8; ++j) { const float xm = cur[j] + (prv[j] - cur[j]) * mu[c0 + j]; o[j] = c0 < 64 ? tanhf_(xm) : (c0 < 128 ? xm : sigmoidf_(xm)); }
          }
          *(u32x4*)(LIN + (size_t)m * LK + c0) = pack8(o);
      } }
    { pg8::ss_t* SS = (pg8::ss_t*)(wsl + WS_SS); for (int i = gtid; i < 3 * MT; i += NT) SS[i] = 0u; }
    for (int it = gtid; it < 16 * RPJ; it += NT) { const int s = it / RPJ, c = it % RPJ; const int mlast = s < 8 ? s * TP + TP - 1 : MPR + (s - 8) * TS + TS - 1;
        F.out[(s < 8 ? O_SHP : O_SHS) + ((size_t)l * 8 + (s & 7)) * RPJ + c] = __uint_as_float((unsigned)PROJ[(size_t)mlast * ICP + 1024 + c] << 16); }
}

__device__ __forceinline__ unsigned char* cb_ptr(unsigned char* ws, size_t i) { return ws + WS_TMP + i * CBSZ; }
__device__ __forceinline__ float sum16(float x) { x += dpp_f<0xB1>(x); x += dpp_f<0x4E>(x); x += dpp_f<0x141>(x); x += dpp_f<0x140>(x); return x; }
__device__ __forceinline__ f32x4 mfma16(bf16x8 a, bf16x8 b, f32x4 c) { return __builtin_amdgcn_mfma_f32_16x16x32_bf16(a, b, c, 0, 0, 0); }
__device__ __forceinline__ bf16x8 mk8(u32x2 lo, u32x2 hi) { u32x4 w = (u32x4){lo.x, lo.y, hi.x, hi.y}; return __builtin_bit_cast(bf16x8, w); }
typedef __bf16 bf16x2_c __attribute__((ext_vector_type(2)));
__device__ __forceinline__ unsigned cvt_pk_c(float lo, float hi) { const f32x2 v = (f32x2){lo, hi}; const bf16x2_c b = __builtin_convertvector(v, bf16x2_c); return __builtin_bit_cast(unsigned, b); }
__device__ __forceinline__ u32x2 pk4(f32x4 v) { return (u32x2){cvt_pk_c(v.x, v.y), cvt_pk_c(v.z, v.w)}; }
__device__ __forceinline__ unsigned short bf1(float f) { return (unsigned short)(cvt_pk_c(f, 0.f) & 0xffffu); }

__device__ __forceinline__ void spre_phase(Frame& F, int l_in) {
    PHASE_IDS
    unsigned char* const wsl = fresh(F.ws);
    PHASE_L
    const int NGW = fresh_i(F.G) * NWAVES;
    LAS unsigned char* L = F.lds + wave * 16384;
    const bf16_t* PROJ = (const bf16_t*)(wsl + WS_PROJ); const bf16_t* AA = (const bf16_t*)(wsl + WS_AA); const float* DEC = (const float*)(wsl + WS_DEC);
    const int fr = lane & 15, fq = lane >> 4;
    const float* mu = INP(9) + (size_t)l * RPJ;
#define SP_LOAD(it_, R, K, V, A, W, PR, PK, PV) do { const int h_ = (it_) & 15, m0_ = ((it_) >> 4) * 16, ch_ = h_ * 64 + lane; int b_, t0_; bool samp_; row_info(m0_, b_, t0_, samp_); \
        _Pragma("unroll") for (int t = 0; t < 16; ++t) { const size_t mm = (size_t)(m0_ + t); const bf16_t* pc = PROJ + mm * ICP + 1024 + ch_; R[t] = pc[0]; K[t] = pc[1024]; V[t] = pc[2048]; A[t] = AA[mm * RWD + ch_]; W[t] = DEC[mm * RWD + ch_]; } \
        if (t0_ > 0) { const bf16_t* pc = PROJ + (size_t)(m0_ - 1) * ICP + 1024 + ch_; PR = __uint_as_float((unsigned)pc[0] << 16); PK = __uint_as_float((unsigned)pc[1024] << 16); PV = __uint_as_float((unsigned)pc[2048] << 16); } \
        else if (samp_) { const float* sp = INP(2) + ((size_t)l * 8 + b_) * RPJ + ch_; PR = sp[0]; PK = sp[1024]; PV = sp[2048]; } \
        else { PR = 0.f; PK = 0.f; PV = 0.f; } } while (0)
    unsigned short cr[16], ck[16], cv[16], ca[16], nr[16], nk[16], nv[16], na[16]; float cw[16], nw[16]; float pr = 0.f, pk = 0.f, pv = 0.f, npr = 0.f, npk = 0.f, npv = 0.f;
    if (gw < (int)CB_N) SP_LOAD(gw, cr, ck, cv, ca, cw, pr, pk, pv);
    for (int it = gw; it < (int)CB_N; it += NGW) {
        const int h = it & 15, crow = it >> 4, m0 = crow * 16, ch = h * 64 + lane;
        unsigned char* cb = cb_ptr(wsl, (size_t)it);
        const float mur = mu[ch], muk = mu[1024 + ch], muv = mu[2048 + ch];
        const float ckk = (INP(17) + (size_t)l * RWD)[ch], cka = (INP(18) + (size_t)l * RWD)[ch], crk = (INP(19) + (size_t)l * RWD)[ch];
        { const int itn = it + NGW; if (itn < (int)CB_N) SP_LOAD(itn, nr, nk, nv, na, nw, npr, npk, npv); }
        float g = 1.0f; unsigned at2[8], bt2[8], kt2[8], vt2[8]; float hold_a = 0.f, hold_b = 0.f, hold_k = 0.f, hold_v = 0.f;
#pragma unroll
        for (int t = 0; t < 16; ++t) {
            const float xr = __uint_as_float((unsigned)cr[t] << 16), xk = __uint_as_float((unsigned)ck[t] << 16), xv = __uint_as_float((unsigned)cv[t] << 16), av = __uint_as_float((unsigned)ca[t] << 16);
            const float r = xr + (pr - xr) * mur, kx = xk + (pk - xk) * muk, vv = xv + (pv - xv) * muv; pr = xr; pk = xk; pv = xv;
            float kkv = kx * ckk; const float ss = wave_sum(kkv * kkv); kkv *= __builtin_amdgcn_rsqf(fmaxf(ss, 1e-24f));
            const float kh = kx * (1.0f + (av - 1.0f) * cka), bb = kkv * av; const float bsum = wave_sum(r * kh * crk);
            if (lane == 0) *(float*)(cb + CB_BS + t * 4) = bsum;
            const float a_t = -kkv * g; g *= cw[t]; const float ig = __builtin_amdgcn_rcpf(g); const float b_t = bb * ig, k_t = kh * ig, r_t = r * g;
            *(LAS unsigned short*)(L + t * 144 + lane * 2) = bf1(a_t); *(LAS unsigned short*)(L + 2304 + t * 144 + lane * 2) = bf1(b_t);
            *(LAS unsigned short*)(L + 4608 + t * 144 + lane * 2) = bf1(k_t); *(LAS unsigned short*)(L + 6912 + t * 144 + lane * 2) = bf1(r_t);
            if (t & 1) { at2[t >> 1] = cvt_pk_c(hold_a, a_t); bt2[t >> 1] = cvt_pk_c(hold_b, b_t); kt2[t >> 1] = cvt_pk_c(hold_k, k_t); vt2[t >> 1] = cvt_pk_c(hold_v, vv); }
            else { hold_a = a_t; hold_b = b_t; hold_k = k_t; hold_v = vv; }
        }
        *(LAS u32x4*)(L + 9216 + lane * 32) = (u32x4){at2[0], at2[1], at2[2], at2[3]}; *(LAS u32x4*)(L + 9216 + lane * 32 + 16) = (u32x4){at2[4], at2[5], at2[6], at2[7]};
        { u32x4* o = (u32x4*)(cb + CB_BK + lane * 64);
#pragma unroll
          for (int q = 0; q < 4; ++q) o[q] = (u32x4){bt2[2 * q], bt2[2 * q + 1], kt2[2 * q], kt2[2 * q + 1]}; }
        { u32x4* o = (u32x4*)(cb + CB_VT + lane * 32); o[0] = (u32x4){vt2[0], vt2[1], vt2[2], vt2[3]}; o[1] = (u32x4){vt2[4], vt2[5], vt2[6], vt2[7]}; }
        *(float*)(cb + CB_GC + lane * 4) = g;
        asm volatile("" ::: "memory");
#define SP_ROWS(off, j) (*(const LAS bf16x8*)(L + (off) + fr * 144 + (j) * 64 + fq * 16))
        f32x4 nD = (f32x4){0.f, 0.f, 0.f, 0.f}, makD = nD, mrbD = nD, mrkD = nD;
#pragma unroll
        for (int j = 0; j < 2; ++j) { const bf16x8 fa = SP_ROWS(0, j), fb = SP_ROWS(2304, j), fk = SP_ROWS(4608, j), fR = SP_ROWS(6912, j);
            nD = mfma16(fb, fa, nD); makD = mfma16(fk, fa, makD); mrbD = mfma16(fb, fR, mrbD); mrkD = mfma16(fk, fR, mrkD); }
#pragma unroll
        for (int rr = 0; rr < 4; ++rr) { const int s = 4 * fq + rr; if (s >= fr) { nD[rr] = 0.f; makD[rr] = 0.f; } if (s > fr) { mrbD[rr] = 0.f; mrkD[rr] = 0.f; } }
        { const u32x2 mb = pk4(mrbD), mk = pk4(mrkD); *(u32x4*)(cb + CB_MBT + (fr * 4 + fq) * 16) = (u32x4){mb.x, mb.y, mk.x, mk.y}; }
#define SP_WR_RM(off, D) do { _Pragma("unroll") for (int rr = 0; rr < 4; ++rr) *(LAS unsigned short*)(L + (off) + (4 * fq + rr) * 32 + fr * 2) = bf1((D)[rr]); } while (0)
#define SP_WR_TR(off, D) do { *(LAS u32x2*)(L + (off) + fr * 32 + fq * 8) = pk4(D); } while (0)
#define SP_FRAG16(off) (fq < 2 ? *(const LAS bf16x8*)(L + (off) + fr * 32 + fq * 16) : (bf16x8){0, 0, 0, 0, 0, 0, 0, 0})
        SP_WR_RM(13568, nD); SP_WR_TR(14080, nD); SP_WR_RM(15616, makD); asm volatile("" ::: "memory");
        f32x4 TD = nD;
#pragma unroll
        for (int rr = 0; rr < 4; ++rr) if (4 * fq + rr == fr) TD[rr] += 1.0f;
#pragma unroll
        for (int itp = 0; itp < 3; ++itp) {
            SP_WR_RM(14592, TD); asm volatile("" ::: "memory");
            const f32x4 p2 = mfma16(SP_FRAG16(13568), SP_FRAG16(14080), (f32x4){0.f, 0.f, 0.f, 0.f}); asm volatile("" ::: "memory");
            SP_WR_RM(13568, p2); SP_WR_TR(14080, p2); asm volatile("" ::: "memory");
            TD = mfma16(SP_FRAG16(14592), SP_FRAG16(14080), TD); asm volatile("" ::: "memory");
        }
        SP_WR_TR(15104, TD); asm volatile("" ::: "memory");
        { const bf16x8 ftt = SP_FRAG16(15104);
#pragma unroll
          for (int blk = 0; blk < 4; ++blk) { const bf16x8 fb = fq < 2 ? *(const LAS bf16x8*)(L + 9216 + (16 * blk + fr) * 32 + fq * 16) : (bf16x8){0, 0, 0, 0, 0, 0, 0, 0};
              const f32x4 d = mfma16(ftt, fb, (f32x4){0.f, 0.f, 0.f, 0.f});
#pragma unroll
              for (int rr = 0; rr < 4; ++rr) *(LAS unsigned short*)(L + 11264 + (4 * fq + rr) * 144 + (16 * blk + fr) * 2) = bf1(d[rr]); }
          const f32x4 p2 = mfma16(SP_FRAG16(15616), ftt, (f32x4){0.f, 0.f, 0.f, 0.f});
          *(u32x2*)(cb + CB_P2T + fr * 32 + fq * 8) = pk4(p2); }
        asm volatile("" ::: "memory");
#pragma unroll
        for (int q = 0; q < 2; ++q) { const int pc = lane + 64 * q, pcc = pc >> 6, pt = (pc >> 2) & 15, pf = pc & 3;
            const u32x2 a0 = *(const LAS u32x2*)(L + 11264 + pt * 144 + (32 * pcc + 4 * pf) * 2), a1 = *(const LAS u32x2*)(L + 11264 + pt * 144 + (32 * pcc + 16 + 4 * pf) * 2);
            const u32x2 r0 = *(const LAS u32x2*)(L + 6912 + pt * 144 + (32 * pcc + 4 * pf) * 2), r1 = *(const LAS u32x2*)(L + 6912 + pt * 144 + (32 * pcc + 16 + 4 * pf) * 2);
            *(u32x4*)(cb + CB_P1T + pc * 16) = (u32x4){a0.x, a0.y, a1.x, a1.y}; *(u32x4*)(cb + CB_RT + pc * 16) = (u32x4){r0.x, r0.y, r1.x, r1.y}; }
        asm volatile("" ::: "memory");
#pragma unroll
        for (int t = 0; t < 16; ++t) { cr[t] = nr[t]; ck[t] = nk[t]; cv[t] = nv[t]; ca[t] = na[t]; cw[t] = nw[t]; }
        pr = npr; pk = npk; pv = npv;
#undef SP_ROWS
#undef SP_LOAD
#undef SP_WR_RM
#undef SP_WR_TR
#undef SP_FRAG16
    }
}

constexpr int SQ_D = 5, SQ_SLOT = 14336, SQ_NSLOT = 7, SQ_DUMP = SQ_NSLOT * SQ_SLOT, SQ_YBUF = SQ_DUMP + 2048;
__device__ __forceinline__ void sseq_phase(Frame& F, int l_in) {
    PHASE_IDS
    unsigned char* const wsl = fresh(F.ws);
    PHASE_L
    const bf16_t* GG = (const bf16_t*)(wsl + WS_GG); bf16_t* YB = (bf16_t*)(wsl + WS_YB);
    const bool is_cons = wave < 4;
    const int fr = lane & 15, fq = lane >> 4, vrow = (wave & 3) * 16 + fr, lw = wave & 3;
    for (int u = blockIdx.x; u < 256; u += fresh_i(F.G)) {
        const bool samp = u >= 128; const int h = u & 15, b = (u >> 4) & 7;
        const int T = samp ? TS : TP, m0 = samp ? MPR + b * TS : b * TP, nch = T / 16, crow0 = m0 / 16;
        f32x4 sreg[4];
        if (samp) { const float* sp = INP(4) + ((((size_t)l * 8 + b) * 16 + h) * 64 + vrow) * 64 + 4 * fq;
#pragma unroll
            for (int kb = 0; kb < 4; ++kb) sreg[kb] = *(const f32x4*)(sp + 16 * kb); }
        else {
#pragma unroll
            for (int kb = 0; kb < 4; ++kb) sreg[kb] = (f32x4){0.f, 0.f, 0.f, 0.f}; }
        const f32x4 gng = *(const f32x4*)(INP(20) + (size_t)l * RWD + h * 64 + 4 * fr), gnb = *(const f32x4*)(INP(21) + (size_t)l * RWD + h * 64 + 4 * fr);
#define SQ_ISSUE(c) do { const unsigned char* src = cb_ptr(wsl, (size_t)(crow0 + (c)) * 16 + h) + (lw * 3) * 1024 + lane * 16; LAS unsigned char* dst = F.lds + ((c) % SQ_NSLOT) * SQ_SLOT + (lw * 3) * 1024; \
        _Pragma("unroll") for (int i = 0; i < 3; ++i) __builtin_amdgcn_global_load_lds((const unsigned*)(src + i * 1024), (LAS unsigned*)(dst + i * 1024), 16, 0, 0); \
        if (lw < 2) __builtin_amdgcn_global_load_lds((const unsigned*)((const unsigned char*)(GG + (size_t)(m0 + (c) * 16 + 8 * lw + (lane >> 3)) * RWD + h * 64) + (lane & 7) * 16), (LAS unsigned*)(F.lds + ((c) % SQ_NSLOT) * SQ_SLOT + 12288 + lw * 1024), 16, 0, 0); \
        else __builtin_amdgcn_global_load_lds((const unsigned*)src, (LAS unsigned*)(F.lds + SQ_DUMP + (lw - 2) * 1024), 16, 0, 0); } while (0)
#define SQ_WAIT(k) do { switch (k) { case 0: asm volatile("s_waitcnt vmcnt(0)" ::: "memory"); break; case 1: asm volatile("s_waitcnt vmcnt(4)" ::: "memory"); break; case 2: asm volatile("s_waitcnt vmcnt(8)" ::: "memory"); break; \
        case 3: asm volatile("s_waitcnt vmcnt(12)" ::: "memory"); break; default: asm volatile("s_waitcnt vmcnt(16)" ::: "memory"); break; } } while (0)
#define SQ_POST(c) do { const LAS unsigned char* Bp = F.lds + ((c) % SQ_NSLOT) * SQ_SLOT; const int tt = 4 * lw + fq; \
        const f32x4 y4 = *(const LAS f32x4*)(F.lds + SQ_YBUF + ((c) & 1) * 4096 + (tt * 64 + 4 * fr) * 4); \
        const float mean = sum16((y4.x + y4.y) + (y4.z + y4.w)) * (1.0f / 64.0f); const f32x4 dv = y4 - mean; \
        const float rstd = __builtin_amdgcn_rsqf(sum16((dv.x * dv.x + dv.y * dv.y) + (dv.z * dv.z + dv.w * dv.w)) * (1.0f / 64.0f) + GN_EPS); \
        const float bs = *(const LAS float*)(Bp + CB_BS + tt * 4); const u32x2 gq = *(const LAS u32x2*)(Bp + 12288 + tt * 128 + fr * 8); \
        f32x4 vv; _Pragma("unroll") for (int j = 0; j < 4; ++j) vv[j] = __uint_as_float((unsigned)(*(const LAS unsigned short*)(Bp + CB_VT + (4 * fr + j) * 32 + tt * 2)) << 16); \
        const f32x4 o = (dv * rstd * gng + gnb + bs * vv) * (f32x4){bf_lo(gq.x), bf_hi(gq.x), bf_lo(gq.y), bf_hi(gq.y)}; \
        *(u32x2*)(YB + (size_t)(m0 + (c) * 16 + tt) * RWD + h * 64 + 4 * fr) = (u32x2){cvt_pk_bf16(o.x, o.y), cvt_pk_bf16(o.z, o.w)}; } while (0)
        __syncthreads();
        if (!is_cons) { const int np = nch < SQ_D ? nch : SQ_D; for (int c = 0; c < np; ++c) SQ_ISSUE(c); SQ_WAIT(np - 1); }
        __syncthreads();
        for (int c = 0; c < nch; ++c) {
            if (is_cons) {
                const LAS unsigned char* B = F.lds + (c % SQ_NSLOT) * SQ_SLOT;
#define SQ_KA(off, cc) (*(const LAS bf16x8*)(B + (off) + (((cc) * 16 + fr) * 4 + fq) * 16))
                const u32x2 vt = *(const LAS u32x2*)(B + CB_VT + vrow * 32 + fq * 8), z2 = (u32x2){0u, 0u};
                const bf16x8 aP2 = mk8(*(const LAS u32x2*)(B + CB_P2T + fr * 32 + fq * 8), z2), aP10 = SQ_KA(CB_P1T, 0), aP11 = SQ_KA(CB_P1T, 1), aR0 = SQ_KA(CB_RT, 0), aR1 = SQ_KA(CB_RT, 1);
                const bf16x8 aM = *(const LAS bf16x8*)(B + CB_MBT + (fr * 4 + fq) * 16);
                bf16x8 aBK[4]; f32x4 gc[4];
#pragma unroll
                for (int kb = 0; kb < 4; ++kb) { aBK[kb] = *(const LAS bf16x8*)(B + CB_BK + ((16 * kb + fr) * 4 + fq) * 16); gc[kb] = *(const LAS f32x4*)(B + CB_GC + (16 * kb + 4 * fq) * 4); }
                __builtin_amdgcn_sched_barrier(0);
                const bf16x8 sB0 = mk8(pk4(sreg[0]), pk4(sreg[1])), sB1 = mk8(pk4(sreg[2]), pk4(sreg[3]));
                f32x4 uD = mfma16(aP2, mk8(vt, z2), (f32x4){0.f, 0.f, 0.f, 0.f});
                uD = mfma16(aP10, sB0, uD); uD = mfma16(aP11, sB1, uD);
                const bf16x8 uvB = mk8(pk4(uD), vt);
                f32x4 nS[4];
#pragma unroll
                for (int kb = 0; kb < 4; ++kb) nS[kb] = mfma16(aBK[kb], uvB, sreg[kb]);
                f32x4 yD = mfma16(aM, uvB, (f32x4){0.f, 0.f, 0.f, 0.f});
                yD = mfma16(aR0, sB0, yD); yD = mfma16(aR1, sB1, yD);
#pragma unroll
                for (int kb = 0; kb < 4; ++kb) sreg[kb] = nS[kb] * gc[kb];
                { LAS float* yo = (LAS float*)(F.lds + SQ_YBUF + (c & 1) * 4096) + (4 * fq) * 64 + vrow; yo[0] = yD[0]; yo[64] = yD[1]; yo[128] = yD[2]; yo[192] = yD[3]; }
#undef SQ_KA
            } else {
                if (c + SQ_D < nch) SQ_ISSUE(c + SQ_D);
                if (c + 1 < nch) { const int last = c + SQ_D < nch ? c + SQ_D : nch - 1; SQ_WAIT(last - (c + 1)); }
                if (c > 0) SQ_POST(c - 1);
            }
            asm volatile("s_waitcnt lgkmcnt(0)" ::: "memory"); __builtin_amdgcn_s_barrier(); asm volatile("" ::: "memory");
        }
        if (!is_cons) SQ_POST(nch - 1);
#undef SQ_ISSUE
#undef SQ_WAIT
#undef SQ_POST
        if (is_cons) { float* so = F.out + (samp ? O_WKS : O_WKP) + ((((size_t)l * 8 + b) * 16 + h) * 64 + vrow) * 64 + 4 * fq;
#pragma unroll
            for (int kb = 0; kb < 4; ++kb) *(f32x4*)(so + 16 * kb) = sreg[kb]; }
    }
}

__device__ __forceinline__ void tile64_mma(const bf16_t* A, int lda, const bf16_t* Bt, int ldb, int K, int m0, int n0, int wave, int lane, f32x4 (&acc)[4][4]) {
    const int kq = K >> 3, kb = wave * kq, lr = lane & 15, lk = (lane >> 4) * 8;
    const bf16_t* ap = A + (size_t)(m0 + lr) * lda + kb + lk; const bf16_t* bp = Bt + (size_t)(n0 + lr) * ldb + kb + lk;
#pragma unroll 2
    for (int k = 0; k < kq; k += 32) {
        bf16x8 af[4], bf[4];
#pragma unroll
        for (int i = 0; i < 4; ++i) { af[i] = *(const bf16x8*)(ap + (size_t)(16 * i) * lda + k); bf[i] = *(const bf16x8*)(bp + (size_t)(16 * i) * ldb + k); }
#pragma unroll
        for (int mi = 0; mi < 4; ++mi)
#pragma unroll
            for (int ni = 0; ni < 4; ++ni) acc[mi][ni] = __builtin_amdgcn_mfma_f32_16x16x32_bf16(bf[ni], af[mi], acc[mi][ni], 0, 0, 0);
    }
}
__device__ __forceinline__ void tile64_reduce(LAS unsigned char* lds, int wave, int lane, const f32x4 (&acc)[4][4], f32x4 (&out)[2]) {
    LAS f32x4* red = (LAS f32x4*)lds;
    __syncthreads();
#pragma unroll
    for (int mi = 0; mi < 4; ++mi)
#pragma unroll
        for (int ni = 0; ni < 4; ++ni) red[(wave * 16 + mi * 4 + ni) * 64 + lane] = acc[mi][ni];
    __syncthreads();
#pragma unroll
    for (int j = 0; j < 2; ++j) { f32x4 s = red[(2 * wave + j) * 64 + lane];
#pragma unroll
        for (int w = 1; w < 8; ++w) s += red[(w * 16 + 2 * wave + j) * 64 + lane];
        out[j] = s; }
}
#define T64_ZERO(acc) do { _Pragma("unroll") for (int mi = 0; mi < 4; ++mi) _Pragma("unroll") for (int ni = 0; ni < 4; ++ni) acc[mi][ni] = (f32x4){0.f, 0.f, 0.f, 0.f}; } while (0)
template <int MODE>
__device__ __forceinline__ void sample_tiles(Frame& F, int l_in) {
    PHASE_IDS
    unsigned char* const wsl = fresh(F.ws);
    PHASE_L
    const size_t xb_cur = (l & 1) ? WS_XB2 : WS_XN, xb_nxt = (l & 1) ? WS_XN : WS_XB2;
    for (int t = blockIdx.x; t < 256; t += fresh_i(F.G)) {
        const int m0 = MPR + (t >> 5) * 64, n0 = (t & 31) * 64;
        f32x4 acc[4][4], o1[2], o2[2]; T64_ZERO(acc);
        if (MODE == 0) { tile64_mma((const bf16_t*)(wsl + WS_YA), PWD, (const bf16_t*)(wsl + WS_PPOOL), PWD, PWD, m0, n0, wave, lane, acc); tile64_reduce(F.lds, wave, lane, acc, o1);
                         T64_ZERO(acc); tile64_mma((const bf16_t*)(wsl + WS_YB), RWD, (const bf16_t*)(wsl + WS_PRWKV), RWD, RWD, m0, n0, wave, lane, acc); tile64_reduce(F.lds, wave, lane, acc, o2); }
        if (MODE == 1) { tile64_mma((const bf16_t*)(wsl + WS_MRG), DM, (const bf16_t*)(wsl + WS_WOUT), DM, DM, m0, n0, wave, lane, acc); tile64_reduce(F.lds, wave, lane, acc, o1); }
        if (MODE == 2) { tile64_mma((const bf16_t*)(wsl + WS_HID), FF, (const bf16_t*)(wsl + WS_WDN), FF, FF, m0, n0, wave, lane, acc); tile64_reduce(F.lds, wave, lane, acc, o1); }
        if (MODE == 3) { tile64_mma((const bf16_t*)(wsl + xb_cur), DM, (const bf16_t*)(wsl + WS_WPG), DM, DM, m0, n0, wave, lane, acc); tile64_reduce(F.lds, wave, lane, acc, o1); }
        if (MODE == 4) { tile64_mma((const bf16_t*)(wsl + WS_PB), PLE, (const bf16_t*)(wsl + WS_WPP), PLE, PLE, m0, n0, wave, lane, acc); tile64_reduce(F.lds, wave, lane, acc, o1); }
#pragma unroll
        for (int j = 0; j < 2; ++j) { const int blk = 2 * wave + j; const size_t row = (size_t)(m0 + 16 * (blk >> 2) + (lane & 15)); const int col = n0 + 16 * (blk & 3) + 4 * (lane >> 4);
            if (MODE == 0) { const bf16_t* PROJ = (const bf16_t*)(wsl + WS_PROJ); const u32x2 g1 = *(const u32x2*)(PROJ + row * ICP + PC_GP + col), g2 = *(const u32x2*)(PROJ + row * ICP + PC_GR + col);
                const f32x4 a = (f32x4){bf_lo(g1.x), bf_hi(g1.x), bf_lo(g1.y), bf_hi(g1.y)} * o1[j] + (f32x4){bf_lo(g2.x), bf_hi(g2.x), bf_lo(g2.y), bf_hi(g2.y)} * o2[j];
                *(u32x2*)((bf16_t*)(wsl + WS_MRG) + row * DM + col) = (u32x2){cvt_pk_bf16(a.x, a.y), cvt_pk_bf16(a.z, a.w)}; }
            if (MODE == 1 || MODE == 2) { bf16_t* p = (bf16_t*)(wsl + xb_cur) + row * DM + col; const u32x2 q = *(const u32x2*)p; const f32x4 x = (f32x4){bf_lo(q.x), bf_hi(q.x), bf_lo(q.y), bf_hi(q.y)} + o1[j];
                *(u32x2*)p = (u32x2){cvt_pk_bf16(x.x, x.y), cvt_pk_bf16(x.z, x.w)}; __hip_atomic_fetch_add((pg8::ss_t*)(wsl + WS_SS) + (size_t)MODE * MT + row, pg8::ss_fix((x.x * x.x + x.y * x.y) + (x.z * x.z + x.w * x.w)), __ATOMIC_RELAXED, __HIP_MEMORY_SCOPE_AGENT); }
            if (MODE == 3) { const u32x2 q = *(const u32x2*)((const bf16_t*)(wsl + WS_PP) + row * DM + col); const u32x2 xq = *(const u32x2*)((const bf16_t*)(wsl + xb_cur) + row * DM + col); bf16_t* p = (bf16_t*)(wsl + xb_nxt) + row * DM + col;
                const float rs = pg8::rstd_of((const pg8::ss_t*)(wsl + WS_SS) + (size_t)2 * MT, row);
                const f32x4 x = (f32x4){bf_lo(xq.x), bf_hi(xq.x), bf_lo(xq.y), bf_hi(xq.y)} + sigmoid4(o1[j] * rs) * (f32x4){bf_lo(q.x), bf_hi(q.x), bf_lo(q.y), bf_hi(q.y)};
                *(u32x2*)p = (u32x2){cvt_pk_bf16(x.x, x.y), cvt_pk_bf16(x.z, x.w)}; __hip_atomic_fetch_add((pg8::ss_t*)(wsl + WS_SS) + row, pg8::ss_fix((x.x * x.x + x.y * x.y) + (x.z * x.z + x.w * x.w)), __ATOMIC_RELAXED, __HIP_MEMORY_SCOPE_AGENT); }
            if (MODE == 4) *(u32x2*)((bf16_t*)(wsl + WS_PP) + row * DM + col) = (u32x2){cvt_pk_bf16(o1[j].x, o1[j].y), cvt_pk_bf16(o1[j].z, o1[j].w)};
        }
    }
    __syncthreads();
}

constexpr int PH_PER_LAYER = 11, N_PHASES = NL * PH_PER_LAYER + 1;
#ifndef MK_REP
#define MK_REP 0
#endif
__global__ void __launch_bounds__(NTHR, 2) mega_fwd(Args args) {
    extern __shared__ __attribute__((aligned(16))) unsigned char lds[];
    Frame F;
    F.lds = (LAS unsigned char*)lds;
    F.G = gridDim.x;
    F.out = args.out; F.ws = args.ws;
    { LAS unsigned long long* pt = (LAS unsigned long long*)(F.lds + LDSCTL_OFF + 1024); F.ptab = pt;
      if (threadIdx.x == 0) {
#define PT_(k) pt[k] = (unsigned long long)args.in[k];
          PT_(0) PT_(1) PT_(2) PT_(3) PT_(4) PT_(5) PT_(6) PT_(7) PT_(8) PT_(9) PT_(10) PT_(11) PT_(12) PT_(13) PT_(14) PT_(15) PT_(16) PT_(17) PT_(18) PT_(19) PT_(20) PT_(21) PT_(22) PT_(23) PT_(24) PT_(25) PT_(26) PT_(27) PT_(28) PT_(29) PT_(30) PT_(31) PT_(32)
#undef PT_
      } }
    volatile LAS unsigned* MISC = (volatile LAS unsigned*)(F.lds + LDSCTL_OFF);
    for (int u = threadIdx.x; u < 256; u += NTHR) ((LAS unsigned*)(F.lds + LDSCTL_OFF))[u] = 0u;
    __syncthreads();
    XcdBarrier bar; bar.bar = (unsigned*)(args.ws + WS_CTL) + CW_BAR; bar.x = 0; bar.st = nullptr;
    if (!MK_PER_PHASE) bar = xcd_barrier_post((unsigned*)(args.ws + WS_CTL) + CW_BAR, MISC + 8);
    const int lo = args.ph_lo, hi = args.ph_hi;
#define IN(k) (lo <= (k) && (k) < hi)
#define REP(k) (1 + ((MK_REP >> (k)) & 1))
#define PHASE(k, ...) do { if (IN(pb + (k))) { for (int rep = 0; rep < REP(k); ++rep) { if (rep) xcd_barrier(bar); __VA_ARGS__ } if (IN(pb + (k) + 1)) xcd_barrier(bar); } } while (0)
#define WSP(off) (fresh(F.ws) + (off))
#define UNPAREN(...) __VA_ARGS__
#define GEMM_M(M_, EPI, EINIT, Aoff, Boff, N_, K_, lda_, ldb_, apn_) do { pg8::Gemm g{(const bf16_t*)WSP(Aoff), (const bf16_t*)WSP(Boff), (M_), (N_), (K_), (lda_), (ldb_), (apn_)}; pg8::StaticOrder S; S.init((M_), (N_), fresh_i(F.G), fresh_i(cid)); \
        pg8::EPI E{UNPAREN EINIT}; pg8::gemm_phase<pg8::EPI, pg8::StaticOrder, true>(ring, g, S, E); } while (0)
#define GEMM(...) GEMM_M(MT, __VA_ARGS__)
#define GEMM_PAIR(M_, EPI, EINIT, Aoff, A2off, Boff, N_, K_, lda_, ldb_) do { pg8::Gemm g{(const bf16_t*)WSP(Aoff), (const bf16_t*)WSP(Boff), (M_), (N_), (K_), (lda_), (ldb_), (int)(((A2off) - (Aoff)) / 2)}; pg8::PairOrder S; \
        S.init((M_), (N_), fresh_i(F.G), fresh_i(cid)); pg8::EPI E{UNPAREN EINIT}; pg8::gemm_phase<pg8::EPI, pg8::PairOrder, true>(ring, g, S, E); } while (0)
#define GEMM_SUB(c0_, M_, EPI, EINIT, Aoff, Boff, N_, K_, lda_, ldb_, apn_) do { pg8::Gemm g{(const bf16_t*)WSP(Aoff), (const bf16_t*)WSP(Boff), (M_), (N_), (K_), (lda_), (ldb_), (apn_)}; pg8::StaticOrder S; \
        const int c0v = (c0_); S.init((M_), (N_), fresh_i(F.G) - c0v, fresh_i(cid) >= c0v ? fresh_i(cid) - c0v : -1); pg8::EPI E{UNPAREN EINIT}; pg8::gemm_phase<pg8::EPI, pg8::StaticOrder, true>(ring, g, S, E); } while (0)
    LAS unsigned char* ring = F.lds;
    const int cid = (int)blockIdx.x;
    for (int l = 0; l < NL; ++l) {
        const int pb = l * PH_PER_LAYER;
#define SSP(i) ((pg8::ss_t*)WSP(WS_SS) + (size_t)(i) * MT)
        const size_t xb_cur = (l & 1) ? WS_XB2 : WS_XN, xb_nxt = (l & 1) ? WS_XN : WS_XB2;
        PHASE(0, { convert_weights(F, l); if (l == 0) xb_from_input(F); });
        PHASE(1, { GEMM(EpiProj, ((bf16_t*)WSP(WS_PROJ), SSP(0)), xb_cur, WS_WIN, ICP, DM, DM, DM, 0); });
        PHASE(2, { prep1_phase(F, l); });
        PHASE(3, { GEMM(EpiBf16, ((bf16_t*)WSP(WS_YA), PWD), WS_D, WS_POOLW, PWD, 256, PWD, 256, 256);
                   GEMM(EpiLora, ((float*)WSP(WS_DEC), (bf16_t*)WSP(WS_AA), (bf16_t*)WSP(WS_GG), INP(12) + (size_t)fresh_i(l) * RWD, INP(14) + (size_t)fresh_i(l) * RWD), WS_LIN, WS_LORA, 3072, LK, LK, LK, 0); });
        PHASE(4, { spre_phase(F, l); });
        PHASE(5, { sseq_phase(F, l); });
        PHASE(6, { GEMM_PAIR(MPR, EpiGatePair, ((const bf16_t*)WSP(WS_PROJ), PC_GP, PC_GR, (bf16_t*)WSP(WS_MRG)), WS_YA, WS_YB, WS_PPOOL, DM, PWD, PWD, PWD);
                   sample_tiles<0>(F, l); });
        PHASE(7, { GEMM_M(MPR, EpiResid, ((bf16_t*)WSP(xb_cur), SSP(1)), WS_MRG, WS_WOUT, DM, DM, DM, DM, 0); sample_tiles<1>(F, l); });
        PHASE(8, { GEMM(EpiSwiglu, ((bf16_t*)WSP(WS_HID), SSP(1)), xb_cur, WS_WGU, 2 * FF, DM, DM, DM, 0);
                   GEMM_SUB((((MT / 256) * (2 * FF / 256)) % fresh_i(F.G)) & ~7, MPR, EpiBf16, ((bf16_t*)WSP(WS_PP), DM), WS_PB, WS_WPP, DM, PLE, PLE, PLE, 0); sample_tiles<4>(F, l); });
        PHASE(9, { GEMM_M(MPR, EpiResid, ((bf16_t*)WSP(xb_cur), SSP(2)), WS_HID, WS_WDN, DM, FF, FF, FF, 0); sample_tiles<2>(F, l); });
        PHASE(10, { GEMM_M(MPR, EpiPle, ((const bf16_t*)WSP(xb_cur), (bf16_t*)WSP(xb_nxt), (const bf16_t*)WSP(WS_PP), SSP(2), SSP(0)), xb_cur, WS_WPG, DM, DM, DM, DM, 0); sample_tiles<3>(F, l); });
#undef SSP
    }
    if (IN(NL * PH_PER_LAYER)) final_norm(F, INP(32));
#undef IN
#undef REP
#undef PHASE
#undef WSP
#undef GEMM
#undef GEMM_M
#undef GEMM_SUB
#undef UNPAREN
}

extern "C" void kernel_launch(void* const* d_in, const int* in_sizes, int n_in, void* d_out, int out_size, void* d_ws, size_t ws_size, hipStream_t stream) {
    static int grid = 0;
    if (grid == 0) {
        if (n_in != 33 || in_sizes[0] != MPR * DM || out_size != (int)O_END || ws_size < WS_END) {
            fprintf(stderr, "kernel_launch: unexpected shapes: n_in %d in0 %d out %d ws %zu (need %zu); nothing launched\n", n_in, n_in > 0 ? in_sizes[0] : -1, out_size, ws_size, (size_t)WS_END); grid = -1; return; }
        int dev = 0, cus = 0, per_cu = 0;
        if (hipGetDevice(&dev) != hipSuccess || hipDeviceGetAttribute(&cus, hipDeviceAttributeMultiprocessorCount, dev) != hipSuccess) { grid = -1; return; }
        if (hipFuncSetAttribute((const void*)mega_fwd, hipFuncAttributeMaxDynamicSharedMemorySize, LDS_BYTES) != hipSuccess) { fprintf(stderr, "kernel_launch: hipFuncSetAttribute failed\n"); grid = -1; return; }
        if (hipOccupancyMaxActiveBlocksPerMultiprocessor(&per_cu, (const void*)mega_fwd, NTHR, LDS_BYTES) != hipSuccess || per_cu < 1) { fprintf(stderr, "kernel_launch: occupancy query says %d\n", per_cu); (void)hipGetLastError(); grid = -1; return; }
        grid = cus;
    }
    if (grid < 0) return;
    (void)hipMemsetAsync((char*)d_ws + WS_CTL, 0, CTL_ZERO_BYTES, stream);
    Args a; memset(&a, 0, sizeof(a));
    for (int i = 0; i < 33; ++i) a.in[i] = (const float*)d_in[i];
    a.out = (float*)d_out; a.ws = (unsigned char*)d_ws;
#if MK_PER_PHASE
    for (int p = 0; p < N_PHASES; ++p) { a.ph_lo = p; a.ph_hi = p + 1; hipLaunchKernelGGL(mega_fwd, dim3(grid), dim3(NTHR), LDS_BYTES, stream, a); }
#else
    a.ph_lo = 0; a.ph_hi = N_PHASES; hipLaunchKernelGGL(mega_fwd, dim3(grid), dim3(NTHR), LDS_BYTES, stream, a);
#endif
}
```

```cpp
#include <hip/hip_runtime.h>
#include <cstdio>
#include <cstdint>
#include <cstring>

#ifndef MK_PER_PHASE
#define MK_PER_PHASE 0
#endif

#define LAS __attribute__((address_space(3)))
typedef unsigned short bf16_t;
typedef short bf16x8 __attribute__((ext_vector_type(8)));
typedef float f32x4 __attribute__((ext_vector_type(4)));
typedef float f32x2 __attribute__((ext_vector_type(2)));
typedef unsigned u32x4 __attribute__((ext_vector_type(4)));
typedef unsigned u32x2 __attribute__((ext_vector_type(2)));

constexpr int DM = 2048, NL = 4, MT = 16896, MPR = 16384, TP = 2048, TS = 64;
constexpr int PWD = 1024, RWD = 1024, RPJ = 3360, ICOLS = 8480, ICP = 8704, FF = 5632, PLE = 256, LK = 384;
constexpr int PC_GP = 4608, PC_GR = 6656;
constexpr float NORM_EPS = 1e-6f, GN_EPS = 64e-5f;
constexpr size_t O_YS = 33554432, O_SHP = 34603008, O_POP = 34710528, O_WKP = 35202048, O_SHS = 37299200, O_POS = 37406720, O_WKS = 37898240, O_END = 39995392;

__device__ __forceinline__ unsigned cvt_pk_bf16(float lo, float hi) { unsigned r; asm volatile("v_cvt_pk_bf16_f32 %0, %1, %2" : "=v"(r) : "v"(lo), "v"(hi)); return r; }
__device__ __forceinline__ float bf_lo(unsigned u) { return __uint_as_float(u << 16); }
__device__ __forceinline__ float bf_hi(unsigned u) { return __uint_as_float(u & 0xffff0000u); }
__device__ __forceinline__ void unpack8(const u32x4 w, float (&f)[8]) { f[0] = bf_lo(w.x); f[1] = bf_hi(w.x); f[2] = bf_lo(w.y); f[3] = bf_hi(w.y); f[4] = bf_lo(w.z); f[5] = bf_hi(w.z); f[6] = bf_lo(w.w); f[7] = bf_hi(w.w); }
__device__ __forceinline__ u32x4 pack8(const float (&f)[8]) { u32x4 w; w.x = cvt_pk_bf16(f[0], f[1]); w.y = cvt_pk_bf16(f[2], f[3]); w.z = cvt_pk_bf16(f[4], f[5]); w.w = cvt_pk_bf16(f[6], f[7]); return w; }
__device__ __forceinline__ float sigmoidf_(float x) { return __builtin_amdgcn_rcpf(1.0f + __expf(-x)); }
__device__ __forceinline__ f32x4 sigmoid4(f32x4 v) { f32x4 o; o.x = sigmoidf_(v.x); o.y = sigmoidf_(v.y); o.z = sigmoidf_(v.z); o.w = sigmoidf_(v.w); return o; }
__device__ __forceinline__ f32x4 rcp4(f32x4 v) { f32x4 o; o.x = __builtin_amdgcn_rcpf(v.x); o.y = __builtin_amdgcn_rcpf(v.y); o.z = __builtin_amdgcn_rcpf(v.z); o.w = __builtin_amdgcn_rcpf(v.w); return o; }
__device__ __forceinline__ f32x4 fmax4(f32x4 a, f32x4 b) { f32x4 o; o.x = fmaxf(a.x, b.x); o.y = fmaxf(a.y, b.y); o.z = fmaxf(a.z, b.z); o.w = fmaxf(a.w, b.w); return o; }
__device__ __forceinline__ float tanhf_(float x) { const float e = __expf(2.0f * x); return 1.0f - 2.0f * __builtin_amdgcn_rcpf(e + 1.0f); }
template <int CTRL> __device__ __forceinline__ float dpp_f(float x) { return __uint_as_float((unsigned)__builtin_amdgcn_update_dpp(0, (int)__float_as_uint(x), CTRL, 0xF, 0xF, true)); }
__device__ __forceinline__ float sum8(float x) { x += dpp_f<0xB1>(x); x += dpp_f<0x4E>(x); x += dpp_f<0x141>(x); return x; }
__device__ __forceinline__ float wave_sum(float x) {
    x += dpp_f<0xB1>(x); x += dpp_f<0x4E>(x); x += dpp_f<0x141>(x); x += dpp_f<0x140>(x);
    x += __uint_as_float((unsigned)__builtin_amdgcn_ds_swizzle((int)__float_as_uint(x), 0x401F));
    return __uint_as_float((unsigned)__builtin_amdgcn_readlane((int)__float_as_uint(x), 0)) + __uint_as_float((unsigned)__builtin_amdgcn_readlane((int)__float_as_uint(x), 32));
}

namespace pg8 {
typedef unsigned ss_t;
constexpr int BM = 256, BK = 64, HALF = 128, HTB = HALF * BK * 2  , STAGE_BYTES = 8 * HTB, NXCD = 8, WGM = 8;
__host__ __device__ __forceinline__ int lds_g2(int fr) { return (0x1230 >> (4 * (fr >> 2))) & 3; }
__host__ __device__ __forceinline__ int lds_byte(int r, int c) { const int fr = r & 15, h = (c >> 5) & 1, q = (c >> 3) & 3; return (r >> 3) * 1024 + (r & 7) * 128 + ((h ^ ((fr >> 1) & 1)) * 64) + ((q ^ lds_g2(fr)) * 16); }
__host__ __device__ __forceinline__ void stage_rc(int b, int& R, int& C) { const int blk = b / 1024, sl = (b % 1024) / 16, rr8 = sl >> 3, fr = (blk & 1) * 8 + rr8, h = ((sl >> 2) & 1) ^ ((fr >> 1) & 1), q = (sl & 3) ^ lds_g2(fr); R = blk * 8 + rr8; C = 8 * (4 * h + q); }
__host__ __device__ __forceinline__ int perm32(int rho) { const int n = rho >> 4, i = rho & 15; return 8 * (i >> 2) + 4 * n + (i & 3); }

struct Unit { int pm, pn; };
struct Gemm { const bf16_t* A; const bf16_t* Bt; int M, N, K, lda, ldb, a_pn_off; };

struct StaticOrder {
    int nM, nN, nwg, G, c;
    __host__ __device__ void init(int M, int N, int G_, int c_) { nM = M / BM; nN = N / BM; nwg = nM * nN; G = G_; c = c_; }
    __host__ __device__ bool next(int i, Unit& u) const {
        if (c < 0) return false;
        const long L = (long)i * G + c; if (L >= nwg) return false;
        int wgid = (int)L; { const int q = nwg / NXCD, r = nwg % NXCD, xcd = wgid % NXCD, off = wgid / NXCD; wgid = (xcd < r ? xcd * (q + 1) : r * (q + 1) + (xcd - r) * q) + off; }
        const int nig = WGM * nN, gid = wgid / nig, fm = gid * WGM, gsz = (nM - fm) < WGM ? (nM - fm) : WGM;
        u.pm = fm + ((wgid % nig) % gsz); u.pn = ((wgid % nig) / gsz + gid) % nN; return true;
    }
    __device__ __forceinline__ void a_ready(const Unit&) const {}
    __device__ __forceinline__ void done(const Unit&) const {}
};

struct PairOrder : StaticOrder {
    __host__ __device__ bool next(int i, Unit& u) const { if (!StaticOrder::next(i >> 1, u)) return false; u.pn += (i & 1) * 8; return true; }
};
template <class T, class = void> struct paired_t { static constexpr bool v = false; };
template <class T> struct paired_t<T, decltype((void)T::PAIRED)> { static constexpr bool v = true; };

__device__ __forceinline__ void acc_zero(f32x4 (&acc)[2][2][4][2]) {
#pragma unroll
    for (int a = 0; a < 2; ++a)
#pragma unroll
        for (int b = 0; b < 2; ++b)
#pragma unroll
            for (int m = 0; m < 4; ++m)
#pragma unroll
                for (int n = 0; n < 2; ++n) acc[a][b][m][n] = (f32x4){0.f, 0.f, 0.f, 0.f};
}
struct RepeatOrder : StaticOrder {
    __host__ __device__ bool next(int i, Unit& u) const { if (i >= 6) return false; return StaticOrder::next(i % 3, u) || StaticOrder::next(0, u); }
};
#define EPI_ZERO_INIT __device__ __forceinline__ void init(f32x4 (&acc)[2][2][4][2], const Unit&, int, int, int, int) const { acc_zero(acc); }
#define EPI_NO_PRE __device__ __forceinline__ void preload(ss_t (&pre)[2], const Unit&, int, int, int) const {}
#define EPI_SS_PRE(SSPTR) __device__ __forceinline__ void preload(ss_t (&pre)[2], const Unit& u, int wr, int fr, int fq) const { _Pragma("unroll") for (int j = 0; j < 2; ++j) { const int g = 2 * fq + j; \
        pre[j] = (SSPTR)[(size_t)(u.pm * BM + (g >> 2) * HALF + wr * 64 + (g & 3) * 16 + fr)]; } }
__device__ __forceinline__ ss_t pre_get(const ss_t (&pre)[2], int g, int fr) { return (ss_t)__builtin_amdgcn_ds_bpermute((((g >> 1) << 4) + fr) << 2, (int)pre[g & 1]); }
template <class Epi, class Sched, bool ALIGN_EPI>
__device__ __forceinline__ void gemm_phase(LAS unsigned char* lds, const Gemm g, const Sched& S, const Epi& E) {
    int tid_ = threadIdx.x; asm volatile("" : "+v"(tid_));
    const int tid = tid_, wid = __builtin_amdgcn_readfirstlane(tid >> 6), lane = tid & 63, wr = wid >> 2, wc = wid & 3, fr = lane & 15, fq = lane >> 4;
    int K_ = g.K; asm volatile("" : "+s"(K_));
    const int K = K_, nt = K / BK;
    unsigned voffA[2], voffB[2];
#pragma unroll
    for (int i = 0; i < 2; ++i) { int R, C; stage_rc(tid * 16 + i * 8192, R, C); const int Rb = Epi::PERM ? (64 * (R >> 5) + perm32(R & 31)) : R;
        voffA[i] = (unsigned)(R * g.lda + C) * 2u; voffB[i] = (unsigned)(Rb * g.ldb + C) * 2u; }
    const size_t kstep = (size_t)(BK * 2);
    const size_t hstepA = (size_t)HALF * g.lda * 2, hstepB = (size_t)(Epi::PERM ? 32 : HALF) * g.ldb * 2;
    const unsigned ldsw = (unsigned)wid * 1024u;
    int aoff = lds_byte(wr * 64 + fr, fq * 8), boff = lds_byte(wc * 32 + fr, fq * 8);
#define PG8_SA(b, h) (((b) * 2 + (h)) * HTB)
#define PG8_APN(u) (paired_t<Epi>::v ? ((u).pn >> 3) : (u).pn)
#define PG8_SB(b, h) ((4 + (b) * 2 + (h)) * HTB)
#define PG8_STAGE(bufoff, gbase, voff) do { _Pragma("unroll") for (int _i = 0; _i < 2; ++_i) \
        __builtin_amdgcn_global_load_lds((const unsigned*)((const char*)(gbase) + (voff)[_i]), (LAS unsigned*)(lds + (bufoff) + ldsw + _i * 8192), 16, 0, 0); } while (0)
#define PG8_TOG(x) asm volatile("v_xor_b32 %0, 64, %0" : "+v"(x))
#define PG8_LDA(dst, b, h) do { _Pragma("unroll") for (int m = 0; m < 4; ++m) dst[m][0] = *(const LAS bf16x8*)(lds + PG8_SA(b, h) + aoff + m * 2048); PG8_TOG(aoff); \
        _Pragma("unroll") for (int m = 0; m < 4; ++m) dst[m][1] = *(const LAS bf16x8*)(lds + PG8_SA(b, h) + aoff + m * 2048); PG8_TOG(aoff); } while (0)
#define PG8_LDB(dst, b, h) do { _Pragma("unroll") for (int n = 0; n < 2; ++n) dst[n][0] = *(const LAS bf16x8*)(lds + PG8_SB(b, h) + boff + n * 2048); PG8_TOG(boff); \
        _Pragma("unroll") for (int n = 0; n < 2; ++n) dst[n][1] = *(const LAS bf16x8*)(lds + PG8_SB(b, h) + boff + n * 2048); PG8_TOG(boff); } while (0)
#define PG8_MMA(ai, bj, At, Bt) do { __builtin_amdgcn_s_setprio(1); _Pragma("unroll") for (int m = 0; m < 4; ++m) _Pragma("unroll") for (int n = 0; n < 2; ++n) _Pragma("unroll") for (int k = 0; k < 2; ++k) \
        acc[ai][bj][m][n] = __builtin_amdgcn_mfma_f32_16x16x32_bf16(Bt[n][k], At[m][k], acc[ai][bj][m][n], 0, 0, 0); __builtin_amdgcn_s_setprio(0); } while (0)
#define PG8_WAIT_V(n) asm volatile("s_waitcnt vmcnt(" #n ")" ::: "memory")
#define PG8_WAIT_L(n) asm volatile("s_waitcnt lgkmcnt(" #n ")" ::: "memory")
#define PG8_BAR __builtin_amdgcn_s_barrier()
#define PG8_SCHED __builtin_amdgcn_sched_barrier(0)
    Unit cur, nxt; int ui = 0;
    if (!S.next(0, cur)) return;
    f32x4 acc[2][2][4][2]; ss_t pre[2];
    E.init(acc, cur, wr, wc, fr, fq); E.preload(pre, cur, wr, fr, fq);
    bf16x8 At[4][2], B0[2][2], B1[2][2];
    const char* cA = (const char*)g.A + ((size_t)cur.pm * BM * g.lda + (size_t)PG8_APN(cur) * g.a_pn_off) * 2; const char* cB = (const char*)g.Bt + (size_t)cur.pn * BM * g.ldb * 2;
    S.a_ready(cur);
    PG8_STAGE(PG8_SB(0, 0), cB, voffB); PG8_STAGE(PG8_SB(0, 1), cB + hstepB, voffB); PG8_STAGE(PG8_SA(0, 0), cA, voffA); PG8_STAGE(PG8_SA(0, 1), cA + hstepA, voffA);
    if (wr == 1) PG8_BAR;
    PG8_WAIT_V(2); PG8_BAR;
    PG8_STAGE(PG8_SB(1, 0), cB + kstep, voffB); PG8_STAGE(PG8_SA(1, 0), cA + kstep, voffA); PG8_STAGE(PG8_SB(1, 1), cB + hstepB + kstep, voffB);
    PG8_WAIT_V(6); PG8_BAR;
    for (;;) {
        const bool has_next = S.next(ui + 1, nxt);
        const char* nA = has_next ? (const char*)g.A + ((size_t)nxt.pm * BM * g.lda + (size_t)PG8_APN(nxt) * g.a_pn_off) * 2 : cA; const char* nB = has_next ? (const char*)g.Bt + (size_t)nxt.pn * BM * g.ldb * 2 : cB;
#pragma unroll 1
        for (int t = 0; t < nt; t += 2) {
            const bool last = (t == nt - 2);
            const char* a1 = cA + (size_t)(t + 1) * kstep;
            const char* a2 = last ? nA : cA + (size_t)(t + 2) * kstep; const char* b2 = last ? nB : cB + (size_t)(t + 2) * kstep;
            const char* a3 = a2 + kstep; const char* b3 = b2 + kstep;
            if (last && has_next) S.a_ready(nxt);
            PG8_LDB(B0, 0, 0); PG8_LDB(B1, 0, 1); PG8_SCHED; PG8_LDA(At, 0, 0); PG8_STAGE(PG8_SA(1, 1), a1 + hstepA, voffA);
            PG8_WAIT_V(8); PG8_WAIT_L(0); PG8_BAR; PG8_MMA(0, 0, At, B0); PG8_MMA(0, 1, At, B1); PG8_BAR; PG8_SCHED;
            PG8_LDA(At, 0, 1); PG8_STAGE(PG8_SB(0, 0), b2, voffB); PG8_STAGE(PG8_SB(0, 1), b2 + hstepB, voffB); PG8_STAGE(PG8_SA(0, 0), a2, voffA);
            PG8_WAIT_V(8); PG8_WAIT_L(0); PG8_BAR; PG8_MMA(1, 0, At, B0); PG8_MMA(1, 1, At, B1); PG8_BAR; PG8_SCHED;
            PG8_LDB(B0, 1, 0); PG8_LDB(B1, 1, 1); PG8_SCHED; PG8_LDA(At, 1, 0); PG8_STAGE(PG8_SA(0, 1), a2 + hstepA, voffA);
            PG8_WAIT_V(8); PG8_WAIT_L(0); PG8_BAR; PG8_MMA(0, 0, At, B0); PG8_MMA(0, 1, At, B1); PG8_BAR; PG8_SCHED;
            PG8_LDA(At, 1, 1); PG8_STAGE(PG8_SB(1, 0), b3, voffB); PG8_STAGE(PG8_SB(1, 1), b3 + hstepB, voffB); PG8_STAGE(PG8_SA(1, 0), a3, voffA);
            PG8_WAIT_V(8); PG8_WAIT_L(0); PG8_BAR; PG8_MMA(1, 0, At, B0); PG8_MMA(1, 1, At, B1); PG8_BAR; PG8_SCHED;
        }
        if constexpr (ALIGN_EPI) { if (wr == 0) PG8_BAR; }
        E(acc, pre, cur, wr, wc, fr, fq); S.done(cur);
        if (!has_next) break;
        E.init(acc, nxt, wr, wc, fr, fq); E.preload(pre, nxt, wr, fr, fq);
        cur = nxt; cA = nA; cB = nB; ++ui;
        if constexpr (ALIGN_EPI) { if (wr == 1) PG8_BAR; }
    }
    PG8_WAIT_V(0);
    if constexpr (!ALIGN_EPI) { if (wr == 0) PG8_BAR; }
    PG8_BAR;
#undef PG8_SA
#undef PG8_APN
#undef PG8_SB
#undef PG8_STAGE
#undef PG8_LDA
#undef PG8_TOG
#undef PG8_LDB
#undef PG8_MMA
#undef PG8_WAIT_V
#undef PG8_WAIT_L
#undef PG8_BAR
#undef PG8_SCHED
}

#define EPI_ROW0 (u.pm * BM + wr * 64 + fr)
#define EPI_FOR_AI_M _Pragma("unroll") for (int ai = 0; ai < 2; ++ai) _Pragma("unroll") for (int m = 0; m < 4; ++m)
__device__ __forceinline__ u32x4 pack_f4x2(f32x4 v0, f32x4 v1) { u32x4 w; w.x = cvt_pk_bf16(v0[0], v0[1]); w.y = cvt_pk_bf16(v0[2], v0[3]); w.z = cvt_pk_bf16(v1[0], v1[1]); w.w = cvt_pk_bf16(v1[2], v1[3]); return w; }
__device__ __forceinline__ void unpack_f4x2(u32x4 w, f32x4& v0, f32x4& v1) { v0[0] = bf_lo(w.x); v0[1] = bf_hi(w.x); v0[2] = bf_lo(w.y); v0[3] = bf_hi(w.y); v1[0] = bf_lo(w.z); v1[1] = bf_hi(w.z); v1[2] = bf_lo(w.w); v1[3] = bf_hi(w.w); }
__device__ __forceinline__ unsigned ror8(unsigned x) { return (unsigned)__builtin_amdgcn_update_dpp(0, (int)x, 0x128, 0xF, 0xF, true); }
__device__ __forceinline__ void st_pair(char* grp, size_t pitch, int fr, int fq, u32x4 vA, u32x4 vB) {
    const bool lo = fr < 8;
    u32x4 snd = lo ? vB : vA, rcv; rcv.x = ror8(snd.x); rcv.y = ror8(snd.y); rcv.z = ror8(snd.z); rcv.w = ror8(snd.w);
    char* p = grp + (size_t)(fr & 7) * pitch + (lo ? 0 : 64) + fq * 16;
    *(u32x4*)p = lo ? vA : rcv;
    *(u32x4*)(p + 8 * pitch) = lo ? rcv : vB;
}
__device__ __forceinline__ u32x4 as_u4(f32x4 v) { return __builtin_bit_cast(u32x4, v); }

__device__ __forceinline__ float rstd_raw(ss_t v) { return __builtin_amdgcn_rsqf((float)v * (1.0f / (256.0f * DM)) + NORM_EPS); }
__device__ __forceinline__ float rstd_of(const ss_t* SS, size_t row) { return rstd_raw(SS[row]); }
__device__ __forceinline__ ss_t ss_fix(float s) { return (ss_t)(s * 256.0f + 0.5f); }
__device__ __forceinline__ float sq8(f32x4 a, f32x4 b) { return (a.x * a.x + a.y * a.y) + (a.z * a.z + a.w * a.w) + (b.x * b.x + b.y * b.y) + (b.z * b.z + b.w * b.w); }
__device__ __forceinline__ void ss_add(ss_t* SS, size_t row, float s, int fq, int fr) { s += __uint_as_float((unsigned)__builtin_amdgcn_ds_swizzle((int)__float_as_uint(s), 0x401F));
    s += __uint_as_float((unsigned)__builtin_amdgcn_ds_bpermute((((fq ^ 2) << 4) + fr) << 2, (int)__float_as_uint(s)));
    if (fq == 0) __hip_atomic_fetch_add(SS + row, ss_fix(s), __ATOMIC_RELAXED, __HIP_MEMORY_SCOPE_AGENT); }
struct EpiNull { static constexpr bool PERM = true; EPI_NO_PRE EPI_ZERO_INIT __device__ __forceinline__ void operator()(const f32x4 (&acc)[2][2][4][2], const ss_t (&pre)[2], const Unit& u, int wr, int wc, int fr, int fq) const {
#pragma unroll
    for (int a = 0; a < 2; ++a)
#pragma unroll
        for (int b = 0; b < 2; ++b)
#pragma unroll
            for (int m = 0; m < 4; ++m)
#pragma unroll
                for (int n = 0; n < 2; ++n) asm volatile("" :: "v"(acc[a][b][m][n]));
} };
struct EpiProj { static constexpr bool PERM = true; EPI_ZERO_INIT
    bf16_t* O; const ss_t* SS; EPI_SS_PRE(SS)
    __device__ __forceinline__ void operator()(const f32x4 (&acc)[2][2][4][2], const ss_t (&pre)[2], const Unit& u, int wr, int wc, int fr, int fq) const {
        const bool sg = u.pn >= 18;
        EPI_FOR_AI_M { const size_t r0 = (size_t)(u.pm * BM + ai * HALF + wr * 64 + m * 16); char* grp = (char*)(O + r0 * ICP + u.pn * BM + 64 * wc); const float rs = rstd_raw(pre_get(pre, ai * 4 + m, fr));
            f32x4 a0 = acc[ai][0][m][0] * rs, a1 = acc[ai][0][m][1] * rs, b0 = acc[ai][1][m][0] * rs, b1 = acc[ai][1][m][1] * rs;
            if (sg) { a0 = sigmoid4(a0); a1 = sigmoid4(a1); b0 = sigmoid4(b0); b1 = sigmoid4(b1); }
            st_pair(grp, (size_t)ICP * 2, fr, fq, pack_f4x2(a0, a1), pack_f4x2(b0, b1)); }
    }
};
struct EpiBf16 { static constexpr bool PERM = true; EPI_NO_PRE EPI_ZERO_INIT
    bf16_t* O; int ldc;
    __device__ __forceinline__ void operator()(const f32x4 (&acc)[2][2][4][2], const ss_t (&pre)[2], const Unit& u, int wr, int wc, int fr, int fq) const {
        EPI_FOR_AI_M { char* grp = (char*)(O + (size_t)(u.pm * BM + ai * HALF + wr * 64 + m * 16) * ldc + u.pn * BM + 64 * wc);
            st_pair(grp, (size_t)ldc * 2, fr, fq, pack_f4x2(acc[ai][0][m][0], acc[ai][0][m][1]), pack_f4x2(acc[ai][1][m][0], acc[ai][1][m][1])); }
    }
};
struct EpiLora { static constexpr bool PERM = true; EPI_NO_PRE EPI_ZERO_INIT
    float* DEC; bf16_t* AA; bf16_t* GG; const float* w0; const float* a0;
    __device__ __forceinline__ void operator()(const f32x4 (&acc)[2][2][4][2], const ss_t (&pre)[2], const Unit& u, int wr, int wc, int fr, int fq) const {
        const int row0 = EPI_ROW0, kind = u.pn >> 2, ct = (u.pn & 3) * BM + 64 * wc, col0 = ct + 8 * fq;
        if (kind == 0) {
            EPI_FOR_AI_M { float* rowp = DEC + (size_t)(row0 + ai * HALF + m * 16) * RWD + col0;
#pragma unroll
                for (int bj = 0; bj < 2; ++bj)
#pragma unroll
                    for (int n = 0; n < 2; ++n) { const f32x4 b = *(const f32x4*)(w0 + col0 + bj * 32 + 4 * n); const f32x4 x = acc[ai][bj][m][n] + b; f32x4 o;
#pragma unroll
                        for (int j = 0; j < 4; ++j) { const float z = -x[j]; const float sp = z > 15.f ? z : __logf(1.0f + __expf(z)); const float w = -sp - 0.5f; o[j] = __expf(-__expf(w)); }
                        *(f32x4*)(rowp + bj * 32 + 4 * n) = o; } asm volatile("" ::: "memory"); }
        } else if (kind == 1) {
            const f32x4 b00 = *(const f32x4*)(a0 + col0), b01 = *(const f32x4*)(a0 + col0 + 4), b10 = *(const f32x4*)(a0 + col0 + 32), b11 = *(const f32x4*)(a0 + col0 + 36);
            EPI_FOR_AI_M { char* grp = (char*)(AA + (size_t)(u.pm * BM + ai * HALF + wr * 64 + m * 16) * RWD + ct);
                st_pair(grp, (size_t)RWD * 2, fr, fq, pack_f4x2(sigmoid4(acc[ai][0][m][0] + b00), sigmoid4(acc[ai][0][m][1] + b01)), pack_f4x2(sigmoid4(acc[ai][1][m][0] + b10), sigmoid4(acc[ai][1][m][1] + b11))); }
        } else {
            EPI_FOR_AI_M { char* grp = (char*)(GG + (size_t)(u.pm * BM + ai * HALF + wr * 64 + m * 16) * RWD + ct);
                st_pair(grp, (size_t)RWD * 2, fr, fq, pack_f4x2(acc[ai][0][m][0], acc[ai][0][m][1]), pack_f4x2(acc[ai][1][m][0], acc[ai][1][m][1])); }
        }
    }
};
struct EpiGate1 { static constexpr bool PERM = true; EPI_NO_PRE EPI_ZERO_INIT
    bf16_t* TMP; const bf16_t* PROJ; int gcol0;
    __device__ __forceinline__ void operator()(const f32x4 (&acc)[2][2][4][2], const ss_t (&pre)[2], const Unit& u, int wr, int wc, int fr, int fq) const {
        const int row0 = EPI_ROW0, ct = u.pn * BM + 64 * wc, col0 = ct + 8 * fq;
        EPI_FOR_AI_M { const size_t row = (size_t)(row0 + ai * HALF + m * 16);
            f32x4 g00, g01, g10, g11; unpack_f4x2(*(const u32x4*)(PROJ + row * ICP + gcol0 + col0), g00, g01); unpack_f4x2(*(const u32x4*)(PROJ + row * ICP + gcol0 + col0 + 32), g10, g11);
            st_pair((char*)(TMP + (size_t)(u.pm * BM + ai * HALF + wr * 64 + m * 16) * DM + ct), (size_t)DM * 2, fr, fq, pack_f4x2(acc[ai][0][m][0] * g00, acc[ai][0][m][1] * g01), pack_f4x2(acc[ai][1][m][0] * g10, acc[ai][1][m][1] * g11));
            if (m & 1) asm volatile("" ::: "memory"); }
    }
};
struct EpiGate2 { static constexpr bool PERM = true; EPI_NO_PRE EPI_ZERO_INIT
    const bf16_t* TMP; const bf16_t* PROJ; int gcol0; bf16_t* O;
    __device__ __forceinline__ void operator()(const f32x4 (&acc)[2][2][4][2], const ss_t (&pre)[2], const Unit& u, int wr, int wc, int fr, int fq) const {
        const int row0 = EPI_ROW0, ct = u.pn * BM + 64 * wc, col0 = ct + 8 * fq;
        EPI_FOR_AI_M { const size_t row = (size_t)(row0 + ai * HALF + m * 16);
            f32x4 g00, g01, g10, g11, t00, t01, t10, t11; unpack_f4x2(*(const u32x4*)(PROJ + row * ICP + gcol0 + col0), g00, g01); unpack_f4x2(*(const u32x4*)(PROJ + row * ICP + gcol0 + col0 + 32), g10, g11);
            unpack_f4x2(*(const u32x4*)(TMP + row * DM + col0), t00, t01); unpack_f4x2(*(const u32x4*)(TMP + row * DM + col0 + 32), t10, t11);
            st_pair((char*)(O + (size_t)(u.pm * BM + ai * HALF + wr * 64 + m * 16) * DM + ct), (size_t)DM * 2, fr, fq, pack_f4x2(t00 + acc[ai][0][m][0] * g00, t01 + acc[ai][0][m][1] * g01), pack_f4x2(t10 + acc[ai][1][m][0] * g10, t11 + acc[ai][1][m][1] * g11));
            if (m & 1) asm volatile("" ::: "memory"); }
    }
};
struct EpiGatePair { static constexpr bool PERM = true; static constexpr bool PAIRED = true; EPI_NO_PRE
    const bf16_t* PROJ; int gc1, gc2; bf16_t* O;
    __device__ __forceinline__ void init(f32x4 (&acc)[2][2][4][2], const Unit& u, int, int, int, int) const { if (u.pn < 8) acc_zero(acc); }
    __device__ __forceinline__ void operator()(f32x4 (&acc)[2][2][4][2], const ss_t (&pre)[2], const Unit& u, int wr, int wc, int fr, int fq) const {
        const int row0 = EPI_ROW0, ct = (u.pn & 7) * BM + 64 * wc, col0 = ct + 8 * fq;
        const f32x4 flo = (f32x4){0x1p-60f, 0x1p-60f, 0x1p-60f, 0x1p-60f};
        if (u.pn < 8) {
#pragma unroll
            for (int ai = 0; ai < 2; ++ai) { u32x4 q[4][4];
#pragma unroll
                for (int m = 0; m < 4; ++m) { const bf16_t* p = PROJ + (size_t)(row0 + ai * HALF + m * 16) * ICP + col0; q[m][0] = *(const u32x4*)(p + gc1); q[m][1] = *(const u32x4*)(p + gc1 + 32); q[m][2] = *(const u32x4*)(p + gc2); q[m][3] = *(const u32x4*)(p + gc2 + 32); }
                __builtin_amdgcn_sched_barrier(0);
#pragma unroll
                for (int m = 0; m < 4; ++m) { f32x4 g00, g01, g10, g11, h00, h01, h10, h11; unpack_f4x2(q[m][0], g00, g01); unpack_f4x2(q[m][1], g10, g11); unpack_f4x2(q[m][2], h00, h01); unpack_f4x2(q[m][3], h10, h11);
                    acc[ai][0][m][0] *= g00 * rcp4(fmax4(h00, flo)); acc[ai][0][m][1] *= g01 * rcp4(fmax4(h01, flo)); acc[ai][1][m][0] *= g10 * rcp4(fmax4(h10, flo)); acc[ai][1][m][1] *= g11 * rcp4(fmax4(h11, flo)); }
                __builtin_amdgcn_sched_barrier(0); }
        } else {
            u32x4 q[2][4][2];
#pragma unroll
            for (int ai = 0; ai < 2; ++ai)
#pragma unroll
                for (int m = 0; m < 4; ++m) { const bf16_t* p = PROJ + (size_t)(row0 + ai * HALF + m * 16) * ICP + gc2 + col0; q[ai][m][0] = *(const u32x4*)p; q[ai][m][1] = *(const u32x4*)(p + 32); }
            __builtin_amdgcn_sched_barrier(0);
            EPI_FOR_AI_M { f32x4 h00, h01, h10, h11; unpack_f4x2(q[ai][m][0], h00, h01); unpack_f4x2(q[ai][m][1], h10, h11);
                st_pair((char*)(O + (size_t)(u.pm * BM + ai * HALF + wr * 64 + m * 16) * DM + ct), (size_t)DM * 2, fr, fq, pack_f4x2(acc[ai][0][m][0] * fmax4(h00, flo), acc[ai][0][m][1] * fmax4(h01, flo)),
                        pack_f4x2(acc[ai][1][m][0] * fmax4(h10, flo), acc[ai][1][m][1] * fmax4(h11, flo)));
                if (m & 1) __builtin_amdgcn_sched_barrier(0); }
        }
    }
};
struct EpiResid { static constexpr bool PERM = true; EPI_NO_PRE
    bf16_t* XB; ss_t* SS;
    __device__ __forceinline__ void init(f32x4 (&acc)[2][2][4][2], const Unit& u, int wr, int wc, int fr, int fq) const {
        const int row0 = EPI_ROW0, col0 = u.pn * BM + 64 * wc + 8 * fq;
        EPI_FOR_AI_M { const bf16_t* rowp = XB + (size_t)(row0 + ai * HALF + m * 16) * DM + col0;
            unpack_f4x2(*(const u32x4*)rowp, acc[ai][0][m][0], acc[ai][0][m][1]); unpack_f4x2(*(const u32x4*)(rowp + 32), acc[ai][1][m][0], acc[ai][1][m][1]); }
    }
    __device__ __forceinline__ void operator()(const f32x4 (&acc)[2][2][4][2], const ss_t (&pre)[2], const Unit& u, int wr, int wc, int fr, int fq) const {
        EPI_FOR_AI_M { const size_t r0 = (size_t)(u.pm * BM + ai * HALF + wr * 64 + m * 16);
            st_pair((char*)(XB + r0 * DM + u.pn * BM + 64 * wc), (size_t)DM * 2, fr, fq, pack_f4x2(acc[ai][0][m][0], acc[ai][0][m][1]), pack_f4x2(acc[ai][1][m][0], acc[ai][1][m][1]));
            ss_add(SS, r0 + fr, sq8(acc[ai][0][m][0], acc[ai][0][m][1]) + sq8(acc[ai][1][m][0], acc[ai][1][m][1]), fq, fr); }
    }
};
struct EpiSwiglu { static constexpr bool PERM = true; EPI_ZERO_INIT
    bf16_t* H; const ss_t* SS; EPI_SS_PRE(SS)
    __device__ __forceinline__ void operator()(const f32x4 (&acc)[2][2][4][2], const ss_t (&pre)[2], const Unit& u, int wr, int wc, int fr, int fq) const {
        const int row0 = EPI_ROW0, col0 = u.pn * HALF + wc * 32 + 8 * fq;
        EPI_FOR_AI_M { const size_t row = (size_t)(row0 + ai * HALF + m * 16); const float rs = rstd_raw(pre_get(pre, ai * 4 + m, fr));
            const f32x4 g0 = acc[ai][0][m][0] * rs, g1 = acc[ai][0][m][1] * rs, u0 = acc[ai][1][m][0] * rs, u1 = acc[ai][1][m][1] * rs;
            *(u32x4*)(H + row * FF + col0) = pack_f4x2(g0 * sigmoid4(g0) * u0, g1 * sigmoid4(g1) * u1); }
    }
};
struct EpiPle { static constexpr bool PERM = true; EPI_ZERO_INIT EPI_SS_PRE(SSi)
    const bf16_t* XB; bf16_t* XO; const bf16_t* PP; const ss_t* SSi; ss_t* SSo;
    __device__ __forceinline__ void operator()(const f32x4 (&acc)[2][2][4][2], const ss_t (&pre)[2], const Unit& u, int wr, int wc, int fr, int fq) const {
        const int col0 = u.pn * BM + 64 * wc + 8 * fq;
        EPI_FOR_AI_M { const size_t r0 = (size_t)(u.pm * BM + ai * HALF + wr * 64 + m * 16), row = r0 + fr; const float rs = rstd_raw(pre_get(pre, ai * 4 + m, fr));
            f32x4 x00, x01, x10, x11, p00, p01, p10, p11; unpack_f4x2(*(const u32x4*)(XB + row * DM + col0), x00, x01); unpack_f4x2(*(const u32x4*)(XB + row * DM + col0 + 32), x10, x11);
            unpack_f4x2(*(const u32x4*)(PP + row * DM + col0), p00, p01); unpack_f4x2(*(const u32x4*)(PP + row * DM + col0 + 32), p10, p11);
            x00 += sigmoid4(acc[ai][0][m][0] * rs) * p00; x01 += sigmoid4(acc[ai][0][m][1] * rs) * p01; x10 += sigmoid4(acc[ai][1][m][0] * rs) * p10; x11 += sigmoid4(acc[ai][1][m][1] * rs) * p11;
            st_pair((char*)(XO + r0 * DM + u.pn * BM + 64 * wc), (size_t)DM * 2, fr, fq, pack_f4x2(x00, x01), pack_f4x2(x10, x11));
            ss_add(SSo, row, sq8(x00, x01) + sq8(x10, x11), fq, fr);
            if (m & 1) asm volatile("" ::: "memory"); }
    }
};
#undef EPI_ROW0
#undef EPI_FOR_AI_M
}

constexpr size_t MiB = 1u << 20;
constexpr size_t al1m(size_t x) { return (x + MiB - 1) / MiB * MiB; }
constexpr size_t WS_CTL = 0, CTL_ZERO_BYTES = 1 * MiB;
constexpr size_t SZ_WIN = (size_t)ICP * DM * 2, SZ_POOLW = (size_t)PWD * 256 * 2, SZ_LORA = (size_t)3072 * LK * 2, SZ_PPOOL = (size_t)DM * PWD * 2, SZ_PRWKV = (size_t)DM * RWD * 2,
                 SZ_WOUT = (size_t)DM * DM * 2, SZ_WGU = (size_t)2 * FF * DM * 2, SZ_WDN = (size_t)DM * FF * 2, SZ_WPG = (size_t)DM * DM * 2, SZ_WPP = (size_t)DM * PLE * 2;
constexpr size_t WS_WIN = 1 * MiB, WS_POOLW = WS_WIN + SZ_WIN, WS_LORA = WS_POOLW + SZ_POOLW, WS_PPOOL = WS_LORA + SZ_LORA, WS_PRWKV = WS_PPOOL + SZ_PPOOL, WS_WOUT = WS_PRWKV + SZ_PRWKV,
                 WS_WGU = WS_WOUT + SZ_WOUT, WS_WDN = WS_WGU + SZ_WGU, WS_WPG = WS_WDN + SZ_WDN, WS_WPP = WS_WPG + SZ_WPG, WS_WEND = WS_WPP + SZ_WPP;
constexpr size_t WS_PB = al1m(WS_WEND);
constexpr size_t WS_XN = al1m(WS_PB + (size_t)MT * PLE * 2);
constexpr size_t WS_AA = al1m(WS_XN + (size_t)MT * DM * 2);
constexpr size_t WS_GG = al1m(WS_AA + (size_t)MT * RWD * 2);
constexpr size_t WS_PP = al1m(WS_GG + (size_t)MT * RWD * 2);
constexpr size_t WS_PROJ = al1m(WS_PP + (size_t)MT * DM * 2);
constexpr size_t WS_HID = WS_PROJ;
constexpr size_t WS_D = al1m(WS_PROJ + (size_t)MT * ICP * 2);
constexpr size_t WS_LIN = al1m(WS_D + (size_t)MT * PWD * 2);
constexpr size_t WS_YA = al1m(WS_LIN + (size_t)MT * LK * 2);
constexpr size_t WS_DEC = al1m(WS_YA + (size_t)MT * PWD * 2);
constexpr size_t WS_BS = al1m(WS_DEC + (size_t)MT * RWD * 4);
constexpr size_t WS_Y = al1m(WS_BS + (size_t)MT * 16 * 4);
constexpr size_t SZ_BH = (size_t)MT * RWD * 2;
constexpr size_t WS_YB = al1m(WS_Y + (size_t)MT * RWD * 4);
constexpr size_t WS_TMP = al1m(WS_YB + SZ_BH);
constexpr size_t WS_MRG = al1m(WS_TMP + (size_t)MT * DM * 4);
constexpr size_t WS_SS = al1m(WS_MRG + (size_t)MT * DM * 2);
constexpr size_t WS_END_OLD = al1m(WS_MRG + (size_t)MT * DM * 2);
static_assert((size_t)MT * FF * 2 <= (size_t)MT * ICP * 2, "HID overlay");

constexpr size_t WS_XB2 = al1m(WS_SS + (size_t)3 * MT * 4);
constexpr size_t CBSZ = 12096, CB_BS = 12032, CB_P1T = 0, CB_RT = 2048, CB_BK = 4096, CB_VT = 8192, CB_P2T = 10240, CB_MBT = 10752, CB_MKT = 11264, CB_GC = 11776;
constexpr size_t CB_N = (size_t)(MT / 16) * 16;
static_assert(WS_MRG + (size_t)MT * DM * 2 - WS_TMP >= CB_N * CBSZ, "chunk blocks fit in TMP | MRG");
static_assert(WS_PRWKV == WS_PPOOL + (size_t)8 * 256 * PWD * 2 && PWD == RWD && (WS_YB - WS_YA) / 2 < (size_t)0x7fffffff, "the paired gate GEMM walks proj_pool | proj_rwkv as one [4096][1024] matrix");
constexpr size_t WS_END = al1m(WS_XB2 + (size_t)MT * DM * 2);
constexpr int CW_BAR = 4096;
constexpr int NWAVES = 8, NTHR = 512;
constexpr int RING_BYTES = 131072, LDSCTL_OFF = RING_BYTES, LDS_BYTES = 147456;

#define XB_TMO      128
#define XB_XCNT(j)  (256  + 64 * (j))
#define XB_XSUB(j)  (1280 + 64 * (j))
#define XB_XGEN(j)  (2304 + 64 * (j))
#define XB_TOP      3328
#define XB_TOPGEN   3392
#define XCD_BAR_WORDS 3456
#define XB_SPIN_CAP (1u << 18)

__device__ __forceinline__ unsigned xb_ld(unsigned* p)              { return __hip_atomic_load(p, __ATOMIC_RELAXED, __HIP_MEMORY_SCOPE_AGENT); }
__device__ __forceinline__ unsigned xb_add(unsigned* p, unsigned v) { return __hip_atomic_fetch_add(p, v, __ATOMIC_RELAXED, __HIP_MEMORY_SCOPE_AGENT); }
__device__ __forceinline__ unsigned xb_xcc_id() { return (unsigned)__builtin_amdgcn_s_getreg((3 << 11) | 20) & 0xFu; }
#define XB_SPIN(cond, bar) do { unsigned _sp = 0; while (cond) { __builtin_amdgcn_s_sleep(1); \
    if ((++_sp & 255u) == 0u) { if (xb_ld(&(bar)[XB_TMO])) break; if (_sp > XB_SPIN_CAP) { atomicAdd(&(bar)[XB_TMO], 1u); break; } } } } while (0)

struct XcdBarrier {
    unsigned* bar; unsigned x;
    volatile LAS unsigned* st;
};

__device__ __forceinline__ XcdBarrier xcd_barrier_post(unsigned* bar, volatile LAS unsigned* st) {
    XcdBarrier b; b.bar = bar; b.x = xb_xcc_id(); b.st = st;
    if (threadIdx.x == 0) (void)xb_add(&bar[XB_XCNT(b.x)], 1u);
    return b;
}
__device__ __forceinline__ void xcd_barrier_complete(unsigned* bar, unsigned x, unsigned& nloc, unsigned& nx) {
    const unsigned G = gridDim.x * gridDim.y * gridDim.z;
    unsigned sum, cnt, mine, sp = 0u;
    for (;;) {
        sum = 0u; cnt = 0u; mine = 0u;
#pragma unroll
        for (unsigned j = 0; j < 16; ++j) { const unsigned c = xb_ld(&bar[XB_XCNT(j)]); sum += c; cnt += (c > 0u) ? 1u : 0u; mine = (j == x) ? c : mine; }
        if (sum == G) break;
        __builtin_amdgcn_s_sleep(1);
        if ((++sp & 255u) == 0u) { if (xb_ld(&bar[XB_TMO])) break; if (sp > XB_SPIN_CAP) { atomicAdd(&bar[XB_TMO], 1u); break; } }
    }
    nloc = mine > 0u ? mine : 1u; nx = cnt > 0u ? cnt : 1u;
}

__device__ __forceinline__ void xcd_barrier(const XcdBarrier& b) {
    asm volatile("s_waitcnt vmcnt(0)" ::: "memory");
    __syncthreads();
    if (threadIdx.x == 0) {
        unsigned* bar = b.bar;
        __builtin_amdgcn_s_waitcnt(0);
        unsigned nloc = b.st[0], nx = b.st[1];
        if (nloc == 0u) { xcd_barrier_complete(bar, b.x, nloc, nx); b.st[0] = nloc; b.st[1] = nx; }
        const unsigned old = xb_add(&bar[XB_XSUB(b.x)], 1u);
        const unsigned gen = old / nloc;
        if (old + 1u == (gen + 1u) * nloc) {
            __builtin_amdgcn_fence(__ATOMIC_RELEASE, "agent");
            asm volatile("s_waitcnt vmcnt(0)" ::: "memory");
            const unsigned og = xb_add(&bar[XB_TOP], 1u);
            const unsigned tg = og / nx;
            if (og + 1u == (tg + 1u) * nx) xb_add(&bar[XB_TOPGEN], 1u);
            else XB_SPIN(xb_ld(&bar[XB_TOPGEN]) == tg, bar);
            __builtin_amdgcn_fence(__ATOMIC_ACQUIRE, "agent");
            xb_add(&bar[XB_XGEN(b.x)], 1u);
            asm volatile("s_waitcnt vmcnt(0)" ::: "memory");
        } else {
            XB_SPIN(xb_ld(&bar[XB_XGEN(b.x)]) == gen, bar);
            __builtin_amdgcn_fence(__ATOMIC_ACQUIRE, "agent");
            asm volatile("s_waitcnt vmcnt(0)" ::: "memory");
        }
    }
    __syncthreads();
}


struct Args {
    const float* in[33]; float* out; unsigned char* ws; int ph_lo, ph_hi;
};
struct Frame {
    LAS unsigned char* lds; int G;
    const LAS unsigned long long* ptab; float* out; unsigned char* ws;
};
#define GAS __attribute__((address_space(1)))
__device__ __forceinline__ const float* ldptr(const LAS unsigned long long* tab, int k) { const unsigned long long v = tab[k]; const unsigned lo = __builtin_amdgcn_readfirstlane((unsigned)v), hi = __builtin_amdgcn_readfirstlane((unsigned)(v >> 32));
    return (const float*)(const GAS float*)(((unsigned long long)hi << 32) | lo); }
__device__ __forceinline__ unsigned char* fresh(unsigned char* p) { GAS unsigned char* q = (GAS unsigned char*)p; asm volatile("" : "+s"(q)); return (unsigned char*)q; }
__device__ __forceinline__ int fresh_i(int v) { asm volatile("" : "+s"(v)); return v; }
#define INP(k) ldptr(F.ptab, (k))
#define PHASE_L const int l = fresh_i(l_in); (void)l;
#define PHASE_IDS int tid_ = threadIdx.x; asm volatile("" : "+v"(tid_)); const int tid = tid_, lane = tid & 63, wave = __builtin_amdgcn_readfirstlane(tid >> 6), gtid = blockIdx.x * NTHR + tid, gw = blockIdx.x * NWAVES + wave; (void)lane; (void)wave; (void)gtid; (void)gw;
#define VM_WAIT() asm volatile("s_waitcnt vmcnt(0)" ::: "memory")
#define LDS_WAIT() asm volatile("s_waitcnt lgkmcnt(0)" ::: "memory")
constexpr int NT_ALL_SHIFT = 9;

__device__ __forceinline__ void row_info(int m, int& b, int& t, bool& samp) { samp = m >= MPR; if (samp) { b = (m - MPR) >> 6; t = (m - MPR) & 63; } else { b = m >> 11; t = m & 2047; } }

__device__ __forceinline__ void transpose_item(const float* W, int N, bf16_t* WT, int ldk, int k0, int n0, int drow0, LAS float* scr, int lane, const float* cscale = nullptr, const float* rscale = nullptr) {
    f32x4 cs = (f32x4){1.f, 1.f, 1.f, 1.f}; if (cscale) cs = *(const f32x4*)(cscale + n0 + 4 * (lane & 7));
    const int c = lane & 7;
    f32x4 g0 = (f32x4){1.f, 1.f, 1.f, 1.f}, g1 = g0;
    if (rscale) { g0 = *(const f32x4*)(rscale + k0 + 8 * c); g1 = *(const f32x4*)(rscale + k0 + 8 * c + 4); }
    f32x4 v[8];
#pragma unroll
    for (int i = 0; i < 8; ++i) v[i] = *(const f32x4*)(W + (size_t)(k0 + 8 * i + (lane >> 3)) * N + n0 + 4 * (lane & 7));
#pragma unroll
    for (int i = 0; i < 8; ++i) { LAS float* d = scr + (8 * i + (lane >> 3)) * 33 + 4 * (lane & 7); const f32x4 t = v[i] * cs; d[0] = t.x; d[1] = t.y; d[2] = t.z; d[3] = t.w; }
    LDS_WAIT(); asm volatile("" ::: "memory");
#pragma unroll
    for (int j = 0; j < 4; ++j) { const int n = (lane >> 3) + 8 * j; const LAS float* sp = scr + (8 * c) * 33 + n;
        u32x4 o; o.x = cvt_pk_bf16(sp[0 * 33] * g0.x, sp[1 * 33] * g0.y); o.y = cvt_pk_bf16(sp[2 * 33] * g0.z, sp[3 * 33] * g0.w); o.z = cvt_pk_bf16(sp[4 * 33] * g1.x, sp[5 * 33] * g1.y); o.w = cvt_pk_bf16(sp[6 * 33] * g1.z, sp[7 * 33] * g1.w);
        *(u32x4*)(WT + (size_t)(drow0 + n) * ldk + k0 + 8 * c) = o; }
    LDS_WAIT(); asm volatile("" ::: "memory");
}
__device__ __forceinline__ void convert_weights(Frame& F, int l_in) {
    PHASE_IDS
    unsigned char* const wsl = fresh(F.ws);
    PHASE_L
    LAS float* scr = (LAS float*)(F.lds + wave * 16384);
    const int NGW = fresh_i(F.G) * NWAVES;
    unsigned char* ws = wsl;
    constexpr int I_WIN = (DM / 64) * (ICOLS / 32), I_PW = 4 * (256 / 64) * (256 / 32), I_PP = (PWD / 64) * (DM / 32), I_WO = (DM / 64) * (DM / 32), I_FG = (DM / 64) * (FF / 32),
                  I_FD = (FF / 64) * (DM / 32), I_PL = (PLE / 64) * (DM / 32);
    constexpr int NITEMS = I_WIN + I_PW + 2 * I_PP + I_WO + 2 * I_FG + I_FD + I_WO + I_PL;
    for (int it = gw; it < NITEMS; it += NGW) {
        int r = it;
        if (r < I_WIN) { const int nblk = ICOLS / 32, kb = r / nblk, nb = r % nblk, n0 = nb * 32; transpose_item(INP(8) + (size_t)l * DM * ICOLS, ICOLS, (bf16_t*)(ws + WS_WIN), DM, kb * 64, n0, n0 < 4384 ? n0 : n0 + 224, scr, lane, nullptr, INP(7) + (size_t)l * DM); continue; } r -= I_WIN;
        if (r < I_PW) { const int g = r >> 5, rr = r & 31, kb = rr >> 3, nb = rr & 7; transpose_item(INP(10) + ((size_t)l * 4 + g) * 65536, 256, (bf16_t*)(ws + WS_POOLW) + (size_t)g * 65536, 256, kb * 64, nb * 32, nb * 32, scr, lane, INP(11) + (size_t)l * PWD + g * 256); continue; } r -= I_PW;
        if (r < I_PP) { const int nblk = DM / 32, kb = r / nblk, nb = r % nblk; transpose_item(INP(22) + (size_t)l * PWD * DM, DM, (bf16_t*)(ws + WS_PPOOL), PWD, kb * 64, nb * 32, nb * 32, scr, lane); continue; } r -= I_PP;
        if (r < I_PP) { const int nblk = DM / 32, kb = r / nblk, nb = r % nblk; transpose_item(INP(23) + (size_t)l * RWD * DM, DM, (bf16_t*)(ws + WS_PRWKV), RWD, kb * 64, nb * 32, nb * 32, scr, lane); continue; } r -= I_PP;
        if (r < I_WO) { const int nblk = DM / 32, kb = r / nblk, nb = r % nblk; transpose_item(INP(24) + (size_t)l * DM * DM, DM, (bf16_t*)(ws + WS_WOUT), DM, kb * 64, nb * 32, nb * 32, scr, lane); continue; } r -= I_WO;
        if (r < I_FG) { const int nblk = FF / 32, kb = r / nblk, nb = r % nblk, n0 = nb * 32; transpose_item(INP(26) + (size_t)l * DM * FF, FF, (bf16_t*)(ws + WS_WGU), DM, kb * 64, n0, 256 * (n0 >> 7) + 64 * ((n0 & 127) >> 5), scr, lane, nullptr, INP(25) + (size_t)l * DM); continue; } r -= I_FG;
        if (r < I_FG) { const int nblk = FF / 32, kb = r / nblk, nb = r % nblk, n0 = nb * 32; transpose_item(INP(27) + (size_t)l * DM * FF, FF, (bf16_t*)(ws + WS_WGU), DM, kb * 64, n0, 256 * (n0 >> 7) + 64 * ((n0 & 127) >> 5) + 32, scr, lane, nullptr, INP(25) + (size_t)l * DM); continue; } r -= I_FG;
        if (r < I_FD) { const int nblk = DM / 32, kb = r / nblk, nb = r % nblk; transpose_item(INP(28) + (size_t)l * FF * DM, DM, (bf16_t*)(ws + WS_WDN), FF, kb * 64, nb * 32, nb * 32, scr, lane); continue; } r -= I_FD;
        if (r < I_WO) { const int nblk = DM / 32, kb = r / nblk, nb = r % nblk; transpose_item(INP(30) + (size_t)l * DM * DM, DM, (bf16_t*)(ws + WS_WPG), DM, kb * 64, nb * 32, nb * 32, scr, lane, nullptr, INP(29) + (size_t)l * DM); continue; } r -= I_WO;
        { const int nblk = DM / 32, kb = r / nblk, nb = r % nblk; transpose_item(INP(31) + (size_t)l * PLE * DM, DM, (bf16_t*)(ws + WS_WPP), PLE, kb * 64, nb * 32, nb * 32, scr, lane); }
    }
    const int NT = fresh_i(F.G) * NTHR;
    { u32x4* z = (u32x4*)((bf16_t*)(ws + WS_WIN) + (size_t)4384 * DM); for (int i = gtid; i < 224 * DM * 2 / 16; i += NT) z[i] = (u32x4){0u, 0u, 0u, 0u}; }
    { bf16_t* LT = (bf16_t*)(ws + WS_LORA); const float* wd = INP(13) + (size_t)l * 64 * RWD; const float* wa = INP(15) + (size_t)l * 64 * RWD; const float* wg = INP(16) + (size_t)l * 160 * RWD;
      for (int i = gtid; i < 3072 * (LK / 8); i += NT) { const int n = i / (LK / 8), k0 = (i % (LK / 8)) * 8; const int kind = n >> 10, c = n & 1023; float f[8];
#pragma unroll
          for (int j = 0; j < 8; ++j) { const int k = k0 + j; float v = 0.f;
              if (kind == 0) { if (k < 64) v = wd[(size_t)k * RWD + c]; }
              else if (kind == 1) { if (k >= 64 && k < 128) v = wa[(size_t)(k - 64) * RWD + c]; }
              else { if (k >= 128 && k < 288) v = wg[(size_t)(k - 128) * RWD + c]; }
              f[j] = v; }
          *(u32x4*)(LT + (size_t)n * LK + k0) = pack8(f); } }
    { bf16_t* PB = (bf16_t*)(ws + WS_PB); const float* pp = INP(5) + (size_t)l * MPR * PLE; const float* ps = INP(6) + (size_t)l * (MT - MPR) * PLE;
      for (int i = gtid; i < MT * PLE / 8; i += NT) { const size_t e = (size_t)i * 8; const float* src = e < (size_t)MPR * PLE ? pp + e : ps + (e - (size_t)MPR * PLE);
          const f32x4 a = *(const f32x4*)src, b = *(const f32x4*)(src + 4); *(u32x4*)(PB + e) = pg8::pack_f4x2(a, b); } }
}

__device__ __forceinline__ void xb_from_input(Frame& F) {
    PHASE_IDS
    unsigned char* const wsl = fresh(F.ws);
    const int NGW = fresh_i(F.G) * NWAVES; bf16_t* XB = (bf16_t*)(wsl + WS_XN); pg8::ss_t* SS = (pg8::ss_t*)(wsl + WS_SS);
    for (int m = gw; m < MT; m += NGW) {
        const float* src = m < MPR ? INP(0) + (size_t)m * DM : INP(1) + (size_t)(m - MPR) * DM;
        f32x4 v[8]; float s = 0.f;
#pragma unroll
        for (int j = 0; j < 8; ++j) { v[j] = *(const f32x4*)(src + 4 * lane + 256 * j); s += (v[j].x * v[j].x + v[j].y * v[j].y) + (v[j].z * v[j].z + v[j].w * v[j].w); }
        s = wave_sum(s);
        if (lane == 0) SS[m] = pg8::ss_fix(s);
#pragma unroll
        for (int j = 0; j < 8; ++j) { u32x2 w; w.x = cvt_pk_bf16(v[j].x, v[j].y); w.y = cvt_pk_bf16(v[j].z, v[j].w); *(u32x2*)(XB + (size_t)m * DM + 4 * lane + 256 * j) = w; }
    }
}
__device__ __forceinline__ void final_norm(Frame& F, const float* gain) {
    PHASE_IDS
    unsigned char* const wsl = fresh(F.ws);
    const int NGW = fresh_i(F.G) * NWAVES; const bf16_t* XB = (const bf16_t*)(wsl + ((NL & 1) ? WS_XB2 : WS_XN));
    f32x4 g[8];
#pragma unroll
    for (int j = 0; j < 8; ++j) g[j] = *(const f32x4*)(gain + 4 * lane + 256 * j);
    for (int m = gw; m < MT; m += NGW) {
        f32x4 v[8]; float s = 0.f;
#pragma unroll
        for (int j = 0; j < 8; ++j) { const u32x2 w = *(const u32x2*)(XB + (size_t)m * DM + 4 * lane + 256 * j); v[j] = (f32x4){bf_lo(w.x), bf_hi(w.x), bf_lo(w.y), bf_hi(w.y)};
            s += (v[j].x * v[j].x + v[j].y * v[j].y) + (v[j].z * v[j].z + v[j].w * v[j].w); }
        const float rstd = __builtin_amdgcn_rsqf(wave_sum(s) * (1.0f / DM) + NORM_EPS);
#pragma unroll
        for (int j = 0; j < 8; ++j) *(f32x4*)(F.out + (size_t)m * DM + 4 * lane + 256 * j) = v[j] * rstd * g[j];
    }
}

__device__ __forceinline__ void load_z(float (&z)[8], const bf16_t* PROJ, const float* past, int m0, int t, bool samp, int c0) {
    if (t >= 0) { unpack8(*(const u32x4*)(PROJ + (size_t)(m0 + t) * ICP + c0), z); }
    else if (samp) { const float* p = past + (size_t)(15 + t) * PWD + c0; const f32x4 a = *(const f32x4*)p, b = *(const f32x4*)(p + 4); z[0] = a.x; z[1] = a.y; z[2] = a.z; z[3] = a.w; z[4] = b.x; z[5] = b.y; z[6] = b.z; z[7] = b.w; }
    else {
#pragma unroll
        for (int j = 0; j < 8; ++j) z[j] = 0.f; }
}
__device__ __forceinline__ void prep1_phase(Frame& F, int l_in) {
    PHASE_IDS
    unsigned char* const wsl = fresh(F.ws);
    PHASE_L
    const int NT = fresh_i(F.G) * NTHR; const bf16_t* PROJ = (const bf16_t*)(wsl + WS_PROJ);
    { bf16_t* D = (bf16_t*)(wsl + WS_D);
      for (int it = gtid; it < (MT / 16) * 128; it += NT) {
          const int oct = it & 127, run = it >> 7, mrow = run * 16, c0 = oct * 8, win = 2 << (c0 >> 8);
          int b, t0; bool samp; row_info(mrow, b, t0, samp);
          const int T = samp ? TS : TP, mseq = mrow - t0;
          const float* past = INP(3) + ((size_t)l * 8 + b) * 15 * PWD;
          float* npool = F.out + (samp ? O_POS : O_POP) + ((size_t)l * 8 + b) * 15 * PWD;
          float S[8], z[8];
#pragma unroll
          for (int j = 0; j < 8; ++j) S[j] = 0.f;
          for (int j = 1; j < win; ++j) { load_z(z, PROJ, past, mseq, t0 - j, samp, c0);
#pragma unroll
              for (int q = 0; q < 8; ++q) S[q] += z[q]; }
          for (int i = 0; i < 16; ++i) { const int t = t0 + i; float cur[8]; load_z(cur, PROJ, past, mseq, t, samp, c0);
              const int cnt = samp ? win : (t + 1 < win ? t + 1 : win); const float inv = 1.0f / (float)cnt; float d[8];
#pragma unroll
              for (int q = 0; q < 8; ++q) { S[q] += cur[q]; d[q] = S[q] * inv - cur[q]; }
              *(u32x4*)(D + (size_t)(mseq + t) * PWD + c0) = pack8(d);
              if (t >= T - 15) { float* o = npool + (size_t)(t - (T - 15)) * PWD + c0; *(f32x4*)o = (f32x4){cur[0], cur[1], cur[2], cur[3]}; *(f32x4*)(o + 4) = (f32x4){cur[4], cur[5], cur[6], cur[7]}; }
              load_z(z, PROJ, past, mseq, t - win + 1, samp, c0);
#pragma unroll
              for (int q = 0; q < 8; ++q) S[q] -= z[q]; }
      } }
    { bf16_t* LIN = (bf16_t*)(wsl + WS_LIN); const float* mu = INP(9) + (size_t)l * RPJ + 3072;
      for (int it = gtid; it < MT * (LK / 8); it += NT) {
          const int m = it / (LK / 8), c0 = (it % (LK / 8)) * 8; float o[8];
          if (c0 >= 288) {
#pragma unroll
              for (int j = 0; j < 8; ++j) o[j] = 0.f;
          } else {
              int b, t; bool samp; row_info(m, b, t, samp);
              float cur[8], prv[8]; unpack8(*(const u32x4*)(PROJ + (size_t)m * ICP + 4096 + c0), cur);
              if (t > 0) unpack8(*(const u32x4*)(PROJ + (size_t)(m - 1) * ICP + 4096 + c0), prv);
              else if (samp) { const float* p = INP(2) + ((size_t)l * 8 + b) * RPJ + 3072 + c0;
#pragma unroll
                  for (int j = 0; j < 8; ++j) prv[j] = p[j]; }
              else {
#pragma unroll
                  for (int j = 0; j < 8; ++j) prv[j] = 0.f; }
#pragma unroll
              for (int j = 0; j < 8; ++j) { const float xm = cur[j] + (prv[j] - cur[j]) * mu[c0 + j]; o[j] = c0 < 64 ? tanhf_(xm) : (c0 < 128 ? xm : sigmoidf_(xm)); }
          }
          *(u32x4*)(LIN + (size_t)m * LK + c0) = pack8(o);
      } }
    { pg8::ss_t* SS = (pg8::ss_t*)(wsl + WS_SS); for (int i = gtid; i < 3 * MT; i += NT) SS[i] = 0u; }
    for (int it = gtid; it < 16 * RPJ; it += NT) { const int s = it / RPJ, c = it % RPJ; const int mlast = s < 8 ? s * TP + TP - 1 : MPR + (s - 8) * TS + TS - 1;
        F.out[(s < 8 ? O_SHP : O_SHS) + ((size_t)l * 8 + (s & 7)) * RPJ + c] = __uint_as_float((unsigned)PROJ[(size_t)mlast * ICP + 1024 + c] << 16); }
}

__device__ __forceinline__ unsigned char* cb_ptr(unsigned char* ws, size_t i) { return ws + WS_TMP + i * CBSZ; }
__device__ __forceinline__ float sum16(float x) { x += dpp_f<0xB1>(x); x += dpp_f<0x4E>(x); x += dpp_f<0x141>(x); x += dpp_f<0x140>(x); return x; }
__device__ __forceinline__ f32x4 mfma16(bf16x8 a, bf16x8 b, f32x4 c) { return __builtin_amdgcn_mfma_f32_16x16x32_bf16(a, b, c, 0, 0, 0); }
__device__ __forceinline__ bf16x8 mk8(u32x2 lo, u32x2 hi) { u32x4 w = (u32x4){lo.x, lo.y, hi.x, hi.y}; return __builtin_bit_cast(bf16x8, w); }
typedef __bf16 bf16x2_c __attribute__((ext_vector_type(2)));
__device__ __forceinline__ unsigned cvt_pk_c(float lo, float hi) { const f32x2 v = (f32x2){lo, hi}; const bf16x2_c b = __builtin_convertvector(v, bf16x2_c); return __builtin_bit_cast(unsigned, b); }
__device__ __forceinline__ u32x2 pk4(f32x4 v) { return (u32x2){cvt_pk_c(v.x, v.y), cvt_pk_c(v.z, v.w)}; }
__device__ __forceinline__ unsigned short bf1(float f) { return (unsigned short)(cvt_pk_c(f, 0.f) & 0xffffu); }

__device__ __forceinline__ void spre_phase(Frame& F, int l_in) {
    PHASE_IDS
    unsigned char* const wsl = fresh(F.ws);
    PHASE_L
    const int NGW = fresh_i(F.G) * NWAVES;
    LAS unsigned char* L = F.lds + wave * 16384;
    const bf16_t* PROJ = (const bf16_t*)(wsl + WS_PROJ); const bf16_t* AA = (const bf16_t*)(wsl + WS_AA); const float* DEC = (const float*)(wsl + WS_DEC);
    const int fr = lane & 15, fq = lane >> 4;
    const float* mu = INP(9) + (size_t)l * RPJ;
#define SP_LOAD(it_, R, K, V, A, W, PR, PK, PV) do { const int h_ = (it_) & 15, m0_ = ((it_) >> 4) * 16, ch_ = h_ * 64 + lane; int b_, t0_; bool samp_; row_info(m0_, b_, t0_, samp_); \
        _Pragma("unroll") for (int t = 0; t < 16; ++t) { const size_t mm = (size_t)(m0_ + t); const bf16_t* pc = PROJ + mm * ICP + 1024 + ch_; R[t] = pc[0]; K[t] = pc[1024]; V[t] = pc[2048]; A[t] = AA[mm * RWD + ch_]; W[t] = DEC[mm * RWD + ch_]; } \
        if (t0_ > 0) { const bf16_t* pc = PROJ + (size_t)(m0_ - 1) * ICP + 1024 + ch_; PR = __uint_as_float((unsigned)pc[0] << 16); PK = __uint_as_float((unsigned)pc[1024] << 16); PV = __uint_as_float((unsigned)pc[2048] << 16); } \
        else if (samp_) { const float* sp = INP(2) + ((size_t)l * 8 + b_) * RPJ + ch_; PR = sp[0]; PK = sp[1024]; PV = sp[2048]; } \
        else { PR = 0.f; PK = 0.f; PV = 0.f; } } while (0)
    unsigned short cr[16], ck[16], cv[16], ca[16], nr[16], nk[16], nv[16], na[16]; float cw[16], nw[16]; float pr = 0.f, pk = 0.f, pv = 0.f, npr = 0.f, npk = 0.f, npv = 0.f;
    if (gw < (int)CB_N) SP_LOAD(gw, cr, ck, cv, ca, cw, pr, pk, pv);
    for (int it = gw; it < (int)CB_N; it += NGW) {
        const int h = it & 15, crow = it >> 4, m0 = crow * 16, ch = h * 64 + lane;
        unsigned char* cb = cb_ptr(wsl, (size_t)it);
        const float mur = mu[ch], muk = mu[1024 + ch], muv = mu[2048 + ch];
        const float ckk = (INP(17) + (size_t)l * RWD)[ch], cka = (INP(18) + (size_t)l * RWD)[ch], crk = (INP(19) + (size_t)l * RWD)[ch];
        { const int itn = it + NGW; if (itn < (int)CB_N) SP_LOAD(itn, nr, nk, nv, na, nw, npr, npk, npv); }
        float g = 1.0f; unsigned at2[8], bt2[8], kt2[8], vt2[8]; float hold_a = 0.f, hold_b = 0.f, hold_k = 0.f, hold_v = 0.f;
#pragma unroll
        for (int t = 0; t < 16; ++t) {
            const float xr = __uint_as_float((unsigned)cr[t] << 16), xk = __uint_as_float((unsigned)ck[t] << 16), xv = __uint_as_float((unsigned)cv[t] << 16), av = __uint_as_float((unsigned)ca[t] << 16);
            const float r = xr + (pr - xr) * mur, kx = xk + (pk - xk) * muk, vv = xv + (pv - xv) * muv; pr = xr; pk = xk; pv = xv;
            float kkv = kx * ckk; const float ss = wave_sum(kkv * kkv); kkv *= __builtin_amdgcn_rsqf(fmaxf(ss, 1e-24f));
            const float kh = kx * (1.0f + (av - 1.0f) * cka), bb = kkv * av; const float bsum = wave_sum(r * kh * crk);
            if (lane == 0) *(float*)(cb + CB_BS + t * 4) = bsum;
            const float a_t = -kkv * g; g *= cw[t]; const float ig = __builtin_amdgcn_rcpf(g); const float b_t = bb * ig, k_t = kh * ig, r_t = r * g;
            *(LAS unsigned short*)(L + t * 144 + lane * 2) = bf1(a_t); *(LAS unsigned short*)(L + 2304 + t * 144 + lane * 2) = bf1(b_t);
            *(LAS unsigned short*)(L + 4608 + t * 144 + lane * 2) = bf1(k_t); *(LAS unsigned short*)(L + 6912 + t * 144 + lane * 2) = bf1(r_t);
            if (t & 1) { at2[t >> 1] = cvt_pk_c(hold_a, a_t); bt2[t >> 1] = cvt_pk_c(hold_b, b_t); kt2[t >> 1] = cvt_pk_c(hold_k, k_t); vt2[t >> 1] = cvt_pk_c(hold_v, vv); }
            else { hold_a = a_t; hold_b = b_t; hold_k = k_t; hold_v = vv; }
        }
        *(LAS u32x4*)(L + 9216 + lane * 32) = (u32x4){at2[0], at2[1], at2[2], at2[3]}; *(LAS u32x4*)(L + 9216 + lane * 32 + 16) = (u32x4){at2[4], at2[5], at2[6], at2[7]};
        { u32x4* o = (u32x4*)(cb + CB_BK + lane * 64);
#pragma unroll
          for (int q = 0; q < 4; ++q) o[q] = (u32x4){bt2[2 * q], bt2[2 * q + 1], kt2[2 * q], kt2[2 * q + 1]}; }
        { u32x4* o = (u32x4*)(cb + CB_VT + lane * 32); o[0] = (u32x4){vt2[0], vt2[1], vt2[2], vt2[3]}; o[1] = (u32x4){vt2[4], vt2[5], vt2[6], vt2[7]}; }
        *(float*)(cb + CB_GC + lane * 4) = g;
        asm volatile("" ::: "memory");
#define SP_ROWS(off, j) (*(const LAS bf16x8*)(L + (off) + fr * 144 + (j) * 64 + fq * 16))
        f32x4 nD = (f32x4){0.f, 0.f, 0.f, 0.f}, makD = nD, mrbD = nD, mrkD = nD;
#pragma unroll
        for (int j = 0; j < 2; ++j) { const bf16x8 fa = SP_ROWS(0, j), fb = SP_ROWS(2304, j), fk = SP_ROWS(4608, j), fR = SP_ROWS(6912, j);
            nD = mfma16(fb, fa, nD); makD = mfma16(fk, fa, makD); mrbD = mfma16(fb, fR, mrbD); mrkD = mfma16(fk, fR, mrkD); }
#pragma unroll
        for (int rr = 0; rr < 4; ++rr) { const int s = 4 * fq + rr; if (s >= fr) { nD[rr] = 0.f; makD[rr] = 0.f; } if (s > fr) { mrbD[rr] = 0.f; mrkD[rr] = 0.f; } }
        { const u32x2 mb = pk4(mrbD), mk = pk4(mrkD); *(u32x4*)(cb + CB_MBT + (fr * 4 + fq) * 16) = (u32x4){mb.x, mb.y, mk.x, mk.y}; }
#define SP_WR_RM(off, D) do { _Pragma("unroll") for (int rr = 0; rr < 4; ++rr) *(LAS unsigned short*)(L + (off) + (4 * fq + rr) * 32 + fr * 2) = bf1((D)[rr]); } while (0)
#define SP_WR_TR(off, D) do { *(LAS u32x2*)(L + (off) + fr * 32 + fq * 8) = pk4(D); } while (0)
#define SP_FRAG16(off) (fq < 2 ? *(const LAS bf16x8*)(L + (off) + fr * 32 + fq * 16) : (bf16x8){0, 0, 0, 0, 0, 0, 0, 0})
        SP_WR_RM(13568, nD); SP_WR_TR(14080, nD); SP_WR_RM(15616, makD); asm volatile("" ::: "memory");
        f32x4 TD = nD;
#pragma unroll
        for (int rr = 0; rr < 4; ++rr) if (4 * fq + rr == fr) TD[rr] += 1.0f;
#pragma unroll
        for (int itp = 0; itp < 3; ++itp) {
            SP_WR_RM(14592, TD); asm volatile("" ::: "memory");
            const f32x4 p2 = mfma16(SP_FRAG16(13568), SP_FRAG16(14080), (f32x4){0.f, 0.f, 0.f, 0.f}); asm volatile("" ::: "memory");
            SP_WR_RM(13568, p2); SP_WR_TR(14080, p2); asm volatile("" ::: "memory");
            TD = mfma16(SP_FRAG16(14592), SP_FRAG16(14080), TD); asm volatile("" ::: "memory");
        }
        SP_WR_TR(15104, TD); asm volatile("" ::: "memory");
        { const bf16x8 ftt = SP_FRAG16(15104);
#pragma unroll
          for (int blk = 0; blk < 4; ++blk) { const bf16x8 fb = fq < 2 ? *(const LAS bf16x8*)(L + 9216 + (16 * blk + fr) * 32 + fq * 16) : (bf16x8){0, 0, 0, 0, 0, 0, 0, 0};
              const f32x4 d = mfma16(ftt, fb, (f32x4){0.f, 0.f, 0.f, 0.f});
#pragma unroll
              for (int rr = 0; rr < 4; ++rr) *(LAS unsigned short*)(L + 11264 + (4 * fq + rr) * 144 + (16 * blk + fr) * 2) = bf1(d[rr]); }
          const f32x4 p2 = mfma16(SP_FRAG16(15616), ftt, (f32x4){0.f, 0.f, 0.f, 0.f});
          *(u32x2*)(cb + CB_P2T + fr * 32 + fq * 8) = pk4(p2); }
        asm volatile("" ::: "memory");
#pragma unroll
        for (int q = 0; q < 2; ++q) { const int pc = lane + 64 * q, pcc = pc >> 6, pt = (pc >> 2) & 15, pf = pc & 3;
            const u32x2 a0 = *(const LAS u32x2*)(L + 11264 + pt * 144 + (32 * pcc + 4 * pf) * 2), a1 = *(const LAS u32x2*)(L + 11264 + pt * 144 + (32 * pcc + 16 + 4 * pf) * 2);
            const u32x2 r0 = *(const LAS u32x2*)(L + 6912 + pt * 144 + (32 * pcc + 4 * pf) * 2), r1 = *(const LAS u32x2*)(L + 6912 + pt * 144 + (32 * pcc + 16 + 4 * pf) * 2);
            *(u32x4*)(cb + CB_P1T + pc * 16) = (u32x4){a0.x, a0.y, a1.x, a1.y}; *(u32x4*)(cb + CB_RT + pc * 16) = (u32x4){r0.x, r0.y, r1.x, r1.y}; }
        asm volatile("" ::: "memory");
#pragma unroll
        for (int t = 0; t < 16; ++t) { cr[t] = nr[t]; ck[t] = nk[t]; cv[t] = nv[t]; ca[t] = na[t]; cw[t] = nw[t]; }
        pr = npr; pk = npk; pv = npv;
#undef SP_ROWS
#undef SP_LOAD
#undef SP_WR_RM
#undef SP_WR_TR
#undef SP_FRAG16
    }
}

constexpr int SQ_D = 5, SQ_SLOT = 14336, SQ_NSLOT = 7, SQ_DUMP = SQ_NSLOT * SQ_SLOT, SQ_YBUF = SQ_DUMP + 2048;
__device__ __forceinline__ void sseq_phase(Frame& F, int l_in) {
    PHASE_IDS
    unsigned char* const wsl = fresh(F.ws);
    PHASE_L
    const bf16_t* GG = (const bf16_t*)(wsl + WS_GG); bf16_t* YB = (bf16_t*)(wsl + WS_YB);
    const bool is_cons = wave < 4;
    const int fr = lane & 15, fq = lane >> 4, vrow = (wave & 3) * 16 + fr, lw = wave & 3;
    for (int u = blockIdx.x; u < 256; u += fresh_i(F.G)) {
        const bool samp = u >= 128; const int h = u & 15, b = (u >> 4) & 7;
        const int T = samp ? TS : TP, m0 = samp ? MPR + b * TS : b * TP, nch = T / 16, crow0 = m0 / 16;
        f32x4 sreg[4];
        if (samp) { const float* sp = INP(4) + ((((size_t)l * 8 + b) * 16 + h) * 64 + vrow) * 64 + 4 * fq;
#pragma unroll
            for (int kb = 0; kb < 4; ++kb) sreg[kb] = *(const f32x4*)(sp + 16 * kb); }
        else {
#pragma unroll
            for (int kb = 0; kb < 4; ++kb) sreg[kb] = (f32x4){0.f, 0.f, 0.f, 0.f}; }
        const f32x4 gng = *(const f32x4*)(INP(20) + (size_t)l * RWD + h * 64 + 4 * fr), gnb = *(const f32x4*)(INP(21) + (size_t)l * RWD + h * 64 + 4 * fr);
#define SQ_ISSUE(c) do { const unsigned char* src = cb_ptr(wsl, (size_t)(crow0 + (c)) * 16 + h) + (lw * 3) * 1024 + lane * 16; LAS unsigned char* dst = F.lds + ((c) % SQ_NSLOT) * SQ_SLOT + (lw * 3) * 1024; \
        _Pragma("unroll") for (int i = 0; i < 3; ++i) __builtin_amdgcn_global_load_lds((const unsigned*)(src + i * 1024), (LAS unsigned*)(dst + i * 1024), 16, 0, 0); \
        if (lw < 2) __builtin_amdgcn_global_load_lds((const unsigned*)((const unsigned char*)(GG + (size_t)(m0 + (c) * 16 + 8 * lw + (lane >> 3)) * RWD + h * 64) + (lane & 7) * 16), (LAS unsigned*)(F.lds + ((c) % SQ_NSLOT) * SQ_SLOT + 12288 + lw * 1024), 16, 0, 0); \
        else __builtin_amdgcn_global_load_lds((const unsigned*)src, (LAS unsigned*)(F.lds + SQ_DUMP + (lw - 2) * 1024), 16, 0, 0); } while (0)
#define SQ_WAIT(k) do { switch (k) { case 0: asm volatile("s_waitcnt vmcnt(0)" ::: "memory"); break; case 1: asm volatile("s_waitcnt vmcnt(4)" ::: "memory"); break; case 2: asm volatile("s_waitcnt vmcnt(8)" ::: "memory"); break; \
        case 3: asm volatile("s_waitcnt vmcnt(12)" ::: "memory"); break; default: asm volatile("s_waitcnt vmcnt(16)" ::: "memory"); break; } } while (0)
#define SQ_POST(c) do { const LAS unsigned char* Bp = F.lds + ((c) % SQ_NSLOT) * SQ_SLOT; const int tt = 4 * lw + fq; \
        const f32x4 y4 = *(const LAS f32x4*)(F.lds + SQ_YBUF + ((c) & 1) * 4096 + (tt * 64 + 4 * fr) * 4); \
        const float mean = sum16((y4.x + y4.y) + (y4.z + y4.w)) * (1.0f / 64.0f); const f32x4 dv = y4 - mean; \
        const float rstd = __builtin_amdgcn_rsqf(sum16((dv.x * dv.x + dv.y * dv.y) + (dv.z * dv.z + dv.w * dv.w)) * (1.0f / 64.0f) + GN_EPS); \
        const float bs = *(const LAS float*)(Bp + CB_BS + tt * 4); const u32x2 gq = *(const LAS u32x2*)(Bp + 12288 + tt * 128 + fr * 8); \
        f32x4 vv; _Pragma("unroll") for (int j = 0; j < 4; ++j) vv[j] = __uint_as_float((unsigned)(*(const LAS unsigned short*)(Bp + CB_VT + (4 * fr + j) * 32 + tt * 2)) << 16); \
        const f32x4 o = (dv * rstd * gng + gnb + bs * vv) * (f32x4){bf_lo(gq.x), bf_hi(gq.x), bf_lo(gq.y), bf_hi(gq.y)}; \
        *(u32x2*)(YB + (size_t)(m0 + (c) * 16 + tt) * RWD + h * 64 + 4 * fr) = (u32x2){cvt_pk_bf16(o.x, o.y), cvt_pk_bf16(o.z, o.w)}; } while (0)
        __syncthreads();
        if (!is_cons) { const int np = nch < SQ_D ? nch : SQ_D; for (int c = 0; c < np; ++c) SQ_ISSUE(c); SQ_WAIT(np - 1); }
        __syncthreads();
        for (int c = 0; c < nch; ++c) {
            if (is_cons) {
                const LAS unsigned char* B = F.lds + (c % SQ_NSLOT) * SQ_SLOT;
#define SQ_KA(off, cc) (*(const LAS bf16x8*)(B + (off) + (((cc) * 16 + fr) * 4 + fq) * 16))
                const u32x2 vt = *(const LAS u32x2*)(B + CB_VT + vrow * 32 + fq * 8), z2 = (u32x2){0u, 0u};
                const bf16x8 aP2 = mk8(*(const LAS u32x2*)(B + CB_P2T + fr * 32 + fq * 8), z2), aP10 = SQ_KA(CB_P1T, 0), aP11 = SQ_KA(CB_P1T, 1), aR0 = SQ_KA(CB_RT, 0), aR1 = SQ_KA(CB_RT, 1);
                const bf16x8 aM = *(const LAS bf16x8*)(B + CB_MBT + (fr * 4 + fq) * 16);
                bf16x8 aBK[4]; f32x4 gc[4];
#pragma unroll
                for (int kb = 0; kb < 4; ++kb) { aBK[kb] = *(const LAS bf16x8*)(B + CB_BK + ((16 * kb + fr) * 4 + fq) * 16); gc[kb] = *(const LAS f32x4*)(B + CB_GC + (16 * kb + 4 * fq) * 4); }
                __builtin_amdgcn_sched_barrier(0);
                const bf16x8 sB0 = mk8(pk4(sreg[0]), pk4(sreg[1])), sB1 = mk8(pk4(sreg[2]), pk4(sreg[3]));
                f32x4 uD = mfma16(aP2, mk8(vt, z2), (f32x4){0.f, 0.f, 0.f, 0.f});
                uD = mfma16(aP10, sB0, uD); uD = mfma16(aP11, sB1, uD);
                const bf16x8 uvB = mk8(pk4(uD), vt);
                f32x4 nS[4];
#pragma unroll
                for (int kb = 0; kb < 4; ++kb) nS[kb] = mfma16(aBK[kb], uvB, sreg[kb]);
                f32x4 yD = mfma16(aM, uvB, (f32x4){0.f, 0.f, 0.f, 0.f});
                yD = mfma16(aR0, sB0, yD); yD = mfma16(aR1, sB1, yD);
#pragma unroll
                for (int kb = 0; kb < 4; ++kb) sreg[kb] = nS[kb] * gc[kb];
                { LAS float* yo = (LAS float*)(F.lds + SQ_YBUF + (c & 1) * 4096) + (4 * fq) * 64 + vrow; yo[0] = yD[0]; yo[64] = yD[1]; yo[128] = yD[2]; yo[192] = yD[3]; }
#undef SQ_KA
            } else {
                if (c + SQ_D < nch) SQ_ISSUE(c + SQ_D);
                if (c + 1 < nch) { const int last = c + SQ_D < nch ? c + SQ_D : nch - 1; SQ_WAIT(last - (c + 1)); }
                if (c > 0) SQ_POST(c - 1);
            }
            asm volatile("s_waitcnt lgkmcnt(0)" ::: "memory"); __builtin_amdgcn_s_barrier(); asm volatile("" ::: "memory");
        }
        if (!is_cons) SQ_POST(nch - 1);
#undef SQ_ISSUE
#undef SQ_WAIT
#undef SQ_POST
        if (is_cons) { float* so = F.out + (samp ? O_WKS : O_WKP) + ((((size_t)l * 8 + b) * 16 + h) * 64 + vrow) * 64 + 4 * fq;
#pragma unroll
            for (int kb = 0; kb < 4; ++kb) *(f32x4*)(so + 16 * kb) = sreg[kb]; }
    }
    VM_WAIT(); __syncthreads();
}

__device__ __forceinline__ void tile64_mma(const bf16_t* A, int lda, const bf16_t* Bt, int ldb, int K, int m0, int n0, int wave, int lane, f32x4 (&acc)[4][4]) {
    const int kq = K >> 3, kb = wave * kq, lr = lane & 15, lk = (lane >> 4) * 8;
    const bf16_t* ap = A + (size_t)(m0 + lr) * lda + kb + lk; const bf16_t* bp = Bt + (size_t)(n0 + lr) * ldb + kb + lk;
#pragma unroll 2
    for (int k = 0; k < kq; k += 32) {
        bf16x8 af[4], bf[4];
#pragma unroll
        for (int i = 0; i < 4; ++i) { af[i] = *(const bf16x8*)(ap + (size_t)(16 * i) * lda + k); bf[i] = *(const bf16x8*)(bp + (size_t)(16 * i) * ldb + k); }
#pragma unroll
        for (int mi = 0; mi < 4; ++mi)
#pragma unroll
            for (int ni = 0; ni < 4; ++ni) acc[mi][ni] = __builtin_amdgcn_mfma_f32_16x16x32_bf16(bf[ni], af[mi], acc[mi][ni], 0, 0, 0);
    }
}
__device__ __forceinline__ void tile64_reduce(LAS unsigned char* lds, int wave, int lane, const f32x4 (&acc)[4][4], f32x4 (&out)[2]) {
    LAS f32x4* red = (LAS f32x4*)lds;
    __syncthreads();
#pragma unroll
    for (int mi = 0; mi < 4; ++mi)
#pragma unroll
        for (int ni = 0; ni < 4; ++ni) red[(wave * 16 + mi * 4 + ni) * 64 + lane] = acc[mi][ni];
    __syncthreads();
#pragma unroll
    for (int j = 0; j < 2; ++j) { f32x4 s = red[(2 * wave + j) * 64 + lane];
#pragma unroll
        for (int w = 1; w < 8; ++w) s += red[(w * 16 + 2 * wave + j) * 64 + lane];
        out[j] = s; }
}
#define T64_ZERO(acc) do { _Pragma("unroll") for (int mi = 0; mi < 4; ++mi) _Pragma("unroll") for (int ni = 0; ni < 4; ++ni) acc[mi][ni] = (f32x4){0.f, 0.f, 0.f, 0.f}; } while (0)
template <int MODE>
__device__ __forceinline__ void sample_tiles(Frame& F, int l_in, int c0 = 0) {
    PHASE_IDS
    unsigned char* const wsl = fresh(F.ws);
    PHASE_L
    const size_t xb_cur = (l & 1) ? WS_XB2 : WS_XN, xb_nxt = (l & 1) ? WS_XN : WS_XB2;
    for (int t = (int)blockIdx.x >= c0 ? (int)blockIdx.x - c0 : 256; t < 256; t += fresh_i(F.G) - c0) {
        const int m0 = MPR + (t >> 5) * 64, n0 = (t & 31) * 64;
        f32x4 acc[4][4], o1[2], o2[2]; T64_ZERO(acc);
        if (MODE == 0) { tile64_mma((const bf16_t*)(wsl + WS_YA), PWD, (const bf16_t*)(wsl + WS_PPOOL), PWD, PWD, m0, n0, wave, lane, acc); tile64_reduce(F.lds, wave, lane, acc, o1);
                         T64_ZERO(acc); tile64_mma((const bf16_t*)(wsl + WS_YB), RWD, (const bf16_t*)(wsl + WS_PRWKV), RWD, RWD, m0, n0, wave, lane, acc); tile64_reduce(F.lds, wave, lane, acc, o2); }
        if (MODE == 1) { tile64_mma((const bf16_t*)(wsl + WS_MRG), DM, (const bf16_t*)(wsl + WS_WOUT), DM, DM, m0, n0, wave, lane, acc); tile64_reduce(F.lds, wave, lane, acc, o1); }
        if (MODE == 2) { tile64_mma((const bf16_t*)(wsl + WS_HID), FF, (const bf16_t*)(wsl + WS_WDN), FF, FF, m0, n0, wave, lane, acc); tile64_reduce(F.lds, wave, lane, acc, o1); }
        if (MODE == 3) { tile64_mma((const bf16_t*)(wsl + xb_cur), DM, (const bf16_t*)(wsl + WS_WPG), DM, DM, m0, n0, wave, lane, acc); tile64_reduce(F.lds, wave, lane, acc, o1); }
        if (MODE == 4) { tile64_mma((const bf16_t*)(wsl + WS_PB), PLE, (const bf16_t*)(wsl + WS_WPP), PLE, PLE, m0, n0, wave, lane, acc); tile64_reduce(F.lds, wave, lane, acc, o1); }
#pragma unroll
        for (int j = 0; j < 2; ++j) { const int blk = 2 * wave + j; const size_t row = (size_t)(m0 + 16 * (blk >> 2) + (lane & 15)); const int col = n0 + 16 * (blk & 3) + 4 * (lane >> 4);
            if (MODE == 0) { const bf16_t* PROJ = (const bf16_t*)(wsl + WS_PROJ); const u32x2 g1 = *(const u32x2*)(PROJ + row * ICP + PC_GP + col), g2 = *(const u32x2*)(PROJ + row * ICP + PC_GR + col);
                const f32x4 a = (f32x4){bf_lo(g1.x), bf_hi(g1.x), bf_lo(g1.y), bf_hi(g1.y)} * o1[j] + (f32x4){bf_lo(g2.x), bf_hi(g2.x), bf_lo(g2.y), bf_hi(g2.y)} * o2[j];
                *(u32x2*)((bf16_t*)(wsl + WS_MRG) + row * DM + col) = (u32x2){cvt_pk_bf16(a.x, a.y), cvt_pk_bf16(a.z, a.w)}; }
            if (MODE == 1 || MODE == 2) { bf16_t* p = (bf16_t*)(wsl + xb_cur) + row * DM + col; const u32x2 q = *(const u32x2*)p; const f32x4 x = (f32x4){bf_lo(q.x), bf_hi(q.x), bf_lo(q.y), bf_hi(q.y)} + o1[j];
                *(u32x2*)p = (u32x2){cvt_pk_bf16(x.x, x.y), cvt_pk_bf16(x.z, x.w)}; __hip_atomic_fetch_add((pg8::ss_t*)(wsl + WS_SS) + (size_t)MODE * MT + row, pg8::ss_fix((x.x * x.x + x.y * x.y) + (x.z * x.z + x.w * x.w)), __ATOMIC_RELAXED, __HIP_MEMORY_SCOPE_AGENT); }
            if (MODE == 3) { const u32x2 q = *(const u32x2*)((const bf16_t*)(wsl + WS_PP) + row * DM + col); const u32x2 xq = *(const u32x2*)((const bf16_t*)(wsl + xb_cur) + row * DM + col); bf16_t* p = (bf16_t*)(wsl + xb_nxt) + row * DM + col;
                const float rs = pg8::rstd_of((const pg8::ss_t*)(wsl + WS_SS) + (size_t)2 * MT, row);
                const f32x4 x = (f32x4){bf_lo(xq.x), bf_hi(xq.x), bf_lo(xq.y), bf_hi(xq.y)} + sigmoid4(o1[j] * rs) * (f32x4){bf_lo(q.x), bf_hi(q.x), bf_lo(q.y), bf_hi(q.y)};
                *(u32x2*)p = (u32x2){cvt_pk_bf16(x.x, x.y), cvt_pk_bf16(x.z, x.w)}; __hip_atomic_fetch_add((pg8::ss_t*)(wsl + WS_SS) + row, pg8::ss_fix((x.x * x.x + x.y * x.y) + (x.z * x.z + x.w * x.w)), __ATOMIC_RELAXED, __HIP_MEMORY_SCOPE_AGENT); }
            if (MODE == 4) *(u32x2*)((bf16_t*)(wsl + WS_PP) + row * DM + col) = (u32x2){cvt_pk_bf16(o1[j].x, o1[j].y), cvt_pk_bf16(o1[j].z, o1[j].w)};
        }
    }
    __syncthreads();
}

constexpr int PH_PER_LAYER = 11, N_PHASES = NL * PH_PER_LAYER + 1;
#ifndef MK_REP
#define MK_REP 0
#endif
__global__ void __launch_bounds__(NTHR, 2) mega_fwd(Args args) {
    extern __shared__ __attribute__((aligned(16))) unsigned char lds[];
    Frame F;
    F.lds = (LAS unsigned char*)lds;
    F.G = gridDim.x;
    F.out = args.out; F.ws = args.ws;
    { LAS unsigned long long* pt = (LAS unsigned long long*)(F.lds + LDSCTL_OFF + 1024); F.ptab = pt;
      if (threadIdx.x == 0) {
#define PT_(k) pt[k] = (unsigned long long)args.in[k];
          PT_(0) PT_(1) PT_(2) PT_(3) PT_(4) PT_(5) PT_(6) PT_(7) PT_(8) PT_(9) PT_(10) PT_(11) PT_(12) PT_(13) PT_(14) PT_(15) PT_(16) PT_(17) PT_(18) PT_(19) PT_(20) PT_(21) PT_(22) PT_(23) PT_(24) PT_(25) PT_(26) PT_(27) PT_(28) PT_(29) PT_(30) PT_(31) PT_(32)
#undef PT_
      } }
    volatile LAS unsigned* MISC = (volatile LAS unsigned*)(F.lds + LDSCTL_OFF);
    for (int u = threadIdx.x; u < 256; u += NTHR) ((LAS unsigned*)(F.lds + LDSCTL_OFF))[u] = 0u;
    __syncthreads();
    XcdBarrier bar; bar.bar = (unsigned*)(args.ws + WS_CTL) + CW_BAR; bar.x = 0; bar.st = nullptr;
    if (!MK_PER_PHASE) bar = xcd_barrier_post((unsigned*)(args.ws + WS_CTL) + CW_BAR, MISC + 8);
    const int lo = args.ph_lo, hi = args.ph_hi;
#define IN(k) (lo <= (k) && (k) < hi)
#define REP(k) (1 + ((MK_REP >> (k)) & 1))
#define PHASE(k, ...) do { if (IN(pb + (k))) { for (int rep = 0; rep < REP(k); ++rep) { if (rep) xcd_barrier(bar); __VA_ARGS__ } if (IN(pb + (k) + 1)) xcd_barrier(bar); } } while (0)
#define WSP(off) (fresh(F.ws) + (off))
#define UNPAREN(...) __VA_ARGS__
#define GEMM_M(M_, EPI, EINIT, Aoff, Boff, N_, K_, lda_, ldb_, apn_) do { pg8::Gemm g{(const bf16_t*)WSP(Aoff), (const bf16_t*)WSP(Boff), (M_), (N_), (K_), (lda_), (ldb_), (apn_)}; pg8::StaticOrder S; S.init((M_), (N_), fresh_i(F.G), fresh_i(cid)); \
        pg8::EPI E{UNPAREN EINIT}; pg8::gemm_phase<pg8::EPI, pg8::StaticOrder, true>(ring, g, S, E); } while (0)
#define GEMM(...) GEMM_M(MT, __VA_ARGS__)
#define GEMM_PAIR(M_, EPI, EINIT, Aoff, A2off, Boff, N_, K_, lda_, ldb_) do { pg8::Gemm g{(const bf16_t*)WSP(Aoff), (const bf16_t*)WSP(Boff), (M_), (N_), (K_), (lda_), (ldb_), (int)(((A2off) - (Aoff)) / 2)}; pg8::PairOrder S; \
        S.init((M_), (N_), fresh_i(F.G), fresh_i(cid)); pg8::EPI E{UNPAREN EINIT}; pg8::gemm_phase<pg8::EPI, pg8::PairOrder, true>(ring, g, S, E); } while (0)
#define GEMM_SUB(c0_, M_, EPI, EINIT, Aoff, Boff, N_, K_, lda_, ldb_, apn_) do { pg8::Gemm g{(const bf16_t*)WSP(Aoff), (const bf16_t*)WSP(Boff), (M_), (N_), (K_), (lda_), (ldb_), (apn_)}; pg8::StaticOrder S; \
        const int c0v = (c0_); S.init((M_), (N_), fresh_i(F.G) - c0v, fresh_i(cid) >= c0v ? fresh_i(cid) - c0v : -1); pg8::EPI E{UNPAREN EINIT}; pg8::gemm_phase<pg8::EPI, pg8::StaticOrder, true>(ring, g, S, E); } while (0)
    LAS unsigned char* ring = F.lds;
    const int cid = (int)blockIdx.x;
    for (int l = 0; l < NL; ++l) {
        const int pb = l * PH_PER_LAYER;
#define SSP(i) ((pg8::ss_t*)WSP(WS_SS) + (size_t)(i) * MT)
        const size_t xb_cur = (l & 1) ? WS_XB2 : WS_XN, xb_nxt = (l & 1) ? WS_XN : WS_XB2;
        PHASE(0, { convert_weights(F, l); if (l == 0) xb_from_input(F); });
        PHASE(1, { GEMM(EpiProj, ((bf16_t*)WSP(WS_PROJ), SSP(0)), xb_cur, WS_WIN, ICP, DM, DM, DM, 0); });
        PHASE(2, { prep1_phase(F, l); });
        PHASE(3, { GEMM(EpiBf16, ((bf16_t*)WSP(WS_YA), PWD), WS_D, WS_POOLW, PWD, 256, PWD, 256, 256);
                   GEMM(EpiLora, ((float*)WSP(WS_DEC), (bf16_t*)WSP(WS_AA), (bf16_t*)WSP(WS_GG), INP(12) + (size_t)fresh_i(l) * RWD, INP(14) + (size_t)fresh_i(l) * RWD), WS_LIN, WS_LORA, 3072, LK, LK, LK, 0); });
        PHASE(4, { spre_phase(F, l); });
        PHASE(5, { sseq_phase(F, l);
                   { const int c0 = fresh_i(F.G) >= 256 ? 128 : 0; GEMM_SUB(c0, MPR, EpiBf16, ((bf16_t*)WSP(WS_PP), DM), WS_PB, WS_WPP, DM, PLE, PLE, PLE, 0); sample_tiles<4>(F, l, c0); } });
        PHASE(6, { GEMM_PAIR(MPR, EpiGatePair, ((const bf16_t*)WSP(WS_PROJ), PC_GP, PC_GR, (bf16_t*)WSP(WS_MRG)), WS_YA, WS_YB, WS_PPOOL, DM, PWD, PWD, PWD);
                   sample_tiles<0>(F, l); });
        PHASE(7, { GEMM_M(MPR, EpiResid, ((bf16_t*)WSP(xb_cur), SSP(1)), WS_MRG, WS_WOUT, DM, DM, DM, DM, 0); sample_tiles<1>(F, l); });
        PHASE(8, { GEMM(EpiSwiglu, ((bf16_t*)WSP(WS_HID), SSP(1)), xb_cur, WS_WGU, 2 * FF, DM, DM, DM, 0); });
        PHASE(9, { GEMM_M(MPR, EpiResid, ((bf16_t*)WSP(xb_cur), SSP(2)), WS_HID, WS_WDN, DM, FF, FF, FF, 0); sample_tiles<2>(F, l); });
        PHASE(10, { GEMM_M(MPR, EpiPle, ((const bf16_t*)WSP(xb_cur), (bf16_t*)WSP(xb_nxt), (const bf16_t*)WSP(WS_PP), SSP(2), SSP(0)), xb_cur, WS_WPG, DM, DM, DM, DM, 0); sample_tiles<3>(F, l); });
#undef SSP
    }
    if (IN(NL * PH_PER_LAYER)) final_norm(F, INP(32));
#undef IN
#undef REP
#undef PHASE
#undef WSP
#undef GEMM
#undef GEMM_M
#undef GEMM_SUB
#undef UNPAREN
}

extern "C" void kernel_launch(void* const* d_in, const int* in_sizes, int n_in, void* d_out, int out_size, void* d_ws, size_t ws_size, hipStream_t stream) {
    static int grid = 0;
    if (grid == 0) {
        if (n_in != 33 || in_sizes[0] != MPR * DM || out_size != (int)O_END || ws_size < WS_END) {
            fprintf(stderr, "kernel_launch: unexpected shapes: n_in %d in0 %d out %d ws %zu (need %zu); nothing launched\n", n_in, n_in > 0 ? in_sizes[0] : -1, out_size, ws_size, (size_t)WS_END); grid = -1; return; }
        int dev = 0, cus = 0, per_cu = 0;
        if (hipGetDevice(&dev) != hipSuccess || hipDeviceGetAttribute(&cus, hipDeviceAttributeMultiprocessorCount, dev) != hipSuccess) { grid = -1; return; }
        if (hipFuncSetAttribute((const void*)mega_fwd, hipFuncAttributeMaxDynamicSharedMemorySize, LDS_BYTES) != hipSuccess) { fprintf(stderr, "kernel_launch: hipFuncSetAttribute failed\n"); grid = -1; return; }
        if (hipOccupancyMaxActiveBlocksPerMultiprocessor(&per_cu, (const void*)mega_fwd, NTHR, LDS_BYTES) != hipSuccess || per_cu < 1) { fprintf(stderr, "kernel_launch: occupancy query says %d\n", per_cu); (void)hipGetLastError(); grid = -1; return; }
        grid = cus;
    }
    if (grid < 0) return;
    (void)hipMemsetAsync((char*)d_ws + WS_CTL, 0, CTL_ZERO_BYTES, stream);
    Args a; memset(&a, 0, sizeof(a));
    for (int i = 0; i < 33; ++i) a.in[i] = (const float*)d_in[i];
    a.out = (float*)d_out; a.ws = (unsigned char*)d_ws;
#if MK_PER_PHASE
    for (int p = 0; p < N_PHASES; ++p) { a.ph_lo = p; a.ph_hi = p + 1; hipLaunchKernelGGL(mega_fwd, dim3(grid), dim3(NTHR), LDS_BYTES, stream, a); }
#else
    a.ph_lo = 0; a.ph_hi = N_PHASES; hipLaunchKernelGGL(mega_fwd, dim3(grid), dim3(NTHR), LDS_BYTES, stream, a);
#endif
}
```

```cpp
#include <hip/hip_runtime.h>
#include <cstdio>
#include <cstdint>
#include <cstring>

#ifndef MK_PER_PHASE
#define MK_PER_PHASE 0
#endif

#define LAS __attribute__((address_space(3)))
typedef unsigned short bf16_t;
typedef short bf16x8 __attribute__((ext_vector_type(8)));
typedef float f32x4 __attribute__((ext_vector_type(4)));
typedef float f32x2 __attribute__((ext_vector_type(2)));
typedef unsigned u32x4 __attribute__((ext_vector_type(4)));
typedef unsigned u32x2 __attribute__((ext_vector_type(2)));

constexpr int DM = 2048, NL = 4, MT = 16896, MPR = 16384, TP = 2048, TS = 64;
constexpr int PWD = 1024, RWD = 1024, RPJ = 3360, ICOLS = 8480, ICP = 8704, FF = 5632, PLE = 256, LK = 384;
constexpr int PC_GP = 4608, PC_GR = 6656;
constexpr float NORM_EPS = 1e-6f, GN_EPS = 64e-5f;
constexpr size_t O_YS = 33554432, O_SHP = 34603008, O_POP = 34710528, O_WKP = 35202048, O_SHS = 37299200, O_POS = 37406720, O_WKS = 37898240, O_END = 39995392;

__device__ __forceinline__ unsigned cvt_pk_bf16(float lo, float hi) { unsigned r; asm volatile("v_cvt_pk_bf16_f32 %0, %1, %2" : "=v"(r) : "v"(lo), "v"(hi)); return r; }
__device__ __forceinline__ float bf_lo(unsigned u) { return __uint_as_float(u << 16); }
__device__ __forceinline__ float bf_hi(unsigned u) { return __uint_as_float(u & 0xffff0000u); }
__device__ __forceinline__ void unpack8(const u32x4 w, float (&f)[8]) { f[0] = bf_lo(w.x); f[1] = bf_hi(w.x); f[2] = bf_lo(w.y); f[3] = bf_hi(w.y); f[4] = bf_lo(w.z); f[5] = bf_hi(w.z); f[6] = bf_lo(w.w); f[7] = bf_hi(w.w); }
__device__ __forceinline__ u32x4 pack8(const float (&f)[8]) { u32x4 w; w.x = cvt_pk_bf16(f[0], f[1]); w.y = cvt_pk_bf16(f[2], f[3]); w.z = cvt_pk_bf16(f[4], f[5]); w.w = cvt_pk_bf16(f[6], f[7]); return w; }
__device__ __forceinline__ float sigmoidf_(float x) { return __builtin_amdgcn_rcpf(1.0f + __expf(-x)); }
__device__ __forceinline__ f32x4 sigmoid4(f32x4 v) { f32x4 o; o.x = sigmoidf_(v.x); o.y = sigmoidf_(v.y); o.z = sigmoidf_(v.z); o.w = sigmoidf_(v.w); return o; }
__device__ __forceinline__ f32x4 rcp4(f32x4 v) { f32x4 o; o.x = __builtin_amdgcn_rcpf(v.x); o.y = __builtin_amdgcn_rcpf(v.y); o.z = __builtin_amdgcn_rcpf(v.z); o.w = __builtin_amdgcn_rcpf(v.w); return o; }
__device__ __forceinline__ f32x4 fmax4(f32x4 a, f32x4 b) { f32x4 o; o.x = fmaxf(a.x, b.x); o.y = fmaxf(a.y, b.y); o.z = fmaxf(a.z, b.z); o.w = fmaxf(a.w, b.w); return o; }
__device__ __forceinline__ float tanhf_(float x) { const float e = __expf(2.0f * x); return 1.0f - 2.0f * __builtin_amdgcn_rcpf(e + 1.0f); }
template <int CTRL> __device__ __forceinline__ float dpp_f(float x) { return __uint_as_float((unsigned)__builtin_amdgcn_update_dpp(0, (int)__float_as_uint(x), CTRL, 0xF, 0xF, true)); }
__device__ __forceinline__ float sum8(float x) { x += dpp_f<0xB1>(x); x += dpp_f<0x4E>(x); x += dpp_f<0x141>(x); return x; }
__device__ __forceinline__ float wave_sum(float x) {
    x += dpp_f<0xB1>(x); x += dpp_f<0x4E>(x); x += dpp_f<0x141>(x); x += dpp_f<0x140>(x);
    x += __uint_as_float((unsigned)__builtin_amdgcn_ds_swizzle((int)__float_as_uint(x), 0x401F));
    return __uint_as_float((unsigned)__builtin_amdgcn_readlane((int)__float_as_uint(x), 0)) + __uint_as_float((unsigned)__builtin_amdgcn_readlane((int)__float_as_uint(x), 32));
}

namespace pg8 {
typedef unsigned ss_t;
constexpr int BM = 256, BK = 64, HALF = 128, HTB = HALF * BK * 2  , STAGE_BYTES = 8 * HTB, NXCD = 8, WGM = 4;
__host__ __device__ __forceinline__ int lds_g2(int fr) { return (0x1230 >> (4 * (fr >> 2))) & 3; }
__host__ __device__ __forceinline__ int lds_byte(int r, int c) { const int fr = r & 15, h = (c >> 5) & 1, q = (c >> 3) & 3; return (r >> 3) * 1024 + (r & 7) * 128 + ((h ^ ((fr >> 1) & 1)) * 64) + ((q ^ lds_g2(fr)) * 16); }
__host__ __device__ __forceinline__ void stage_rc(int b, int& R, int& C) { const int blk = b / 1024, sl = (b % 1024) / 16, rr8 = sl >> 3, fr = (blk & 1) * 8 + rr8, h = ((sl >> 2) & 1) ^ ((fr >> 1) & 1), q = (sl & 3) ^ lds_g2(fr); R = blk * 8 + rr8; C = 8 * (4 * h + q); }
__host__ __device__ __forceinline__ int perm32(int rho) { const int n = rho >> 4, i = rho & 15; return 8 * (i >> 2) + 4 * n + (i & 3); }

struct Unit { int pm, pn; };
struct Gemm { const bf16_t* A; const bf16_t* Bt; int M, N, K, lda, ldb, a_pn_off; };

struct StaticOrder {
    int nM, nN, nwg, G, c;
    __host__ __device__ void init(int M, int N, int G_, int c_) { nM = M / BM; nN = N / BM; nwg = nM * nN; G = G_; c = c_; }
    __host__ __device__ bool next(int i, Unit& u) const {
        if (c < 0) return false;
        const long L = (long)i * G + c; if (L >= nwg) return false;
        int wgid = (int)L; { const int q = nwg / NXCD, r = nwg % NXCD, xcd = wgid % NXCD, off = wgid / NXCD; wgid = (xcd < r ? xcd * (q + 1) : r * (q + 1) + (xcd - r) * q) + off; }
        const int nig = WGM * nN, gid = wgid / nig, fm = gid * WGM, gsz = (nM - fm) < WGM ? (nM - fm) : WGM;
        u.pm = fm + ((wgid % nig) % gsz); u.pn = ((wgid % nig) / gsz + gid) % nN; return true;
    }
    __device__ __forceinline__ void a_ready(const Unit&) const {}
    __device__ __forceinline__ void done(const Unit&) const {}
};

struct PairOrder : StaticOrder {
    __host__ __device__ bool next(int i, Unit& u) const { if (!StaticOrder::next(i >> 1, u)) return false; u.pn += (i & 1) * 8; return true; }
};
template <class T, class = void> struct paired_t { static constexpr bool v = false; };
template <class T> struct paired_t<T, decltype((void)T::PAIRED)> { static constexpr bool v = true; };

__device__ __forceinline__ void acc_zero(f32x4 (&acc)[2][2][4][2]) {
#pragma unroll
    for (int a = 0; a < 2; ++a)
#pragma unroll
        for (int b = 0; b < 2; ++b)
#pragma unroll
            for (int m = 0; m < 4; ++m)
#pragma unroll
                for (int n = 0; n < 2; ++n) acc[a][b][m][n] = (f32x4){0.f, 0.f, 0.f, 0.f};
}
struct RepeatOrder : StaticOrder {
    __host__ __device__ bool next(int i, Unit& u) const { if (i >= 6) return false; return StaticOrder::next(i % 3, u) || StaticOrder::next(0, u); }
};
#define EPI_ZERO_INIT __device__ __forceinline__ void init(f32x4 (&acc)[2][2][4][2], const Unit&, int, int, int, int) const { acc_zero(acc); }
#define EPI_NO_PRE __device__ __forceinline__ void preload(ss_t (&pre)[2], const Unit&, int, int, int) const {}
#define EPI_SS_PRE(SSPTR) __device__ __forceinline__ void preload(ss_t (&pre)[2], const Unit& u, int wr, int fr, int fq) const { _Pragma("unroll") for (int j = 0; j < 2; ++j) { const int g = 2 * fq + j; \
        pre[j] = (SSPTR)[(size_t)(u.pm * BM + (g >> 2) * HALF + wr * 64 + (g & 3) * 16 + fr)]; } }
__device__ __forceinline__ ss_t pre_get(const ss_t (&pre)[2], int g, int fr) { return (ss_t)__builtin_amdgcn_ds_bpermute((((g >> 1) << 4) + fr) << 2, (int)pre[g & 1]); }
template <class Epi, class Sched, bool ALIGN_EPI>
__device__ __forceinline__ void gemm_phase(LAS unsigned char* lds, const Gemm g, const Sched& S, const Epi& E) {
    int tid_ = threadIdx.x; asm volatile("" : "+v"(tid_));
    const int tid = tid_, wid = __builtin_amdgcn_readfirstlane(tid >> 6), lane = tid & 63, wr = wid >> 2, wc = wid & 3, fr = lane & 15, fq = lane >> 4;
    int K_ = g.K; asm volatile("" : "+s"(K_));
    const int K = K_, nt = K / BK;
    unsigned voffA[2], voffB[2];
#pragma unroll
    for (int i = 0; i < 2; ++i) { int R, C; stage_rc(tid * 16 + i * 8192, R, C); const int Rb = Epi::PERM ? (64 * (R >> 5) + perm32(R & 31)) : R;
        voffA[i] = (unsigned)(R * g.lda + C) * 2u; voffB[i] = (unsigned)(Rb * g.ldb + C) * 2u; }
    const size_t kstep = (size_t)(BK * 2);
    const size_t hstepA = (size_t)HALF * g.lda * 2, hstepB = (size_t)(Epi::PERM ? 32 : HALF) * g.ldb * 2;
    const unsigned ldsw = (unsigned)wid * 1024u;
    int aoff = lds_byte(wr * 64 + fr, fq * 8), boff = lds_byte(wc * 32 + fr, fq * 8);
#define PG8_SA(b, h) (((b) * 2 + (h)) * HTB)
#define PG8_APN(u) (paired_t<Epi>::v ? ((u).pn >> 3) : (u).pn)
#define PG8_SB(b, h) ((4 + (b) * 2 + (h)) * HTB)
#define PG8_STAGE(bufoff, gbase, voff) do { _Pragma("unroll") for (int _i = 0; _i < 2; ++_i) \
        __builtin_amdgcn_global_load_lds((const unsigned*)((const char*)(gbase) + (voff)[_i]), (LAS unsigned*)(lds + (bufoff) + ldsw + _i * 8192), 16, 0, 0); } while (0)
#define PG8_TOG(x) asm volatile("v_xor_b32 %0, 64, %0" : "+v"(x))
#define PG8_LDA(dst, b, h) do { _Pragma("unroll") for (int m = 0; m < 4; ++m) dst[m][0] = *(const LAS bf16x8*)(lds + PG8_SA(b, h) + aoff + m * 2048); PG8_TOG(aoff); \
        _Pragma("unroll") for (int m = 0; m < 4; ++m) dst[m][1] = *(const LAS bf16x8*)(lds + PG8_SA(b, h) + aoff + m * 2048); PG8_TOG(aoff); } while (0)
#define PG8_LDB(dst, b, h) do { _Pragma("unroll") for (int n = 0; n < 2; ++n) dst[n][0] = *(const LAS bf16x8*)(lds + PG8_SB(b, h) + boff + n * 2048); PG8_TOG(boff); \
        _Pragma("unroll") for (int n = 0; n < 2; ++n) dst[n][1] = *(const LAS bf16x8*)(lds + PG8_SB(b, h) + boff + n * 2048); PG8_TOG(boff); } while (0)
#define PG8_MMA(ai, bj, At, Bt) do { __builtin_amdgcn_s_setprio(1); _Pragma("unroll") for (int m = 0; m < 4; ++m) _Pragma("unroll") for (int n = 0; n < 2; ++n) _Pragma("unroll") for (int k = 0; k < 2; ++k) \
        acc[ai][bj][m][n] = __builtin_amdgcn_mfma_f32_16x16x32_bf16(Bt[n][k], At[m][k], acc[ai][bj][m][n], 0, 0, 0); __builtin_amdgcn_s_setprio(0); } while (0)
#define PG8_WAIT_V(n) asm volatile("s_waitcnt vmcnt(" #n ")" ::: "memory")
#define PG8_WAIT_L(n) asm volatile("s_waitcnt lgkmcnt(" #n ")" ::: "memory")
#define PG8_BAR __builtin_amdgcn_s_barrier()
#define PG8_SCHED __builtin_amdgcn_sched_barrier(0)
    Unit cur, nxt; int ui = 0;
    if (!S.next(0, cur)) return;
    f32x4 acc[2][2][4][2]; ss_t pre[2];
    E.init(acc, cur, wr, wc, fr, fq); E.preload(pre, cur, wr, fr, fq);
    bf16x8 At[4][2], B0[2][2], B1[2][2];
    const char* cA = (const char*)g.A + ((size_t)cur.pm * BM * g.lda + (size_t)PG8_APN(cur) * g.a_pn_off) * 2; const char* cB = (const char*)g.Bt + (size_t)cur.pn * BM * g.ldb * 2;
    S.a_ready(cur);
    PG8_STAGE(PG8_SB(0, 0), cB, voffB); PG8_STAGE(PG8_SB(0, 1), cB + hstepB, voffB); PG8_STAGE(PG8_SA(0, 0), cA, voffA); PG8_STAGE(PG8_SA(0, 1), cA + hstepA, voffA);
    if (wr == 1) PG8_BAR;
    PG8_WAIT_V(2); PG8_BAR;
    PG8_STAGE(PG8_SB(1, 0), cB + kstep, voffB); PG8_STAGE(PG8_SA(1, 0), cA + kstep, voffA); PG8_STAGE(PG8_SB(1, 1), cB + hstepB + kstep, voffB);
    PG8_WAIT_V(6); PG8_BAR;
    for (;;) {
        const bool has_next = S.next(ui + 1, nxt);
        const char* nA = has_next ? (const char*)g.A + ((size_t)nxt.pm * BM * g.lda + (size_t)PG8_APN(nxt) * g.a_pn_off) * 2 : cA; const char* nB = has_next ? (const char*)g.Bt + (size_t)nxt.pn * BM * g.ldb * 2 : cB;
#pragma unroll 1
        for (int t = 0; t < nt; t += 2) {
            const bool last = (t == nt - 2);
            const char* a1 = cA + (size_t)(t + 1) * kstep;
            const char* a2 = last ? nA : cA + (size_t)(t + 2) * kstep; const char* b2 = last ? nB : cB + (size_t)(t + 2) * kstep;
            const char* a3 = a2 + kstep; const char* b3 = b2 + kstep;
            if (last && has_next) S.a_ready(nxt);
            PG8_LDB(B0, 0, 0); PG8_LDB(B1, 0, 1); PG8_SCHED; PG8_LDA(At, 0, 0); PG8_STAGE(PG8_SA(1, 1), a1 + hstepA, voffA);
            PG8_WAIT_V(8); PG8_WAIT_L(0); PG8_BAR; PG8_MMA(0, 0, At, B0); PG8_MMA(0, 1, At, B1); PG8_BAR; PG8_SCHED;
            PG8_LDA(At, 0, 1); PG8_STAGE(PG8_SB(0, 0), b2, voffB); PG8_STAGE(PG8_SB(0, 1), b2 + hstepB, voffB); PG8_STAGE(PG8_SA(0, 0), a2, voffA);
            PG8_WAIT_V(8); PG8_WAIT_L(0); PG8_BAR; PG8_MMA(1, 0, At, B0); PG8_MMA(1, 1, At, B1); PG8_BAR; PG8_SCHED;
            PG8_LDB(B0, 1, 0); PG8_LDB(B1, 1, 1); PG8_SCHED; PG8_LDA(At, 1, 0); PG8_STAGE(PG8_SA(0, 1), a2 + hstepA, voffA);
            PG8_WAIT_V(8); PG8_WAIT_L(0); PG8_BAR; PG8_MMA(0, 0, At, B0); PG8_MMA(0, 1, At, B1); PG8_BAR; PG8_SCHED;
            PG8_LDA(At, 1, 1); PG8_STAGE(PG8_SB(1, 0), b3, voffB); PG8_STAGE(PG8_SB(1, 1), b3 + hstepB, voffB); PG8_STAGE(PG8_SA(1, 0), a3, voffA);
            PG8_WAIT_V(8); PG8_WAIT_L(0); PG8_BAR; PG8_MMA(1, 0, At, B0); PG8_MMA(1, 1, At, B1); PG8_BAR; PG8_SCHED;
        }
        if constexpr (ALIGN_EPI) { if (wr == 0) PG8_BAR; }
        E(acc, pre, cur, wr, wc, fr, fq); S.done(cur);
        if (!has_next) break;
        E.init(acc, nxt, wr, wc, fr, fq); E.preload(pre, nxt, wr, fr, fq);
        cur = nxt; cA = nA; cB = nB; ++ui;
        if constexpr (ALIGN_EPI) { if (wr == 1) PG8_BAR; }
    }
    PG8_WAIT_V(0);
    if constexpr (!ALIGN_EPI) { if (wr == 0) PG8_BAR; }
    PG8_BAR;
#undef PG8_SA
#undef PG8_APN
#undef PG8_SB
#undef PG8_STAGE
#undef PG8_LDA
#undef PG8_TOG
#undef PG8_LDB
#undef PG8_MMA
#undef PG8_WAIT_V
#undef PG8_WAIT_L
#undef PG8_BAR
#undef PG8_SCHED
}

#define EPI_ROW0 (u.pm * BM + wr * 64 + fr)
#define EPI_FOR_AI_M _Pragma("unroll") for (int ai = 0; ai < 2; ++ai) _Pragma("unroll") for (int m = 0; m < 4; ++m)
__device__ __forceinline__ u32x4 pack_f4x2(f32x4 v0, f32x4 v1) { u32x4 w; w.x = cvt_pk_bf16(v0[0], v0[1]); w.y = cvt_pk_bf16(v0[2], v0[3]); w.z = cvt_pk_bf16(v1[0], v1[1]); w.w = cvt_pk_bf16(v1[2], v1[3]); return w; }
__device__ __forceinline__ void unpack_f4x2(u32x4 w, f32x4& v0, f32x4& v1) { v0[0] = bf_lo(w.x); v0[1] = bf_hi(w.x); v0[2] = bf_lo(w.y); v0[3] = bf_hi(w.y); v1[0] = bf_lo(w.z); v1[1] = bf_hi(w.z); v1[2] = bf_lo(w.w); v1[3] = bf_hi(w.w); }
__device__ __forceinline__ unsigned ror8(unsigned x) { return (unsigned)__builtin_amdgcn_update_dpp(0, (int)x, 0x128, 0xF, 0xF, true); }
__device__ __forceinline__ void st_pair(char* grp, size_t pitch, int fr, int fq, u32x4 vA, u32x4 vB) {
    const bool lo = fr < 8;
    u32x4 snd = lo ? vB : vA, rcv; rcv.x = ror8(snd.x); rcv.y = ror8(snd.y); rcv.z = ror8(snd.z); rcv.w = ror8(snd.w);
    char* p = grp + (size_t)(fr & 7) * pitch + (lo ? 0 : 64) + fq * 16;
    *(u32x4*)p = lo ? vA : rcv;
    *(u32x4*)(p + 8 * pitch) = lo ? rcv : vB;
}
__device__ __forceinline__ u32x4 as_u4(f32x4 v) { return __builtin_bit_cast(u32x4, v); }

__device__ __forceinline__ float rstd_raw(ss_t v) { return __builtin_amdgcn_rsqf((float)v * (1.0f / (256.0f * DM)) + NORM_EPS); }
__device__ __forceinline__ float rstd_of(const ss_t* SS, size_t row) { return rstd_raw(SS[row]); }
__device__ __forceinline__ ss_t ss_fix(float s) { return (ss_t)(s * 256.0f + 0.5f); }
__device__ __forceinline__ float sq8(f32x4 a, f32x4 b) { return (a.x * a.x + a.y * a.y) + (a.z * a.z + a.w * a.w) + (b.x * b.x + b.y * b.y) + (b.z * b.z + b.w * b.w); }
__device__ __forceinline__ void ss_add(ss_t* SS, size_t row, float s, int fq, int fr) { s += __uint_as_float((unsigned)__builtin_amdgcn_ds_swizzle((int)__float_as_uint(s), 0x401F));
    s += __uint_as_float((unsigned)__builtin_amdgcn_ds_bpermute((((fq ^ 2) << 4) + fr) << 2, (int)__float_as_uint(s)));
    if (fq == 0) __hip_atomic_fetch_add(SS + row, ss_fix(s), __ATOMIC_RELAXED, __HIP_MEMORY_SCOPE_AGENT); }
struct EpiNull { static constexpr bool PERM = true; EPI_NO_PRE EPI_ZERO_INIT __device__ __forceinline__ void operator()(const f32x4 (&acc)[2][2][4][2], const ss_t (&pre)[2], const Unit& u, int wr, int wc, int fr, int fq) const {
#pragma unroll
    for (int a = 0; a < 2; ++a)
#pragma unroll
        for (int b = 0; b < 2; ++b)
#pragma unroll
            for (int m = 0; m < 4; ++m)
#pragma unroll
                for (int n = 0; n < 2; ++n) asm volatile("" :: "v"(acc[a][b][m][n]));
} };
struct EpiProj { static constexpr bool PERM = true; EPI_ZERO_INIT
    bf16_t* O; const ss_t* SS; EPI_SS_PRE(SS)
    __device__ __forceinline__ void operator()(const f32x4 (&acc)[2][2][4][2], const ss_t (&pre)[2], const Unit& u, int wr, int wc, int fr, int fq) const {
        const bool sg = u.pn >= 18;
        EPI_FOR_AI_M { const size_t r0 = (size_t)(u.pm * BM + ai * HALF + wr * 64 + m * 16); char* grp = (char*)(O + r0 * ICP + u.pn * BM + 64 * wc); const float rs = rstd_raw(pre_get(pre, ai * 4 + m, fr));
            f32x4 a0 = acc[ai][0][m][0] * rs, a1 = acc[ai][0][m][1] * rs, b0 = acc[ai][1][m][0] * rs, b1 = acc[ai][1][m][1] * rs;
            if (sg) { a0 = sigmoid4(a0); a1 = sigmoid4(a1); b0 = sigmoid4(b0); b1 = sigmoid4(b1); }
            st_pair(grp, (size_t)ICP * 2, fr, fq, pack_f4x2(a0, a1), pack_f4x2(b0, b1)); }
    }
};
struct EpiBf16 { static constexpr bool PERM = true; EPI_NO_PRE EPI_ZERO_INIT
    bf16_t* O; int ldc;
    __device__ __forceinline__ void operator()(const f32x4 (&acc)[2][2][4][2], const ss_t (&pre)[2], const Unit& u, int wr, int wc, int fr, int fq) const {
        EPI_FOR_AI_M { char* grp = (char*)(O + (size_t)(u.pm * BM + ai * HALF + wr * 64 + m * 16) * ldc + u.pn * BM + 64 * wc);
            st_pair(grp, (size_t)ldc * 2, fr, fq, pack_f4x2(acc[ai][0][m][0], acc[ai][0][m][1]), pack_f4x2(acc[ai][1][m][0], acc[ai][1][m][1])); }
    }
};
struct EpiLora { static constexpr bool PERM = true; EPI_NO_PRE EPI_ZERO_INIT
    float* DEC; bf16_t* AA; bf16_t* GG; const float* w0; const float* a0;
    __device__ __forceinline__ void operator()(const f32x4 (&acc)[2][2][4][2], const ss_t (&pre)[2], const Unit& u, int wr, int wc, int fr, int fq) const {
        const int row0 = EPI_ROW0, kind = u.pn >> 2, ct = (u.pn & 3) * BM + 64 * wc, col0 = ct + 8 * fq;
        if (kind == 0) {
            EPI_FOR_AI_M { float* rowp = DEC + (size_t)(row0 + ai * HALF + m * 16) * RWD + col0;
#pragma unroll
                for (int bj = 0; bj < 2; ++bj)
#pragma unroll
                    for (int n = 0; n < 2; ++n) { const f32x4 b = *(const f32x4*)(w0 + col0 + bj * 32 + 4 * n); const f32x4 x = acc[ai][bj][m][n] + b; f32x4 o;
#pragma unroll
                        for (int j = 0; j < 4; ++j) { const float z = -x[j]; const float sp = z > 15.f ? z : __logf(1.0f + __expf(z)); const float w = -sp - 0.5f; o[j] = __expf(-__expf(w)); }
                        *(f32x4*)(rowp + bj * 32 + 4 * n) = o; } asm volatile("" ::: "memory"); }
        } else if (kind == 1) {
            const f32x4 b00 = *(const f32x4*)(a0 + col0), b01 = *(const f32x4*)(a0 + col0 + 4), b10 = *(const f32x4*)(a0 + col0 + 32), b11 = *(const f32x4*)(a0 + col0 + 36);
            EPI_FOR_AI_M { char* grp = (char*)(AA + (size_t)(u.pm * BM + ai * HALF + wr * 64 + m * 16) * RWD + ct);
                st_pair(grp, (size_t)RWD * 2, fr, fq, pack_f4x2(sigmoid4(acc[ai][0][m][0] + b00), sigmoid4(acc[ai][0][m][1] + b01)), pack_f4x2(sigmoid4(acc[ai][1][m][0] + b10), sigmoid4(acc[ai][1][m][1] + b11))); }
        } else {
            EPI_FOR_AI_M { char* grp = (char*)(GG + (size_t)(u.pm * BM + ai * HALF + wr * 64 + m * 16) * RWD + ct);
                st_pair(grp, (size_t)RWD * 2, fr, fq, pack_f4x2(acc[ai][0][m][0], acc[ai][0][m][1]), pack_f4x2(acc[ai][1][m][0], acc[ai][1][m][1])); }
        }
    }
};
struct EpiGate1 { static constexpr bool PERM = true; EPI_NO_PRE EPI_ZERO_INIT
    bf16_t* TMP; const bf16_t* PROJ; int gcol0;
    __device__ __forceinline__ void operator()(const f32x4 (&acc)[2][2][4][2], const ss_t (&pre)[2], const Unit& u, int wr, int wc, int fr, int fq) const {
        const int row0 = EPI_ROW0, ct = u.pn * BM + 64 * wc, col0 = ct + 8 * fq;
        EPI_FOR_AI_M { const size_t row = (size_t)(row0 + ai * HALF + m * 16);
            f32x4 g00, g01, g10, g11; unpack_f4x2(*(const u32x4*)(PROJ + row * ICP + gcol0 + col0), g00, g01); unpack_f4x2(*(const u32x4*)(PROJ + row * ICP + gcol0 + col0 + 32), g10, g11);
            st_pair((char*)(TMP + (size_t)(u.pm * BM + ai * HALF + wr * 64 + m * 16) * DM + ct), (size_t)DM * 2, fr, fq, pack_f4x2(acc[ai][0][m][0] * g00, acc[ai][0][m][1] * g01), pack_f4x2(acc[ai][1][m][0] * g10, acc[ai][1][m][1] * g11));
            if (m & 1) asm volatile("" ::: "memory"); }
    }
};
struct EpiGate2 { static constexpr bool PERM = true; EPI_NO_PRE EPI_ZERO_INIT
    const bf16_t* TMP; const bf16_t* PROJ; int gcol0; bf16_t* O;
    __device__ __forceinline__ void operator()(const f32x4 (&acc)[2][2][4][2], const ss_t (&pre)[2], const Unit& u, int wr, int wc, int fr, int fq) const {
        const int row0 = EPI_ROW0, ct = u.pn * BM + 64 * wc, col0 = ct + 8 * fq;
        EPI_FOR_AI_M { const size_t row = (size_t)(row0 + ai * HALF + m * 16);
            f32x4 g00, g01, g10, g11, t00, t01, t10, t11; unpack_f4x2(*(const u32x4*)(PROJ + row * ICP + gcol0 + col0), g00, g01); unpack_f4x2(*(const u32x4*)(PROJ + row * ICP + gcol0 + col0 + 32), g10, g11);
            unpack_f4x2(*(const u32x4*)(TMP + row * DM + col0), t00, t01); unpack_f4x2(*(const u32x4*)(TMP + row * DM + col0 + 32), t10, t11);
            st_pair((char*)(O + (size_t)(u.pm * BM + ai * HALF + wr * 64 + m * 16) * DM + ct), (size_t)DM * 2, fr, fq, pack_f4x2(t00 + acc[ai][0][m][0] * g00, t01 + acc[ai][0][m][1] * g01), pack_f4x2(t10 + acc[ai][1][m][0] * g10, t11 + acc[ai][1][m][1] * g11));
            if (m & 1) asm volatile("" ::: "memory"); }
    }
};
struct EpiGatePair { static constexpr bool PERM = true; static constexpr bool PAIRED = true; EPI_NO_PRE
    const bf16_t* PROJ; int gc1, gc2; bf16_t* O;
    __device__ __forceinline__ void init(f32x4 (&acc)[2][2][4][2], const Unit& u, int, int, int, int) const { if (u.pn < 8) acc_zero(acc); }
    __device__ __forceinline__ void operator()(f32x4 (&acc)[2][2][4][2], const ss_t (&pre)[2], const Unit& u, int wr, int wc, int fr, int fq) const {
        const int row0 = EPI_ROW0, ct = (u.pn & 7) * BM + 64 * wc, col0 = ct + 8 * fq;
        const f32x4 flo = (f32x4){0x1p-60f, 0x1p-60f, 0x1p-60f, 0x1p-60f};
        if (u.pn < 8) {
#pragma unroll
            for (int ai = 0; ai < 2; ++ai) { u32x4 q[4][4];
#pragma unroll
                for (int m = 0; m < 4; ++m) { const bf16_t* p = PROJ + (size_t)(row0 + ai * HALF + m * 16) * ICP + col0; q[m][0] = *(const u32x4*)(p + gc1); q[m][1] = *(const u32x4*)(p + gc1 + 32); q[m][2] = *(const u32x4*)(p + gc2); q[m][3] = *(const u32x4*)(p + gc2 + 32); }
                __builtin_amdgcn_sched_barrier(0);
#pragma unroll
                for (int m = 0; m < 4; ++m) { f32x4 g00, g01, g10, g11, h00, h01, h10, h11; unpack_f4x2(q[m][0], g00, g01); unpack_f4x2(q[m][1], g10, g11); unpack_f4x2(q[m][2], h00, h01); unpack_f4x2(q[m][3], h10, h11);
                    acc[ai][0][m][0] *= g00 * rcp4(fmax4(h00, flo)); acc[ai][0][m][1] *= g01 * rcp4(fmax4(h01, flo)); acc[ai][1][m][0] *= g10 * rcp4(fmax4(h10, flo)); acc[ai][1][m][1] *= g11 * rcp4(fmax4(h11, flo)); }
                __builtin_amdgcn_sched_barrier(0); }
        } else {
            u32x4 q[2][4][2];
#pragma unroll
            for (int ai = 0; ai < 2; ++ai)
#pragma unroll
                for (int m = 0; m < 4; ++m) { const bf16_t* p = PROJ + (size_t)(row0 + ai * HALF + m * 16) * ICP + gc2 + col0; q[ai][m][0] = *(const u32x4*)p; q[ai][m][1] = *(const u32x4*)(p + 32); }
            __builtin_amdgcn_sched_barrier(0);
            EPI_FOR_AI_M { f32x4 h00, h01, h10, h11; unpack_f4x2(q[ai][m][0], h00, h01); unpack_f4x2(q[ai][m][1], h10, h11);
                st_pair((char*)(O + (size_t)(u.pm * BM + ai * HALF + wr * 64 + m * 16) * DM + ct), (size_t)DM * 2, fr, fq, pack_f4x2(acc[ai][0][m][0] * fmax4(h00, flo), acc[ai][0][m][1] * fmax4(h01, flo)),
                        pack_f4x2(acc[ai][1][m][0] * fmax4(h10, flo), acc[ai][1][m][1] * fmax4(h11, flo)));
                if (m & 1) __builtin_amdgcn_sched_barrier(0); }
        }
    }
};
struct EpiResid { static constexpr bool PERM = true; EPI_NO_PRE
    bf16_t* XB; ss_t* SS;
    __device__ __forceinline__ void init(f32x4 (&acc)[2][2][4][2], const Unit& u, int wr, int wc, int fr, int fq) const {
        const int row0 = EPI_ROW0, col0 = u.pn * BM + 64 * wc + 8 * fq;
        EPI_FOR_AI_M { const bf16_t* rowp = XB + (size_t)(row0 + ai * HALF + m * 16) * DM + col0;
            unpack_f4x2(*(const u32x4*)rowp, acc[ai][0][m][0], acc[ai][0][m][1]); unpack_f4x2(*(const u32x4*)(rowp + 32), acc[ai][1][m][0], acc[ai][1][m][1]); }
    }
    __device__ __forceinline__ void operator()(const f32x4 (&acc)[2][2][4][2], const ss_t (&pre)[2], const Unit& u, int wr, int wc, int fr, int fq) const {
        EPI_FOR_AI_M { const size_t r0 = (size_t)(u.pm * BM + ai * HALF + wr * 64 + m * 16);
            st_pair((char*)(XB + r0 * DM + u.pn * BM + 64 * wc), (size_t)DM * 2, fr, fq, pack_f4x2(acc[ai][0][m][0], acc[ai][0][m][1]), pack_f4x2(acc[ai][1][m][0], acc[ai][1][m][1]));
            ss_add(SS, r0 + fr, sq8(acc[ai][0][m][0], acc[ai][0][m][1]) + sq8(acc[ai][1][m][0], acc[ai][1][m][1]), fq, fr); }
    }
};
struct EpiSwiglu { static constexpr bool PERM = true; EPI_ZERO_INIT
    bf16_t* H; const ss_t* SS; EPI_SS_PRE(SS)
    __device__ __forceinline__ void operator()(const f32x4 (&acc)[2][2][4][2], const ss_t (&pre)[2], const Unit& u, int wr, int wc, int fr, int fq) const {
        const int row0 = EPI_ROW0, col0 = u.pn * HALF + wc * 32 + 8 * fq;
        EPI_FOR_AI_M { const size_t row = (size_t)(row0 + ai * HALF + m * 16); const float rs = rstd_raw(pre_get(pre, ai * 4 + m, fr));
            const f32x4 g0 = acc[ai][0][m][0] * rs, g1 = acc[ai][0][m][1] * rs, u0 = acc[ai][1][m][0] * rs, u1 = acc[ai][1][m][1] * rs;
            *(u32x4*)(H + row * FF + col0) = pack_f4x2(g0 * sigmoid4(g0) * u0, g1 * sigmoid4(g1) * u1); }
    }
};
struct EpiPle { static constexpr bool PERM = true; EPI_ZERO_INIT EPI_SS_PRE(SSi)
    const bf16_t* XB; bf16_t* XO; const bf16_t* PP; const ss_t* SSi; ss_t* SSo;
    __device__ __forceinline__ void operator()(const f32x4 (&acc)[2][2][4][2], const ss_t (&pre)[2], const Unit& u, int wr, int wc, int fr, int fq) const {
        const int col0 = u.pn * BM + 64 * wc + 8 * fq;
        EPI_FOR_AI_M { const size_t r0 = (size_t)(u.pm * BM + ai * HALF + wr * 64 + m * 16), row = r0 + fr; const float rs = rstd_raw(pre_get(pre, ai * 4 + m, fr));
            f32x4 x00, x01, x10, x11, p00, p01, p10, p11; unpack_f4x2(*(const u32x4*)(XB + row * DM + col0), x00, x01); unpack_f4x2(*(const u32x4*)(XB + row * DM + col0 + 32), x10, x11);
            unpack_f4x2(*(const u32x4*)(PP + row * DM + col0), p00, p01); unpack_f4x2(*(const u32x4*)(PP + row * DM + col0 + 32), p10, p11);
            x00 += sigmoid4(acc[ai][0][m][0] * rs) * p00; x01 += sigmoid4(acc[ai][0][m][1] * rs) * p01; x10 += sigmoid4(acc[ai][1][m][0] * rs) * p10; x11 += sigmoid4(acc[ai][1][m][1] * rs) * p11;
            st_pair((char*)(XO + r0 * DM + u.pn * BM + 64 * wc), (size_t)DM * 2, fr, fq, pack_f4x2(x00, x01), pack_f4x2(x10, x11));
            ss_add(SSo, row, sq8(x00, x01) + sq8(x10, x11), fq, fr);
            if (m & 1) asm volatile("" ::: "memory"); }
    }
};
#undef EPI_ROW0
#undef EPI_FOR_AI_M
}

constexpr size_t MiB = 1u << 20;
constexpr size_t al1m(size_t x) { return (x + MiB - 1) / MiB * MiB; }
constexpr size_t WS_CTL = 0, CTL_ZERO_BYTES = 1 * MiB;
constexpr size_t SZ_WIN = (size_t)ICP * DM * 2, SZ_POOLW = (size_t)PWD * 256 * 2, SZ_LORA = (size_t)3072 * LK * 2, SZ_PPOOL = (size_t)DM * PWD * 2, SZ_PRWKV = (size_t)DM * RWD * 2,
                 SZ_WOUT = (size_t)DM * DM * 2, SZ_WGU = (size_t)2 * FF * DM * 2, SZ_WDN = (size_t)DM * FF * 2, SZ_WPG = (size_t)DM * DM * 2, SZ_WPP = (size_t)DM * PLE * 2;
constexpr size_t WS_WIN = 1 * MiB, WS_POOLW = WS_WIN + SZ_WIN, WS_LORA = WS_POOLW + SZ_POOLW, WS_PPOOL = WS_LORA + SZ_LORA, WS_PRWKV = WS_PPOOL + SZ_PPOOL, WS_WOUT = WS_PRWKV + SZ_PRWKV,
                 WS_WGU = WS_WOUT + SZ_WOUT, WS_WDN = WS_WGU + SZ_WGU, WS_WPG = WS_WDN + SZ_WDN, WS_WPP = WS_WPG + SZ_WPG, WS_WEND = WS_WPP + SZ_WPP;
constexpr size_t WS_PB = al1m(WS_WEND);
constexpr size_t WS_XN = al1m(WS_PB + (size_t)MT * PLE * 2);
constexpr size_t WS_AA = al1m(WS_XN + (size_t)MT * DM * 2);
constexpr size_t WS_GG = al1m(WS_AA + (size_t)MT * RWD * 2);
constexpr size_t WS_PP = al1m(WS_GG + (size_t)MT * RWD * 2);
constexpr size_t WS_PROJ = al1m(WS_PP + (size_t)MT * DM * 2);
constexpr size_t WS_HID = WS_PROJ;
constexpr size_t WS_D = al1m(WS_PROJ + (size_t)MT * ICP * 2);
constexpr size_t WS_LIN = al1m(WS_D + (size_t)MT * PWD * 2);
constexpr size_t WS_YA = al1m(WS_LIN + (size_t)MT * LK * 2);
constexpr size_t WS_DEC = al1m(WS_YA + (size_t)MT * PWD * 2);
constexpr size_t WS_BS = al1m(WS_DEC + (size_t)MT * RWD * 4);
constexpr size_t WS_Y = al1m(WS_BS + (size_t)MT * 16 * 4);
constexpr size_t SZ_BH = (size_t)MT * RWD * 2;
constexpr size_t WS_YB = al1m(WS_Y + (size_t)MT * RWD * 4);
constexpr size_t WS_TMP = al1m(WS_YB + SZ_BH);
constexpr size_t WS_MRG = al1m(WS_TMP + (size_t)MT * DM * 4);
constexpr size_t WS_SS = al1m(WS_MRG + (size_t)MT * DM * 2);
constexpr size_t WS_END_OLD = al1m(WS_MRG + (size_t)MT * DM * 2);
static_assert((size_t)MT * FF * 2 <= (size_t)MT * ICP * 2, "HID overlay");

constexpr size_t WS_XB2 = al1m(WS_SS + (size_t)3 * MT * 4);
constexpr size_t CBSZ = 12096, CB_BS = 12032, CB_P1T = 0, CB_RT = 2048, CB_BK = 4096, CB_VT = 8192, CB_P2T = 10240, CB_MBT = 10752, CB_MKT = 11264, CB_GC = 11776;
constexpr size_t CB_N = (size_t)(MT / 16) * 16;
static_assert(WS_MRG + (size_t)MT * DM * 2 - WS_TMP >= CB_N * CBSZ, "chunk blocks fit in TMP | MRG");
static_assert(WS_PRWKV == WS_PPOOL + (size_t)8 * 256 * PWD * 2 && PWD == RWD && (WS_YB - WS_YA) / 2 < (size_t)0x7fffffff, "the paired gate GEMM walks proj_pool | proj_rwkv as one [4096][1024] matrix");
constexpr size_t WS_END = al1m(WS_XB2 + (size_t)MT * DM * 2);
constexpr int CW_BAR = 4096;
constexpr int NWAVES = 8, NTHR = 512;
constexpr int RING_BYTES = 131072, LDSCTL_OFF = RING_BYTES, LDS_BYTES = 147456;

#define XB_TMO      128
#define XB_XCNT(j)  (256  + 64 * (j))
#define XB_XSUB(j)  (1280 + 64 * (j))
#define XB_XGEN(j)  (2304 + 64 * (j))
#define XB_TOP      3328
#define XB_TOPGEN   3392
#define XCD_BAR_WORDS 3456
#define XB_SPIN_CAP (1u << 18)

__device__ __forceinline__ unsigned xb_ld(unsigned* p)              { return __hip_atomic_load(p, __ATOMIC_RELAXED, __HIP_MEMORY_SCOPE_AGENT); }
__device__ __forceinline__ unsigned xb_add(unsigned* p, unsigned v) { return __hip_atomic_fetch_add(p, v, __ATOMIC_RELAXED, __HIP_MEMORY_SCOPE_AGENT); }
__device__ __forceinline__ unsigned xb_xcc_id() { return (unsigned)__builtin_amdgcn_s_getreg((3 << 11) | 20) & 0xFu; }
#define XB_SPIN(cond, bar) do { unsigned _sp = 0; while (cond) { __builtin_amdgcn_s_sleep(1); \
    if ((++_sp & 255u) == 0u) { if (xb_ld(&(bar)[XB_TMO])) break; if (_sp > XB_SPIN_CAP) { atomicAdd(&(bar)[XB_TMO], 1u); break; } } } } while (0)

struct XcdBarrier {
    unsigned* bar; unsigned x;
    volatile LAS unsigned* st;
};

__device__ __forceinline__ XcdBarrier xcd_barrier_post(unsigned* bar, volatile LAS unsigned* st) {
    XcdBarrier b; b.bar = bar; b.x = xb_xcc_id(); b.st = st;
    if (threadIdx.x == 0) (void)xb_add(&bar[XB_XCNT(b.x)], 1u);
    return b;
}
__device__ __forceinline__ void xcd_barrier_complete(unsigned* bar, unsigned x, unsigned& nloc, unsigned& nx) {
    const unsigned G = gridDim.x * gridDim.y * gridDim.z;
    unsigned sum, cnt, mine, sp = 0u;
    for (;;) {
        sum = 0u; cnt = 0u; mine = 0u;
#pragma unroll
        for (unsigned j = 0; j < 16; ++j) { const unsigned c = xb_ld(&bar[XB_XCNT(j)]); sum += c; cnt += (c > 0u) ? 1u : 0u; mine = (j == x) ? c : mine; }
        if (sum == G) break;
        __builtin_amdgcn_s_sleep(1);
        if ((++sp & 255u) == 0u) { if (xb_ld(&bar[XB_TMO])) break; if (sp > XB_SPIN_CAP) { atomicAdd(&bar[XB_TMO], 1u); break; } }
    }
    nloc = mine > 0u ? mine : 1u; nx = cnt > 0u ? cnt : 1u;
}

__device__ __forceinline__ void xcd_barrier(const XcdBarrier& b) {
    asm volatile("s_waitcnt vmcnt(0)" ::: "memory");
    __syncthreads();
    if (threadIdx.x == 0) {
        unsigned* bar = b.bar;
        __builtin_amdgcn_s_waitcnt(0);
        unsigned nloc = b.st[0], nx = b.st[1];
        if (nloc == 0u) { xcd_barrier_complete(bar, b.x, nloc, nx); b.st[0] = nloc; b.st[1] = nx; }
        const unsigned old = xb_add(&bar[XB_XSUB(b.x)], 1u);
        const unsigned gen = old / nloc;
        if (old + 1u == (gen + 1u) * nloc) {
            __builtin_amdgcn_fence(__ATOMIC_RELEASE, "agent");
            asm volatile("s_waitcnt vmcnt(0)" ::: "memory");
            const unsigned og = xb_add(&bar[XB_TOP], 1u);
            const unsigned tg = og / nx;
            if (og + 1u == (tg + 1u) * nx) xb_add(&bar[XB_TOPGEN], 1u);
            else XB_SPIN(xb_ld(&bar[XB_TOPGEN]) == tg, bar);
            __builtin_amdgcn_fence(__ATOMIC_ACQUIRE, "agent");
            xb_add(&bar[XB_XGEN(b.x)], 1u);
            asm volatile("s_waitcnt vmcnt(0)" ::: "memory");
        } else {
            XB_SPIN(xb_ld(&bar[XB_XGEN(b.x)]) == gen, bar);
            __builtin_amdgcn_fence(__ATOMIC_ACQUIRE, "agent");
            asm volatile("s_waitcnt vmcnt(0)" ::: "memory");
        }
    }
    __syncthreads();
}


struct Args {
    const float* in[33]; float* out; unsigned char* ws; int ph_lo, ph_hi;
};
struct Frame {
    LAS unsigned char* lds; int G;
    const LAS unsigned long long* ptab; float* out; unsigned char* ws;
};
#define GAS __attribute__((address_space(1)))
__device__ __forceinline__ const float* ldptr(const LAS unsigned long long* tab, int k) { const unsigned long long v = tab[k]; const unsigned lo = __builtin_amdgcn_readfirstlane((unsigned)v), hi = __builtin_amdgcn_readfirstlane((unsigned)(v >> 32));
    return (const float*)(const GAS float*)(((unsigned long long)hi << 32) | lo); }
__device__ __forceinline__ unsigned char* fresh(unsigned char* p) { GAS unsigned char* q = (GAS unsigned char*)p; asm volatile("" : "+s"(q)); return (unsigned char*)q; }
__device__ __forceinline__ int fresh_i(int v) { asm volatile("" : "+s"(v)); return v; }
#define INP(k) ldptr(F.ptab, (k))
#define PHASE_L const int l = fresh_i(l_in); (void)l;
#define PHASE_IDS int tid_ = threadIdx.x; asm volatile("" : "+v"(tid_)); const int tid = tid_, lane = tid & 63, wave = __builtin_amdgcn_readfirstlane(tid >> 6), gtid = blockIdx.x * NTHR + tid, gw = blockIdx.x * NWAVES + wave; (void)lane; (void)wave; (void)gtid; (void)gw;
#define VM_WAIT() asm volatile("s_waitcnt vmcnt(0)" ::: "memory")
#define LDS_WAIT() asm volatile("s_waitcnt lgkmcnt(0)" ::: "memory")
constexpr int NT_ALL_SHIFT = 9;

__device__ __forceinline__ void row_info(int m, int& b, int& t, bool& samp) { samp = m >= MPR; if (samp) { b = (m - MPR) >> 6; t = (m - MPR) & 63; } else { b = m >> 11; t = m & 2047; } }

__device__ __forceinline__ void transpose_item(const float* W, int N, bf16_t* WT, int ldk, int k0, int n0, int drow0, LAS float* scr, int lane, const float* cscale = nullptr, const float* rscale = nullptr) {
    f32x4 cs = (f32x4){1.f, 1.f, 1.f, 1.f}; if (cscale) cs = *(const f32x4*)(cscale + n0 + 4 * (lane & 7));
    const int c = lane & 7;
    f32x4 g0 = (f32x4){1.f, 1.f, 1.f, 1.f}, g1 = g0;
    if (rscale) { g0 = *(const f32x4*)(rscale + k0 + 8 * c); g1 = *(const f32x4*)(rscale + k0 + 8 * c + 4); }
    f32x4 v[8];
#pragma unroll
    for (int i = 0; i < 8; ++i) v[i] = *(const f32x4*)(W + (size_t)(k0 + 8 * i + (lane >> 3)) * N + n0 + 4 * (lane & 7));
#pragma unroll
    for (int i = 0; i < 8; ++i) { LAS float* d = scr + (8 * i + (lane >> 3)) * 33 + 4 * (lane & 7); const f32x4 t = v[i] * cs; d[0] = t.x; d[1] = t.y; d[2] = t.z; d[3] = t.w; }
    LDS_WAIT(); asm volatile("" ::: "memory");
#pragma unroll
    for (int j = 0; j < 4; ++j) { const int n = (lane >> 3) + 8 * j; const LAS float* sp = scr + (8 * c) * 33 + n;
        u32x4 o; o.x = cvt_pk_bf16(sp[0 * 33] * g0.x, sp[1 * 33] * g0.y); o.y = cvt_pk_bf16(sp[2 * 33] * g0.z, sp[3 * 33] * g0.w); o.z = cvt_pk_bf16(sp[4 * 33] * g1.x, sp[5 * 33] * g1.y); o.w = cvt_pk_bf16(sp[6 * 33] * g1.z, sp[7 * 33] * g1.w);
        *(u32x4*)(WT + (size_t)(drow0 + n) * ldk + k0 + 8 * c) = o; }
    LDS_WAIT(); asm volatile("" ::: "memory");
}
__device__ __forceinline__ void convert_weights(Frame& F, int l_in) {
    PHASE_IDS
    unsigned char* const wsl = fresh(F.ws);
    PHASE_L
    LAS float* scr = (LAS float*)(F.lds + wave * 16384);
    const int NGW = fresh_i(F.G) * NWAVES;
    unsigned char* ws = wsl;
    constexpr int I_WIN = (DM / 64) * (ICOLS / 32), I_PW = 4 * (256 / 64) * (256 / 32), I_PP = (PWD / 64) * (DM / 32), I_WO = (DM / 64) * (DM / 32), I_FG = (DM / 64) * (FF / 32),
                  I_FD = (FF / 64) * (DM / 32), I_PL = (PLE / 64) * (DM / 32);
    constexpr int NITEMS = I_WIN + I_PW + 2 * I_PP + I_WO + 2 * I_FG + I_FD + I_WO + I_PL;
    for (int it = gw; it < NITEMS; it += NGW) {
        int r = it;
        if (r < I_WIN) { const int nblk = ICOLS / 32, kb = r / nblk, nb = r % nblk, n0 = nb * 32; transpose_item(INP(8) + (size_t)l * DM * ICOLS, ICOLS, (bf16_t*)(ws + WS_WIN), DM, kb * 64, n0, n0 < 4384 ? n0 : n0 + 224, scr, lane, nullptr, INP(7) + (size_t)l * DM); continue; } r -= I_WIN;
        if (r < I_PW) { const int g = r >> 5, rr = r & 31, kb = rr >> 3, nb = rr & 7; transpose_item(INP(10) + ((size_t)l * 4 + g) * 65536, 256, (bf16_t*)(ws + WS_POOLW) + (size_t)g * 65536, 256, kb * 64, nb * 32, nb * 32, scr, lane, INP(11) + (size_t)l * PWD + g * 256); continue; } r -= I_PW;
        if (r < I_PP) { const int nblk = DM / 32, kb = r / nblk, nb = r % nblk; transpose_item(INP(22) + (size_t)l * PWD * DM, DM, (bf16_t*)(ws + WS_PPOOL), PWD, kb * 64, nb * 32, nb * 32, scr, lane); continue; } r -= I_PP;
        if (r < I_PP) { const int nblk = DM / 32, kb = r / nblk, nb = r % nblk; transpose_item(INP(23) + (size_t)l * RWD * DM, DM, (bf16_t*)(ws + WS_PRWKV), RWD, kb * 64, nb * 32, nb * 32, scr, lane); continue; } r -= I_PP;
        if (r < I_WO) { const int nblk = DM / 32, kb = r / nblk, nb = r % nblk; transpose_item(INP(24) + (size_t)l * DM * DM, DM, (bf16_t*)(ws + WS_WOUT), DM, kb * 64, nb * 32, nb * 32, scr, lane); continue; } r -= I_WO;
        if (r < I_FG) { const int nblk = FF / 32, kb = r / nblk, nb = r % nblk, n0 = nb * 32; transpose_item(INP(26) + (size_t)l * DM * FF, FF, (bf16_t*)(ws + WS_WGU), DM, kb * 64, n0, 256 * (n0 >> 7) + 64 * ((n0 & 127) >> 5), scr, lane, nullptr, INP(25) + (size_t)l * DM); continue; } r -= I_FG;
        if (r < I_FG) { const int nblk = FF / 32, kb = r / nblk, nb = r % nblk, n0 = nb * 32; transpose_item(INP(27) + (size_t)l * DM * FF, FF, (bf16_t*)(ws + WS_WGU), DM, kb * 64, n0, 256 * (n0 >> 7) + 64 * ((n0 & 127) >> 5) + 32, scr, lane, nullptr, INP(25) + (size_t)l * DM); continue; } r -= I_FG;
        if (r < I_FD) { const int nblk = DM / 32, kb = r / nblk, nb = r % nblk; transpose_item(INP(28) + (size_t)l * FF * DM, DM, (bf16_t*)(ws + WS_WDN), FF, kb * 64, nb * 32, nb * 32, scr, lane); continue; } r -= I_FD;
        if (r < I_WO) { const int nblk = DM / 32, kb = r / nblk, nb = r % nblk; transpose_item(INP(30) + (size_t)l * DM * DM, DM, (bf16_t*)(ws + WS_WPG), DM, kb * 64, nb * 32, nb * 32, scr, lane, nullptr, INP(29) + (size_t)l * DM); continue; } r -= I_WO;
        { const int nblk = DM / 32, kb = r / nblk, nb = r % nblk; transpose_item(INP(31) + (size_t)l * PLE * DM, DM, (bf16_t*)(ws + WS_WPP), PLE, kb * 64, nb * 32, nb * 32, scr, lane); }
    }
    const int NT = fresh_i(F.G) * NTHR;
    { u32x4* z = (u32x4*)((bf16_t*)(ws + WS_WIN) + (size_t)4384 * DM); u32x4 zz = (u32x4){0u, 0u, 0u, 0u}; asm volatile("" : "+v"(zz));
      for (int i = gtid; i < 224 * DM * 2 / 16; i += NT) z[i] = zz; }
    { bf16_t* LT = (bf16_t*)(ws + WS_LORA); const float* wd = INP(13) + (size_t)l * 64 * RWD; const float* wa = INP(15) + (size_t)l * 64 * RWD; const float* wg = INP(16) + (size_t)l * 160 * RWD;
      for (int i = gtid; i < 3072 * (LK / 8); i += NT) { const int n = i / (LK / 8), k0 = (i % (LK / 8)) * 8; const int kind = n >> 10, c = n & 1023; float f[8];
#pragma unroll
          for (int j = 0; j < 8; ++j) { const int k = k0 + j; float v = 0.f;
              if (kind == 0) { if (k < 64) v = wd[(size_t)k * RWD + c]; }
              else if (kind == 1) { if (k >= 64 && k < 128) v = wa[(size_t)(k - 64) * RWD + c]; }
              else { if (k >= 128 && k < 288) v = wg[(size_t)(k - 128) * RWD + c]; }
              f[j] = v; }
          *(u32x4*)(LT + (size_t)n * LK + k0) = pack8(f); } }
    { bf16_t* PB = (bf16_t*)(ws + WS_PB); const float* pp = INP(5) + (size_t)l * MPR * PLE; const float* ps = INP(6) + (size_t)l * (MT - MPR) * PLE;
      for (int i = gtid; i < MT * PLE / 8; i += NT) { const size_t e = (size_t)i * 8; const float* src = e < (size_t)MPR * PLE ? pp + e : ps + (e - (size_t)MPR * PLE);
          const f32x4 a = *(const f32x4*)src, b = *(const f32x4*)(src + 4); *(u32x4*)(PB + e) = pg8::pack_f4x2(a, b); } }
}

__device__ __forceinline__ void xb_from_input(Frame& F) {
    PHASE_IDS
    unsigned char* const wsl = fresh(F.ws);
    const int NGW = fresh_i(F.G) * NWAVES; bf16_t* XB = (bf16_t*)(wsl + WS_XN); pg8::ss_t* SS = (pg8::ss_t*)(wsl + WS_SS);
    for (int m = gw; m < MT; m += NGW) {
        const float* src = m < MPR ? INP(0) + (size_t)m * DM : INP(1) + (size_t)(m - MPR) * DM;
        f32x4 v[8]; float s = 0.f;
#pragma unroll
        for (int j = 0; j < 8; ++j) { v[j] = *(const f32x4*)(src + 4 * lane + 256 * j); s += (v[j].x * v[j].x + v[j].y * v[j].y) + (v[j].z * v[j].z + v[j].w * v[j].w); }
        s = wave_sum(s);
        if (lane == 0) SS[m] = pg8::ss_fix(s);
#pragma unroll
        for (int j = 0; j < 8; ++j) { u32x2 w; w.x = cvt_pk_bf16(v[j].x, v[j].y); w.y = cvt_pk_bf16(v[j].z, v[j].w); *(u32x2*)(XB + (size_t)m * DM + 4 * lane + 256 * j) = w; }
    }
}
__device__ __forceinline__ void final_norm(Frame& F, const float* gain) {
    PHASE_IDS
    unsigned char* const wsl = fresh(F.ws);
    const int NGW = fresh_i(F.G) * NWAVES; const bf16_t* XB = (const bf16_t*)(wsl + ((NL & 1) ? WS_XB2 : WS_XN));
    f32x4 g[8];
#pragma unroll
    for (int j = 0; j < 8; ++j) g[j] = *(const f32x4*)(gain + 4 * lane + 256 * j);
    for (int m = gw; m < MT; m += NGW) {
        f32x4 v[8]; float s = 0.f;
#pragma unroll
        for (int j = 0; j < 8; ++j) { const u32x2 w = *(const u32x2*)(XB + (size_t)m * DM + 4 * lane + 256 * j); v[j] = (f32x4){bf_lo(w.x), bf_hi(w.x), bf_lo(w.y), bf_hi(w.y)};
            s += (v[j].x * v[j].x + v[j].y * v[j].y) + (v[j].z * v[j].z + v[j].w * v[j].w); }
        const float rstd = __builtin_amdgcn_rsqf(wave_sum(s) * (1.0f / DM) + NORM_EPS);
#pragma unroll
        for (int j = 0; j < 8; ++j) *(f32x4*)(F.out + (size_t)m * DM + 4 * lane + 256 * j) = v[j] * rstd * g[j];
    }
}

__device__ __forceinline__ void load_z(float (&z)[8], const bf16_t* PROJ, const float* past, int m0, int t, bool samp, int c0) {
    if (t >= 0) { unpack8(*(const u32x4*)(PROJ + (size_t)(m0 + t) * ICP + c0), z); }
    else if (samp) { const float* p = past + (size_t)(15 + t) * PWD + c0; const f32x4 a = *(const f32x4*)p, b = *(const f32x4*)(p + 4); z[0] = a.x; z[1] = a.y; z[2] = a.z; z[3] = a.w; z[4] = b.x; z[5] = b.y; z[6] = b.z; z[7] = b.w; }
    else {
#pragma unroll
        for (int j = 0; j < 8; ++j) z[j] = 0.f; }
}
__device__ __forceinline__ void prep1_phase(Frame& F, int l_in) {
    PHASE_IDS
    unsigned char* const wsl = fresh(F.ws);
    PHASE_L
    const int NT = fresh_i(F.G) * NTHR; const bf16_t* PROJ = (const bf16_t*)(wsl + WS_PROJ);
    { bf16_t* D = (bf16_t*)(wsl + WS_D);
      for (int it = gtid; it < (MT / 16) * 128; it += NT) {
          const int oct = it & 127, run = it >> 7, mrow = run * 16, c0 = oct * 8, win = 2 << (c0 >> 8);
          int b, t0; bool samp; row_info(mrow, b, t0, samp);
          const int T = samp ? TS : TP, mseq = mrow - t0;
          const float* past = INP(3) + ((size_t)l * 8 + b) * 15 * PWD;
          float* npool = F.out + (samp ? O_POS : O_POP) + ((size_t)l * 8 + b) * 15 * PWD;
          float S[8], z[8];
#pragma unroll
          for (int j = 0; j < 8; ++j) S[j] = 0.f;
          for (int j = 1; j < win; ++j) { load_z(z, PROJ, past, mseq, t0 - j, samp, c0);
#pragma unroll
              for (int q = 0; q < 8; ++q) S[q] += z[q]; }
          for (int i = 0; i < 16; ++i) { const int t = t0 + i; float cur[8]; load_z(cur, PROJ, past, mseq, t, samp, c0);
              const int cnt = samp ? win : (t + 1 < win ? t + 1 : win); const float inv = 1.0f / (float)cnt; float d[8];
#pragma unroll
              for (int q = 0; q < 8; ++q) { S[q] += cur[q]; d[q] = S[q] * inv - cur[q]; }
              *(u32x4*)(D + (size_t)(mseq + t) * PWD + c0) = pack8(d);
              if (t >= T - 15) { float* o = npool + (size_t)(t - (T - 15)) * PWD + c0; *(f32x4*)o = (f32x4){cur[0], cur[1], cur[2], cur[3]}; *(f32x4*)(o + 4) = (f32x4){cur[4], cur[5], cur[6], cur[7]}; }
              load_z(z, PROJ, past, mseq, t - win + 1, samp, c0);
#pragma unroll
              for (int q = 0; q < 8; ++q) S[q] -= z[q]; }
      } }
    { bf16_t* LIN = (bf16_t*)(wsl + WS_LIN); const float* mu = INP(9) + (size_t)l * RPJ + 3072;
      for (int it = gtid; it < MT * (LK / 8); it += NT) {
          const int m = it / (LK / 8), c0 = (it % (LK / 8)) * 8; float o[8];
          if (c0 >= 288) {
#pragma unroll
              for (int j = 0; j < 8; ++j) o[j] = 0.f;
          } else {
              int b, t; bool samp; row_info(m, b, t, samp);
              float cur[8], prv[8]; unpack8(*(const u32x4*)(PROJ + (size_t)m * ICP + 4096 + c0), cur);
              if (t > 0) unpack8(*(const u32x4*)(PROJ + (size_t)(m - 1) * ICP + 4096 + c0), prv);
              else if (samp) { const float* p = INP(2) + ((size_t)l * 8 + b) * RPJ + 3072 + c0;
#pragma unroll
                  for (int j = 0; j < 8; ++j) prv[j] = p[j]; }
              else {
#pragma unroll
                  for (int j = 0; j < 8; ++j) prv[j] = 0.f; }
#pragma unroll
              for (int j = 0; j < 8; ++j) { const float xm = cur[j] + (prv[j] - cur[j]) * mu[c0 + j]; o[j] = c0 < 64 ? tanhf_(xm) : (c0 < 128 ? xm : sigmoidf_(xm)); }
          }
          *(u32x4*)(LIN + (size_t)m * LK + c0) = pack8(o);
      } }
    { pg8::ss_t* SS = (pg8::ss_t*)(wsl + WS_SS); for (int i = gtid; i < 3 * MT; i += NT) SS[i] = 0u; }
    for (int it = gtid; it < 16 * RPJ; it += NT) { const int s = it / RPJ, c = it % RPJ; const int mlast = s < 8 ? s * TP + TP - 1 : MPR + (s - 8) * TS + TS - 1;
        F.out[(s < 8 ? O_SHP : O_SHS) + ((size_t)l * 8 + (s & 7)) * RPJ + c] = __uint_as_float((unsigned)PROJ[(size_t)mlast * ICP + 1024 + c] << 16); }
}

__device__ __forceinline__ unsigned char* cb_ptr(unsigned char* ws, size_t i) { return ws + WS_TMP + i * CBSZ; }
__device__ __forceinline__ float sum16(float x) { x += dpp_f<0xB1>(x); x += dpp_f<0x4E>(x); x += dpp_f<0x141>(x); x += dpp_f<0x140>(x); return x; }
__device__ __forceinline__ f32x4 mfma16(bf16x8 a, bf16x8 b, f32x4 c) { return __builtin_amdgcn_mfma_f32_16x16x32_bf16(a, b, c, 0, 0, 0); }
__device__ __forceinline__ bf16x8 mk8(u32x2 lo, u32x2 hi) { u32x4 w = (u32x4){lo.x, lo.y, hi.x, hi.y}; return __builtin_bit_cast(bf16x8, w); }
typedef __bf16 bf16x2_c __attribute__((ext_vector_type(2)));
__device__ __forceinline__ unsigned cvt_pk_c(float lo, float hi) { const f32x2 v = (f32x2){lo, hi}; const bf16x2_c b = __builtin_convertvector(v, bf16x2_c); return __builtin_bit_cast(unsigned, b); }
__device__ __forceinline__ u32x2 pk4(f32x4 v) { return (u32x2){cvt_pk_c(v.x, v.y), cvt_pk_c(v.z, v.w)}; }
__device__ __forceinline__ unsigned short bf1(float f) { return (unsigned short)(cvt_pk_c(f, 0.f) & 0xffffu); }

__device__ __forceinline__ void spre_phase(Frame& F, int l_in) {
    PHASE_IDS
    unsigned char* const wsl = fresh(F.ws);
    PHASE_L
    const int NGW = fresh_i(F.G) * NWAVES;
    LAS unsigned char* L = F.lds + wave * 16384;
    const bf16_t* PROJ = (const bf16_t*)(wsl + WS_PROJ); const bf16_t* AA = (const bf16_t*)(wsl + WS_AA); const float* DEC = (const float*)(wsl + WS_DEC);
    const int fr = lane & 15, fq = lane >> 4;
    const float* mu = INP(9) + (size_t)l * RPJ;
#define SP_LOAD(it_, R, K, V, A, W, PR, PK, PV) do { const int h_ = (it_) & 15, m0_ = ((it_) >> 4) * 16, ch_ = h_ * 64 + lane; int b_, t0_; bool samp_; row_info(m0_, b_, t0_, samp_); \
        _Pragma("unroll") for (int t = 0; t < 16; ++t) { const size_t mm = (size_t)(m0_ + t); const bf16_t* pc = PROJ + mm * ICP + 1024 + ch_; R[t] = pc[0]; K[t] = pc[1024]; V[t] = pc[2048]; A[t] = AA[mm * RWD + ch_]; W[t] = DEC[mm * RWD + ch_]; } \
        if (t0_ > 0) { const bf16_t* pc = PROJ + (size_t)(m0_ - 1) * ICP + 1024 + ch_; PR = __uint_as_float((unsigned)pc[0] << 16); PK = __uint_as_float((unsigned)pc[1024] << 16); PV = __uint_as_float((unsigned)pc[2048] << 16); } \
        else if (samp_) { const float* sp = INP(2) + ((size_t)l * 8 + b_) * RPJ + ch_; PR = sp[0]; PK = sp[1024]; PV = sp[2048]; } \
        else { PR = 0.f; PK = 0.f; PV = 0.f; } } while (0)
    unsigned short cr[16], ck[16], cv[16], ca[16], nr[16], nk[16], nv[16], na[16]; float cw[16], nw[16]; float pr = 0.f, pk = 0.f, pv = 0.f, npr = 0.f, npk = 0.f, npv = 0.f;
    if (gw < (int)CB_N) SP_LOAD(gw, cr, ck, cv, ca, cw, pr, pk, pv);
    for (int it = gw; it < (int)CB_N; it += NGW) {
        const int h = it & 15, crow = it >> 4, m0 = crow * 16, ch = h * 64 + lane;
        unsigned char* cb = cb_ptr(wsl, (size_t)it);
        const float mur = mu[ch], muk = mu[1024 + ch], muv = mu[2048 + ch];
        const float ckk = (INP(17) + (size_t)l * RWD)[ch], cka = (INP(18) + (size_t)l * RWD)[ch], crk = (INP(19) + (size_t)l * RWD)[ch];
        { const int itn = it + NGW; if (itn < (int)CB_N) SP_LOAD(itn, nr, nk, nv, na, nw, npr, npk, npv); }
        float g = 1.0f; unsigned at2[8], bt2[8], kt2[8], vt2[8]; float hold_a = 0.f, hold_b = 0.f, hold_k = 0.f, hold_v = 0.f;
#pragma unroll
        for (int t = 0; t < 16; ++t) {
            const float xr = __uint_as_float((unsigned)cr[t] << 16), xk = __uint_as_float((unsigned)ck[t] << 16), xv = __uint_as_float((unsigned)cv[t] << 16), av = __uint_as_float((unsigned)ca[t] << 16);
            const float r = xr + (pr - xr) * mur, kx = xk + (pk - xk) * muk, vv = xv + (pv - xv) * muv; pr = xr; pk = xk; pv = xv;
            float kkv = kx * ckk; const float ss = wave_sum(kkv * kkv); kkv *= __builtin_amdgcn_rsqf(fmaxf(ss, 1e-24f));
            const float kh = kx * (1.0f + (av - 1.0f) * cka), bb = kkv * av; const float bsum = wave_sum(r * kh * crk);
            if (lane == 0) *(float*)(cb + CB_BS + t * 4) = bsum;
            const float a_t = -kkv * g; g *= cw[t]; const float ig = __builtin_amdgcn_rcpf(g); const float b_t = bb * ig, k_t = kh * ig, r_t = r * g;
            *(LAS unsigned short*)(L + t * 144 + lane * 2) = bf1(a_t); *(LAS unsigned short*)(L + 2304 + t * 144 + lane * 2) = bf1(b_t);
            *(LAS unsigned short*)(L + 4608 + t * 144 + lane * 2) = bf1(k_t); *(LAS unsigned short*)(L + 6912 + t * 144 + lane * 2) = bf1(r_t);
            if (t & 1) { at2[t >> 1] = cvt_pk_c(hold_a, a_t); bt2[t >> 1] = cvt_pk_c(hold_b, b_t); kt2[t >> 1] = cvt_pk_c(hold_k, k_t); vt2[t >> 1] = cvt_pk_c(hold_v, vv); }
            else { hold_a = a_t; hold_b = b_t; hold_k = k_t; hold_v = vv; }
        }
        *(LAS u32x4*)(L + 9216 + lane * 32) = (u32x4){at2[0], at2[1], at2[2], at2[3]}; *(LAS u32x4*)(L + 9216 + lane * 32 + 16) = (u32x4){at2[4], at2[5], at2[6], at2[7]};
        { u32x4* o = (u32x4*)(cb + CB_BK + lane * 64);
#pragma unroll
          for (int q = 0; q < 4; ++q) o[q] = (u32x4){bt2[2 * q], bt2[2 * q + 1], kt2[2 * q], kt2[2 * q + 1]}; }
        { u32x4* o = (u32x4*)(cb + CB_VT + lane * 32); o[0] = (u32x4){vt2[0], vt2[1], vt2[2], vt2[3]}; o[1] = (u32x4){vt2[4], vt2[5], vt2[6], vt2[7]}; }
        *(float*)(cb + CB_GC + lane * 4) = g;
        asm volatile("" ::: "memory");
#define SP_ROWS(off, j) (*(const LAS bf16x8*)(L + (off) + fr * 144 + (j) * 64 + fq * 16))
        f32x4 nD = (f32x4){0.f, 0.f, 0.f, 0.f}, makD = nD, mrbD = nD, mrkD = nD;
#pragma unroll
        for (int j = 0; j < 2; ++j) { const bf16x8 fa = SP_ROWS(0, j), fb = SP_ROWS(2304, j), fk = SP_ROWS(4608, j), fR = SP_ROWS(6912, j);
            nD = mfma16(fb, fa, nD); makD = mfma16(fk, fa, makD); mrbD = mfma16(fb, fR, mrbD); mrkD = mfma16(fk, fR, mrkD); }
#pragma unroll
        for (int rr = 0; rr < 4; ++rr) { const int s = 4 * fq + rr; if (s >= fr) { nD[rr] = 0.f; makD[rr] = 0.f; } if (s > fr) { mrbD[rr] = 0.f; mrkD[rr] = 0.f; } }
        { const u32x2 mb = pk4(mrbD), mk = pk4(mrkD); *(u32x4*)(cb + CB_MBT + (fr * 4 + fq) * 16) = (u32x4){mb.x, mb.y, mk.x, mk.y}; }
#define SP_WR_RM(off, D) do { _Pragma("unroll") for (int rr = 0; rr < 4; ++rr) *(LAS unsigned short*)(L + (off) + (4 * fq + rr) * 32 + fr * 2) = bf1((D)[rr]); } while (0)
#define SP_WR_TR(off, D) do { *(LAS u32x2*)(L + (off) + fr * 32 + fq * 8) = pk4(D); } while (0)
#define SP_FRAG16(off) (fq < 2 ? *(const LAS bf16x8*)(L + (off) + fr * 32 + fq * 16) : (bf16x8){0, 0, 0, 0, 0, 0, 0, 0})
        SP_WR_RM(13568, nD); SP_WR_TR(14080, nD); SP_WR_RM(15616, makD); asm volatile("" ::: "memory");
        f32x4 TD = nD;
#pragma unroll
        for (int rr = 0; rr < 4; ++rr) if (4 * fq + rr == fr) TD[rr] += 1.0f;
#pragma unroll
        for (int itp = 0; itp < 3; ++itp) {
            SP_WR_RM(14592, TD); asm volatile("" ::: "memory");
            const f32x4 p2 = mfma16(SP_FRAG16(13568), SP_FRAG16(14080), (f32x4){0.f, 0.f, 0.f, 0.f}); asm volatile("" ::: "memory");
            SP_WR_RM(13568, p2); SP_WR_TR(14080, p2); asm volatile("" ::: "memory");
            TD = mfma16(SP_FRAG16(14592), SP_FRAG16(14080), TD); asm volatile("" ::: "memory");
        }
        SP_WR_TR(15104, TD); asm volatile("" ::: "memory");
        { const bf16x8 ftt = SP_FRAG16(15104);
#pragma unroll
          for (int blk = 0; blk < 4; ++blk) { const bf16x8 fb = fq < 2 ? *(const LAS bf16x8*)(L + 9216 + (16 * blk + fr) * 32 + fq * 16) : (bf16x8){0, 0, 0, 0, 0, 0, 0, 0};
              const f32x4 d = mfma16(ftt, fb, (f32x4){0.f, 0.f, 0.f, 0.f});
#pragma unroll
              for (int rr = 0; rr < 4; ++rr) *(LAS unsigned short*)(L + 11264 + (4 * fq + rr) * 144 + (16 * blk + fr) * 2) = bf1(d[rr]); }
          const f32x4 p2 = mfma16(SP_FRAG16(15616), ftt, (f32x4){0.f, 0.f, 0.f, 0.f});
          *(u32x2*)(cb + CB_P2T + fr * 32 + fq * 8) = pk4(p2); }
        asm volatile("" ::: "memory");
#pragma unroll
        for (int q = 0; q < 2; ++q) { const int pc = lane + 64 * q, pcc = pc >> 6, pt = (pc >> 2) & 15, pf = pc & 3;
            const u32x2 a0 = *(const LAS u32x2*)(L + 11264 + pt * 144 + (32 * pcc + 4 * pf) * 2), a1 = *(const LAS u32x2*)(L + 11264 + pt * 144 + (32 * pcc + 16 + 4 * pf) * 2);
            const u32x2 r0 = *(const LAS u32x2*)(L + 6912 + pt * 144 + (32 * pcc + 4 * pf) * 2), r1 = *(const LAS u32x2*)(L + 6912 + pt * 144 + (32 * pcc + 16 + 4 * pf) * 2);
            *(u32x4*)(cb + CB_P1T + pc * 16) = (u32x4){a0.x, a0.y, a1.x, a1.y}; *(u32x4*)(cb + CB_RT + pc * 16) = (u32x4){r0.x, r0.y, r1.x, r1.y}; }
        asm volatile("" ::: "memory");
#pragma unroll
        for (int t = 0; t < 16; ++t) { cr[t] = nr[t]; ck[t] = nk[t]; cv[t] = nv[t]; ca[t] = na[t]; cw[t] = nw[t]; }
        pr = npr; pk = npk; pv = npv;
#undef SP_ROWS
#undef SP_LOAD
#undef SP_WR_RM
#undef SP_WR_TR
#undef SP_FRAG16
    }
}

constexpr int SQ_D = 5, SQ_SLOT = 14336, SQ_NSLOT = 7, SQ_DUMP = SQ_NSLOT * SQ_SLOT, SQ_YBUF = SQ_DUMP + 2048;
__device__ __forceinline__ void sseq_phase(Frame& F, int l_in) {
    PHASE_IDS
    unsigned char* const wsl = fresh(F.ws);
    PHASE_L
    const bf16_t* GG = (const bf16_t*)(wsl + WS_GG); bf16_t* YB = (bf16_t*)(wsl + WS_YB);
    const bool is_cons = wave < 4;
    const int fr = lane & 15, fq = lane >> 4, vrow = (wave & 3) * 16 + fr, lw = wave & 3;
    for (int u = blockIdx.x; u < 256; u += fresh_i(F.G)) {
        const bool samp = u >= 128; const int h = u & 15, b = (u >> 4) & 7;
        const int T = samp ? TS : TP, m0 = samp ? MPR + b * TS : b * TP, nch = T / 16, crow0 = m0 / 16;
        f32x4 sreg[4];
        if (samp) { const float* sp = INP(4) + ((((size_t)l * 8 + b) * 16 + h) * 64 + vrow) * 64 + 4 * fq;
#pragma unroll
            for (int kb = 0; kb < 4; ++kb) sreg[kb] = *(const f32x4*)(sp + 16 * kb); }
        else {
#pragma unroll
            for (int kb = 0; kb < 4; ++kb) sreg[kb] = (f32x4){0.f, 0.f, 0.f, 0.f}; }
        const f32x4 gng = *(const f32x4*)(INP(20) + (size_t)l * RWD + h * 64 + 4 * fr), gnb = *(const f32x4*)(INP(21) + (size_t)l * RWD + h * 64 + 4 * fr);
#define SQ_ISSUE(c) do { const unsigned char* src = cb_ptr(wsl, (size_t)(crow0 + (c)) * 16 + h) + (lw * 3) * 1024 + lane * 16; LAS unsigned char* dst = F.lds + ((c) % SQ_NSLOT) * SQ_SLOT + (lw * 3) * 1024; \
        _Pragma("unroll") for (int i = 0; i < 3; ++i) __builtin_amdgcn_global_load_lds((const unsigned*)(src + i * 1024), (LAS unsigned*)(dst + i * 1024), 16, 0, 0); \
        if (lw < 2) __builtin_amdgcn_global_load_lds((const unsigned*)((const unsigned char*)(GG + (size_t)(m0 + (c) * 16 + 8 * lw + (lane >> 3)) * RWD + h * 64) + (lane & 7) * 16), (LAS unsigned*)(F.lds + ((c) % SQ_NSLOT) * SQ_SLOT + 12288 + lw * 1024), 16, 0, 0); \
        else __builtin_amdgcn_global_load_lds((const unsigned*)src, (LAS unsigned*)(F.lds + SQ_DUMP + (lw - 2) * 1024), 16, 0, 0); } while (0)
#define SQ_WAIT(k) do { switch (k) { case 0: asm volatile("s_waitcnt vmcnt(0)" ::: "memory"); break; case 1: asm volatile("s_waitcnt vmcnt(4)" ::: "memory"); break; case 2: asm volatile("s_waitcnt vmcnt(8)" ::: "memory"); break; \
        case 3: asm volatile("s_waitcnt vmcnt(12)" ::: "memory"); break; default: asm volatile("s_waitcnt vmcnt(16)" ::: "memory"); break; } } while (0)
#define SQ_POST(c) do { const LAS unsigned char* Bp = F.lds + ((c) % SQ_NSLOT) * SQ_SLOT; const int tt = 4 * lw + fq; \
        const f32x4 y4 = *(const LAS f32x4*)(F.lds + SQ_YBUF + ((c) & 1) * 4096 + (tt * 64 + 4 * fr) * 4); \
        const float mean = sum16((y4.x + y4.y) + (y4.z + y4.w)) * (1.0f / 64.0f); const f32x4 dv = y4 - mean; \
        const float rstd = __builtin_amdgcn_rsqf(sum16((dv.x * dv.x + dv.y * dv.y) + (dv.z * dv.z + dv.w * dv.w)) * (1.0f / 64.0f) + GN_EPS); \
        const float bs = *(const LAS float*)(Bp + CB_BS + tt * 4); const u32x2 gq = *(const LAS u32x2*)(Bp + 12288 + tt * 128 + fr * 8); \
        f32x4 vv; _Pragma("unroll") for (int j = 0; j < 4; ++j) vv[j] = __uint_as_float((unsigned)(*(const LAS unsigned short*)(Bp + CB_VT + (4 * fr + j) * 32 + tt * 2)) << 16); \
        const f32x4 o = (dv * rstd * gng + gnb + bs * vv) * (f32x4){bf_lo(gq.x), bf_hi(gq.x), bf_lo(gq.y), bf_hi(gq.y)}; \
        *(u32x2*)(YB + (size_t)(m0 + (c) * 16 + tt) * RWD + h * 64 + 4 * fr) = (u32x2){cvt_pk_bf16(o.x, o.y), cvt_pk_bf16(o.z, o.w)}; } while (0)
        __syncthreads();
        if (is_cons) { const int np = nch < SQ_D ? nch : SQ_D; for (int c = 0; c < np; ++c) SQ_ISSUE(c); SQ_WAIT(np > 2 ? np - 2 : 0); }
        __syncthreads();
        u32x2 vt = (u32x2){0u, 0u}; const u32x2 z2 = (u32x2){0u, 0u}; bf16x8 aP2, aP10, aP11, aR0, aR1, aM, aBK[4]; f32x4 gc[4];
#define SQ_KA(off, cc) (*(const LAS bf16x8*)(B + (off) + (((cc) * 16 + fr) * 4 + fq) * 16))
#define SQ_OPS(c) do { const LAS unsigned char* B = F.lds + ((c) % SQ_NSLOT) * SQ_SLOT; vt = *(const LAS u32x2*)(B + CB_VT + vrow * 32 + fq * 8); \
        aP2 = mk8(*(const LAS u32x2*)(B + CB_P2T + fr * 32 + fq * 8), z2); aP10 = SQ_KA(CB_P1T, 0); aP11 = SQ_KA(CB_P1T, 1); aR0 = SQ_KA(CB_RT, 0); aR1 = SQ_KA(CB_RT, 1); aM = *(const LAS bf16x8*)(B + CB_MBT + (fr * 4 + fq) * 16); \
        _Pragma("unroll") for (int kb = 0; kb < 4; ++kb) { aBK[kb] = *(const LAS bf16x8*)(B + CB_BK + ((16 * kb + fr) * 4 + fq) * 16); gc[kb] = *(const LAS f32x4*)(B + CB_GC + (16 * kb + 4 * fq) * 4); } } while (0)
        if (is_cons) SQ_OPS(0);
        for (int c = 0; c < nch; ++c) {
            if (is_cons) {
                if (c + SQ_D < nch) SQ_ISSUE(c + SQ_D);
                asm volatile("s_waitcnt lgkmcnt(0)" ::: "memory"); __builtin_amdgcn_sched_barrier(0);
                const bf16x8 sB0 = mk8(pk4(sreg[0]), pk4(sreg[1])), sB1 = mk8(pk4(sreg[2]), pk4(sreg[3]));
                f32x4 uD = mfma16(aP2, mk8(vt, z2), (f32x4){0.f, 0.f, 0.f, 0.f});
                uD = mfma16(aP10, sB0, uD); uD = mfma16(aP11, sB1, uD);
                const bf16x8 uvB = mk8(pk4(uD), vt);
                f32x4 nS[4];
#pragma unroll
                for (int kb = 0; kb < 4; ++kb) nS[kb] = mfma16(aBK[kb], uvB, sreg[kb]);
                f32x4 yD = mfma16(aM, uvB, (f32x4){0.f, 0.f, 0.f, 0.f});
                yD = mfma16(aR0, sB0, yD); yD = mfma16(aR1, sB1, yD);
#pragma unroll
                for (int kb = 0; kb < 4; ++kb) sreg[kb] = nS[kb] * gc[kb];
                { LAS float* yo = (LAS float*)(F.lds + SQ_YBUF + (c & 1) * 4096) + (4 * fq) * 64 + vrow; yo[0] = yD[0]; yo[64] = yD[1]; yo[128] = yD[2]; yo[192] = yD[3]; }
                asm volatile("s_waitcnt lgkmcnt(0)" ::: "memory"); __builtin_amdgcn_sched_barrier(0);
                if (c + 1 < nch) SQ_OPS(c + 1);
                if (c + 2 < nch) { const int last = c + SQ_D < nch ? c + SQ_D : nch - 1; SQ_WAIT(last - (c + 2)); }
            } else {
                if (c > 0) SQ_POST(c - 1);
                asm volatile("s_waitcnt lgkmcnt(0)" ::: "memory");
            }
            __builtin_amdgcn_s_barrier(); asm volatile("" ::: "memory");
        }
#undef SQ_KA
#undef SQ_OPS
        if (!is_cons) SQ_POST(nch - 1);
#undef SQ_ISSUE
#undef SQ_WAIT
#undef SQ_POST
        if (is_cons) { float* so = F.out + (samp ? O_WKS : O_WKP) + ((((size_t)l * 8 + b) * 16 + h) * 64 + vrow) * 64 + 4 * fq;
#pragma unroll
            for (int kb = 0; kb < 4; ++kb) *(f32x4*)(so + 16 * kb) = sreg[kb]; }
    }
    VM_WAIT(); __syncthreads();
}

__device__ __forceinline__ void tile64_mma(const bf16_t* A, int lda, const bf16_t* Bt, int ldb, int K, int m0, int n0, int wave, int lane, f32x4 (&acc)[4][4]) {
    const int kq = K >> 3, kb = wave * kq, lr = lane & 15, lk = (lane >> 4) * 8;
    const bf16_t* ap = A + (size_t)(m0 + lr) * lda + kb + lk; const bf16_t* bp = Bt + (size_t)(n0 + lr) * ldb + kb + lk;
#pragma unroll 2
    for (int k = 0; k < kq; k += 32) {
        bf16x8 af[4], bf[4];
#pragma unroll
        for (int i = 0; i < 4; ++i) { af[i] = *(const bf16x8*)(ap + (size_t)(16 * i) * lda + k); bf[i] = *(const bf16x8*)(bp + (size_t)(16 * i) * ldb + k); }
#pragma unroll
        for (int mi = 0; mi < 4; ++mi)
#pragma unroll
            for (int ni = 0; ni < 4; ++ni) acc[mi][ni] = __builtin_amdgcn_mfma_f32_16x16x32_bf16(bf[ni], af[mi], acc[mi][ni], 0, 0, 0);
    }
}
__device__ __forceinline__ void tile64_reduce(LAS unsigned char* lds, int wave, int lane, const f32x4 (&acc)[4][4], f32x4 (&out)[2]) {
    LAS f32x4* red = (LAS f32x4*)lds;
    __syncthreads();
#pragma unroll
    for (int mi = 0; mi < 4; ++mi)
#pragma unroll
        for (int ni = 0; ni < 4; ++ni) red[(wave * 16 + mi * 4 + ni) * 64 + lane] = acc[mi][ni];
    __syncthreads();
#pragma unroll
    for (int j = 0; j < 2; ++j) { f32x4 s = red[(2 * wave + j) * 64 + lane];
#pragma unroll
        for (int w = 1; w < 8; ++w) s += red[(w * 16 + 2 * wave + j) * 64 + lane];
        out[j] = s; }
}
#define T64_ZERO(acc) do { _Pragma("unroll") for (int mi = 0; mi < 4; ++mi) _Pragma("unroll") for (int ni = 0; ni < 4; ++ni) acc[mi][ni] = (f32x4){0.f, 0.f, 0.f, 0.f}; } while (0)
template <int MODE>
__device__ __forceinline__ void sample_tiles(Frame& F, int l_in, int c0 = 0) {
    PHASE_IDS
    unsigned char* const wsl = fresh(F.ws);
    PHASE_L
    const size_t xb_cur = (l & 1) ? WS_XB2 : WS_XN, xb_nxt = (l & 1) ? WS_XN : WS_XB2;
    for (int t = (int)blockIdx.x >= c0 ? (int)blockIdx.x - c0 : 256; t < 256; t += fresh_i(F.G) - c0) {
        const int m0 = MPR + (t >> 5) * 64, n0 = (t & 31) * 64;
        f32x4 acc[4][4], o1[2], o2[2]; T64_ZERO(acc);
        if (MODE == 0) { tile64_mma((const bf16_t*)(wsl + WS_YA), PWD, (const bf16_t*)(wsl + WS_PPOOL), PWD, PWD, m0, n0, wave, lane, acc); tile64_reduce(F.lds, wave, lane, acc, o1);
                         T64_ZERO(acc); tile64_mma((const bf16_t*)(wsl + WS_YB), RWD, (const bf16_t*)(wsl + WS_PRWKV), RWD, RWD, m0, n0, wave, lane, acc); tile64_reduce(F.lds, wave, lane, acc, o2); }
        if (MODE == 1) { tile64_mma((const bf16_t*)(wsl + WS_MRG), DM, (const bf16_t*)(wsl + WS_WOUT), DM, DM, m0, n0, wave, lane, acc); tile64_reduce(F.lds, wave, lane, acc, o1); }
        if (MODE == 2) { tile64_mma((const bf16_t*)(wsl + WS_HID), FF, (const bf16_t*)(wsl + WS_WDN), FF, FF, m0, n0, wave, lane, acc); tile64_reduce(F.lds, wave, lane, acc, o1); }
        if (MODE == 3) { tile64_mma((const bf16_t*)(wsl + xb_cur), DM, (const bf16_t*)(wsl + WS_WPG), DM, DM, m0, n0, wave, lane, acc); tile64_reduce(F.lds, wave, lane, acc, o1); }
        if (MODE == 4) { tile64_mma((const bf16_t*)(wsl + WS_PB), PLE, (const bf16_t*)(wsl + WS_WPP), PLE, PLE, m0, n0, wave, lane, acc); tile64_reduce(F.lds, wave, lane, acc, o1); }
#pragma unroll
        for (int j = 0; j < 2; ++j) { const int blk = 2 * wave + j; const size_t row = (size_t)(m0 + 16 * (blk >> 2) + (lane & 15)); const int col = n0 + 16 * (blk & 3) + 4 * (lane >> 4);
            if (MODE == 0) { const bf16_t* PROJ = (const bf16_t*)(wsl + WS_PROJ); const u32x2 g1 = *(const u32x2*)(PROJ + row * ICP + PC_GP + col), g2 = *(const u32x2*)(PROJ + row * ICP + PC_GR + col);
                const f32x4 a = (f32x4){bf_lo(g1.x), bf_hi(g1.x), bf_lo(g1.y), bf_hi(g1.y)} * o1[j] + (f32x4){bf_lo(g2.x), bf_hi(g2.x), bf_lo(g2.y), bf_hi(g2.y)} * o2[j];
                *(u32x2*)((bf16_t*)(wsl + WS_MRG) + row * DM + col) = (u32x2){cvt_pk_bf16(a.x, a.y), cvt_pk_bf16(a.z, a.w)}; }
            if (MODE == 1 || MODE == 2) { bf16_t* p = (bf16_t*)(wsl + xb_cur) + row * DM + col; const u32x2 q = *(const u32x2*)p; const f32x4 x = (f32x4){bf_lo(q.x), bf_hi(q.x), bf_lo(q.y), bf_hi(q.y)} + o1[j];
                *(u32x2*)p = (u32x2){cvt_pk_bf16(x.x, x.y), cvt_pk_bf16(x.z, x.w)}; __hip_atomic_fetch_add((pg8::ss_t*)(wsl + WS_SS) + (size_t)MODE * MT + row, pg8::ss_fix((x.x * x.x + x.y * x.y) + (x.z * x.z + x.w * x.w)), __ATOMIC_RELAXED, __HIP_MEMORY_SCOPE_AGENT); }
            if (MODE == 3) { const u32x2 q = *(const u32x2*)((const bf16_t*)(wsl + WS_PP) + row * DM + col); const u32x2 xq = *(const u32x2*)((const bf16_t*)(wsl + xb_cur) + row * DM + col); bf16_t* p = (bf16_t*)(wsl + xb_nxt) + row * DM + col;
                const float rs = pg8::rstd_of((const pg8::ss_t*)(wsl + WS_SS) + (size_t)2 * MT, row);
                const f32x4 x = (f32x4){bf_lo(xq.x), bf_hi(xq.x), bf_lo(xq.y), bf_hi(xq.y)} + sigmoid4(o1[j] * rs) * (f32x4){bf_lo(q.x), bf_hi(q.x), bf_lo(q.y), bf_hi(q.y)};
                *(u32x2*)p = (u32x2){cvt_pk_bf16(x.x, x.y), cvt_pk_bf16(x.z, x.w)}; __hip_atomic_fetch_add((pg8::ss_t*)(wsl + WS_SS) + row, pg8::ss_fix((x.x * x.x + x.y * x.y) + (x.z * x.z + x.w * x.w)), __ATOMIC_RELAXED, __HIP_MEMORY_SCOPE_AGENT); }
            if (MODE == 4) *(u32x2*)((bf16_t*)(wsl + WS_PP) + row * DM + col) = (u32x2){cvt_pk_bf16(o1[j].x, o1[j].y), cvt_pk_bf16(o1[j].z, o1[j].w)};
        }
    }
    __syncthreads();
}

constexpr int PH_PER_LAYER = 11, N_PHASES = NL * PH_PER_LAYER + 1;
#ifndef MK_REP
#define MK_REP 0
#endif
__global__ void __launch_bounds__(NTHR, 2) mega_fwd(Args args) {
    extern __shared__ __attribute__((aligned(16))) unsigned char lds[];
    Frame F;
    F.lds = (LAS unsigned char*)lds;
    F.G = gridDim.x;
    F.out = args.out; F.ws = args.ws;
    { LAS unsigned long long* pt = (LAS unsigned long long*)(F.lds + LDSCTL_OFF + 1024); F.ptab = pt;
      if (threadIdx.x == 0) {
#define PT_(k) pt[k] = (unsigned long long)args.in[k];
          PT_(0) PT_(1) PT_(2) PT_(3) PT_(4) PT_(5) PT_(6) PT_(7) PT_(8) PT_(9) PT_(10) PT_(11) PT_(12) PT_(13) PT_(14) PT_(15) PT_(16) PT_(17) PT_(18) PT_(19) PT_(20) PT_(21) PT_(22) PT_(23) PT_(24) PT_(25) PT_(26) PT_(27) PT_(28) PT_(29) PT_(30) PT_(31) PT_(32)
#undef PT_
      } }
    volatile LAS unsigned* MISC = (volatile LAS unsigned*)(F.lds + LDSCTL_OFF);
    for (int u = threadIdx.x; u < 256; u += NTHR) ((LAS unsigned*)(F.lds + LDSCTL_OFF))[u] = 0u;
    __syncthreads();
    XcdBarrier bar; bar.bar = (unsigned*)(args.ws + WS_CTL) + CW_BAR; bar.x = 0; bar.st = nullptr;
    if (!MK_PER_PHASE) bar = xcd_barrier_post((unsigned*)(args.ws + WS_CTL) + CW_BAR, MISC + 8);
    const int lo = args.ph_lo, hi = args.ph_hi;
#define IN(k) (lo <= (k) && (k) < hi)
#define REP(k) (1 + ((MK_REP >> (k)) & 1))
#define PHASE(k, ...) do { if (IN(pb + (k))) { for (int rep = 0; rep < REP(k); ++rep) { if (rep) xcd_barrier(bar); __VA_ARGS__ } if (IN(pb + (k) + 1)) xcd_barrier(bar); } } while (0)
#define WSP(off) (fresh(F.ws) + (off))
#define UNPAREN(...) __VA_ARGS__
#define GEMM_M(M_, EPI, EINIT, Aoff, Boff, N_, K_, lda_, ldb_, apn_) do { pg8::Gemm g{(const bf16_t*)WSP(Aoff), (const bf16_t*)WSP(Boff), (M_), (N_), (K_), (lda_), (ldb_), (apn_)}; pg8::StaticOrder S; S.init((M_), (N_), fresh_i(F.G), fresh_i(cid)); \
        pg8::EPI E{UNPAREN EINIT}; pg8::gemm_phase<pg8::EPI, pg8::StaticOrder, true>(ring, g, S, E); } while (0)
#define GEMM(...) GEMM_M(MT, __VA_ARGS__)
#define GEMM_PAIR(M_, EPI, EINIT, Aoff, A2off, Boff, N_, K_, lda_, ldb_) do { pg8::Gemm g{(const bf16_t*)WSP(Aoff), (const bf16_t*)WSP(Boff), (M_), (N_), (K_), (lda_), (ldb_), (int)(((A2off) - (Aoff)) / 2)}; pg8::PairOrder S; \
        S.init((M_), (N_), fresh_i(F.G), fresh_i(cid)); pg8::EPI E{UNPAREN EINIT}; pg8::gemm_phase<pg8::EPI, pg8::PairOrder, true>(ring, g, S, E); } while (0)
#define GEMM_SUB(c0_, M_, EPI, EINIT, Aoff, Boff, N_, K_, lda_, ldb_, apn_) do { pg8::Gemm g{(const bf16_t*)WSP(Aoff), (const bf16_t*)WSP(Boff), (M_), (N_), (K_), (lda_), (ldb_), (apn_)}; pg8::StaticOrder S; \
        const int c0v = (c0_); S.init((M_), (N_), fresh_i(F.G) - c0v, fresh_i(cid) >= c0v ? fresh_i(cid) - c0v : -1); pg8::EPI E{UNPAREN EINIT}; pg8::gemm_phase<pg8::EPI, pg8::StaticOrder, true>(ring, g, S, E); } while (0)
    LAS unsigned char* ring = F.lds;
    const int cid = (int)blockIdx.x;
    for (int l = 0; l < NL; ++l) {
        const int pb = l * PH_PER_LAYER;
#define SSP(i) ((pg8::ss_t*)WSP(WS_SS) + (size_t)(i) * MT)
        const size_t xb_cur = (l & 1) ? WS_XB2 : WS_XN, xb_nxt = (l & 1) ? WS_XN : WS_XB2;
        PHASE(0, { convert_weights(F, l); if (l == 0) xb_from_input(F); });
        PHASE(1, { GEMM(EpiProj, ((bf16_t*)WSP(WS_PROJ), SSP(0)), xb_cur, WS_WIN, ICP, DM, DM, DM, 0); });
        PHASE(2, { prep1_phase(F, l); });
        PHASE(3, { GEMM(EpiBf16, ((bf16_t*)WSP(WS_YA), PWD), WS_D, WS_POOLW, PWD, 256, PWD, 256, 256);
                   GEMM(EpiLora, ((float*)WSP(WS_DEC), (bf16_t*)WSP(WS_AA), (bf16_t*)WSP(WS_GG), INP(12) + (size_t)fresh_i(l) * RWD, INP(14) + (size_t)fresh_i(l) * RWD), WS_LIN, WS_LORA, 3072, LK, LK, LK, 0); });
        PHASE(4, { spre_phase(F, l); });
        PHASE(5, { sseq_phase(F, l);
                   { const int c0 = fresh_i(F.G) >= 256 ? 128 : 0; GEMM_SUB(c0, MPR, EpiBf16, ((bf16_t*)WSP(WS_PP), DM), WS_PB, WS_WPP, DM, PLE, PLE, PLE, 0); } });
        PHASE(6, { GEMM_PAIR(MPR, EpiGatePair, ((const bf16_t*)WSP(WS_PROJ), PC_GP, PC_GR, (bf16_t*)WSP(WS_MRG)), WS_YA, WS_YB, WS_PPOOL, DM, PWD, PWD, PWD);
                   sample_tiles<0>(F, l); });
        PHASE(7, { GEMM_M(MPR, EpiResid, ((bf16_t*)WSP(xb_cur), SSP(1)), WS_MRG, WS_WOUT, DM, DM, DM, DM, 0); sample_tiles<1>(F, l); });
        PHASE(8, { GEMM(EpiSwiglu, ((bf16_t*)WSP(WS_HID), SSP(1)), xb_cur, WS_WGU, 2 * FF, DM, DM, DM, 0);
                   sample_tiles<4>(F, l, (((MT / 256) * (2 * FF / 256)) % fresh_i(F.G)) & ~7); });
        PHASE(9, { GEMM_M(MPR, EpiResid, ((bf16_t*)WSP(xb_cur), SSP(2)), WS_HID, WS_WDN, DM, FF, FF, FF, 0); sample_tiles<2>(F, l); });
        PHASE(10, { GEMM_M(MPR, EpiPle, ((const bf16_t*)WSP(xb_cur), (bf16_t*)WSP(xb_nxt), (const bf16_t*)WSP(WS_PP), SSP(2), SSP(0)), xb_cur, WS_WPG, DM, DM, DM, DM, 0); sample_tiles<3>(F, l); });
#undef SSP
    }
    if (IN(NL * PH_PER_LAYER)) final_norm(F, INP(32));
#undef IN
#undef REP
#undef PHASE
#undef WSP
#undef GEMM
#undef GEMM_M
#undef GEMM_SUB
#undef UNPAREN
}

extern "C" void kernel_launch(void* const* d_in, const int* in_sizes, int n_in, void* d_out, int out_size, void* d_ws, size_t ws_size, hipStream_t stream) {
    static int grid = 0;
    if (grid == 0) {
        if (n_in != 33 || in_sizes[0] != MPR * DM || out_size != (int)O_END || ws_size < WS_END) {
            fprintf(stderr, "kernel_launch: unexpected shapes: n_in %d in0 %d out %d ws %zu (need %zu); nothing launched\n", n_in, n_in > 0 ? in_sizes[0] : -1, out_size, ws_size, (size_t)WS_END); grid = -1; return; }
        int dev = 0, cus = 0, per_cu = 0;
        if (hipGetDevice(&dev) != hipSuccess || hipDeviceGetAttribute(&cus, hipDeviceAttributeMultiprocessorCount, dev) != hipSuccess) { grid = -1; return; }
        if (hipFuncSetAttribute((const void*)mega_fwd, hipFuncAttributeMaxDynamicSharedMemorySize, LDS_BYTES) != hipSuccess) { fprintf(stderr, "kernel_launch: hipFuncSetAttribute failed\n"); grid = -1; return; }
        if (hipOccupancyMaxActiveBlocksPerMultiprocessor(&per_cu, (const void*)mega_fwd, NTHR, LDS_BYTES) != hipSuccess || per_cu < 1) { fprintf(stderr, "kernel_launch: occupancy query says %d\n", per_cu); (void)hipGetLastError(); grid = -1; return; }
        grid = cus;
    }
    if (grid < 0) return;
    (void)hipMemsetAsync((char*)d_ws + WS_CTL, 0, CTL_ZERO_BYTES, stream);
    Args a; memset(&a, 0, sizeof(a));
    for (int i = 0; i < 33; ++i) a.in[i] = (const float*)d_in[i];
    a.out = (float*)d_out; a.ws = (unsigned char*)d_ws;
#if MK_PER_PHASE
    for (int p = 0; p < N_PHASES; ++p) { a.ph_lo = p; a.ph_hi = p + 1; hipLaunchKernelGGL(mega_fwd, dim3(grid), dim3(NTHR), LDS_BYTES, stream, a); }
#else
    a.ph_lo = 0; a.ph_hi = N_PHASES; hipLaunchKernelGGL(mega_fwd, dim3(grid), dim3(NTHR), LDS_BYTES, stream, a);
#endif
}
```

```cpp
#include <hip/hip_runtime.h>
#include <cstdio>
#include <cstdint>
#include <cstring>

#ifndef MK_PER_PHASE
#define MK_PER_PHASE 0
#endif

#define LAS __attribute__((address_space(3)))
typedef unsigned short bf16_t;
typedef short bf16x8 __attribute__((ext_vector_type(8)));
typedef float f32x4 __attribute__((ext_vector_type(4)));
typedef float f32x2 __attribute__((ext_vector_type(2)));
typedef unsigned u32x4 __attribute__((ext_vector_type(4)));
typedef unsigned u32x2 __attribute__((ext_vector_type(2)));

constexpr int DM = 2048, NL = 4, MT = 16896, MPR = 16384, TP = 2048, TS = 64;
constexpr int PWD = 1024, RWD = 1024, RPJ = 3360, ICOLS = 8480, ICP = 8704, FF = 5632, PLE = 256, LK = 384;
constexpr int PC_GP = 4608, PC_GR = 6656;
constexpr float NORM_EPS = 1e-6f, GN_EPS = 64e-5f;
constexpr size_t O_YS = 33554432, O_SHP = 34603008, O_POP = 34710528, O_WKP = 35202048, O_SHS = 37299200, O_POS = 37406720, O_WKS = 37898240, O_END = 39995392;

__device__ __forceinline__ unsigned cvt_pk_bf16(float lo, float hi) { unsigned r; asm volatile("v_cvt_pk_bf16_f32 %0, %1, %2" : "=v"(r) : "v"(lo), "v"(hi)); return r; }
__device__ __forceinline__ float bf_lo(unsigned u) { return __uint_as_float(u << 16); }
__device__ __forceinline__ float bf_hi(unsigned u) { return __uint_as_float(u & 0xffff0000u); }
__device__ __forceinline__ void unpack8(const u32x4 w, float (&f)[8]) { f[0] = bf_lo(w.x); f[1] = bf_hi(w.x); f[2] = bf_lo(w.y); f[3] = bf_hi(w.y); f[4] = bf_lo(w.z); f[5] = bf_hi(w.z); f[6] = bf_lo(w.w); f[7] = bf_hi(w.w); }
__device__ __forceinline__ u32x4 pack8(const float (&f)[8]) { u32x4 w; w.x = cvt_pk_bf16(f[0], f[1]); w.y = cvt_pk_bf16(f[2], f[3]); w.z = cvt_pk_bf16(f[4], f[5]); w.w = cvt_pk_bf16(f[6], f[7]); return w; }
__device__ __forceinline__ float sigmoidf_(float x) { return __builtin_amdgcn_rcpf(1.0f + __expf(-x)); }
__device__ __forceinline__ f32x4 sigmoid4(f32x4 v) { f32x4 o; o.x = sigmoidf_(v.x); o.y = sigmoidf_(v.y); o.z = sigmoidf_(v.z); o.w = sigmoidf_(v.w); return o; }
__device__ __forceinline__ f32x4 rcp4(f32x4 v) { f32x4 o; o.x = __builtin_amdgcn_rcpf(v.x); o.y = __builtin_amdgcn_rcpf(v.y); o.z = __builtin_amdgcn_rcpf(v.z); o.w = __builtin_amdgcn_rcpf(v.w); return o; }
__device__ __forceinline__ f32x4 fmax4(f32x4 a, f32x4 b) { f32x4 o; o.x = fmaxf(a.x, b.x); o.y = fmaxf(a.y, b.y); o.z = fmaxf(a.z, b.z); o.w = fmaxf(a.w, b.w); return o; }
__device__ __forceinline__ float tanhf_(float x) { const float e = __expf(2.0f * x); return 1.0f - 2.0f * __builtin_amdgcn_rcpf(e + 1.0f); }
template <int CTRL> __device__ __forceinline__ float dpp_f(float x) { return __uint_as_float((unsigned)__builtin_amdgcn_update_dpp(0, (int)__float_as_uint(x), CTRL, 0xF, 0xF, true)); }
__device__ __forceinline__ float sum8(float x) { x += dpp_f<0xB1>(x); x += dpp_f<0x4E>(x); x += dpp_f<0x141>(x); return x; }
__device__ __forceinline__ float wave_sum(float x) {
    x += dpp_f<0xB1>(x); x += dpp_f<0x4E>(x); x += dpp_f<0x141>(x); x += dpp_f<0x140>(x);
    x += __uint_as_float((unsigned)__builtin_amdgcn_ds_swizzle((int)__float_as_uint(x), 0x401F));
    return __uint_as_float((unsigned)__builtin_amdgcn_readlane((int)__float_as_uint(x), 0)) + __uint_as_float((unsigned)__builtin_amdgcn_readlane((int)__float_as_uint(x), 32));
}

namespace pg8 {
typedef unsigned ss_t;
constexpr int BM = 256, BK = 64, HALF = 128, HTB = HALF * BK * 2  , STAGE_BYTES = 8 * HTB, NXCD = 8, WGM = 4;
__host__ __device__ __forceinline__ int lds_g2(int fr) { return (0x1230 >> (4 * (fr >> 2))) & 3; }
__host__ __device__ __forceinline__ int lds_byte(int r, int c) { const int fr = r & 15, h = (c >> 5) & 1, q = (c >> 3) & 3; return (r >> 3) * 1024 + (r & 7) * 128 + ((h ^ ((fr >> 1) & 1)) * 64) + ((q ^ lds_g2(fr)) * 16); }
__host__ __device__ __forceinline__ void stage_rc(int b, int& R, int& C) { const int blk = b / 1024, sl = (b % 1024) / 16, rr8 = sl >> 3, fr = (blk & 1) * 8 + rr8, h = ((sl >> 2) & 1) ^ ((fr >> 1) & 1), q = (sl & 3) ^ lds_g2(fr); R = blk * 8 + rr8; C = 8 * (4 * h + q); }
__host__ __device__ __forceinline__ int perm32(int rho) { const int n = rho >> 4, i = rho & 15; return 8 * (i >> 2) + 4 * n + (i & 3); }

struct Unit { int pm, pn; };
struct Gemm { const bf16_t* A; const bf16_t* Bt; int M, N, K, lda, ldb, a_pn_off; };

struct StaticOrder {
    int nM, nN, nwg, G, c;
    __host__ __device__ void init(int M, int N, int G_, int c_) { nM = M / BM; nN = N / BM; nwg = nM * nN; G = G_; c = c_; }
    __host__ __device__ bool next(int i, Unit& u) const {
        if (c < 0) return false;
        const long L = (long)i * G + c; if (L >= nwg) return false;
        int wgid = (int)L; { const int q = nwg / NXCD, r = nwg % NXCD, xcd = wgid % NXCD, off = wgid / NXCD; wgid = (xcd < r ? xcd * (q + 1) : r * (q + 1) + (xcd - r) * q) + off; }
        const int nig = WGM * nN, gid = wgid / nig, fm = gid * WGM, gsz = (nM - fm) < WGM ? (nM - fm) : WGM;
        u.pm = fm + ((wgid % nig) % gsz); u.pn = ((wgid % nig) / gsz + gid) % nN; return true;
    }
    __device__ __forceinline__ void a_ready(const Unit&) const {}
    __device__ __forceinline__ void done(const Unit&) const {}
};

struct PairOrder : StaticOrder {
    __host__ __device__ bool next(int i, Unit& u) const { if (!StaticOrder::next(i >> 1, u)) return false; u.pn += (i & 1) * 8; return true; }
};
template <class T, class = void> struct paired_t { static constexpr bool v = false; };
template <class T> struct paired_t<T, decltype((void)T::PAIRED)> { static constexpr bool v = true; };

__device__ __forceinline__ void acc_zero(f32x4 (&acc)[2][2][4][2]) {
#pragma unroll
    for (int a = 0; a < 2; ++a)
#pragma unroll
        for (int b = 0; b < 2; ++b)
#pragma unroll
            for (int m = 0; m < 4; ++m)
#pragma unroll
                for (int n = 0; n < 2; ++n) acc[a][b][m][n] = (f32x4){0.f, 0.f, 0.f, 0.f};
}
struct RepeatOrder : StaticOrder {
    __host__ __device__ bool next(int i, Unit& u) const { if (i >= 6) return false; return StaticOrder::next(i % 3, u) || StaticOrder::next(0, u); }
};
#define EPI_ZERO_INIT __device__ __forceinline__ void init(f32x4 (&acc)[2][2][4][2], const Unit&, int, int, int, int) const { acc_zero(acc); }
#define EPI_NO_PRE __device__ __forceinline__ void preload(ss_t (&pre)[2], const Unit&, int, int, int) const {}
#define EPI_SS_PRE(SSPTR) __device__ __forceinline__ void preload(ss_t (&pre)[2], const Unit& u, int wr, int fr, int fq) const { _Pragma("unroll") for (int j = 0; j < 2; ++j) { const int g = 2 * fq + j; \
        pre[j] = (SSPTR)[(size_t)(u.pm * BM + (g >> 2) * HALF + wr * 64 + (g & 3) * 16 + fr)]; } }
__device__ __forceinline__ ss_t pre_get(const ss_t (&pre)[2], int g, int fr) { return (ss_t)__builtin_amdgcn_ds_bpermute((((g >> 1) << 4) + fr) << 2, (int)pre[g & 1]); }
template <class Epi, class Sched, bool ALIGN_EPI>
__device__ __forceinline__ void gemm_phase(LAS unsigned char* lds, const Gemm g, const Sched& S, const Epi& E) {
    int tid_ = threadIdx.x; asm volatile("" : "+v"(tid_));
    const int tid = tid_, wid = __builtin_amdgcn_readfirstlane(tid >> 6), lane = tid & 63, wr = wid >> 2, wc = wid & 3, fr = lane & 15, fq = lane >> 4;
    int K_ = g.K; asm volatile("" : "+s"(K_));
    const int K = K_, nt = K / BK;
    unsigned voffA[2], voffB[2];
#pragma unroll
    for (int i = 0; i < 2; ++i) { int R, C; stage_rc(tid * 16 + i * 8192, R, C); const int Rb = Epi::PERM ? (64 * (R >> 5) + perm32(R & 31)) : R;
        voffA[i] = (unsigned)(R * g.lda + C) * 2u; voffB[i] = (unsigned)(Rb * g.ldb + C) * 2u; }
    const size_t kstep = (size_t)(BK * 2);
    const size_t hstepA = (size_t)HALF * g.lda * 2, hstepB = (size_t)(Epi::PERM ? 32 : HALF) * g.ldb * 2;
    const unsigned ldsw = (unsigned)wid * 1024u;
    int aoff = lds_byte(wr * 64 + fr, fq * 8), boff = lds_byte(wc * 32 + fr, fq * 8);
#define PG8_SA(b, h) (((b) * 2 + (h)) * HTB)
#define PG8_APN(u) (paired_t<Epi>::v ? ((u).pn >> 3) : (u).pn)
#define PG8_SB(b, h) ((4 + (b) * 2 + (h)) * HTB)
#define PG8_STAGE(bufoff, gbase, voff) do { _Pragma("unroll") for (int _i = 0; _i < 2; ++_i) \
        __builtin_amdgcn_global_load_lds((const unsigned*)((const char*)(gbase) + (voff)[_i]), (LAS unsigned*)(lds + (bufoff) + ldsw + _i * 8192), 16, 0, 0); } while (0)
#define PG8_TOG(x) asm volatile("v_xor_b32 %0, 64, %0" : "+v"(x))
#define PG8_LDA(dst, b, h) do { _Pragma("unroll") for (int m = 0; m < 4; ++m) dst[m][0] = *(const LAS bf16x8*)(lds + PG8_SA(b, h) + aoff + m * 2048); PG8_TOG(aoff); \
        _Pragma("unroll") for (int m = 0; m < 4; ++m) dst[m][1] = *(const LAS bf16x8*)(lds + PG8_SA(b, h) + aoff + m * 2048); PG8_TOG(aoff); } while (0)
#define PG8_LDB(dst, b, h) do { _Pragma("unroll") for (int n = 0; n < 2; ++n) dst[n][0] = *(const LAS bf16x8*)(lds + PG8_SB(b, h) + boff + n * 2048); PG8_TOG(boff); \
        _Pragma("unroll") for (int n = 0; n < 2; ++n) dst[n][1] = *(const LAS bf16x8*)(lds + PG8_SB(b, h) + boff + n * 2048); PG8_TOG(boff); } while (0)
#define PG8_MMA(ai, bj, At, Bt) do { __builtin_amdgcn_s_setprio(1); _Pragma("unroll") for (int m = 0; m < 4; ++m) _Pragma("unroll") for (int n = 0; n < 2; ++n) _Pragma("unroll") for (int k = 0; k < 2; ++k) \
        acc[ai][bj][m][n] = __builtin_amdgcn_mfma_f32_16x16x32_bf16(Bt[n][k], At[m][k], acc[ai][bj][m][n], 0, 0, 0); __builtin_amdgcn_s_setprio(0); } while (0)
#define PG8_WAIT_V(n) asm volatile("s_waitcnt vmcnt(" #n ")" ::: "memory")
#define PG8_WAIT_L(n) asm volatile("s_waitcnt lgkmcnt(" #n ")" ::: "memory")
#define PG8_BAR __builtin_amdgcn_s_barrier()
#define PG8_SCHED __builtin_amdgcn_sched_barrier(0)
    Unit cur, nxt; int ui = 0;
    if (!S.next(0, cur)) return;
    f32x4 acc[2][2][4][2]; ss_t pre[2];
    E.init(acc, cur, wr, wc, fr, fq); E.preload(pre, cur, wr, fr, fq);
    bf16x8 At[4][2], B0[2][2], B1[2][2];
    const char* cA = (const char*)g.A + ((size_t)cur.pm * BM * g.lda + (size_t)PG8_APN(cur) * g.a_pn_off) * 2; const char* cB = (const char*)g.Bt + (size_t)cur.pn * BM * g.ldb * 2;
    S.a_ready(cur);
    PG8_STAGE(PG8_SB(0, 0), cB, voffB); PG8_STAGE(PG8_SB(0, 1), cB + hstepB, voffB); PG8_STAGE(PG8_SA(0, 0), cA, voffA); PG8_STAGE(PG8_SA(0, 1), cA + hstepA, voffA);
    if (wr == 1) PG8_BAR;
    PG8_WAIT_V(2); PG8_BAR;
    PG8_STAGE(PG8_SB(1, 0), cB + kstep, voffB); PG8_STAGE(PG8_SA(1, 0), cA + kstep, voffA); PG8_STAGE(PG8_SB(1, 1), cB + hstepB + kstep, voffB);
    PG8_WAIT_V(6); PG8_BAR;
    for (;;) {
        const bool has_next = S.next(ui + 1, nxt);
        const char* nA = has_next ? (const char*)g.A + ((size_t)nxt.pm * BM * g.lda + (size_t)PG8_APN(nxt) * g.a_pn_off) * 2 : cA; const char* nB = has_next ? (const char*)g.Bt + (size_t)nxt.pn * BM * g.ldb * 2 : cB;
#pragma unroll 1
        for (int t = 0; t < nt; t += 2) {
            const bool last = (t == nt - 2);
            const char* a1 = cA + (size_t)(t + 1) * kstep;
            const char* a2 = last ? nA : cA + (size_t)(t + 2) * kstep; const char* b2 = last ? nB : cB + (size_t)(t + 2) * kstep;
            const char* a3 = a2 + kstep; const char* b3 = b2 + kstep;
            if (last && has_next) S.a_ready(nxt);
            PG8_LDB(B0, 0, 0); PG8_LDB(B1, 0, 1); PG8_SCHED; PG8_LDA(At, 0, 0); PG8_STAGE(PG8_SA(1, 1), a1 + hstepA, voffA);
            PG8_WAIT_V(8); PG8_WAIT_L(0); PG8_BAR; PG8_MMA(0, 0, At, B0); PG8_MMA(0, 1, At, B1); PG8_BAR; PG8_SCHED;
            PG8_LDA(At, 0, 1); PG8_STAGE(PG8_SB(0, 0), b2, voffB); PG8_STAGE(PG8_SB(0, 1), b2 + hstepB, voffB); PG8_STAGE(PG8_SA(0, 0), a2, voffA);
            PG8_WAIT_V(8); PG8_WAIT_L(0); PG8_BAR; PG8_MMA(1, 0, At, B0); PG8_MMA(1, 1, At, B1); PG8_BAR; PG8_SCHED;
            PG8_LDB(B0, 1, 0); PG8_LDB(B1, 1, 1); PG8_SCHED; PG8_LDA(At, 1, 0); PG8_STAGE(PG8_SA(0, 1), a2 + hstepA, voffA);
            PG8_WAIT_V(8); PG8_WAIT_L(0); PG8_BAR; PG8_MMA(0, 0, At, B0); PG8_MMA(0, 1, At, B1); PG8_BAR; PG8_SCHED;
            PG8_LDA(At, 1, 1); PG8_STAGE(PG8_SB(1, 0), b3, voffB); PG8_STAGE(PG8_SB(1, 1), b3 + hstepB, voffB); PG8_STAGE(PG8_SA(1, 0), a3, voffA);
            PG8_WAIT_V(8); PG8_WAIT_L(0); PG8_BAR; PG8_MMA(1, 0, At, B0); PG8_MMA(1, 1, At, B1); PG8_BAR; PG8_SCHED;
        }
        if constexpr (ALIGN_EPI) { if (wr == 0) PG8_BAR; }
        E(acc, pre, cur, wr, wc, fr, fq); S.done(cur);
        if (!has_next) break;
        E.init(acc, nxt, wr, wc, fr, fq); E.preload(pre, nxt, wr, fr, fq);
        cur = nxt; cA = nA; cB = nB; ++ui;
        if constexpr (ALIGN_EPI) { if (wr == 1) PG8_BAR; }
    }
    PG8_WAIT_V(0);
    if constexpr (!ALIGN_EPI) { if (wr == 0) PG8_BAR; }
    PG8_BAR;
#undef PG8_SA
#undef PG8_APN
#undef PG8_SB
#undef PG8_STAGE
#undef PG8_LDA
#undef PG8_TOG
#undef PG8_LDB
#undef PG8_MMA
#undef PG8_WAIT_V
#undef PG8_WAIT_L
#undef PG8_BAR
#undef PG8_SCHED
}

#define EPI_ROW0 (u.pm * BM + wr * 64 + fr)
#define EPI_FOR_AI_M _Pragma("unroll") for (int ai = 0; ai < 2; ++ai) _Pragma("unroll") for (int m = 0; m < 4; ++m)
__device__ __forceinline__ u32x4 pack_f4x2(f32x4 v0, f32x4 v1) { u32x4 w; w.x = cvt_pk_bf16(v0[0], v0[1]); w.y = cvt_pk_bf16(v0[2], v0[3]); w.z = cvt_pk_bf16(v1[0], v1[1]); w.w = cvt_pk_bf16(v1[2], v1[3]); return w; }
__device__ __forceinline__ void unpack_f4x2(u32x4 w, f32x4& v0, f32x4& v1) { v0[0] = bf_lo(w.x); v0[1] = bf_hi(w.x); v0[2] = bf_lo(w.y); v0[3] = bf_hi(w.y); v1[0] = bf_lo(w.z); v1[1] = bf_hi(w.z); v1[2] = bf_lo(w.w); v1[3] = bf_hi(w.w); }
__device__ __forceinline__ unsigned ror8(unsigned x) { return (unsigned)__builtin_amdgcn_update_dpp(0, (int)x, 0x128, 0xF, 0xF, true); }
__device__ __forceinline__ void st_pair(char* grp, size_t pitch, int fr, int fq, u32x4 vA, u32x4 vB) {
    const bool lo = fr < 8;
    u32x4 snd = lo ? vB : vA, rcv; rcv.x = ror8(snd.x); rcv.y = ror8(snd.y); rcv.z = ror8(snd.z); rcv.w = ror8(snd.w);
    char* p = grp + (size_t)(fr & 7) * pitch + (lo ? 0 : 64) + fq * 16;
    *(u32x4*)p = lo ? vA : rcv;
    *(u32x4*)(p + 8 * pitch) = lo ? rcv : vB;
}
__device__ __forceinline__ u32x4 as_u4(f32x4 v) { return __builtin_bit_cast(u32x4, v); }

__device__ __forceinline__ float rstd_raw(ss_t v) { return __builtin_amdgcn_rsqf((float)v * (1.0f / (256.0f * DM)) + NORM_EPS); }
__device__ __forceinline__ float rstd_of(const ss_t* SS, size_t row) { return rstd_raw(SS[row]); }
__device__ __forceinline__ ss_t ss_fix(float s) { return (ss_t)(s * 256.0f + 0.5f); }
__device__ __forceinline__ float sq8(f32x4 a, f32x4 b) { return (a.x * a.x + a.y * a.y) + (a.z * a.z + a.w * a.w) + (b.x * b.x + b.y * b.y) + (b.z * b.z + b.w * b.w); }
__device__ __forceinline__ void ss_add(ss_t* SS, size_t row, float s, int fq, int fr) { s += __uint_as_float((unsigned)__builtin_amdgcn_ds_swizzle((int)__float_as_uint(s), 0x401F));
    s += __uint_as_float((unsigned)__builtin_amdgcn_ds_bpermute((((fq ^ 2) << 4) + fr) << 2, (int)__float_as_uint(s)));
    if (fq == 0) __hip_atomic_fetch_add(SS + row, ss_fix(s), __ATOMIC_RELAXED, __HIP_MEMORY_SCOPE_AGENT); }
struct EpiNull { static constexpr bool PERM = true; EPI_NO_PRE EPI_ZERO_INIT __device__ __forceinline__ void operator()(const f32x4 (&acc)[2][2][4][2], const ss_t (&pre)[2], const Unit& u, int wr, int wc, int fr, int fq) const {
#pragma unroll
    for (int a = 0; a < 2; ++a)
#pragma unroll
        for (int b = 0; b < 2; ++b)
#pragma unroll
            for (int m = 0; m < 4; ++m)
#pragma unroll
                for (int n = 0; n < 2; ++n) asm volatile("" :: "v"(acc[a][b][m][n]));
} };
struct EpiProj { static constexpr bool PERM = true; EPI_ZERO_INIT
    bf16_t* O; const ss_t* SS; EPI_SS_PRE(SS)
    __device__ __forceinline__ void operator()(const f32x4 (&acc)[2][2][4][2], const ss_t (&pre)[2], const Unit& u, int wr, int wc, int fr, int fq) const {
        const bool sg = u.pn >= 18;
        EPI_FOR_AI_M { const size_t r0 = (size_t)(u.pm * BM + ai * HALF + wr * 64 + m * 16); char* grp = (char*)(O + r0 * ICP + u.pn * BM + 64 * wc); const float rs = rstd_raw(pre_get(pre, ai * 4 + m, fr));
            f32x4 a0 = acc[ai][0][m][0] * rs, a1 = acc[ai][0][m][1] * rs, b0 = acc[ai][1][m][0] * rs, b1 = acc[ai][1][m][1] * rs;
            if (sg) { a0 = sigmoid4(a0); a1 = sigmoid4(a1); b0 = sigmoid4(b0); b1 = sigmoid4(b1); }
            st_pair(grp, (size_t)ICP * 2, fr, fq, pack_f4x2(a0, a1), pack_f4x2(b0, b1)); }
    }
};
struct EpiBf16 { static constexpr bool PERM = true; EPI_NO_PRE EPI_ZERO_INIT
    bf16_t* O; int ldc;
    __device__ __forceinline__ void operator()(const f32x4 (&acc)[2][2][4][2], const ss_t (&pre)[2], const Unit& u, int wr, int wc, int fr, int fq) const {
        EPI_FOR_AI_M { char* grp = (char*)(O + (size_t)(u.pm * BM + ai * HALF + wr * 64 + m * 16) * ldc + u.pn * BM + 64 * wc);
            st_pair(grp, (size_t)ldc * 2, fr, fq, pack_f4x2(acc[ai][0][m][0], acc[ai][0][m][1]), pack_f4x2(acc[ai][1][m][0], acc[ai][1][m][1])); }
    }
};
struct EpiLora { static constexpr bool PERM = true; EPI_NO_PRE EPI_ZERO_INIT
    float* DEC; bf16_t* AA; bf16_t* GG; const float* w0; const float* a0;
    __device__ __forceinline__ void operator()(const f32x4 (&acc)[2][2][4][2], const ss_t (&pre)[2], const Unit& u, int wr, int wc, int fr, int fq) const {
        const int row0 = EPI_ROW0, kind = u.pn >> 2, ct = (u.pn & 3) * BM + 64 * wc, col0 = ct + 8 * fq;
        if (kind == 0) {
            EPI_FOR_AI_M { float* rowp = DEC + (size_t)(row0 + ai * HALF + m * 16) * RWD + col0;
#pragma unroll
                for (int bj = 0; bj < 2; ++bj)
#pragma unroll
                    for (int n = 0; n < 2; ++n) { const f32x4 b = *(const f32x4*)(w0 + col0 + bj * 32 + 4 * n); const f32x4 x = acc[ai][bj][m][n] + b; f32x4 o;
#pragma unroll
                        for (int j = 0; j < 4; ++j) { const float z = -x[j]; const float sp = z > 15.f ? z : __logf(1.0f + __expf(z)); const float w = -sp - 0.5f; o[j] = __expf(-__expf(w)); }
                        *(f32x4*)(rowp + bj * 32 + 4 * n) = o; } asm volatile("" ::: "memory"); }
        } else if (kind == 1) {
            const f32x4 b00 = *(const f32x4*)(a0 + col0), b01 = *(const f32x4*)(a0 + col0 + 4), b10 = *(const f32x4*)(a0 + col0 + 32), b11 = *(const f32x4*)(a0 + col0 + 36);
            EPI_FOR_AI_M { char* grp = (char*)(AA + (size_t)(u.pm * BM + ai * HALF + wr * 64 + m * 16) * RWD + ct);
                st_pair(grp, (size_t)RWD * 2, fr, fq, pack_f4x2(sigmoid4(acc[ai][0][m][0] + b00), sigmoid4(acc[ai][0][m][1] + b01)), pack_f4x2(sigmoid4(acc[ai][1][m][0] + b10), sigmoid4(acc[ai][1][m][1] + b11))); }
        } else {
            EPI_FOR_AI_M { char* grp = (char*)(GG + (size_t)(u.pm * BM + ai * HALF + wr * 64 + m * 16) * RWD + ct);
                st_pair(grp, (size_t)RWD * 2, fr, fq, pack_f4x2(acc[ai][0][m][0], acc[ai][0][m][1]), pack_f4x2(acc[ai][1][m][0], acc[ai][1][m][1])); }
        }
    }
};
struct EpiGate1 { static constexpr bool PERM = true; EPI_NO_PRE EPI_ZERO_INIT
    bf16_t* TMP; const bf16_t* PROJ; int gcol0;
    __device__ __forceinline__ void operator()(const f32x4 (&acc)[2][2][4][2], const ss_t (&pre)[2], const Unit& u, int wr, int wc, int fr, int fq) const {
        const int row0 = EPI_ROW0, ct = u.pn * BM + 64 * wc, col0 = ct + 8 * fq;
        EPI_FOR_AI_M { const size_t row = (size_t)(row0 + ai * HALF + m * 16);
            f32x4 g00, g01, g10, g11; unpack_f4x2(*(const u32x4*)(PROJ + row * ICP + gcol0 + col0), g00, g01); unpack_f4x2(*(const u32x4*)(PROJ + row * ICP + gcol0 + col0 + 32), g10, g11);
            st_pair((char*)(TMP + (size_t)(u.pm * BM + ai * HALF + wr * 64 + m * 16) * DM + ct), (size_t)DM * 2, fr, fq, pack_f4x2(acc[ai][0][m][0] * g00, acc[ai][0][m][1] * g01), pack_f4x2(acc[ai][1][m][0] * g10, acc[ai][1][m][1] * g11));
            if (m & 1) asm volatile("" ::: "memory"); }
    }
};
struct EpiGate2 { static constexpr bool PERM = true; EPI_NO_PRE EPI_ZERO_INIT
    const bf16_t* TMP; const bf16_t* PROJ; int gcol0; bf16_t* O;
    __device__ __forceinline__ void operator()(const f32x4 (&acc)[2][2][4][2], const ss_t (&pre)[2], const Unit& u, int wr, int wc, int fr, int fq) const {
        const int row0 = EPI_ROW0, ct = u.pn * BM + 64 * wc, col0 = ct + 8 * fq;
        EPI_FOR_AI_M { const size_t row = (size_t)(row0 + ai * HALF + m * 16);
            f32x4 g00, g01, g10, g11, t00, t01, t10, t11; unpack_f4x2(*(const u32x4*)(PROJ + row * ICP + gcol0 + col0), g00, g01); unpack_f4x2(*(const u32x4*)(PROJ + row * ICP + gcol0 + col0 + 32), g10, g11);
            unpack_f4x2(*(const u32x4*)(TMP + row * DM + col0), t00, t01); unpack_f4x2(*(const u32x4*)(TMP + row * DM + col0 + 32), t10, t11);
            st_pair((char*)(O + (size_t)(u.pm * BM + ai * HALF + wr * 64 + m * 16) * DM + ct), (size_t)DM * 2, fr, fq, pack_f4x2(t00 + acc[ai][0][m][0] * g00, t01 + acc[ai][0][m][1] * g01), pack_f4x2(t10 + acc[ai][1][m][0] * g10, t11 + acc[ai][1][m][1] * g11));
            if (m & 1) asm volatile("" ::: "memory"); }
    }
};
struct EpiGatePair { static constexpr bool PERM = true; static constexpr bool PAIRED = true; EPI_NO_PRE
    const bf16_t* PROJ; int gc1, gc2; bf16_t* O;
    __device__ __forceinline__ void init(f32x4 (&acc)[2][2][4][2], const Unit& u, int, int, int, int) const { if (u.pn < 8) acc_zero(acc); }
    __device__ __forceinline__ void operator()(f32x4 (&acc)[2][2][4][2], const ss_t (&pre)[2], const Unit& u, int wr, int wc, int fr, int fq) const {
        const int row0 = EPI_ROW0, ct = (u.pn & 7) * BM + 64 * wc, col0 = ct + 8 * fq;
        const f32x4 flo = (f32x4){0x1p-60f, 0x1p-60f, 0x1p-60f, 0x1p-60f};
        if (u.pn < 8) {
#pragma unroll
            for (int ai = 0; ai < 2; ++ai) { u32x4 q[4][4];
#pragma unroll
                for (int m = 0; m < 4; ++m) { const bf16_t* p = PROJ + (size_t)(row0 + ai * HALF + m * 16) * ICP + col0; q[m][0] = *(const u32x4*)(p + gc1); q[m][1] = *(const u32x4*)(p + gc1 + 32); q[m][2] = *(const u32x4*)(p + gc2); q[m][3] = *(const u32x4*)(p + gc2 + 32); }
                __builtin_amdgcn_sched_barrier(0);
#pragma unroll
                for (int m = 0; m < 4; ++m) { f32x4 g00, g01, g10, g11, h00, h01, h10, h11; unpack_f4x2(q[m][0], g00, g01); unpack_f4x2(q[m][1], g10, g11); unpack_f4x2(q[m][2], h00, h01); unpack_f4x2(q[m][3], h10, h11);
                    acc[ai][0][m][0] *= g00 * rcp4(fmax4(h00, flo)); acc[ai][0][m][1] *= g01 * rcp4(fmax4(h01, flo)); acc[ai][1][m][0] *= g10 * rcp4(fmax4(h10, flo)); acc[ai][1][m][1] *= g11 * rcp4(fmax4(h11, flo)); }
                __builtin_amdgcn_sched_barrier(0); }
        } else {
            u32x4 q[2][4][2];
#pragma unroll
            for (int ai = 0; ai < 2; ++ai)
#pragma unroll
                for (int m = 0; m < 4; ++m) { const bf16_t* p = PROJ + (size_t)(row0 + ai * HALF + m * 16) * ICP + gc2 + col0; q[ai][m][0] = *(const u32x4*)p; q[ai][m][1] = *(const u32x4*)(p + 32); }
            __builtin_amdgcn_sched_barrier(0);
            EPI_FOR_AI_M { f32x4 h00, h01, h10, h11; unpack_f4x2(q[ai][m][0], h00, h01); unpack_f4x2(q[ai][m][1], h10, h11);
                st_pair((char*)(O + (size_t)(u.pm * BM + ai * HALF + wr * 64 + m * 16) * DM + ct), (size_t)DM * 2, fr, fq, pack_f4x2(acc[ai][0][m][0] * fmax4(h00, flo), acc[ai][0][m][1] * fmax4(h01, flo)),
                        pack_f4x2(acc[ai][1][m][0] * fmax4(h10, flo), acc[ai][1][m][1] * fmax4(h11, flo)));
                if (m & 1) __builtin_amdgcn_sched_barrier(0); }
        }
    }
};
struct EpiResid { static constexpr bool PERM = true; EPI_NO_PRE
    bf16_t* XB; ss_t* SS;
    __device__ __forceinline__ void init(f32x4 (&acc)[2][2][4][2], const Unit& u, int wr, int wc, int fr, int fq) const {
        const int row0 = EPI_ROW0, col0 = u.pn * BM + 64 * wc + 8 * fq;
        EPI_FOR_AI_M { const bf16_t* rowp = XB + (size_t)(row0 + ai * HALF + m * 16) * DM + col0;
            unpack_f4x2(*(const u32x4*)rowp, acc[ai][0][m][0], acc[ai][0][m][1]); unpack_f4x2(*(const u32x4*)(rowp + 32), acc[ai][1][m][0], acc[ai][1][m][1]); }
    }
    __device__ __forceinline__ void operator()(const f32x4 (&acc)[2][2][4][2], const ss_t (&pre)[2], const Unit& u, int wr, int wc, int fr, int fq) const {
        EPI_FOR_AI_M { const size_t r0 = (size_t)(u.pm * BM + ai * HALF + wr * 64 + m * 16);
            st_pair((char*)(XB + r0 * DM + u.pn * BM + 64 * wc), (size_t)DM * 2, fr, fq, pack_f4x2(acc[ai][0][m][0], acc[ai][0][m][1]), pack_f4x2(acc[ai][1][m][0], acc[ai][1][m][1]));
            ss_add(SS, r0 + fr, sq8(acc[ai][0][m][0], acc[ai][0][m][1]) + sq8(acc[ai][1][m][0], acc[ai][1][m][1]), fq, fr); }
    }
};
struct EpiSwiglu { static constexpr bool PERM = true; EPI_ZERO_INIT
    bf16_t* H; const ss_t* SS; EPI_SS_PRE(SS)
    __device__ __forceinline__ void operator()(const f32x4 (&acc)[2][2][4][2], const ss_t (&pre)[2], const Unit& u, int wr, int wc, int fr, int fq) const {
        const int row0 = EPI_ROW0, col0 = u.pn * HALF + wc * 32 + 8 * fq;
        EPI_FOR_AI_M { const size_t row = (size_t)(row0 + ai * HALF + m * 16); const float rs = rstd_raw(pre_get(pre, ai * 4 + m, fr));
            const f32x4 g0 = acc[ai][0][m][0] * rs, g1 = acc[ai][0][m][1] * rs, u0 = acc[ai][1][m][0] * rs, u1 = acc[ai][1][m][1] * rs;
            *(u32x4*)(H + row * FF + col0) = pack_f4x2(g0 * sigmoid4(g0) * u0, g1 * sigmoid4(g1) * u1); }
    }
};
struct EpiPle { static constexpr bool PERM = true; EPI_ZERO_INIT EPI_SS_PRE(SSi)
    const bf16_t* XB; bf16_t* XO; const bf16_t* PP; const ss_t* SSi; ss_t* SSo;
    __device__ __forceinline__ void operator()(const f32x4 (&acc)[2][2][4][2], const ss_t (&pre)[2], const Unit& u, int wr, int wc, int fr, int fq) const {
        const int col0 = u.pn * BM + 64 * wc + 8 * fq;
        EPI_FOR_AI_M { const size_t r0 = (size_t)(u.pm * BM + ai * HALF + wr * 64 + m * 16), row = r0 + fr; const float rs = rstd_raw(pre_get(pre, ai * 4 + m, fr));
            f32x4 x00, x01, x10, x11, p00, p01, p10, p11; unpack_f4x2(*(const u32x4*)(XB + row * DM + col0), x00, x01); unpack_f4x2(*(const u32x4*)(XB + row * DM + col0 + 32), x10, x11);
            unpack_f4x2(*(const u32x4*)(PP + row * DM + col0), p00, p01); unpack_f4x2(*(const u32x4*)(PP + row * DM + col0 + 32), p10, p11);
            x00 += sigmoid4(acc[ai][0][m][0] * rs) * p00; x01 += sigmoid4(acc[ai][0][m][1] * rs) * p01; x10 += sigmoid4(acc[ai][1][m][0] * rs) * p10; x11 += sigmoid4(acc[ai][1][m][1] * rs) * p11;
            st_pair((char*)(XO + r0 * DM + u.pn * BM + 64 * wc), (size_t)DM * 2, fr, fq, pack_f4x2(x00, x01), pack_f4x2(x10, x11));
            ss_add(SSo, row, sq8(x00, x01) + sq8(x10, x11), fq, fr);
            if (m & 1) asm volatile("" ::: "memory"); }
    }
};
#undef EPI_ROW0
#undef EPI_FOR_AI_M
}

constexpr size_t MiB = 1u << 20;
constexpr size_t al1m(size_t x) { return (x + MiB - 1) / MiB * MiB; }
constexpr size_t WS_CTL = 0, CTL_ZERO_BYTES = 1 * MiB;
constexpr size_t SZ_WIN = (size_t)ICP * DM * 2, SZ_POOLW = (size_t)PWD * 256 * 2, SZ_LORA = (size_t)3072 * LK * 2, SZ_PPOOL = (size_t)DM * PWD * 2, SZ_PRWKV = (size_t)DM * RWD * 2,
                 SZ_WOUT = (size_t)DM * DM * 2, SZ_WGU = (size_t)2 * FF * DM * 2, SZ_WDN = (size_t)DM * FF * 2, SZ_WPG = (size_t)DM * DM * 2, SZ_WPP = (size_t)DM * PLE * 2;
constexpr size_t WS_WIN = 1 * MiB, WS_POOLW = WS_WIN + SZ_WIN, WS_LORA = WS_POOLW + SZ_POOLW, WS_PPOOL = WS_LORA + SZ_LORA, WS_PRWKV = WS_PPOOL + SZ_PPOOL, WS_WOUT = WS_PRWKV + SZ_PRWKV,
                 WS_WGU = WS_WOUT + SZ_WOUT, WS_WDN = WS_WGU + SZ_WGU, WS_WPG = WS_WDN + SZ_WDN, WS_WPP = WS_WPG + SZ_WPG, WS_WEND = WS_WPP + SZ_WPP;
constexpr size_t WS_PB = al1m(WS_WEND);
constexpr size_t WS_XN = al1m(WS_PB + (size_t)MT * PLE * 2);
constexpr size_t WS_AA = al1m(WS_XN + (size_t)MT * DM * 2);
constexpr size_t WS_GG = al1m(WS_AA + (size_t)MT * RWD * 2);
constexpr size_t WS_PP = al1m(WS_GG + (size_t)MT * RWD * 2);
constexpr size_t WS_PROJ = al1m(WS_PP + (size_t)MT * DM * 2);
constexpr size_t WS_HID = WS_PROJ;
constexpr size_t WS_D = al1m(WS_PROJ + (size_t)MT * ICP * 2);
constexpr size_t WS_LIN = al1m(WS_D + (size_t)MT * PWD * 2);
constexpr size_t WS_YA = al1m(WS_LIN + (size_t)MT * LK * 2);
constexpr size_t WS_DEC = al1m(WS_YA + (size_t)MT * PWD * 2);
constexpr size_t WS_BS = al1m(WS_DEC + (size_t)MT * RWD * 4);
constexpr size_t WS_Y = al1m(WS_BS + (size_t)MT * 16 * 4);
constexpr size_t SZ_BH = (size_t)MT * RWD * 2;
constexpr size_t WS_YB = al1m(WS_Y + (size_t)MT * RWD * 4);
constexpr size_t WS_TMP = al1m(WS_YB + SZ_BH);
constexpr size_t WS_MRG = al1m(WS_TMP + (size_t)MT * DM * 4);
constexpr size_t WS_SS = al1m(WS_MRG + (size_t)MT * DM * 2);
constexpr size_t WS_END_OLD = al1m(WS_MRG + (size_t)MT * DM * 2);
static_assert((size_t)MT * FF * 2 <= (size_t)MT * ICP * 2, "HID overlay");

constexpr size_t WS_XB2 = al1m(WS_SS + (size_t)3 * MT * 4);
constexpr size_t CBSZ = 12096, CB_BS = 12032, CB_P1T = 0, CB_RT = 2048, CB_BK = 4096, CB_VT = 8192, CB_P2T = 10240, CB_MBT = 10752, CB_MKT = 11264, CB_GC = 11776;
constexpr size_t CB_N = (size_t)(MT / 16) * 16;
static_assert(WS_MRG + (size_t)MT * DM * 2 - WS_TMP >= CB_N * CBSZ, "chunk blocks fit in TMP | MRG");
static_assert(WS_PRWKV == WS_PPOOL + (size_t)8 * 256 * PWD * 2 && PWD == RWD && (WS_YB - WS_YA) / 2 < (size_t)0x7fffffff, "the paired gate GEMM walks proj_pool | proj_rwkv as one [4096][1024] matrix");
constexpr size_t WS_END = al1m(WS_XB2 + (size_t)MT * DM * 2);
constexpr int CW_BAR = 4096;
constexpr int NWAVES = 8, NTHR = 512;
constexpr int RING_BYTES = 131072, LDSCTL_OFF = RING_BYTES, LDS_BYTES = 147456;

#define XB_TMO      128
#define XB_XCNT(j)  (256  + 64 * (j))
#define XB_XSUB(j)  (1280 + 64 * (j))
#define XB_XGEN(j)  (2304 + 64 * (j))
#define XB_TOP      3328
#define XB_TOPGEN   3392
#define XCD_BAR_WORDS 3456
#define XB_SPIN_CAP (1u << 18)

__device__ __forceinline__ unsigned xb_ld(unsigned* p)              { return __hip_atomic_load(p, __ATOMIC_RELAXED, __HIP_MEMORY_SCOPE_AGENT); }
__device__ __forceinline__ unsigned xb_add(unsigned* p, unsigned v) { return __hip_atomic_fetch_add(p, v, __ATOMIC_RELAXED, __HIP_MEMORY_SCOPE_AGENT); }
__device__ __forceinline__ unsigned xb_xcc_id() { return (unsigned)__builtin_amdgcn_s_getreg((3 << 11) | 20) & 0xFu; }
#define XB_SPIN(cond, bar) do { unsigned _sp = 0; while (cond) { __builtin_amdgcn_s_sleep(1); \
    if ((++_sp & 255u) == 0u) { if (xb_ld(&(bar)[XB_TMO])) break; if (_sp > XB_SPIN_CAP) { atomicAdd(&(bar)[XB_TMO], 1u); break; } } } } while (0)

struct XcdBarrier {
    unsigned* bar; unsigned x;
    volatile LAS unsigned* st;
};

__device__ __forceinline__ XcdBarrier xcd_barrier_post(unsigned* bar, volatile LAS unsigned* st) {
    XcdBarrier b; b.bar = bar; b.x = xb_xcc_id(); b.st = st;
    if (threadIdx.x == 0) (void)xb_add(&bar[XB_XCNT(b.x)], 1u);
    return b;
}
__device__ __forceinline__ void xcd_barrier_complete(unsigned* bar, unsigned x, unsigned& nloc, unsigned& nx) {
    const unsigned G = gridDim.x * gridDim.y * gridDim.z;
    unsigned sum, cnt, mine, sp = 0u;
    for (;;) {
        sum = 0u; cnt = 0u; mine = 0u;
#pragma unroll
        for (unsigned j = 0; j < 16; ++j) { const unsigned c = xb_ld(&bar[XB_XCNT(j)]); sum += c; cnt += (c > 0u) ? 1u : 0u; mine = (j == x) ? c : mine; }
        if (sum == G) break;
        __builtin_amdgcn_s_sleep(1);
        if ((++sp & 255u) == 0u) { if (xb_ld(&bar[XB_TMO])) break; if (sp > XB_SPIN_CAP) { atomicAdd(&bar[XB_TMO], 1u); break; } }
    }
    nloc = mine > 0u ? mine : 1u; nx = cnt > 0u ? cnt : 1u;
}

__device__ __forceinline__ void xcd_barrier(const XcdBarrier& b) {
    asm volatile("s_waitcnt vmcnt(0)" ::: "memory");
    __syncthreads();
    if (threadIdx.x == 0) {
        unsigned* bar = b.bar;
        __builtin_amdgcn_s_waitcnt(0);
        unsigned nloc = b.st[0], nx = b.st[1];
        if (nloc == 0u) { xcd_barrier_complete(bar, b.x, nloc, nx); b.st[0] = nloc; b.st[1] = nx; }
        const unsigned old = xb_add(&bar[XB_XSUB(b.x)], 1u);
        const unsigned gen = old / nloc;
        if (old + 1u == (gen + 1u) * nloc) {
            __builtin_amdgcn_fence(__ATOMIC_RELEASE, "agent");
            asm volatile("s_waitcnt vmcnt(0)" ::: "memory");
            const unsigned og = xb_add(&bar[XB_TOP], 1u);
            const unsigned tg = og / nx;
            if (og + 1u == (tg + 1u) * nx) xb_add(&bar[XB_TOPGEN], 1u);
            else XB_SPIN(xb_ld(&bar[XB_TOPGEN]) == tg, bar);
            __builtin_amdgcn_fence(__ATOMIC_ACQUIRE, "agent");
            xb_add(&bar[XB_XGEN(b.x)], 1u);
            asm volatile("s_waitcnt vmcnt(0)" ::: "memory");
        } else {
            XB_SPIN(xb_ld(&bar[XB_XGEN(b.x)]) == gen, bar);
            __builtin_amdgcn_fence(__ATOMIC_ACQUIRE, "agent");
            asm volatile("s_waitcnt vmcnt(0)" ::: "memory");
        }
    }
    __syncthreads();
}


struct Args {
    const float* in[33]; float* out; unsigned char* ws; int ph_lo, ph_hi;
};
struct Frame {
    LAS unsigned char* lds; int G;
    const LAS unsigned long long* ptab; float* out; unsigned char* ws;
};
#define GAS __attribute__((address_space(1)))
__device__ __forceinline__ const float* ldptr(const LAS unsigned long long* tab, int k) { const unsigned long long v = tab[k]; const unsigned lo = __builtin_amdgcn_readfirstlane((unsigned)v), hi = __builtin_amdgcn_readfirstlane((unsigned)(v >> 32));
    return (const float*)(const GAS float*)(((unsigned long long)hi << 32) | lo); }
__device__ __forceinline__ unsigned char* fresh(unsigned char* p) { GAS unsigned char* q = (GAS unsigned char*)p; asm volatile("" : "+s"(q)); return (unsigned char*)q; }
__device__ __forceinline__ int fresh_i(int v) { asm volatile("" : "+s"(v)); return v; }
#define INP(k) ldptr(F.ptab, (k))
#define PHASE_L const int l = fresh_i(l_in); (void)l;
#define PHASE_IDS int tid_ = threadIdx.x; asm volatile("" : "+v"(tid_)); const int tid = tid_, lane = tid & 63, wave = __builtin_amdgcn_readfirstlane(tid >> 6), gtid = blockIdx.x * NTHR + tid, gw = blockIdx.x * NWAVES + wave; (void)lane; (void)wave; (void)gtid; (void)gw;
#define VM_WAIT() asm volatile("s_waitcnt vmcnt(0)" ::: "memory")
#define LDS_WAIT() asm volatile("s_waitcnt lgkmcnt(0)" ::: "memory")
constexpr int NT_ALL_SHIFT = 9;

__device__ __forceinline__ void row_info(int m, int& b, int& t, bool& samp) { samp = m >= MPR; if (samp) { b = (m - MPR) >> 6; t = (m - MPR) & 63; } else { b = m >> 11; t = m & 2047; } }

__device__ __forceinline__ void transpose_item(const float* W, int N, bf16_t* WT, int ldk, int k0, int n0, int drow0, LAS float* scr, int lane, const float* cscale = nullptr, const float* rscale = nullptr) {
    f32x4 cs = (f32x4){1.f, 1.f, 1.f, 1.f}; if (cscale) cs = *(const f32x4*)(cscale + n0 + 4 * (lane & 7));
    const int c = lane & 7;
    f32x4 g0 = (f32x4){1.f, 1.f, 1.f, 1.f}, g1 = g0;
    if (rscale) { g0 = *(const f32x4*)(rscale + k0 + 8 * c); g1 = *(const f32x4*)(rscale + k0 + 8 * c + 4); }
    f32x4 v[8];
#pragma unroll
    for (int i = 0; i < 8; ++i) v[i] = *(const f32x4*)(W + (size_t)(k0 + 8 * i + (lane >> 3)) * N + n0 + 4 * (lane & 7));
#pragma unroll
    for (int i = 0; i < 8; ++i) { LAS float* d = scr + (8 * i + (lane >> 3)) * 33 + 4 * (lane & 7); const f32x4 t = v[i] * cs; d[0] = t.x; d[1] = t.y; d[2] = t.z; d[3] = t.w; }
    LDS_WAIT(); asm volatile("" ::: "memory");
#pragma unroll
    for (int j = 0; j < 4; ++j) { const int n = (lane >> 3) + 8 * j; const LAS float* sp = scr + (8 * c) * 33 + n;
        u32x4 o; o.x = cvt_pk_bf16(sp[0 * 33] * g0.x, sp[1 * 33] * g0.y); o.y = cvt_pk_bf16(sp[2 * 33] * g0.z, sp[3 * 33] * g0.w); o.z = cvt_pk_bf16(sp[4 * 33] * g1.x, sp[5 * 33] * g1.y); o.w = cvt_pk_bf16(sp[6 * 33] * g1.z, sp[7 * 33] * g1.w);
        *(u32x4*)(WT + (size_t)(drow0 + n) * ldk + k0 + 8 * c) = o; }
    LDS_WAIT(); asm volatile("" ::: "memory");
}
__device__ __forceinline__ void convert_weights(Frame& F, int l_in) {
    PHASE_IDS
    unsigned char* const wsl = fresh(F.ws);
    PHASE_L
    LAS float* scr = (LAS float*)(F.lds + wave * 16384);
    const int NGW = fresh_i(F.G) * NWAVES;
    unsigned char* ws = wsl;
    constexpr int I_WIN = (DM / 64) * (ICOLS / 32), I_PW = 4 * (256 / 64) * (256 / 32), I_PP = (PWD / 64) * (DM / 32), I_WO = (DM / 64) * (DM / 32), I_FG = (DM / 64) * (FF / 32),
                  I_FD = (FF / 64) * (DM / 32), I_PL = (PLE / 64) * (DM / 32);
    constexpr int NITEMS = I_WIN + I_PW + 2 * I_PP + I_WO + 2 * I_FG + I_FD + I_WO + I_PL;
    for (int it = gw; it < NITEMS; it += NGW) {
        int r = it;
        if (r < I_WIN) { const int nblk = ICOLS / 32, kb = r / nblk, nb = r % nblk, n0 = nb * 32; transpose_item(INP(8) + (size_t)l * DM * ICOLS, ICOLS, (bf16_t*)(ws + WS_WIN), DM, kb * 64, n0, n0 < 4384 ? n0 : n0 + 224, scr, lane, nullptr, INP(7) + (size_t)l * DM); continue; } r -= I_WIN;
        if (r < I_PW) { const int g = r >> 5, rr = r & 31, kb = rr >> 3, nb = rr & 7; transpose_item(INP(10) + ((size_t)l * 4 + g) * 65536, 256, (bf16_t*)(ws + WS_POOLW) + (size_t)g * 65536, 256, kb * 64, nb * 32, nb * 32, scr, lane, INP(11) + (size_t)l * PWD + g * 256); continue; } r -= I_PW;
        if (r < I_PP) { const int nblk = DM / 32, kb = r / nblk, nb = r % nblk; transpose_item(INP(22) + (size_t)l * PWD * DM, DM, (bf16_t*)(ws + WS_PPOOL), PWD, kb * 64, nb * 32, nb * 32, scr, lane); continue; } r -= I_PP;
        if (r < I_PP) { const int nblk = DM / 32, kb = r / nblk, nb = r % nblk; transpose_item(INP(23) + (size_t)l * RWD * DM, DM, (bf16_t*)(ws + WS_PRWKV), RWD, kb * 64, nb * 32, nb * 32, scr, lane); continue; } r -= I_PP;
        if (r < I_WO) { const int nblk = DM / 32, kb = r / nblk, nb = r % nblk; transpose_item(INP(24) + (size_t)l * DM * DM, DM, (bf16_t*)(ws + WS_WOUT), DM, kb * 64, nb * 32, nb * 32, scr, lane); continue; } r -= I_WO;
        if (r < I_FG) { const int nblk = FF / 32, kb = r / nblk, nb = r % nblk, n0 = nb * 32; transpose_item(INP(26) + (size_t)l * DM * FF, FF, (bf16_t*)(ws + WS_WGU), DM, kb * 64, n0, 256 * (n0 >> 7) + 64 * ((n0 & 127) >> 5), scr, lane, nullptr, INP(25) + (size_t)l * DM); continue; } r -= I_FG;
        if (r < I_FG) { const int nblk = FF / 32, kb = r / nblk, nb = r % nblk, n0 = nb * 32; transpose_item(INP(27) + (size_t)l * DM * FF, FF, (bf16_t*)(ws + WS_WGU), DM, kb * 64, n0, 256 * (n0 >> 7) + 64 * ((n0 & 127) >> 5) + 32, scr, lane, nullptr, INP(25) + (size_t)l * DM); continue; } r -= I_FG;
        if (r < I_FD) { const int nblk = DM / 32, kb = r / nblk, nb = r % nblk; transpose_item(INP(28) + (size_t)l * FF * DM, DM, (bf16_t*)(ws + WS_WDN), FF, kb * 64, nb * 32, nb * 32, scr, lane); continue; } r -= I_FD;
        if (r < I_WO) { const int nblk = DM / 32, kb = r / nblk, nb = r % nblk; transpose_item(INP(30) + (size_t)l * DM * DM, DM, (bf16_t*)(ws + WS_WPG), DM, kb * 64, nb * 32, nb * 32, scr, lane, nullptr, INP(29) + (size_t)l * DM); continue; } r -= I_WO;
        { const int nblk = DM / 32, kb = r / nblk, nb = r % nblk; transpose_item(INP(31) + (size_t)l * PLE * DM, DM, (bf16_t*)(ws + WS_WPP), PLE, kb * 64, nb * 32, nb * 32, scr, lane); }
    }
    const int NT = fresh_i(F.G) * NTHR;
    { u32x4* z = (u32x4*)((bf16_t*)(ws + WS_WIN) + (size_t)4384 * DM); for (int i = gtid; i < 224 * DM * 2 / 16; i += NT) z[i] = (u32x4){0u, 0u, 0u, 0u}; }
    { bf16_t* LT = (bf16_t*)(ws + WS_LORA); const float* wd = INP(13) + (size_t)l * 64 * RWD; const float* wa = INP(15) + (size_t)l * 64 * RWD; const float* wg = INP(16) + (size_t)l * 160 * RWD;
      for (int i = gtid; i < 3072 * (LK / 8); i += NT) { const int n = i / (LK / 8), k0 = (i % (LK / 8)) * 8; const int kind = n >> 10, c = n & 1023; float f[8];
#pragma unroll
          for (int j = 0; j < 8; ++j) { const int k = k0 + j; float v = 0.f;
              if (kind == 0) { if (k < 64) v = wd[(size_t)k * RWD + c]; }
              else if (kind == 1) { if (k >= 64 && k < 128) v = wa[(size_t)(k - 64) * RWD + c]; }
              else { if (k >= 128 && k < 288) v = wg[(size_t)(k - 128) * RWD + c]; }
              f[j] = v; }
          *(u32x4*)(LT + (size_t)n * LK + k0) = pack8(f); } }
    { bf16_t* PB = (bf16_t*)(ws + WS_PB); const float* pp = INP(5) + (size_t)l * MPR * PLE; const float* ps = INP(6) + (size_t)l * (MT - MPR) * PLE;
      for (int i = gtid; i < MT * PLE / 8; i += NT) { const size_t e = (size_t)i * 8; const float* src = e < (size_t)MPR * PLE ? pp + e : ps + (e - (size_t)MPR * PLE);
          const f32x4 a = *(const f32x4*)src, b = *(const f32x4*)(src + 4); *(u32x4*)(PB + e) = pg8::pack_f4x2(a, b); } }
}

__device__ __forceinline__ void xb_from_input(Frame& F) {
    PHASE_IDS
    unsigned char* const wsl = fresh(F.ws);
    const int NGW = fresh_i(F.G) * NWAVES; bf16_t* XB = (bf16_t*)(wsl + WS_XN); pg8::ss_t* SS = (pg8::ss_t*)(wsl + WS_SS);
    for (int m = gw; m < MT; m += NGW) {
        const float* src = m < MPR ? INP(0) + (size_t)m * DM : INP(1) + (size_t)(m - MPR) * DM;
        f32x4 v[8]; float s = 0.f;
#pragma unroll
        for (int j = 0; j < 8; ++j) { v[j] = *(const f32x4*)(src + 4 * lane + 256 * j); s += (v[j].x * v[j].x + v[j].y * v[j].y) + (v[j].z * v[j].z + v[j].w * v[j].w); }
        s = wave_sum(s);
        if (lane == 0) SS[m] = pg8::ss_fix(s);
#pragma unroll
        for (int j = 0; j < 8; ++j) { u32x2 w; w.x = cvt_pk_bf16(v[j].x, v[j].y); w.y = cvt_pk_bf16(v[j].z, v[j].w); *(u32x2*)(XB + (size_t)m * DM + 4 * lane + 256 * j) = w; }
    }
}
__device__ __forceinline__ void final_norm(Frame& F, const float* gain) {
    PHASE_IDS
    unsigned char* const wsl = fresh(F.ws);
    const int NGW = fresh_i(F.G) * NWAVES; const bf16_t* XB = (const bf16_t*)(wsl + ((NL & 1) ? WS_XB2 : WS_XN));
    f32x4 g[8];
#pragma unroll
    for (int j = 0; j < 8; ++j) g[j] = *(const f32x4*)(gain + 4 * lane + 256 * j);
    for (int m = gw; m < MT; m += NGW) {
        f32x4 v[8]; float s = 0.f;
#pragma unroll
        for (int j = 0; j < 8; ++j) { const u32x2 w = *(const u32x2*)(XB + (size_t)m * DM + 4 * lane + 256 * j); v[j] = (f32x4){bf_lo(w.x), bf_hi(w.x), bf_lo(w.y), bf_hi(w.y)};
            s += (v[j].x * v[j].x + v[j].y * v[j].y) + (v[j].z * v[j].z + v[j].w * v[j].w); }
        const float rstd = __builtin_amdgcn_rsqf(wave_sum(s) * (1.0f / DM) + NORM_EPS);
#pragma unroll
        for (int j = 0; j < 8; ++j) *(f32x4*)(F.out + (size_t)m * DM + 4 * lane + 256 * j) = v[j] * rstd * g[j];
    }
}

__device__ __forceinline__ void load_z(float (&z)[8], const bf16_t* PROJ, const float* past, int m0, int t, bool samp, int c0) {
    if (t >= 0) { unpack8(*(const u32x4*)(PROJ + (size_t)(m0 + t) * ICP + c0), z); }
    else if (samp) { const float* p = past + (size_t)(15 + t) * PWD + c0; const f32x4 a = *(const f32x4*)p, b = *(const f32x4*)(p + 4); z[0] = a.x; z[1] = a.y; z[2] = a.z; z[3] = a.w; z[4] = b.x; z[5] = b.y; z[6] = b.z; z[7] = b.w; }
    else {
#pragma unroll
        for (int j = 0; j < 8; ++j) z[j] = 0.f; }
}
__device__ __forceinline__ void prep1_phase(Frame& F, int l_in) {
    PHASE_IDS
    unsigned char* const wsl = fresh(F.ws);
    PHASE_L
    const int NT = fresh_i(F.G) * NTHR; const bf16_t* PROJ = (const bf16_t*)(wsl + WS_PROJ);
    { bf16_t* D = (bf16_t*)(wsl + WS_D);
      for (int it = gtid; it < (MT / 16) * 128; it += NT) {
          const int oct = it & 127, run = it >> 7, mrow = run * 16, c0 = oct * 8, win = 2 << (c0 >> 8);
          int b, t0; bool samp; row_info(mrow, b, t0, samp);
          const int T = samp ? TS : TP, mseq = mrow - t0;
          const float* past = INP(3) + ((size_t)l * 8 + b) * 15 * PWD;
          float* npool = F.out + (samp ? O_POS : O_POP) + ((size_t)l * 8 + b) * 15 * PWD;
          float S[8], z[8];
#pragma unroll
          for (int j = 0; j < 8; ++j) S[j] = 0.f;
          for (int j = 1; j < win; ++j) { load_z(z, PROJ, past, mseq, t0 - j, samp, c0);
#pragma unroll
              for (int q = 0; q < 8; ++q) S[q] += z[q]; }
          for (int i = 0; i < 16; ++i) { const int t = t0 + i; float cur[8]; load_z(cur, PROJ, past, mseq, t, samp, c0);
              const int cnt = samp ? win : (t + 1 < win ? t + 1 : win); const float inv = 1.0f / (float)cnt; float d[8];
#pragma unroll
              for (int q = 0; q < 8; ++q) { S[q] += cur[q]; d[q] = S[q] * inv - cur[q]; }
              *(u32x4*)(D + (size_t)(mseq + t) * PWD + c0) = pack8(d);
              if (t >= T - 15) { float* o = npool + (size_t)(t - (T - 15)) * PWD + c0; *(f32x4*)o = (f32x4){cur[0], cur[1], cur[2], cur[3]}; *(f32x4*)(o + 4) = (f32x4){cur[4], cur[5], cur[6], cur[7]}; }
              load_z(z, PROJ, past, mseq, t - win + 1, samp, c0);
#pragma unroll
              for (int q = 0; q < 8; ++q) S[q] -= z[q]; }
      } }
    { bf16_t* LIN = (bf16_t*)(wsl + WS_LIN); const float* mu = INP(9) + (size_t)l * RPJ + 3072;
      for (int it = gtid; it < MT * (LK / 8); it += NT) {
          const int m = it / (LK / 8), c0 = (it % (LK / 8)) * 8; float o[8];
          if (c0 >= 288) {
#pragma unroll
              for (int j = 0; j < 8; ++j) o[j] = 0.f;
          } else {
              int b, t; bool samp; row_info(m, b, t, samp);
              float cur[8], prv[8]; unpack8(*(const u32x4*)(PROJ + (size_t)m * ICP + 4096 + c0), cur);
              if (t > 0) unpack8(*(const u32x4*)(PROJ + (size_t)(m - 1) * ICP + 4096 + c0), prv);
              else if (samp) { const float* p = INP(2) + ((size_t)l * 8 + b) * RPJ + 3072 + c0;
#pragma unroll
                  for (int j = 0; j < 8; ++j) prv[j] = p[j]; }
              else {
#pragma unroll
                  for (int j = 0; j < 8; ++j) prv[j] = 0.f; }
#pragma unroll
              for (int j = 0; j < 8; ++j) { const float xm = cur[j] + (prv[j] - cur[j]) * mu[c0 + j]; o[j] = c0 < 64 ? tanhf_(xm) : (c0 < 128 ? xm : sigmoidf_(xm)); }
          }
          *(u32x4*)(LIN + (size_t)m * LK + c0) = pack8(o);
      } }
    { pg8::ss_t* SS = (pg8::ss_t*)(wsl + WS_SS); for (int i = gtid; i < 3 * MT; i += NT) SS[i] = 0u; }
    for (int it = gtid; it < 16 * RPJ; it += NT) { const int s = it / RPJ, c = it % RPJ; const int mlast = s < 8 ? s * TP + TP - 1 : MPR + (s - 8) * TS + TS - 1;
        F.out[(s < 8 ? O_SHP : O_SHS) + ((size_t)l * 8 + (s & 7)) * RPJ + c] = __uint_as_float((unsigned)PROJ[(size_t)mlast * ICP + 1024 + c] << 16); }
}

__device__ __forceinline__ unsigned char* cb_ptr(unsigned char* ws, size_t i) { return ws + WS_TMP + i * CBSZ; }
__device__ __forceinline__ float sum16(float x) { x += dpp_f<0xB1>(x); x += dpp_f<0x4E>(x); x += dpp_f<0x141>(x); x += dpp_f<0x140>(x); return x; }
__device__ __forceinline__ f32x4 mfma16(bf16x8 a, bf16x8 b, f32x4 c) { return __builtin_amdgcn_mfma_f32_16x16x32_bf16(a, b, c, 0, 0, 0); }
__device__ __forceinline__ bf16x8 mk8(u32x2 lo, u32x2 hi) { u32x4 w = (u32x4){lo.x, lo.y, hi.x, hi.y}; return __builtin_bit_cast(bf16x8, w); }
typedef __bf16 bf16x2_c __attribute__((ext_vector_type(2)));
__device__ __forceinline__ unsigned cvt_pk_c(float lo, float hi) { const f32x2 v = (f32x2){lo, hi}; const bf16x2_c b = __builtin_convertvector(v, bf16x2_c); return __builtin_bit_cast(unsigned, b); }
__device__ __forceinline__ u32x2 pk4(f32x4 v) { return (u32x2){cvt_pk_c(v.x, v.y), cvt_pk_c(v.z, v.w)}; }
__device__ __forceinline__ unsigned short bf1(float f) { return (unsigned short)(cvt_pk_c(f, 0.f) & 0xffffu); }

__device__ __forceinline__ void spre_phase(Frame& F, int l_in) {
    PHASE_IDS
    unsigned char* const wsl = fresh(F.ws);
    PHASE_L
    const int NGW = fresh_i(F.G) * NWAVES;
    LAS unsigned char* L = F.lds + wave * 16384;
    const bf16_t* PROJ = (const bf16_t*)(wsl + WS_PROJ); const bf16_t* AA = (const bf16_t*)(wsl + WS_AA); const float* DEC = (const float*)(wsl + WS_DEC);
    const int fr = lane & 15, fq = lane >> 4;
    const float* mu = INP(9) + (size_t)l * RPJ;
#define SP_LOAD(it_, R, K, V, A, W, PR, PK, PV) do { const int h_ = (it_) & 15, m0_ = ((it_) >> 4) * 16, ch_ = h_ * 64 + lane; int b_, t0_; bool samp_; row_info(m0_, b_, t0_, samp_); \
        _Pragma("unroll") for (int t = 0; t < 16; ++t) { const size_t mm = (size_t)(m0_ + t); const bf16_t* pc = PROJ + mm * ICP + 1024 + ch_; R[t] = pc[0]; K[t] = pc[1024]; V[t] = pc[2048]; A[t] = AA[mm * RWD + ch_]; W[t] = DEC[mm * RWD + ch_]; } \
        if (t0_ > 0) { const bf16_t* pc = PROJ + (size_t)(m0_ - 1) * ICP + 1024 + ch_; PR = __uint_as_float((unsigned)pc[0] << 16); PK = __uint_as_float((unsigned)pc[1024] << 16); PV = __uint_as_float((unsigned)pc[2048] << 16); } \
        else if (samp_) { const float* sp = INP(2) + ((size_t)l * 8 + b_) * RPJ + ch_; PR = sp[0]; PK = sp[1024]; PV = sp[2048]; } \
        else { PR = 0.f; PK = 0.f; PV = 0.f; } } while (0)
    unsigned short cr[16], ck[16], cv[16], ca[16], nr[16], nk[16], nv[16], na[16]; float cw[16], nw[16]; float pr = 0.f, pk = 0.f, pv = 0.f, npr = 0.f, npk = 0.f, npv = 0.f;
    if (gw < (int)CB_N) SP_LOAD(gw, cr, ck, cv, ca, cw, pr, pk, pv);
    for (int it = gw; it < (int)CB_N; it += NGW) {
        const int h = it & 15, crow = it >> 4, m0 = crow * 16, ch = h * 64 + lane;
        unsigned char* cb = cb_ptr(wsl, (size_t)it);
        const float mur = mu[ch], muk = mu[1024 + ch], muv = mu[2048 + ch];
        const float ckk = (INP(17) + (size_t)l * RWD)[ch], cka = (INP(18) + (size_t)l * RWD)[ch], crk = (INP(19) + (size_t)l * RWD)[ch];
        { const int itn = it + NGW; if (itn < (int)CB_N) SP_LOAD(itn, nr, nk, nv, na, nw, npr, npk, npv); }
        float g = 1.0f; unsigned at2[8], bt2[8], kt2[8], vt2[8]; float hold_a = 0.f, hold_b = 0.f, hold_k = 0.f, hold_v = 0.f;
#pragma unroll
        for (int t = 0; t < 16; ++t) {
            const float xr = __uint_as_float((unsigned)cr[t] << 16), xk = __uint_as_float((unsigned)ck[t] << 16), xv = __uint_as_float((unsigned)cv[t] << 16), av = __uint_as_float((unsigned)ca[t] << 16);
            const float r = xr + (pr - xr) * mur, kx = xk + (pk - xk) * muk, vv = xv + (pv - xv) * muv; pr = xr; pk = xk; pv = xv;
            float kkv = kx * ckk; const float ss = wave_sum(kkv * kkv); kkv *= __builtin_amdgcn_rsqf(fmaxf(ss, 1e-24f));
            const float kh = kx * (1.0f + (av - 1.0f) * cka), bb = kkv * av; const float bsum = wave_sum(r * kh * crk);
            if (lane == 0) *(float*)(cb + CB_BS + t * 4) = bsum;
            const float a_t = -kkv * g; g *= cw[t]; const float ig = __builtin_amdgcn_rcpf(g); const float b_t = bb * ig, k_t = kh * ig, r_t = r * g;
            *(LAS unsigned short*)(L + t * 144 + lane * 2) = bf1(a_t); *(LAS unsigned short*)(L + 2304 + t * 144 + lane * 2) = bf1(b_t);
            *(LAS unsigned short*)(L + 4608 + t * 144 + lane * 2) = bf1(k_t); *(LAS unsigned short*)(L + 6912 + t * 144 + lane * 2) = bf1(r_t);
            if (t & 1) { at2[t >> 1] = cvt_pk_c(hold_a, a_t); bt2[t >> 1] = cvt_pk_c(hold_b, b_t); kt2[t >> 1] = cvt_pk_c(hold_k, k_t); vt2[t >> 1] = cvt_pk_c(hold_v, vv); }
            else { hold_a = a_t; hold_b = b_t; hold_k = k_t; hold_v = vv; }
        }
        *(LAS u32x4*)(L + 9216 + lane * 32) = (u32x4){at2[0], at2[1], at2[2], at2[3]}; *(LAS u32x4*)(L + 9216 + lane * 32 + 16) = (u32x4){at2[4], at2[5], at2[6], at2[7]};
        { u32x4* o = (u32x4*)(cb + CB_BK + lane * 64);
#pragma unroll
          for (int q = 0; q < 4; ++q) o[q] = (u32x4){bt2[2 * q], bt2[2 * q + 1], kt2[2 * q], kt2[2 * q + 1]}; }
        { u32x4* o = (u32x4*)(cb + CB_VT + lane * 32); o[0] = (u32x4){vt2[0], vt2[1], vt2[2], vt2[3]}; o[1] = (u32x4){vt2[4], vt2[5], vt2[6], vt2[7]}; }
        *(float*)(cb + CB_GC + lane * 4) = g;
        asm volatile("" ::: "memory");
#define SP_ROWS(off, j) (*(const LAS bf16x8*)(L + (off) + fr * 144 + (j) * 64 + fq * 16))
        f32x4 nD = (f32x4){0.f, 0.f, 0.f, 0.f}, makD = nD, mrbD = nD, mrkD = nD;
#pragma unroll
        for (int j = 0; j < 2; ++j) { const bf16x8 fa = SP_ROWS(0, j), fb = SP_ROWS(2304, j), fk = SP_ROWS(4608, j), fR = SP_ROWS(6912, j);
            nD = mfma16(fb, fa, nD); makD = mfma16(fk, fa, makD); mrbD = mfma16(fb, fR, mrbD); mrkD = mfma16(fk, fR, mrkD); }
#pragma unroll
        for (int rr = 0; rr < 4; ++rr) { const int s = 4 * fq + rr; if (s >= fr) { nD[rr] = 0.f; makD[rr] = 0.f; } if (s > fr) { mrbD[rr] = 0.f; mrkD[rr] = 0.f; } }
        { const u32x2 mb = pk4(mrbD), mk = pk4(mrkD); *(u32x4*)(cb + CB_MBT + (fr * 4 + fq) * 16) = (u32x4){mb.x, mb.y, mk.x, mk.y}; }
#define SP_WR_RM(off, D) do { _Pragma("unroll") for (int rr = 0; rr < 4; ++rr) *(LAS unsigned short*)(L + (off) + (4 * fq + rr) * 32 + fr * 2) = bf1((D)[rr]); } while (0)
#define SP_WR_TR(off, D) do { *(LAS u32x2*)(L + (off) + fr * 32 + fq * 8) = pk4(D); } while (0)
#define SP_FRAG16(off) (fq < 2 ? *(const LAS bf16x8*)(L + (off) + fr * 32 + fq * 16) : (bf16x8){0, 0, 0, 0, 0, 0, 0, 0})
        SP_WR_RM(13568, nD); SP_WR_TR(14080, nD); SP_WR_RM(15616, makD); asm volatile("" ::: "memory");
        f32x4 TD = nD;
#pragma unroll
        for (int rr = 0; rr < 4; ++rr) if (4 * fq + rr == fr) TD[rr] += 1.0f;
#pragma unroll
        for (int itp = 0; itp < 3; ++itp) {
            SP_WR_RM(14592, TD); asm volatile("" ::: "memory");
            const f32x4 p2 = mfma16(SP_FRAG16(13568), SP_FRAG16(14080), (f32x4){0.f, 0.f, 0.f, 0.f}); asm volatile("" ::: "memory");
            SP_WR_RM(13568, p2); SP_WR_TR(14080, p2); asm volatile("" ::: "memory");
            TD = mfma16(SP_FRAG16(14592), SP_FRAG16(14080), TD); asm volatile("" ::: "memory");
        }
        SP_WR_TR(15104, TD); asm volatile("" ::: "memory");
        { const bf16x8 ftt = SP_FRAG16(15104);
#pragma unroll
          for (int blk = 0; blk < 4; ++blk) { const bf16x8 fb = fq < 2 ? *(const LAS bf16x8*)(L + 9216 + (16 * blk + fr) * 32 + fq * 16) : (bf16x8){0, 0, 0, 0, 0, 0, 0, 0};
              const f32x4 d = mfma16(ftt, fb, (f32x4){0.f, 0.f, 0.f, 0.f});
#pragma unroll
              for (int rr = 0; rr < 4; ++rr) *(LAS unsigned short*)(L + 11264 + (4 * fq + rr) * 144 + (16 * blk + fr) * 2) = bf1(d[rr]); }
          const f32x4 p2 = mfma16(SP_FRAG16(15616), ftt, (f32x4){0.f, 0.f, 0.f, 0.f});
          *(u32x2*)(cb + CB_P2T + fr * 32 + fq * 8) = pk4(p2); }
        asm volatile("" ::: "memory");
#pragma unroll
        for (int q = 0; q < 2; ++q) { const int pc = lane + 64 * q, pcc = pc >> 6, pt = (pc >> 2) & 15, pf = pc & 3;
            const u32x2 a0 = *(const LAS u32x2*)(L + 11264 + pt * 144 + (32 * pcc + 4 * pf) * 2), a1 = *(const LAS u32x2*)(L + 11264 + pt * 144 + (32 * pcc + 16 + 4 * pf) * 2);
            const u32x2 r0 = *(const LAS u32x2*)(L + 6912 + pt * 144 + (32 * pcc + 4 * pf) * 2), r1 = *(const LAS u32x2*)(L + 6912 + pt * 144 + (32 * pcc + 16 + 4 * pf) * 2);
            *(u32x4*)(cb + CB_P1T + pc * 16) = (u32x4){a0.x, a0.y, a1.x, a1.y}; *(u32x4*)(cb + CB_RT + pc * 16) = (u32x4){r0.x, r0.y, r1.x, r1.y}; }
        asm volatile("" ::: "memory");
#pragma unroll
        for (int t = 0; t < 16; ++t) { cr[t] = nr[t]; ck[t] = nk[t]; cv[t] = nv[t]; ca[t] = na[t]; cw[t] = nw[t]; }
        pr = npr; pk = npk; pv = npv;
#undef SP_ROWS
#undef SP_LOAD
#undef SP_WR_RM
#undef SP_WR_TR
#undef SP_FRAG16
    }
}

constexpr int SQ_D = 5, SQ_SLOT = 14336, SQ_NSLOT = 7, SQ_DUMP = SQ_NSLOT * SQ_SLOT, SQ_YBUF = SQ_DUMP + 2048;
__device__ __forceinline__ void sseq_phase(Frame& F, int l_in) {
    PHASE_IDS
    unsigned char* const wsl = fresh(F.ws);
    PHASE_L
    const bf16_t* GG = (const bf16_t*)(wsl + WS_GG); bf16_t* YB = (bf16_t*)(wsl + WS_YB);
    const bool is_cons = wave < 4;
    const int fr = lane & 15, fq = lane >> 4, vrow = (wave & 3) * 16 + fr, lw = wave & 3;
    for (int u = blockIdx.x; u < 256; u += fresh_i(F.G)) {
        const bool samp = u >= 128; const int h = u & 15, b = (u >> 4) & 7;
        const int T = samp ? TS : TP, m0 = samp ? MPR + b * TS : b * TP, nch = T / 16, crow0 = m0 / 16;
        f32x4 sreg[4];
        if (samp) { const float* sp = INP(4) + ((((size_t)l * 8 + b) * 16 + h) * 64 + vrow) * 64 + 4 * fq;
#pragma unroll
            for (int kb = 0; kb < 4; ++kb) sreg[kb] = *(const f32x4*)(sp + 16 * kb); }
        else {
#pragma unroll
            for (int kb = 0; kb < 4; ++kb) sreg[kb] = (f32x4){0.f, 0.f, 0.f, 0.f}; }
        const f32x4 gng = *(const f32x4*)(INP(20) + (size_t)l * RWD + h * 64 + 4 * fr), gnb = *(const f32x4*)(INP(21) + (size_t)l * RWD + h * 64 + 4 * fr);
#define SQ_ISSUE(c) do { const unsigned char* src = cb_ptr(wsl, (size_t)(crow0 + (c)) * 16 + h) + (lw * 3) * 1024 + lane * 16; LAS unsigned char* dst = F.lds + ((c) % SQ_NSLOT) * SQ_SLOT + (lw * 3) * 1024; \
        _Pragma("unroll") for (int i = 0; i < 3; ++i) __builtin_amdgcn_global_load_lds((const unsigned*)(src + i * 1024), (LAS unsigned*)(dst + i * 1024), 16, 0, 0); \
        if (lw < 2) __builtin_amdgcn_global_load_lds((const unsigned*)((const unsigned char*)(GG + (size_t)(m0 + (c) * 16 + 8 * lw + (lane >> 3)) * RWD + h * 64) + (lane & 7) * 16), (LAS unsigned*)(F.lds + ((c) % SQ_NSLOT) * SQ_SLOT + 12288 + lw * 1024), 16, 0, 0); \
        else __builtin_amdgcn_global_load_lds((const unsigned*)src, (LAS unsigned*)(F.lds + SQ_DUMP + (lw - 2) * 1024), 16, 0, 0); } while (0)
#define SQ_WAIT(k) do { switch (k) { case 0: asm volatile("s_waitcnt vmcnt(0)" ::: "memory"); break; case 1: asm volatile("s_waitcnt vmcnt(4)" ::: "memory"); break; case 2: asm volatile("s_waitcnt vmcnt(8)" ::: "memory"); break; \
        case 3: asm volatile("s_waitcnt vmcnt(12)" ::: "memory"); break; default: asm volatile("s_waitcnt vmcnt(16)" ::: "memory"); break; } } while (0)
#define SQ_POST(c) do { const LAS unsigned char* Bp = F.lds + ((c) % SQ_NSLOT) * SQ_SLOT; const int tt = 4 * lw + fq; \
        const f32x4 y4 = *(const LAS f32x4*)(F.lds + SQ_YBUF + ((c) & 1) * 4096 + (tt * 64 + 4 * fr) * 4); \
        const float mean = sum16((y4.x + y4.y) + (y4.z + y4.w)) * (1.0f / 64.0f); const f32x4 dv = y4 - mean; \
        const float rstd = __builtin_amdgcn_rsqf(sum16((dv.x * dv.x + dv.y * dv.y) + (dv.z * dv.z + dv.w * dv.w)) * (1.0f / 64.0f) + GN_EPS); \
        const float bs = *(const LAS float*)(Bp + CB_BS + tt * 4); const u32x2 gq = *(const LAS u32x2*)(Bp + 12288 + tt * 128 + fr * 8); \
        f32x4 vv; _Pragma("unroll") for (int j = 0; j < 4; ++j) vv[j] = __uint_as_float((unsigned)(*(const LAS unsigned short*)(Bp + CB_VT + (4 * fr + j) * 32 + tt * 2)) << 16); \
        const f32x4 o = (dv * rstd * gng + gnb + bs * vv) * (f32x4){bf_lo(gq.x), bf_hi(gq.x), bf_lo(gq.y), bf_hi(gq.y)}; \
        *(u32x2*)(YB + (size_t)(m0 + (c) * 16 + tt) * RWD + h * 64 + 4 * fr) = (u32x2){cvt_pk_bf16(o.x, o.y), cvt_pk_bf16(o.z, o.w)}; } while (0)
        __syncthreads();
        if (!is_cons) { const int np = nch < SQ_D ? nch : SQ_D; for (int c = 0; c < np; ++c) SQ_ISSUE(c); SQ_WAIT(np - 1); }
        __syncthreads();
        for (int c = 0; c < nch; ++c) {
            if (is_cons) {
                const LAS unsigned char* B = F.lds + (c % SQ_NSLOT) * SQ_SLOT;
#define SQ_KA(off, cc) (*(const LAS bf16x8*)(B + (off) + (((cc) * 16 + fr) * 4 + fq) * 16))
                const u32x2 vt = *(const LAS u32x2*)(B + CB_VT + vrow * 32 + fq * 8), z2 = (u32x2){0u, 0u};
                const bf16x8 aP2 = mk8(*(const LAS u32x2*)(B + CB_P2T + fr * 32 + fq * 8), z2), aP10 = SQ_KA(CB_P1T, 0), aP11 = SQ_KA(CB_P1T, 1), aR0 = SQ_KA(CB_RT, 0), aR1 = SQ_KA(CB_RT, 1);
                const bf16x8 aM = *(const LAS bf16x8*)(B + CB_MBT + (fr * 4 + fq) * 16);
                bf16x8 aBK[4]; f32x4 gc[4];
#pragma unroll
                for (int kb = 0; kb < 4; ++kb) { aBK[kb] = *(const LAS bf16x8*)(B + CB_BK + ((16 * kb + fr) * 4 + fq) * 16); gc[kb] = *(const LAS f32x4*)(B + CB_GC + (16 * kb + 4 * fq) * 4); }
                __builtin_amdgcn_sched_barrier(0);
                const bf16x8 sB0 = mk8(pk4(sreg[0]), pk4(sreg[1])), sB1 = mk8(pk4(sreg[2]), pk4(sreg[3]));
                f32x4 uD = mfma16(aP2, mk8(vt, z2), (f32x4){0.f, 0.f, 0.f, 0.f});
                uD = mfma16(aP10, sB0, uD); uD = mfma16(aP11, sB1, uD);
                const bf16x8 uvB = mk8(pk4(uD), vt);
                f32x4 nS[4];
#pragma unroll
                for (int kb = 0; kb < 4; ++kb) nS[kb] = mfma16(aBK[kb], uvB, sreg[kb]);
                f32x4 yD = mfma16(aM, uvB, (f32x4){0.f, 0.f, 0.f, 0.f});
                yD = mfma16(aR0, sB0, yD); yD = mfma16(aR1, sB1, yD);
#pragma unroll
                for (int kb = 0; kb < 4; ++kb) sreg[kb] = nS[kb] * gc[kb];
                { LAS float* yo = (LAS float*)(F.lds + SQ_YBUF + (c & 1) * 4096) + (4 * fq) * 64 + vrow; yo[0] = yD[0]; yo[64] = yD[1]; yo[128] = yD[2]; yo[192] = yD[3]; }
#undef SQ_KA
            } else {
                if (c + SQ_D < nch) SQ_ISSUE(c + SQ_D);
                if (c + 1 < nch) { const int last = c + SQ_D < nch ? c + SQ_D : nch - 1; SQ_WAIT(last - (c + 1)); }
                if (c > 0) SQ_POST(c - 1);
            }
            asm volatile("s_waitcnt lgkmcnt(0)" ::: "memory"); __builtin_amdgcn_s_barrier(); asm volatile("" ::: "memory");
        }
        if (!is_cons) SQ_POST(nch - 1);
#undef SQ_ISSUE
#undef SQ_WAIT
#undef SQ_POST
        if (is_cons) { float* so = F.out + (samp ? O_WKS : O_WKP) + ((((size_t)l * 8 + b) * 16 + h) * 64 + vrow) * 64 + 4 * fq;
#pragma unroll
            for (int kb = 0; kb < 4; ++kb) *(f32x4*)(so + 16 * kb) = sreg[kb]; }
    }
    VM_WAIT(); __syncthreads();
}

__device__ __forceinline__ void tile64_mma(const bf16_t* A, int lda, const bf16_t* Bt, int ldb, int K, int m0, int n0, int wave, int lane, f32x4 (&acc)[4][4]) {
    const int kq = K >> 3, kb = wave * kq, lr = lane & 15, lk = (lane >> 4) * 8;
    const bf16_t* ap = A + (size_t)(m0 + lr) * lda + kb + lk; const bf16_t* bp = Bt + (size_t)(n0 + lr) * ldb + kb + lk;
#pragma unroll 2
    for (int k = 0; k < kq; k += 32) {
        bf16x8 af[4], bf[4];
#pragma unroll
        for (int i = 0; i < 4; ++i) { af[i] = *(const bf16x8*)(ap + (size_t)(16 * i) * lda + k); bf[i] = *(const bf16x8*)(bp + (size_t)(16 * i) * ldb + k); }
#pragma unroll
        for (int mi = 0; mi < 4; ++mi)
#pragma unroll
            for (int ni = 0; ni < 4; ++ni) acc[mi][ni] = __builtin_amdgcn_mfma_f32_16x16x32_bf16(bf[ni], af[mi], acc[mi][ni], 0, 0, 0);
    }
}
__device__ __forceinline__ void tile64_reduce(LAS unsigned char* lds, int wave, int lane, const f32x4 (&acc)[4][4], f32x4 (&out)[2]) {
    LAS f32x4* red = (LAS f32x4*)lds;
    __syncthreads();
#pragma unroll
    for (int mi = 0; mi < 4; ++mi)
#pragma unroll
        for (int ni = 0; ni < 4; ++ni) red[(wave * 16 + mi * 4 + ni) * 64 + lane] = acc[mi][ni];
    __syncthreads();
#pragma unroll
    for (int j = 0; j < 2; ++j) { f32x4 s = red[(2 * wave + j) * 64 + lane];
#pragma unroll
        for (int w = 1; w < 8; ++w) s += red[(w * 16 + 2 * wave + j) * 64 + lane];
        out[j] = s; }
}
#define T64_ZERO(acc) do { _Pragma("unroll") for (int mi = 0; mi < 4; ++mi) _Pragma("unroll") for (int ni = 0; ni < 4; ++ni) acc[mi][ni] = (f32x4){0.f, 0.f, 0.f, 0.f}; } while (0)
template <int MODE>
__device__ __forceinline__ void sample_tiles(Frame& F, int l_in, int c0 = 0) {
    PHASE_IDS
    unsigned char* const wsl = fresh(F.ws);
    PHASE_L
    const size_t xb_cur = (l & 1) ? WS_XB2 : WS_XN, xb_nxt = (l & 1) ? WS_XN : WS_XB2;
    for (int t = (int)blockIdx.x >= c0 ? (int)blockIdx.x - c0 : 256; t < 256; t += fresh_i(F.G) - c0) {
        const int m0 = MPR + (t >> 5) * 64, n0 = (t & 31) * 64;
        f32x4 acc[4][4], o1[2], o2[2]; T64_ZERO(acc);
        if (MODE == 0) { tile64_mma((const bf16_t*)(wsl + WS_YA), PWD, (const bf16_t*)(wsl + WS_PPOOL), PWD, PWD, m0, n0, wave, lane, acc); tile64_reduce(F.lds, wave, lane, acc, o1);
                         T64_ZERO(acc); tile64_mma((const bf16_t*)(wsl + WS_YB), RWD, (const bf16_t*)(wsl + WS_PRWKV), RWD, RWD, m0, n0, wave, lane, acc); tile64_reduce(F.lds, wave, lane, acc, o2); }
        if (MODE == 1) { tile64_mma((const bf16_t*)(wsl + WS_MRG), DM, (const bf16_t*)(wsl + WS_WOUT), DM, DM, m0, n0, wave, lane, acc); tile64_reduce(F.lds, wave, lane, acc, o1); }
        if (MODE == 2) { tile64_mma((const bf16_t*)(wsl + WS_HID), FF, (const bf16_t*)(wsl + WS_WDN), FF, FF, m0, n0, wave, lane, acc); tile64_reduce(F.lds, wave, lane, acc, o1); }
        if (MODE == 3) { tile64_mma((const bf16_t*)(wsl + xb_cur), DM, (const bf16_t*)(wsl + WS_WPG), DM, DM, m0, n0, wave, lane, acc); tile64_reduce(F.lds, wave, lane, acc, o1); }
        if (MODE == 4) { tile64_mma((const bf16_t*)(wsl + WS_PB), PLE, (const bf16_t*)(wsl + WS_WPP), PLE, PLE, m0, n0, wave, lane, acc); tile64_reduce(F.lds, wave, lane, acc, o1); }
#pragma unroll
        for (int j = 0; j < 2; ++j) { const int blk = 2 * wave + j; const size_t row = (size_t)(m0 + 16 * (blk >> 2) + (lane & 15)); const int col = n0 + 16 * (blk & 3) + 4 * (lane >> 4);
            if (MODE == 0) { const bf16_t* PROJ = (const bf16_t*)(wsl + WS_PROJ); const u32x2 g1 = *(const u32x2*)(PROJ + row * ICP + PC_GP + col), g2 = *(const u32x2*)(PROJ + row * ICP + PC_GR + col);
                const f32x4 a = (f32x4){bf_lo(g1.x), bf_hi(g1.x), bf_lo(g1.y), bf_hi(g1.y)} * o1[j] + (f32x4){bf_lo(g2.x), bf_hi(g2.x), bf_lo(g2.y), bf_hi(g2.y)} * o2[j];
                *(u32x2*)((bf16_t*)(wsl + WS_MRG) + row * DM + col) = (u32x2){cvt_pk_bf16(a.x, a.y), cvt_pk_bf16(a.z, a.w)}; }
            if (MODE == 1 || MODE == 2) { bf16_t* p = (bf16_t*)(wsl + xb_cur) + row * DM + col; const u32x2 q = *(const u32x2*)p; const f32x4 x = (f32x4){bf_lo(q.x), bf_hi(q.x), bf_lo(q.y), bf_hi(q.y)} + o1[j];
                *(u32x2*)p = (u32x2){cvt_pk_bf16(x.x, x.y), cvt_pk_bf16(x.z, x.w)}; __hip_atomic_fetch_add((pg8::ss_t*)(wsl + WS_SS) + (size_t)MODE * MT + row, pg8::ss_fix((x.x * x.x + x.y * x.y) + (x.z * x.z + x.w * x.w)), __ATOMIC_RELAXED, __HIP_MEMORY_SCOPE_AGENT); }
            if (MODE == 3) { const u32x2 q = *(const u32x2*)((const bf16_t*)(wsl + WS_PP) + row * DM + col); const u32x2 xq = *(const u32x2*)((const bf16_t*)(wsl + xb_cur) + row * DM + col); bf16_t* p = (bf16_t*)(wsl + xb_nxt) + row * DM + col;
                const float rs = pg8::rstd_of((const pg8::ss_t*)(wsl + WS_SS) + (size_t)2 * MT, row);
                const f32x4 x = (f32x4){bf_lo(xq.x), bf_hi(xq.x), bf_lo(xq.y), bf_hi(xq.y)} + sigmoid4(o1[j] * rs) * (f32x4){bf_lo(q.x), bf_hi(q.x), bf_lo(q.y), bf_hi(q.y)};
                *(u32x2*)p = (u32x2){cvt_pk_bf16(x.x, x.y), cvt_pk_bf16(x.z, x.w)}; __hip_atomic_fetch_add((pg8::ss_t*)(wsl + WS_SS) + row, pg8::ss_fix((x.x * x.x + x.y * x.y) + (x.z * x.z + x.w * x.w)), __ATOMIC_RELAXED, __HIP_MEMORY_SCOPE_AGENT); }
            if (MODE == 4) *(u32x2*)((bf16_t*)(wsl + WS_PP) + row * DM + col) = (u32x2){cvt_pk_bf16(o1[j].x, o1[j].y), cvt_pk_bf16(o1[j].z, o1[j].w)};
        }
    }
    __syncthreads();
}

constexpr int PH_PER_LAYER = 11, N_PHASES = NL * PH_PER_LAYER + 1;
#ifndef MK_REP
#define MK_REP 0
#endif
__global__ void __launch_bounds__(NTHR, 2) mega_fwd(Args args) {
    extern __shared__ __attribute__((aligned(16))) unsigned char lds[];
    Frame F;
    F.lds = (LAS unsigned char*)lds;
    F.G = gridDim.x;
    F.out = args.out; F.ws = args.ws;
    { LAS unsigned long long* pt = (LAS unsigned long long*)(F.lds + LDSCTL_OFF + 1024); F.ptab = pt;
      if (threadIdx.x == 0) {
#define PT_(k) pt[k] = (unsigned long long)args.in[k];
          PT_(0) PT_(1) PT_(2) PT_(3) PT_(4) PT_(5) PT_(6) PT_(7) PT_(8) PT_(9) PT_(10) PT_(11) PT_(12) PT_(13) PT_(14) PT_(15) PT_(16) PT_(17) PT_(18) PT_(19) PT_(20) PT_(21) PT_(22) PT_(23) PT_(24) PT_(25) PT_(26) PT_(27) PT_(28) PT_(29) PT_(30) PT_(31) PT_(32)
#undef PT_
      } }
    volatile LAS unsigned* MISC = (volatile LAS unsigned*)(F.lds + LDSCTL_OFF);
    for (int u = threadIdx.x; u < 256; u += NTHR) ((LAS unsigned*)(F.lds + LDSCTL_OFF))[u] = 0u;
    __syncthreads();
    XcdBarrier bar; bar.bar = (unsigned*)(args.ws + WS_CTL) + CW_BAR; bar.x = 0; bar.st = nullptr;
    if (!MK_PER_PHASE) bar = xcd_barrier_post((unsigned*)(args.ws + WS_CTL) + CW_BAR, MISC + 8);
    const int lo = args.ph_lo, hi = args.ph_hi;
#define IN(k) (lo <= (k) && (k) < hi)
#define REP(k) (1 + ((MK_REP >> (k)) & 1))
#define PHASE(k, ...) do { if (IN(pb + (k))) { for (int rep = 0; rep < REP(k); ++rep) { if (rep) xcd_barrier(bar); __VA_ARGS__ } if (IN(pb + (k) + 1)) xcd_barrier(bar); } } while (0)
#define WSP(off) (fresh(F.ws) + (off))
#define UNPAREN(...) __VA_ARGS__
#define GEMM_M(M_, EPI, EINIT, Aoff, Boff, N_, K_, lda_, ldb_, apn_) do { pg8::Gemm g{(const bf16_t*)WSP(Aoff), (const bf16_t*)WSP(Boff), (M_), (N_), (K_), (lda_), (ldb_), (apn_)}; pg8::StaticOrder S; S.init((M_), (N_), fresh_i(F.G), fresh_i(cid)); \
        pg8::EPI E{UNPAREN EINIT}; pg8::gemm_phase<pg8::EPI, pg8::StaticOrder, true>(ring, g, S, E); } while (0)
#define GEMM(...) GEMM_M(MT, __VA_ARGS__)
#define GEMM_PAIR(M_, EPI, EINIT, Aoff, A2off, Boff, N_, K_, lda_, ldb_) do { pg8::Gemm g{(const bf16_t*)WSP(Aoff), (const bf16_t*)WSP(Boff), (M_), (N_), (K_), (lda_), (ldb_), (int)(((A2off) - (Aoff)) / 2)}; pg8::PairOrder S; \
        S.init((M_), (N_), fresh_i(F.G), fresh_i(cid)); pg8::EPI E{UNPAREN EINIT}; pg8::gemm_phase<pg8::EPI, pg8::PairOrder, true>(ring, g, S, E); } while (0)
#define GEMM_SUB(c0_, M_, EPI, EINIT, Aoff, Boff, N_, K_, lda_, ldb_, apn_) do { pg8::Gemm g{(const bf16_t*)WSP(Aoff), (const bf16_t*)WSP(Boff), (M_), (N_), (K_), (lda_), (ldb_), (apn_)}; pg8::StaticOrder S; \
        const int c0v = (c0_); S.init((M_), (N_), fresh_i(F.G) - c0v, fresh_i(cid) >= c0v ? fresh_i(cid) - c0v : -1); pg8::EPI E{UNPAREN EINIT}; pg8::gemm_phase<pg8::EPI, pg8::StaticOrder, true>(ring, g, S, E); } while (0)
    LAS unsigned char* ring = F.lds;
    const int cid = (int)blockIdx.x;
    for (int l = 0; l < NL; ++l) {
        const int pb = l * PH_PER_LAYER;
#define SSP(i) ((pg8::ss_t*)WSP(WS_SS) + (size_t)(i) * MT)
        const size_t xb_cur = (l & 1) ? WS_XB2 : WS_XN, xb_nxt = (l & 1) ? WS_XN : WS_XB2;
        PHASE(0, { convert_weights(F, l); if (l == 0) xb_from_input(F); });
        PHASE(1, { GEMM(EpiProj, ((bf16_t*)WSP(WS_PROJ), SSP(0)), xb_cur, WS_WIN, ICP, DM, DM, DM, 0); });
        PHASE(2, { prep1_phase(F, l); });
        PHASE(3, { GEMM(EpiBf16, ((bf16_t*)WSP(WS_YA), PWD), WS_D, WS_POOLW, PWD, 256, PWD, 256, 256);
                   GEMM(EpiLora, ((float*)WSP(WS_DEC), (bf16_t*)WSP(WS_AA), (bf16_t*)WSP(WS_GG), INP(12) + (size_t)fresh_i(l) * RWD, INP(14) + (size_t)fresh_i(l) * RWD), WS_LIN, WS_LORA, 3072, LK, LK, LK, 0); });
        PHASE(4, { spre_phase(F, l); });
        PHASE(5, { sseq_phase(F, l);
                   { const int c0 = fresh_i(F.G) >= 256 ? 128 : 0; GEMM_SUB(c0, MPR, EpiBf16, ((bf16_t*)WSP(WS_PP), DM), WS_PB, WS_WPP, DM, PLE, PLE, PLE, 0); sample_tiles<4>(F, l, c0); } });
        PHASE(6, { GEMM_PAIR(MPR, EpiGatePair, ((const bf16_t*)WSP(WS_PROJ), PC_GP, PC_GR, (bf16_t*)WSP(WS_MRG)), WS_YA, WS_YB, WS_PPOOL, DM, PWD, PWD, PWD);
                   sample_tiles<0>(F, l); });
        PHASE(7, { GEMM_M(MPR, EpiResid, ((bf16_t*)WSP(xb_cur), SSP(1)), WS_MRG, WS_WOUT, DM, DM, DM, DM, 0); sample_tiles<1>(F, l); });
        PHASE(8, { GEMM(EpiSwiglu, ((bf16_t*)WSP(WS_HID), SSP(1)), xb_cur, WS_WGU, 2 * FF, DM, DM, DM, 0); });
        PHASE(9, { GEMM_M(MPR, EpiResid, ((bf16_t*)WSP(xb_cur), SSP(2)), WS_HID, WS_WDN, DM, FF, FF, FF, 0); sample_tiles<2>(F, l); });
        PHASE(10, { GEMM_M(MPR, EpiPle, ((const bf16_t*)WSP(xb_cur), (bf16_t*)WSP(xb_nxt), (const bf16_t*)WSP(WS_PP), SSP(2), SSP(0)), xb_cur, WS_WPG, DM, DM, DM, DM, 0); sample_tiles<3>(F, l); });
#undef SSP
    }
    if (IN(NL * PH_PER_LAYER)) final_norm(F, INP(32));
#undef IN
#undef REP
#undef PHASE
#undef WSP
#undef GEMM
#undef GEMM_M
#undef GEMM_SUB
#undef UNPAREN
}

extern "C" void kernel_launch(void* const* d_in, const int* in_sizes, int n_in, void* d_out, int out_size, void* d_ws, size_t ws_size, hipStream_t stream) {
    static int grid = 0;
    if (grid == 0) {
        if (n_in != 33 || in_sizes[0] != MPR * DM || out_size != (int)O_END || ws_size < WS_END) {
            fprintf(stderr, "kernel_launch: unexpected shapes: n_in %d in0 %d out %d ws %zu (need %zu); nothing launched\n", n_in, n_in > 0 ? in_sizes[0] : -1, out_size, ws_size, (size_t)WS_END); grid = -1; return; }
        int dev = 0, cus = 0, per_cu = 0;
        if (hipGetDevice(&dev) != hipSuccess || hipDeviceGetAttribute(&cus, hipDeviceAttributeMultiprocessorCount, dev) != hipSuccess) { grid = -1; return; }
        if (hipFuncSetAttribute((const void*)mega_fwd, hipFuncAttributeMaxDynamicSharedMemorySize, LDS_BYTES) != hipSuccess) { fprintf(stderr, "kernel_launch: hipFuncSetAttribute failed\n"); grid = -1; return; }
        if (hipOccupancyMaxActiveBlocksPerMultiprocessor(&per_cu, (const void*)mega_fwd, NTHR, LDS_BYTES) != hipSuccess || per_cu < 1) { fprintf(stderr, "kernel_launch: occupancy query says %d\n", per_cu); (void)hipGetLastError(); grid = -1; return; }
        grid = cus;
    }
    if (grid < 0) return;
    (void)hipMemsetAsync((char*)d_ws + WS_CTL, 0, CTL_ZERO_BYTES, stream);
    Args a; memset(&a, 0, sizeof(a));
    for (int i = 0; i < 33; ++i) a.in[i] = (const float*)d_in[i];
    a.out = (float*)d_out; a.ws = (unsigned char*)d_ws;
#if MK_PER_PHASE
    for (int p = 0; p < N_PHASES; ++p) { a.ph_lo = p; a.ph_hi = p + 1; hipLaunchKernelGGL(mega_fwd, dim3(grid), dim3(NTHR), LDS_BYTES, stream, a); }
#else
    a.ph_lo = 0; a.ph_hi = N_PHASES; hipLaunchKernelGGL(mega_fwd, dim3(grid), dim3(NTHR), LDS_BYTES, stream, a);
#endif
}
```

```cpp
#include <hip/hip_runtime.h>
#include <cstdio>
#include <cstdint>
#include <cstring>

#ifndef MK_PER_PHASE
#define MK_PER_PHASE 0
#endif

#define LAS __attribute__((address_space(3)))
typedef unsigned short bf16_t;
typedef short bf16x8 __attribute__((ext_vector_type(8)));
typedef float f32x4 __attribute__((ext_vector_type(4)));
typedef float f32x2 __attribute__((ext_vector_type(2)));
typedef unsigned u32x4 __attribute__((ext_vector_type(4)));
typedef unsigned u32x2 __attribute__((ext_vector_type(2)));

constexpr int DM = 2048, NL = 4, MT = 16896, MPR = 16384, TP = 2048, TS = 64;
constexpr int PWD = 1024, RWD = 1024, RPJ = 3360, ICOLS = 8480, ICP = 8704, FF = 5632, PLE = 256, LK = 384;
constexpr int PC_GP = 4608, PC_GR = 6656;
constexpr float NORM_EPS = 1e-6f, GN_EPS = 64e-5f;
constexpr size_t O_YS = 33554432, O_SHP = 34603008, O_POP = 34710528, O_WKP = 35202048, O_SHS = 37299200, O_POS = 37406720, O_WKS = 37898240, O_END = 39995392;

__device__ __forceinline__ unsigned cvt_pk_bf16(float lo, float hi) { unsigned r; asm volatile("v_cvt_pk_bf16_f32 %0, %1, %2" : "=v"(r) : "v"(lo), "v"(hi)); return r; }
__device__ __forceinline__ float bf_lo(unsigned u) { return __uint_as_float(u << 16); }
__device__ __forceinline__ float bf_hi(unsigned u) { return __uint_as_float(u & 0xffff0000u); }
__device__ __forceinline__ void unpack8(const u32x4 w, float (&f)[8]) { f[0] = bf_lo(w.x); f[1] = bf_hi(w.x); f[2] = bf_lo(w.y); f[3] = bf_hi(w.y); f[4] = bf_lo(w.z); f[5] = bf_hi(w.z); f[6] = bf_lo(w.w); f[7] = bf_hi(w.w); }
__device__ __forceinline__ u32x4 pack8(const float (&f)[8]) { u32x4 w; w.x = cvt_pk_bf16(f[0], f[1]); w.y = cvt_pk_bf16(f[2], f[3]); w.z = cvt_pk_bf16(f[4], f[5]); w.w = cvt_pk_bf16(f[6], f[7]); return w; }
__device__ __forceinline__ float sigmoidf_(float x) { return __builtin_amdgcn_rcpf(1.0f + __expf(-x)); }
__device__ __forceinline__ f32x4 sigmoid4(f32x4 v) { f32x4 o; o.x = sigmoidf_(v.x); o.y = sigmoidf_(v.y); o.z = sigmoidf_(v.z); o.w = sigmoidf_(v.w); return o; }
__device__ __forceinline__ f32x4 rcp4(f32x4 v) { f32x4 o; o.x = __builtin_amdgcn_rcpf(v.x); o.y = __builtin_amdgcn_rcpf(v.y); o.z = __builtin_amdgcn_rcpf(v.z); o.w = __builtin_amdgcn_rcpf(v.w); return o; }
__device__ __forceinline__ f32x4 fmax4(f32x4 a, f32x4 b) { f32x4 o; o.x = fmaxf(a.x, b.x); o.y = fmaxf(a.y, b.y); o.z = fmaxf(a.z, b.z); o.w = fmaxf(a.w, b.w); return o; }
__device__ __forceinline__ float tanhf_(float x) { const float e = __expf(2.0f * x); return 1.0f - 2.0f * __builtin_amdgcn_rcpf(e + 1.0f); }
template <int CTRL> __device__ __forceinline__ float dpp_f(float x) { return __uint_as_float((unsigned)__builtin_amdgcn_update_dpp(0, (int)__float_as_uint(x), CTRL, 0xF, 0xF, true)); }
__device__ __forceinline__ float sum8(float x) { x += dpp_f<0xB1>(x); x += dpp_f<0x4E>(x); x += dpp_f<0x141>(x); return x; }
__device__ __forceinline__ float wave_sum(float x) {
    x += dpp_f<0xB1>(x); x += dpp_f<0x4E>(x); x += dpp_f<0x141>(x); x += dpp_f<0x140>(x);
    x += __uint_as_float((unsigned)__builtin_amdgcn_ds_swizzle((int)__float_as_uint(x), 0x401F));
    return __uint_as_float((unsigned)__builtin_amdgcn_readlane((int)__float_as_uint(x), 0)) + __uint_as_float((unsigned)__builtin_amdgcn_readlane((int)__float_as_uint(x), 32));
}

namespace pg8 {
typedef unsigned ss_t;
constexpr int BM = 256, BK = 64, HALF = 128, HTB = HALF * BK * 2  , STAGE_BYTES = 8 * HTB, NXCD = 8, WGM = 4;
__host__ __device__ __forceinline__ int lds_g2(int fr) { return (0x1230 >> (4 * (fr >> 2))) & 3; }
__host__ __device__ __forceinline__ int lds_byte(int r, int c) { const int fr = r & 15, h = (c >> 5) & 1, q = (c >> 3) & 3; return (r >> 3) * 1024 + (r & 7) * 128 + ((h ^ ((fr >> 1) & 1)) * 64) + ((q ^ lds_g2(fr)) * 16); }
__host__ __device__ __forceinline__ void stage_rc(int b, int& R, int& C) { const int blk = b / 1024, sl = (b % 1024) / 16, rr8 = sl >> 3, fr = (blk & 1) * 8 + rr8, h = ((sl >> 2) & 1) ^ ((fr >> 1) & 1), q = (sl & 3) ^ lds_g2(fr); R = blk * 8 + rr8; C = 8 * (4 * h + q); }
__host__ __device__ __forceinline__ int perm32(int rho) { const int n = rho >> 4, i = rho & 15; return 8 * (i >> 2) + 4 * n + (i & 3); }

struct Unit { int pm, pn; };
struct Gemm { const bf16_t* A; const bf16_t* Bt; int M, N, K, lda, ldb, a_pn_off; };

struct StaticOrder {
    int nM, nN, nwg, G, c;
    __host__ __device__ void init(int M, int N, int G_, int c_) { nM = M / BM; nN = N / BM; nwg = nM * nN; G = G_; c = c_; }
    __host__ __device__ bool next(int i, Unit& u) const {
        if (c < 0) return false;
        const long L = (long)i * G + c; if (L >= nwg) return false;
        int wgid = (int)L; { const int q = nwg / NXCD, r = nwg % NXCD, xcd = wgid % NXCD, off = wgid / NXCD; wgid = (xcd < r ? xcd * (q + 1) : r * (q + 1) + (xcd - r) * q) + off; }
        const int nig = WGM * nN, gid = wgid / nig, fm = gid * WGM, gsz = (nM - fm) < WGM ? (nM - fm) : WGM;
        u.pm = fm + ((wgid % nig) % gsz); u.pn = ((wgid % nig) / gsz + gid) % nN; return true;
    }
    __device__ __forceinline__ void a_ready(const Unit&) const {}
    __device__ __forceinline__ void done(const Unit&) const {}
};

struct PairOrder : StaticOrder {
    __host__ __device__ bool next(int i, Unit& u) const { if (!StaticOrder::next(i >> 1, u)) return false; u.pn += (i & 1) * 8; return true; }
};
template <class T, class = void> struct paired_t { static constexpr bool v = false; };
template <class T> struct paired_t<T, decltype((void)T::PAIRED)> { static constexpr bool v = true; };

__device__ __forceinline__ void acc_zero(f32x4 (&acc)[2][2][4][2]) {
#pragma unroll
    for (int a = 0; a < 2; ++a)
#pragma unroll
        for (int b = 0; b < 2; ++b)
#pragma unroll
            for (int m = 0; m < 4; ++m)
#pragma unroll
                for (int n = 0; n < 2; ++n) acc[a][b][m][n] = (f32x4){0.f, 0.f, 0.f, 0.f};
}
struct RepeatOrder : StaticOrder {
    __host__ __device__ bool next(int i, Unit& u) const { if (i >= 6) return false; return StaticOrder::next(i % 3, u) || StaticOrder::next(0, u); }
};
#define EPI_ZERO_INIT __device__ __forceinline__ void init(f32x4 (&acc)[2][2][4][2], const Unit&, int, int, int, int) const { acc_zero(acc); }
#define EPI_NO_PRE __device__ __forceinline__ void preload(ss_t (&pre)[2], const Unit&, int, int, int) const {}
#define EPI_SS_PRE(SSPTR) __device__ __forceinline__ void preload(ss_t (&pre)[2], const Unit& u, int wr, int fr, int fq) const { _Pragma("unroll") for (int j = 0; j < 2; ++j) { const int g = 2 * fq + j; \
        pre[j] = (SSPTR)[(size_t)(u.pm * BM + (g >> 2) * HALF + wr * 64 + (g & 3) * 16 + fr)]; } }
__device__ __forceinline__ ss_t pre_get(const ss_t (&pre)[2], int g, int fr) { return (ss_t)__builtin_amdgcn_ds_bpermute((((g >> 1) << 4) + fr) << 2, (int)pre[g & 1]); }
template <class Epi, class Sched, bool ALIGN_EPI>
__device__ __forceinline__ void gemm_phase(LAS unsigned char* lds, const Gemm g, const Sched& S, const Epi& E) {
    int tid_ = threadIdx.x; asm volatile("" : "+v"(tid_));
    const int tid = tid_, wid = __builtin_amdgcn_readfirstlane(tid >> 6), lane = tid & 63, wr = wid >> 2, wc = wid & 3, fr = lane & 15, fq = lane >> 4;
    int K_ = g.K; asm volatile("" : "+s"(K_));
    const int K = K_, nt = K / BK;
    unsigned voffA[2], voffB[2];
#pragma unroll
    for (int i = 0; i < 2; ++i) { int R, C; stage_rc(tid * 16 + i * 8192, R, C); const int Rb = Epi::PERM ? (64 * (R >> 5) + perm32(R & 31)) : R;
        voffA[i] = (unsigned)(R * g.lda + C) * 2u; voffB[i] = (unsigned)(Rb * g.ldb + C) * 2u; }
    const size_t kstep = (size_t)(BK * 2);
    const size_t hstepA = (size_t)HALF * g.lda * 2, hstepB = (size_t)(Epi::PERM ? 32 : HALF) * g.ldb * 2;
    const unsigned ldsw = (unsigned)wid * 1024u;
    int aoff = lds_byte(wr * 64 + fr, fq * 8), boff = lds_byte(wc * 32 + fr, fq * 8);
#define PG8_SA(b, h) (((b) * 2 + (h)) * HTB)
#define PG8_APN(u) (paired_t<Epi>::v ? ((u).pn >> 3) : (u).pn)
#define PG8_SB(b, h) ((4 + (b) * 2 + (h)) * HTB)
#define PG8_STAGE(bufoff, gbase, voff) do { _Pragma("unroll") for (int _i = 0; _i < 2; ++_i) \
        __builtin_amdgcn_global_load_lds((const unsigned*)((const char*)(gbase) + (voff)[_i]), (LAS unsigned*)(lds + (bufoff) + ldsw + _i * 8192), 16, 0, 0); } while (0)
#define PG8_TOG(x) asm volatile("v_xor_b32 %0, 64, %0" : "+v"(x))
#define PG8_LDA(dst, b, h) do { _Pragma("unroll") for (int m = 0; m < 4; ++m) dst[m][0] = *(const LAS bf16x8*)(lds + PG8_SA(b, h) + aoff + m * 2048); PG8_TOG(aoff); \
        _Pragma("unroll") for (int m = 0; m < 4; ++m) dst[m][1] = *(const LAS bf16x8*)(lds + PG8_SA(b, h) + aoff + m * 2048); PG8_TOG(aoff); } while (0)
#define PG8_LDB(dst, b, h) do { _Pragma("unroll") for (int n = 0; n < 2; ++n) dst[n][0] = *(const LAS bf16x8*)(lds + PG8_SB(b, h) + boff + n * 2048); PG8_TOG(boff); \
        _Pragma("unroll") for (int n = 0; n < 2; ++n) dst[n][1] = *(const LAS bf16x8*)(lds + PG8_SB(b, h) + boff + n * 2048); PG8_TOG(boff); } while (0)
#define PG8_MMA(ai, bj, At, Bt) do { __builtin_amdgcn_s_setprio(1); _Pragma("unroll") for (int m = 0; m < 4; ++m) _Pragma("unroll") for (int n = 0; n < 2; ++n) _Pragma("unroll") for (int k = 0; k < 2; ++k) \
        acc[ai][bj][m][n] = __builtin_amdgcn_mfma_f32_16x16x32_bf16(Bt[n][k], At[m][k], acc[ai][bj][m][n], 0, 0, 0); __builtin_amdgcn_s_setprio(0); } while (0)
#define PG8_WAIT_V(n) asm volatile("s_waitcnt vmcnt(" #n ")" ::: "memory")
#define PG8_WAIT_L(n) asm volatile("s_waitcnt lgkmcnt(" #n ")" ::: "memory")
#define PG8_BAR __builtin_amdgcn_s_barrier()
#define PG8_SCHED __builtin_amdgcn_sched_barrier(0)
    Unit cur, nxt; int ui = 0;
    if (!S.next(0, cur)) return;
    f32x4 acc[2][2][4][2]; ss_t pre[2];
    E.init(acc, cur, wr, wc, fr, fq); E.preload(pre, cur, wr, fr, fq);
    bf16x8 At[4][2], B0[2][2], B1[2][2];
    const char* cA = (const char*)g.A + ((size_t)cur.pm * BM * g.lda + (size_t)PG8_APN(cur) * g.a_pn_off) * 2; const char* cB = (const char*)g.Bt + (size_t)cur.pn * BM * g.ldb * 2;
    S.a_ready(cur);
    PG8_STAGE(PG8_SB(0, 0), cB, voffB); PG8_STAGE(PG8_SB(0, 1), cB + hstepB, voffB); PG8_STAGE(PG8_SA(0, 0), cA, voffA); PG8_STAGE(PG8_SA(0, 1), cA + hstepA, voffA);
    if (wr == 1) PG8_BAR;
    PG8_WAIT_V(2); PG8_BAR;
    PG8_STAGE(PG8_SB(1, 0), cB + kstep, voffB); PG8_STAGE(PG8_SA(1, 0), cA + kstep, voffA); PG8_STAGE(PG8_SB(1, 1), cB + hstepB + kstep, voffB);
    PG8_WAIT_V(6); PG8_BAR;
    for (;;) {
        const bool has_next = S.next(ui + 1, nxt);
        const char* nA = has_next ? (const char*)g.A + ((size_t)nxt.pm * BM * g.lda + (size_t)PG8_APN(nxt) * g.a_pn_off) * 2 : cA; const char* nB = has_next ? (const char*)g.Bt + (size_t)nxt.pn * BM * g.ldb * 2 : cB;
#pragma unroll 1
        for (int t = 0; t < nt; t += 2) {
            const bool last = (t == nt - 2);
            const char* a1 = cA + (size_t)(t + 1) * kstep;
            const char* a2 = last ? nA : cA + (size_t)(t + 2) * kstep; const char* b2 = last ? nB : cB + (size_t)(t + 2) * kstep;
            const char* a3 = a2 + kstep; const char* b3 = b2 + kstep;
            if (last && has_next) S.a_ready(nxt);
            PG8_LDB(B0, 0, 0); PG8_LDB(B1, 0, 1); PG8_SCHED; PG8_LDA(At, 0, 0); PG8_STAGE(PG8_SA(1, 1), a1 + hstepA, voffA);
            PG8_WAIT_V(8); PG8_WAIT_L(0); PG8_BAR; PG8_MMA(0, 0, At, B0); PG8_MMA(0, 1, At, B1); PG8_BAR; PG8_SCHED;
            PG8_LDA(At, 0, 1); PG8_STAGE(PG8_SB(0, 0), b2, voffB); PG8_STAGE(PG8_SB(0, 1), b2 + hstepB, voffB); PG8_STAGE(PG8_SA(0, 0), a2, voffA);
            PG8_WAIT_V(8); PG8_WAIT_L(0); PG8_BAR; PG8_MMA(1, 0, At, B0); PG8_MMA(1, 1, At, B1); PG8_BAR; PG8_SCHED;
            PG8_LDB(B0, 1, 0); PG8_LDB(B1, 1, 1); PG8_SCHED; PG8_LDA(At, 1, 0); PG8_STAGE(PG8_SA(0, 1), a2 + hstepA, voffA);
            PG8_WAIT_V(8); PG8_WAIT_L(0); PG8_BAR; PG8_MMA(0, 0, At, B0); PG8_MMA(0, 1, At, B1); PG8_BAR; PG8_SCHED;
            PG8_LDA(At, 1, 1); PG8_STAGE(PG8_SB(1, 0), b3, voffB); PG8_STAGE(PG8_SB(1, 1), b3 + hstepB, voffB); PG8_STAGE(PG8_SA(1, 0), a3, voffA);
            PG8_WAIT_V(8); PG8_WAIT_L(0); PG8_BAR; PG8_MMA(1, 0, At, B0); PG8_MMA(1, 1, At, B1); PG8_BAR; PG8_SCHED;
        }
        if constexpr (ALIGN_EPI) { if (wr == 0) PG8_BAR; }
        E(acc, pre, cur, wr, wc, fr, fq); S.done(cur);
        if (!has_next) break;
        E.init(acc, nxt, wr, wc, fr, fq); E.preload(pre, nxt, wr, fr, fq);
        cur = nxt; cA = nA; cB = nB; ++ui;
        if constexpr (ALIGN_EPI) { if (wr == 1) PG8_BAR; }
    }
    PG8_WAIT_V(0);
    if constexpr (!ALIGN_EPI) { if (wr == 0) PG8_BAR; }
    PG8_BAR;
#undef PG8_SA
#undef PG8_APN
#undef PG8_SB
#undef PG8_STAGE
#undef PG8_LDA
#undef PG8_TOG
#undef PG8_LDB
#undef PG8_MMA
#undef PG8_WAIT_V
#undef PG8_WAIT_L
#undef PG8_BAR
#undef PG8_SCHED
}

#define EPI_ROW0 (u.pm * BM + wr * 64 + fr)
#define EPI_FOR_AI_M _Pragma("unroll") for (int ai = 0; ai < 2; ++ai) _Pragma("unroll") for (int m = 0; m < 4; ++m)
__device__ __forceinline__ u32x4 pack_f4x2(f32x4 v0, f32x4 v1) { u32x4 w; w.x = cvt_pk_bf16(v0[0], v0[1]); w.y = cvt_pk_bf16(v0[2], v0[3]); w.z = cvt_pk_bf16(v1[0], v1[1]); w.w = cvt_pk_bf16(v1[2], v1[3]); return w; }
__device__ __forceinline__ void unpack_f4x2(u32x4 w, f32x4& v0, f32x4& v1) { v0[0] = bf_lo(w.x); v0[1] = bf_hi(w.x); v0[2] = bf_lo(w.y); v0[3] = bf_hi(w.y); v1[0] = bf_lo(w.z); v1[1] = bf_hi(w.z); v1[2] = bf_lo(w.w); v1[3] = bf_hi(w.w); }
__device__ __forceinline__ unsigned ror8(unsigned x) { return (unsigned)__builtin_amdgcn_update_dpp(0, (int)x, 0x128, 0xF, 0xF, true); }
__device__ __forceinline__ void st_pair(char* grp, size_t pitch, int fr, int fq, u32x4 vA, u32x4 vB) {
    const bool lo = fr < 8;
    u32x4 snd = lo ? vB : vA, rcv; rcv.x = ror8(snd.x); rcv.y = ror8(snd.y); rcv.z = ror8(snd.z); rcv.w = ror8(snd.w);
    char* p = grp + (size_t)(fr & 7) * pitch + (lo ? 0 : 64) + fq * 16;
    *(u32x4*)p = lo ? vA : rcv;
    *(u32x4*)(p + 8 * pitch) = lo ? rcv : vB;
}
__device__ __forceinline__ u32x4 as_u4(f32x4 v) { return __builtin_bit_cast(u32x4, v); }

__device__ __forceinline__ float rstd_raw(ss_t v) { return __builtin_amdgcn_rsqf((float)v * (1.0f / (256.0f * DM)) + NORM_EPS); }
__device__ __forceinline__ float rstd_of(const ss_t* SS, size_t row) { return rstd_raw(SS[row]); }
__device__ __forceinline__ ss_t ss_fix(float s) { return (ss_t)(s * 256.0f + 0.5f); }
__device__ __forceinline__ float sq8(f32x4 a, f32x4 b) { return (a.x * a.x + a.y * a.y) + (a.z * a.z + a.w * a.w) + (b.x * b.x + b.y * b.y) + (b.z * b.z + b.w * b.w); }
__device__ __forceinline__ void ss_add(ss_t* SS, size_t row, float s, int fq, int fr) { s += __uint_as_float((unsigned)__builtin_amdgcn_ds_swizzle((int)__float_as_uint(s), 0x401F));
    s += __uint_as_float((unsigned)__builtin_amdgcn_ds_bpermute((((fq ^ 2) << 4) + fr) << 2, (int)__float_as_uint(s)));
    if (fq == 0) __hip_atomic_fetch_add(SS + row, ss_fix(s), __ATOMIC_RELAXED, __HIP_MEMORY_SCOPE_AGENT); }
struct EpiNull { static constexpr bool PERM = true; EPI_NO_PRE EPI_ZERO_INIT __device__ __forceinline__ void operator()(const f32x4 (&acc)[2][2][4][2], const ss_t (&pre)[2], const Unit& u, int wr, int wc, int fr, int fq) const {
#pragma unroll
    for (int a = 0; a < 2; ++a)
#pragma unroll
        for (int b = 0; b < 2; ++b)
#pragma unroll
            for (int m = 0; m < 4; ++m)
#pragma unroll
                for (int n = 0; n < 2; ++n) asm volatile("" :: "v"(acc[a][b][m][n]));
} };
struct EpiProj { static constexpr bool PERM = true; EPI_ZERO_INIT
    bf16_t* O; const ss_t* SS; EPI_SS_PRE(SS)
    __device__ __forceinline__ void operator()(const f32x4 (&acc)[2][2][4][2], const ss_t (&pre)[2], const Unit& u, int wr, int wc, int fr, int fq) const {
        const bool sg = u.pn >= 18;
        EPI_FOR_AI_M { const size_t r0 = (size_t)(u.pm * BM + ai * HALF + wr * 64 + m * 16); char* grp = (char*)(O + r0 * ICP + u.pn * BM + 64 * wc); const float rs = rstd_raw(pre_get(pre, ai * 4 + m, fr));
            f32x4 a0 = acc[ai][0][m][0] * rs, a1 = acc[ai][0][m][1] * rs, b0 = acc[ai][1][m][0] * rs, b1 = acc[ai][1][m][1] * rs;
            if (sg) { a0 = sigmoid4(a0); a1 = sigmoid4(a1); b0 = sigmoid4(b0); b1 = sigmoid4(b1); }
            st_pair(grp, (size_t)ICP * 2, fr, fq, pack_f4x2(a0, a1), pack_f4x2(b0, b1)); }
    }
};
struct EpiBf16 { static constexpr bool PERM = true; EPI_NO_PRE EPI_ZERO_INIT
    bf16_t* O; int ldc;
    __device__ __forceinline__ void operator()(const f32x4 (&acc)[2][2][4][2], const ss_t (&pre)[2], const Unit& u, int wr, int wc, int fr, int fq) const {
        EPI_FOR_AI_M { char* grp = (char*)(O + (size_t)(u.pm * BM + ai * HALF + wr * 64 + m * 16) * ldc + u.pn * BM + 64 * wc);
            st_pair(grp, (size_t)ldc * 2, fr, fq, pack_f4x2(acc[ai][0][m][0], acc[ai][0][m][1]), pack_f4x2(acc[ai][1][m][0], acc[ai][1][m][1])); }
    }
};
struct EpiLora { static constexpr bool PERM = true; EPI_NO_PRE EPI_ZERO_INIT
    float* DEC; bf16_t* AA; bf16_t* GG; const float* w0; const float* a0;
    __device__ __forceinline__ void operator()(const f32x4 (&acc)[2][2][4][2], const ss_t (&pre)[2], const Unit& u, int wr, int wc, int fr, int fq) const {
        const int row0 = EPI_ROW0, kind = u.pn >> 2, ct = (u.pn & 3) * BM + 64 * wc, col0 = ct + 8 * fq;
        if (kind == 0) {
            EPI_FOR_AI_M { float* rowp = DEC + (size_t)(row0 + ai * HALF + m * 16) * RWD + col0;
#pragma unroll
                for (int bj = 0; bj < 2; ++bj)
#pragma unroll
                    for (int n = 0; n < 2; ++n) { const f32x4 b = *(const f32x4*)(w0 + col0 + bj * 32 + 4 * n); const f32x4 x = acc[ai][bj][m][n] + b; f32x4 o;
#pragma unroll
                        for (int j = 0; j < 4; ++j) { const float z = -x[j]; const float sp = z > 15.f ? z : __logf(1.0f + __expf(z)); const float w = -sp - 0.5f; o[j] = __expf(-__expf(w)); }
                        *(f32x4*)(rowp + bj * 32 + 4 * n) = o; } asm volatile("" ::: "memory"); }
        } else if (kind == 1) {
            const f32x4 b00 = *(const f32x4*)(a0 + col0), b01 = *(const f32x4*)(a0 + col0 + 4), b10 = *(const f32x4*)(a0 + col0 + 32), b11 = *(const f32x4*)(a0 + col0 + 36);
            EPI_FOR_AI_M { char* grp = (char*)(AA + (size_t)(u.pm * BM + ai * HALF + wr * 64 + m * 16) * RWD + ct);
                st_pair(grp, (size_t)RWD * 2, fr, fq, pack_f4x2(sigmoid4(acc[ai][0][m][0] + b00), sigmoid4(acc[ai][0][m][1] + b01)), pack_f4x2(sigmoid4(acc[ai][1][m][0] + b10), sigmoid4(acc[ai][1][m][1] + b11))); }
        } else {
            EPI_FOR_AI_M { char* grp = (char*)(GG + (size_t)(u.pm * BM + ai * HALF + wr * 64 + m * 16) * RWD + ct);
                st_pair(grp, (size_t)RWD * 2, fr, fq, pack_f4x2(acc[ai][0][m][0], acc[ai][0][m][1]), pack_f4x2(acc[ai][1][m][0], acc[ai][1][m][1])); }
        }
    }
};
struct EpiGate1 { static constexpr bool PERM = true; EPI_NO_PRE EPI_ZERO_INIT
    bf16_t* TMP; const bf16_t* PROJ; int gcol0;
    __device__ __forceinline__ void operator()(const f32x4 (&acc)[2][2][4][2], const ss_t (&pre)[2], const Unit& u, int wr, int wc, int fr, int fq) const {
        const int row0 = EPI_ROW0, ct = u.pn * BM + 64 * wc, col0 = ct + 8 * fq;
        EPI_FOR_AI_M { const size_t row = (size_t)(row0 + ai * HALF + m * 16);
            f32x4 g00, g01, g10, g11; unpack_f4x2(*(const u32x4*)(PROJ + row * ICP + gcol0 + col0), g00, g01); unpack_f4x2(*(const u32x4*)(PROJ + row * ICP + gcol0 + col0 + 32), g10, g11);
            st_pair((char*)(TMP + (size_t)(u.pm * BM + ai * HALF + wr * 64 + m * 16) * DM + ct), (size_t)DM * 2, fr, fq, pack_f4x2(acc[ai][0][m][0] * g00, acc[ai][0][m][1] * g01), pack_f4x2(acc[ai][1][m][0] * g10, acc[ai][1][m][1] * g11));
            if (m & 1) asm volatile("" ::: "memory"); }
    }
};
struct EpiGate2 { static constexpr bool PERM = true; EPI_NO_PRE EPI_ZERO_INIT
    const bf16_t* TMP; const bf16_t* PROJ; int gcol0; bf16_t* O;
    __device__ __forceinline__ void operator()(const f32x4 (&acc)[2][2][4][2], const ss_t (&pre)[2], const Unit& u, int wr, int wc, int fr, int fq) const {
        const int row0 = EPI_ROW0, ct = u.pn * BM + 64 * wc, col0 = ct + 8 * fq;
        EPI_FOR_AI_M { const size_t row = (size_t)(row0 + ai * HALF + m * 16);
            f32x4 g00, g01, g10, g11, t00, t01, t10, t11; unpack_f4x2(*(const u32x4*)(PROJ + row * ICP + gcol0 + col0), g00, g01); unpack_f4x2(*(const u32x4*)(PROJ + row * ICP + gcol0 + col0 + 32), g10, g11);
            unpack_f4x2(*(const u32x4*)(TMP + row * DM + col0), t00, t01); unpack_f4x2(*(const u32x4*)(TMP + row * DM + col0 + 32), t10, t11);
            st_pair((char*)(O + (size_t)(u.pm * BM + ai * HALF + wr * 64 + m * 16) * DM + ct), (size_t)DM * 2, fr, fq, pack_f4x2(t00 + acc[ai][0][m][0] * g00, t01 + acc[ai][0][m][1] * g01), pack_f4x2(t10 + acc[ai][1][m][0] * g10, t11 + acc[ai][1][m][1] * g11));
            if (m & 1) asm volatile("" ::: "memory"); }
    }
};
struct EpiGatePair { static constexpr bool PERM = true; static constexpr bool PAIRED = true; EPI_NO_PRE
    const bf16_t* PROJ; int gc1, gc2; bf16_t* O;
    __device__ __forceinline__ void init(f32x4 (&acc)[2][2][4][2], const Unit& u, int, int, int, int) const { if (u.pn < 8) acc_zero(acc); }
    __device__ __forceinline__ void operator()(f32x4 (&acc)[2][2][4][2], const ss_t (&pre)[2], const Unit& u, int wr, int wc, int fr, int fq) const {
        const int row0 = EPI_ROW0, ct = (u.pn & 7) * BM + 64 * wc, col0 = ct + 8 * fq;
        const f32x4 flo = (f32x4){0x1p-60f, 0x1p-60f, 0x1p-60f, 0x1p-60f};
        if (u.pn < 8) {
#pragma unroll
            for (int ai = 0; ai < 2; ++ai) { u32x4 q[4][4];
#pragma unroll
                for (int m = 0; m < 4; ++m) { const bf16_t* p = PROJ + (size_t)(row0 + ai * HALF + m * 16) * ICP + col0; q[m][0] = *(const u32x4*)(p + gc1); q[m][1] = *(const u32x4*)(p + gc1 + 32); q[m][2] = *(const u32x4*)(p + gc2); q[m][3] = *(const u32x4*)(p + gc2 + 32); }
                __builtin_amdgcn_sched_barrier(0);
#pragma unroll
                for (int m = 0; m < 4; ++m) { f32x4 g00, g01, g10, g11, h00, h01, h10, h11; unpack_f4x2(q[m][0], g00, g01); unpack_f4x2(q[m][1], g10, g11); unpack_f4x2(q[m][2], h00, h01); unpack_f4x2(q[m][3], h10, h11);
                    acc[ai][0][m][0] *= g00 * rcp4(fmax4(h00, flo)); acc[ai][0][m][1] *= g01 * rcp4(fmax4(h01, flo)); acc[ai][1][m][0] *= g10 * rcp4(fmax4(h10, flo)); acc[ai][1][m][1] *= g11 * rcp4(fmax4(h11, flo)); }
                __builtin_amdgcn_sched_barrier(0); }
        } else {
            u32x4 q[2][4][2];
#pragma unroll
            for (int ai = 0; ai < 2; ++ai)
#pragma unroll
                for (int m = 0; m < 4; ++m) { const bf16_t* p = PROJ + (size_t)(row0 + ai * HALF + m * 16) * ICP + gc2 + col0; q[ai][m][0] = *(const u32x4*)p; q[ai][m][1] = *(const u32x4*)(p + 32); }
            __builtin_amdgcn_sched_barrier(0);
            EPI_FOR_AI_M { f32x4 h00, h01, h10, h11; unpack_f4x2(q[ai][m][0], h00, h01); unpack_f4x2(q[ai][m][1], h10, h11);
                st_pair((char*)(O + (size_t)(u.pm * BM + ai * HALF + wr * 64 + m * 16) * DM + ct), (size_t)DM * 2, fr, fq, pack_f4x2(acc[ai][0][m][0] * fmax4(h00, flo), acc[ai][0][m][1] * fmax4(h01, flo)),
                        pack_f4x2(acc[ai][1][m][0] * fmax4(h10, flo), acc[ai][1][m][1] * fmax4(h11, flo)));
                if (m & 1) __builtin_amdgcn_sched_barrier(0); }
        }
    }
};
struct EpiResid { static constexpr bool PERM = true; EPI_NO_PRE
    bf16_t* XB; ss_t* SS;
    __device__ __forceinline__ void init(f32x4 (&acc)[2][2][4][2], const Unit& u, int wr, int wc, int fr, int fq) const {
        const int row0 = EPI_ROW0, col0 = u.pn * BM + 64 * wc + 8 * fq;
        EPI_FOR_AI_M { const bf16_t* rowp = XB + (size_t)(row0 + ai * HALF + m * 16) * DM + col0;
            unpack_f4x2(*(const u32x4*)rowp, acc[ai][0][m][0], acc[ai][0][m][1]); unpack_f4x2(*(const u32x4*)(rowp + 32), acc[ai][1][m][0], acc[ai][1][m][1]); }
    }
    __device__ __forceinline__ void operator()(const f32x4 (&acc)[2][2][4][2], const ss_t (&pre)[2], const Unit& u, int wr, int wc, int fr, int fq) const {
        EPI_FOR_AI_M { const size_t r0 = (size_t)(u.pm * BM + ai * HALF + wr * 64 + m * 16);
            st_pair((char*)(XB + r0 * DM + u.pn * BM + 64 * wc), (size_t)DM * 2, fr, fq, pack_f4x2(acc[ai][0][m][0], acc[ai][0][m][1]), pack_f4x2(acc[ai][1][m][0], acc[ai][1][m][1]));
            ss_add(SS, r0 + fr, sq8(acc[ai][0][m][0], acc[ai][0][m][1]) + sq8(acc[ai][1][m][0], acc[ai][1][m][1]), fq, fr); }
    }
};
struct EpiSwiglu { static constexpr bool PERM = true; EPI_ZERO_INIT
    bf16_t* H; const ss_t* SS; EPI_SS_PRE(SS)
    __device__ __forceinline__ void operator()(const f32x4 (&acc)[2][2][4][2], const ss_t (&pre)[2], const Unit& u, int wr, int wc, int fr, int fq) const {
        const int row0 = EPI_ROW0, col0 = u.pn * HALF + wc * 32 + 8 * fq;
        EPI_FOR_AI_M { const size_t row = (size_t)(row0 + ai * HALF + m * 16); const float rs = rstd_raw(pre_get(pre, ai * 4 + m, fr));
            const f32x4 g0 = acc[ai][0][m][0] * rs, g1 = acc[ai][0][m][1] * rs, u0 = acc[ai][1][m][0] * rs, u1 = acc[ai][1][m][1] * rs;
            *(u32x4*)(H + row * FF + col0) = pack_f4x2(g0 * sigmoid4(g0) * u0, g1 * sigmoid4(g1) * u1); }
    }
};
struct EpiPle { static constexpr bool PERM = true; EPI_ZERO_INIT EPI_SS_PRE(SSi)
    const bf16_t* XB; bf16_t* XO; const bf16_t* PP; const ss_t* SSi; ss_t* SSo;
    __device__ __forceinline__ void operator()(const f32x4 (&acc)[2][2][4][2], const ss_t (&pre)[2], const Unit& u, int wr, int wc, int fr, int fq) const {
        const int col0 = u.pn * BM + 64 * wc + 8 * fq;
        EPI_FOR_AI_M { const size_t r0 = (size_t)(u.pm * BM + ai * HALF + wr * 64 + m * 16), row = r0 + fr; const float rs = rstd_raw(pre_get(pre, ai * 4 + m, fr));
            f32x4 x00, x01, x10, x11, p00, p01, p10, p11; unpack_f4x2(*(const u32x4*)(XB + row * DM + col0), x00, x01); unpack_f4x2(*(const u32x4*)(XB + row * DM + col0 + 32), x10, x11);
            unpack_f4x2(*(const u32x4*)(PP + row * DM + col0), p00, p01); unpack_f4x2(*(const u32x4*)(PP + row * DM + col0 + 32), p10, p11);
            x00 += sigmoid4(acc[ai][0][m][0] * rs) * p00; x01 += sigmoid4(acc[ai][0][m][1] * rs) * p01; x10 += sigmoid4(acc[ai][1][m][0] * rs) * p10; x11 += sigmoid4(acc[ai][1][m][1] * rs) * p11;
            st_pair((char*)(XO + r0 * DM + u.pn * BM + 64 * wc), (size_t)DM * 2, fr, fq, pack_f4x2(x00, x01), pack_f4x2(x10, x11));
            ss_add(SSo, row, sq8(x00, x01) + sq8(x10, x11), fq, fr);
            if (m & 1) asm volatile("" ::: "memory"); }
    }
};
#undef EPI_ROW0
#undef EPI_FOR_AI_M
}

constexpr size_t MiB = 1u << 20;
constexpr size_t al1m(size_t x) { return (x + MiB - 1) / MiB * MiB; }
constexpr size_t WS_CTL = 0, CTL_ZERO_BYTES = 1 * MiB;
constexpr size_t SZ_WIN = (size_t)ICP * DM * 2, SZ_POOLW = (size_t)PWD * 256 * 2, SZ_LORA = (size_t)3072 * LK * 2, SZ_PPOOL = (size_t)DM * PWD * 2, SZ_PRWKV = (size_t)DM * RWD * 2,
                 SZ_WOUT = (size_t)DM * DM * 2, SZ_WGU = (size_t)2 * FF * DM * 2, SZ_WDN = (size_t)DM * FF * 2, SZ_WPG = (size_t)DM * DM * 2, SZ_WPP = (size_t)DM * PLE * 2;
constexpr size_t WS_WIN = 1 * MiB, WS_POOLW = WS_WIN + SZ_WIN, WS_LORA = WS_POOLW + SZ_POOLW, WS_PPOOL = WS_LORA + SZ_LORA, WS_PRWKV = WS_PPOOL + SZ_PPOOL, WS_WOUT = WS_PRWKV + SZ_PRWKV,
                 WS_WGU = WS_WOUT + SZ_WOUT, WS_WDN = WS_WGU + SZ_WGU, WS_WPG = WS_WDN + SZ_WDN, WS_WPP = WS_WPG + SZ_WPG, WS_WEND = WS_WPP + SZ_WPP;
constexpr size_t WS_PB = al1m(WS_WEND);
constexpr size_t WS_XN = al1m(WS_PB + (size_t)MT * PLE * 2);
constexpr size_t WS_AA = al1m(WS_XN + (size_t)MT * DM * 2);
constexpr size_t WS_GG = al1m(WS_AA + (size_t)MT * RWD * 2);
constexpr size_t WS_PP = al1m(WS_GG + (size_t)MT * RWD * 2);
constexpr size_t WS_PROJ = al1m(WS_PP + (size_t)MT * DM * 2);
constexpr size_t WS_HID = WS_PROJ;
constexpr size_t WS_D = al1m(WS_PROJ + (size_t)MT * ICP * 2);
constexpr size_t WS_LIN = al1m(WS_D + (size_t)MT * PWD * 2);
constexpr size_t WS_YA = al1m(WS_LIN + (size_t)MT * LK * 2);
constexpr size_t WS_DEC = al1m(WS_YA + (size_t)MT * PWD * 2);
constexpr size_t WS_BS = al1m(WS_DEC + (size_t)MT * RWD * 4);
constexpr size_t WS_Y = al1m(WS_BS + (size_t)MT * 16 * 4);
constexpr size_t SZ_BH = (size_t)MT * RWD * 2;
constexpr size_t WS_YB = al1m(WS_Y + (size_t)MT * RWD * 4);
constexpr size_t WS_TMP = al1m(WS_YB + SZ_BH);
constexpr size_t WS_MRG = al1m(WS_TMP + (size_t)MT * DM * 4);
constexpr size_t WS_SS = al1m(WS_MRG + (size_t)MT * DM * 2);
constexpr size_t WS_END_OLD = al1m(WS_MRG + (size_t)MT * DM * 2);
static_assert((size_t)MT * FF * 2 <= (size_t)MT * ICP * 2, "HID overlay");

constexpr size_t WS_XB2 = al1m(WS_SS + (size_t)3 * MT * 4);
constexpr size_t CBSZ = 12096, CB_BS = 12032, CB_P1T = 0, CB_RT = 2048, CB_BK = 4096, CB_VT = 8192, CB_P2T = 10240, CB_MBT = 10752, CB_MKT = 11264, CB_GC = 11776;
constexpr size_t CB_N = (size_t)(MT / 16) * 16;
static_assert(WS_MRG + (size_t)MT * DM * 2 - WS_TMP >= CB_N * CBSZ, "chunk blocks fit in TMP | MRG");
static_assert(WS_PRWKV == WS_PPOOL + (size_t)8 * 256 * PWD * 2 && PWD == RWD && (WS_YB - WS_YA) / 2 < (size_t)0x7fffffff, "the paired gate GEMM walks proj_pool | proj_rwkv as one [4096][1024] matrix");
constexpr size_t WS_END = al1m(WS_XB2 + (size_t)MT * DM * 2);
constexpr int CW_BAR = 4096;
constexpr int NWAVES = 8, NTHR = 512;
constexpr int RING_BYTES = 131072, LDSCTL_OFF = RING_BYTES, LDS_BYTES = 147456;

#define XB_TMO      128
#define XB_XCNT(j)  (256  + 64 * (j))
#define XB_XSUB(j)  (1280 + 64 * (j))
#define XB_XGEN(j)  (2304 + 64 * (j))
#define XB_TOP      3328
#define XB_TOPGEN   3392
#define XCD_BAR_WORDS 3456
#define XB_SPIN_CAP (1u << 18)

__device__ __forceinline__ unsigned xb_ld(unsigned* p)              { return __hip_atomic_load(p, __ATOMIC_RELAXED, __HIP_MEMORY_SCOPE_AGENT); }
__device__ __forceinline__ unsigned xb_add(unsigned* p, unsigned v) { return __hip_atomic_fetch_add(p, v, __ATOMIC_RELAXED, __HIP_MEMORY_SCOPE_AGENT); }
__device__ __forceinline__ unsigned xb_xcc_id() { return (unsigned)__builtin_amdgcn_s_getreg((3 << 11) | 20) & 0xFu; }
#define XB_SPIN(cond, bar) do { unsigned _sp = 0; while (cond) { __builtin_amdgcn_s_sleep(1); \
    if ((++_sp & 255u) == 0u) { if (xb_ld(&(bar)[XB_TMO])) break; if (_sp > XB_SPIN_CAP) { atomicAdd(&(bar)[XB_TMO], 1u); break; } } } } while (0)

struct XcdBarrier {
    unsigned* bar; unsigned x;
    volatile LAS unsigned* st;
};

__device__ __forceinline__ XcdBarrier xcd_barrier_post(unsigned* bar, volatile LAS unsigned* st) {
    XcdBarrier b; b.bar = bar; b.x = xb_xcc_id(); b.st = st;
    if (threadIdx.x == 0) (void)xb_add(&bar[XB_XCNT(b.x)], 1u);
    return b;
}
__device__ __forceinline__ void xcd_barrier_complete(unsigned* bar, unsigned x, unsigned& nloc, unsigned& nx) {
    const unsigned G = gridDim.x * gridDim.y * gridDim.z;
    unsigned sum, cnt, mine, sp = 0u;
    for (;;) {
        sum = 0u; cnt = 0u; mine = 0u;
#pragma unroll
        for (unsigned j = 0; j < 16; ++j) { const unsigned c = xb_ld(&bar[XB_XCNT(j)]); sum += c; cnt += (c > 0u) ? 1u : 0u; mine = (j == x) ? c : mine; }
        if (sum == G) break;
        __builtin_amdgcn_s_sleep(1);
        if ((++sp & 255u) == 0u) { if (xb_ld(&bar[XB_TMO])) break; if (sp > XB_SPIN_CAP) { atomicAdd(&bar[XB_TMO], 1u); break; } }
    }
    nloc = mine > 0u ? mine : 1u; nx = cnt > 0u ? cnt : 1u;
}

__device__ __forceinline__ void xcd_barrier(const XcdBarrier& b) {
    asm volatile("s_waitcnt vmcnt(0)" ::: "memory");
    __syncthreads();
    if (threadIdx.x == 0) {
        unsigned* bar = b.bar;
        __builtin_amdgcn_s_waitcnt(0);
        unsigned nloc = b.st[0], nx = b.st[1];
        if (nloc == 0u) { xcd_barrier_complete(bar, b.x, nloc, nx); b.st[0] = nloc; b.st[1] = nx; }
        const unsigned old = xb_add(&bar[XB_XSUB(b.x)], 1u);
        const unsigned gen = old / nloc;
        if (old + 1u == (gen + 1u) * nloc) {
            __builtin_amdgcn_fence(__ATOMIC_RELEASE, "agent");
            asm volatile("s_waitcnt vmcnt(0)" ::: "memory");
            const unsigned og = xb_add(&bar[XB_TOP], 1u);
            const unsigned tg = og / nx;
            if (og + 1u == (tg + 1u) * nx) xb_add(&bar[XB_TOPGEN], 1u);
            else XB_SPIN(xb_ld(&bar[XB_TOPGEN]) == tg, bar);
            __builtin_amdgcn_fence(__ATOMIC_ACQUIRE, "agent");
            xb_add(&bar[XB_XGEN(b.x)], 1u);
            asm volatile("s_waitcnt vmcnt(0)" ::: "memory");
        } else {
            XB_SPIN(xb_ld(&bar[XB_XGEN(b.x)]) == gen, bar);
            __builtin_amdgcn_fence(__ATOMIC_ACQUIRE, "agent");
            asm volatile("s_waitcnt vmcnt(0)" ::: "memory");
        }
    }
    __syncthreads();
}


struct Args {
    const float* in[33]; float* out; unsigned char* ws; int ph_lo, ph_hi;
};
struct Frame {
    LAS unsigned char* lds; int G;
    const LAS unsigned long long* ptab; float* out; unsigned char* ws;
};
#define GAS __attribute__((address_space(1)))
__device__ __forceinline__ const float* ldptr(const LAS unsigned long long* tab, int k) { const unsigned long long v = tab[k]; const unsigned lo = __builtin_amdgcn_readfirstlane((unsigned)v), hi = __builtin_amdgcn_readfirstlane((unsigned)(v >> 32));
    return (const float*)(const GAS float*)(((unsigned long long)hi << 32) | lo); }
__device__ __forceinline__ unsigned char* fresh(unsigned char* p) { GAS unsigned char* q = (GAS unsigned char*)p; asm volatile("" : "+s"(q)); return (unsigned char*)q; }
__device__ __forceinline__ int fresh_i(int v) { asm volatile("" : "+s"(v)); return v; }
#define INP(k) ldptr(F.ptab, (k))
#define PHASE_L const int l = fresh_i(l_in); (void)l;
#define PHASE_IDS int tid_ = threadIdx.x; asm volatile("" : "+v"(tid_)); const int tid = tid_, lane = tid & 63, wave = __builtin_amdgcn_readfirstlane(tid >> 6), gtid = blockIdx.x * NTHR + tid, gw = blockIdx.x * NWAVES + wave; (void)lane; (void)wave; (void)gtid; (void)gw;
#define VM_WAIT() asm volatile("s_waitcnt vmcnt(0)" ::: "memory")
#define LDS_WAIT() asm volatile("s_waitcnt lgkmcnt(0)" ::: "memory")
constexpr int NT_ALL_SHIFT = 9;

__device__ __forceinline__ void row_info(int m, int& b, int& t, bool& samp) { samp = m >= MPR; if (samp) { b = (m - MPR) >> 6; t = (m - MPR) & 63; } else { b = m >> 11; t = m & 2047; } }

__device__ __forceinline__ void transpose_item(const float* W, int N, bf16_t* WT, int ldk, int k0, int n0, int drow0, LAS float* scr, int lane, const float* cscale = nullptr, const float* rscale = nullptr) {
    f32x4 cs = (f32x4){1.f, 1.f, 1.f, 1.f}; if (cscale) cs = *(const f32x4*)(cscale + n0 + 4 * (lane & 7));
    const int c = lane & 7;
    f32x4 g0 = (f32x4){1.f, 1.f, 1.f, 1.f}, g1 = g0;
    if (rscale) { g0 = *(const f32x4*)(rscale + k0 + 8 * c); g1 = *(const f32x4*)(rscale + k0 + 8 * c + 4); }
    f32x4 v[8];
#pragma unroll
    for (int i = 0; i < 8; ++i) v[i] = *(const f32x4*)(W + (size_t)(k0 + 8 * i + (lane >> 3)) * N + n0 + 4 * (lane & 7));
#pragma unroll
    for (int i = 0; i < 8; ++i) { LAS float* d = scr + (8 * i + (lane >> 3)) * 33 + 4 * (lane & 7); const f32x4 t = v[i] * cs; d[0] = t.x; d[1] = t.y; d[2] = t.z; d[3] = t.w; }
    LDS_WAIT(); asm volatile("" ::: "memory");
#pragma unroll
    for (int j = 0; j < 4; ++j) { const int n = (lane >> 3) + 8 * j; const LAS float* sp = scr + (8 * c) * 33 + n;
        u32x4 o; o.x = cvt_pk_bf16(sp[0 * 33] * g0.x, sp[1 * 33] * g0.y); o.y = cvt_pk_bf16(sp[2 * 33] * g0.z, sp[3 * 33] * g0.w); o.z = cvt_pk_bf16(sp[4 * 33] * g1.x, sp[5 * 33] * g1.y); o.w = cvt_pk_bf16(sp[6 * 33] * g1.z, sp[7 * 33] * g1.w);
        *(u32x4*)(WT + (size_t)(drow0 + n) * ldk + k0 + 8 * c) = o; }
    LDS_WAIT(); asm volatile("" ::: "memory");
}
__device__ __forceinline__ void convert_weights(Frame& F, int l_in, int part_in) {
    PHASE_IDS
    unsigned char* const wsl = fresh(F.ws);
    PHASE_L
    LAS float* scr = (LAS float*)(F.lds + wave * 16384);
    const int NGW = fresh_i(F.G) * NWAVES;
    unsigned char* ws = wsl;
    constexpr int I_WIN = (DM / 64) * (ICOLS / 32), I_PW = 4 * (256 / 64) * (256 / 32), I_PP = (PWD / 64) * (DM / 32), I_WO = (DM / 64) * (DM / 32), I_FG = (DM / 64) * (FF / 32),
                  I_FD = (FF / 64) * (DM / 32), I_PL = (PLE / 64) * (DM / 32);
    constexpr int NITEMS = I_WIN + I_PW + 2 * I_PP + I_WO + 2 * I_FG + I_FD + I_WO + I_PL;
    constexpr int IA = I_WIN + I_PW + 2 * I_PP + I_WO + 2 * I_FG + I_FD;
    const int part = fresh_i(part_in), cnt = part == 0 ? NITEMS : part == 1 ? NITEMS - I_WO : I_WO;
    for (int ix = gw; ix < cnt; ix += NGW) {
        int r = part == 0 ? ix : part == 1 ? (ix < IA ? ix : ix + I_WO) : ix + IA;
        if (r < I_WIN) { const int nblk = ICOLS / 32, kb = r / nblk, nb = r % nblk, n0 = nb * 32; transpose_item(INP(8) + (size_t)l * DM * ICOLS, ICOLS, (bf16_t*)(ws + WS_WIN), DM, kb * 64, n0, n0 < 4384 ? n0 : n0 + 224, scr, lane, nullptr, INP(7) + (size_t)l * DM); continue; } r -= I_WIN;
        if (r < I_PW) { const int g = r >> 5, rr = r & 31, kb = rr >> 3, nb = rr & 7; transpose_item(INP(10) + ((size_t)l * 4 + g) * 65536, 256, (bf16_t*)(ws + WS_POOLW) + (size_t)g * 65536, 256, kb * 64, nb * 32, nb * 32, scr, lane, INP(11) + (size_t)l * PWD + g * 256); continue; } r -= I_PW;
        if (r < I_PP) { const int nblk = DM / 32, kb = r / nblk, nb = r % nblk; transpose_item(INP(22) + (size_t)l * PWD * DM, DM, (bf16_t*)(ws + WS_PPOOL), PWD, kb * 64, nb * 32, nb * 32, scr, lane); continue; } r -= I_PP;
        if (r < I_PP) { const int nblk = DM / 32, kb = r / nblk, nb = r % nblk; transpose_item(INP(23) + (size_t)l * RWD * DM, DM, (bf16_t*)(ws + WS_PRWKV), RWD, kb * 64, nb * 32, nb * 32, scr, lane); continue; } r -= I_PP;
        if (r < I_WO) { const int nblk = DM / 32, kb = r / nblk, nb = r % nblk; transpose_item(INP(24) + (size_t)l * DM * DM, DM, (bf16_t*)(ws + WS_WOUT), DM, kb * 64, nb * 32, nb * 32, scr, lane); continue; } r -= I_WO;
        if (r < I_FG) { const int nblk = FF / 32, kb = r / nblk, nb = r % nblk, n0 = nb * 32; transpose_item(INP(26) + (size_t)l * DM * FF, FF, (bf16_t*)(ws + WS_WGU), DM, kb * 64, n0, 256 * (n0 >> 7) + 64 * ((n0 & 127) >> 5), scr, lane, nullptr, INP(25) + (size_t)l * DM); continue; } r -= I_FG;
        if (r < I_FG) { const int nblk = FF / 32, kb = r / nblk, nb = r % nblk, n0 = nb * 32; transpose_item(INP(27) + (size_t)l * DM * FF, FF, (bf16_t*)(ws + WS_WGU), DM, kb * 64, n0, 256 * (n0 >> 7) + 64 * ((n0 & 127) >> 5) + 32, scr, lane, nullptr, INP(25) + (size_t)l * DM); continue; } r -= I_FG;
        if (r < I_FD) { const int nblk = DM / 32, kb = r / nblk, nb = r % nblk; transpose_item(INP(28) + (size_t)l * FF * DM, DM, (bf16_t*)(ws + WS_WDN), FF, kb * 64, nb * 32, nb * 32, scr, lane); continue; } r -= I_FD;
        if (r < I_WO) { const int nblk = DM / 32, kb = r / nblk, nb = r % nblk; transpose_item(INP(30) + (size_t)l * DM * DM, DM, (bf16_t*)(ws + WS_WPG), DM, kb * 64, nb * 32, nb * 32, scr, lane, nullptr, INP(29) + (size_t)l * DM); continue; } r -= I_WO;
        { const int nblk = DM / 32, kb = r / nblk, nb = r % nblk; transpose_item(INP(31) + (size_t)l * PLE * DM, DM, (bf16_t*)(ws + WS_WPP), PLE, kb * 64, nb * 32, nb * 32, scr, lane); }
    }
    if (part == 2) return;
    const int NT = fresh_i(F.G) * NTHR;
    { u32x4* z = (u32x4*)((bf16_t*)(ws + WS_WIN) + (size_t)4384 * DM); u32x4 zz = (u32x4){0u, 0u, 0u, 0u}; asm volatile("" : "+v"(zz));
      for (int i = gtid; i < 224 * DM * 2 / 16; i += NT) z[i] = zz; }
    { bf16_t* LT = (bf16_t*)(ws + WS_LORA); const float* wd = INP(13) + (size_t)l * 64 * RWD; const float* wa = INP(15) + (size_t)l * 64 * RWD; const float* wg = INP(16) + (size_t)l * 160 * RWD;
      for (int i = gtid; i < 3072 * (LK / 8); i += NT) { const int n = i / (LK / 8), k0 = (i % (LK / 8)) * 8; const int kind = n >> 10, c = n & 1023; float f[8];
#pragma unroll
          for (int j = 0; j < 8; ++j) { const int k = k0 + j; float v = 0.f;
              if (kind == 0) { if (k < 64) v = wd[(size_t)k * RWD + c]; }
              else if (kind == 1) { if (k >= 64 && k < 128) v = wa[(size_t)(k - 64) * RWD + c]; }
              else { if (k >= 128 && k < 288) v = wg[(size_t)(k - 128) * RWD + c]; }
              f[j] = v; }
          *(u32x4*)(LT + (size_t)n * LK + k0) = pack8(f); } }
    { bf16_t* PB = (bf16_t*)(ws + WS_PB); const float* pp = INP(5) + (size_t)l * MPR * PLE; const float* ps = INP(6) + (size_t)l * (MT - MPR) * PLE;
      for (int i = gtid; i < MT * PLE / 8; i += NT) { const size_t e = (size_t)i * 8; const float* src = e < (size_t)MPR * PLE ? pp + e : ps + (e - (size_t)MPR * PLE);
          const f32x4 a = *(const f32x4*)src, b = *(const f32x4*)(src + 4); *(u32x4*)(PB + e) = pg8::pack_f4x2(a, b); } }
}

__device__ __forceinline__ void xb_from_input(Frame& F) {
    PHASE_IDS
    unsigned char* const wsl = fresh(F.ws);
    const int NGW = fresh_i(F.G) * NWAVES; bf16_t* XB = (bf16_t*)(wsl + WS_XN); pg8::ss_t* SS = (pg8::ss_t*)(wsl + WS_SS);
    for (int m = gw; m < MT; m += NGW) {
        const float* src = m < MPR ? INP(0) + (size_t)m * DM : INP(1) + (size_t)(m - MPR) * DM;
        f32x4 v[8]; float s = 0.f;
#pragma unroll
        for (int j = 0; j < 8; ++j) { v[j] = *(const f32x4*)(src + 4 * lane + 256 * j); s += (v[j].x * v[j].x + v[j].y * v[j].y) + (v[j].z * v[j].z + v[j].w * v[j].w); }
        s = wave_sum(s);
        if (lane == 0) SS[m] = pg8::ss_fix(s);
#pragma unroll
        for (int j = 0; j < 8; ++j) { u32x2 w; w.x = cvt_pk_bf16(v[j].x, v[j].y); w.y = cvt_pk_bf16(v[j].z, v[j].w); *(u32x2*)(XB + (size_t)m * DM + 4 * lane + 256 * j) = w; }
    }
}
__device__ __forceinline__ void final_norm(Frame& F, const float* gain) {
    PHASE_IDS
    unsigned char* const wsl = fresh(F.ws);
    const int NGW = fresh_i(F.G) * NWAVES; const bf16_t* XB = (const bf16_t*)(wsl + ((NL & 1) ? WS_XB2 : WS_XN));
    f32x4 g[8];
#pragma unroll
    for (int j = 0; j < 8; ++j) g[j] = *(const f32x4*)(gain + 4 * lane + 256 * j);
    for (int m = gw; m < MT; m += NGW) {
        f32x4 v[8]; float s = 0.f;
#pragma unroll
        for (int j = 0; j < 8; ++j) { const u32x2 w = *(const u32x2*)(XB + (size_t)m * DM + 4 * lane + 256 * j); v[j] = (f32x4){bf_lo(w.x), bf_hi(w.x), bf_lo(w.y), bf_hi(w.y)};
            s += (v[j].x * v[j].x + v[j].y * v[j].y) + (v[j].z * v[j].z + v[j].w * v[j].w); }
        const float rstd = __builtin_amdgcn_rsqf(wave_sum(s) * (1.0f / DM) + NORM_EPS);
#pragma unroll
        for (int j = 0; j < 8; ++j) *(f32x4*)(F.out + (size_t)m * DM + 4 * lane + 256 * j) = v[j] * rstd * g[j];
    }
}

__device__ __forceinline__ void load_z(float (&z)[8], const bf16_t* PROJ, const float* past, int m0, int t, bool samp, int c0) {
    if (t >= 0) { unpack8(*(const u32x4*)(PROJ + (size_t)(m0 + t) * ICP + c0), z); }
    else if (samp) { const float* p = past + (size_t)(15 + t) * PWD + c0; const f32x4 a = *(const f32x4*)p, b = *(const f32x4*)(p + 4); z[0] = a.x; z[1] = a.y; z[2] = a.z; z[3] = a.w; z[4] = b.x; z[5] = b.y; z[6] = b.z; z[7] = b.w; }
    else {
#pragma unroll
        for (int j = 0; j < 8; ++j) z[j] = 0.f; }
}
template <int WIN>
__device__ __forceinline__ void pool_run(const bf16_t* PROJ, bf16_t* D, float* npool, int mseq, int t0, bool samp, int T, int c0) {
    constexpr int NR = WIN - 1 + 16;
    u32x4 R[NR];
#pragma unroll
    for (int k = 0; k < NR; ++k) { const int t = t0 - (WIN - 1) + k;
        if (k >= WIN - 1 || t >= 0) R[k] = *(const u32x4*)(PROJ + (size_t)(mseq + t) * ICP + c0); else R[k] = (u32x4){0u, 0u, 0u, 0u}; }
    float S[8], z[8];
#pragma unroll
    for (int q = 0; q < 8; ++q) S[q] = 0.f;
#pragma unroll
    for (int k = WIN - 2; k >= 0; --k) { asm volatile("" : "+v"(R[k])); unpack8(R[k], z);
#pragma unroll
        for (int q = 0; q < 8; ++q) S[q] += z[q];
        __builtin_amdgcn_sched_barrier(0); }
#pragma unroll
    for (int i = 0; i < 16; ++i) { const int t = t0 + i; float cur[8], d[8]; asm volatile("" : "+v"(R[WIN - 1 + i]), "+v"(R[i])); unpack8(R[WIN - 1 + i], cur);
        const float inv = (samp || t + 1 >= WIN) ? 1.0f / (float)WIN : 1.0f / (float)(t + 1);
#pragma unroll
        for (int q = 0; q < 8; ++q) { S[q] += cur[q]; d[q] = S[q] * inv - cur[q]; }
        *(u32x4*)(D + (size_t)(mseq + t) * PWD + c0) = pack8(d);
        if (t >= T - 15) { float* o = npool + (size_t)(t - (T - 15)) * PWD + c0; *(f32x4*)o = (f32x4){cur[0], cur[1], cur[2], cur[3]}; *(f32x4*)(o + 4) = (f32x4){cur[4], cur[5], cur[6], cur[7]}; }
        unpack8(R[i], z);
#pragma unroll
        for (int q = 0; q < 8; ++q) S[q] -= z[q];
        __builtin_amdgcn_sched_barrier(0); }
}
__device__ __forceinline__ void prep1_phase(Frame& F, int l_in) {
    PHASE_IDS
    unsigned char* const wsl = fresh(F.ws);
    PHASE_L
    const int NT = fresh_i(F.G) * NTHR; const bf16_t* PROJ = (const bf16_t*)(wsl + WS_PROJ);
    { bf16_t* D = (bf16_t*)(wsl + WS_D);
      for (int wi = gw; wi < (MT / 32) * 4; wi += fresh_i(F.G) * NWAVES) {
          const int g4 = wi & 3, run = 2 * (wi >> 2) + (lane >> 5), oct = 32 * g4 + (lane & 31), mrow = run * 16, c0 = oct * 8, win = 2 << g4;
          int b, t0; bool samp; row_info(mrow, b, t0, samp);
          const int T = samp ? TS : TP, mseq = mrow - t0;
          const float* past = INP(3) + ((size_t)l * 8 + b) * 15 * PWD;
          float* npool = F.out + (samp ? O_POS : O_POP) + ((size_t)l * 8 + b) * 15 * PWD;
          if (!(samp && t0 == 0)) {
              if (g4 == 0) pool_run<2>(PROJ, D, npool, mseq, t0, samp, T, c0); else if (g4 == 1) pool_run<4>(PROJ, D, npool, mseq, t0, samp, T, c0);
              else if (g4 == 2) pool_run<8>(PROJ, D, npool, mseq, t0, samp, T, c0); else pool_run<16>(PROJ, D, npool, mseq, t0, samp, T, c0);
              continue; }
          float S[8], z[8];
#pragma unroll
          for (int j = 0; j < 8; ++j) S[j] = 0.f;
          for (int j = 1; j < win; ++j) { load_z(z, PROJ, past, mseq, t0 - j, samp, c0);
#pragma unroll
              for (int q = 0; q < 8; ++q) S[q] += z[q]; }
          for (int i = 0; i < 16; ++i) { const int t = t0 + i; float cur[8]; load_z(cur, PROJ, past, mseq, t, samp, c0);
              const int cnt = samp ? win : (t + 1 < win ? t + 1 : win); const float inv = 1.0f / (float)cnt; float d[8];
#pragma unroll
              for (int q = 0; q < 8; ++q) { S[q] += cur[q]; d[q] = S[q] * inv - cur[q]; }
              *(u32x4*)(D + (size_t)(mseq + t) * PWD + c0) = pack8(d);
              if (t >= T - 15) { float* o = npool + (size_t)(t - (T - 15)) * PWD + c0; *(f32x4*)o = (f32x4){cur[0], cur[1], cur[2], cur[3]}; *(f32x4*)(o + 4) = (f32x4){cur[4], cur[5], cur[6], cur[7]}; }
              load_z(z, PROJ, past, mseq, t - win + 1, samp, c0);
#pragma unroll
              for (int q = 0; q < 8; ++q) S[q] -= z[q]; }
      } }
    { bf16_t* LIN = (bf16_t*)(wsl + WS_LIN); const float* mu = INP(9) + (size_t)l * RPJ + 3072;
      const int c0 = lane * 8; const bool act = lane < 36, wrl = lane < 48; const float kx = c0 < 64 ? 2.0f : -1.0f;
      float mv[8];
#pragma unroll
      for (int j = 0; j < 8; ++j) mv[j] = act ? mu[c0 + j] : 0.f;
      for (int ci = gw; ci < MT / 8; ci += fresh_i(F.G) * NWAVES) {
          const int m0 = ci * 8; int b, t0; bool samp; row_info(m0, b, t0, samp);
          u32x4 R[9]; float prv[8];
#pragma unroll
          for (int i = 0; i < 9; ++i) R[i] = (u32x4){0u, 0u, 0u, 0u};
          if (act) {
#pragma unroll
              for (int i = 0; i < 8; ++i) R[i + 1] = *(const u32x4*)(PROJ + (size_t)(m0 + i) * ICP + 4096 + c0);
              if (t0 > 0) R[0] = *(const u32x4*)(PROJ + (size_t)(m0 - 1) * ICP + 4096 + c0); }
          unpack8(R[0], prv);
          if (act && t0 == 0 && samp) { const float* p = INP(2) + ((size_t)l * 8 + b) * RPJ + 3072 + c0;
#pragma unroll
              for (int j = 0; j < 8; ++j) prv[j] = p[j]; }
#pragma unroll
          for (int i = 0; i < 8; ++i) { float cur[8], o[8]; unpack8(R[i + 1], cur);
#pragma unroll
              for (int j = 0; j < 8; ++j) { const float xm = cur[j] + (prv[j] - cur[j]) * mv[j]; const float rr = __builtin_amdgcn_rcpf(__expf(kx * xm) + 1.0f);
                  o[j] = c0 < 64 ? 1.0f - 2.0f * rr : (c0 < 128 ? xm : rr); prv[j] = cur[j]; }
              if (!act) {
#pragma unroll
                  for (int j = 0; j < 8; ++j) o[j] = 0.f; }
              if (wrl) *(u32x4*)(LIN + (size_t)(m0 + i) * LK + c0) = pack8(o); }
      } }
    { pg8::ss_t* SS = (pg8::ss_t*)(wsl + WS_SS); for (int i = gtid; i < 3 * MT; i += NT) SS[i] = 0u; }
    for (int it = gtid; it < 16 * RPJ; it += NT) { const int s = it / RPJ, c = it % RPJ; const int mlast = s < 8 ? s * TP + TP - 1 : MPR + (s - 8) * TS + TS - 1;
        F.out[(s < 8 ? O_SHP : O_SHS) + ((size_t)l * 8 + (s & 7)) * RPJ + c] = __uint_as_float((unsigned)PROJ[(size_t)mlast * ICP + 1024 + c] << 16); }
}

__device__ __forceinline__ unsigned char* cb_ptr(unsigned char* ws, size_t i) { return ws + WS_TMP + i * CBSZ; }
__device__ __forceinline__ float sum16(float x) { x += dpp_f<0xB1>(x); x += dpp_f<0x4E>(x); x += dpp_f<0x141>(x); x += dpp_f<0x140>(x); return x; }
__device__ __forceinline__ f32x4 mfma16(bf16x8 a, bf16x8 b, f32x4 c) { return __builtin_amdgcn_mfma_f32_16x16x32_bf16(a, b, c, 0, 0, 0); }
__device__ __forceinline__ bf16x8 mk8(u32x2 lo, u32x2 hi) { u32x4 w = (u32x4){lo.x, lo.y, hi.x, hi.y}; return __builtin_bit_cast(bf16x8, w); }
typedef __bf16 bf16x2_c __attribute__((ext_vector_type(2)));
__device__ __forceinline__ unsigned cvt_pk_c(float lo, float hi) { const f32x2 v = (f32x2){lo, hi}; const bf16x2_c b = __builtin_convertvector(v, bf16x2_c); return __builtin_bit_cast(unsigned, b); }
__device__ __forceinline__ u32x2 pk4(f32x4 v) { return (u32x2){cvt_pk_c(v.x, v.y), cvt_pk_c(v.z, v.w)}; }
__device__ __forceinline__ unsigned short bf1(float f) { return (unsigned short)(cvt_pk_c(f, 0.f) & 0xffffu); }

__device__ __forceinline__ void spre_phase(Frame& F, int l_in) {
    PHASE_IDS
    unsigned char* const wsl = fresh(F.ws);
    PHASE_L
    const int NGW = fresh_i(F.G) * NWAVES;
    LAS unsigned char* L = F.lds + wave * 16384;
    const bf16_t* PROJ = (const bf16_t*)(wsl + WS_PROJ); const bf16_t* AA = (const bf16_t*)(wsl + WS_AA); const float* DEC = (const float*)(wsl + WS_DEC);
    const int fr = lane & 15, fq = lane >> 4;
    const float* mu = INP(9) + (size_t)l * RPJ;
#define SP_LOAD(it_, R, K, V, A, W, PR, PK, PV) do { const int h_ = (it_) & 15, m0_ = ((it_) >> 4) * 16, ch_ = h_ * 64 + lane; int b_, t0_; bool samp_; row_info(m0_, b_, t0_, samp_); \
        _Pragma("unroll") for (int t = 0; t < 16; ++t) { const size_t mm = (size_t)(m0_ + t); const bf16_t* pc = PROJ + mm * ICP + 1024 + ch_; R[t] = pc[0]; K[t] = pc[1024]; V[t] = pc[2048]; A[t] = AA[mm * RWD + ch_]; W[t] = DEC[mm * RWD + ch_]; } \
        if (t0_ > 0) { const bf16_t* pc = PROJ + (size_t)(m0_ - 1) * ICP + 1024 + ch_; PR = __uint_as_float((unsigned)pc[0] << 16); PK = __uint_as_float((unsigned)pc[1024] << 16); PV = __uint_as_float((unsigned)pc[2048] << 16); } \
        else if (samp_) { const float* sp = INP(2) + ((size_t)l * 8 + b_) * RPJ + ch_; PR = sp[0]; PK = sp[1024]; PV = sp[2048]; } \
        else { PR = 0.f; PK = 0.f; PV = 0.f; } } while (0)
    unsigned short cr[16], ck[16], cv[16], ca[16], nr[16], nk[16], nv[16], na[16]; float cw[16], nw[16]; float pr = 0.f, pk = 0.f, pv = 0.f, npr = 0.f, npk = 0.f, npv = 0.f;
    int hprev = -1; float mur = 0.f, muk = 0.f, muv = 0.f, ckk = 0.f, cka = 0.f, crk = 0.f;
    if (gw < (int)CB_N) SP_LOAD(gw, cr, ck, cv, ca, cw, pr, pk, pv);
    for (int it = gw; it < (int)CB_N; it += NGW) {
        const int h = it & 15, crow = it >> 4, m0 = crow * 16, ch = h * 64 + lane;
        unsigned char* cb = cb_ptr(wsl, (size_t)it);
        if (h != hprev) { hprev = h; mur = mu[ch]; muk = mu[1024 + ch]; muv = mu[2048 + ch];
            ckk = (INP(17) + (size_t)l * RWD)[ch]; cka = (INP(18) + (size_t)l * RWD)[ch]; crk = (INP(19) + (size_t)l * RWD)[ch]; }
        { const int itn = it + NGW; if (itn < (int)CB_N) SP_LOAD(itn, nr, nk, nv, na, nw, npr, npk, npv); }
        float g = 1.0f; unsigned at2[8], bt2[8], kt2[8], vt2[8]; float hold_a = 0.f, hold_b = 0.f, hold_k = 0.f, hold_v = 0.f;
#pragma unroll
        for (int t = 0; t < 16; ++t) {
            const float xr = __uint_as_float((unsigned)cr[t] << 16), xk = __uint_as_float((unsigned)ck[t] << 16), xv = __uint_as_float((unsigned)cv[t] << 16), av = __uint_as_float((unsigned)ca[t] << 16);
            const float r = xr + (pr - xr) * mur, kx = xk + (pk - xk) * muk, vv = xv + (pv - xv) * muv; pr = xr; pk = xk; pv = xv;
            float kkv = kx * ckk; const float ss = wave_sum(kkv * kkv); kkv *= __builtin_amdgcn_rsqf(fmaxf(ss, 1e-24f));
            const float kh = kx * (1.0f + (av - 1.0f) * cka), bb = kkv * av; const float bsum = wave_sum(r * kh * crk);
            if (lane == 0) *(float*)(cb + CB_BS + t * 4) = bsum;
            const float a_t = -kkv * g; g *= cw[t]; const float ig = __builtin_amdgcn_rcpf(g); const float b_t = bb * ig, k_t = kh * ig, r_t = r * g;
            *(LAS unsigned short*)(L + t * 144 + lane * 2) = bf1(a_t); *(LAS unsigned short*)(L + 2304 + t * 144 + lane * 2) = bf1(b_t);
            *(LAS unsigned short*)(L + 4608 + t * 144 + lane * 2) = bf1(k_t); *(LAS unsigned short*)(L + 6912 + t * 144 + lane * 2) = bf1(r_t);
            if (t & 1) { at2[t >> 1] = cvt_pk_c(hold_a, a_t); bt2[t >> 1] = cvt_pk_c(hold_b, b_t); kt2[t >> 1] = cvt_pk_c(hold_k, k_t); vt2[t >> 1] = cvt_pk_c(hold_v, vv); }
            else { hold_a = a_t; hold_b = b_t; hold_k = k_t; hold_v = vv; }
        }
        *(LAS u32x4*)(L + 9216 + lane * 32) = (u32x4){at2[0], at2[1], at2[2], at2[3]}; *(LAS u32x4*)(L + 9216 + lane * 32 + 16) = (u32x4){at2[4], at2[5], at2[6], at2[7]};
        { u32x4* o = (u32x4*)(cb + CB_BK + lane * 64);
#pragma unroll
          for (int q = 0; q < 4; ++q) o[q] = (u32x4){bt2[2 * q], bt2[2 * q + 1], kt2[2 * q], kt2[2 * q + 1]}; }
        { u32x4* o = (u32x4*)(cb + CB_VT + lane * 32); o[0] = (u32x4){vt2[0], vt2[1], vt2[2], vt2[3]}; o[1] = (u32x4){vt2[4], vt2[5], vt2[6], vt2[7]}; }
        *(float*)(cb + CB_GC + lane * 4) = g;
        asm volatile("" ::: "memory");
#define SP_ROWS(off, j) (*(const LAS bf16x8*)(L + (off) + fr * 144 + (j) * 64 + fq * 16))
        f32x4 nD = (f32x4){0.f, 0.f, 0.f, 0.f}, makD = nD, mrbD = nD, mrkD = nD;
#pragma unroll
        for (int j = 0; j < 2; ++j) { const bf16x8 fa = SP_ROWS(0, j), fb = SP_ROWS(2304, j), fk = SP_ROWS(4608, j), fR = SP_ROWS(6912, j);
            nD = mfma16(fb, fa, nD); makD = mfma16(fk, fa, makD); mrbD = mfma16(fb, fR, mrbD); mrkD = mfma16(fk, fR, mrkD); }
#pragma unroll
        for (int rr = 0; rr < 4; ++rr) { const int s = 4 * fq + rr; if (s >= fr) { nD[rr] = 0.f; makD[rr] = 0.f; } if (s > fr) { mrbD[rr] = 0.f; mrkD[rr] = 0.f; } }
        { const u32x2 mb = pk4(mrbD), mk = pk4(mrkD); *(u32x4*)(cb + CB_MBT + (fr * 4 + fq) * 16) = (u32x4){mb.x, mb.y, mk.x, mk.y}; }
#define SP_WR_RM(off, D) do { _Pragma("unroll") for (int rr = 0; rr < 4; ++rr) *(LAS unsigned short*)(L + (off) + (4 * fq + rr) * 32 + fr * 2) = bf1((D)[rr]); } while (0)
#define SP_WR_TR(off, D) do { *(LAS u32x2*)(L + (off) + fr * 32 + fq * 8) = pk4(D); } while (0)
#define SP_FRAG16(off) (fq < 2 ? *(const LAS bf16x8*)(L + (off) + fr * 32 + fq * 16) : (bf16x8){0, 0, 0, 0, 0, 0, 0, 0})
        SP_WR_RM(13568, nD); SP_WR_TR(14080, nD); SP_WR_RM(15616, makD); asm volatile("" ::: "memory");
        f32x4 TD = nD;
#pragma unroll
        for (int rr = 0; rr < 4; ++rr) if (4 * fq + rr == fr) TD[rr] += 1.0f;
#pragma unroll
        for (int itp = 0; itp < 3; ++itp) {
            SP_WR_RM(14592, TD); asm volatile("" ::: "memory");
            const f32x4 p2 = mfma16(SP_FRAG16(13568), SP_FRAG16(14080), (f32x4){0.f, 0.f, 0.f, 0.f}); asm volatile("" ::: "memory");
            SP_WR_RM(13568, p2); SP_WR_TR(14080, p2); asm volatile("" ::: "memory");
            TD = mfma16(SP_FRAG16(14592), SP_FRAG16(14080), TD); asm volatile("" ::: "memory");
        }
        SP_WR_TR(15104, TD); asm volatile("" ::: "memory");
        { const bf16x8 ftt = SP_FRAG16(15104);
#pragma unroll
          for (int blk = 0; blk < 4; ++blk) { const bf16x8 fb = fq < 2 ? *(const LAS bf16x8*)(L + 9216 + (16 * blk + fr) * 32 + fq * 16) : (bf16x8){0, 0, 0, 0, 0, 0, 0, 0};
              const f32x4 d = mfma16(ftt, fb, (f32x4){0.f, 0.f, 0.f, 0.f});
#pragma unroll
              for (int rr = 0; rr < 4; ++rr) *(LAS unsigned short*)(L + 11264 + (4 * fq + rr) * 144 + (16 * blk + fr) * 2) = bf1(d[rr]); }
          const f32x4 p2 = mfma16(SP_FRAG16(15616), ftt, (f32x4){0.f, 0.f, 0.f, 0.f});
          *(u32x2*)(cb + CB_P2T + fr * 32 + fq * 8) = pk4(p2); }
        asm volatile("" ::: "memory");
#pragma unroll
        for (int q = 0; q < 2; ++q) { const int pc = lane + 64 * q, pcc = pc >> 6, pt = (pc >> 2) & 15, pf = pc & 3;
            const u32x2 a0 = *(const LAS u32x2*)(L + 11264 + pt * 144 + (32 * pcc + 4 * pf) * 2), a1 = *(const LAS u32x2*)(L + 11264 + pt * 144 + (32 * pcc + 16 + 4 * pf) * 2);
            const u32x2 r0 = *(const LAS u32x2*)(L + 6912 + pt * 144 + (32 * pcc + 4 * pf) * 2), r1 = *(const LAS u32x2*)(L + 6912 + pt * 144 + (32 * pcc + 16 + 4 * pf) * 2);
            *(u32x4*)(cb + CB_P1T + pc * 16) = (u32x4){a0.x, a0.y, a1.x, a1.y}; *(u32x4*)(cb + CB_RT + pc * 16) = (u32x4){r0.x, r0.y, r1.x, r1.y}; }
        asm volatile("" ::: "memory");
#pragma unroll
        for (int t = 0; t < 16; ++t) { cr[t] = nr[t]; ck[t] = nk[t]; cv[t] = nv[t]; ca[t] = na[t]; cw[t] = nw[t]; }
        pr = npr; pk = npk; pv = npv;
#undef SP_ROWS
#undef SP_LOAD
#undef SP_WR_RM
#undef SP_WR_TR
#undef SP_FRAG16
    }
}

constexpr int SQ_D = 5, SQ_SLOT = 14336, SQ_NSLOT = 7, SQ_DUMP = SQ_NSLOT * SQ_SLOT, SQ_YBUF = SQ_DUMP + 2048;
__device__ __forceinline__ void sseq_phase(Frame& F, int l_in) {
    PHASE_IDS
    unsigned char* const wsl = fresh(F.ws);
    PHASE_L
    const bf16_t* GG = (const bf16_t*)(wsl + WS_GG); bf16_t* YB = (bf16_t*)(wsl + WS_YB);
    const bool is_cons = wave < 4;
    const int fr = lane & 15, fq = lane >> 4, vrow = (wave & 3) * 16 + fr, lw = wave & 3;
    for (int u = blockIdx.x; u < 256; u += fresh_i(F.G)) {
        const bool samp = u >= 128; const int h = u & 15, b = (u >> 4) & 7;
        const int T = samp ? TS : TP, m0 = samp ? MPR + b * TS : b * TP, nch = T / 16, crow0 = m0 / 16;
        f32x4 sreg[4];
        if (samp) { const float* sp = INP(4) + ((((size_t)l * 8 + b) * 16 + h) * 64 + vrow) * 64 + 4 * fq;
#pragma unroll
            for (int kb = 0; kb < 4; ++kb) sreg[kb] = *(const f32x4*)(sp + 16 * kb); }
        else {
#pragma unroll
            for (int kb = 0; kb < 4; ++kb) sreg[kb] = (f32x4){0.f, 0.f, 0.f, 0.f}; }
        const f32x4 gng = *(const f32x4*)(INP(20) + (size_t)l * RWD + h * 64 + 4 * fr), gnb = *(const f32x4*)(INP(21) + (size_t)l * RWD + h * 64 + 4 * fr);
#define SQ_ISSUE(c) do { const unsigned char* src = cb_ptr(wsl, (size_t)(crow0 + (c)) * 16 + h) + (lw * 3) * 1024 + lane * 16; LAS unsigned char* dst = F.lds + ((c) % SQ_NSLOT) * SQ_SLOT + (lw * 3) * 1024; \
        _Pragma("unroll") for (int i = 0; i < 3; ++i) __builtin_amdgcn_global_load_lds((const unsigned*)(src + i * 1024), (LAS unsigned*)(dst + i * 1024), 16, 0, 0); \
        if (lw < 2) __builtin_amdgcn_global_load_lds((const unsigned*)((const unsigned char*)(GG + (size_t)(m0 + (c) * 16 + 8 * lw + (lane >> 3)) * RWD + h * 64) + (lane & 7) * 16), (LAS unsigned*)(F.lds + ((c) % SQ_NSLOT) * SQ_SLOT + 12288 + lw * 1024), 16, 0, 0); \
        else __builtin_amdgcn_global_load_lds((const unsigned*)src, (LAS unsigned*)(F.lds + SQ_DUMP + (lw - 2) * 1024), 16, 0, 0); } while (0)
#define SQ_WAIT(k) do { switch (k) { case 0: asm volatile("s_waitcnt vmcnt(0)" ::: "memory"); break; case 1: asm volatile("s_waitcnt vmcnt(4)" ::: "memory"); break; case 2: asm volatile("s_waitcnt vmcnt(8)" ::: "memory"); break; \
        case 3: asm volatile("s_waitcnt vmcnt(12)" ::: "memory"); break; default: asm volatile("s_waitcnt vmcnt(16)" ::: "memory"); break; } } while (0)
#define SQ_POST(c) do { const LAS unsigned char* Bp = F.lds + ((c) % SQ_NSLOT) * SQ_SLOT; const int tt = 4 * lw + fq; \
        const f32x4 y4 = *(const LAS f32x4*)(F.lds + SQ_YBUF + ((c) & 1) * 4096 + (tt * 64 + 4 * fr) * 4); \
        const float mean = sum16((y4.x + y4.y) + (y4.z + y4.w)) * (1.0f / 64.0f); const f32x4 dv = y4 - mean; \
        const float rstd = __builtin_amdgcn_rsqf(sum16((dv.x * dv.x + dv.y * dv.y) + (dv.z * dv.z + dv.w * dv.w)) * (1.0f / 64.0f) + GN_EPS); \
        const float bs = *(const LAS float*)(Bp + CB_BS + tt * 4); const u32x2 gq = *(const LAS u32x2*)(Bp + 12288 + tt * 128 + fr * 8); \
        f32x4 vv; _Pragma("unroll") for (int j = 0; j < 4; ++j) vv[j] = __uint_as_float((unsigned)(*(const LAS unsigned short*)(Bp + CB_VT + (4 * fr + j) * 32 + tt * 2)) << 16); \
        const f32x4 o = (dv * rstd * gng + gnb + bs * vv) * (f32x4){bf_lo(gq.x), bf_hi(gq.x), bf_lo(gq.y), bf_hi(gq.y)}; \
        *(u32x2*)(YB + (size_t)(m0 + (c) * 16 + tt) * RWD + h * 64 + 4 * fr) = (u32x2){cvt_pk_bf16(o.x, o.y), cvt_pk_bf16(o.z, o.w)}; } while (0)
        __syncthreads();
        if (!is_cons) { const int np = nch < SQ_D ? nch : SQ_D; for (int c = 0; c < np; ++c) SQ_ISSUE(c); SQ_WAIT(np - 1); }
        __syncthreads();
        for (int c = 0; c < nch; ++c) {
            if (is_cons) {
                const LAS unsigned char* B = F.lds + (c % SQ_NSLOT) * SQ_SLOT;
#define SQ_KA(off, cc) (*(const LAS bf16x8*)(B + (off) + (((cc) * 16 + fr) * 4 + fq) * 16))
                const u32x2 vt = *(const LAS u32x2*)(B + CB_VT + vrow * 32 + fq * 8), z2 = (u32x2){0u, 0u};
                const bf16x8 aP2 = mk8(*(const LAS u32x2*)(B + CB_P2T + fr * 32 + fq * 8), z2), aP10 = SQ_KA(CB_P1T, 0), aP11 = SQ_KA(CB_P1T, 1), aR0 = SQ_KA(CB_RT, 0), aR1 = SQ_KA(CB_RT, 1);
                const bf16x8 aM = *(const LAS bf16x8*)(B + CB_MBT + (fr * 4 + fq) * 16);
                bf16x8 aBK[4]; f32x4 gc[4];
#pragma unroll
                for (int kb = 0; kb < 4; ++kb) { aBK[kb] = *(const LAS bf16x8*)(B + CB_BK + ((16 * kb + fr) * 4 + fq) * 16); gc[kb] = *(const LAS f32x4*)(B + CB_GC + (16 * kb + 4 * fq) * 4); }
                __builtin_amdgcn_sched_barrier(0);
                const bf16x8 sB0 = mk8(pk4(sreg[0]), pk4(sreg[1])), sB1 = mk8(pk4(sreg[2]), pk4(sreg[3]));
                f32x4 uD = mfma16(aP2, mk8(vt, z2), (f32x4){0.f, 0.f, 0.f, 0.f});
                uD = mfma16(aP10, sB0, uD); uD = mfma16(aP11, sB1, uD);
                const bf16x8 uvB = mk8(pk4(uD), vt);
                f32x4 nS[4];
#pragma unroll
                for (int kb = 0; kb < 4; ++kb) nS[kb] = mfma16(aBK[kb], uvB, sreg[kb]);
                f32x4 yD = mfma16(aM, uvB, (f32x4){0.f, 0.f, 0.f, 0.f});
                yD = mfma16(aR0, sB0, yD); yD = mfma16(aR1, sB1, yD);
#pragma unroll
                for (int kb = 0; kb < 4; ++kb) sreg[kb] = nS[kb] * gc[kb];
                { LAS float* yo = (LAS float*)(F.lds + SQ_YBUF + (c & 1) * 4096) + (4 * fq) * 64 + vrow; yo[0] = yD[0]; yo[64] = yD[1]; yo[128] = yD[2]; yo[192] = yD[3]; }
#undef SQ_KA
            } else {
                if (c + SQ_D < nch) SQ_ISSUE(c + SQ_D);
                if (c + 1 < nch) { const int last = c + SQ_D < nch ? c + SQ_D : nch - 1; SQ_WAIT(last - (c + 1)); }
                if (c > 0) SQ_POST(c - 1);
            }
            asm volatile("s_waitcnt lgkmcnt(0)" ::: "memory"); __builtin_amdgcn_s_barrier(); asm volatile("" ::: "memory");
        }
        if (!is_cons) SQ_POST(nch - 1);
#undef SQ_ISSUE
#undef SQ_WAIT
#undef SQ_POST
        if (is_cons) { float* so = F.out + (samp ? O_WKS : O_WKP) + ((((size_t)l * 8 + b) * 16 + h) * 64 + vrow) * 64 + 4 * fq;
#pragma unroll
            for (int kb = 0; kb < 4; ++kb) *(f32x4*)(so + 16 * kb) = sreg[kb]; }
    }
    VM_WAIT(); __syncthreads();
}

__device__ __forceinline__ void tile64_mma(const bf16_t* A, int lda, const bf16_t* Bt, int ldb, int K, int m0, int n0, int wave, int lane, f32x4 (&acc)[4][4]) {
    const int kq = K >> 3, kb = wave * kq, lr = lane & 15, lk = (lane >> 4) * 8;
    const bf16_t* ap = A + (size_t)(m0 + lr) * lda + kb + lk; const bf16_t* bp = Bt + (size_t)(n0 + lr) * ldb + kb + lk;
#pragma unroll 2
    for (int k = 0; k < kq; k += 32) {
        bf16x8 af[4], bf[4];
#pragma unroll
        for (int i = 0; i < 4; ++i) { af[i] = *(const bf16x8*)(ap + (size_t)(16 * i) * lda + k); bf[i] = *(const bf16x8*)(bp + (size_t)(16 * i) * ldb + k); }
#pragma unroll
        for (int mi = 0; mi < 4; ++mi)
#pragma unroll
            for (int ni = 0; ni < 4; ++ni) acc[mi][ni] = __builtin_amdgcn_mfma_f32_16x16x32_bf16(bf[ni], af[mi], acc[mi][ni], 0, 0, 0);
    }
}
__device__ __forceinline__ void tile64_reduce(LAS unsigned char* lds, int wave, int lane, const f32x4 (&acc)[4][4], f32x4 (&out)[2]) {
    LAS f32x4* red = (LAS f32x4*)lds;
    __syncthreads();
#pragma unroll
    for (int mi = 0; mi < 4; ++mi)
#pragma unroll
        for (int ni = 0; ni < 4; ++ni) red[(wave * 16 + mi * 4 + ni) * 64 + lane] = acc[mi][ni];
    __syncthreads();
#pragma unroll
    for (int j = 0; j < 2; ++j) { f32x4 s = red[(2 * wave + j) * 64 + lane];
#pragma unroll
        for (int w = 1; w < 8; ++w) s += red[(w * 16 + 2 * wave + j) * 64 + lane];
        out[j] = s; }
}
#define T64_ZERO(acc) do { _Pragma("unroll") for (int mi = 0; mi < 4; ++mi) _Pragma("unroll") for (int ni = 0; ni < 4; ++ni) acc[mi][ni] = (f32x4){0.f, 0.f, 0.f, 0.f}; } while (0)
template <int MODE>
__device__ __forceinline__ void sample_tiles(Frame& F, int l_in, int c0 = 0) {
    PHASE_IDS
    unsigned char* const wsl = fresh(F.ws);
    PHASE_L
    const size_t xb_cur = (l & 1) ? WS_XB2 : WS_XN, xb_nxt = (l & 1) ? WS_XN : WS_XB2;
    for (int t = (int)blockIdx.x >= c0 ? (int)blockIdx.x - c0 : 256; t < 256; t += fresh_i(F.G) - c0) {
        const int m0 = MPR + (t >> 5) * 64, n0 = (t & 31) * 64;
        f32x4 acc[4][4], o1[2], o2[2]; T64_ZERO(acc);
        u32x2 pa[2], pb[2]; float prs[2];
#pragma unroll
        for (int j = 0; j < 2; ++j) { const int blk = 2 * wave + j; const size_t row = (size_t)(m0 + 16 * (blk >> 2) + (lane & 15)); const int col = n0 + 16 * (blk & 3) + 4 * (lane >> 4);
            pa[j] = (u32x2){0u, 0u}; pb[j] = pa[j]; prs[j] = 0.f;
            if (MODE == 0) { const bf16_t* PROJ = (const bf16_t*)(wsl + WS_PROJ); pa[j] = *(const u32x2*)(PROJ + row * ICP + PC_GP + col); pb[j] = *(const u32x2*)(PROJ + row * ICP + PC_GR + col); }
            if (MODE == 1 || MODE == 2) pa[j] = *(const u32x2*)((const bf16_t*)(wsl + xb_cur) + row * DM + col);
            if (MODE == 3) { pa[j] = *(const u32x2*)((const bf16_t*)(wsl + WS_PP) + row * DM + col); pb[j] = *(const u32x2*)((const bf16_t*)(wsl + xb_cur) + row * DM + col); prs[j] = pg8::rstd_of((const pg8::ss_t*)(wsl + WS_SS) + (size_t)2 * MT, row); } }
        if (MODE == 0) { tile64_mma((const bf16_t*)(wsl + WS_YA), PWD, (const bf16_t*)(wsl + WS_PPOOL), PWD, PWD, m0, n0, wave, lane, acc); tile64_reduce(F.lds, wave, lane, acc, o1);
                         T64_ZERO(acc); tile64_mma((const bf16_t*)(wsl + WS_YB), RWD, (const bf16_t*)(wsl + WS_PRWKV), RWD, RWD, m0, n0, wave, lane, acc); tile64_reduce(F.lds, wave, lane, acc, o2); }
        if (MODE == 1) { tile64_mma((const bf16_t*)(wsl + WS_MRG), DM, (const bf16_t*)(wsl + WS_WOUT), DM, DM, m0, n0, wave, lane, acc); tile64_reduce(F.lds, wave, lane, acc, o1); }
        if (MODE == 2) { tile64_mma((const bf16_t*)(wsl + WS_HID), FF, (const bf16_t*)(wsl + WS_WDN), FF, FF, m0, n0, wave, lane, acc); tile64_reduce(F.lds, wave, lane, acc, o1); }
        if (MODE == 3) { tile64_mma((const bf16_t*)(wsl + xb_cur), DM, (const bf16_t*)(wsl + WS_WPG), DM, DM, m0, n0, wave, lane, acc); tile64_reduce(F.lds, wave, lane, acc, o1); }
        if (MODE == 4) { tile64_mma((const bf16_t*)(wsl + WS_PB), PLE, (const bf16_t*)(wsl + WS_WPP), PLE, PLE, m0, n0, wave, lane, acc); tile64_reduce(F.lds, wave, lane, acc, o1); }
#pragma unroll
        for (int j = 0; j < 2; ++j) { const int blk = 2 * wave + j; const size_t row = (size_t)(m0 + 16 * (blk >> 2) + (lane & 15)); const int col = n0 + 16 * (blk & 3) + 4 * (lane >> 4);
            if (MODE == 0) { const u32x2 g1 = pa[j], g2 = pb[j];
                const f32x4 a = (f32x4){bf_lo(g1.x), bf_hi(g1.x), bf_lo(g1.y), bf_hi(g1.y)} * o1[j] + (f32x4){bf_lo(g2.x), bf_hi(g2.x), bf_lo(g2.y), bf_hi(g2.y)} * o2[j];
                *(u32x2*)((bf16_t*)(wsl + WS_MRG) + row * DM + col) = (u32x2){cvt_pk_bf16(a.x, a.y), cvt_pk_bf16(a.z, a.w)}; }
            if (MODE == 1 || MODE == 2) { bf16_t* p = (bf16_t*)(wsl + xb_cur) + row * DM + col; const u32x2 q = pa[j]; const f32x4 x = (f32x4){bf_lo(q.x), bf_hi(q.x), bf_lo(q.y), bf_hi(q.y)} + o1[j];
                *(u32x2*)p = (u32x2){cvt_pk_bf16(x.x, x.y), cvt_pk_bf16(x.z, x.w)}; __hip_atomic_fetch_add((pg8::ss_t*)(wsl + WS_SS) + (size_t)MODE * MT + row, pg8::ss_fix((x.x * x.x + x.y * x.y) + (x.z * x.z + x.w * x.w)), __ATOMIC_RELAXED, __HIP_MEMORY_SCOPE_AGENT); }
            if (MODE == 3) { const u32x2 q = pa[j]; const u32x2 xq = pb[j]; bf16_t* p = (bf16_t*)(wsl + xb_nxt) + row * DM + col;
                const float rs = prs[j];
                const f32x4 x = (f32x4){bf_lo(xq.x), bf_hi(xq.x), bf_lo(xq.y), bf_hi(xq.y)} + sigmoid4(o1[j] * rs) * (f32x4){bf_lo(q.x), bf_hi(q.x), bf_lo(q.y), bf_hi(q.y)};
                *(u32x2*)p = (u32x2){cvt_pk_bf16(x.x, x.y), cvt_pk_bf16(x.z, x.w)}; __hip_atomic_fetch_add((pg8::ss_t*)(wsl + WS_SS) + row, pg8::ss_fix((x.x * x.x + x.y * x.y) + (x.z * x.z + x.w * x.w)), __ATOMIC_RELAXED, __HIP_MEMORY_SCOPE_AGENT); }
            if (MODE == 4) *(u32x2*)((bf16_t*)(wsl + WS_PP) + row * DM + col) = (u32x2){cvt_pk_bf16(o1[j].x, o1[j].y), cvt_pk_bf16(o1[j].z, o1[j].w)};
        }
    }
    __syncthreads();
}

constexpr int PH_PER_LAYER = 11, N_PHASES = NL * PH_PER_LAYER + 1;
#ifndef MK_REP
#define MK_REP 0
#endif
__global__ void __launch_bounds__(NTHR, 2) mega_fwd(Args args) {
    extern __shared__ __attribute__((aligned(16))) unsigned char lds[];
    Frame F;
    F.lds = (LAS unsigned char*)lds;
    F.G = gridDim.x;
    F.out = args.out; F.ws = args.ws;
    { LAS unsigned long long* pt = (LAS unsigned long long*)(F.lds + LDSCTL_OFF + 1024); F.ptab = pt;
      if (threadIdx.x == 0) {
#define PT_(k) pt[k] = (unsigned long long)args.in[k];
          PT_(0) PT_(1) PT_(2) PT_(3) PT_(4) PT_(5) PT_(6) PT_(7) PT_(8) PT_(9) PT_(10) PT_(11) PT_(12) PT_(13) PT_(14) PT_(15) PT_(16) PT_(17) PT_(18) PT_(19) PT_(20) PT_(21) PT_(22) PT_(23) PT_(24) PT_(25) PT_(26) PT_(27) PT_(28) PT_(29) PT_(30) PT_(31) PT_(32)
#undef PT_
      } }
    volatile LAS unsigned* MISC = (volatile LAS unsigned*)(F.lds + LDSCTL_OFF);
    for (int u = threadIdx.x; u < 256; u += NTHR) ((LAS unsigned*)(F.lds + LDSCTL_OFF))[u] = 0u;
    __syncthreads();
    XcdBarrier bar; bar.bar = (unsigned*)(args.ws + WS_CTL) + CW_BAR; bar.x = 0; bar.st = nullptr;
    if (!MK_PER_PHASE) bar = xcd_barrier_post((unsigned*)(args.ws + WS_CTL) + CW_BAR, MISC + 8);
    const int lo = args.ph_lo, hi = args.ph_hi;
#define IN(k) (lo <= (k) && (k) < hi)
#define REP(k) (1 + ((MK_REP >> (k)) & 1))
#define PHASE(k, ...) do { if (IN(pb + (k))) { for (int rep = 0; rep < REP(k); ++rep) { if (rep) xcd_barrier(bar); __VA_ARGS__ } if (IN(pb + (k) + 1)) xcd_barrier(bar); } } while (0)
#define WSP(off) (fresh(F.ws) + (off))
#define UNPAREN(...) __VA_ARGS__
#define GEMM_M(M_, EPI, EINIT, Aoff, Boff, N_, K_, lda_, ldb_, apn_) do { pg8::Gemm g{(const bf16_t*)WSP(Aoff), (const bf16_t*)WSP(Boff), (M_), (N_), (K_), (lda_), (ldb_), (apn_)}; pg8::StaticOrder S; S.init((M_), (N_), fresh_i(F.G), fresh_i(cid)); \
        pg8::EPI E{UNPAREN EINIT}; pg8::gemm_phase<pg8::EPI, pg8::StaticOrder, true>(ring, g, S, E); } while (0)
#define GEMM(...) GEMM_M(MT, __VA_ARGS__)
#define GEMM_PAIR(M_, EPI, EINIT, Aoff, A2off, Boff, N_, K_, lda_, ldb_) do { pg8::Gemm g{(const bf16_t*)WSP(Aoff), (const bf16_t*)WSP(Boff), (M_), (N_), (K_), (lda_), (ldb_), (int)(((A2off) - (Aoff)) / 2)}; pg8::PairOrder S; \
        S.init((M_), (N_), fresh_i(F.G), fresh_i(cid)); pg8::EPI E{UNPAREN EINIT}; pg8::gemm_phase<pg8::EPI, pg8::PairOrder, true>(ring, g, S, E); } while (0)
#define GEMM_SUB(c0_, M_, EPI, EINIT, Aoff, Boff, N_, K_, lda_, ldb_, apn_) do { pg8::Gemm g{(const bf16_t*)WSP(Aoff), (const bf16_t*)WSP(Boff), (M_), (N_), (K_), (lda_), (ldb_), (apn_)}; pg8::StaticOrder S; \
        const int c0v = (c0_); S.init((M_), (N_), fresh_i(F.G) - c0v, fresh_i(cid) >= c0v ? fresh_i(cid) - c0v : -1); pg8::EPI E{UNPAREN EINIT}; pg8::gemm_phase<pg8::EPI, pg8::StaticOrder, true>(ring, g, S, E); } while (0)
    LAS unsigned char* ring = F.lds;
    const int cid = (int)blockIdx.x;
    for (int l = 0; l < NL; ++l) {
        const int pb = l * PH_PER_LAYER;
#define SSP(i) ((pg8::ss_t*)WSP(WS_SS) + (size_t)(i) * MT)
        const size_t xb_cur = (l & 1) ? WS_XB2 : WS_XN, xb_nxt = (l & 1) ? WS_XN : WS_XB2;
        if (l == 0) PHASE(0, { convert_weights(F, l, 0); xb_from_input(F); });
        PHASE(1, { GEMM(EpiProj, ((bf16_t*)WSP(WS_PROJ), SSP(0)), xb_cur, WS_WIN, ICP, DM, DM, DM, 0); if (l > 0) convert_weights(F, l, 2); });
        PHASE(2, { prep1_phase(F, l); });
        PHASE(3, { GEMM(EpiBf16, ((bf16_t*)WSP(WS_YA), PWD), WS_D, WS_POOLW, PWD, 256, PWD, 256, 256);
                   GEMM(EpiLora, ((float*)WSP(WS_DEC), (bf16_t*)WSP(WS_AA), (bf16_t*)WSP(WS_GG), INP(12) + (size_t)fresh_i(l) * RWD, INP(14) + (size_t)fresh_i(l) * RWD), WS_LIN, WS_LORA, 3072, LK, LK, LK, 0); });
        PHASE(4, { spre_phase(F, l); });
        PHASE(5, { sseq_phase(F, l);
                   { const int c0 = fresh_i(F.G) >= 256 ? 128 : 0; GEMM_SUB(c0, MPR, EpiBf16, ((bf16_t*)WSP(WS_PP), DM), WS_PB, WS_WPP, DM, PLE, PLE, PLE, 0); sample_tiles<4>(F, l, c0); } });
        PHASE(6, { GEMM_PAIR(MPR, EpiGatePair, ((const bf16_t*)WSP(WS_PROJ), PC_GP, PC_GR, (bf16_t*)WSP(WS_MRG)), WS_YA, WS_YB, WS_PPOOL, DM, PWD, PWD, PWD);
                   sample_tiles<0>(F, l); });
        PHASE(7, { GEMM_M(MPR, EpiResid, ((bf16_t*)WSP(xb_cur), SSP(1)), WS_MRG, WS_WOUT, DM, DM, DM, DM, 0); sample_tiles<1>(F, l); });
        PHASE(8, { GEMM(EpiSwiglu, ((bf16_t*)WSP(WS_HID), SSP(1)), xb_cur, WS_WGU, 2 * FF, DM, DM, DM, 0); });
        PHASE(9, { GEMM_M(MPR, EpiResid, ((bf16_t*)WSP(xb_cur), SSP(2)), WS_HID, WS_WDN, DM, FF, FF, FF, 0); sample_tiles<2>(F, l); });
        PHASE(10, { GEMM_M(MPR, EpiPle, ((const bf16_t*)WSP(xb_cur), (bf16_t*)WSP(xb_nxt), (const bf16_t*)WSP(WS_PP), SSP(2), SSP(0)), xb_cur, WS_WPG, DM, DM, DM, DM, 0); sample_tiles<3>(F, l); if (l + 1 < NL) convert_weights(F, l + 1, 1); });
#undef SSP
    }
    if (IN(NL * PH_PER_LAYER)) final_norm(F, INP(32));
#undef IN
#undef REP
#undef PHASE
#undef WSP
#undef GEMM
#undef GEMM_M
#undef GEMM_SUB
#undef UNPAREN
}

extern "C" void kernel_launch(void* const* d_in, const int* in_sizes, int n_in, void* d_out, int out_size, void* d_ws, size_t ws_size, hipStream_t stream) {
    static int grid = 0;
    if (grid == 0) {
        if (n_in != 33 || in_sizes[0] != MPR * DM || out_size != (int)O_END || ws_size < WS_END) {
            fprintf(stderr, "kernel_launch: unexpected shapes: n_in %d in0 %d out %d ws %zu (need %zu); nothing launched\n", n_in, n_in > 0 ? in_sizes[0] : -1, out_size, ws_size, (size_t)WS_END); grid = -1; return; }
        int dev = 0, cus = 0, per_cu = 0;
        if (hipGetDevice(&dev) != hipSuccess || hipDeviceGetAttribute(&cus, hipDeviceAttributeMultiprocessorCount, dev) != hipSuccess) { grid = -1; return; }
        if (hipFuncSetAttribute((const void*)mega_fwd, hipFuncAttributeMaxDynamicSharedMemorySize, LDS_BYTES) != hipSuccess) { fprintf(stderr, "kernel_launch: hipFuncSetAttribute failed\n"); grid = -1; return; }
        if (hipOccupancyMaxActiveBlocksPerMultiprocessor(&per_cu, (const void*)mega_fwd, NTHR, LDS_BYTES) != hipSuccess || per_cu < 1) { fprintf(stderr, "kernel_launch: occupancy query says %d\n", per_cu); (void)hipGetLastError(); grid = -1; return; }
        grid = cus;
    }
    if (grid < 0) return;
    (void)hipMemsetAsync((char*)d_ws + WS_CTL, 0, CTL_ZERO_BYTES, stream);
    Args a; memset(&a, 0, sizeof(a));
    for (int i = 0; i < 33; ++i) a.in[i] = (const float*)d_in[i];
    a.out = (float*)d_out; a.ws = (unsigned char*)d_ws;
#if MK_PER_PHASE
    for (int p = 0; p < N_PHASES; ++p) { a.ph_lo = p; a.ph_hi = p + 1; hipLaunchKernelGGL(mega_fwd, dim3(grid), dim3(NTHR), LDS_BYTES, stream, a); }
#else
    a.ph_lo = 0; a.ph_hi = N_PHASES; hipLaunchKernelGGL(mega_fwd, dim3(grid), dim3(NTHR), LDS_BYTES, stream, a);
#endif
}
```
